# Optimizing an MI355X kernel written in HIP

```python
import math
import jax
import jax.numpy as jnp
from jax import lax
import numpy as np

D_MODEL = 1024
BATCH = 16
SEQ = 256
DEPTH = 4
DEC_BATCH = 8
DEC_SEQ = 2048
PAST_LEN = 512

GRID_W = 64
N_MIXERS = 3
N_LAYERS_A = (DEPTH + 2) // N_MIXERS
N_LAYERS_B = (DEPTH + 1) // N_MIXERS
N_LAYERS_C = DEPTH // N_MIXERS
D_FF = 4 * D_MODEL
N_MOD = 6
EPS = 1e-6
ROPE_THETA = 10000.0
Q_BLOCK = 128
H_A = 8
DK_A = 128
DV_A = 128
WK_A = H_A * DK_A
WV_A = H_A * DV_A
CONV_K = 3
CHUNK = 64
H_B = 8
Q_LORA = 384
KV_LORA = 256
NOPE_B = 128
ROPE_B = 64
V_B = 128
H_C = 8
KVH_C = 2
HD_C = 128

kernel_name = 'hybrid_gdn_mla_gqa_diffusion_step'


def rms_norm(x, g):
    xf = x.astype(jnp.float32)
    y = xf * lax.rsqrt(jnp.mean(xf * xf, axis=-1, keepdims=True) + EPS)
    return (y * g.astype(jnp.float32)).astype(x.dtype)


def l2_norm(x):
    xf = x.astype(jnp.float32)
    return (xf * lax.rsqrt(jnp.sum(xf * xf, axis=-1, keepdims=True) + EPS)).astype(x.dtype)


def adaln(cond, w_mod, b_mod):
    m = jax.nn.silu(cond) @ w_mod + b_mod
    return jnp.split(m[:, None, :], N_MOD, axis=-1)


def modulated_norm(x, g, shift, scale):
    return rms_norm(x, g) * (1 + scale) + shift


def sq_relu_mlp(h, w_in, w_out):
    return jnp.square(jax.nn.relu(h @ w_in)) @ w_out


def grid_positions(rows):
    row = jnp.repeat(jnp.arange(rows, dtype=jnp.float32), GRID_W)
    col = jnp.tile(jnp.arange(GRID_W, dtype=jnp.float32), rows)
    return row, col


def rope_1d(x, pos):
    half = x.shape[-1] // 2
    freqs = ROPE_THETA ** (-jnp.arange(half, dtype=jnp.float32) / half)
    ang = pos[:, None] * freqs[None, :]
    cos = jnp.cos(ang)[None, :, None, :]
    sin = jnp.sin(ang)[None, :, None, :]
    x1 = x[..., :half].astype(jnp.float32)
    x2 = x[..., half:].astype(jnp.float32)
    return jnp.concatenate([x1 * cos - x2 * sin, x1 * sin + x2 * cos], axis=-1).astype(x.dtype)


def axial_rope(x, row_pos, col_pos):
    half = x.shape[-1] // 2
    return jnp.concatenate([rope_1d(x[..., :half], row_pos), rope_1d(x[..., half:], col_pos)], axis=-1)


def block_attention(q, k, v):
    b, sq, h, dk = q.shape
    hk, dv = k.shape[2], v.shape[-1]
    grp = h // hk
    scale = dk ** -0.5
    qb = jnp.moveaxis(q.reshape(b, sq // Q_BLOCK, Q_BLOCK, hk, grp, dk), 1, 0)

    def one_block(q_blk):
        s = jnp.einsum('bqkgd,bskd->bkgqs', q_blk, k, preferred_element_type=jnp.float32) * scale
        p = jax.nn.softmax(s, axis=-1).astype(v.dtype)
        return jnp.einsum('bkgqs,bskd->bqkgd', p, v)

    o = lax.map(one_block, qb)
    return jnp.moveaxis(o, 0, 1).reshape(b, sq, h, dv)


def centred_depthwise_conv(x, w):
    pad = (CONV_K - 1) // 2
    return lax.conv_general_dilated(x, w[:, None, :].astype(x.dtype), window_strides=(1,),
                                    padding=[(pad, pad)], dimension_numbers=('NWC', 'WIO', 'NWC'),
                                    feature_group_count=x.shape[-1])


def gated_delta_chunked(q, k, v, g, beta, s0):
    f32 = jnp.float32
    b, n_tok, h, _ = q.shape
    dv = v.shape[-1]
    n = n_tok // CHUNK

    def chunks(t):
        t = t.astype(f32).reshape((b, n, CHUNK, h) + t.shape[3:])
        return jnp.moveaxis(t, 3, 1)

    qc, kc, vc, gc, bc = map(chunks, (q, k, v, g, beta))
    gcum = jnp.cumsum(gc, axis=-1)
    idx = jnp.arange(CHUNK)
    incl = idx[:, None] >= idx[None, :]
    strict = idx[:, None] > idx[None, :]
    decay = jnp.exp(jnp.where(incl, gcum[..., :, None] - gcum[..., None, :], -jnp.inf))
    kb = kc * bc[..., None]
    a_mat = jnp.where(strict, jnp.einsum('bhncd,bhnmd->bhncm', kb, kc) * decay, 0.0)
    lower = a_mat + jnp.eye(CHUNK, dtype=f32)
    rhs = jnp.concatenate([vc * bc[..., None], kb * jnp.exp(gcum)[..., None]], axis=-1)
    sol = lax.linalg.triangular_solve(lower, rhs, left_side=True, lower=True, unit_diagonal=True)
    u, w = sol[..., :dv], sol[..., dv:]
    qk = jnp.einsum('bhncd,bhnmd->bhncm', qc, kc) * decay
    q_dec = qc * jnp.exp(gcum)[..., None]
    k_dec = kc * jnp.exp(gcum[..., -1:] - gcum)[..., None]
    g_tot = jnp.exp(gcum[..., -1])
    xs = tuple(jnp.moveaxis(t, 2, 0) for t in (u, w, qk, q_dec, k_dec, g_tot))

    def step(state, xs_i):
        u_i, w_i, qk_i, qd_i, kd_i, gt_i = xs_i
        v_new = u_i - jnp.einsum('bhcd,bhde->bhce', w_i, state)
        o_i = jnp.einsum('bhcd,bhde->bhce', qd_i, state) + jnp.einsum('bhcm,bhme->bhce', qk_i, v_new)
        state = state * gt_i[..., None, None] + jnp.einsum('bhcd,bhce->bhde', kd_i, v_new)
        return state, o_i

    s_fin, o = lax.scan(step, s0.astype(f32), xs)
    o = jnp.transpose(o, (1, 0, 3, 2, 4)).reshape(b, n_tok, h, dv)
    return o.astype(v.dtype), s_fin


def gdn_mixer(h, p, s0_fwd, s0_bwd):
    w_in, conv_w, a_log, dt_bias, out_norm, w_out = p
    b, s, _ = h.shape
    proj = h @ w_in
    n_qkv = 2 * WK_A + WV_A
    qkv = jax.nn.silu(centred_depthwise_conv(proj[..., :n_qkv], conv_w))
    z = proj[..., n_qkv:n_qkv + WV_A]
    gb = proj[..., n_qkv + WV_A:].astype(jnp.float32).reshape(b, s, 2, 2, H_A)
    q = l2_norm(qkv[..., :WK_A].reshape(b, s, H_A, DK_A)) * (DK_A ** -0.5)
    k = l2_norm(qkv[..., WK_A:2 * WK_A].reshape(b, s, H_A, DK_A))
    v = qkv[..., 2 * WK_A:].reshape(b, s, H_A, DV_A)
    g = -jnp.exp(a_log.astype(jnp.float32)) * jax.nn.softplus(gb[:, :, 0] + dt_bias.astype(jnp.float32))
    beta = jax.nn.sigmoid(gb[:, :, 1])
    o_f, s_f = gated_delta_chunked(q, k, v, g[:, :, 0], beta[:, :, 0], s0_fwd)
    rev = lambda t: jnp.flip(t, axis=1)
    o_b, s_b = gated_delta_chunked(rev(q), rev(k), rev(v), rev(g[:, :, 1]), rev(beta[:, :, 1]), s0_bwd)
    o = rms_norm(o_f + rev(o_b), out_norm) * jax.nn.silu(z).reshape(b, s, H_A, DV_A)
    return o.reshape(b, s, WV_A) @ w_out, s_f, s_b


def mla_project(h, p):
    w_down, q_lat_g, kv_lat_g, w_uq, w_ukv, qn_nope, qn_rope, kn_nope, kn_rope, w_out = p
    b, s, _ = h.shape
    proj = h @ w_down
    cq = rms_norm(proj[..., :Q_LORA], q_lat_g)
    ckv = rms_norm(proj[..., Q_LORA:Q_LORA + KV_LORA], kv_lat_g)
    k_rope = rms_norm(proj[..., Q_LORA + KV_LORA:], kn_rope)
    q = (cq @ w_uq).reshape(b, s, H_B, NOPE_B + ROPE_B)
    return rms_norm(q[..., :NOPE_B], qn_nope), rms_norm(q[..., NOPE_B:], qn_rope), ckv, k_rope


def mla_keys_values(ckv, k_rope, p):
    w_ukv, kn_nope = p[4], p[7]
    b, s, _ = ckv.shape
    kv = (ckv @ w_ukv).reshape(b, s, H_B, NOPE_B + V_B)
    k_nope = rms_norm(kv[..., :NOPE_B], kn_nope)
    k_rope_h = jnp.broadcast_to(k_rope[:, :, None, :], (b, s, H_B, ROPE_B))
    return jnp.concatenate([k_nope, k_rope_h], axis=-1), kv[..., NOPE_B:]


def mla_context(h, p):
    b, s, _ = h.shape
    q_nope, q_rope, ckv, k_rope = mla_project(h, p)
    k, v = mla_keys_values(ckv, k_rope, p)
    o = block_attention(jnp.concatenate([q_nope, q_rope], axis=-1), k, v)
    return o.reshape(b, s, H_B * V_B) @ p[9], ckv, k_rope


def mla_latent(h, ckv_ctx, krope_ctx, row_pos, col_pos, p):
    b, s, _ = h.shape
    q_nope, q_rope, ckv, k_rope = mla_project(h, p)
    q_rope = axial_rope(q_rope, row_pos, col_pos)
    k_rope = axial_rope(k_rope[:, :, None, :], row_pos, col_pos)[:, :, 0]
    k_lat, v_lat = mla_keys_values(ckv, k_rope, p)
    k_ctx, v_ctx = mla_keys_values(ckv_ctx, krope_ctx, p)
    o = block_attention(jnp.concatenate([q_nope, q_rope], axis=-1),
                        jnp.concatenate([k_ctx, k_lat], axis=1), jnp.concatenate([v_ctx, v_lat], axis=1))
    return o.reshape(b, s, H_B * V_B) @ p[9]


def gqa_project(h, p):
    w_in, q_g, k_g, _ = p
    b, s, _ = h.shape
    proj = h @ w_in
    q = rms_norm(proj[..., :H_C * HD_C].reshape(b, s, H_C, HD_C), q_g)
    k = rms_norm(proj[..., H_C * HD_C:(H_C + KVH_C) * HD_C].reshape(b, s, KVH_C, HD_C), k_g)
    v = proj[..., (H_C + KVH_C) * HD_C:].reshape(b, s, KVH_C, HD_C)
    return q, k, v


def gqa_context(h, p):
    b, s, _ = h.shape
    q, k, v = gqa_project(h, p)
    o = block_attention(q, k, v)
    return o.reshape(b, s, H_C * HD_C) @ p[3], k, v


def gqa_latent(h, k_ctx, v_ctx, row_pos, col_pos, p):
    b, s, _ = h.shape
    q, k, v = gqa_project(h, p)
    q = axial_rope(q, row_pos, col_pos)
    k = axial_rope(k, row_pos, col_pos)
    o = block_attention(q, jnp.concatenate([k_ctx, k], axis=1), jnp.concatenate([v_ctx, v], axis=1))
    return o.reshape(b, s, H_C * HD_C) @ p[3]


def setup_inputs(seed: int = 0) -> dict:
    key = jax.random.key(seed)
    keys = iter(jax.random.split(key, 64))
    f32 = jnp.float32
    d = D_MODEL

    def normal(shape, scale):
        return scale * jax.random.normal(next(keys), shape, f32)

    def gain(shape):
        return 1.0 + 0.05 * jax.random.normal(next(keys), shape, f32)

    a_log = jnp.log(jax.random.uniform(next(keys), (N_LAYERS_A, 2, H_A), f32, 1.0, 16.0))
    dt = jnp.exp(jax.random.uniform(next(keys), (N_LAYERS_A, 2, H_A), f32, math.log(1e-3), math.log(1e-1)))
    dt_bias = dt + jnp.log(-jnp.expm1(-dt))
    return {
        'x_prompt': normal((BATCH, SEQ, d), 1.0),
        'x_sample': normal((DEC_BATCH, DEC_SEQ, d), 1.0),
        'state_gdn_fwd': normal((DEC_BATCH, N_LAYERS_A, H_A, DK_A, DV_A), 0.2),
        'state_gdn_bwd': normal((DEC_BATCH, N_LAYERS_A, H_A, DK_A, DV_A), 0.2),
        'cache_mla_ckv': normal((DEC_BATCH, N_LAYERS_B, PAST_LEN, KV_LORA), 1.0),
        'cache_mla_krope': normal((DEC_BATCH, N_LAYERS_B, PAST_LEN, ROPE_B), 1.0),
        'cache_gqa_k': normal((DEC_BATCH, N_LAYERS_C, PAST_LEN, KVH_C, HD_C), 1.0),
        'cache_gqa_v': normal((DEC_BATCH, N_LAYERS_C, PAST_LEN, KVH_C, HD_C), 1.0),
        'c': normal((DEC_BATCH, d), 1.0),
        'c_ctx': normal((d,), 1.0),
        'norm_mix': gain((DEPTH, d)),
        'norm_mlp': gain((DEPTH, d)),
        'w_mod': normal((DEPTH, d, N_MOD * d), 0.5 * d ** -0.5),
        'b_mod': normal((DEPTH, N_MOD * d), 0.02),
        'w_mlp_in': normal((DEPTH, d, D_FF), d ** -0.5),
        'w_mlp_out': normal((DEPTH, D_FF, d), D_FF ** -0.5),
        'gdn_w_in': normal((N_LAYERS_A, d, 2 * WK_A + 2 * WV_A + 4 * H_A), d ** -0.5),
        'gdn_conv': normal((N_LAYERS_A, CONV_K, 2 * WK_A + WV_A), CONV_K ** -0.5),
        'gdn_a_log': a_log,
        'gdn_dt_bias': dt_bias,
        'gdn_out_norm': gain((N_LAYERS_A, DV_A)),
        'gdn_w_out': normal((N_LAYERS_A, WV_A, d), WV_A ** -0.5),
        'mla_w_down': normal((N_LAYERS_B, d, Q_LORA + KV_LORA + ROPE_B), d ** -0.5),
        'mla_q_lat_norm': gain((N_LAYERS_B, Q_LORA)),
        'mla_kv_lat_norm': gain((N_LAYERS_B, KV_LORA)),
        'mla_w_uq': normal((N_LAYERS_B, Q_LORA, H_B * (NOPE_B + ROPE_B)), Q_LORA ** -0.5),
        'mla_w_ukv': normal((N_LAYERS_B, KV_LORA, H_B * (NOPE_B + V_B)), KV_LORA ** -0.5),
        'mla_qn_nope': gain((N_LAYERS_B, NOPE_B)),
        'mla_qn_rope': gain((N_LAYERS_B, ROPE_B)),
        'mla_kn_nope': gain((N_LAYERS_B, NOPE_B)),
        'mla_kn_rope': gain((N_LAYERS_B, ROPE_B)),
        'mla_w_out': normal((N_LAYERS_B, H_B * V_B, d), (H_B * V_B) ** -0.5),
        'gqa_w_in': normal((N_LAYERS_C, d, (H_C + 2 * KVH_C) * HD_C), d ** -0.5),
        'gqa_q_norm': gain((N_LAYERS_C, HD_C)),
        'gqa_k_norm': gain((N_LAYERS_C, HD_C)),
        'gqa_w_out': normal((N_LAYERS_C, H_C * HD_C, d), (H_C * HD_C) ** -0.5),
    }


def reference(x_prompt, x_sample, state_gdn_fwd, state_gdn_bwd, cache_mla_ckv, cache_mla_krope, cache_gqa_k,
              cache_gqa_v, c, c_ctx, norm_mix, norm_mlp, w_mod, b_mod, w_mlp_in, w_mlp_out, gdn_w_in, gdn_conv,
              gdn_a_log, gdn_dt_bias, gdn_out_norm, gdn_w_out, mla_w_down, mla_q_lat_norm, mla_kv_lat_norm,
              mla_w_uq, mla_w_ukv, mla_qn_nope, mla_qn_rope, mla_kn_nope, mla_kn_rope, mla_w_out, gqa_w_in,
              gqa_q_norm, gqa_k_norm, gqa_w_out):
    rows = x_sample.shape[1] // GRID_W
    row_pos, col_pos = grid_positions(rows)
    xp, xs = x_prompt, x_sample
    bp = x_prompt.shape[0]
    cond_ctx = c_ctx[None, :]
    gdn_f, gdn_b, mla_c, mla_r, gqa_k, gqa_v = [], [], [], [], [], []
    for i in range(DEPTH):
        kind, j = i % N_MIXERS, i // N_MIXERS
        mp = adaln(cond_ctx, w_mod[i], b_mod[i])
        ms = adaln(c, w_mod[i], b_mod[i])
        hp = modulated_norm(xp, norm_mix[i], mp[0], mp[1])
        hs = modulated_norm(xs, norm_mix[i], ms[0], ms[1])
        if kind == 0:
            p = (gdn_w_in[j], gdn_conv[j], gdn_a_log[j], gdn_dt_bias[j], gdn_out_norm[j], gdn_w_out[j])
            zero = jnp.zeros((bp, H_A, DK_A, DV_A), jnp.float32)
            op, s_f, s_b = gdn_mixer(hp, p, zero, zero)
            os_, _, _ = gdn_mixer(hs, p, state_gdn_fwd[:, j], state_gdn_bwd[:, j])
            gdn_f.append(s_f)
            gdn_b.append(s_b)
        elif kind == 1:
            p = (mla_w_down[j], mla_q_lat_norm[j], mla_kv_lat_norm[j], mla_w_uq[j], mla_w_ukv[j],
                 mla_qn_nope[j], mla_qn_rope[j], mla_kn_nope[j], mla_kn_rope[j], mla_w_out[j])
            op, ckv, kr = mla_context(hp, p)
            os_ = mla_latent(hs, cache_mla_ckv[:, j], cache_mla_krope[:, j], row_pos, col_pos, p)
            mla_c.append(ckv)
            mla_r.append(kr)
        else:
            p = (gqa_w_in[j], gqa_q_norm[j], gqa_k_norm[j], gqa_w_out[j])
            op, kc, vc = gqa_context(hp, p)
            os_ = gqa_latent(hs, cache_gqa_k[:, j], cache_gqa_v[:, j], row_pos, col_pos, p)
            gqa_k.append(kc)
            gqa_v.append(vc)
        xp = xp + mp[2] * op
        xs = xs + ms[2] * os_
        hp = modulated_norm(xp, norm_mlp[i], mp[3], mp[4])
        hs = modulated_norm(xs, norm_mlp[i], ms[3], ms[4])
        xp = xp + mp[5] * sq_relu_mlp(hp, w_mlp_in[i], w_mlp_out[i])
        xs = xs + ms[5] * sq_relu_mlp(hs, w_mlp_in[i], w_mlp_out[i])
    dt = x_prompt.dtype
    new_gdn_fwd = jnp.stack(gdn_f, axis=1).astype(dt)
    new_gdn_bwd = jnp.stack(gdn_b, axis=1).astype(dt)
    new_mla_ckv = jnp.stack(mla_c, axis=1).astype(dt)
    new_mla_krope = jnp.stack(mla_r, axis=1).astype(dt)
    new_gqa_k = jnp.stack(gqa_k, axis=1).astype(dt)
    new_gqa_v = jnp.stack(gqa_v, axis=1).astype(dt)
    return (xp, xs, new_gdn_fwd, new_gdn_bwd, new_mla_ckv, new_mla_krope, new_gqa_k, new_gqa_v)
```

```cpp
#include <hip/hip_runtime.h>
#include <hip/hip_cooperative_groups.h>
#include <cstdio>
namespace cg = cooperative_groups;

typedef unsigned short u16;
typedef __attribute__((ext_vector_type(8))) short bf16x8;
typedef __attribute__((ext_vector_type(4))) short bf16x4;
typedef __attribute__((ext_vector_type(4))) float f32x4;
typedef __attribute__((ext_vector_type(4))) unsigned u32x4;
typedef __attribute__((ext_vector_type(2))) unsigned u32x2;

#define DI __device__ __forceinline__

constexpr int NTOK = 20480;
constexpr int NPROMPT = 4096;
constexpr float EPS = 1e-6f;

constexpr size_t WS_MODS = 0;
constexpr size_t MODS_BYTES = 4ull * 9 * 6144 * 4;
constexpr size_t WS_ROPE = 1048576;
constexpr size_t WS_WMIX = 1114112;
constexpr size_t WS_WMLP = 14090240;
constexpr size_t WS_HBUF = 30867456;
constexpr size_t WS_OBUF = 72810496;
constexpr size_t WS_R    = 114753536;
constexpr size_t R_ABUF = 0;
constexpr size_t R_PROJ = 0;
constexpr size_t R_VBUF = 167772160;
constexpr size_t R_TBUF = 209715200;
constexpr size_t R_GBUF = 251658240;
constexpr size_t R_GCB  = 254279680;
constexpr size_t R_BETA = 255590400;
constexpr size_t R_DPROJ = 0;
constexpr size_t R_Q    = 0;
constexpr size_t R_CQ   = 62914560;
constexpr size_t R_CKV  = 78643200;
constexpr size_t R_KM   = 91226112;
constexpr size_t R_VTM  = 166723584;
constexpr size_t R_KG   = 41943040;
constexpr size_t R_VTG  = 54525952;
constexpr size_t WM_IN = 0;
constexpr size_t WM_OUT = 4325376;
constexpr size_t WM_UQ = 5373952;
constexpr size_t WM_UKV = 5963776;
constexpr size_t O_SF = 20971520, O_SB = 25165824, O_CKV = 29360128, O_KR = 30408704, O_GK = 30670848, O_GV = 31719424;

struct P {
  const float* in[36];
  float* out;
  char* ws;
};

DI u16 f2bf(float x) { unsigned u = __float_as_uint(x); u += 0x7fffu + ((u >> 16) & 1u); return (u16)(u >> 16); }
DI float bf2f(u16 h) { return __uint_as_float(((unsigned)h) << 16); }
DI unsigned pack2(float a, float b) { return (unsigned)f2bf(a) | ((unsigned)f2bf(b) << 16); }
DI float bflo(unsigned w) { return __uint_as_float(w << 16); }
DI float bfhi(unsigned w) { return __uint_as_float(w & 0xffff0000u); }
DI f32x4 mma(bf16x8 a, bf16x8 b, f32x4 c) { return __builtin_amdgcn_mfma_f32_16x16x32_bf16(a, b, c, 0, 0, 0); }
DI bf16x8 pack8(f32x4 a, f32x4 b) {
  u32x4 p; p[0] = pack2(a[0], a[1]); p[1] = pack2(a[2], a[3]); p[2] = pack2(b[0], b[1]); p[3] = pack2(b[2], b[3]);
  return __builtin_bit_cast(bf16x8, p);
}
DI bf16x8 ld8(const u16* p) { return *(const bf16x8*)p; }
DI bf16x8 ld44(const u16* p0, const u16* p1) {
  u32x2 a = *(const u32x2*)p0; u32x2 b = *(const u32x2*)p1;
  u32x4 r; r[0] = a[0]; r[1] = a[1]; r[2] = b[0]; r[3] = b[1];
  return __builtin_bit_cast(bf16x8, r);
}
DI void st4bf(u16* p, float a, float b, float c, float d) { u32x2 v; v[0] = pack2(a, b); v[1] = pack2(c, d); *(u32x2*)p = v; }
DI float wave_sum(float v) {
  v += __shfl_xor(v, 1); v += __shfl_xor(v, 2); v += __shfl_xor(v, 4); v += __shfl_xor(v, 8); v += __shfl_xor(v, 16); v += __shfl_xor(v, 32);
  return v;
}
DI float sum_g(float v) { v += __shfl_xor(v, 16); v += __shfl_xor(v, 32); return v; }
DI int opaque_tid() { int t = threadIdx.x; asm volatile("" : "+v"(t)); return t; }
DI int opaque_bid() { int t = blockIdx.x; asm volatile("" : "+s"(t)); return t; }
DI char* opaque_ptr(char* q) { asm volatile("" : "+s"(q)); return q; }
DI int cond_of(int t) { return t < NPROMPT ? 0 : 1 + ((t - NPROMPT) >> 11); }
DI int kvrow_of_tok(int t) { return t < NPROMPT ? t : NPROMPT + ((t - NPROMPT) >> 11) * 2560 + 512 + ((t - NPROMPT) & 2047); }

template <int NI, class Epi>
DI void gemm_tile(const u16* __restrict__ A, int lda, const u16* __restrict__ Bt, int ldb, int K, int m0, int n0, u16* smem, Epi& epi) {
  constexpr int MI = 16 / NI;
  constexpr int WN = 8 / NI;
  const int tid = opaque_tid(), lane = tid & 63, wid = tid >> 6, l15 = lane & 15, g = lane >> 4;
  const int wm = wid / WN, wn = wid % WN;
  u16* sA = smem; u16* sB = smem + 128 * 72;
  f32x4 acc[MI][NI];
#pragma unroll
  for (int mi = 0; mi < MI; ++mi)
#pragma unroll
    for (int ni = 0; ni < NI; ++ni) { acc[mi][ni][0] = 0.f; acc[mi][ni][1] = 0.f; acc[mi][ni][2] = 0.f; acc[mi][ni][3] = 0.f; }
  const int lrow = tid >> 3, lkc = (tid & 7) * 8;
  const u16* pa = A + (size_t)(m0 + lrow) * lda + lkc;
  const u16* pb = Bt + (size_t)(n0 + lrow) * ldb + lkc;
  u32x4 ra[4], rb[4];
#pragma unroll
  for (int i = 0; i < 4; ++i) { ra[i] = *(const u32x4*)(pa + (size_t)i * 32 * lda); rb[i] = *(const u32x4*)(pb + (size_t)i * 32 * ldb); }
  for (int k0 = 0; k0 < K; k0 += 64) {
    __syncthreads();
#pragma unroll
    for (int i = 0; i < 4; ++i) { *(u32x4*)(sA + (lrow + 32 * i) * 72 + lkc) = ra[i]; *(u32x4*)(sB + (lrow + 32 * i) * 72 + lkc) = rb[i]; }
    __syncthreads();
    if (k0 + 64 < K) {
#pragma unroll
      for (int i = 0; i < 4; ++i) { ra[i] = *(const u32x4*)(pa + (size_t)i * 32 * lda + k0 + 64); rb[i] = *(const u32x4*)(pb + (size_t)i * 32 * ldb + k0 + 64); }
    }
#pragma unroll
    for (int ks = 0; ks < 2; ++ks) {
      bf16x8 af[MI], bfv[NI];
#pragma unroll
      for (int mi = 0; mi < MI; ++mi) af[mi] = ld8(sA + (wm * MI * 16 + mi * 16 + l15) * 72 + ks * 32 + g * 8);
#pragma unroll
      for (int ni = 0; ni < NI; ++ni) bfv[ni] = ld8(sB + (wn * NI * 16 + ni * 16 + l15) * 72 + ks * 32 + g * 8);
#pragma unroll
      for (int mi = 0; mi < MI; ++mi)
#pragma unroll
        for (int ni = 0; ni < NI; ++ni) acc[mi][ni] = mma(bfv[ni], af[mi], acc[mi][ni]);
    }
  }
  epi.template run<MI, NI>(acc, m0 + wm * MI * 16, n0 + wn * NI * 16, l15, g);
}

struct EpiResid {
  const float* xin; float* xout; const float* gate;
  template <int MI, int NI> DI void run(f32x4 (&acc)[MI][NI], int mr, int nc, int l15, int g) {
#pragma unroll
    for (int mi = 0; mi < MI; ++mi)
#pragma unroll
      for (int ni = 0; ni < NI; ++ni) {
        const int m = mr + mi * 16 + l15, n = nc + ni * 16 + g * 4;
        const float4 xi = *(const float4*)(xin + (size_t)m * 1024 + n);
        const float4 gt = *(const float4*)(gate + n);
        float4 o; o.x = xi.x + gt.x * acc[mi][ni][0]; o.y = xi.y + gt.y * acc[mi][ni][1]; o.z = xi.z + gt.z * acc[mi][ni][2]; o.w = xi.w + gt.w * acc[mi][ni][3];
        *(float4*)(xout + (size_t)m * 1024 + n) = o;
      }
  }
};
struct EpiGdnIn {
  u16* proj; float* gbuf;
  template <int MI, int NI> DI void run(f32x4 (&acc)[MI][NI], int mr, int nc, int l15, int g) {
#pragma unroll
    for (int mi = 0; mi < MI; ++mi)
#pragma unroll
      for (int ni = 0; ni < NI; ++ni) {
        const int m = mr + mi * 16 + l15, n = nc + ni * 16 + g * 4;
        if (n < 4096) st4bf(proj + (size_t)m * 4096 + n, acc[mi][ni][0], acc[mi][ni][1], acc[mi][ni][2], acc[mi][ni][3]);
        else if (n < 4128) { float4 o; o.x = acc[mi][ni][0]; o.y = acc[mi][ni][1]; o.z = acc[mi][ni][2]; o.w = acc[mi][ni][3]; *(float4*)(gbuf + (size_t)m * 32 + (n - 4096)) = o; }
      }
  }
};
struct EpiMlpIn {
  u16* abuf;
  template <int MI, int NI> DI void run(f32x4 (&acc)[MI][NI], int mr, int nc, int l15, int g) {
#pragma unroll
    for (int mi = 0; mi < MI; ++mi)
#pragma unroll
      for (int ni = 0; ni < NI; ++ni) {
        const int m = mr + mi * 16 + l15, n = nc + ni * 16 + g * 4;
        float a = fmaxf(acc[mi][ni][0], 0.f), b = fmaxf(acc[mi][ni][1], 0.f), c = fmaxf(acc[mi][ni][2], 0.f), d = fmaxf(acc[mi][ni][3], 0.f);
        st4bf(abuf + (size_t)m * 4096 + n, a * a, b * b, c * c, d * d);
      }
  }
};
struct EpiF32 {
  float* dst; int ld;
  template <int MI, int NI> DI void run(f32x4 (&acc)[MI][NI], int mr, int nc, int l15, int g) {
#pragma unroll
    for (int mi = 0; mi < MI; ++mi)
#pragma unroll
      for (int ni = 0; ni < NI; ++ni) {
        const int m = mr + mi * 16 + l15, n = nc + ni * 16 + g * 4;
        float4 o; o.x = acc[mi][ni][0]; o.y = acc[mi][ni][1]; o.z = acc[mi][ni][2]; o.w = acc[mi][ni][3];
        *(float4*)(dst + (size_t)m * ld + n) = o;
      }
  }
};

DI void rope128(f32x4 (&v)[8], int rowp, int colp, int g, const float* cosT, const float* sinT) {
#pragma unroll
  for (int hf = 0; hf < 2; ++hf) {
    const int pos = hf ? colp : rowp;
#pragma unroll
    for (int a = 0; a < 2; ++a) {
      const int n1 = hf * 4 + a, n2 = n1 + 2;
      const float4 cs = *(const float4*)(cosT + pos * 32 + a * 16 + g * 4);
      const float4 sn = *(const float4*)(sinT + pos * 32 + a * 16 + g * 4);
      const float c4[4] = {cs.x, cs.y, cs.z, cs.w}, s4[4] = {sn.x, sn.y, sn.z, sn.w};
#pragma unroll
      for (int j = 0; j < 4; ++j) { const float x1 = v[n1][j], x2 = v[n2][j]; v[n1][j] = x1 * c4[j] - x2 * s4[j]; v[n2][j] = x1 * s4[j] + x2 * c4[j]; }
    }
  }
}
DI void rope64(f32x4* v, int rowp, int colp, int g, const float* cosT, const float* sinT) {
#pragma unroll
  for (int hf = 0; hf < 2; ++hf) {
    const int pos = hf ? colp : rowp;
    const int n1 = hf * 2, n2 = n1 + 1;
    const float4 cs = *(const float4*)(cosT + pos * 16 + g * 4);
    const float4 sn = *(const float4*)(sinT + pos * 16 + g * 4);
    const float c4[4] = {cs.x, cs.y, cs.z, cs.w}, s4[4] = {sn.x, sn.y, sn.z, sn.w};
#pragma unroll
    for (int j = 0; j < 4; ++j) { const float x1 = v[n1][j], x2 = v[n2][j]; v[n1][j] = x1 * c4[j] - x2 * s4[j]; v[n2][j] = x1 * s4[j] + x2 * c4[j]; }
  }
}

struct EpiGqaIn {
  u16* Q; u16* Kb; u16* Vt; const float* qg; const float* kg; const float* cosT; const float* sinT; float* out;
  template <int MI, int NI> DI void run(f32x4 (&acc)[MI][NI], int mr, int nc, int l15, int g) {
    const int nt = nc >> 7;
#pragma unroll
    for (int mi = 0; mi < MI; ++mi) {
      const int m = mr + mi * 16 + l15;
      const bool prompt = m < NPROMPT;
      const int s = prompt ? (m & 255) : ((m - NPROMPT) & 2047);
      const int rowp = s >> 6, colp = s & 63;
      const int kvrow = kvrow_of_tok(m);
      if (nt < 10) {
        float ss = 0.f;
#pragma unroll
        for (int ni = 0; ni < NI; ++ni)
#pragma unroll
          for (int j = 0; j < 4; ++j) ss += acc[mi][ni][j] * acc[mi][ni][j];
        ss = sum_g(ss);
        const float rs = rsqrtf(ss * (1.f / 128.f) + EPS);
        const float* gn = nt < 8 ? qg : kg;
#pragma unroll
        for (int ni = 0; ni < NI; ++ni) {
          const float4 gv = *(const float4*)(gn + ni * 16 + g * 4);
          acc[mi][ni][0] *= rs * gv.x; acc[mi][ni][1] *= rs * gv.y; acc[mi][ni][2] *= rs * gv.z; acc[mi][ni][3] *= rs * gv.w;
        }
        if (nt >= 8 && prompt) {
#pragma unroll
          for (int ni = 0; ni < NI; ++ni) { float4 o; o.x = acc[mi][ni][0]; o.y = acc[mi][ni][1]; o.z = acc[mi][ni][2]; o.w = acc[mi][ni][3]; *(float4*)(out + O_GK + (size_t)m * 256 + (nt - 8) * 128 + ni * 16 + g * 4) = o; }
        }
        if (!prompt) rope128(acc[mi], rowp, colp, g, cosT, sinT);
        u16* dst = nt < 8 ? Q + (size_t)m * 1024 + nt * 128 : Kb + (size_t)kvrow * 256 + (nt - 8) * 128;
#pragma unroll
        for (int ni = 0; ni < NI; ++ni) st4bf(dst + ni * 16 + g * 4, acc[mi][ni][0], acc[mi][ni][1], acc[mi][ni][2], acc[mi][ni][3]);
      } else {
        const int kvh = nt - 10;
        if (prompt) {
#pragma unroll
          for (int ni = 0; ni < NI; ++ni) { float4 o; o.x = acc[mi][ni][0]; o.y = acc[mi][ni][1]; o.z = acc[mi][ni][2]; o.w = acc[mi][ni][3]; *(float4*)(out + O_GV + (size_t)m * 256 + kvh * 128 + ni * 16 + g * 4) = o; }
        }
        size_t base; int kvlen, pos;
        if (prompt) { base = (size_t)(m >> 8) * 256 * 256; kvlen = 256; pos = m & 255; }
        else { const int b = (m - NPROMPT) >> 11; base = (size_t)(NPROMPT + b * 2560) * 256; kvlen = 2560; pos = 512 + s; }
#pragma unroll
        for (int ni = 0; ni < NI; ++ni)
#pragma unroll
          for (int j = 0; j < 4; ++j) Vt[base + (size_t)(kvh * 128 + ni * 16 + g * 4 + j) * kvlen + pos] = f2bf(acc[mi][ni][j]);
      }
    }
  }
};
struct EpiMlaUq {
  u16* Q; const float* gnope; const float* grope; const float* cosT; const float* sinT;
  template <int MI, int NI> DI void run(f32x4 (&acc)[MI][NI], int mr, int nc, int l15, int g) {
    const int nt = nc >> 7;
#pragma unroll
    for (int mi = 0; mi < MI; ++mi) {
      const int m = mr + mi * 16 + l15;
      const bool prompt = m < NPROMPT;
      const int s = prompt ? (m & 255) : ((m - NPROMPT) & 2047);
      const int rowp = s >> 6, colp = s & 63;
      if (nt < 8) {
        float ss = 0.f;
#pragma unroll
        for (int ni = 0; ni < NI; ++ni)
#pragma unroll
          for (int j = 0; j < 4; ++j) ss += acc[mi][ni][j] * acc[mi][ni][j];
        ss = sum_g(ss);
        const float rs = rsqrtf(ss * (1.f / 128.f) + EPS);
#pragma unroll
        for (int ni = 0; ni < NI; ++ni) {
          const float4 gv = *(const float4*)(gnope + ni * 16 + g * 4);
          st4bf(Q + (size_t)m * 1536 + nt * 192 + ni * 16 + g * 4, acc[mi][ni][0] * rs * gv.x, acc[mi][ni][1] * rs * gv.y, acc[mi][ni][2] * rs * gv.z, acc[mi][ni][3] * rs * gv.w);
        }
      } else {
#pragma unroll
        for (int hh = 0; hh < 2; ++hh) {
          const int h = (nt - 8) * 2 + hh;
          float ss = 0.f;
#pragma unroll
          for (int ni = 0; ni < 4; ++ni)
#pragma unroll
            for (int j = 0; j < 4; ++j) ss += acc[mi][hh * 4 + ni][j] * acc[mi][hh * 4 + ni][j];
          ss = sum_g(ss);
          const float rs = rsqrtf(ss * (1.f / 64.f) + EPS);
#pragma unroll
          for (int ni = 0; ni < 4; ++ni) {
            const float4 gv = *(const float4*)(grope + ni * 16 + g * 4);
            acc[mi][hh * 4 + ni][0] *= rs * gv.x; acc[mi][hh * 4 + ni][1] *= rs * gv.y; acc[mi][hh * 4 + ni][2] *= rs * gv.z; acc[mi][hh * 4 + ni][3] *= rs * gv.w;
          }
          if (!prompt) rope64(&acc[mi][hh * 4], rowp, colp, g, cosT, sinT);
#pragma unroll
          for (int ni = 0; ni < 4; ++ni)
            st4bf(Q + (size_t)m * 1536 + h * 192 + 128 + ni * 16 + g * 4, acc[mi][hh * 4 + ni][0], acc[mi][hh * 4 + ni][1], acc[mi][hh * 4 + ni][2], acc[mi][hh * 4 + ni][3]);
        }
      }
    }
  }
};
struct EpiMlaUkv {
  u16* Kb; u16* Vt; const float* gnope;
  template <int MI, int NI> DI void run(f32x4 (&acc)[MI][NI], int mr, int nc, int l15, int g) {
    const int nt = nc >> 7, h = nt >> 1;
#pragma unroll
    for (int mi = 0; mi < MI; ++mi) {
      const int m = mr + mi * 16 + l15;
      if ((nt & 1) == 0) {
        float ss = 0.f;
#pragma unroll
        for (int ni = 0; ni < NI; ++ni)
#pragma unroll
          for (int j = 0; j < 4; ++j) ss += acc[mi][ni][j] * acc[mi][ni][j];
        ss = sum_g(ss);
        const float rs = rsqrtf(ss * (1.f / 128.f) + EPS);
#pragma unroll
        for (int ni = 0; ni < NI; ++ni) {
          const float4 gv = *(const float4*)(gnope + ni * 16 + g * 4);
          st4bf(Kb + (size_t)m * 1536 + h * 192 + ni * 16 + g * 4, acc[mi][ni][0] * rs * gv.x, acc[mi][ni][1] * rs * gv.y, acc[mi][ni][2] * rs * gv.z, acc[mi][ni][3] * rs * gv.w);
        }
      } else {
        size_t base; int kvlen, pos;
        if (m < NPROMPT) { base = (size_t)(m >> 8) * 256 * 1024; kvlen = 256; pos = m & 255; }
        else { const int r = m - NPROMPT; const int b = r / 2560; base = (size_t)(NPROMPT + b * 2560) * 1024; kvlen = 2560; pos = r - b * 2560; }
#pragma unroll
        for (int ni = 0; ni < NI; ++ni)
#pragma unroll
          for (int j = 0; j < 4; ++j) Vt[base + (size_t)(h * 128 + ni * 16 + g * 4 + j) * kvlen + pos] = f2bf(acc[mi][ni][j]);
      }
    }
  }
};

DI void convert_tile(const float* __restrict__ W, int K, int N, u16* __restrict__ Bt, int tile, int perm, float* sT) {
  const int nkt = K >> 6;
  const int kt = tile % nkt, nt = tile / nkt;
  const int k0 = kt * 64, n0 = nt * 64;
  const int tid = opaque_tid();
  __syncthreads();
  {
    const int n = tid & 63, kq = tid >> 6;
    int nd = n0 + n, ns = nd;
    if (perm == 1) { if (nd < 1024) ns = (nd >> 7) * 192 + (nd & 127); else { const int x = nd - 1024; ns = (x >> 6) * 192 + 128 + (x & 63); } }
    const bool ok = nd < N;
#pragma unroll
    for (int r = 0; r < 16; ++r) { const int k = r * 4 + kq; sT[k * 65 + n] = ok ? W[(size_t)(k0 + k) * N + ns] : 0.f; }
  }
  __syncthreads();
  {
    const int n = tid >> 2, kq = (tid & 3) * 16;
    u32x4 a, b;
#pragma unroll
    for (int e = 0; e < 4; ++e) { a[e] = pack2(sT[(kq + 2 * e) * 65 + n], sT[(kq + 2 * e + 1) * 65 + n]); b[e] = pack2(sT[(kq + 8 + 2 * e) * 65 + n], sT[(kq + 9 + 2 * e) * 65 + n]); }
    u16* dst = Bt + (size_t)(n0 + n) * K + k0 + kq;
    *(u32x4*)dst = a; *(u32x4*)(dst + 8) = b;
  }
}

DI void norm_rows(const P& p, int layer, bool from_input, int item, const float* gnorm, int shift_idx, int scale_idx) {
  const int tidn = opaque_tid();
  char* const ws = opaque_ptr(p.ws);
  const int lane = tidn & 63, wid = tidn >> 6;
  const int t = item * 4 + wid;
  const float* x = from_input ? (t < NPROMPT ? p.in[0] + (size_t)t * 1024 : p.in[1] + (size_t)(t - NPROMPT) * 1024) : p.out + (size_t)t * 1024;
  const float* mods = (const float*)(ws + WS_MODS) + ((size_t)layer * 9 + cond_of(t)) * 6144;
  u16* h = (u16*)(ws + WS_HBUF) + (size_t)t * 1024;
  float4 v[4]; float ss = 0.f;
#pragma unroll
  for (int e = 0; e < 4; ++e) { v[e] = *(const float4*)(x + e * 256 + lane * 4); ss += v[e].x * v[e].x + v[e].y * v[e].y + v[e].z * v[e].z + v[e].w * v[e].w; }
  ss = wave_sum(ss);
  const float rs = rsqrtf(ss * (1.f / 1024.f) + EPS);
#pragma unroll
  for (int e = 0; e < 4; ++e) {
    const int c = e * 256 + lane * 4;
    const float4 gv = *(const float4*)(gnorm + c);
    const float4 sc = *(const float4*)(mods + scale_idx * 1024 + c);
    const float4 sh = *(const float4*)(mods + shift_idx * 1024 + c);
    st4bf(h + c, v[e].x * rs * gv.x * (1.f + sc.x) + sh.x, v[e].y * rs * gv.y * (1.f + sc.y) + sh.y, v[e].z * rs * gv.z * (1.f + sc.z) + sh.z, v[e].w * rs * gv.w * (1.f + sc.w) + sh.w);
  }
}

template <int DK, int HK>
DI void attn_phase(const u16* __restrict__ Q, const u16* __restrict__ Kb, const u16* __restrict__ Vt, u16* __restrict__ obuf, char* smem_raw) {
  const int bid = opaque_bid();
  constexpr int KS = DK / 32, KSTR = DK + 8, QSTR = 8 * DK, KROW = HK * DK, GRP = 8 / HK;
  constexpr int CPR = DK / 8;
  constexpr int KCH = 64 * CPR / 256;
  u16* sK = (u16*)smem_raw;
  u16* sV = sK + 64 * KSTR;
  const int tid = opaque_tid(), lane = tid & 63, wid = tid >> 6, l15 = lane & 15, g = lane >> 4;
  const float sc = rsqrtf((float)DK) * 1.4426950408889634f;
  for (int item = bid; item < 1280; item += gridDim.x) {
    int qb, h, kvlen, tokbase, kvbase;
    if (item < 1024) { const int b = item >> 7, rem = item & 127; h = rem & 7; qb = rem >> 3; kvlen = 2560; tokbase = NPROMPT + b * 2048; kvbase = NPROMPT + b * 2560; }
    else { const int it2 = item - 1024; const int b = it2 >> 4, rem = it2 & 15; h = rem & 7; qb = rem >> 3; kvlen = 256; tokbase = b * 256; kvbase = b * 256; }
    const int kvh = h / GRP;
    const u16* Kp = Kb + (size_t)kvbase * KROW + kvh * DK;
    const u16* Vp = Vt + (size_t)kvbase * (HK * 128) + (size_t)kvh * 128 * kvlen;
    const int qrow0 = tokbase + qb * 128 + wid * 32;
    bf16x8 qf[2][KS];
#pragma unroll
    for (int qi = 0; qi < 2; ++qi)
#pragma unroll
      for (int ks = 0; ks < KS; ++ks) qf[qi][ks] = ld8(Q + (size_t)(qrow0 + qi * 16 + l15) * QSTR + h * DK + ks * 32 + g * 8);
    f32x4 ot[2][8];
#pragma unroll
    for (int qi = 0; qi < 2; ++qi)
#pragma unroll
      for (int dj = 0; dj < 8; ++dj) { ot[qi][dj][0] = 0.f; ot[qi][dj][1] = 0.f; ot[qi][dj][2] = 0.f; ot[qi][dj][3] = 0.f; }
    float mrun[2] = {-1e30f, -1e30f}, lrun[2] = {0.f, 0.f};
    const int ntiles = kvlen >> 6;
    for (int kt = 0; kt < ntiles; ++kt) {
      const u16* Kt = Kp + (size_t)kt * 64 * KROW;
      const u16* Vtp = Vp + kt * 64;
      __syncthreads();
#pragma unroll
      for (int i = 0; i < KCH; ++i) { const int c = tid + 256 * i; const int row = c / CPR, kc = (c % CPR) * 8; *(u32x4*)(sK + row * KSTR + kc) = *(const u32x4*)(Kt + (unsigned)(row * KROW + kc)); }
      __builtin_amdgcn_sched_barrier(0);
#pragma unroll
      for (int i = 0; i < 4; ++i) { const int c = tid + 256 * i; const int row = c >> 3, kc = (c & 7) * 8; *(u32x4*)(sV + row * 72 + kc) = *(const u32x4*)(Vtp + (unsigned)(row * kvlen + kc)); }
      __syncthreads();
#pragma unroll
      for (int qi = 0; qi < 2; ++qi) {
        __builtin_amdgcn_sched_barrier(0);
        f32x4 st[4];
#pragma unroll
        for (int kj = 0; kj < 4; ++kj) { st[kj][0] = 0.f; st[kj][1] = 0.f; st[kj][2] = 0.f; st[kj][3] = 0.f; }
#pragma unroll
        for (int ks = 0; ks < KS; ++ks) {
#pragma unroll
          for (int kj = 0; kj < 4; ++kj) st[kj] = mma(ld8(sK + (kj * 16 + l15) * KSTR + ks * 32 + g * 8), qf[qi][ks], st[kj]);
          __builtin_amdgcn_sched_barrier(0);
        }
        float mx = -1e30f;
#pragma unroll
        for (int kj = 0; kj < 4; ++kj)
#pragma unroll
          for (int r = 0; r < 4; ++r) mx = fmaxf(mx, st[kj][r]);
        mx = fmaxf(mx, __shfl_xor(mx, 16)); mx = fmaxf(mx, __shfl_xor(mx, 32));
        const float mnew = fmaxf(mrun[qi], mx);
        const float alpha = __builtin_amdgcn_exp2f((mrun[qi] - mnew) * sc);
        mrun[qi] = mnew;
        float ps = 0.f;
#pragma unroll
        for (int kj = 0; kj < 4; ++kj)
#pragma unroll
          for (int r = 0; r < 4; ++r) { const float pv = __builtin_amdgcn_exp2f((st[kj][r] - mnew) * sc); st[kj][r] = pv; ps += pv; }
        lrun[qi] = lrun[qi] * alpha + ps;
#pragma unroll
        for (int dj = 0; dj < 8; ++dj) { ot[qi][dj][0] *= alpha; ot[qi][dj][1] *= alpha; ot[qi][dj][2] *= alpha; ot[qi][dj][3] *= alpha; }
        bf16x8 pf[2];
        pf[0] = pack8(st[0], st[1]);
        pf[1] = pack8(st[2], st[3]);
        __builtin_amdgcn_sched_barrier(0);
#pragma unroll
        for (int kk = 0; kk < 2; ++kk)
#pragma unroll
          for (int dj = 0; dj < 8; ++dj) {
            const u16* vp = sV + (dj * 16 + l15) * 72 + kk * 32 + g * 4;
            ot[qi][dj] = mma(ld44(vp, vp + 16), pf[kk], ot[qi][dj]);
            if ((dj & 3) == 3) __builtin_amdgcn_sched_barrier(0);
          }
      }
    }
#pragma unroll
    for (int qi = 0; qi < 2; ++qi) {
      const float inv = 1.f / sum_g(lrun[qi]);
      u16* dst = obuf + (size_t)(qrow0 + qi * 16 + l15) * 1024 + h * 128 + g * 4;
#pragma unroll
      for (int dj = 0; dj < 8; ++dj) st4bf(dst + dj * 16, ot[qi][dj][0] * inv, ot[qi][dj][1] * inv, ot[qi][dj][2] * inv, ot[qi][dj][3] * inv);
    }
  }
}

DI void gdn_chunk_phase(const P& p, int j, char* smem_raw) {
  const int bid = opaque_bid();
  char* const ws = opaque_ptr(p.ws);
  u16* sK = (u16*)smem_raw;
  float* sA = (float*)(smem_raw + 17408);
  float* sG = (float*)(smem_raw + 17408 + 32768);
  float* sBt = sG + 128;
  const int tid = opaque_tid(), lane = tid & 63, wid = tid >> 6, l15 = lane & 15, g = lane >> 4;
  const u16* proj = (const u16*)(ws + WS_R + R_PROJ);
  u16* qn = (u16*)(ws + WS_HBUF); u16* kn = (u16*)(ws + WS_OBUF); u16* vb = (u16*)(ws + WS_R + R_VBUF);
  u16* Tbuf = (u16*)(ws + WS_R + R_TBUF);
  const float* gbuf = (const float*)(ws + WS_R + R_GBUF);
  float* gcb = (float*)(ws + WS_R + R_GCB); float* betab = (float*)(ws + WS_R + R_BETA);
  const float* conv = p.in[17] + (size_t)j * 3 * 3072;
  const float* a_log = p.in[18] + j * 16; const float* dt_bias = p.in[19] + j * 16;
  for (int unit = bid; unit < 2560; unit += gridDim.x) {
    const int cgi = unit >> 3, h = unit & 7;
    int c, nch; if (cgi < 64) { c = cgi & 3; nch = 4; } else { c = (cgi - 64) & 31; nch = 32; }
    const int t0 = cgi * 64;
    const bool has_prev = c > 0, has_next = c < nch - 1;
    __syncthreads();
    {
      const int r = tid >> 4, cc = (tid & 15) * 8;
#pragma unroll
      for (int part = 0; part < 3; ++part) {
        const int ch = part * 1024 + h * 128 + cc;
        float w0[8], w1[8], w2[8];
#pragma unroll
        for (int e = 0; e < 8; ++e) { w0[e] = conv[ch + e]; w1[e] = conv[3072 + ch + e]; w2[e] = conv[6144 + ch + e]; }
        u16* dstb = part == 0 ? qn : (part == 1 ? kn : vb);
        for (int it = 0; it < 4; ++it) {
          const int i = it * 16 + r, t = t0 + i;
          const u16* src = proj + (size_t)t * 4096 + ch;
          const u32x4 xc = *(const u32x4*)src;
          u32x4 xp = {0u, 0u, 0u, 0u}, xn = {0u, 0u, 0u, 0u};
          if (i > 0 || has_prev) xp = *(const u32x4*)(src - 4096);
          if (i < 63 || has_next) xn = *(const u32x4*)(src + 4096);
          float y[8];
#pragma unroll
          for (int e = 0; e < 4; ++e) {
            float a = w0[2 * e] * bflo(xp[e]) + w1[2 * e] * bflo(xc[e]) + w2[2 * e] * bflo(xn[e]);
            float b = w0[2 * e + 1] * bfhi(xp[e]) + w1[2 * e + 1] * bfhi(xc[e]) + w2[2 * e + 1] * bfhi(xn[e]);
            y[2 * e] = a / (1.f + expf(-a)); y[2 * e + 1] = b / (1.f + expf(-b));
          }
          if (part < 2) {
            float ss = 0.f;
#pragma unroll
            for (int e = 0; e < 8; ++e) ss += y[e] * y[e];
            ss += __shfl_xor(ss, 1); ss += __shfl_xor(ss, 2); ss += __shfl_xor(ss, 4); ss += __shfl_xor(ss, 8);
            const float rs = rsqrtf(ss + EPS) * (part == 0 ? 0.08838834764831845f : 1.f);
#pragma unroll
            for (int e = 0; e < 8; ++e) y[e] *= rs;
          }
          u32x4 o; o[0] = pack2(y[0], y[1]); o[1] = pack2(y[2], y[3]); o[2] = pack2(y[4], y[5]); o[3] = pack2(y[6], y[7]);
          *(u32x4*)(dstb + (size_t)t * 1024 + h * 128 + cc) = o;
          if (part == 1) *(u32x4*)(sK + i * 136 + cc) = o;
        }
      }
    }
    if (tid < 128) {
      const int dir = tid >> 6, L = tid & 63;
      const int i = dir ? 63 - L : L;
      const float* gb = gbuf + (size_t)(t0 + i) * 32;
      const float gin = gb[dir * 8 + h], bin = gb[16 + dir * 8 + h];
      const float x = gin + dt_bias[dir * 8 + h];
      const float sp = fmaxf(x, 0.f) + log1pf(expf(-fabsf(x)));
      float gv = -expf(a_log[dir * 8 + h]) * sp;
      const float bt = 1.f / (1.f + expf(-bin));
#pragma unroll
      for (int off = 1; off < 64; off <<= 1) { const float v = __shfl_up(gv, off); if (L >= off) gv += v; }
      sG[dir * 64 + i] = gv; sBt[dir * 64 + i] = bt;
      gcb[((size_t)(t0 + i) * 8 + h) * 2 + dir] = gv; betab[((size_t)(t0 + i) * 8 + h) * 2 + dir] = bt;
    }
    __syncthreads();
    {
      f32x4 ga[4];
#pragma unroll
      for (int mt = 0; mt < 4; ++mt) { ga[mt][0] = 0.f; ga[mt][1] = 0.f; ga[mt][2] = 0.f; ga[mt][3] = 0.f; }
#pragma unroll
      for (int ks = 0; ks < 4; ++ks) {
        const bf16x8 a = ld8(sK + (wid * 16 + l15) * 136 + ks * 32 + g * 8);
#pragma unroll
        for (int mt = 0; mt < 4; ++mt) { const bf16x8 b = ld8(sK + (mt * 16 + l15) * 136 + ks * 32 + g * 8); ga[mt] = mma(a, b, ga[mt]); }
      }
#pragma unroll
      for (int dir = 0; dir < 2; ++dir)
#pragma unroll
        for (int mt = 0; mt < 4; ++mt)
#pragma unroll
          for (int r = 0; r < 4; ++r) {
            const int i = wid * 16 + g * 4 + r, m = mt * 16 + l15;
            const bool valid = dir ? (i < m) : (i > m);
            const float val = valid ? sBt[dir * 64 + i] * ga[mt][r] * expf(sG[dir * 64 + i] - sG[dir * 64 + m]) : 0.f;
            const int ii = dir ? 63 - i : i, mm = dir ? 63 - m : m;
            sA[dir * 4096 + ii * 64 + mm] = val;
          }
    }
    __syncthreads();
    if (wid < 2) {
      const int dir = wid;
      float* Am = sA + dir * 4096;
      for (int i = 0; i < 64; ++i) {
        float a = (i == lane) ? 1.f : 0.f;
        for (int m = 0; m < i; ++m) a -= Am[i * 64 + m] * Am[m * 64 + lane];
        Am[i * 64 + lane] = a;
      }
      const int mn = dir ? 63 - lane : lane;
      const float bm = sBt[dir * 64 + mn];
      u16* Td = Tbuf + ((size_t)unit * 2 + dir) * 4096;
#pragma unroll 4
      for (int i = 0; i < 64; ++i) { const int in_ = dir ? 63 - i : i; Td[in_ * 64 + mn] = f2bf(Am[i * 64 + lane] * bm); }
    }
  }
}

DI void gdn_scan_phase(const P& p, int j, char* smem_raw) {
  const int bid = opaque_bid();
  char* const ws = opaque_ptr(p.ws);
  u16* sK = (u16*)smem_raw;
  u16* sKT = sK + 64 * 136;
  u16* sVT = sKT + 128 * 72;
  u16* sST = sVT + 32 * 72;
  u16* sVN = sST + 32 * 136;
  u16* sVD = sVN + 32 * 72;
  float* sGc = (float*)(sVD + 32 * 72);
  const int tid = opaque_tid(), lane = tid & 63, w = tid >> 6, l15 = lane & 15, g = lane >> 4;
  const u16* qn = (const u16*)(ws + WS_HBUF); const u16* kn = (const u16*)(ws + WS_OBUF); const u16* vb = (const u16*)(ws + WS_R + R_VBUF);
  const u16* Tbuf = (const u16*)(ws + WS_R + R_TBUF);
  const float* gcb = (const float*)(ws + WS_R + R_GCB);
  u16* obase = (u16*)(ws + WS_R + R_PROJ);
  for (int wk = bid; wk < 1536; wk += gridDim.x) {
    int seq, rem;
    if (wk < 512) { seq = 16 + (wk >> 6); rem = wk & 63; } else { seq = (wk - 512) >> 6; rem = (wk - 512) & 63; }
    const int h = rem >> 3, dir = (rem >> 2) & 1, dvq = rem & 3;
    const int nch = seq < 16 ? 4 : 32;
    const int cgb = seq < 16 ? seq * 4 : 64 + (seq - 16) * 32;
    f32x4 S[2][2];
    if (seq >= 16) {
      const float* s0 = p.in[2 + dir] + (((size_t)(seq - 16) * 2 + j) * 8 + h) * 16384;
#pragma unroll
      for (int dt = 0; dt < 2; ++dt)
#pragma unroll
        for (int et = 0; et < 2; ++et)
#pragma unroll
          for (int r = 0; r < 4; ++r) S[dt][et][r] = s0[(size_t)(w * 32 + dt * 16 + g * 4 + r) * 128 + dvq * 32 + et * 16 + l15];
    } else {
#pragma unroll
      for (int dt = 0; dt < 2; ++dt)
#pragma unroll
        for (int et = 0; et < 2; ++et) { S[dt][et][0] = 0.f; S[dt][et][1] = 0.f; S[dt][et][2] = 0.f; S[dt][et][3] = 0.f; }
    }
    __syncthreads();
#pragma unroll
    for (int dt = 0; dt < 2; ++dt)
#pragma unroll
      for (int et = 0; et < 2; ++et) st4bf(sST + (et * 16 + l15) * 136 + w * 32 + dt * 16 + g * 4, S[dt][et][0], S[dt][et][1], S[dt][et][2], S[dt][et][3]);
    for (int step = 0; step < nch; ++step) {
      const int c = dir ? nch - 1 - step : step;
      const int t0 = (cgb + c) * 64;
      const int unit = (cgb + c) * 8 + h;
#pragma unroll
      for (int i = 0; i < 4; ++i) {
        const int ci = tid + 256 * i; const int row = ci >> 4, dc = (ci & 15) * 8;
        const u32x4 v = *(const u32x4*)(kn + (size_t)(t0 + row) * 1024 + h * 128 + dc);
        *(u32x4*)(sK + row * 136 + dc) = v;
#pragma unroll
        for (int e = 0; e < 4; ++e) { sKT[(dc + 2 * e) * 72 + row] = (u16)(v[e] & 0xffffu); sKT[(dc + 2 * e + 1) * 72 + row] = (u16)(v[e] >> 16); }
      }
      {
        const int row = tid >> 2, ec = (tid & 3) * 8;
        const u32x4 v = *(const u32x4*)(vb + (size_t)(t0 + row) * 1024 + h * 128 + dvq * 32 + ec);
#pragma unroll
        for (int e = 0; e < 4; ++e) { sVT[(ec + 2 * e) * 72 + row] = (u16)(v[e] & 0xffffu); sVT[(ec + 2 * e + 1) * 72 + row] = (u16)(v[e] >> 16); }
      }
      if (tid < 64) sGc[tid] = gcb[((size_t)(t0 + tid) * 8 + h) * 2 + dir];
      bf16x8 qf[4], tf[2];
#pragma unroll
      for (int ks = 0; ks < 4; ++ks) qf[ks] = ld8(qn + (size_t)(t0 + w * 16 + l15) * 1024 + h * 128 + ks * 32 + g * 8);
#pragma unroll
      for (int ks = 0; ks < 2; ++ks) tf[ks] = ld8(Tbuf + ((size_t)unit * 2 + dir) * 4096 + (w * 16 + l15) * 64 + ks * 32 + g * 8);
      __syncthreads();
      const float gl = dir ? sGc[0] : sGc[63];
      f32x4 ua[2];
#pragma unroll
      for (int et = 0; et < 2; ++et) {
        ua[et][0] = 0.f; ua[et][1] = 0.f; ua[et][2] = 0.f; ua[et][3] = 0.f;
#pragma unroll
        for (int ks = 0; ks < 2; ++ks) ua[et] = mma(tf[ks], ld8(sVT + (et * 16 + l15) * 72 + ks * 32 + g * 8), ua[et]);
      }
      bf16x8 tf2[2];
#pragma unroll
      for (int ks = 0; ks < 2; ++ks) {
        const u32x4 tw = __builtin_bit_cast(u32x4, tf[ks]);
        u32x4 o;
#pragma unroll
        for (int e = 0; e < 4; ++e) {
          const int m = ks * 32 + g * 8 + 2 * e;
          o[e] = pack2(bflo(tw[e]) * expf(sGc[m]), bfhi(tw[e]) * expf(sGc[m + 1]));
        }
        tf2[ks] = __builtin_bit_cast(bf16x8, o);
      }
      bf16x8 wf[4];
#pragma unroll
      for (int kq = 0; kq < 4; ++kq) {
        f32x4 wa[2];
#pragma unroll
        for (int hh = 0; hh < 2; ++hh) {
          const int dt = kq * 2 + hh;
          wa[hh][0] = 0.f; wa[hh][1] = 0.f; wa[hh][2] = 0.f; wa[hh][3] = 0.f;
#pragma unroll
          for (int ks = 0; ks < 2; ++ks) wa[hh] = mma(ld8(sKT + (dt * 16 + l15) * 72 + ks * 32 + g * 8), tf2[ks], wa[hh]);
        }
        wf[kq] = pack8(wa[0], wa[1]);
      }
      f32x4 vn[2];
#pragma unroll
      for (int et = 0; et < 2; ++et) {
        f32x4 a; a[0] = 0.f; a[1] = 0.f; a[2] = 0.f; a[3] = 0.f;
#pragma unroll
        for (int kq = 0; kq < 4; ++kq) { const u16* sp = sST + (et * 16 + l15) * 136 + kq * 32 + g * 4; a = mma(wf[kq], ld44(sp, sp + 16), a); }
        vn[et][0] = ua[et][0] - a[0]; vn[et][1] = ua[et][1] - a[1]; vn[et][2] = ua[et][2] - a[2]; vn[et][3] = ua[et][3] - a[3];
      }
      bf16x8 qkf[2];
      {
        const int iq = w * 16 + l15;
        const float gi = sGc[iq];
#pragma unroll
        for (int kk = 0; kk < 2; ++kk) {
          f32x4 ka[2];
#pragma unroll
          for (int hh = 0; hh < 2; ++hh) {
            const int mt = kk * 2 + hh;
            ka[hh][0] = 0.f; ka[hh][1] = 0.f; ka[hh][2] = 0.f; ka[hh][3] = 0.f;
#pragma unroll
            for (int ks = 0; ks < 4; ++ks) ka[hh] = mma(ld8(sK + (mt * 16 + l15) * 136 + ks * 32 + g * 8), qf[ks], ka[hh]);
#pragma unroll
            for (int r = 0; r < 4; ++r) {
              const int m = mt * 16 + g * 4 + r;
              const bool valid = dir ? (iq <= m) : (iq >= m);
              ka[hh][r] = valid ? ka[hh][r] * expf(gi - sGc[m]) : 0.f;
            }
          }
          qkf[kk] = pack8(ka[0], ka[1]);
        }
      }
#pragma unroll
      for (int et = 0; et < 2; ++et) {
        const int i0 = w * 16 + g * 4;
        st4bf(sVN + (et * 16 + l15) * 72 + i0, vn[et][0], vn[et][1], vn[et][2], vn[et][3]);
        st4bf(sVD + (et * 16 + l15) * 72 + i0, vn[et][0] * expf(gl - sGc[i0]), vn[et][1] * expf(gl - sGc[i0 + 1]), vn[et][2] * expf(gl - sGc[i0 + 2]), vn[et][3] * expf(gl - sGc[i0 + 3]));
      }
      __syncthreads();
#pragma unroll
      for (int et = 0; et < 2; ++et) {
        f32x4 a1; a1[0] = 0.f; a1[1] = 0.f; a1[2] = 0.f; a1[3] = 0.f;
#pragma unroll
        for (int ks = 0; ks < 4; ++ks) a1 = mma(qf[ks], ld8(sST + (et * 16 + l15) * 136 + ks * 32 + g * 8), a1);
        f32x4 a2; a2[0] = 0.f; a2[1] = 0.f; a2[2] = 0.f; a2[3] = 0.f;
#pragma unroll
        for (int kk = 0; kk < 2; ++kk) { const u16* sp = sVN + (et * 16 + l15) * 72 + kk * 32 + g * 4; a2 = mma(qkf[kk], ld44(sp, sp + 16), a2); }
#pragma unroll
        for (int r = 0; r < 4; ++r) {
          const int i = w * 16 + g * 4 + r;
          const float o = a1[r] * expf(sGc[i]) + a2[r];
          obase[(size_t)(t0 + i) * 4096 + dir * 1024 + h * 128 + dvq * 32 + et * 16 + l15] = f2bf(o);
        }
      }
      {
        const float eg = expf(gl);
#pragma unroll
        for (int dt = 0; dt < 2; ++dt)
#pragma unroll
          for (int et = 0; et < 2; ++et) {
            f32x4 a; a[0] = S[dt][et][0] * eg; a[1] = S[dt][et][1] * eg; a[2] = S[dt][et][2] * eg; a[3] = S[dt][et][3] * eg;
#pragma unroll
            for (int kk = 0; kk < 2; ++kk) a = mma(ld8(sKT + (w * 32 + dt * 16 + l15) * 72 + kk * 32 + g * 8), ld8(sVD + (et * 16 + l15) * 72 + kk * 32 + g * 8), a);
            S[dt][et] = a;
          }
      }
      __syncthreads();
#pragma unroll
      for (int dt = 0; dt < 2; ++dt)
#pragma unroll
        for (int et = 0; et < 2; ++et) st4bf(sST + (et * 16 + l15) * 136 + w * 32 + dt * 16 + g * 4, S[dt][et][0], S[dt][et][1], S[dt][et][2], S[dt][et][3]);
    }
    if (seq < 16) {
      float* so = p.out + (dir ? O_SB : O_SF) + (((size_t)seq * 2 + j) * 8 + h) * 16384;
#pragma unroll
      for (int dt = 0; dt < 2; ++dt)
#pragma unroll
        for (int et = 0; et < 2; ++et)
#pragma unroll
          for (int r = 0; r < 4; ++r) so[(size_t)(w * 32 + dt * 16 + g * 4 + r) * 128 + dvq * 32 + et * 16 + l15] = S[dt][et][r];
    }
  }
}

__global__ void __launch_bounds__(256, 2) fwd_megakernel(P p) {
  cg::grid_group grid = cg::this_grid();
  __shared__ __attribute__((aligned(16))) char smem[60416];
  const int tid = opaque_tid(), lane = tid & 63, wid = tid >> 6;
  const int G = gridDim.x;
  const int bid0 = opaque_bid();
  {
  char* const ws0 = opaque_ptr(p.ws);
  float* mods = (float*)(ws0 + WS_MODS);
  float* ropeT = (float*)(ws0 + WS_ROPE);
  float* cosG = ropeT, *sinG = ropeT + 2048, *cosM = ropeT + 4096, *sinM = ropeT + 5120;

  {
    float* sc = (float*)smem;
    float* red = sc + 9 * 128;
    float* part = (float*)(ws0 + WS_R);
    for (int item = bid0; item < 3072; item += G) {
      const int ks = item & 7, cgp = (item >> 3) % 96, layer = item / 768;
      __syncthreads();
      for (int e = tid; e < 9 * 128; e += 256) {
        const int ci = e >> 7, k = ks * 128 + (e & 127);
        const float v = ci == 0 ? p.in[9][k] : p.in[8][(ci - 1) * 1024 + k];
        sc[e] = v / (1.f + expf(-v));
      }
      __syncthreads();
      const int col = tid & 63, kg = tid >> 6;
      const float* wp = p.in[12] + ((size_t)layer * 1024 + ks * 128 + kg * 32) * 6144 + cgp * 64 + col;
      float acc[9];
#pragma unroll
      for (int ci = 0; ci < 9; ++ci) acc[ci] = 0.f;
#pragma unroll 8
      for (int kk = 0; kk < 32; ++kk) {
        const float wv = wp[(size_t)kk * 6144];
#pragma unroll
        for (int ci = 0; ci < 9; ++ci) acc[ci] += sc[ci * 128 + kg * 32 + kk] * wv;
      }
#pragma unroll
      for (int ci = 0; ci < 9; ++ci) red[(kg * 64 + col) * 9 + ci] = acc[ci];
      __syncthreads();
      if (kg == 0) {
        const int n = cgp * 64 + col;
        const float bias = ks == 0 ? p.in[13][(size_t)layer * 6144 + n] : 0.f;
#pragma unroll
        for (int ci = 0; ci < 9; ++ci) {
          const float s = red[col * 9 + ci] + red[(64 + col) * 9 + ci] + red[(128 + col) * 9 + ci] + red[(192 + col) * 9 + ci] + bias;
          part[(size_t)ks * 221184 + ((size_t)layer * 9 + ci) * 6144 + n] = s;
        }
      }
    }
    if (bid0 == G - 1) {
      for (int e = tid; e < 2048; e += 256) { const int pos = e >> 5, f = e & 31; const float fr = powf(10000.f, -(float)f / 32.f); const float a = (float)pos * fr; cosG[e] = cosf(a); sinG[e] = sinf(a); }
      for (int e = tid; e < 1024; e += 256) { const int pos = e >> 4, f = e & 15; const float fr = powf(10000.f, -(float)f / 16.f); const float a = (float)pos * fr; cosM[e] = cosf(a); sinM[e] = sinf(a); }
    }
  }
  grid.sync();
  {
    const float* part = (const float*)(ws0 + WS_R);
    for (int e = bid0 * 256 + tid; e < 221184; e += G * 256) {
      float sacc = 0.f;
#pragma unroll
      for (int ks = 0; ks < 8; ++ks) sacc += part[(size_t)ks * 221184 + e];
      mods[e] = sacc;
    }
  }
  }
  grid.sync();

#pragma unroll 1
  for (int layer = 0; layer < 4; ++layer) {
    const int kind = layer % 3, j = layer / 3;
    const int bid = opaque_bid();
    char* const ws = opaque_ptr(p.ws);
    float* mods = (float*)(ws + WS_MODS);
    float* ropeT = (float*)(ws + WS_ROPE);
    float* cosG = ropeT, *sinG = ropeT + 2048, *cosM = ropeT + 4096, *sinM = ropeT + 5120;
    u16* hbuf = (u16*)(ws + WS_HBUF);
    u16* obuf = (u16*)(ws + WS_OBUF);
    u16* wmix = (u16*)(ws + WS_WMIX);
    u16* wmlp = (u16*)(ws + WS_WMLP);
    char* R = ws + WS_R;
    const float* lmods = mods + (size_t)layer * 9 * 6144;
    {
      for (int it = bid; it < 5120; it += G) norm_rows(p, layer, layer == 0, it, p.in[10] + layer * 1024, 0, 1);
      float* sT = (float*)smem;
      for (int it = bid; it < 2048; it += G) {
        if (it < 1024) convert_tile(p.in[14] + (size_t)layer * 1024 * 4096, 1024, 4096, wmlp, it, 0, sT);
        else convert_tile(p.in[15] + (size_t)layer * 4096 * 1024, 4096, 1024, wmlp + 4194304, it - 1024, 0, sT);
      }
      if (kind == 0) {
        for (int it = bid; it < 1056 + 256; it += G) {
          if (it < 1056) convert_tile(p.in[16] + (size_t)j * 1024 * 4128, 1024, 4128, wmix + WM_IN, it, 0, sT);
          else convert_tile(p.in[21] + (size_t)j * 1024 * 1024, 1024, 1024, wmix + WM_OUT, it - 1056, 0, sT);
        }
      } else if (kind == 1) {
        for (int it = bid; it < 192 + 144 + 128 + 256; it += G) {
          if (it < 192) convert_tile(p.in[22], 1024, 704, wmix + WM_IN, it, 0, sT);
          else if (it < 336) convert_tile(p.in[25], 384, 1536, wmix + WM_UQ, it - 192, 1, sT);
          else if (it < 464) convert_tile(p.in[26], 256, 2048, wmix + WM_UKV, it - 336, 0, sT);
          else convert_tile(p.in[31], 1024, 1024, wmix + WM_OUT, it - 464, 0, sT);
        }
      } else {
        for (int it = bid; it < 384 + 256; it += G) {
          if (it < 384) convert_tile(p.in[32], 1024, 1536, wmix + WM_IN, it, 0, sT);
          else convert_tile(p.in[35], 1024, 1024, wmix + WM_OUT, it - 384, 0, sT);
        }
        u16* Kg = (u16*)(R + R_KG); u16* Vg = (u16*)(R + R_VTG);
        const int tid = opaque_tid();
        for (int it = bid; it < 512; it += G) {
          const int b = it >> 6, s0 = (it & 63) * 8;
          const int ch = tid;
          float kv[8], vv[8];
#pragma unroll
          for (int e = 0; e < 8; ++e) { kv[e] = p.in[6][((size_t)b * 512 + s0 + e) * 256 + ch]; vv[e] = p.in[7][((size_t)b * 512 + s0 + e) * 256 + ch]; }
#pragma unroll
          for (int e = 0; e < 8; ++e) Kg[(size_t)(NPROMPT + b * 2560 + s0 + e) * 256 + ch] = f2bf(kv[e]);
          u32x4 o; o[0] = pack2(vv[0], vv[1]); o[1] = pack2(vv[2], vv[3]); o[2] = pack2(vv[4], vv[5]); o[3] = pack2(vv[6], vv[7]);
          *(u32x4*)(Vg + (size_t)(NPROMPT + b * 2560) * 256 + (size_t)ch * 2560 + s0) = o;
        }
      }
    }
    grid.sync();

    if (kind == 0) {
      {
        EpiGdnIn epi; epi.proj = (u16*)(R + R_PROJ); epi.gbuf = (float*)(R + R_GBUF);
        for (int it = bid; it < 160 * 33; it += G) { const int mt = it / 33, nt = it % 33; gemm_tile<4>(hbuf, 1024, wmix + WM_IN, 1024, 1024, mt * 128, nt * 128, (u16*)smem, epi); }
      }
      grid.sync();
      gdn_chunk_phase(p, j, smem);
      grid.sync();
      gdn_scan_phase(p, j, smem);
      grid.sync();
      {
        const u16* pr = (const u16*)(R + R_PROJ);
        const float* on = p.in[20] + j * 128;
        const int tid = opaque_tid();
        for (int t = bid; t < NTOK; t += G) {
          const int h = tid >> 5, c = (tid & 31) * 4;
          const u16* row = pr + (size_t)t * 4096;
          const u32x2 f = *(const u32x2*)(row + h * 128 + c), b = *(const u32x2*)(row + 1024 + h * 128 + c), z = *(const u32x2*)(row + 3072 + h * 128 + c);
          float o[4] = {bflo(f[0]) + bflo(b[0]), bfhi(f[0]) + bfhi(b[0]), bflo(f[1]) + bflo(b[1]), bfhi(f[1]) + bfhi(b[1])};
          float zz[4] = {bflo(z[0]), bfhi(z[0]), bflo(z[1]), bfhi(z[1])};
          float ss = o[0] * o[0] + o[1] * o[1] + o[2] * o[2] + o[3] * o[3];
          ss += __shfl_xor(ss, 1); ss += __shfl_xor(ss, 2); ss += __shfl_xor(ss, 4); ss += __shfl_xor(ss, 8); ss += __shfl_xor(ss, 16);
          const float rs = rsqrtf(ss * (1.f / 128.f) + EPS);
          const float4 gn = *(const float4*)(on + c);
          const float gg[4] = {gn.x, gn.y, gn.z, gn.w};
          float y[4];
#pragma unroll
          for (int e = 0; e < 4; ++e) y[e] = o[e] * rs * gg[e] * (zz[e] / (1.f + expf(-zz[e])));
          st4bf(obuf + (size_t)t * 1024 + h * 128 + c, y[0], y[1], y[2], y[3]);
        }
      }
      grid.sync();
    } else if (kind == 1) {
      {
        EpiF32 epi; epi.dst = (float*)(R + R_DPROJ); epi.ld = 768;
        for (int it = bid; it < 160 * 6; it += G) { const int mt = it / 6, nt = it % 6; gemm_tile<4>(hbuf, 1024, wmix + WM_IN, 1024, 1024, mt * 128, nt * 128, (u16*)smem, epi); }
      }
      grid.sync();
      {
        const float* dproj = (const float*)(R + R_DPROJ);
        u16* cq = (u16*)(R + R_CQ); u16* ckv = (u16*)(R + R_CKV); u16* Km = (u16*)(R + R_KM);
        const int tid = opaque_tid(), lane = tid & 63, wid = tid >> 6;
        for (int it = bid; it < 6144; it += G) {
          const int row = it * 4 + wid;
          if (row < NTOK) {
            const int t = row;
            const float* pr = dproj + (size_t)t * 768;
            float v[6]; float ss = 0.f;
#pragma unroll
            for (int e = 0; e < 6; ++e) { v[e] = pr[lane + 64 * e]; ss += v[e] * v[e]; }
            ss = wave_sum(ss);
            float rs = rsqrtf(ss * (1.f / 384.f) + EPS);
#pragma unroll
            for (int e = 0; e < 6; ++e) cq[(size_t)t * 384 + lane + 64 * e] = f2bf(v[e] * rs * p.in[23][lane + 64 * e]);
            const int kvrow = kvrow_of_tok(t);
            float wv[4]; ss = 0.f;
#pragma unroll
            for (int e = 0; e < 4; ++e) { wv[e] = pr[384 + lane + 64 * e]; ss += wv[e] * wv[e]; }
            ss = wave_sum(ss);
            rs = rsqrtf(ss * (1.f / 256.f) + EPS);
#pragma unroll
            for (int e = 0; e < 4; ++e) {
              const float o = wv[e] * rs * p.in[24][lane + 64 * e];
              ckv[(size_t)kvrow * 256 + lane + 64 * e] = f2bf(o);
              if (t < NPROMPT) p.out[O_CKV + (size_t)t * 256 + lane + 64 * e] = o;
            }
            const float x = pr[640 + lane];
            ss = wave_sum(x * x);
            float kr = x * rsqrtf(ss * (1.f / 64.f) + EPS) * p.in[30][lane];
            if (t < NPROMPT) p.out[O_KR + (size_t)t * 64 + lane] = kr;
            else {
              const int s = (t - NPROMPT) & 2047;
              const int pos = lane < 32 ? (s >> 6) : (s & 63);
              const float cs = cosM[pos * 16 + (lane & 15)], sn = sinM[pos * 16 + (lane & 15)];
              const float partner = __shfl_xor(kr, 16);
              kr = ((lane & 16) == 0) ? kr * cs - partner * sn : partner * sn + kr * cs;
            }
            const u16 kb = f2bf(kr);
#pragma unroll
            for (int hh = 0; hh < 8; ++hh) Km[(size_t)kvrow * 1536 + hh * 192 + 128 + lane] = kb;
          } else {
            const int r = row - NTOK; const int b = r >> 9, s = r & 511;
            const int kvrow = NPROMPT + b * 2560 + s;
#pragma unroll
            for (int e = 0; e < 4; ++e) ckv[(size_t)kvrow * 256 + lane + 64 * e] = f2bf(p.in[4][((size_t)b * 512 + s) * 256 + lane + 64 * e]);
            const u16 kb = f2bf(p.in[5][((size_t)b * 512 + s) * 64 + lane]);
#pragma unroll
            for (int hh = 0; hh < 8; ++hh) Km[(size_t)kvrow * 1536 + hh * 192 + 128 + lane] = kb;
          }
        }
      }
      grid.sync();
      {
        EpiMlaUq e1; e1.Q = (u16*)(R + R_Q); e1.gnope = p.in[27]; e1.grope = p.in[28]; e1.cosT = cosM; e1.sinT = sinM;
        for (int it = bid; it < 160 * 12; it += G) { const int mt = it / 12, nt = it % 12; gemm_tile<8>((const u16*)(R + R_CQ), 384, wmix + WM_UQ, 384, 384, mt * 128, nt * 128, (u16*)smem, e1); }
        EpiMlaUkv e2; e2.Kb = (u16*)(R + R_KM); e2.Vt = (u16*)(R + R_VTM); e2.gnope = p.in[29];
        for (int it = bid; it < 192 * 16; it += G) { const int mt = it / 16, nt = it % 16; gemm_tile<8>((const u16*)(R + R_CKV), 256, wmix + WM_UKV, 256, 256, mt * 128, nt * 128, (u16*)smem, e2); }
      }
      grid.sync();
      attn_phase<192, 8>((const u16*)(R + R_Q), (const u16*)(R + R_KM), (const u16*)(R + R_VTM), obuf, smem);
      grid.sync();
    } else {
      {
        EpiGqaIn epi; epi.Q = (u16*)(R + R_Q); epi.Kb = (u16*)(R + R_KG); epi.Vt = (u16*)(R + R_VTG); epi.qg = p.in[33]; epi.kg = p.in[34]; epi.cosT = cosG; epi.sinT = sinG; epi.out = p.out;
        for (int it = bid; it < 160 * 12; it += G) { const int mt = it / 12, nt = it % 12; gemm_tile<8>(hbuf, 1024, wmix + WM_IN, 1024, 1024, mt * 128, nt * 128, (u16*)smem, epi); }
      }
      grid.sync();
      attn_phase<128, 2>((const u16*)(R + R_Q), (const u16*)(R + R_KG), (const u16*)(R + R_VTG), obuf, smem);
      grid.sync();
    }

    for (int it = bid; it < 160 * 8; it += G) {
      const int mt = it >> 3, nt = it & 7; const int m0 = mt * 128;
      EpiResid epi;
      epi.xin = (layer == 0) ? (m0 < NPROMPT ? p.in[0] : p.in[1] - (size_t)NPROMPT * 1024) : p.out;
      epi.xout = p.out; epi.gate = lmods + (size_t)cond_of(m0) * 6144 + 2 * 1024;
      gemm_tile<4>(obuf, 1024, wmix + WM_OUT, 1024, 1024, m0, nt * 128, (u16*)smem, epi);
    }
    grid.sync();
    for (int it = bid; it < 5120; it += G) norm_rows(p, layer, false, it, p.in[11] + layer * 1024, 3, 4);
    grid.sync();
    {
      EpiMlpIn epi; epi.abuf = (u16*)(R + R_ABUF);
      for (int it = bid; it < 160 * 32; it += G) { const int mt = it >> 5, nt = it & 31; gemm_tile<4>(hbuf, 1024, wmlp, 1024, 1024, mt * 128, nt * 128, (u16*)smem, epi); }
    }
    grid.sync();
    for (int it = bid; it < 160 * 8; it += G) {
      const int mt = it >> 3, nt = it & 7; const int m0 = mt * 128;
      EpiResid epi; epi.xin = p.out; epi.xout = p.out; epi.gate = lmods + (size_t)cond_of(m0) * 6144 + 5 * 1024;
      gemm_tile<4>((const u16*)(R + R_ABUF), 4096, wmlp + 4194304, 4096, 4096, m0, nt * 128, (u16*)smem, epi);
    }
    grid.sync();
  }
}

extern "C" void kernel_launch(void* const* d_in, const int* in_sizes, int n_in, void* d_out, int out_size, void* d_ws, size_t ws_size, hipStream_t stream) {
  static int grid_blocks = 0;
  if (!grid_blocks) {
    int dev = 0, cus = 0, per_cu = 0;
    hipGetDevice(&dev);
    hipDeviceGetAttribute(&cus, hipDeviceAttributeMultiprocessorCount, dev);
    hipOccupancyMaxActiveBlocksPerMultiprocessor(&per_cu, fwd_megakernel, 256, 0);
    if (per_cu < 1) per_cu = 1;
    if (per_cu > 2) per_cu = 2;
    grid_blocks = cus * per_cu;
  }
  P p{};
  for (int i = 0; i < 36; ++i) p.in[i] = (const float*)d_in[i];
  p.out = (float*)d_out;
  p.ws = (char*)d_ws;
  void* args[] = {&p};
  hipError_t e = hipLaunchCooperativeKernel((void*)fwd_megakernel, dim3(grid_blocks), dim3(256), args, 0, stream);
  if (e != hipSuccess) fprintf(stderr, "cooperative launch failed: %s (grid %d)\n", hipGetErrorString(e), grid_blocks);
}
```

```cpp
#include <hip/hip_runtime.h>
#include <hip/hip_cooperative_groups.h>
#include <cstdio>
namespace cg = cooperative_groups;

typedef unsigned short u16;
typedef __attribute__((ext_vector_type(8))) short bf16x8;
typedef __attribute__((ext_vector_type(4))) short bf16x4;
typedef __attribute__((ext_vector_type(4))) float f32x4;
typedef __attribute__((ext_vector_type(4))) unsigned u32x4;
typedef __attribute__((ext_vector_type(2))) unsigned u32x2;

#define DI __device__ __forceinline__

constexpr int NTOK = 20480;
constexpr int NPROMPT = 4096;
constexpr float EPS = 1e-6f;

constexpr size_t WS_MODS = 0;
constexpr size_t MODS_BYTES = 4ull * 9 * 6144 * 4;
constexpr size_t WS_BAR = 917504;
constexpr size_t WS_ROPE = 1048576;
constexpr size_t WS_WMIX = 1114112;
constexpr size_t WS_WMLP = 14090240;
constexpr size_t WS_HBUF = 30867456;
constexpr size_t WS_OBUF = 72810496;
constexpr size_t WS_R    = 114753536;
constexpr size_t R_ABUF = 0;
constexpr size_t R_PROJ = 0;
constexpr size_t R_VBUF = 167772160;
constexpr size_t R_TBUF = 209715200;
constexpr size_t R_GBUF = 251658240;
constexpr size_t R_GCB  = 254279680;
constexpr size_t R_BETA = 255590400;
constexpr size_t R_DPROJ = 0;
constexpr size_t R_Q    = 0;
constexpr size_t R_CQ   = 62914560;
constexpr size_t R_CKV  = 78643200;
constexpr size_t R_KM   = 91226112;
constexpr size_t R_VTM  = 166723584;
constexpr size_t R_KG   = 41943040;
constexpr size_t R_VTG  = 54525952;
constexpr size_t WM_IN = 0;
constexpr size_t WM_OUT = 4325376;
constexpr size_t WM_UQ = 5373952;
constexpr size_t WM_UKV = 5963776;
constexpr size_t O_SF = 20971520, O_SB = 25165824, O_CKV = 29360128, O_KR = 30408704, O_GK = 30670848, O_GV = 31719424;

struct P {
  const float* in[36];
  float* out;
  char* ws;
};

DI u16 f2bf(float x) { unsigned u = __float_as_uint(x); u += 0x7fffu + ((u >> 16) & 1u); return (u16)(u >> 16); }
DI float bf2f(u16 h) { return __uint_as_float(((unsigned)h) << 16); }
DI unsigned pack2(float a, float b) { return (unsigned)f2bf(a) | ((unsigned)f2bf(b) << 16); }
DI float bflo(unsigned w) { return __uint_as_float(w << 16); }
DI float bfhi(unsigned w) { return __uint_as_float(w & 0xffff0000u); }
DI f32x4 mma(bf16x8 a, bf16x8 b, f32x4 c) { return __builtin_amdgcn_mfma_f32_16x16x32_bf16(a, b, c, 0, 0, 0); }
DI bf16x8 pack8(f32x4 a, f32x4 b) {
  u32x4 p; p[0] = pack2(a[0], a[1]); p[1] = pack2(a[2], a[3]); p[2] = pack2(b[0], b[1]); p[3] = pack2(b[2], b[3]);
  return __builtin_bit_cast(bf16x8, p);
}
DI bf16x8 ld8(const u16* p) { return *(const bf16x8*)p; }
DI bf16x8 ld44(const u16* p0, const u16* p1) {
  u32x2 a = *(const u32x2*)p0; u32x2 b = *(const u32x2*)p1;
  u32x4 r; r[0] = a[0]; r[1] = a[1]; r[2] = b[0]; r[3] = b[1];
  return __builtin_bit_cast(bf16x8, r);
}
DI void st4bf(u16* p, float a, float b, float c, float d) { u32x2 v; v[0] = pack2(a, b); v[1] = pack2(c, d); *(u32x2*)p = v; }
DI float wave_sum(float v) {
  v += __shfl_xor(v, 1); v += __shfl_xor(v, 2); v += __shfl_xor(v, 4); v += __shfl_xor(v, 8); v += __shfl_xor(v, 16); v += __shfl_xor(v, 32);
  return v;
}
DI float sum_g(float v) { v += __shfl_xor(v, 16); v += __shfl_xor(v, 32); return v; }
DI int opaque_tid() { int t = threadIdx.x; asm volatile("" : "+v"(t)); return t; }
DI int opaque_bid() { int t = __builtin_amdgcn_readfirstlane((int)blockIdx.x); asm volatile("" : "+s"(t)); return t; }
DI char* opaque_ptr(char* q) {
  unsigned lo = __builtin_amdgcn_readfirstlane((unsigned)(size_t)q), hi = __builtin_amdgcn_readfirstlane((unsigned)((size_t)q >> 32));
  asm volatile("" : "+s"(lo), "+s"(hi));
  return (char*)(((size_t)hi << 32) | (size_t)lo);
}
DI int cond_of(int t) { return t < NPROMPT ? 0 : 1 + ((t - NPROMPT) >> 11); }
DI int kvrow_of_tok(int t) { return t < NPROMPT ? t : NPROMPT + ((t - NPROMPT) >> 11) * 2560 + 512 + ((t - NPROMPT) & 2047); }

template <int NI, class Epi>
DI void gemm_tile(const u16* __restrict__ A, int lda, const u16* __restrict__ Bt, int ldb, int K, int m0, int n0, u16* smem, Epi& epi) {
  constexpr int MI = 16 / NI;
  constexpr int WN = 8 / NI;
  const int tid = opaque_tid(), lane = tid & 63, wid = tid >> 6, l15 = lane & 15, g = lane >> 4;
  const int wm = wid / WN, wn = wid % WN;
  u16* sA = smem; u16* sB = smem + 128 * 72;
  f32x4 acc[MI][NI];
#pragma unroll
  for (int mi = 0; mi < MI; ++mi)
#pragma unroll
    for (int ni = 0; ni < NI; ++ni) { acc[mi][ni][0] = 0.f; acc[mi][ni][1] = 0.f; acc[mi][ni][2] = 0.f; acc[mi][ni][3] = 0.f; }
  const int lrow = tid >> 3, lkc = (tid & 7) * 8;
  const u16* pa = A + (size_t)(m0 + lrow) * lda + lkc;
  const u16* pb = Bt + (size_t)(n0 + lrow) * ldb + lkc;
  u32x4 ra[2][4], rb[2][4];
  const int nk = K >> 6;
#pragma unroll
  for (int i = 0; i < 4; ++i) { ra[0][i] = *(const u32x4*)(pa + (size_t)i * 32 * lda); rb[0][i] = *(const u32x4*)(pb + (size_t)i * 32 * ldb); }
#pragma unroll
  for (int i = 0; i < 4; ++i) { ra[1][i] = *(const u32x4*)(pa + (size_t)i * 32 * lda + 64); rb[1][i] = *(const u32x4*)(pb + (size_t)i * 32 * ldb + 64); }
  for (int kt = 0; kt < nk; kt += 2) {
#pragma unroll
    for (int half = 0; half < 2; ++half) {
      __syncthreads();
#pragma unroll
      for (int i = 0; i < 4; ++i) { *(u32x4*)(sA + (lrow + 32 * i) * 72 + lkc) = ra[half][i]; *(u32x4*)(sB + (lrow + 32 * i) * 72 + lkc) = rb[half][i]; }
      __syncthreads();
      if (kt + half + 2 < nk) {
        const int ko = (kt + half + 2) * 64;
#pragma unroll
        for (int i = 0; i < 4; ++i) { ra[half][i] = *(const u32x4*)(pa + (size_t)i * 32 * lda + ko); rb[half][i] = *(const u32x4*)(pb + (size_t)i * 32 * ldb + ko); }
      }
#pragma unroll
      for (int ks = 0; ks < 2; ++ks) {
        bf16x8 af[MI], bfv[NI];
#pragma unroll
        for (int mi = 0; mi < MI; ++mi) af[mi] = ld8(sA + (wm * MI * 16 + mi * 16 + l15) * 72 + ks * 32 + g * 8);
#pragma unroll
        for (int ni = 0; ni < NI; ++ni) bfv[ni] = ld8(sB + (wn * NI * 16 + ni * 16 + l15) * 72 + ks * 32 + g * 8);
#pragma unroll
        for (int mi = 0; mi < MI; ++mi)
#pragma unroll
          for (int ni = 0; ni < NI; ++ni) acc[mi][ni] = mma(bfv[ni], af[mi], acc[mi][ni]);
      }
    }
  }
  epi.template run<MI, NI>(acc, m0 + wm * MI * 16, n0 + wn * NI * 16, l15, g);
}

struct EpiResid {
  const float* xin; float* xout; const float* gate;
  template <int MI, int NI> DI void run(f32x4 (&acc)[MI][NI], int mr, int nc, int l15, int g) {
#pragma unroll
    for (int mi = 0; mi < MI; ++mi)
#pragma unroll
      for (int ni = 0; ni < NI; ++ni) {
        const int m = mr + mi * 16 + l15, n = nc + ni * 16 + g * 4;
        const float4 xi = *(const float4*)(xin + (size_t)m * 1024 + n);
        const float4 gt = *(const float4*)(gate + n);
        float4 o; o.x = xi.x + gt.x * acc[mi][ni][0]; o.y = xi.y + gt.y * acc[mi][ni][1]; o.z = xi.z + gt.z * acc[mi][ni][2]; o.w = xi.w + gt.w * acc[mi][ni][3];
        *(float4*)(xout + (size_t)m * 1024 + n) = o;
      }
  }
};
struct EpiGdnIn {
  u16* proj; float* gbuf;
  template <int MI, int NI> DI void run(f32x4 (&acc)[MI][NI], int mr, int nc, int l15, int g) {
#pragma unroll
    for (int mi = 0; mi < MI; ++mi)
#pragma unroll
      for (int ni = 0; ni < NI; ++ni) {
        const int m = mr + mi * 16 + l15, n = nc + ni * 16 + g * 4;
        if (n < 4096) st4bf(proj + (size_t)m * 4096 + n, acc[mi][ni][0], acc[mi][ni][1], acc[mi][ni][2], acc[mi][ni][3]);
        else if (n < 4128) { float4 o; o.x = acc[mi][ni][0]; o.y = acc[mi][ni][1]; o.z = acc[mi][ni][2]; o.w = acc[mi][ni][3]; *(float4*)(gbuf + (size_t)m * 32 + (n - 4096)) = o; }
      }
  }
};
struct EpiMlpIn {
  u16* abuf;
  template <int MI, int NI> DI void run(f32x4 (&acc)[MI][NI], int mr, int nc, int l15, int g) {
#pragma unroll
    for (int mi = 0; mi < MI; ++mi)
#pragma unroll
      for (int ni = 0; ni < NI; ++ni) {
        const int m = mr + mi * 16 + l15, n = nc + ni * 16 + g * 4;
        float a = fmaxf(acc[mi][ni][0], 0.f), b = fmaxf(acc[mi][ni][1], 0.f), c = fmaxf(acc[mi][ni][2], 0.f), d = fmaxf(acc[mi][ni][3], 0.f);
        st4bf(abuf + (size_t)m * 4096 + n, a * a, b * b, c * c, d * d);
      }
  }
};
struct EpiF32 {
  float* dst; int ld;
  template <int MI, int NI> DI void run(f32x4 (&acc)[MI][NI], int mr, int nc, int l15, int g) {
#pragma unroll
    for (int mi = 0; mi < MI; ++mi)
#pragma unroll
      for (int ni = 0; ni < NI; ++ni) {
        const int m = mr + mi * 16 + l15, n = nc + ni * 16 + g * 4;
        float4 o; o.x = acc[mi][ni][0]; o.y = acc[mi][ni][1]; o.z = acc[mi][ni][2]; o.w = acc[mi][ni][3];
        *(float4*)(dst + (size_t)m * ld + n) = o;
      }
  }
};

DI void rope128(f32x4 (&v)[8], int rowp, int colp, int g, const float* cosT, const float* sinT) {
#pragma unroll
  for (int hf = 0; hf < 2; ++hf) {
    const int pos = hf ? colp : rowp;
#pragma unroll
    for (int a = 0; a < 2; ++a) {
      const int n1 = hf * 4 + a, n2 = n1 + 2;
      const float4 cs = *(const float4*)(cosT + pos * 32 + a * 16 + g * 4);
      const float4 sn = *(const float4*)(sinT + pos * 32 + a * 16 + g * 4);
      const float c4[4] = {cs.x, cs.y, cs.z, cs.w}, s4[4] = {sn.x, sn.y, sn.z, sn.w};
#pragma unroll
      for (int j = 0; j < 4; ++j) { const float x1 = v[n1][j], x2 = v[n2][j]; v[n1][j] = x1 * c4[j] - x2 * s4[j]; v[n2][j] = x1 * s4[j] + x2 * c4[j]; }
    }
  }
}
DI void rope64(f32x4* v, int rowp, int colp, int g, const float* cosT, const float* sinT) {
#pragma unroll
  for (int hf = 0; hf < 2; ++hf) {
    const int pos = hf ? colp : rowp;
    const int n1 = hf * 2, n2 = n1 + 1;
    const float4 cs = *(const float4*)(cosT + pos * 16 + g * 4);
    const float4 sn = *(const float4*)(sinT + pos * 16 + g * 4);
    const float c4[4] = {cs.x, cs.y, cs.z, cs.w}, s4[4] = {sn.x, sn.y, sn.z, sn.w};
#pragma unroll
    for (int j = 0; j < 4; ++j) { const float x1 = v[n1][j], x2 = v[n2][j]; v[n1][j] = x1 * c4[j] - x2 * s4[j]; v[n2][j] = x1 * s4[j] + x2 * c4[j]; }
  }
}

struct EpiGqaIn {
  u16* Q; u16* Kb; u16* Vt; const float* qg; const float* kg; const float* cosT; const float* sinT; float* out;
  template <int MI, int NI> DI void run(f32x4 (&acc)[MI][NI], int mr, int nc, int l15, int g) {
    const int nt = nc >> 7;
#pragma unroll
    for (int mi = 0; mi < MI; ++mi) {
      const int m = mr + mi * 16 + l15;
      const bool prompt = m < NPROMPT;
      const int s = prompt ? (m & 255) : ((m - NPROMPT) & 2047);
      const int rowp = s >> 6, colp = s & 63;
      const int kvrow = kvrow_of_tok(m);
      if (nt < 10) {
        float ss = 0.f;
#pragma unroll
        for (int ni = 0; ni < NI; ++ni)
#pragma unroll
          for (int j = 0; j < 4; ++j) ss += acc[mi][ni][j] * acc[mi][ni][j];
        ss = sum_g(ss);
        const float rs = rsqrtf(ss * (1.f / 128.f) + EPS);
        const float* gn = nt < 8 ? qg : kg;
#pragma unroll
        for (int ni = 0; ni < NI; ++ni) {
          const float4 gv = *(const float4*)(gn + ni * 16 + g * 4);
          acc[mi][ni][0] *= rs * gv.x; acc[mi][ni][1] *= rs * gv.y; acc[mi][ni][2] *= rs * gv.z; acc[mi][ni][3] *= rs * gv.w;
        }
        if (nt >= 8 && prompt) {
#pragma unroll
          for (int ni = 0; ni < NI; ++ni) { float4 o; o.x = acc[mi][ni][0]; o.y = acc[mi][ni][1]; o.z = acc[mi][ni][2]; o.w = acc[mi][ni][3]; *(float4*)(out + O_GK + (size_t)m * 256 + (nt - 8) * 128 + ni * 16 + g * 4) = o; }
        }
        if (!prompt) rope128(acc[mi], rowp, colp, g, cosT, sinT);
        u16* dst = nt < 8 ? Q + (size_t)m * 1024 + nt * 128 : Kb + (size_t)kvrow * 256 + (nt - 8) * 128;
#pragma unroll
        for (int ni = 0; ni < NI; ++ni) st4bf(dst + ni * 16 + g * 4, acc[mi][ni][0], acc[mi][ni][1], acc[mi][ni][2], acc[mi][ni][3]);
      } else {
        const int kvh = nt - 10;
        if (prompt) {
#pragma unroll
          for (int ni = 0; ni < NI; ++ni) { float4 o; o.x = acc[mi][ni][0]; o.y = acc[mi][ni][1]; o.z = acc[mi][ni][2]; o.w = acc[mi][ni][3]; *(float4*)(out + O_GV + (size_t)m * 256 + kvh * 128 + ni * 16 + g * 4) = o; }
        }
        size_t base; int kvlen, pos;
        if (prompt) { base = (size_t)(m >> 8) * 256 * 256; kvlen = 256; pos = m & 255; }
        else { const int b = (m - NPROMPT) >> 11; base = (size_t)(NPROMPT + b * 2560) * 256; kvlen = 2560; pos = 512 + s; }
#pragma unroll
        for (int ni = 0; ni < NI; ++ni)
#pragma unroll
          for (int j = 0; j < 4; ++j) Vt[base + (size_t)(kvh * 128 + ni * 16 + g * 4 + j) * kvlen + pos] = f2bf(acc[mi][ni][j]);
      }
    }
  }
};
struct EpiMlaUq {
  u16* Q; const float* gnope; const float* grope; const float* cosT; const float* sinT;
  template <int MI, int NI> DI void run(f32x4 (&acc)[MI][NI], int mr, int nc, int l15, int g) {
    const int nt = nc >> 7;
#pragma unroll
    for (int mi = 0; mi < MI; ++mi) {
      const int m = mr + mi * 16 + l15;
      const bool prompt = m < NPROMPT;
      const int s = prompt ? (m & 255) : ((m - NPROMPT) & 2047);
      const int rowp = s >> 6, colp = s & 63;
      if (nt < 8) {
        float ss = 0.f;
#pragma unroll
        for (int ni = 0; ni < NI; ++ni)
#pragma unroll
          for (int j = 0; j < 4; ++j) ss += acc[mi][ni][j] * acc[mi][ni][j];
        ss = sum_g(ss);
        const float rs = rsqrtf(ss * (1.f / 128.f) + EPS);
#pragma unroll
        for (int ni = 0; ni < NI; ++ni) {
          const float4 gv = *(const float4*)(gnope + ni * 16 + g * 4);
          st4bf(Q + (size_t)m * 1536 + nt * 192 + ni * 16 + g * 4, acc[mi][ni][0] * rs * gv.x, acc[mi][ni][1] * rs * gv.y, acc[mi][ni][2] * rs * gv.z, acc[mi][ni][3] * rs * gv.w);
        }
      } else {
#pragma unroll
        for (int hh = 0; hh < 2; ++hh) {
          const int h = (nt - 8) * 2 + hh;
          float ss = 0.f;
#pragma unroll
          for (int ni = 0; ni < 4; ++ni)
#pragma unroll
            for (int j = 0; j < 4; ++j) ss += acc[mi][hh * 4 + ni][j] * acc[mi][hh * 4 + ni][j];
          ss = sum_g(ss);
          const float rs = rsqrtf(ss * (1.f / 64.f) + EPS);
#pragma unroll
          for (int ni = 0; ni < 4; ++ni) {
            const float4 gv = *(const float4*)(grope + ni * 16 + g * 4);
            acc[mi][hh * 4 + ni][0] *= rs * gv.x; acc[mi][hh * 4 + ni][1] *= rs * gv.y; acc[mi][hh * 4 + ni][2] *= rs * gv.z; acc[mi][hh * 4 + ni][3] *= rs * gv.w;
          }
          if (!prompt) rope64(&acc[mi][hh * 4], rowp, colp, g, cosT, sinT);
#pragma unroll
          for (int ni = 0; ni < 4; ++ni)
            st4bf(Q + (size_t)m * 1536 + h * 192 + 128 + ni * 16 + g * 4, acc[mi][hh * 4 + ni][0], acc[mi][hh * 4 + ni][1], acc[mi][hh * 4 + ni][2], acc[mi][hh * 4 + ni][3]);
        }
      }
    }
  }
};
struct EpiMlaUkv {
  u16* Kb; u16* Vt; const float* gnope;
  template <int MI, int NI> DI void run(f32x4 (&acc)[MI][NI], int mr, int nc, int l15, int g) {
    const int nt = nc >> 7, h = nt >> 1;
#pragma unroll
    for (int mi = 0; mi < MI; ++mi) {
      const int m = mr + mi * 16 + l15;
      if ((nt & 1) == 0) {
        float ss = 0.f;
#pragma unroll
        for (int ni = 0; ni < NI; ++ni)
#pragma unroll
          for (int j = 0; j < 4; ++j) ss += acc[mi][ni][j] * acc[mi][ni][j];
        ss = sum_g(ss);
        const float rs = rsqrtf(ss * (1.f / 128.f) + EPS);
#pragma unroll
        for (int ni = 0; ni < NI; ++ni) {
          const float4 gv = *(const float4*)(gnope + ni * 16 + g * 4);
          st4bf(Kb + (size_t)m * 1536 + h * 192 + ni * 16 + g * 4, acc[mi][ni][0] * rs * gv.x, acc[mi][ni][1] * rs * gv.y, acc[mi][ni][2] * rs * gv.z, acc[mi][ni][3] * rs * gv.w);
        }
      } else {
        size_t base; int kvlen, pos;
        if (m < NPROMPT) { base = (size_t)(m >> 8) * 256 * 1024; kvlen = 256; pos = m & 255; }
        else { const int r = m - NPROMPT; const int b = r / 2560; base = (size_t)(NPROMPT + b * 2560) * 1024; kvlen = 2560; pos = r - b * 2560; }
#pragma unroll
        for (int ni = 0; ni < NI; ++ni)
#pragma unroll
          for (int j = 0; j < 4; ++j) Vt[base + (size_t)(h * 128 + ni * 16 + g * 4 + j) * kvlen + pos] = f2bf(acc[mi][ni][j]);
      }
    }
  }
};

DI void convert_tile(const float* __restrict__ W, int K, int N, u16* __restrict__ Bt, int tile, int perm, float* sT) {
  const int nkt = K >> 6;
  const int kt = tile % nkt, nt = tile / nkt;
  const int k0 = kt * 64, n0 = nt * 64;
  const int tid = opaque_tid();
  __syncthreads();
  {
    const int n = tid & 63, kq = tid >> 6;
    int nd = n0 + n, ns = nd;
    if (perm == 1) { if (nd < 1024) ns = (nd >> 7) * 192 + (nd & 127); else { const int x = nd - 1024; ns = (x >> 6) * 192 + 128 + (x & 63); } }
    const bool ok = nd < N;
#pragma unroll
    for (int r = 0; r < 16; ++r) { const int k = r * 4 + kq; sT[k * 65 + n] = ok ? W[(size_t)(k0 + k) * N + ns] : 0.f; }
  }
  __syncthreads();
  {
    const int n = tid >> 2, kq = (tid & 3) * 16;
    u32x4 a, b;
#pragma unroll
    for (int e = 0; e < 4; ++e) { a[e] = pack2(sT[(kq + 2 * e) * 65 + n], sT[(kq + 2 * e + 1) * 65 + n]); b[e] = pack2(sT[(kq + 8 + 2 * e) * 65 + n], sT[(kq + 9 + 2 * e) * 65 + n]); }
    u16* dst = Bt + (size_t)(n0 + n) * K + k0 + kq;
    *(u32x4*)dst = a; *(u32x4*)(dst + 8) = b;
  }
}

DI void norm_rows(const P& p, int layer, bool from_input, int item, const float* gnorm, int shift_idx, int scale_idx) {
  const int tidn = opaque_tid();
  char* const ws = opaque_ptr(p.ws);
  const int lane = tidn & 63, wid = tidn >> 6;
  const int t = item * 4 + wid;
  const float* x = from_input ? (t < NPROMPT ? p.in[0] + (size_t)t * 1024 : p.in[1] + (size_t)(t - NPROMPT) * 1024) : p.out + (size_t)t * 1024;
  const float* mods = (const float*)(ws + WS_MODS) + ((size_t)layer * 9 + cond_of(t)) * 6144;
  u16* h = (u16*)(ws + WS_HBUF) + (size_t)t * 1024;
  float4 v[4]; float ss = 0.f;
#pragma unroll
  for (int e = 0; e < 4; ++e) { v[e] = *(const float4*)(x + e * 256 + lane * 4); ss += v[e].x * v[e].x + v[e].y * v[e].y + v[e].z * v[e].z + v[e].w * v[e].w; }
  ss = wave_sum(ss);
  const float rs = rsqrtf(ss * (1.f / 1024.f) + EPS);
#pragma unroll
  for (int e = 0; e < 4; ++e) {
    const int c = e * 256 + lane * 4;
    const float4 gv = *(const float4*)(gnorm + c);
    const float4 sc = *(const float4*)(mods + scale_idx * 1024 + c);
    const float4 sh = *(const float4*)(mods + shift_idx * 1024 + c);
    st4bf(h + c, v[e].x * rs * gv.x * (1.f + sc.x) + sh.x, v[e].y * rs * gv.y * (1.f + sc.y) + sh.y, v[e].z * rs * gv.z * (1.f + sc.z) + sh.z, v[e].w * rs * gv.w * (1.f + sc.w) + sh.w);
  }
}

template <int DK, int HK>
DI void attn_phase(const u16* __restrict__ Q, const u16* __restrict__ Kb, const u16* __restrict__ Vt, u16* __restrict__ obuf, char* smem_raw) {
  const int bid = opaque_bid();
  constexpr int KS = DK / 32, KSTR = DK + 8, QSTR = 8 * DK, KROW = HK * DK, GRP = 8 / HK;
  constexpr int CPR = DK / 8;
  constexpr int KCH = 64 * CPR / 256;
  u16* sK = (u16*)smem_raw;
  u16* sV = sK + 64 * KSTR;
  const int tid = opaque_tid(), lane = tid & 63, wid = tid >> 6, l15 = lane & 15, g = lane >> 4;
  const float sc = rsqrtf((float)DK) * 1.4426950408889634f;
  for (int item = bid; item < 1280; item += gridDim.x) {
    int qb, h, kvlen, tokbase, kvbase;
    if (item < 1024) { const int b = item >> 7, rem = item & 127; h = rem & 7; qb = rem >> 3; kvlen = 2560; tokbase = NPROMPT + b * 2048; kvbase = NPROMPT + b * 2560; }
    else { const int it2 = item - 1024; const int b = it2 >> 4, rem = it2 & 15; h = rem & 7; qb = rem >> 3; kvlen = 256; tokbase = b * 256; kvbase = b * 256; }
    const int kvh = h / GRP;
    const u16* Kp = Kb + (size_t)kvbase * KROW + kvh * DK;
    const u16* Vp = Vt + (size_t)kvbase * (HK * 128) + (size_t)kvh * 128 * kvlen;
    const int qrow0 = tokbase + qb * 128 + wid * 32;
    bf16x8 qf[2][KS];
#pragma unroll
    for (int qi = 0; qi < 2; ++qi)
#pragma unroll
      for (int ks = 0; ks < KS; ++ks) qf[qi][ks] = ld8(Q + (size_t)(qrow0 + qi * 16 + l15) * QSTR + h * DK + ks * 32 + g * 8);
    f32x4 ot[2][8];
#pragma unroll
    for (int qi = 0; qi < 2; ++qi)
#pragma unroll
      for (int dj = 0; dj < 8; ++dj) { ot[qi][dj][0] = 0.f; ot[qi][dj][1] = 0.f; ot[qi][dj][2] = 0.f; ot[qi][dj][3] = 0.f; }
    float mrun[2] = {-1e30f, -1e30f}, lrun[2] = {0.f, 0.f};
    const int ntiles = kvlen >> 6;
    for (int kt = 0; kt < ntiles; ++kt) {
      const u16* Kt = Kp + (size_t)kt * 64 * KROW;
      const u16* Vtp = Vp + kt * 64;
      __syncthreads();
#pragma unroll
      for (int i = 0; i < KCH; ++i) { const int c = tid + 256 * i; const int row = c / CPR, kc = (c % CPR) * 8; *(u32x4*)(sK + row * KSTR + kc) = *(const u32x4*)(Kt + (unsigned)(row * KROW + kc)); }
      __builtin_amdgcn_sched_barrier(0);
#pragma unroll
      for (int i = 0; i < 4; ++i) { const int c = tid + 256 * i; const int row = c >> 3, kc = (c & 7) * 8; *(u32x4*)(sV + row * 72 + kc) = *(const u32x4*)(Vtp + (unsigned)(row * kvlen + kc)); }
      __syncthreads();
#pragma unroll
      for (int qi = 0; qi < 2; ++qi) {
        __builtin_amdgcn_sched_barrier(0);
        f32x4 st[4];
#pragma unroll
        for (int kj = 0; kj < 4; ++kj) { st[kj][0] = 0.f; st[kj][1] = 0.f; st[kj][2] = 0.f; st[kj][3] = 0.f; }
#pragma unroll
        for (int ks = 0; ks < KS; ++ks) {
#pragma unroll
          for (int kj = 0; kj < 4; ++kj) st[kj] = mma(ld8(sK + (kj * 16 + l15) * KSTR + ks * 32 + g * 8), qf[qi][ks], st[kj]);
          __builtin_amdgcn_sched_barrier(0);
        }
        float mx = -1e30f;
#pragma unroll
        for (int kj = 0; kj < 4; ++kj)
#pragma unroll
          for (int r = 0; r < 4; ++r) mx = fmaxf(mx, st[kj][r]);
        mx = fmaxf(mx, __shfl_xor(mx, 16)); mx = fmaxf(mx, __shfl_xor(mx, 32));
        const float mnew = fmaxf(mrun[qi], mx);
        const float alpha = __builtin_amdgcn_exp2f((mrun[qi] - mnew) * sc);
        mrun[qi] = mnew;
        float ps = 0.f;
#pragma unroll
        for (int kj = 0; kj < 4; ++kj)
#pragma unroll
          for (int r = 0; r < 4; ++r) { const float pv = __builtin_amdgcn_exp2f((st[kj][r] - mnew) * sc); st[kj][r] = pv; ps += pv; }
        lrun[qi] = lrun[qi] * alpha + ps;
#pragma unroll
        for (int dj = 0; dj < 8; ++dj) { ot[qi][dj][0] *= alpha; ot[qi][dj][1] *= alpha; ot[qi][dj][2] *= alpha; ot[qi][dj][3] *= alpha; }
        bf16x8 pf[2];
        pf[0] = pack8(st[0], st[1]);
        pf[1] = pack8(st[2], st[3]);
        __builtin_amdgcn_sched_barrier(0);
#pragma unroll
        for (int kk = 0; kk < 2; ++kk)
#pragma unroll
          for (int dj = 0; dj < 8; ++dj) {
            const u16* vp = sV + (dj * 16 + l15) * 72 + kk * 32 + g * 4;
            ot[qi][dj] = mma(ld44(vp, vp + 16), pf[kk], ot[qi][dj]);
            if ((dj & 3) == 3) __builtin_amdgcn_sched_barrier(0);
          }
      }
    }
#pragma unroll
    for (int qi = 0; qi < 2; ++qi) {
      const float inv = 1.f / sum_g(lrun[qi]);
      u16* dst = obuf + (size_t)(qrow0 + qi * 16 + l15) * 1024 + h * 128 + g * 4;
#pragma unroll
      for (int dj = 0; dj < 8; ++dj) st4bf(dst + dj * 16, ot[qi][dj][0] * inv, ot[qi][dj][1] * inv, ot[qi][dj][2] * inv, ot[qi][dj][3] * inv);
    }
  }
}

DI void gdn_chunk_phase(const P& p, int j, char* smem_raw) {
  const int bid = opaque_bid();
  char* const ws = opaque_ptr(p.ws);
  u16* sK = (u16*)smem_raw;
  float* sA = (float*)(smem_raw + 17408);
  float* sG = (float*)(smem_raw + 17408 + 32768);
  float* sBt = sG + 128;
  const int tid = opaque_tid(), lane = tid & 63, wid = tid >> 6, l15 = lane & 15, g = lane >> 4;
  const u16* proj = (const u16*)(ws + WS_R + R_PROJ);
  u16* qn = (u16*)(ws + WS_HBUF); u16* kn = (u16*)(ws + WS_OBUF); u16* vb = (u16*)(ws + WS_R + R_VBUF);
  u16* Tbuf = (u16*)(ws + WS_R + R_TBUF);
  const float* gbuf = (const float*)(ws + WS_R + R_GBUF);
  float* gcb = (float*)(ws + WS_R + R_GCB); float* betab = (float*)(ws + WS_R + R_BETA);
  const float* conv = p.in[17] + (size_t)j * 3 * 3072;
  const float* a_log = p.in[18] + j * 16; const float* dt_bias = p.in[19] + j * 16;
  for (int unit = bid; unit < 2560; unit += gridDim.x) {
    const int cgi = unit >> 3, h = unit & 7;
    int c, nch; if (cgi < 64) { c = cgi & 3; nch = 4; } else { c = (cgi - 64) & 31; nch = 32; }
    const int t0 = cgi * 64;
    const bool has_prev = c > 0, has_next = c < nch - 1;
    __syncthreads();
    {
      const int r = tid >> 4, cc = (tid & 15) * 8;
#pragma unroll
      for (int part = 0; part < 3; ++part) {
        const int ch = part * 1024 + h * 128 + cc;
        float w0[8], w1[8], w2[8];
#pragma unroll
        for (int e = 0; e < 8; ++e) { w0[e] = conv[ch + e]; w1[e] = conv[3072 + ch + e]; w2[e] = conv[6144 + ch + e]; }
        u16* dstb = part == 0 ? qn : (part == 1 ? kn : vb);
        for (int it = 0; it < 4; ++it) {
          const int i = it * 16 + r, t = t0 + i;
          const u16* src = proj + (size_t)t * 4096 + ch;
          const u32x4 xc = *(const u32x4*)src;
          u32x4 xp = {0u, 0u, 0u, 0u}, xn = {0u, 0u, 0u, 0u};
          if (i > 0 || has_prev) xp = *(const u32x4*)(src - 4096);
          if (i < 63 || has_next) xn = *(const u32x4*)(src + 4096);
          float y[8];
#pragma unroll
          for (int e = 0; e < 4; ++e) {
            float a = w0[2 * e] * bflo(xp[e]) + w1[2 * e] * bflo(xc[e]) + w2[2 * e] * bflo(xn[e]);
            float b = w0[2 * e + 1] * bfhi(xp[e]) + w1[2 * e + 1] * bfhi(xc[e]) + w2[2 * e + 1] * bfhi(xn[e]);
            y[2 * e] = a / (1.f + expf(-a)); y[2 * e + 1] = b / (1.f + expf(-b));
          }
          if (part < 2) {
            float ss = 0.f;
#pragma unroll
            for (int e = 0; e < 8; ++e) ss += y[e] * y[e];
            ss += __shfl_xor(ss, 1); ss += __shfl_xor(ss, 2); ss += __shfl_xor(ss, 4); ss += __shfl_xor(ss, 8);
            const float rs = rsqrtf(ss + EPS) * (part == 0 ? 0.08838834764831845f : 1.f);
#pragma unroll
            for (int e = 0; e < 8; ++e) y[e] *= rs;
          }
          u32x4 o; o[0] = pack2(y[0], y[1]); o[1] = pack2(y[2], y[3]); o[2] = pack2(y[4], y[5]); o[3] = pack2(y[6], y[7]);
          *(u32x4*)(dstb + (size_t)t * 1024 + h * 128 + cc) = o;
          if (part == 1) *(u32x4*)(sK + i * 136 + cc) = o;
        }
      }
    }
    if (tid < 128) {
      const int dir = tid >> 6, L = tid & 63;
      const int i = dir ? 63 - L : L;
      const float* gb = gbuf + (size_t)(t0 + i) * 32;
      const float gin = gb[dir * 8 + h], bin = gb[16 + dir * 8 + h];
      const float x = gin + dt_bias[dir * 8 + h];
      const float sp = fmaxf(x, 0.f) + log1pf(expf(-fabsf(x)));
      float gv = -expf(a_log[dir * 8 + h]) * sp;
      const float bt = 1.f / (1.f + expf(-bin));
#pragma unroll
      for (int off = 1; off < 64; off <<= 1) { const float v = __shfl_up(gv, off); if (L >= off) gv += v; }
      sG[dir * 64 + i] = gv; sBt[dir * 64 + i] = bt;
      gcb[((size_t)(t0 + i) * 8 + h) * 2 + dir] = gv; betab[((size_t)(t0 + i) * 8 + h) * 2 + dir] = bt;
    }
    __syncthreads();
    {
      f32x4 ga[4];
#pragma unroll
      for (int mt = 0; mt < 4; ++mt) { ga[mt][0] = 0.f; ga[mt][1] = 0.f; ga[mt][2] = 0.f; ga[mt][3] = 0.f; }
#pragma unroll
      for (int ks = 0; ks < 4; ++ks) {
        const bf16x8 a = ld8(sK + (wid * 16 + l15) * 136 + ks * 32 + g * 8);
#pragma unroll
        for (int mt = 0; mt < 4; ++mt) { const bf16x8 b = ld8(sK + (mt * 16 + l15) * 136 + ks * 32 + g * 8); ga[mt] = mma(a, b, ga[mt]); }
      }
#pragma unroll
      for (int dir = 0; dir < 2; ++dir)
#pragma unroll
        for (int mt = 0; mt < 4; ++mt)
#pragma unroll
          for (int r = 0; r < 4; ++r) {
            const int i = wid * 16 + g * 4 + r, m = mt * 16 + l15;
            const bool valid = dir ? (i < m) : (i > m);
            const float val = valid ? sBt[dir * 64 + i] * ga[mt][r] * expf(sG[dir * 64 + i] - sG[dir * 64 + m]) : 0.f;
            const int ii = dir ? 63 - i : i, mm = dir ? 63 - m : m;
            sA[dir * 4096 + ii * 64 + mm] = val;
          }
    }
    __syncthreads();
    if (wid < 2) {
      const int dir = wid;
      float* Am = sA + dir * 4096;
      for (int i = 0; i < 64; ++i) {
        float a = (i == lane) ? 1.f : 0.f;
        for (int m = 0; m < i; ++m) a -= Am[i * 64 + m] * Am[m * 64 + lane];
        Am[i * 64 + lane] = a;
      }
      const int mn = dir ? 63 - lane : lane;
      const float bm = sBt[dir * 64 + mn];
      u16* Td = Tbuf + ((size_t)unit * 2 + dir) * 4096;
#pragma unroll 4
      for (int i = 0; i < 64; ++i) { const int in_ = dir ? 63 - i : i; Td[in_ * 64 + mn] = f2bf(Am[i * 64 + lane] * bm); }
    }
  }
}

DI void gdn_scan_phase(const P& p, int j, char* smem_raw) {
  const int bid = opaque_bid();
  char* const ws = opaque_ptr(p.ws);
  u16* sK = (u16*)smem_raw;
  u16* sKT = sK + 64 * 136;
  u16* sVT = sKT + 128 * 72;
  u16* sST = sVT + 32 * 72;
  u16* sVN = sST + 32 * 136;
  u16* sVD = sVN + 32 * 72;
  float* sGc = (float*)(sVD + 32 * 72);
  const int tid = opaque_tid(), lane = tid & 63, w = tid >> 6, l15 = lane & 15, g = lane >> 4;
  const u16* qn = (const u16*)(ws + WS_HBUF); const u16* kn = (const u16*)(ws + WS_OBUF); const u16* vb = (const u16*)(ws + WS_R + R_VBUF);
  const u16* Tbuf = (const u16*)(ws + WS_R + R_TBUF);
  const float* gcb = (const float*)(ws + WS_R + R_GCB);
  u16* obase = (u16*)(ws + WS_R + R_PROJ);
  for (int wk = bid; wk < 1536; wk += gridDim.x) {
    int seq, rem;
    if (wk < 512) { seq = 16 + (wk >> 6); rem = wk & 63; } else { seq = (wk - 512) >> 6; rem = (wk - 512) & 63; }
    const int h = rem >> 3, dir = (rem >> 2) & 1, dvq = rem & 3;
    const int nch = seq < 16 ? 4 : 32;
    const int cgb = seq < 16 ? seq * 4 : 64 + (seq - 16) * 32;
    f32x4 S[2][2];
    if (seq >= 16) {
      const float* s0 = p.in[2 + dir] + (((size_t)(seq - 16) * 2 + j) * 8 + h) * 16384;
#pragma unroll
      for (int dt = 0; dt < 2; ++dt)
#pragma unroll
        for (int et = 0; et < 2; ++et)
#pragma unroll
          for (int r = 0; r < 4; ++r) S[dt][et][r] = s0[(size_t)(w * 32 + dt * 16 + g * 4 + r) * 128 + dvq * 32 + et * 16 + l15];
    } else {
#pragma unroll
      for (int dt = 0; dt < 2; ++dt)
#pragma unroll
        for (int et = 0; et < 2; ++et) { S[dt][et][0] = 0.f; S[dt][et][1] = 0.f; S[dt][et][2] = 0.f; S[dt][et][3] = 0.f; }
    }
    __syncthreads();
#pragma unroll
    for (int dt = 0; dt < 2; ++dt)
#pragma unroll
      for (int et = 0; et < 2; ++et) st4bf(sST + (et * 16 + l15) * 136 + w * 32 + dt * 16 + g * 4, S[dt][et][0], S[dt][et][1], S[dt][et][2], S[dt][et][3]);
    for (int step = 0; step < nch; ++step) {
      const int c = dir ? nch - 1 - step : step;
      const int t0 = (cgb + c) * 64;
      const int unit = (cgb + c) * 8 + h;
#pragma unroll
      for (int i = 0; i < 4; ++i) {
        const int ci = tid + 256 * i; const int row = ci >> 4, dc = (ci & 15) * 8;
        const u32x4 v = *(const u32x4*)(kn + (size_t)(t0 + row) * 1024 + h * 128 + dc);
        *(u32x4*)(sK + row * 136 + dc) = v;
#pragma unroll
        for (int e = 0; e < 4; ++e) { sKT[(dc + 2 * e) * 72 + row] = (u16)(v[e] & 0xffffu); sKT[(dc + 2 * e + 1) * 72 + row] = (u16)(v[e] >> 16); }
      }
      {
        const int row = tid >> 2, ec = (tid & 3) * 8;
        const u32x4 v = *(const u32x4*)(vb + (size_t)(t0 + row) * 1024 + h * 128 + dvq * 32 + ec);
#pragma unroll
        for (int e = 0; e < 4; ++e) { sVT[(ec + 2 * e) * 72 + row] = (u16)(v[e] & 0xffffu); sVT[(ec + 2 * e + 1) * 72 + row] = (u16)(v[e] >> 16); }
      }
      if (tid < 64) sGc[tid] = gcb[((size_t)(t0 + tid) * 8 + h) * 2 + dir];
      bf16x8 qf[4], tf[2];
#pragma unroll
      for (int ks = 0; ks < 4; ++ks) qf[ks] = ld8(qn + (size_t)(t0 + w * 16 + l15) * 1024 + h * 128 + ks * 32 + g * 8);
#pragma unroll
      for (int ks = 0; ks < 2; ++ks) tf[ks] = ld8(Tbuf + ((size_t)unit * 2 + dir) * 4096 + (w * 16 + l15) * 64 + ks * 32 + g * 8);
      __syncthreads();
      const float gl = dir ? sGc[0] : sGc[63];
      f32x4 ua[2];
#pragma unroll
      for (int et = 0; et < 2; ++et) {
        ua[et][0] = 0.f; ua[et][1] = 0.f; ua[et][2] = 0.f; ua[et][3] = 0.f;
#pragma unroll
        for (int ks = 0; ks < 2; ++ks) ua[et] = mma(tf[ks], ld8(sVT + (et * 16 + l15) * 72 + ks * 32 + g * 8), ua[et]);
      }
      bf16x8 tf2[2];
#pragma unroll
      for (int ks = 0; ks < 2; ++ks) {
        const u32x4 tw = __builtin_bit_cast(u32x4, tf[ks]);
        u32x4 o;
#pragma unroll
        for (int e = 0; e < 4; ++e) {
          const int m = ks * 32 + g * 8 + 2 * e;
          o[e] = pack2(bflo(tw[e]) * expf(sGc[m]), bfhi(tw[e]) * expf(sGc[m + 1]));
        }
        tf2[ks] = __builtin_bit_cast(bf16x8, o);
      }
      bf16x8 wf[4];
#pragma unroll
      for (int kq = 0; kq < 4; ++kq) {
        f32x4 wa[2];
#pragma unroll
        for (int hh = 0; hh < 2; ++hh) {
          const int dt = kq * 2 + hh;
          wa[hh][0] = 0.f; wa[hh][1] = 0.f; wa[hh][2] = 0.f; wa[hh][3] = 0.f;
#pragma unroll
          for (int ks = 0; ks < 2; ++ks) wa[hh] = mma(ld8(sKT + (dt * 16 + l15) * 72 + ks * 32 + g * 8), tf2[ks], wa[hh]);
        }
        wf[kq] = pack8(wa[0], wa[1]);
      }
      f32x4 vn[2];
#pragma unroll
      for (int et = 0; et < 2; ++et) {
        f32x4 a; a[0] = 0.f; a[1] = 0.f; a[2] = 0.f; a[3] = 0.f;
#pragma unroll
        for (int kq = 0; kq < 4; ++kq) { const u16* sp = sST + (et * 16 + l15) * 136 + kq * 32 + g * 4; a = mma(wf[kq], ld44(sp, sp + 16), a); }
        vn[et][0] = ua[et][0] - a[0]; vn[et][1] = ua[et][1] - a[1]; vn[et][2] = ua[et][2] - a[2]; vn[et][3] = ua[et][3] - a[3];
      }
      bf16x8 qkf[2];
      {
        const int iq = w * 16 + l15;
        const float gi = sGc[iq];
#pragma unroll
        for (int kk = 0; kk < 2; ++kk) {
          f32x4 ka[2];
#pragma unroll
          for (int hh = 0; hh < 2; ++hh) {
            const int mt = kk * 2 + hh;
            ka[hh][0] = 0.f; ka[hh][1] = 0.f; ka[hh][2] = 0.f; ka[hh][3] = 0.f;
#pragma unroll
            for (int ks = 0; ks < 4; ++ks) ka[hh] = mma(ld8(sK + (mt * 16 + l15) * 136 + ks * 32 + g * 8), qf[ks], ka[hh]);
#pragma unroll
            for (int r = 0; r < 4; ++r) {
              const int m = mt * 16 + g * 4 + r;
              const bool valid = dir ? (iq <= m) : (iq >= m);
              ka[hh][r] = valid ? ka[hh][r] * expf(gi - sGc[m]) : 0.f;
            }
          }
          qkf[kk] = pack8(ka[0], ka[1]);
        }
      }
#pragma unroll
      for (int et = 0; et < 2; ++et) {
        const int i0 = w * 16 + g * 4;
        st4bf(sVN + (et * 16 + l15) * 72 + i0, vn[et][0], vn[et][1], vn[et][2], vn[et][3]);
        st4bf(sVD + (et * 16 + l15) * 72 + i0, vn[et][0] * expf(gl - sGc[i0]), vn[et][1] * expf(gl - sGc[i0 + 1]), vn[et][2] * expf(gl - sGc[i0 + 2]), vn[et][3] * expf(gl - sGc[i0 + 3]));
      }
      __syncthreads();
#pragma unroll
      for (int et = 0; et < 2; ++et) {
        f32x4 a1; a1[0] = 0.f; a1[1] = 0.f; a1[2] = 0.f; a1[3] = 0.f;
#pragma unroll
        for (int ks = 0; ks < 4; ++ks) a1 = mma(qf[ks], ld8(sST + (et * 16 + l15) * 136 + ks * 32 + g * 8), a1);
        f32x4 a2; a2[0] = 0.f; a2[1] = 0.f; a2[2] = 0.f; a2[3] = 0.f;
#pragma unroll
        for (int kk = 0; kk < 2; ++kk) { const u16* sp = sVN + (et * 16 + l15) * 72 + kk * 32 + g * 4; a2 = mma(qkf[kk], ld44(sp, sp + 16), a2); }
#pragma unroll
        for (int r = 0; r < 4; ++r) {
          const int i = w * 16 + g * 4 + r;
          const float o = a1[r] * expf(sGc[i]) + a2[r];
          obase[(size_t)(t0 + i) * 4096 + dir * 1024 + h * 128 + dvq * 32 + et * 16 + l15] = f2bf(o);
        }
      }
      {
        const float eg = expf(gl);
#pragma unroll
        for (int dt = 0; dt < 2; ++dt)
#pragma unroll
          for (int et = 0; et < 2; ++et) {
            f32x4 a; a[0] = S[dt][et][0] * eg; a[1] = S[dt][et][1] * eg; a[2] = S[dt][et][2] * eg; a[3] = S[dt][et][3] * eg;
#pragma unroll
            for (int kk = 0; kk < 2; ++kk) a = mma(ld8(sKT + (w * 32 + dt * 16 + l15) * 72 + kk * 32 + g * 8), ld8(sVD + (et * 16 + l15) * 72 + kk * 32 + g * 8), a);
            S[dt][et] = a;
          }
      }
      __syncthreads();
#pragma unroll
      for (int dt = 0; dt < 2; ++dt)
#pragma unroll
        for (int et = 0; et < 2; ++et) st4bf(sST + (et * 16 + l15) * 136 + w * 32 + dt * 16 + g * 4, S[dt][et][0], S[dt][et][1], S[dt][et][2], S[dt][et][3]);
    }
    if (seq < 16) {
      float* so = p.out + (dir ? O_SB : O_SF) + (((size_t)seq * 2 + j) * 8 + h) * 16384;
#pragma unroll
      for (int dt = 0; dt < 2; ++dt)
#pragma unroll
        for (int et = 0; et < 2; ++et)
#pragma unroll
          for (int r = 0; r < 4; ++r) so[(size_t)(w * 32 + dt * 16 + g * 4 + r) * 128 + dvq * 32 + et * 16 + l15] = S[dt][et][r];
    }
  }
}

#define XB_TMO      128
#define XB_XCNT(j)  (256  + 64 * (j))
#define XB_XSUB(j)  (1280 + 64 * (j))
#define XB_XGEN(j)  (2304 + 64 * (j))
#define XB_TOP      3328
#define XB_TOPGEN   3392
#define XCD_BAR_WORDS 3456
#define XB_SPIN_CAP (1u << 20)
#define LAS __attribute__((address_space(3)))
DI unsigned xb_ld(unsigned* p)              { return __hip_atomic_load(p, __ATOMIC_RELAXED, __HIP_MEMORY_SCOPE_AGENT); }
DI unsigned xb_add(unsigned* p, unsigned v) { return __hip_atomic_fetch_add(p, v, __ATOMIC_RELAXED, __HIP_MEMORY_SCOPE_AGENT); }
DI unsigned xb_xcc_id() { return (unsigned)__builtin_amdgcn_s_getreg((3 << 11) | 20) & 0xFu; }
#define XB_SPIN(cond, bar) do { unsigned _sp = 0; while (cond) { __builtin_amdgcn_s_sleep(1); \
    if ((++_sp & 255u) == 0u) { if (xb_ld(&(bar)[XB_TMO])) break; if (_sp > XB_SPIN_CAP) { atomicAdd(&(bar)[XB_TMO], 1u); break; } } } } while (0)
struct XcdBarrier { unsigned* bar; unsigned x; volatile LAS unsigned* st; };
DI XcdBarrier xcd_barrier_post(unsigned* bar, volatile LAS unsigned* st) {
  XcdBarrier b; b.bar = bar; b.x = xb_xcc_id(); b.st = st;
  if (threadIdx.x == 0) (void)xb_add(&bar[XB_XCNT(b.x)], 1u);
  return b;
}
DI void xcd_barrier_complete(unsigned* bar, unsigned x, unsigned& nloc, unsigned& nx) {
  const unsigned Gn = gridDim.x * gridDim.y * gridDim.z;
  unsigned sum, cnt, mine, sp = 0u;
  for (;;) {
    sum = 0u; cnt = 0u; mine = 0u;
#pragma unroll
    for (unsigned j = 0; j < 16; ++j) { const unsigned c = xb_ld(&bar[XB_XCNT(j)]); sum += c; cnt += (c > 0u) ? 1u : 0u; mine = (j == x) ? c : mine; }
    if (sum == Gn) break;
    __builtin_amdgcn_s_sleep(1);
    if ((++sp & 255u) == 0u) { if (xb_ld(&bar[XB_TMO])) break; if (sp > XB_SPIN_CAP) { atomicAdd(&bar[XB_TMO], 1u); break; } }
  }
  nloc = mine > 0u ? mine : 1u; nx = cnt > 0u ? cnt : 1u;
}
DI void xcd_barrier(const XcdBarrier& b) {
  asm volatile("s_waitcnt vmcnt(0)" ::: "memory");
  __syncthreads();
  if (threadIdx.x == 0) {
    unsigned* bar = b.bar;
    __builtin_amdgcn_s_waitcnt(0);
    unsigned nloc = b.st[0], nx = b.st[1];
    if (nloc == 0u) { xcd_barrier_complete(bar, b.x, nloc, nx); b.st[0] = nloc; b.st[1] = nx; }
    const unsigned old = xb_add(&bar[XB_XSUB(b.x)], 1u);
    const unsigned gen = old / nloc;
    if (old + 1u == (gen + 1u) * nloc) {
      __builtin_amdgcn_fence(__ATOMIC_RELEASE, "agent");
      asm volatile("s_waitcnt vmcnt(0)" ::: "memory");
      const unsigned og = xb_add(&bar[XB_TOP], 1u);
      const unsigned tg = og / nx;
      if (og + 1u == (tg + 1u) * nx) xb_add(&bar[XB_TOPGEN], 1u);
      else XB_SPIN(xb_ld(&bar[XB_TOPGEN]) == tg, bar);
      __builtin_amdgcn_fence(__ATOMIC_ACQUIRE, "agent");
      xb_add(&bar[XB_XGEN(b.x)], 1u);
      asm volatile("s_waitcnt vmcnt(0)" ::: "memory");
    } else {
      XB_SPIN(xb_ld(&bar[XB_XGEN(b.x)]) == gen, bar);
      __builtin_amdgcn_fence(__ATOMIC_ACQUIRE, "agent");
      asm volatile("s_waitcnt vmcnt(0)" ::: "memory");
    }
  }
  __syncthreads();
}

__global__ void __launch_bounds__(256, 2) fwd_megakernel(P p) {
  cg::grid_group grid = cg::this_grid();
  __shared__ __attribute__((aligned(16))) char smem[60416];
  const int tid = opaque_tid(), lane = tid & 63, wid = tid >> 6;
  const int G = gridDim.x;
  __shared__ uint4 xb_words;
  if (threadIdx.x == 0) xb_words = make_uint4(0u, 0u, 0u, 0u);
  __syncthreads();
  (void)xcd_barrier_post((unsigned*)(p.ws + WS_BAR), (volatile LAS unsigned*)&xb_words);
#define GSYNC() do { XcdBarrier xb_; xb_.bar = (unsigned*)(opaque_ptr(p.ws) + WS_BAR); xb_.x = xb_xcc_id(); xb_.st = (volatile LAS unsigned*)&xb_words; xcd_barrier(xb_); } while (0)
  const int bid0 = opaque_bid();
  {
  char* const ws0 = opaque_ptr(p.ws);
  float* mods = (float*)(ws0 + WS_MODS);
  float* ropeT = (float*)(ws0 + WS_ROPE);
  float* cosG = ropeT, *sinG = ropeT + 2048, *cosM = ropeT + 4096, *sinM = ropeT + 5120;

  {
    float* sc = (float*)smem;
    float* red = sc + 9 * 128;
    float* part = (float*)(ws0 + WS_R);
    for (int item = bid0; item < 3072; item += G) {
      const int ks = item & 7, cgp = (item >> 3) % 96, layer = item / 768;
      __syncthreads();
      for (int e = tid; e < 9 * 128; e += 256) {
        const int ci = e >> 7, k = ks * 128 + (e & 127);
        const float v = ci == 0 ? p.in[9][k] : p.in[8][(ci - 1) * 1024 + k];
        sc[e] = v / (1.f + expf(-v));
      }
      __syncthreads();
      const int col = tid & 63, kg = tid >> 6;
      const float* wp = p.in[12] + ((size_t)layer * 1024 + ks * 128 + kg * 32) * 6144 + cgp * 64 + col;
      float acc[9];
#pragma unroll
      for (int ci = 0; ci < 9; ++ci) acc[ci] = 0.f;
#pragma unroll 8
      for (int kk = 0; kk < 32; ++kk) {
        const float wv = wp[(size_t)kk * 6144];
#pragma unroll
        for (int ci = 0; ci < 9; ++ci) acc[ci] += sc[ci * 128 + kg * 32 + kk] * wv;
      }
#pragma unroll
      for (int ci = 0; ci < 9; ++ci) red[(kg * 64 + col) * 9 + ci] = acc[ci];
      __syncthreads();
      if (kg == 0) {
        const int n = cgp * 64 + col;
        const float bias = ks == 0 ? p.in[13][(size_t)layer * 6144 + n] : 0.f;
#pragma unroll
        for (int ci = 0; ci < 9; ++ci) {
          const float s = red[col * 9 + ci] + red[(64 + col) * 9 + ci] + red[(128 + col) * 9 + ci] + red[(192 + col) * 9 + ci] + bias;
          part[(size_t)ks * 221184 + ((size_t)layer * 9 + ci) * 6144 + n] = s;
        }
      }
    }
    if (bid0 == G - 1) {
      for (int e = tid; e < 2048; e += 256) { const int pos = e >> 5, f = e & 31; const float fr = powf(10000.f, -(float)f / 32.f); const float a = (float)pos * fr; cosG[e] = cosf(a); sinG[e] = sinf(a); }
      for (int e = tid; e < 1024; e += 256) { const int pos = e >> 4, f = e & 15; const float fr = powf(10000.f, -(float)f / 16.f); const float a = (float)pos * fr; cosM[e] = cosf(a); sinM[e] = sinf(a); }
    }
  }
  grid.sync();
  {
    const float* part = (const float*)(ws0 + WS_R);
    for (int e = bid0 * 256 + tid; e < 221184; e += G * 256) {
      float sacc = 0.f;
#pragma unroll
      for (int ks = 0; ks < 8; ++ks) sacc += part[(size_t)ks * 221184 + e];
      mods[e] = sacc;
    }
  }
  }
  GSYNC();

#pragma unroll 1
  for (int layer = 0; layer < 4; ++layer) {
    const int kind = layer % 3, j = layer / 3;
    const int bid = opaque_bid();
    char* const ws = opaque_ptr(p.ws);
    float* mods = (float*)(ws + WS_MODS);
    float* ropeT = (float*)(ws + WS_ROPE);
    float* cosG = ropeT, *sinG = ropeT + 2048, *cosM = ropeT + 4096, *sinM = ropeT + 5120;
    u16* hbuf = (u16*)(ws + WS_HBUF);
    u16* obuf = (u16*)(ws + WS_OBUF);
    u16* wmix = (u16*)(ws + WS_WMIX);
    u16* wmlp = (u16*)(ws + WS_WMLP);
    char* R = ws + WS_R;
    const float* lmods = mods + (size_t)layer * 9 * 6144;
    {
      for (int it = bid; it < 5120; it += G) norm_rows(p, layer, layer == 0, it, p.in[10] + layer * 1024, 0, 1);
      float* sT = (float*)smem;
      for (int it = bid; it < 2048; it += G) {
        if (it < 1024) convert_tile(p.in[14] + (size_t)layer * 1024 * 4096, 1024, 4096, wmlp, it, 0, sT);
        else convert_tile(p.in[15] + (size_t)layer * 4096 * 1024, 4096, 1024, wmlp + 4194304, it - 1024, 0, sT);
      }
      if (kind == 0) {
        for (int it = bid; it < 1056 + 256; it += G) {
          if (it < 1056) convert_tile(p.in[16] + (size_t)j * 1024 * 4128, 1024, 4128, wmix + WM_IN, it, 0, sT);
          else convert_tile(p.in[21] + (size_t)j * 1024 * 1024, 1024, 1024, wmix + WM_OUT, it - 1056, 0, sT);
        }
      } else if (kind == 1) {
        for (int it = bid; it < 192 + 144 + 128 + 256; it += G) {
          if (it < 192) convert_tile(p.in[22], 1024, 704, wmix + WM_IN, it, 0, sT);
          else if (it < 336) convert_tile(p.in[25], 384, 1536, wmix + WM_UQ, it - 192, 1, sT);
          else if (it < 464) convert_tile(p.in[26], 256, 2048, wmix + WM_UKV, it - 336, 0, sT);
          else convert_tile(p.in[31], 1024, 1024, wmix + WM_OUT, it - 464, 0, sT);
        }
      } else {
        for (int it = bid; it < 384 + 256; it += G) {
          if (it < 384) convert_tile(p.in[32], 1024, 1536, wmix + WM_IN, it, 0, sT);
          else convert_tile(p.in[35], 1024, 1024, wmix + WM_OUT, it - 384, 0, sT);
        }
        u16* Kg = (u16*)(R + R_KG); u16* Vg = (u16*)(R + R_VTG);
        const int tid = opaque_tid();
        for (int it = bid; it < 512; it += G) {
          const int b = it >> 6, s0 = (it & 63) * 8;
          const int ch = tid;
          float kv[8], vv[8];
#pragma unroll
          for (int e = 0; e < 8; ++e) { kv[e] = p.in[6][((size_t)b * 512 + s0 + e) * 256 + ch]; vv[e] = p.in[7][((size_t)b * 512 + s0 + e) * 256 + ch]; }
#pragma unroll
          for (int e = 0; e < 8; ++e) Kg[(size_t)(NPROMPT + b * 2560 + s0 + e) * 256 + ch] = f2bf(kv[e]);
          u32x4 o; o[0] = pack2(vv[0], vv[1]); o[1] = pack2(vv[2], vv[3]); o[2] = pack2(vv[4], vv[5]); o[3] = pack2(vv[6], vv[7]);
          *(u32x4*)(Vg + (size_t)(NPROMPT + b * 2560) * 256 + (size_t)ch * 2560 + s0) = o;
        }
      }
    }
    GSYNC();

    if (kind == 0) {
      {
        EpiGdnIn epi; epi.proj = (u16*)(R + R_PROJ); epi.gbuf = (float*)(R + R_GBUF);
        for (int it = bid; it < 160 * 33; it += G) { const int mt = it / 33, nt = it % 33; gemm_tile<4>(hbuf, 1024, wmix + WM_IN, 1024, 1024, mt * 128, nt * 128, (u16*)smem, epi); }
      }
      GSYNC();
      gdn_chunk_phase(p, j, smem);
      GSYNC();
      gdn_scan_phase(p, j, smem);
      GSYNC();
      {
        const u16* pr = (const u16*)(R + R_PROJ);
        const float* on = p.in[20] + j * 128;
        const int tid = opaque_tid();
        for (int t = bid; t < NTOK; t += G) {
          const int h = tid >> 5, c = (tid & 31) * 4;
          const u16* row = pr + (size_t)t * 4096;
          const u32x2 f = *(const u32x2*)(row + h * 128 + c), b = *(const u32x2*)(row + 1024 + h * 128 + c), z = *(const u32x2*)(row + 3072 + h * 128 + c);
          float o[4] = {bflo(f[0]) + bflo(b[0]), bfhi(f[0]) + bfhi(b[0]), bflo(f[1]) + bflo(b[1]), bfhi(f[1]) + bfhi(b[1])};
          float zz[4] = {bflo(z[0]), bfhi(z[0]), bflo(z[1]), bfhi(z[1])};
          float ss = o[0] * o[0] + o[1] * o[1] + o[2] * o[2] + o[3] * o[3];
          ss += __shfl_xor(ss, 1); ss += __shfl_xor(ss, 2); ss += __shfl_xor(ss, 4); ss += __shfl_xor(ss, 8); ss += __shfl_xor(ss, 16);
          const float rs = rsqrtf(ss * (1.f / 128.f) + EPS);
          const float4 gn = *(const float4*)(on + c);
          const float gg[4] = {gn.x, gn.y, gn.z, gn.w};
          float y[4];
#pragma unroll
          for (int e = 0; e < 4; ++e) y[e] = o[e] * rs * gg[e] * (zz[e] / (1.f + expf(-zz[e])));
          st4bf(obuf + (size_t)t * 1024 + h * 128 + c, y[0], y[1], y[2], y[3]);
        }
      }
      GSYNC();
    } else if (kind == 1) {
      {
        EpiF32 epi; epi.dst = (float*)(R + R_DPROJ); epi.ld = 768;
        for (int it = bid; it < 160 * 6; it += G) { const int mt = it / 6, nt = it % 6; gemm_tile<4>(hbuf, 1024, wmix + WM_IN, 1024, 1024, mt * 128, nt * 128, (u16*)smem, epi); }
      }
      GSYNC();
      {
        const float* dproj = (const float*)(R + R_DPROJ);
        u16* cq = (u16*)(R + R_CQ); u16* ckv = (u16*)(R + R_CKV); u16* Km = (u16*)(R + R_KM);
        const int tid = opaque_tid(), lane = tid & 63, wid = tid >> 6;
        for (int it = bid; it < 6144; it += G) {
          const int row = it * 4 + wid;
          if (row < NTOK) {
            const int t = row;
            const float* pr = dproj + (size_t)t * 768;
            float v[6]; float ss = 0.f;
#pragma unroll
            for (int e = 0; e < 6; ++e) { v[e] = pr[lane + 64 * e]; ss += v[e] * v[e]; }
            ss = wave_sum(ss);
            float rs = rsqrtf(ss * (1.f / 384.f) + EPS);
#pragma unroll
            for (int e = 0; e < 6; ++e) cq[(size_t)t * 384 + lane + 64 * e] = f2bf(v[e] * rs * p.in[23][lane + 64 * e]);
            const int kvrow = kvrow_of_tok(t);
            float wv[4]; ss = 0.f;
#pragma unroll
            for (int e = 0; e < 4; ++e) { wv[e] = pr[384 + lane + 64 * e]; ss += wv[e] * wv[e]; }
            ss = wave_sum(ss);
            rs = rsqrtf(ss * (1.f / 256.f) + EPS);
#pragma unroll
            for (int e = 0; e < 4; ++e) {
              const float o = wv[e] * rs * p.in[24][lane + 64 * e];
              ckv[(size_t)kvrow * 256 + lane + 64 * e] = f2bf(o);
              if (t < NPROMPT) p.out[O_CKV + (size_t)t * 256 + lane + 64 * e] = o;
            }
            const float x = pr[640 + lane];
            ss = wave_sum(x * x);
            float kr = x * rsqrtf(ss * (1.f / 64.f) + EPS) * p.in[30][lane];
            if (t < NPROMPT) p.out[O_KR + (size_t)t * 64 + lane] = kr;
            else {
              const int s = (t - NPROMPT) & 2047;
              const int pos = lane < 32 ? (s >> 6) : (s & 63);
              const float cs = cosM[pos * 16 + (lane & 15)], sn = sinM[pos * 16 + (lane & 15)];
              const float partner = __shfl_xor(kr, 16);
              kr = ((lane & 16) == 0) ? kr * cs - partner * sn : partner * sn + kr * cs;
            }
            const u16 kb = f2bf(kr);
#pragma unroll
            for (int hh = 0; hh < 8; ++hh) Km[(size_t)kvrow * 1536 + hh * 192 + 128 + lane] = kb;
          } else {
            const int r = row - NTOK; const int b = r >> 9, s = r & 511;
            const int kvrow = NPROMPT + b * 2560 + s;
#pragma unroll
            for (int e = 0; e < 4; ++e) ckv[(size_t)kvrow * 256 + lane + 64 * e] = f2bf(p.in[4][((size_t)b * 512 + s) * 256 + lane + 64 * e]);
            const u16 kb = f2bf(p.in[5][((size_t)b * 512 + s) * 64 + lane]);
#pragma unroll
            for (int hh = 0; hh < 8; ++hh) Km[(size_t)kvrow * 1536 + hh * 192 + 128 + lane] = kb;
          }
        }
      }
      GSYNC();
      {
        EpiMlaUq e1; e1.Q = (u16*)(R + R_Q); e1.gnope = p.in[27]; e1.grope = p.in[28]; e1.cosT = cosM; e1.sinT = sinM;
        for (int it = bid; it < 160 * 12; it += G) { const int mt = it / 12, nt = it % 12; gemm_tile<8>((const u16*)(R + R_CQ), 384, wmix + WM_UQ, 384, 384, mt * 128, nt * 128, (u16*)smem, e1); }
        EpiMlaUkv e2; e2.Kb = (u16*)(R + R_KM); e2.Vt = (u16*)(R + R_VTM); e2.gnope = p.in[29];
        for (int it = bid; it < 192 * 16; it += G) { const int mt = it / 16, nt = it % 16; gemm_tile<8>((const u16*)(R + R_CKV), 256, wmix + WM_UKV, 256, 256, mt * 128, nt * 128, (u16*)smem, e2); }
      }
      GSYNC();
      attn_phase<192, 8>((const u16*)(R + R_Q), (const u16*)(R + R_KM), (const u16*)(R + R_VTM), obuf, smem);
      GSYNC();
    } else {
      {
        EpiGqaIn epi; epi.Q = (u16*)(R + R_Q); epi.Kb = (u16*)(R + R_KG); epi.Vt = (u16*)(R + R_VTG); epi.qg = p.in[33]; epi.kg = p.in[34]; epi.cosT = cosG; epi.sinT = sinG; epi.out = p.out;
        for (int it = bid; it < 160 * 12; it += G) { const int mt = it / 12, nt = it % 12; gemm_tile<8>(hbuf, 1024, wmix + WM_IN, 1024, 1024, mt * 128, nt * 128, (u16*)smem, epi); }
      }
      GSYNC();
      attn_phase<128, 2>((const u16*)(R + R_Q), (const u16*)(R + R_KG), (const u16*)(R + R_VTG), obuf, smem);
      GSYNC();
    }

    for (int it = bid; it < 160 * 8; it += G) {
      const int mt = it >> 3, nt = it & 7; const int m0 = mt * 128;
      EpiResid epi;
      epi.xin = (layer == 0) ? (m0 < NPROMPT ? p.in[0] : p.in[1] - (size_t)NPROMPT * 1024) : p.out;
      epi.xout = p.out; epi.gate = lmods + (size_t)cond_of(m0) * 6144 + 2 * 1024;
      gemm_tile<4>(obuf, 1024, wmix + WM_OUT, 1024, 1024, m0, nt * 128, (u16*)smem, epi);
    }
    GSYNC();
    for (int it = bid; it < 5120; it += G) norm_rows(p, layer, false, it, p.in[11] + layer * 1024, 3, 4);
    GSYNC();
    {
      EpiMlpIn epi; epi.abuf = (u16*)(R + R_ABUF);
      for (int it = bid; it < 160 * 32; it += G) { const int mt = it >> 5, nt = it & 31; gemm_tile<4>(hbuf, 1024, wmlp, 1024, 1024, mt * 128, nt * 128, (u16*)smem, epi); }
    }
    GSYNC();
    for (int it = bid; it < 160 * 8; it += G) {
      const int mt = it >> 3, nt = it & 7; const int m0 = mt * 128;
      EpiResid epi; epi.xin = p.out; epi.xout = p.out; epi.gate = lmods + (size_t)cond_of(m0) * 6144 + 5 * 1024;
      gemm_tile<4>((const u16*)(R + R_ABUF), 4096, wmlp + 4194304, 4096, 4096, m0, nt * 128, (u16*)smem, epi);
    }
    GSYNC();
  }
}

extern "C" void kernel_launch(void* const* d_in, const int* in_sizes, int n_in, void* d_out, int out_size, void* d_ws, size_t ws_size, hipStream_t stream) {
  static int grid_blocks = 0;
  if (!grid_blocks) {
    int dev = 0, cus = 0, per_cu = 0;
    hipGetDevice(&dev);
    hipDeviceGetAttribute(&cus, hipDeviceAttributeMultiprocessorCount, dev);
    hipOccupancyMaxActiveBlocksPerMultiprocessor(&per_cu, fwd_megakernel, 256, 0);
    if (per_cu < 1) per_cu = 1;
    if (per_cu > 2) per_cu = 2;
    grid_blocks = cus * per_cu;
  }
  P p{};
  for (int i = 0; i < 36; ++i) p.in[i] = (const float*)d_in[i];
  p.out = (float*)d_out;
  p.ws = (char*)d_ws;
  (void)hipMemsetAsync((char*)d_ws + WS_BAR, 0, XCD_BAR_WORDS * 4, stream);
  void* args[] = {&p};
  hipError_t e = hipLaunchCooperativeKernel((void*)fwd_megakernel, dim3(grid_blocks), dim3(256), args, 0, stream);
  if (e != hipSuccess) fprintf(stderr, "cooperative launch failed: %s (grid %d)\n", hipGetErrorString(e), grid_blocks);
}
```

```cpp
#include <hip/hip_runtime.h>
#include <hip/hip_cooperative_groups.h>
#include <cstdio>
namespace cg = cooperative_groups;

typedef unsigned short u16;
typedef __attribute__((ext_vector_type(8))) short bf16x8;
typedef __attribute__((ext_vector_type(4))) short bf16x4;
typedef __attribute__((ext_vector_type(4))) float f32x4;
typedef __attribute__((ext_vector_type(4))) unsigned u32x4;
typedef __attribute__((ext_vector_type(2))) unsigned u32x2;

#define DI __device__ __forceinline__

constexpr int NTOK = 20480;
constexpr int NPROMPT = 4096;
constexpr float EPS = 1e-6f;

constexpr size_t WS_MODS = 0;
constexpr size_t MODS_BYTES = 4ull * 9 * 6144 * 4;
constexpr size_t WS_BAR = 917504;
constexpr size_t WS_ROPE = 1048576;
constexpr size_t WS_WMIX = 1114112;
constexpr size_t WS_WMLP = 14090240;
constexpr size_t WS_HBUF = 30867456;
constexpr size_t WS_OBUF = 72810496;
constexpr size_t WS_R    = 114753536;
constexpr size_t R_ABUF = 0;
constexpr size_t R_PROJ = 0;
constexpr size_t R_VBUF = 167772160;
constexpr size_t R_TBUF = 209715200;
constexpr size_t R_GBUF = 251658240;
constexpr size_t R_GCB  = 254279680;
constexpr size_t R_BETA = 255590400;
constexpr size_t R_DPROJ = 0;
constexpr size_t R_Q    = 0;
constexpr size_t R_CQ   = 62914560;
constexpr size_t R_CKV  = 78643200;
constexpr size_t R_KM   = 91226112;
constexpr size_t R_VTM  = 166723584;
constexpr size_t R_KG   = 41943040;
constexpr size_t R_VTG  = 54525952;
constexpr size_t WM_IN = 0;
constexpr size_t WM_OUT = 4325376;
constexpr size_t WM_UQ = 5373952;
constexpr size_t WM_UKV = 5963776;
constexpr size_t O_SF = 20971520, O_SB = 25165824, O_CKV = 29360128, O_KR = 30408704, O_GK = 30670848, O_GV = 31719424;

struct P {
  const float* in[36];
  float* out;
  char* ws;
};

typedef __attribute__((ext_vector_type(2))) float f32x2_t;
typedef __attribute__((ext_vector_type(2))) __bf16 bf16x2_t;
DI u16 f2bf(float x) { return __builtin_bit_cast(u16, (__bf16)x); }
DI float bf2f(u16 h) { return __uint_as_float(((unsigned)h) << 16); }
DI unsigned pack2(float a, float b) { f32x2_t v; v[0] = a; v[1] = b; return __builtin_bit_cast(unsigned, __builtin_convertvector(v, bf16x2_t)); }
DI float bflo(unsigned w) { return __uint_as_float(w << 16); }
DI float bfhi(unsigned w) { return __uint_as_float(w & 0xffff0000u); }
DI f32x4 mma(bf16x8 a, bf16x8 b, f32x4 c) { return __builtin_amdgcn_mfma_f32_16x16x32_bf16(a, b, c, 0, 0, 0); }
DI bf16x8 pack8(f32x4 a, f32x4 b) {
  u32x4 p; p[0] = pack2(a[0], a[1]); p[1] = pack2(a[2], a[3]); p[2] = pack2(b[0], b[1]); p[3] = pack2(b[2], b[3]);
  return __builtin_bit_cast(bf16x8, p);
}
DI bf16x8 ld8(const u16* p) { return *(const bf16x8*)p; }
DI bf16x8 ld44(const u16* p0, const u16* p1) {
  u32x2 a = *(const u32x2*)p0; u32x2 b = *(const u32x2*)p1;
  u32x4 r; r[0] = a[0]; r[1] = a[1]; r[2] = b[0]; r[3] = b[1];
  return __builtin_bit_cast(bf16x8, r);
}
DI void st4bf(u16* p, float a, float b, float c, float d) { u32x2 v; v[0] = pack2(a, b); v[1] = pack2(c, d); *(u32x2*)p = v; }
DI float wave_sum(float v) {
  v += __shfl_xor(v, 1); v += __shfl_xor(v, 2); v += __shfl_xor(v, 4); v += __shfl_xor(v, 8); v += __shfl_xor(v, 16); v += __shfl_xor(v, 32);
  return v;
}
DI float sum_g(float v) { v += __shfl_xor(v, 16); v += __shfl_xor(v, 32); return v; }
DI int opaque_tid() { int t = threadIdx.x; asm volatile("" : "+v"(t)); return t; }
DI int opaque_bid() { int t = __builtin_amdgcn_readfirstlane((int)blockIdx.x); asm volatile("" : "+s"(t)); return t; }
DI char* opaque_ptr(char* q) {
  unsigned lo = __builtin_amdgcn_readfirstlane((unsigned)(size_t)q), hi = __builtin_amdgcn_readfirstlane((unsigned)((size_t)q >> 32));
  asm volatile("" : "+s"(lo), "+s"(hi));
  return (char*)(((size_t)hi << 32) | (size_t)lo);
}
DI int cond_of(int t) { return t < NPROMPT ? 0 : 1 + ((t - NPROMPT) >> 11); }
DI int kvrow_of_tok(int t) { return t < NPROMPT ? t : NPROMPT + ((t - NPROMPT) >> 11) * 2560 + 512 + ((t - NPROMPT) & 2047); }

template <int NI, class Epi>
DI void gemm_tile(const u16* __restrict__ A, int lda, const u16* __restrict__ Bt, int ldb, int K, int m0, int n0, u16* smem, Epi& epi) {
  constexpr int MI = 16 / NI;
  constexpr int WN = 8 / NI;
  const int tid = opaque_tid(), lane = tid & 63, wid = tid >> 6, l15 = lane & 15, g = lane >> 4;
  const int wm = wid / WN, wn = wid % WN;
  u16* sA = smem; u16* sB = smem + 128 * 72;
  f32x4 acc[MI][NI];
#pragma unroll
  for (int mi = 0; mi < MI; ++mi)
#pragma unroll
    for (int ni = 0; ni < NI; ++ni) { acc[mi][ni][0] = 0.f; acc[mi][ni][1] = 0.f; acc[mi][ni][2] = 0.f; acc[mi][ni][3] = 0.f; }
  const int lrow = tid >> 3, lkc = (tid & 7) * 8;
  const u16* pa = A + (size_t)(m0 + lrow) * lda + lkc;
  const u16* pb = Bt + (size_t)(n0 + lrow) * ldb + lkc;
  u32x4 ra[2][4], rb[2][4];
  const int nk = K >> 6;
#pragma unroll
  for (int i = 0; i < 4; ++i) { ra[0][i] = *(const u32x4*)(pa + (size_t)i * 32 * lda); rb[0][i] = *(const u32x4*)(pb + (size_t)i * 32 * ldb); }
#pragma unroll
  for (int i = 0; i < 4; ++i) { ra[1][i] = *(const u32x4*)(pa + (size_t)i * 32 * lda + 64); rb[1][i] = *(const u32x4*)(pb + (size_t)i * 32 * ldb + 64); }
  for (int kt = 0; kt < nk; kt += 2) {
#pragma unroll
    for (int half = 0; half < 2; ++half) {
      __syncthreads();
#pragma unroll
      for (int i = 0; i < 4; ++i) { *(u32x4*)(sA + (lrow + 32 * i) * 72 + lkc) = ra[half][i]; *(u32x4*)(sB + (lrow + 32 * i) * 72 + lkc) = rb[half][i]; }
      __syncthreads();
      if (kt + half + 2 < nk) {
        const int ko = (kt + half + 2) * 64;
#pragma unroll
        for (int i = 0; i < 4; ++i) { ra[half][i] = *(const u32x4*)(pa + (size_t)i * 32 * lda + ko); rb[half][i] = *(const u32x4*)(pb + (size_t)i * 32 * ldb + ko); }
      }
#pragma unroll
      for (int ks = 0; ks < 2; ++ks) {
        bf16x8 af[MI], bfv[NI];
#pragma unroll
        for (int mi = 0; mi < MI; ++mi) af[mi] = ld8(sA + (wm * MI * 16 + mi * 16 + l15) * 72 + ks * 32 + g * 8);
#pragma unroll
        for (int ni = 0; ni < NI; ++ni) bfv[ni] = ld8(sB + (wn * NI * 16 + ni * 16 + l15) * 72 + ks * 32 + g * 8);
#pragma unroll
        for (int mi = 0; mi < MI; ++mi)
#pragma unroll
          for (int ni = 0; ni < NI; ++ni) acc[mi][ni] = mma(bfv[ni], af[mi], acc[mi][ni]);
      }
    }
  }
  epi.template run<MI, NI>(acc, m0 + wm * MI * 16, n0 + wn * NI * 16, l15, g);
}

struct EpiResid {
  const float* xin; float* xout; const float* gate;
  template <int MI, int NI> DI void run(f32x4 (&acc)[MI][NI], int mr, int nc, int l15, int g) {
#pragma unroll
    for (int mi = 0; mi < MI; ++mi)
#pragma unroll
      for (int ni = 0; ni < NI; ++ni) {
        const int m = mr + mi * 16 + l15, n = nc + ni * 16 + g * 4;
        const float4 xi = *(const float4*)(xin + (size_t)m * 1024 + n);
        const float4 gt = *(const float4*)(gate + n);
        float4 o; o.x = xi.x + gt.x * acc[mi][ni][0]; o.y = xi.y + gt.y * acc[mi][ni][1]; o.z = xi.z + gt.z * acc[mi][ni][2]; o.w = xi.w + gt.w * acc[mi][ni][3];
        *(float4*)(xout + (size_t)m * 1024 + n) = o;
      }
  }
};
struct EpiGdnIn {
  u16* proj; float* gbuf;
  template <int MI, int NI> DI void run(f32x4 (&acc)[MI][NI], int mr, int nc, int l15, int g) {
#pragma unroll
    for (int mi = 0; mi < MI; ++mi)
#pragma unroll
      for (int ni = 0; ni < NI; ++ni) {
        const int m = mr + mi * 16 + l15, n = nc + ni * 16 + g * 4;
        if (n < 4096) st4bf(proj + (size_t)m * 4096 + n, acc[mi][ni][0], acc[mi][ni][1], acc[mi][ni][2], acc[mi][ni][3]);
        else if (n < 4128) { float4 o; o.x = acc[mi][ni][0]; o.y = acc[mi][ni][1]; o.z = acc[mi][ni][2]; o.w = acc[mi][ni][3]; *(float4*)(gbuf + (size_t)m * 32 + (n - 4096)) = o; }
      }
  }
};
struct EpiMlpIn {
  u16* abuf;
  template <int MI, int NI> DI void run(f32x4 (&acc)[MI][NI], int mr, int nc, int l15, int g) {
#pragma unroll
    for (int mi = 0; mi < MI; ++mi)
#pragma unroll
      for (int ni = 0; ni < NI; ++ni) {
        const int m = mr + mi * 16 + l15, n = nc + ni * 16 + g * 4;
        float a = fmaxf(acc[mi][ni][0], 0.f), b = fmaxf(acc[mi][ni][1], 0.f), c = fmaxf(acc[mi][ni][2], 0.f), d = fmaxf(acc[mi][ni][3], 0.f);
        st4bf(abuf + (size_t)m * 4096 + n, a * a, b * b, c * c, d * d);
      }
  }
};
struct EpiF32 {
  float* dst; int ld;
  template <int MI, int NI> DI void run(f32x4 (&acc)[MI][NI], int mr, int nc, int l15, int g) {
#pragma unroll
    for (int mi = 0; mi < MI; ++mi)
#pragma unroll
      for (int ni = 0; ni < NI; ++ni) {
        const int m = mr + mi * 16 + l15, n = nc + ni * 16 + g * 4;
        float4 o; o.x = acc[mi][ni][0]; o.y = acc[mi][ni][1]; o.z = acc[mi][ni][2]; o.w = acc[mi][ni][3];
        *(float4*)(dst + (size_t)m * ld + n) = o;
      }
  }
};

DI void rope128(f32x4 (&v)[8], int rowp, int colp, int g, const float* cosT, const float* sinT) {
#pragma unroll
  for (int hf = 0; hf < 2; ++hf) {
    const int pos = hf ? colp : rowp;
#pragma unroll
    for (int a = 0; a < 2; ++a) {
      const int n1 = hf * 4 + a, n2 = n1 + 2;
      const float4 cs = *(const float4*)(cosT + pos * 32 + a * 16 + g * 4);
      const float4 sn = *(const float4*)(sinT + pos * 32 + a * 16 + g * 4);
      const float c4[4] = {cs.x, cs.y, cs.z, cs.w}, s4[4] = {sn.x, sn.y, sn.z, sn.w};
#pragma unroll
      for (int j = 0; j < 4; ++j) { const float x1 = v[n1][j], x2 = v[n2][j]; v[n1][j] = x1 * c4[j] - x2 * s4[j]; v[n2][j] = x1 * s4[j] + x2 * c4[j]; }
    }
  }
}
DI void rope64(f32x4* v, int rowp, int colp, int g, const float* cosT, const float* sinT) {
#pragma unroll
  for (int hf = 0; hf < 2; ++hf) {
    const int pos = hf ? colp : rowp;
    const int n1 = hf * 2, n2 = n1 + 1;
    const float4 cs = *(const float4*)(cosT + pos * 16 + g * 4);
    const float4 sn = *(const float4*)(sinT + pos * 16 + g * 4);
    const float c4[4] = {cs.x, cs.y, cs.z, cs.w}, s4[4] = {sn.x, sn.y, sn.z, sn.w};
#pragma unroll
    for (int j = 0; j < 4; ++j) { const float x1 = v[n1][j], x2 = v[n2][j]; v[n1][j] = x1 * c4[j] - x2 * s4[j]; v[n2][j] = x1 * s4[j] + x2 * c4[j]; }
  }
}

struct EpiGqaIn {
  u16* Q; u16* Kb; u16* Vt; const float* qg; const float* kg; const float* cosT; const float* sinT; float* out;
  template <int MI, int NI> DI void run(f32x4 (&acc)[MI][NI], int mr, int nc, int l15, int g) {
    const int nt = nc >> 7;
#pragma unroll
    for (int mi = 0; mi < MI; ++mi) {
      const int m = mr + mi * 16 + l15;
      const bool prompt = m < NPROMPT;
      const int s = prompt ? (m & 255) : ((m - NPROMPT) & 2047);
      const int rowp = s >> 6, colp = s & 63;
      const int kvrow = kvrow_of_tok(m);
      if (nt < 10) {
        float ss = 0.f;
#pragma unroll
        for (int ni = 0; ni < NI; ++ni)
#pragma unroll
          for (int j = 0; j < 4; ++j) ss += acc[mi][ni][j] * acc[mi][ni][j];
        ss = sum_g(ss);
        const float rs = rsqrtf(ss * (1.f / 128.f) + EPS);
        const float* gn = nt < 8 ? qg : kg;
#pragma unroll
        for (int ni = 0; ni < NI; ++ni) {
          const float4 gv = *(const float4*)(gn + ni * 16 + g * 4);
          acc[mi][ni][0] *= rs * gv.x; acc[mi][ni][1] *= rs * gv.y; acc[mi][ni][2] *= rs * gv.z; acc[mi][ni][3] *= rs * gv.w;
        }
        if (nt >= 8 && prompt) {
#pragma unroll
          for (int ni = 0; ni < NI; ++ni) { float4 o; o.x = acc[mi][ni][0]; o.y = acc[mi][ni][1]; o.z = acc[mi][ni][2]; o.w = acc[mi][ni][3]; *(float4*)(out + O_GK + (size_t)m * 256 + (nt - 8) * 128 + ni * 16 + g * 4) = o; }
        }
        if (!prompt) rope128(acc[mi], rowp, colp, g, cosT, sinT);
        u16* dst = nt < 8 ? Q + (size_t)m * 1024 + nt * 128 : Kb + (size_t)kvrow * 256 + (nt - 8) * 128;
#pragma unroll
        for (int ni = 0; ni < NI; ++ni) st4bf(dst + ni * 16 + g * 4, acc[mi][ni][0], acc[mi][ni][1], acc[mi][ni][2], acc[mi][ni][3]);
      } else {
        const int kvh = nt - 10;
        if (prompt) {
#pragma unroll
          for (int ni = 0; ni < NI; ++ni) { float4 o; o.x = acc[mi][ni][0]; o.y = acc[mi][ni][1]; o.z = acc[mi][ni][2]; o.w = acc[mi][ni][3]; *(float4*)(out + O_GV + (size_t)m * 256 + kvh * 128 + ni * 16 + g * 4) = o; }
        }
        size_t base; int kvlen, pos;
        if (prompt) { base = (size_t)(m >> 8) * 256 * 256; kvlen = 256; pos = m & 255; }
        else { const int b = (m - NPROMPT) >> 11; base = (size_t)(NPROMPT + b * 2560) * 256; kvlen = 2560; pos = 512 + s; }
#pragma unroll
        for (int ni = 0; ni < NI; ++ni)
#pragma unroll
          for (int j = 0; j < 4; ++j) Vt[base + (size_t)(kvh * 128 + ni * 16 + g * 4 + j) * kvlen + pos] = f2bf(acc[mi][ni][j]);
      }
    }
  }
};
struct EpiMlaUq {
  u16* Q; const float* gnope; const float* grope; const float* cosT; const float* sinT;
  template <int MI, int NI> DI void run(f32x4 (&acc)[MI][NI], int mr, int nc, int l15, int g) {
    const int nt = nc >> 7;
#pragma unroll
    for (int mi = 0; mi < MI; ++mi) {
      const int m = mr + mi * 16 + l15;
      const bool prompt = m < NPROMPT;
      const int s = prompt ? (m & 255) : ((m - NPROMPT) & 2047);
      const int rowp = s >> 6, colp = s & 63;
      if (nt < 8) {
        float ss = 0.f;
#pragma unroll
        for (int ni = 0; ni < NI; ++ni)
#pragma unroll
          for (int j = 0; j < 4; ++j) ss += acc[mi][ni][j] * acc[mi][ni][j];
        ss = sum_g(ss);
        const float rs = rsqrtf(ss * (1.f / 128.f) + EPS);
#pragma unroll
        for (int ni = 0; ni < NI; ++ni) {
          const float4 gv = *(const float4*)(gnope + ni * 16 + g * 4);
          st4bf(Q + (size_t)m * 1536 + nt * 192 + ni * 16 + g * 4, acc[mi][ni][0] * rs * gv.x, acc[mi][ni][1] * rs * gv.y, acc[mi][ni][2] * rs * gv.z, acc[mi][ni][3] * rs * gv.w);
        }
      } else {
#pragma unroll
        for (int hh = 0; hh < 2; ++hh) {
          const int h = (nt - 8) * 2 + hh;
          float ss = 0.f;
#pragma unroll
          for (int ni = 0; ni < 4; ++ni)
#pragma unroll
            for (int j = 0; j < 4; ++j) ss += acc[mi][hh * 4 + ni][j] * acc[mi][hh * 4 + ni][j];
          ss = sum_g(ss);
          const float rs = rsqrtf(ss * (1.f / 64.f) + EPS);
#pragma unroll
          for (int ni = 0; ni < 4; ++ni) {
            const float4 gv = *(const float4*)(grope + ni * 16 + g * 4);
            acc[mi][hh * 4 + ni][0] *= rs * gv.x; acc[mi][hh * 4 + ni][1] *= rs * gv.y; acc[mi][hh * 4 + ni][2] *= rs * gv.z; acc[mi][hh * 4 + ni][3] *= rs * gv.w;
          }
          if (!prompt) rope64(&acc[mi][hh * 4], rowp, colp, g, cosT, sinT);
#pragma unroll
          for (int ni = 0; ni < 4; ++ni)
            st4bf(Q + (size_t)m * 1536 + h * 192 + 128 + ni * 16 + g * 4, acc[mi][hh * 4 + ni][0], acc[mi][hh * 4 + ni][1], acc[mi][hh * 4 + ni][2], acc[mi][hh * 4 + ni][3]);
        }
      }
    }
  }
};
struct EpiMlaUkv {
  u16* Kb; u16* Vt; const float* gnope;
  template <int MI, int NI> DI void run(f32x4 (&acc)[MI][NI], int mr, int nc, int l15, int g) {
    const int nt = nc >> 7, h = nt >> 1;
#pragma unroll
    for (int mi = 0; mi < MI; ++mi) {
      const int m = mr + mi * 16 + l15;
      if ((nt & 1) == 0) {
        float ss = 0.f;
#pragma unroll
        for (int ni = 0; ni < NI; ++ni)
#pragma unroll
          for (int j = 0; j < 4; ++j) ss += acc[mi][ni][j] * acc[mi][ni][j];
        ss = sum_g(ss);
        const float rs = rsqrtf(ss * (1.f / 128.f) + EPS);
#pragma unroll
        for (int ni = 0; ni < NI; ++ni) {
          const float4 gv = *(const float4*)(gnope + ni * 16 + g * 4);
          st4bf(Kb + (size_t)m * 1536 + h * 192 + ni * 16 + g * 4, acc[mi][ni][0] * rs * gv.x, acc[mi][ni][1] * rs * gv.y, acc[mi][ni][2] * rs * gv.z, acc[mi][ni][3] * rs * gv.w);
        }
      } else {
        size_t base; int kvlen, pos;
        if (m < NPROMPT) { base = (size_t)(m >> 8) * 256 * 1024; kvlen = 256; pos = m & 255; }
        else { const int r = m - NPROMPT; const int b = r / 2560; base = (size_t)(NPROMPT + b * 2560) * 1024; kvlen = 2560; pos = r - b * 2560; }
#pragma unroll
        for (int ni = 0; ni < NI; ++ni)
#pragma unroll
          for (int j = 0; j < 4; ++j) Vt[base + (size_t)(h * 128 + ni * 16 + g * 4 + j) * kvlen + pos] = f2bf(acc[mi][ni][j]);
      }
    }
  }
};

DI void convert_tile(const float* __restrict__ W, int K, int N, u16* __restrict__ Bt, int tile, int perm, float* sT) {
  const int nkt = K >> 6;
  const int kt = tile % nkt, nt = tile / nkt;
  const int k0 = kt * 64, n0 = nt * 64;
  const int tid = opaque_tid();
  __syncthreads();
  {
    const int n = tid & 63, kq = tid >> 6;
    int nd = n0 + n, ns = nd;
    if (perm == 1) { if (nd < 1024) ns = (nd >> 7) * 192 + (nd & 127); else { const int x = nd - 1024; ns = (x >> 6) * 192 + 128 + (x & 63); } }
    const bool ok = nd < N;
#pragma unroll
    for (int r = 0; r < 16; ++r) { const int k = r * 4 + kq; sT[k * 65 + n] = ok ? W[(size_t)(k0 + k) * N + ns] : 0.f; }
  }
  __syncthreads();
  {
    const int n = tid >> 2, kq = (tid & 3) * 16;
    u32x4 a, b;
#pragma unroll
    for (int e = 0; e < 4; ++e) { a[e] = pack2(sT[(kq + 2 * e) * 65 + n], sT[(kq + 2 * e + 1) * 65 + n]); b[e] = pack2(sT[(kq + 8 + 2 * e) * 65 + n], sT[(kq + 9 + 2 * e) * 65 + n]); }
    u16* dst = Bt + (size_t)(n0 + n) * K + k0 + kq;
    *(u32x4*)dst = a; *(u32x4*)(dst + 8) = b;
  }
}

DI void norm_rows(const P& p, int layer, bool from_input, int item, const float* gnorm, int shift_idx, int scale_idx) {
  const int tidn = opaque_tid();
  char* const ws = opaque_ptr(p.ws);
  const int lane = tidn & 63, wid = tidn >> 6;
  const int t = item * 4 + wid;
  const float* x = from_input ? (t < NPROMPT ? p.in[0] + (size_t)t * 1024 : p.in[1] + (size_t)(t - NPROMPT) * 1024) : p.out + (size_t)t * 1024;
  const float* mods = (const float*)(ws + WS_MODS) + ((size_t)layer * 9 + cond_of(t)) * 6144;
  u16* h = (u16*)(ws + WS_HBUF) + (size_t)t * 1024;
  float4 v[4]; float ss = 0.f;
#pragma unroll
  for (int e = 0; e < 4; ++e) { v[e] = *(const float4*)(x + e * 256 + lane * 4); ss += v[e].x * v[e].x + v[e].y * v[e].y + v[e].z * v[e].z + v[e].w * v[e].w; }
  ss = wave_sum(ss);
  const float rs = rsqrtf(ss * (1.f / 1024.f) + EPS);
#pragma unroll
  for (int e = 0; e < 4; ++e) {
    const int c = e * 256 + lane * 4;
    const float4 gv = *(const float4*)(gnorm + c);
    const float4 sc = *(const float4*)(mods + scale_idx * 1024 + c);
    const float4 sh = *(const float4*)(mods + shift_idx * 1024 + c);
    st4bf(h + c, v[e].x * rs * gv.x * (1.f + sc.x) + sh.x, v[e].y * rs * gv.y * (1.f + sc.y) + sh.y, v[e].z * rs * gv.z * (1.f + sc.z) + sh.z, v[e].w * rs * gv.w * (1.f + sc.w) + sh.w);
  }
}

template <int DK, int HK>
DI void attn_phase(const u16* __restrict__ Q, const u16* __restrict__ Kb, const u16* __restrict__ Vt, u16* __restrict__ obuf, char* smem_raw) {
  const int bid = opaque_bid();
  constexpr int KS = DK / 32, KSTR = DK + 8, QSTR = 8 * DK, KROW = HK * DK, GRP = 8 / HK;
  constexpr int CPR = DK / 8;
  constexpr int KCH = 64 * CPR / 256;
  u16* sK = (u16*)smem_raw;
  u16* sV = sK + 64 * KSTR;
  const int tid = opaque_tid(), lane = tid & 63, wid = tid >> 6, l15 = lane & 15, g = lane >> 4;
  const float sc = rsqrtf((float)DK) * 1.4426950408889634f;
  for (int item = bid; item < 1280; item += gridDim.x) {
    int qb, h, kvlen, tokbase, kvbase;
    if (item < 1024) { const int b = item >> 7, rem = item & 127; h = rem & 7; qb = rem >> 3; kvlen = 2560; tokbase = NPROMPT + b * 2048; kvbase = NPROMPT + b * 2560; }
    else { const int it2 = item - 1024; const int b = it2 >> 4, rem = it2 & 15; h = rem & 7; qb = rem >> 3; kvlen = 256; tokbase = b * 256; kvbase = b * 256; }
    const int kvh = h / GRP;
    const u16* Kp = Kb + (size_t)kvbase * KROW + kvh * DK;
    const u16* Vp = Vt + (size_t)kvbase * (HK * 128) + (size_t)kvh * 128 * kvlen;
    const int qrow0 = tokbase + qb * 128 + wid * 32;
    bf16x8 qf[2][KS];
#pragma unroll
    for (int qi = 0; qi < 2; ++qi)
#pragma unroll
      for (int ks = 0; ks < KS; ++ks) qf[qi][ks] = ld8(Q + (size_t)(qrow0 + qi * 16 + l15) * QSTR + h * DK + ks * 32 + g * 8);
    f32x4 ot[2][8];
#pragma unroll
    for (int qi = 0; qi < 2; ++qi)
#pragma unroll
      for (int dj = 0; dj < 8; ++dj) { ot[qi][dj][0] = 0.f; ot[qi][dj][1] = 0.f; ot[qi][dj][2] = 0.f; ot[qi][dj][3] = 0.f; }
    float mrun[2] = {-1e30f, -1e30f}, lrun[2] = {0.f, 0.f};
    const int ntiles = kvlen >> 6;
    const unsigned toffK = (unsigned)((tid >> 3) * KROW + (tid & 7) * 8), toffV = (unsigned)((tid >> 3) * kvlen + (tid & 7) * 8);
    const int ldsoffK = (tid >> 3) * KSTR + (tid & 7) * 8, ldsoffV = (tid >> 3) * 72 + (tid & 7) * 8;
    for (int kt = 0; kt < ntiles; ++kt) {
      const u16* Kt = Kp + (size_t)kt * 64 * KROW;
      const u16* Vtp = Vp + kt * 64;
      __syncthreads();
#pragma unroll
      for (int i = 0; i < KCH; ++i) {
        const int rh = i & 1, cgp = i >> 1;
        *(u32x4*)(sK + ldsoffK + rh * 32 * KSTR + cgp * 64) = *(const u32x4*)(Kt + (size_t)(rh * 32 * KROW + cgp * 64) + toffK);
      }
      __builtin_amdgcn_sched_barrier(0);
#pragma unroll
      for (int i = 0; i < 4; ++i) *(u32x4*)(sV + ldsoffV + i * 32 * 72) = *(const u32x4*)(Vtp + (size_t)i * 32 * kvlen + toffV);
      __syncthreads();
#pragma unroll
      for (int qi = 0; qi < 2; ++qi) {
        __builtin_amdgcn_sched_barrier(0);
        f32x4 st[4];
#pragma unroll
        for (int kj = 0; kj < 4; ++kj) { st[kj][0] = 0.f; st[kj][1] = 0.f; st[kj][2] = 0.f; st[kj][3] = 0.f; }
#pragma unroll
        for (int ks = 0; ks < KS; ++ks) {
#pragma unroll
          for (int kj = 0; kj < 4; ++kj) st[kj] = mma(ld8(sK + (kj * 16 + l15) * KSTR + ks * 32 + g * 8), qf[qi][ks], st[kj]);
          __builtin_amdgcn_sched_barrier(0);
        }
        float mx = -1e30f;
#pragma unroll
        for (int kj = 0; kj < 4; ++kj)
#pragma unroll
          for (int r = 0; r < 4; ++r) mx = fmaxf(mx, st[kj][r]);
        mx = fmaxf(mx, __shfl_xor(mx, 16)); mx = fmaxf(mx, __shfl_xor(mx, 32));
        const float mnew = fmaxf(mrun[qi], mx);
        const float alpha = __builtin_amdgcn_exp2f((mrun[qi] - mnew) * sc);
        mrun[qi] = mnew;
        float ps = 0.f;
#pragma unroll
        for (int kj = 0; kj < 4; ++kj)
#pragma unroll
          for (int r = 0; r < 4; ++r) { const float pv = __builtin_amdgcn_exp2f((st[kj][r] - mnew) * sc); st[kj][r] = pv; ps += pv; }
        lrun[qi] = lrun[qi] * alpha + ps;
#pragma unroll
        for (int dj = 0; dj < 8; ++dj) { ot[qi][dj][0] *= alpha; ot[qi][dj][1] *= alpha; ot[qi][dj][2] *= alpha; ot[qi][dj][3] *= alpha; }
        bf16x8 pf[2];
        pf[0] = pack8(st[0], st[1]);
        pf[1] = pack8(st[2], st[3]);
        __builtin_amdgcn_sched_barrier(0);
#pragma unroll
        for (int kk = 0; kk < 2; ++kk)
#pragma unroll
          for (int dj = 0; dj < 8; ++dj) {
            const u16* vp = sV + (dj * 16 + l15) * 72 + kk * 32 + g * 4;
            ot[qi][dj] = mma(ld44(vp, vp + 16), pf[kk], ot[qi][dj]);
            if ((dj & 3) == 3) __builtin_amdgcn_sched_barrier(0);
          }
      }
    }
#pragma unroll
    for (int qi = 0; qi < 2; ++qi) {
      const float inv = 1.f / sum_g(lrun[qi]);
      u16* dst = obuf + (size_t)(qrow0 + qi * 16 + l15) * 1024 + h * 128 + g * 4;
#pragma unroll
      for (int dj = 0; dj < 8; ++dj) st4bf(dst + dj * 16, ot[qi][dj][0] * inv, ot[qi][dj][1] * inv, ot[qi][dj][2] * inv, ot[qi][dj][3] * inv);
    }
  }
}

DI void gdn_chunk_phase(const P& p, int j, char* smem_raw) {
  const int bid = opaque_bid();
  char* const ws = opaque_ptr(p.ws);
  u16* sK = (u16*)smem_raw;
  float* sA = (float*)(smem_raw + 17408);
  float* sG = (float*)(smem_raw + 17408 + 32768);
  float* sBt = sG + 128;
  const int tid = opaque_tid(), lane = tid & 63, wid = tid >> 6, l15 = lane & 15, g = lane >> 4;
  const u16* proj = (const u16*)(ws + WS_R + R_PROJ);
  u16* qn = (u16*)(ws + WS_HBUF); u16* kn = (u16*)(ws + WS_OBUF); u16* vb = (u16*)(ws + WS_R + R_VBUF);
  u16* Tbuf = (u16*)(ws + WS_R + R_TBUF);
  const float* gbuf = (const float*)(ws + WS_R + R_GBUF);
  float* gcb = (float*)(ws + WS_R + R_GCB); float* betab = (float*)(ws + WS_R + R_BETA);
  const float* conv = p.in[17] + (size_t)j * 3 * 3072;
  const float* a_log = p.in[18] + j * 16; const float* dt_bias = p.in[19] + j * 16;
  for (int unit = bid; unit < 2560; unit += gridDim.x) {
    const int cgi = unit >> 3, h = unit & 7;
    int c, nch; if (cgi < 64) { c = cgi & 3; nch = 4; } else { c = (cgi - 64) & 31; nch = 32; }
    const int t0 = cgi * 64;
    const bool has_prev = c > 0, has_next = c < nch - 1;
    __syncthreads();
    {
      const int r = tid >> 4, cc = (tid & 15) * 8;
#pragma unroll
      for (int part = 0; part < 3; ++part) {
        const int ch = part * 1024 + h * 128 + cc;
        float w0[8], w1[8], w2[8];
#pragma unroll
        for (int e = 0; e < 8; ++e) { w0[e] = conv[ch + e]; w1[e] = conv[3072 + ch + e]; w2[e] = conv[6144 + ch + e]; }
        u16* dstb = part == 0 ? qn : (part == 1 ? kn : vb);
        for (int it = 0; it < 4; ++it) {
          const int i = it * 16 + r, t = t0 + i;
          const u16* src = proj + (size_t)t * 4096 + ch;
          const u32x4 xc = *(const u32x4*)src;
          u32x4 xp = {0u, 0u, 0u, 0u}, xn = {0u, 0u, 0u, 0u};
          if (i > 0 || has_prev) xp = *(const u32x4*)(src - 4096);
          if (i < 63 || has_next) xn = *(const u32x4*)(src + 4096);
          float y[8];
#pragma unroll
          for (int e = 0; e < 4; ++e) {
            float a = w0[2 * e] * bflo(xp[e]) + w1[2 * e] * bflo(xc[e]) + w2[2 * e] * bflo(xn[e]);
            float b = w0[2 * e + 1] * bfhi(xp[e]) + w1[2 * e + 1] * bfhi(xc[e]) + w2[2 * e + 1] * bfhi(xn[e]);
            y[2 * e] = a / (1.f + __expf(-a)); y[2 * e + 1] = b / (1.f + __expf(-b));
          }
          if (part < 2) {
            float ss = 0.f;
#pragma unroll
            for (int e = 0; e < 8; ++e) ss += y[e] * y[e];
            ss += __shfl_xor(ss, 1); ss += __shfl_xor(ss, 2); ss += __shfl_xor(ss, 4); ss += __shfl_xor(ss, 8);
            const float rs = rsqrtf(ss + EPS) * (part == 0 ? 0.08838834764831845f : 1.f);
#pragma unroll
            for (int e = 0; e < 8; ++e) y[e] *= rs;
          }
          u32x4 o; o[0] = pack2(y[0], y[1]); o[1] = pack2(y[2], y[3]); o[2] = pack2(y[4], y[5]); o[3] = pack2(y[6], y[7]);
          *(u32x4*)(dstb + (size_t)t * 1024 + h * 128 + cc) = o;
          if (part == 1) *(u32x4*)(sK + i * 136 + cc) = o;
        }
      }
    }
    if (tid < 128) {
      const int dir = tid >> 6, L = tid & 63;
      const int i = dir ? 63 - L : L;
      const float* gb = gbuf + (size_t)(t0 + i) * 32;
      const float gin = gb[dir * 8 + h], bin = gb[16 + dir * 8 + h];
      const float x = gin + dt_bias[dir * 8 + h];
      const float sp = fmaxf(x, 0.f) + log1pf(expf(-fabsf(x)));
      float gv = -expf(a_log[dir * 8 + h]) * sp;
      const float bt = 1.f / (1.f + expf(-bin));
#pragma unroll
      for (int off = 1; off < 64; off <<= 1) { const float v = __shfl_up(gv, off); if (L >= off) gv += v; }
      sG[dir * 64 + i] = gv; sBt[dir * 64 + i] = bt;
      gcb[((size_t)(t0 + i) * 8 + h) * 2 + dir] = gv; betab[((size_t)(t0 + i) * 8 + h) * 2 + dir] = bt;
    }
    __syncthreads();
    {
      f32x4 ga[4];
#pragma unroll
      for (int mt = 0; mt < 4; ++mt) { ga[mt][0] = 0.f; ga[mt][1] = 0.f; ga[mt][2] = 0.f; ga[mt][3] = 0.f; }
#pragma unroll
      for (int ks = 0; ks < 4; ++ks) {
        const bf16x8 a = ld8(sK + (wid * 16 + l15) * 136 + ks * 32 + g * 8);
#pragma unroll
        for (int mt = 0; mt < 4; ++mt) { const bf16x8 b = ld8(sK + (mt * 16 + l15) * 136 + ks * 32 + g * 8); ga[mt] = mma(a, b, ga[mt]); }
      }
#pragma unroll
      for (int dir = 0; dir < 2; ++dir)
#pragma unroll
        for (int mt = 0; mt < 4; ++mt)
#pragma unroll
          for (int r = 0; r < 4; ++r) {
            const int i = wid * 16 + g * 4 + r, m = mt * 16 + l15;
            const bool valid = dir ? (i < m) : (i > m);
            const float val = valid ? sBt[dir * 64 + i] * ga[mt][r] * __expf(sG[dir * 64 + i] - sG[dir * 64 + m]) : 0.f;
            const int ii = dir ? 63 - i : i, mm = dir ? 63 - m : m;
            sA[dir * 4096 + ii * 64 + mm] = val;
          }
    }
    __syncthreads();
    if (wid < 2) {
      const int dir = wid;
      float* Am = sA + dir * 4096;
      for (int i = 0; i < 64; ++i) {
        float a = (i == lane) ? 1.f : 0.f;
        int m = 0;
        for (; m + 8 <= i; m += 8) {
          const float4 a0 = *(const float4*)(Am + i * 64 + m), a1 = *(const float4*)(Am + i * 64 + m + 4);
          float tv[8];
#pragma unroll
          for (int e = 0; e < 8; ++e) tv[e] = Am[(m + e) * 64 + lane];
          a -= a0.x * tv[0]; a -= a0.y * tv[1]; a -= a0.z * tv[2]; a -= a0.w * tv[3];
          a -= a1.x * tv[4]; a -= a1.y * tv[5]; a -= a1.z * tv[6]; a -= a1.w * tv[7];
        }
        for (; m < i; ++m) a -= Am[i * 64 + m] * Am[m * 64 + lane];
        Am[i * 64 + lane] = a;
      }
      const int mn = dir ? 63 - lane : lane;
      const float bm = sBt[dir * 64 + mn];
      u16* Td = Tbuf + ((size_t)unit * 2 + dir) * 4096;
#pragma unroll 4
      for (int i = 0; i < 64; ++i) { const int in_ = dir ? 63 - i : i; Td[in_ * 64 + mn] = f2bf(Am[i * 64 + lane] * bm); }
    }
  }
}

DI void gdn_scan_phase(const P& p, int j, char* smem_raw) {
  const int bid = opaque_bid();
  char* const ws = opaque_ptr(p.ws);
  u16* sK = (u16*)smem_raw;
  u16* sKT = sK + 64 * 136;
  u16* sVT = sKT + 128 * 72;
  u16* sST = sVT + 32 * 72;
  u16* sVN = sST + 32 * 136;
  u16* sVD = sVN + 32 * 72;
  float* sGc = (float*)(sVD + 32 * 72);
  const int tid = opaque_tid(), lane = tid & 63, w = tid >> 6, l15 = lane & 15, g = lane >> 4;
  const u16* qn = (const u16*)(ws + WS_HBUF); const u16* kn = (const u16*)(ws + WS_OBUF); const u16* vb = (const u16*)(ws + WS_R + R_VBUF);
  const u16* Tbuf = (const u16*)(ws + WS_R + R_TBUF);
  const float* gcb = (const float*)(ws + WS_R + R_GCB);
  u16* obase = (u16*)(ws + WS_R + R_PROJ);
  for (int wk = bid; wk < 1536; wk += gridDim.x) {
    int seq, rem;
    if (wk < 512) { seq = 16 + (wk >> 6); rem = wk & 63; } else { seq = (wk - 512) >> 6; rem = (wk - 512) & 63; }
    const int h = rem >> 3, dir = (rem >> 2) & 1, dvq = rem & 3;
    const int nch = seq < 16 ? 4 : 32;
    const int cgb = seq < 16 ? seq * 4 : 64 + (seq - 16) * 32;
    f32x4 S[2][2];
    if (seq >= 16) {
      const float* s0 = p.in[2 + dir] + (((size_t)(seq - 16) * 2 + j) * 8 + h) * 16384;
#pragma unroll
      for (int dt = 0; dt < 2; ++dt)
#pragma unroll
        for (int et = 0; et < 2; ++et)
#pragma unroll
          for (int r = 0; r < 4; ++r) S[dt][et][r] = s0[(size_t)(w * 32 + dt * 16 + g * 4 + r) * 128 + dvq * 32 + et * 16 + l15];
    } else {
#pragma unroll
      for (int dt = 0; dt < 2; ++dt)
#pragma unroll
        for (int et = 0; et < 2; ++et) { S[dt][et][0] = 0.f; S[dt][et][1] = 0.f; S[dt][et][2] = 0.f; S[dt][et][3] = 0.f; }
    }
    __syncthreads();
#pragma unroll
    for (int dt = 0; dt < 2; ++dt)
#pragma unroll
      for (int et = 0; et < 2; ++et) st4bf(sST + (et * 16 + l15) * 136 + w * 32 + dt * 16 + g * 4, S[dt][et][0], S[dt][et][1], S[dt][et][2], S[dt][et][3]);
    u32x4 pk[4], pv; bf16x8 pq[4], pt[2]; float pg = 0.f;
#define SCAN_PREFETCH(cc) do { \
      const int t0n_ = (cgb + (cc)) * 64; const int unitn_ = (cgb + (cc)) * 8 + h; \
      _Pragma("unroll") for (int i = 0; i < 4; ++i) { const int ci = tid + 256 * i; const int row = ci >> 4, dc = (ci & 15) * 8; pk[i] = *(const u32x4*)(kn + (size_t)(t0n_ + row) * 1024 + h * 128 + dc); } \
      { const int row = tid >> 2, ec = (tid & 3) * 8; pv = *(const u32x4*)(vb + (size_t)(t0n_ + row) * 1024 + h * 128 + dvq * 32 + ec); } \
      if (tid < 64) pg = gcb[((size_t)(t0n_ + tid) * 8 + h) * 2 + dir]; \
      _Pragma("unroll") for (int ks = 0; ks < 4; ++ks) pq[ks] = ld8(qn + (size_t)(t0n_ + w * 16 + l15) * 1024 + h * 128 + ks * 32 + g * 8); \
      _Pragma("unroll") for (int ks = 0; ks < 2; ++ks) pt[ks] = ld8(Tbuf + ((size_t)unitn_ * 2 + dir) * 4096 + (w * 16 + l15) * 64 + ks * 32 + g * 8); \
    } while (0)
    SCAN_PREFETCH(dir ? nch - 1 : 0);
    for (int step = 0; step < nch; ++step) {
      const int c = dir ? nch - 1 - step : step;
      const int t0 = (cgb + c) * 64;
      const int unit = (cgb + c) * 8 + h;
#pragma unroll
      for (int i = 0; i < 4; ++i) {
        const int ci = tid + 256 * i; const int row = ci >> 4, dc = (ci & 15) * 8;
        const u32x4 v = pk[i];
        *(u32x4*)(sK + row * 136 + dc) = v;
#pragma unroll
        for (int e = 0; e < 4; ++e) { sKT[(dc + 2 * e) * 72 + row] = (u16)(v[e] & 0xffffu); sKT[(dc + 2 * e + 1) * 72 + row] = (u16)(v[e] >> 16); }
      }
      {
        const int row = tid >> 2, ec = (tid & 3) * 8;
        const u32x4 v = pv;
#pragma unroll
        for (int e = 0; e < 4; ++e) { sVT[(ec + 2 * e) * 72 + row] = (u16)(v[e] & 0xffffu); sVT[(ec + 2 * e + 1) * 72 + row] = (u16)(v[e] >> 16); }
      }
      if (tid < 64) sGc[tid] = pg;
      bf16x8 qf[4], tf[2];
#pragma unroll
      for (int ks = 0; ks < 4; ++ks) qf[ks] = pq[ks];
#pragma unroll
      for (int ks = 0; ks < 2; ++ks) tf[ks] = pt[ks];
      __syncthreads();
      if (step + 1 < nch) { const int cn = dir ? nch - 2 - step : step + 1; SCAN_PREFETCH(cn); }
      const float gl = dir ? sGc[0] : sGc[63];
      f32x4 ua[2];
#pragma unroll
      for (int et = 0; et < 2; ++et) {
        ua[et][0] = 0.f; ua[et][1] = 0.f; ua[et][2] = 0.f; ua[et][3] = 0.f;
#pragma unroll
        for (int ks = 0; ks < 2; ++ks) ua[et] = mma(tf[ks], ld8(sVT + (et * 16 + l15) * 72 + ks * 32 + g * 8), ua[et]);
      }
      bf16x8 tf2[2];
#pragma unroll
      for (int ks = 0; ks < 2; ++ks) {
        const u32x4 tw = __builtin_bit_cast(u32x4, tf[ks]);
        u32x4 o;
#pragma unroll
        for (int e = 0; e < 4; ++e) {
          const int m = ks * 32 + g * 8 + 2 * e;
          o[e] = pack2(bflo(tw[e]) * __expf(sGc[m]), bfhi(tw[e]) * __expf(sGc[m + 1]));
        }
        tf2[ks] = __builtin_bit_cast(bf16x8, o);
      }
      bf16x8 wf[4];
#pragma unroll
      for (int kq = 0; kq < 4; ++kq) {
        f32x4 wa[2];
#pragma unroll
        for (int hh = 0; hh < 2; ++hh) {
          const int dt = kq * 2 + hh;
          wa[hh][0] = 0.f; wa[hh][1] = 0.f; wa[hh][2] = 0.f; wa[hh][3] = 0.f;
#pragma unroll
          for (int ks = 0; ks < 2; ++ks) wa[hh] = mma(ld8(sKT + (dt * 16 + l15) * 72 + ks * 32 + g * 8), tf2[ks], wa[hh]);
        }
        wf[kq] = pack8(wa[0], wa[1]);
      }
      f32x4 vn[2];
#pragma unroll
      for (int et = 0; et < 2; ++et) {
        f32x4 a; a[0] = 0.f; a[1] = 0.f; a[2] = 0.f; a[3] = 0.f;
#pragma unroll
        for (int kq = 0; kq < 4; ++kq) { const u16* sp = sST + (et * 16 + l15) * 136 + kq * 32 + g * 4; a = mma(wf[kq], ld44(sp, sp + 16), a); }
        vn[et][0] = ua[et][0] - a[0]; vn[et][1] = ua[et][1] - a[1]; vn[et][2] = ua[et][2] - a[2]; vn[et][3] = ua[et][3] - a[3];
      }
      bf16x8 qkf[2];
      {
        const int iq = w * 16 + l15;
        const float gi = sGc[iq];
#pragma unroll
        for (int kk = 0; kk < 2; ++kk) {
          f32x4 ka[2];
#pragma unroll
          for (int hh = 0; hh < 2; ++hh) {
            const int mt = kk * 2 + hh;
            ka[hh][0] = 0.f; ka[hh][1] = 0.f; ka[hh][2] = 0.f; ka[hh][3] = 0.f;
#pragma unroll
            for (int ks = 0; ks < 4; ++ks) ka[hh] = mma(ld8(sK + (mt * 16 + l15) * 136 + ks * 32 + g * 8), qf[ks], ka[hh]);
#pragma unroll
            for (int r = 0; r < 4; ++r) {
              const int m = mt * 16 + g * 4 + r;
              const bool valid = dir ? (iq <= m) : (iq >= m);
              ka[hh][r] = valid ? ka[hh][r] * __expf(gi - sGc[m]) : 0.f;
            }
          }
          qkf[kk] = pack8(ka[0], ka[1]);
        }
      }
#pragma unroll
      for (int et = 0; et < 2; ++et) {
        const int i0 = w * 16 + g * 4;
        st4bf(sVN + (et * 16 + l15) * 72 + i0, vn[et][0], vn[et][1], vn[et][2], vn[et][3]);
        st4bf(sVD + (et * 16 + l15) * 72 + i0, vn[et][0] * __expf(gl - sGc[i0]), vn[et][1] * __expf(gl - sGc[i0 + 1]), vn[et][2] * __expf(gl - sGc[i0 + 2]), vn[et][3] * __expf(gl - sGc[i0 + 3]));
      }
      __syncthreads();
#pragma unroll
      for (int et = 0; et < 2; ++et) {
        f32x4 a1; a1[0] = 0.f; a1[1] = 0.f; a1[2] = 0.f; a1[3] = 0.f;
#pragma unroll
        for (int ks = 0; ks < 4; ++ks) a1 = mma(qf[ks], ld8(sST + (et * 16 + l15) * 136 + ks * 32 + g * 8), a1);
        f32x4 a2; a2[0] = 0.f; a2[1] = 0.f; a2[2] = 0.f; a2[3] = 0.f;
#pragma unroll
        for (int kk = 0; kk < 2; ++kk) { const u16* sp = sVN + (et * 16 + l15) * 72 + kk * 32 + g * 4; a2 = mma(qkf[kk], ld44(sp, sp + 16), a2); }
#pragma unroll
        for (int r = 0; r < 4; ++r) {
          const int i = w * 16 + g * 4 + r;
          const float o = a1[r] * __expf(sGc[i]) + a2[r];
          obase[(size_t)(t0 + i) * 4096 + dir * 1024 + h * 128 + dvq * 32 + et * 16 + l15] = f2bf(o);
        }
      }
      {
        const float eg = __expf(gl);
#pragma unroll
        for (int dt = 0; dt < 2; ++dt)
#pragma unroll
          for (int et = 0; et < 2; ++et) {
            f32x4 a; a[0] = S[dt][et][0] * eg; a[1] = S[dt][et][1] * eg; a[2] = S[dt][et][2] * eg; a[3] = S[dt][et][3] * eg;
#pragma unroll
            for (int kk = 0; kk < 2; ++kk) a = mma(ld8(sKT + (w * 32 + dt * 16 + l15) * 72 + kk * 32 + g * 8), ld8(sVD + (et * 16 + l15) * 72 + kk * 32 + g * 8), a);
            S[dt][et] = a;
          }
      }
      __syncthreads();
#pragma unroll
      for (int dt = 0; dt < 2; ++dt)
#pragma unroll
        for (int et = 0; et < 2; ++et) st4bf(sST + (et * 16 + l15) * 136 + w * 32 + dt * 16 + g * 4, S[dt][et][0], S[dt][et][1], S[dt][et][2], S[dt][et][3]);
    }
    if (seq < 16) {
      float* so = p.out + (dir ? O_SB : O_SF) + (((size_t)seq * 2 + j) * 8 + h) * 16384;
#pragma unroll
      for (int dt = 0; dt < 2; ++dt)
#pragma unroll
        for (int et = 0; et < 2; ++et)
#pragma unroll
          for (int r = 0; r < 4; ++r) so[(size_t)(w * 32 + dt * 16 + g * 4 + r) * 128 + dvq * 32 + et * 16 + l15] = S[dt][et][r];
    }
  }
}

#define XB_TMO      128
#define XB_XCNT(j)  (256  + 64 * (j))
#define XB_XSUB(j)  (1280 + 64 * (j))
#define XB_XGEN(j)  (2304 + 64 * (j))
#define XB_TOP      3328
#define XB_TOPGEN   3392
#define XCD_BAR_WORDS 3456
#define XB_SPIN_CAP (1u << 20)
#define LAS __attribute__((address_space(3)))
DI unsigned xb_ld(unsigned* p)              { return __hip_atomic_load(p, __ATOMIC_RELAXED, __HIP_MEMORY_SCOPE_AGENT); }
DI unsigned xb_add(unsigned* p, unsigned v) { return __hip_atomic_fetch_add(p, v, __ATOMIC_RELAXED, __HIP_MEMORY_SCOPE_AGENT); }
DI unsigned xb_xcc_id() { return (unsigned)__builtin_amdgcn_s_getreg((3 << 11) | 20) & 0xFu; }
#define XB_SPIN(cond, bar) do { unsigned _sp = 0; while (cond) { __builtin_amdgcn_s_sleep(1); \
    if ((++_sp & 255u) == 0u) { if (xb_ld(&(bar)[XB_TMO])) break; if (_sp > XB_SPIN_CAP) { atomicAdd(&(bar)[XB_TMO], 1u); break; } } } } while (0)
struct XcdBarrier { unsigned* bar; unsigned x; volatile LAS unsigned* st; };
DI XcdBarrier xcd_barrier_post(unsigned* bar, volatile LAS unsigned* st) {
  XcdBarrier b; b.bar = bar; b.x = xb_xcc_id(); b.st = st;
  if (threadIdx.x == 0) (void)xb_add(&bar[XB_XCNT(b.x)], 1u);
  return b;
}
DI void xcd_barrier_complete(unsigned* bar, unsigned x, unsigned& nloc, unsigned& nx) {
  const unsigned Gn = gridDim.x * gridDim.y * gridDim.z;
  unsigned sum, cnt, mine, sp = 0u;
  for (;;) {
    sum = 0u; cnt = 0u; mine = 0u;
#pragma unroll
    for (unsigned j = 0; j < 16; ++j) { const unsigned c = xb_ld(&bar[XB_XCNT(j)]); sum += c; cnt += (c > 0u) ? 1u : 0u; mine = (j == x) ? c : mine; }
    if (sum == Gn) break;
    __builtin_amdgcn_s_sleep(1);
    if ((++sp & 255u) == 0u) { if (xb_ld(&bar[XB_TMO])) break; if (sp > XB_SPIN_CAP) { atomicAdd(&bar[XB_TMO], 1u); break; } }
  }
  nloc = mine > 0u ? mine : 1u; nx = cnt > 0u ? cnt : 1u;
}
DI void xcd_barrier(const XcdBarrier& b) {
  asm volatile("s_waitcnt vmcnt(0)" ::: "memory");
  __syncthreads();
  if (threadIdx.x == 0) {
    unsigned* bar = b.bar;
    __builtin_amdgcn_s_waitcnt(0);
    unsigned nloc = b.st[0], nx = b.st[1];
    if (nloc == 0u) { xcd_barrier_complete(bar, b.x, nloc, nx); b.st[0] = nloc; b.st[1] = nx; }
    const unsigned old = xb_add(&bar[XB_XSUB(b.x)], 1u);
    const unsigned gen = old / nloc;
    if (old + 1u == (gen + 1u) * nloc) {
      __builtin_amdgcn_fence(__ATOMIC_RELEASE, "agent");
      asm volatile("s_waitcnt vmcnt(0)" ::: "memory");
      const unsigned og = xb_add(&bar[XB_TOP], 1u);
      const unsigned tg = og / nx;
      if (og + 1u == (tg + 1u) * nx) xb_add(&bar[XB_TOPGEN], 1u);
      else XB_SPIN(xb_ld(&bar[XB_TOPGEN]) == tg, bar);
      __builtin_amdgcn_fence(__ATOMIC_ACQUIRE, "agent");
      xb_add(&bar[XB_XGEN(b.x)], 1u);
      asm volatile("s_waitcnt vmcnt(0)" ::: "memory");
    } else {
      XB_SPIN(xb_ld(&bar[XB_XGEN(b.x)]) == gen, bar);
      __builtin_amdgcn_fence(__ATOMIC_ACQUIRE, "agent");
      asm volatile("s_waitcnt vmcnt(0)" ::: "memory");
    }
  }
  __syncthreads();
}

__global__ void __launch_bounds__(256, 2) fwd_megakernel(P p) {
  cg::grid_group grid = cg::this_grid();
  __shared__ __attribute__((aligned(16))) char smem[60416];
  const int tid = opaque_tid(), lane = tid & 63, wid = tid >> 6;
  const int G = gridDim.x;
  __shared__ uint4 xb_words;
  if (threadIdx.x == 0) xb_words = make_uint4(0u, 0u, 0u, 0u);
  __syncthreads();
  (void)xcd_barrier_post((unsigned*)(p.ws + WS_BAR), (volatile LAS unsigned*)&xb_words);
#define GSYNC() do { XcdBarrier xb_; xb_.bar = (unsigned*)(opaque_ptr(p.ws) + WS_BAR); xb_.x = xb_xcc_id(); xb_.st = (volatile LAS unsigned*)&xb_words; xcd_barrier(xb_); } while (0)
  const int bid0 = opaque_bid();
  {
  char* const ws0 = opaque_ptr(p.ws);
  float* mods = (float*)(ws0 + WS_MODS);
  float* ropeT = (float*)(ws0 + WS_ROPE);
  float* cosG = ropeT, *sinG = ropeT + 2048, *cosM = ropeT + 4096, *sinM = ropeT + 5120;

  {
    float* sc = (float*)smem;
    float* red = sc + 9 * 128;
    float* part = (float*)(ws0 + WS_R);
    for (int item = bid0; item < 3072; item += G) {
      const int ks = item & 7, cgp = (item >> 3) % 96, layer = item / 768;
      __syncthreads();
      for (int e = tid; e < 9 * 128; e += 256) {
        const int ci = e >> 7, k = ks * 128 + (e & 127);
        const float v = ci == 0 ? p.in[9][k] : p.in[8][(ci - 1) * 1024 + k];
        sc[e] = v / (1.f + expf(-v));
      }
      __syncthreads();
      const int col = tid & 63, kg = tid >> 6;
      const float* wp = p.in[12] + ((size_t)layer * 1024 + ks * 128 + kg * 32) * 6144 + cgp * 64 + col;
      float acc[9];
#pragma unroll
      for (int ci = 0; ci < 9; ++ci) acc[ci] = 0.f;
#pragma unroll 8
      for (int kk = 0; kk < 32; ++kk) {
        const float wv = wp[(size_t)kk * 6144];
#pragma unroll
        for (int ci = 0; ci < 9; ++ci) acc[ci] += sc[ci * 128 + kg * 32 + kk] * wv;
      }
#pragma unroll
      for (int ci = 0; ci < 9; ++ci) red[(kg * 64 + col) * 9 + ci] = acc[ci];
      __syncthreads();
      if (kg == 0) {
        const int n = cgp * 64 + col;
        const float bias = ks == 0 ? p.in[13][(size_t)layer * 6144 + n] : 0.f;
#pragma unroll
        for (int ci = 0; ci < 9; ++ci) {
          const float s = red[col * 9 + ci] + red[(64 + col) * 9 + ci] + red[(128 + col) * 9 + ci] + red[(192 + col) * 9 + ci] + bias;
          part[(size_t)ks * 221184 + ((size_t)layer * 9 + ci) * 6144 + n] = s;
        }
      }
    }
    if (bid0 == G - 1) {
      for (int e = tid; e < 2048; e += 256) { const int pos = e >> 5, f = e & 31; const float fr = powf(10000.f, -(float)f / 32.f); const float a = (float)pos * fr; cosG[e] = cosf(a); sinG[e] = sinf(a); }
      for (int e = tid; e < 1024; e += 256) { const int pos = e >> 4, f = e & 15; const float fr = powf(10000.f, -(float)f / 16.f); const float a = (float)pos * fr; cosM[e] = cosf(a); sinM[e] = sinf(a); }
    }
  }
  grid.sync();
  {
    const float* part = (const float*)(ws0 + WS_R);
    for (int e = bid0 * 256 + tid; e < 221184; e += G * 256) {
      float sacc = 0.f;
#pragma unroll
      for (int ks = 0; ks < 8; ++ks) sacc += part[(size_t)ks * 221184 + e];
      mods[e] = sacc;
    }
  }
  }
  GSYNC();

#pragma unroll 1
  for (int layer = 0; layer < 4; ++layer) {
    const int kind = layer % 3, j = layer / 3;
    const int bid = opaque_bid();
    char* const ws = opaque_ptr(p.ws);
    float* mods = (float*)(ws + WS_MODS);
    float* ropeT = (float*)(ws + WS_ROPE);
    float* cosG = ropeT, *sinG = ropeT + 2048, *cosM = ropeT + 4096, *sinM = ropeT + 5120;
    u16* hbuf = (u16*)(ws + WS_HBUF);
    u16* obuf = (u16*)(ws + WS_OBUF);
    u16* wmix = (u16*)(ws + WS_WMIX);
    u16* wmlp = (u16*)(ws + WS_WMLP);
    char* R = ws + WS_R;
    const float* lmods = mods + (size_t)layer * 9 * 6144;
    {
      for (int it = bid; it < 5120; it += G) norm_rows(p, layer, layer == 0, it, p.in[10] + layer * 1024, 0, 1);
      float* sT = (float*)smem;
      for (int it = bid; it < 2048; it += G) {
        if (it < 1024) convert_tile(p.in[14] + (size_t)layer * 1024 * 4096, 1024, 4096, wmlp, it, 0, sT);
        else convert_tile(p.in[15] + (size_t)layer * 4096 * 1024, 4096, 1024, wmlp + 4194304, it - 1024, 0, sT);
      }
      if (kind == 0) {
        for (int it = bid; it < 1056 + 256; it += G) {
          if (it < 1056) convert_tile(p.in[16] + (size_t)j * 1024 * 4128, 1024, 4128, wmix + WM_IN, it, 0, sT);
          else convert_tile(p.in[21] + (size_t)j * 1024 * 1024, 1024, 1024, wmix + WM_OUT, it - 1056, 0, sT);
        }
      } else if (kind == 1) {
        for (int it = bid; it < 192 + 144 + 128 + 256; it += G) {
          if (it < 192) convert_tile(p.in[22], 1024, 704, wmix + WM_IN, it, 0, sT);
          else if (it < 336) convert_tile(p.in[25], 384, 1536, wmix + WM_UQ, it - 192, 1, sT);
          else if (it < 464) convert_tile(p.in[26], 256, 2048, wmix + WM_UKV, it - 336, 0, sT);
          else convert_tile(p.in[31], 1024, 1024, wmix + WM_OUT, it - 464, 0, sT);
        }
      } else {
        for (int it = bid; it < 384 + 256; it += G) {
          if (it < 384) convert_tile(p.in[32], 1024, 1536, wmix + WM_IN, it, 0, sT);
          else convert_tile(p.in[35], 1024, 1024, wmix + WM_OUT, it - 384, 0, sT);
        }
        u16* Kg = (u16*)(R + R_KG); u16* Vg = (u16*)(R + R_VTG);
        const int tid = opaque_tid();
        for (int it = bid; it < 512; it += G) {
          const int b = it >> 6, s0 = (it & 63) * 8;
          const int ch = tid;
          float kv[8], vv[8];
#pragma unroll
          for (int e = 0; e < 8; ++e) { kv[e] = p.in[6][((size_t)b * 512 + s0 + e) * 256 + ch]; vv[e] = p.in[7][((size_t)b * 512 + s0 + e) * 256 + ch]; }
#pragma unroll
          for (int e = 0; e < 8; ++e) Kg[(size_t)(NPROMPT + b * 2560 + s0 + e) * 256 + ch] = f2bf(kv[e]);
          u32x4 o; o[0] = pack2(vv[0], vv[1]); o[1] = pack2(vv[2], vv[3]); o[2] = pack2(vv[4], vv[5]); o[3] = pack2(vv[6], vv[7]);
          *(u32x4*)(Vg + (size_t)(NPROMPT + b * 2560) * 256 + (size_t)ch * 2560 + s0) = o;
        }
      }
    }
    GSYNC();

    if (kind == 0) {
      {
        EpiGdnIn epi; epi.proj = (u16*)(R + R_PROJ); epi.gbuf = (float*)(R + R_GBUF);
        for (int it = bid; it < 160 * 33; it += G) { const int mt = it / 33, nt = it % 33; gemm_tile<4>(hbuf, 1024, wmix + WM_IN, 1024, 1024, mt * 128, nt * 128, (u16*)smem, epi); }
      }
      GSYNC();
      gdn_chunk_phase(p, j, smem);
      GSYNC();
      gdn_scan_phase(p, j, smem);
      GSYNC();
      {
        const u16* pr = (const u16*)(R + R_PROJ);
        const float* on = p.in[20] + j * 128;
        const int tid = opaque_tid();
        for (int t = bid; t < NTOK; t += G) {
          const int h = tid >> 5, c = (tid & 31) * 4;
          const u16* row = pr + (size_t)t * 4096;
          const u32x2 f = *(const u32x2*)(row + h * 128 + c), b = *(const u32x2*)(row + 1024 + h * 128 + c), z = *(const u32x2*)(row + 3072 + h * 128 + c);
          float o[4] = {bflo(f[0]) + bflo(b[0]), bfhi(f[0]) + bfhi(b[0]), bflo(f[1]) + bflo(b[1]), bfhi(f[1]) + bfhi(b[1])};
          float zz[4] = {bflo(z[0]), bfhi(z[0]), bflo(z[1]), bfhi(z[1])};
          float ss = o[0] * o[0] + o[1] * o[1] + o[2] * o[2] + o[3] * o[3];
          ss += __shfl_xor(ss, 1); ss += __shfl_xor(ss, 2); ss += __shfl_xor(ss, 4); ss += __shfl_xor(ss, 8); ss += __shfl_xor(ss, 16);
          const float rs = rsqrtf(ss * (1.f / 128.f) + EPS);
          const float4 gn = *(const float4*)(on + c);
          const float gg[4] = {gn.x, gn.y, gn.z, gn.w};
          float y[4];
#pragma unroll
          for (int e = 0; e < 4; ++e) y[e] = o[e] * rs * gg[e] * (zz[e] / (1.f + __expf(-zz[e])));
          st4bf(obuf + (size_t)t * 1024 + h * 128 + c, y[0], y[1], y[2], y[3]);
        }
      }
      GSYNC();
    } else if (kind == 1) {
      {
        EpiF32 epi; epi.dst = (float*)(R + R_DPROJ); epi.ld = 768;
        for (int it = bid; it < 160 * 6; it += G) { const int mt = it / 6, nt = it % 6; gemm_tile<4>(hbuf, 1024, wmix + WM_IN, 1024, 1024, mt * 128, nt * 128, (u16*)smem, epi); }
      }
      GSYNC();
      {
        const float* dproj = (const float*)(R + R_DPROJ);
        u16* cq = (u16*)(R + R_CQ); u16* ckv = (u16*)(R + R_CKV); u16* Km = (u16*)(R + R_KM);
        const int tid = opaque_tid(), lane = tid & 63, wid = tid >> 6;
        for (int it = bid; it < 6144; it += G) {
          const int row = it * 4 + wid;
          if (row < NTOK) {
            const int t = row;
            const float* pr = dproj + (size_t)t * 768;
            float v[6]; float ss = 0.f;
#pragma unroll
            for (int e = 0; e < 6; ++e) { v[e] = pr[lane + 64 * e]; ss += v[e] * v[e]; }
            ss = wave_sum(ss);
            float rs = rsqrtf(ss * (1.f / 384.f) + EPS);
#pragma unroll
            for (int e = 0; e < 6; ++e) cq[(size_t)t * 384 + lane + 64 * e] = f2bf(v[e] * rs * p.in[23][lane + 64 * e]);
            const int kvrow = kvrow_of_tok(t);
            float wv[4]; ss = 0.f;
#pragma unroll
            for (int e = 0; e < 4; ++e) { wv[e] = pr[384 + lane + 64 * e]; ss += wv[e] * wv[e]; }
            ss = wave_sum(ss);
            rs = rsqrtf(ss * (1.f / 256.f) + EPS);
#pragma unroll
            for (int e = 0; e < 4; ++e) {
              const float o = wv[e] * rs * p.in[24][lane + 64 * e];
              ckv[(size_t)kvrow * 256 + lane + 64 * e] = f2bf(o);
              if (t < NPROMPT) p.out[O_CKV + (size_t)t * 256 + lane + 64 * e] = o;
            }
            const float x = pr[640 + lane];
            ss = wave_sum(x * x);
            float kr = x * rsqrtf(ss * (1.f / 64.f) + EPS) * p.in[30][lane];
            if (t < NPROMPT) p.out[O_KR + (size_t)t * 64 + lane] = kr;
            else {
              const int s = (t - NPROMPT) & 2047;
              const int pos = lane < 32 ? (s >> 6) : (s & 63);
              const float cs = cosM[pos * 16 + (lane & 15)], sn = sinM[pos * 16 + (lane & 15)];
              const float partner = __shfl_xor(kr, 16);
              kr = ((lane & 16) == 0) ? kr * cs - partner * sn : partner * sn + kr * cs;
            }
            const u16 kb = f2bf(kr);
#pragma unroll
            for (int hh = 0; hh < 8; ++hh) Km[(size_t)kvrow * 1536 + hh * 192 + 128 + lane] = kb;
          } else {
            const int r = row - NTOK; const int b = r >> 9, s = r & 511;
            const int kvrow = NPROMPT + b * 2560 + s;
#pragma unroll
            for (int e = 0; e < 4; ++e) ckv[(size_t)kvrow * 256 + lane + 64 * e] = f2bf(p.in[4][((size_t)b * 512 + s) * 256 + lane + 64 * e]);
            const u16 kb = f2bf(p.in[5][((size_t)b * 512 + s) * 64 + lane]);
#pragma unroll
            for (int hh = 0; hh < 8; ++hh) Km[(size_t)kvrow * 1536 + hh * 192 + 128 + lane] = kb;
          }
        }
      }
      GSYNC();
      {
        EpiMlaUq e1; e1.Q = (u16*)(R + R_Q); e1.gnope = p.in[27]; e1.grope = p.in[28]; e1.cosT = cosM; e1.sinT = sinM;
        for (int it = bid; it < 160 * 12; it += G) { const int mt = it / 12, nt = it % 12; gemm_tile<8>((const u16*)(R + R_CQ), 384, wmix + WM_UQ, 384, 384, mt * 128, nt * 128, (u16*)smem, e1); }
        EpiMlaUkv e2; e2.Kb = (u16*)(R + R_KM); e2.Vt = (u16*)(R + R_VTM); e2.gnope = p.in[29];
        for (int it = bid; it < 192 * 16; it += G) { const int mt = it / 16, nt = it % 16; gemm_tile<8>((const u16*)(R + R_CKV), 256, wmix + WM_UKV, 256, 256, mt * 128, nt * 128, (u16*)smem, e2); }
      }
      GSYNC();
      attn_phase<192, 8>((const u16*)(R + R_Q), (const u16*)(R + R_KM), (const u16*)(R + R_VTM), obuf, smem);
      GSYNC();
    } else {
      {
        EpiGqaIn epi; epi.Q = (u16*)(R + R_Q); epi.Kb = (u16*)(R + R_KG); epi.Vt = (u16*)(R + R_VTG); epi.qg = p.in[33]; epi.kg = p.in[34]; epi.cosT = cosG; epi.sinT = sinG; epi.out = p.out;
        for (int it = bid; it < 160 * 12; it += G) { const int mt = it / 12, nt = it % 12; gemm_tile<8>(hbuf, 1024, wmix + WM_IN, 1024, 1024, mt * 128, nt * 128, (u16*)smem, epi); }
      }
      GSYNC();
      attn_phase<128, 2>((const u16*)(R + R_Q), (const u16*)(R + R_KG), (const u16*)(R + R_VTG), obuf, smem);
      GSYNC();
    }

    for (int it = bid; it < 160 * 8; it += G) {
      const int mt = it >> 3, nt = it & 7; const int m0 = mt * 128;
      EpiResid epi;
      epi.xin = (layer == 0) ? (m0 < NPROMPT ? p.in[0] : p.in[1] - (size_t)NPROMPT * 1024) : p.out;
      epi.xout = p.out; epi.gate = lmods + (size_t)cond_of(m0) * 6144 + 2 * 1024;
      gemm_tile<4>(obuf, 1024, wmix + WM_OUT, 1024, 1024, m0, nt * 128, (u16*)smem, epi);
    }
    GSYNC();
    for (int it = bid; it < 5120; it += G) norm_rows(p, layer, false, it, p.in[11] + layer * 1024, 3, 4);
    GSYNC();
    {
      EpiMlpIn epi; epi.abuf = (u16*)(R + R_ABUF);
      for (int it = bid; it < 160 * 32; it += G) { const int mt = it >> 5, nt = it & 31; gemm_tile<4>(hbuf, 1024, wmlp, 1024, 1024, mt * 128, nt * 128, (u16*)smem, epi); }
    }
    GSYNC();
    for (int it = bid; it < 160 * 8; it += G) {
      const int mt = it >> 3, nt = it & 7; const int m0 = mt * 128;
      EpiResid epi; epi.xin = p.out; epi.xout = p.out; epi.gate = lmods + (size_t)cond_of(m0) * 6144 + 5 * 1024;
      gemm_tile<4>((const u16*)(R + R_ABUF), 4096, wmlp + 4194304, 4096, 4096, m0, nt * 128, (u16*)smem, epi);
    }
    GSYNC();
  }
}

extern "C" void kernel_launch(void* const* d_in, const int* in_sizes, int n_in, void* d_out, int out_size, void* d_ws, size_t ws_size, hipStream_t stream) {
  static int grid_blocks = 0;
  if (!grid_blocks) {
    int dev = 0, cus = 0, per_cu = 0;
    hipGetDevice(&dev);
    hipDeviceGetAttribute(&cus, hipDeviceAttributeMultiprocessorCount, dev);
    hipOccupancyMaxActiveBlocksPerMultiprocessor(&per_cu, fwd_megakernel, 256, 0);
    if (per_cu < 1) per_cu = 1;
    if (per_cu > 2) per_cu = 2;
    grid_blocks = cus * per_cu;
  }
  P p{};
  for (int i = 0; i < 36; ++i) p.in[i] = (const float*)d_in[i];
  p.out = (float*)d_out;
  p.ws = (char*)d_ws;
  (void)hipMemsetAsync((char*)d_ws + WS_BAR, 0, XCD_BAR_WORDS * 4, stream);
  void* args[] = {&p};
  hipError_t e = hipLaunchCooperativeKernel((void*)fwd_megakernel, dim3(grid_blocks), dim3(256), args, 0, stream);
  if (e != hipSuccess) fprintf(stderr, "cooperative launch failed: %s (grid %d)\n", hipGetErrorString(e), grid_blocks);
}
```

```cpp
#include <hip/hip_runtime.h>
#include <hip/hip_cooperative_groups.h>
#include <cstdio>
namespace cg = cooperative_groups;

typedef unsigned short u16;
typedef __attribute__((ext_vector_type(8))) short bf16x8;
typedef __attribute__((ext_vector_type(4))) short bf16x4;
typedef __attribute__((ext_vector_type(4))) float f32x4;
typedef __attribute__((ext_vector_type(4))) unsigned u32x4;
typedef __attribute__((ext_vector_type(2))) unsigned u32x2;

#define DI __device__ __forceinline__

constexpr int NTOK = 20480;
constexpr int NPROMPT = 4096;
constexpr float EPS = 1e-6f;

constexpr size_t WS_MODS = 0;
constexpr size_t MODS_BYTES = 4ull * 9 * 6144 * 4;
constexpr size_t WS_BAR = 917504;
constexpr size_t WS_ROPE = 1048576;
constexpr size_t WS_WMIX = 1114112;
constexpr size_t WS_WMLP = 14090240;
constexpr size_t WS_HBUF = 30867456;
constexpr size_t WS_OBUF = 72810496;
constexpr size_t WS_R    = 114753536;
constexpr size_t R_ABUF = 0;
constexpr size_t R_PROJ = 0;
constexpr size_t R_VBUF = 167772160;
constexpr size_t R_TBUF = 209715200;
constexpr size_t R_GBUF = 251658240;
constexpr size_t R_GCB  = 254279680;
constexpr size_t R_BETA = 255590400;
constexpr size_t R_DPROJ = 0;
constexpr size_t R_Q    = 0;
constexpr size_t R_CQ   = 62914560;
constexpr size_t R_CKV  = 78643200;
constexpr size_t R_KM   = 91226112;
constexpr size_t R_VTM  = 166723584;
constexpr size_t R_KG   = 41943040;
constexpr size_t R_VTG  = 54525952;
constexpr size_t WM_IN = 0;
constexpr size_t WM_OUT = 4325376;
constexpr size_t WM_UQ = 5373952;
constexpr size_t WM_UKV = 5963776;
constexpr size_t O_SF = 20971520, O_SB = 25165824, O_CKV = 29360128, O_KR = 30408704, O_GK = 30670848, O_GV = 31719424;

struct P {
  const float* in[36];
  float* out;
  char* ws;
};

typedef __attribute__((ext_vector_type(2))) float f32x2_t;
typedef __attribute__((ext_vector_type(2))) __bf16 bf16x2_t;
DI u16 f2bf(float x) { return __builtin_bit_cast(u16, (__bf16)x); }
DI float bf2f(u16 h) { return __uint_as_float(((unsigned)h) << 16); }
DI unsigned pack2(float a, float b) { f32x2_t v; v[0] = a; v[1] = b; return __builtin_bit_cast(unsigned, __builtin_convertvector(v, bf16x2_t)); }
DI float bflo(unsigned w) { return __uint_as_float(w << 16); }
DI float bfhi(unsigned w) { return __uint_as_float(w & 0xffff0000u); }
DI f32x4 mma(bf16x8 a, bf16x8 b, f32x4 c) { return __builtin_amdgcn_mfma_f32_16x16x32_bf16(a, b, c, 0, 0, 0); }
DI bf16x8 pack8(f32x4 a, f32x4 b) {
  u32x4 p; p[0] = pack2(a[0], a[1]); p[1] = pack2(a[2], a[3]); p[2] = pack2(b[0], b[1]); p[3] = pack2(b[2], b[3]);
  return __builtin_bit_cast(bf16x8, p);
}
DI bf16x8 ld8(const u16* p) { return *(const bf16x8*)p; }
DI bf16x8 ld44(const u16* p0, const u16* p1) {
  u32x2 a = *(const u32x2*)p0; u32x2 b = *(const u32x2*)p1;
  u32x4 r; r[0] = a[0]; r[1] = a[1]; r[2] = b[0]; r[3] = b[1];
  return __builtin_bit_cast(bf16x8, r);
}
DI void st4bf(u16* p, float a, float b, float c, float d) { u32x2 v; v[0] = pack2(a, b); v[1] = pack2(c, d); *(u32x2*)p = v; }
DI float wave_sum(float v) {
  v += __shfl_xor(v, 1); v += __shfl_xor(v, 2); v += __shfl_xor(v, 4); v += __shfl_xor(v, 8); v += __shfl_xor(v, 16); v += __shfl_xor(v, 32);
  return v;
}
DI float sum_g(float v) { v += __shfl_xor(v, 16); v += __shfl_xor(v, 32); return v; }
DI int opaque_tid() { int t = threadIdx.x; asm volatile("" : "+v"(t)); return t; }
DI int opaque_bid() { int t = __builtin_amdgcn_readfirstlane((int)blockIdx.x); asm volatile("" : "+s"(t)); return t; }
DI char* opaque_ptr(char* q) {
  unsigned lo = __builtin_amdgcn_readfirstlane((unsigned)(size_t)q), hi = __builtin_amdgcn_readfirstlane((unsigned)((size_t)q >> 32));
  asm volatile("" : "+s"(lo), "+s"(hi));
  return (char*)(((size_t)hi << 32) | (size_t)lo);
}
DI int cond_of(int t) { return t < NPROMPT ? 0 : 1 + ((t - NPROMPT) >> 11); }
DI int kvrow_of_tok(int t) { return t < NPROMPT ? t : NPROMPT + ((t - NPROMPT) >> 11) * 2560 + 512 + ((t - NPROMPT) & 2047); }

template <int NI, class Epi>
DI void gemm_tile(const u16* __restrict__ A, int lda, const u16* __restrict__ Bt, int ldb, int K, int m0, int n0, u16* smem, Epi& epi) {
  constexpr int MI = 16 / NI;
  constexpr int WN = 8 / NI;
  const int tid = opaque_tid(), lane = tid & 63, wid = tid >> 6, l15 = lane & 15, g = lane >> 4;
  const int wm = wid / WN, wn = wid % WN;
  u16* sA = smem; u16* sB = smem + 128 * 64;
  f32x4 acc[MI][NI];
#pragma unroll
  for (int mi = 0; mi < MI; ++mi)
#pragma unroll
    for (int ni = 0; ni < NI; ++ni) { acc[mi][ni][0] = 0.f; acc[mi][ni][1] = 0.f; acc[mi][ni][2] = 0.f; acc[mi][ni][3] = 0.f; }
  const int lrow = tid >> 3, lkc = (tid & 7) * 8;
  const int wofs = lrow * 64 + (((tid & 7) ^ ((lrow >> 1) & 7)) * 8);
  const int rsw = (l15 >> 1) & 7;
  const int rofs0 = l15 * 64 + ((g ^ rsw) * 8), rofs1 = l15 * 64 + (((4 + g) ^ rsw) * 8);
  const u16* pa = A + (size_t)(m0 + lrow) * lda + lkc;
  const u16* pb = Bt + (size_t)(n0 + lrow) * ldb + lkc;
  u32x4 ra[2][4], rb[2][4];
  const int nk = K >> 6;
#pragma unroll
  for (int i = 0; i < 4; ++i) { ra[0][i] = *(const u32x4*)(pa + (size_t)i * 32 * lda); rb[0][i] = *(const u32x4*)(pb + (size_t)i * 32 * ldb); }
#pragma unroll
  for (int i = 0; i < 4; ++i) { ra[1][i] = *(const u32x4*)(pa + (size_t)i * 32 * lda + 64); rb[1][i] = *(const u32x4*)(pb + (size_t)i * 32 * ldb + 64); }
  for (int kt = 0; kt < nk; kt += 2) {
#pragma unroll
    for (int half = 0; half < 2; ++half) {
      __syncthreads();
#pragma unroll
      for (int i = 0; i < 4; ++i) { *(u32x4*)(sA + wofs + i * 32 * 64) = ra[half][i]; *(u32x4*)(sB + wofs + i * 32 * 64) = rb[half][i]; }
      __syncthreads();
      if (kt + half + 2 < nk) {
        const int ko = (kt + half + 2) * 64;
#pragma unroll
        for (int i = 0; i < 4; ++i) { ra[half][i] = *(const u32x4*)(pa + (size_t)i * 32 * lda + ko); rb[half][i] = *(const u32x4*)(pb + (size_t)i * 32 * ldb + ko); }
      }
#pragma unroll
      for (int ks = 0; ks < 2; ++ks) {
        const int ro = ks ? rofs1 : rofs0;
        bf16x8 af[MI], bfv[NI];
#pragma unroll
        for (int mi = 0; mi < MI; ++mi) af[mi] = ld8(sA + (wm * MI * 16 + mi * 16) * 64 + ro);
#pragma unroll
        for (int ni = 0; ni < NI; ++ni) bfv[ni] = ld8(sB + (wn * NI * 16 + ni * 16) * 64 + ro);
#pragma unroll
        for (int mi = 0; mi < MI; ++mi)
#pragma unroll
          for (int ni = 0; ni < NI; ++ni) acc[mi][ni] = mma(bfv[ni], af[mi], acc[mi][ni]);
      }
    }
  }
  epi.template run<MI, NI>(acc, m0 + wm * MI * 16, n0 + wn * NI * 16, l15, g);
}

struct EpiResid {
  const float* xin; float* xout; const float* gate;
  template <int MI, int NI> DI void run(f32x4 (&acc)[MI][NI], int mr, int nc, int l15, int g) {
#pragma unroll
    for (int mi = 0; mi < MI; ++mi)
#pragma unroll
      for (int ni = 0; ni < NI; ++ni) {
        const int m = mr + mi * 16 + l15, n = nc + ni * 16 + g * 4;
        const float4 xi = *(const float4*)(xin + (size_t)m * 1024 + n);
        const float4 gt = *(const float4*)(gate + n);
        float4 o; o.x = xi.x + gt.x * acc[mi][ni][0]; o.y = xi.y + gt.y * acc[mi][ni][1]; o.z = xi.z + gt.z * acc[mi][ni][2]; o.w = xi.w + gt.w * acc[mi][ni][3];
        *(float4*)(xout + (size_t)m * 1024 + n) = o;
      }
  }
};
struct EpiGdnIn {
  u16* proj; float* gbuf;
  template <int MI, int NI> DI void run(f32x4 (&acc)[MI][NI], int mr, int nc, int l15, int g) {
#pragma unroll
    for (int mi = 0; mi < MI; ++mi)
#pragma unroll
      for (int ni = 0; ni < NI; ++ni) {
        const int m = mr + mi * 16 + l15, n = nc + ni * 16 + g * 4;
        if (n < 4096) st4bf(proj + (size_t)m * 4096 + n, acc[mi][ni][0], acc[mi][ni][1], acc[mi][ni][2], acc[mi][ni][3]);
        else if (n < 4128) { float4 o; o.x = acc[mi][ni][0]; o.y = acc[mi][ni][1]; o.z = acc[mi][ni][2]; o.w = acc[mi][ni][3]; *(float4*)(gbuf + (size_t)m * 32 + (n - 4096)) = o; }
      }
  }
};
struct EpiMlpIn {
  u16* abuf;
  template <int MI, int NI> DI void run(f32x4 (&acc)[MI][NI], int mr, int nc, int l15, int g) {
#pragma unroll
    for (int mi = 0; mi < MI; ++mi)
#pragma unroll
      for (int ni = 0; ni < NI; ++ni) {
        const int m = mr + mi * 16 + l15, n = nc + ni * 16 + g * 4;
        float a = fmaxf(acc[mi][ni][0], 0.f), b = fmaxf(acc[mi][ni][1], 0.f), c = fmaxf(acc[mi][ni][2], 0.f), d = fmaxf(acc[mi][ni][3], 0.f);
        st4bf(abuf + (size_t)m * 4096 + n, a * a, b * b, c * c, d * d);
      }
  }
};
struct EpiF32 {
  float* dst; int ld;
  template <int MI, int NI> DI void run(f32x4 (&acc)[MI][NI], int mr, int nc, int l15, int g) {
#pragma unroll
    for (int mi = 0; mi < MI; ++mi)
#pragma unroll
      for (int ni = 0; ni < NI; ++ni) {
        const int m = mr + mi * 16 + l15, n = nc + ni * 16 + g * 4;
        float4 o; o.x = acc[mi][ni][0]; o.y = acc[mi][ni][1]; o.z = acc[mi][ni][2]; o.w = acc[mi][ni][3];
        *(float4*)(dst + (size_t)m * ld + n) = o;
      }
  }
};

DI void rope128(f32x4 (&v)[8], int rowp, int colp, int g, const float* cosT, const float* sinT) {
#pragma unroll
  for (int hf = 0; hf < 2; ++hf) {
    const int pos = hf ? colp : rowp;
#pragma unroll
    for (int a = 0; a < 2; ++a) {
      const int n1 = hf * 4 + a, n2 = n1 + 2;
      const float4 cs = *(const float4*)(cosT + pos * 32 + a * 16 + g * 4);
      const float4 sn = *(const float4*)(sinT + pos * 32 + a * 16 + g * 4);
      const float c4[4] = {cs.x, cs.y, cs.z, cs.w}, s4[4] = {sn.x, sn.y, sn.z, sn.w};
#pragma unroll
      for (int j = 0; j < 4; ++j) { const float x1 = v[n1][j], x2 = v[n2][j]; v[n1][j] = x1 * c4[j] - x2 * s4[j]; v[n2][j] = x1 * s4[j] + x2 * c4[j]; }
    }
  }
}
DI void rope64(f32x4* v, int rowp, int colp, int g, const float* cosT, const float* sinT) {
#pragma unroll
  for (int hf = 0; hf < 2; ++hf) {
    const int pos = hf ? colp : rowp;
    const int n1 = hf * 2, n2 = n1 + 1;
    const float4 cs = *(const float4*)(cosT + pos * 16 + g * 4);
    const float4 sn = *(const float4*)(sinT + pos * 16 + g * 4);
    const float c4[4] = {cs.x, cs.y, cs.z, cs.w}, s4[4] = {sn.x, sn.y, sn.z, sn.w};
#pragma unroll
    for (int j = 0; j < 4; ++j) { const float x1 = v[n1][j], x2 = v[n2][j]; v[n1][j] = x1 * c4[j] - x2 * s4[j]; v[n2][j] = x1 * s4[j] + x2 * c4[j]; }
  }
}

struct EpiGqaIn {
  u16* Q; u16* Kb; u16* Vt; const float* qg; const float* kg; const float* cosT; const float* sinT; float* out;
  template <int MI, int NI> DI void run(f32x4 (&acc)[MI][NI], int mr, int nc, int l15, int g) {
    const int nt = nc >> 7;
#pragma unroll
    for (int mi = 0; mi < MI; ++mi) {
      const int m = mr + mi * 16 + l15;
      const bool prompt = m < NPROMPT;
      const int s = prompt ? (m & 255) : ((m - NPROMPT) & 2047);
      const int rowp = s >> 6, colp = s & 63;
      const int kvrow = kvrow_of_tok(m);
      if (nt < 10) {
        float ss = 0.f;
#pragma unroll
        for (int ni = 0; ni < NI; ++ni)
#pragma unroll
          for (int j = 0; j < 4; ++j) ss += acc[mi][ni][j] * acc[mi][ni][j];
        ss = sum_g(ss);
        const float rs = rsqrtf(ss * (1.f / 128.f) + EPS);
        const float* gn = nt < 8 ? qg : kg;
#pragma unroll
        for (int ni = 0; ni < NI; ++ni) {
          const float4 gv = *(const float4*)(gn + ni * 16 + g * 4);
          acc[mi][ni][0] *= rs * gv.x; acc[mi][ni][1] *= rs * gv.y; acc[mi][ni][2] *= rs * gv.z; acc[mi][ni][3] *= rs * gv.w;
        }
        if (nt >= 8 && prompt) {
#pragma unroll
          for (int ni = 0; ni < NI; ++ni) { float4 o; o.x = acc[mi][ni][0]; o.y = acc[mi][ni][1]; o.z = acc[mi][ni][2]; o.w = acc[mi][ni][3]; *(float4*)(out + O_GK + (size_t)m * 256 + (nt - 8) * 128 + ni * 16 + g * 4) = o; }
        }
        if (!prompt) rope128(acc[mi], rowp, colp, g, cosT, sinT);
        u16* dst = nt < 8 ? Q + (size_t)m * 1024 + nt * 128 : Kb + (size_t)kvrow * 256 + (nt - 8) * 128;
#pragma unroll
        for (int ni = 0; ni < NI; ++ni) st4bf(dst + ni * 16 + g * 4, acc[mi][ni][0], acc[mi][ni][1], acc[mi][ni][2], acc[mi][ni][3]);
      } else {
        const int kvh = nt - 10;
        if (prompt) {
#pragma unroll
          for (int ni = 0; ni < NI; ++ni) { float4 o; o.x = acc[mi][ni][0]; o.y = acc[mi][ni][1]; o.z = acc[mi][ni][2]; o.w = acc[mi][ni][3]; *(float4*)(out + O_GV + (size_t)m * 256 + kvh * 128 + ni * 16 + g * 4) = o; }
        }
        size_t base; int kvlen, pos;
        if (prompt) { base = (size_t)(m >> 8) * 256 * 256; kvlen = 256; pos = m & 255; }
        else { const int b = (m - NPROMPT) >> 11; base = (size_t)(NPROMPT + b * 2560) * 256; kvlen = 2560; pos = 512 + s; }
#pragma unroll
        for (int ni = 0; ni < NI; ++ni)
#pragma unroll
          for (int j = 0; j < 4; ++j) Vt[base + (size_t)(kvh * 128 + ni * 16 + g * 4 + j) * kvlen + pos] = f2bf(acc[mi][ni][j]);
      }
    }
  }
};
struct EpiMlaUq {
  u16* Q; const float* gnope; const float* grope; const float* cosT; const float* sinT;
  template <int MI, int NI> DI void run(f32x4 (&acc)[MI][NI], int mr, int nc, int l15, int g) {
    const int nt = nc >> 7;
#pragma unroll
    for (int mi = 0; mi < MI; ++mi) {
      const int m = mr + mi * 16 + l15;
      const bool prompt = m < NPROMPT;
      const int s = prompt ? (m & 255) : ((m - NPROMPT) & 2047);
      const int rowp = s >> 6, colp = s & 63;
      if (nt < 8) {
        float ss = 0.f;
#pragma unroll
        for (int ni = 0; ni < NI; ++ni)
#pragma unroll
          for (int j = 0; j < 4; ++j) ss += acc[mi][ni][j] * acc[mi][ni][j];
        ss = sum_g(ss);
        const float rs = rsqrtf(ss * (1.f / 128.f) + EPS);
#pragma unroll
        for (int ni = 0; ni < NI; ++ni) {
          const float4 gv = *(const float4*)(gnope + ni * 16 + g * 4);
          st4bf(Q + (size_t)m * 1536 + nt * 192 + ni * 16 + g * 4, acc[mi][ni][0] * rs * gv.x, acc[mi][ni][1] * rs * gv.y, acc[mi][ni][2] * rs * gv.z, acc[mi][ni][3] * rs * gv.w);
        }
      } else {
#pragma unroll
        for (int hh = 0; hh < 2; ++hh) {
          const int h = (nt - 8) * 2 + hh;
          float ss = 0.f;
#pragma unroll
          for (int ni = 0; ni < 4; ++ni)
#pragma unroll
            for (int j = 0; j < 4; ++j) ss += acc[mi][hh * 4 + ni][j] * acc[mi][hh * 4 + ni][j];
          ss = sum_g(ss);
          const float rs = rsqrtf(ss * (1.f / 64.f) + EPS);
#pragma unroll
          for (int ni = 0; ni < 4; ++ni) {
            const float4 gv = *(const float4*)(grope + ni * 16 + g * 4);
            acc[mi][hh * 4 + ni][0] *= rs * gv.x; acc[mi][hh * 4 + ni][1] *= rs * gv.y; acc[mi][hh * 4 + ni][2] *= rs * gv.z; acc[mi][hh * 4 + ni][3] *= rs * gv.w;
          }
          if (!prompt) rope64(&acc[mi][hh * 4], rowp, colp, g, cosT, sinT);
#pragma unroll
          for (int ni = 0; ni < 4; ++ni)
            st4bf(Q + (size_t)m * 1536 + h * 192 + 128 + ni * 16 + g * 4, acc[mi][hh * 4 + ni][0], acc[mi][hh * 4 + ni][1], acc[mi][hh * 4 + ni][2], acc[mi][hh * 4 + ni][3]);
        }
      }
    }
  }
};
struct EpiMlaUkv {
  u16* Kb; u16* Vt; const float* gnope;
  template <int MI, int NI> DI void run(f32x4 (&acc)[MI][NI], int mr, int nc, int l15, int g) {
    const int nt = nc >> 7, h = nt >> 1;
#pragma unroll
    for (int mi = 0; mi < MI; ++mi) {
      const int m = mr + mi * 16 + l15;
      if ((nt & 1) == 0) {
        float ss = 0.f;
#pragma unroll
        for (int ni = 0; ni < NI; ++ni)
#pragma unroll
          for (int j = 0; j < 4; ++j) ss += acc[mi][ni][j] * acc[mi][ni][j];
        ss = sum_g(ss);
        const float rs = rsqrtf(ss * (1.f / 128.f) + EPS);
#pragma unroll
        for (int ni = 0; ni < NI; ++ni) {
          const float4 gv = *(const float4*)(gnope + ni * 16 + g * 4);
          st4bf(Kb + (size_t)m * 1536 + h * 192 + ni * 16 + g * 4, acc[mi][ni][0] * rs * gv.x, acc[mi][ni][1] * rs * gv.y, acc[mi][ni][2] * rs * gv.z, acc[mi][ni][3] * rs * gv.w);
        }
      } else {
        size_t base; int kvlen, pos;
        if (m < NPROMPT) { base = (size_t)(m >> 8) * 256 * 1024; kvlen = 256; pos = m & 255; }
        else { const int r = m - NPROMPT; const int b = r / 2560; base = (size_t)(NPROMPT + b * 2560) * 1024; kvlen = 2560; pos = r - b * 2560; }
#pragma unroll
        for (int ni = 0; ni < NI; ++ni)
#pragma unroll
          for (int j = 0; j < 4; ++j) Vt[base + (size_t)(h * 128 + ni * 16 + g * 4 + j) * kvlen + pos] = f2bf(acc[mi][ni][j]);
      }
    }
  }
};

DI void convert_tile(const float* __restrict__ W, int K, int N, u16* __restrict__ Bt, int tile, int perm, float* sT) {
  const int nkt = K >> 6;
  const int kt = tile % nkt, nt = tile / nkt;
  const int k0 = kt * 64, n0 = nt * 64;
  const int tid = opaque_tid();
  __syncthreads();
  {
    const int n = tid & 63, kq = tid >> 6;
    int nd = n0 + n, ns = nd;
    if (perm == 1) { if (nd < 1024) ns = (nd >> 7) * 192 + (nd & 127); else { const int x = nd - 1024; ns = (x >> 6) * 192 + 128 + (x & 63); } }
    const bool ok = nd < N;
#pragma unroll
    for (int r = 0; r < 16; ++r) { const int k = r * 4 + kq; sT[k * 65 + n] = ok ? W[(size_t)(k0 + k) * N + ns] : 0.f; }
  }
  __syncthreads();
  {
    const int n = tid >> 2, kq = (tid & 3) * 16;
    u32x4 a, b;
#pragma unroll
    for (int e = 0; e < 4; ++e) { a[e] = pack2(sT[(kq + 2 * e) * 65 + n], sT[(kq + 2 * e + 1) * 65 + n]); b[e] = pack2(sT[(kq + 8 + 2 * e) * 65 + n], sT[(kq + 9 + 2 * e) * 65 + n]); }
    u16* dst = Bt + (size_t)(n0 + n) * K + k0 + kq;
    *(u32x4*)dst = a; *(u32x4*)(dst + 8) = b;
  }
}

DI void norm_rows(const P& p, int layer, bool from_input, int item, const float* gnorm, int shift_idx, int scale_idx) {
  const int tidn = opaque_tid();
  char* const ws = opaque_ptr(p.ws);
  const int lane = tidn & 63, wid = tidn >> 6;
  const int t = item * 4 + wid;
  const float* x = from_input ? (t < NPROMPT ? p.in[0] + (size_t)t * 1024 : p.in[1] + (size_t)(t - NPROMPT) * 1024) : p.out + (size_t)t * 1024;
  const float* mods = (const float*)(ws + WS_MODS) + ((size_t)layer * 9 + cond_of(t)) * 6144;
  u16* h = (u16*)(ws + WS_HBUF) + (size_t)t * 1024;
  float4 v[4]; float ss = 0.f;
#pragma unroll
  for (int e = 0; e < 4; ++e) { v[e] = *(const float4*)(x + e * 256 + lane * 4); ss += v[e].x * v[e].x + v[e].y * v[e].y + v[e].z * v[e].z + v[e].w * v[e].w; }
  ss = wave_sum(ss);
  const float rs = rsqrtf(ss * (1.f / 1024.f) + EPS);
#pragma unroll
  for (int e = 0; e < 4; ++e) {
    const int c = e * 256 + lane * 4;
    const float4 gv = *(const float4*)(gnorm + c);
    const float4 sc = *(const float4*)(mods + scale_idx * 1024 + c);
    const float4 sh = *(const float4*)(mods + shift_idx * 1024 + c);
    st4bf(h + c, v[e].x * rs * gv.x * (1.f + sc.x) + sh.x, v[e].y * rs * gv.y * (1.f + sc.y) + sh.y, v[e].z * rs * gv.z * (1.f + sc.z) + sh.z, v[e].w * rs * gv.w * (1.f + sc.w) + sh.w);
  }
}

template <int DK, int HK>
DI void attn_phase(const u16* __restrict__ Q, const u16* __restrict__ Kb, const u16* __restrict__ Vt, u16* __restrict__ obuf, char* smem_raw) {
  const int bid = opaque_bid();
  constexpr int KS = DK / 32, KSTR = DK + 8, QSTR = 8 * DK, KROW = HK * DK, GRP = 8 / HK;
  constexpr int CPR = DK / 8;
  constexpr int KCH = 64 * CPR / 256;
  u16* sK = (u16*)smem_raw;
  u16* sV = sK + 64 * KSTR;
  const int tid = opaque_tid(), lane = tid & 63, wid = tid >> 6, l15 = lane & 15, g = lane >> 4;
  const float sc = rsqrtf((float)DK) * 1.4426950408889634f;
  for (int item = bid; item < 1280; item += gridDim.x) {
    int qb, h, kvlen, tokbase, kvbase;
    if (item < 1024) { const int b = item >> 7, rem = item & 127; h = rem & 7; qb = rem >> 3; kvlen = 2560; tokbase = NPROMPT + b * 2048; kvbase = NPROMPT + b * 2560; }
    else { const int it2 = item - 1024; const int b = it2 >> 4, rem = it2 & 15; h = rem & 7; qb = rem >> 3; kvlen = 256; tokbase = b * 256; kvbase = b * 256; }
    const int kvh = h / GRP;
    const u16* Kp = Kb + (size_t)kvbase * KROW + kvh * DK;
    const u16* Vp = Vt + (size_t)kvbase * (HK * 128) + (size_t)kvh * 128 * kvlen;
    const int qrow0 = tokbase + qb * 128 + wid * 32;
    bf16x8 qf[2][KS];
#pragma unroll
    for (int qi = 0; qi < 2; ++qi)
#pragma unroll
      for (int ks = 0; ks < KS; ++ks) qf[qi][ks] = ld8(Q + (size_t)(qrow0 + qi * 16 + l15) * QSTR + h * DK + ks * 32 + g * 8);
    f32x4 ot[2][8];
#pragma unroll
    for (int qi = 0; qi < 2; ++qi)
#pragma unroll
      for (int dj = 0; dj < 8; ++dj) { ot[qi][dj][0] = 0.f; ot[qi][dj][1] = 0.f; ot[qi][dj][2] = 0.f; ot[qi][dj][3] = 0.f; }
    float mrun[2] = {-1e30f, -1e30f}, lrun[2] = {0.f, 0.f};
    const int ntiles = kvlen >> 6;
    const unsigned toffK = (unsigned)((tid >> 3) * KROW + (tid & 7) * 8), toffV = (unsigned)((tid >> 3) * kvlen + (tid & 7) * 8);
    const int ldsoffK = (tid >> 3) * KSTR + (tid & 7) * 8, ldsoffV = (tid >> 3) * 72 + (tid & 7) * 8;
    u32x4 rk[KCH], rv[4];
#pragma unroll
    for (int i = 0; i < KCH; ++i) { const int rh = i & 1, cgp = i >> 1; rk[i] = *(const u32x4*)(Kp + (size_t)(rh * 32 * KROW + cgp * 64) + toffK); }
#pragma unroll
    for (int i = 0; i < 4; ++i) rv[i] = *(const u32x4*)(Vp + (size_t)i * 32 * kvlen + toffV);
    for (int kt = 0; kt < ntiles; ++kt) {
      const u16* Kt = Kp + (size_t)(kt + 1) * 64 * KROW;
      const u16* Vtp = Vp + (kt + 1) * 64;
      const bool more = kt + 1 < ntiles;
      __syncthreads();
#pragma unroll
      for (int i = 0; i < KCH; ++i) { const int rh = i & 1, cgp = i >> 1; *(u32x4*)(sK + ldsoffK + rh * 32 * KSTR + cgp * 64) = rk[i]; }
#pragma unroll
      for (int i = 0; i < 4; ++i) *(u32x4*)(sV + ldsoffV + i * 32 * 72) = rv[i];
      __syncthreads();
      if (more) {
#pragma unroll
        for (int i = 0; i < KCH; ++i) { const int rh = i & 1, cgp = i >> 1; rk[i] = *(const u32x4*)(Kt + (size_t)(rh * 32 * KROW + cgp * 64) + toffK); }
      }
      __builtin_amdgcn_sched_barrier(0);
      f32x4 st[2][4];
#pragma unroll
      for (int qi = 0; qi < 2; ++qi)
#pragma unroll
        for (int kj = 0; kj < 4; ++kj) { st[qi][kj][0] = 0.f; st[qi][kj][1] = 0.f; st[qi][kj][2] = 0.f; st[qi][kj][3] = 0.f; }
#pragma unroll
      for (int ks = 0; ks < KS; ++ks) {
#pragma unroll
        for (int kj = 0; kj < 4; ++kj) {
          const bf16x8 ka = ld8(sK + (kj * 16 + l15) * KSTR + ks * 32 + g * 8);
          st[0][kj] = mma(ka, qf[0][ks], st[0][kj]);
          st[1][kj] = mma(ka, qf[1][ks], st[1][kj]);
        }
        __builtin_amdgcn_sched_barrier(0);
      }
      bf16x8 pf[2][2];
#pragma unroll
      for (int qi = 0; qi < 2; ++qi) {
        float mx = -1e30f;
#pragma unroll
        for (int kj = 0; kj < 4; ++kj)
#pragma unroll
          for (int r = 0; r < 4; ++r) mx = fmaxf(mx, st[qi][kj][r]);
        mx = fmaxf(mx, __shfl_xor(mx, 16)); mx = fmaxf(mx, __shfl_xor(mx, 32));
        const float mnew = fmaxf(mrun[qi], mx);
        const float alpha = __builtin_amdgcn_exp2f((mrun[qi] - mnew) * sc);
        mrun[qi] = mnew;
        float ps = 0.f;
#pragma unroll
        for (int kj = 0; kj < 4; ++kj)
#pragma unroll
          for (int r = 0; r < 4; ++r) { const float pv = __builtin_amdgcn_exp2f((st[qi][kj][r] - mnew) * sc); st[qi][kj][r] = pv; ps += pv; }
        lrun[qi] = lrun[qi] * alpha + ps;
#pragma unroll
        for (int dj = 0; dj < 8; ++dj) { ot[qi][dj][0] *= alpha; ot[qi][dj][1] *= alpha; ot[qi][dj][2] *= alpha; ot[qi][dj][3] *= alpha; }
        pf[qi][0] = pack8(st[qi][0], st[qi][1]);
        pf[qi][1] = pack8(st[qi][2], st[qi][3]);
        __builtin_amdgcn_sched_barrier(0);
      }
      if (more) {
#pragma unroll
        for (int i = 0; i < 4; ++i) rv[i] = *(const u32x4*)(Vtp + (size_t)i * 32 * kvlen + toffV);
      }
      __builtin_amdgcn_sched_barrier(0);
#pragma unroll
      for (int kk = 0; kk < 2; ++kk)
#pragma unroll
        for (int dj = 0; dj < 8; ++dj) {
          const u16* vp = sV + (dj * 16 + l15) * 72 + kk * 32 + g * 4;
          const bf16x8 va = ld44(vp, vp + 16);
          ot[0][dj] = mma(va, pf[0][kk], ot[0][dj]);
          ot[1][dj] = mma(va, pf[1][kk], ot[1][dj]);
          if ((dj & 3) == 3) __builtin_amdgcn_sched_barrier(0);
        }
    }
#pragma unroll
    for (int qi = 0; qi < 2; ++qi) {
      const float inv = 1.f / sum_g(lrun[qi]);
      u16* dst = obuf + (size_t)(qrow0 + qi * 16 + l15) * 1024 + h * 128 + g * 4;
#pragma unroll
      for (int dj = 0; dj < 8; ++dj) st4bf(dst + dj * 16, ot[qi][dj][0] * inv, ot[qi][dj][1] * inv, ot[qi][dj][2] * inv, ot[qi][dj][3] * inv);
    }
  }
}

DI void gdn_chunk_phase(const P& p, int j, char* smem_raw) {
  const int bid = opaque_bid();
  char* const ws = opaque_ptr(p.ws);
  u16* sK = (u16*)smem_raw;
  float* sA = (float*)(smem_raw + 17408);
  float* sG = (float*)(smem_raw + 17408 + 32768);
  float* sBt = sG + 128;
  const int tid = opaque_tid(), lane = tid & 63, wid = tid >> 6, l15 = lane & 15, g = lane >> 4;
  const u16* proj = (const u16*)(ws + WS_R + R_PROJ);
  u16* qn = (u16*)(ws + WS_HBUF); u16* kn = (u16*)(ws + WS_OBUF); u16* vb = (u16*)(ws + WS_R + R_VBUF);
  u16* Tbuf = (u16*)(ws + WS_R + R_TBUF);
  const float* gbuf = (const float*)(ws + WS_R + R_GBUF);
  float* gcb = (float*)(ws + WS_R + R_GCB); float* betab = (float*)(ws + WS_R + R_BETA);
  const float* conv = p.in[17] + (size_t)j * 3 * 3072;
  const float* a_log = p.in[18] + j * 16; const float* dt_bias = p.in[19] + j * 16;
  for (int unit = bid; unit < 2560; unit += gridDim.x) {
    const int cgi = unit >> 3, h = unit & 7;
    int c, nch; if (cgi < 64) { c = cgi & 3; nch = 4; } else { c = (cgi - 64) & 31; nch = 32; }
    const int t0 = cgi * 64;
    const bool has_prev = c > 0, has_next = c < nch - 1;
    __syncthreads();
    {
      const int r = tid >> 4, cc = (tid & 15) * 8;
#pragma unroll
      for (int part = 0; part < 3; ++part) {
        const int ch = part * 1024 + h * 128 + cc;
        float w0[8], w1[8], w2[8];
#pragma unroll
        for (int e = 0; e < 8; ++e) { w0[e] = conv[ch + e]; w1[e] = conv[3072 + ch + e]; w2[e] = conv[6144 + ch + e]; }
        u16* dstb = part == 0 ? qn : (part == 1 ? kn : vb);
        for (int it = 0; it < 4; ++it) {
          const int i = it * 16 + r, t = t0 + i;
          const u16* src = proj + (size_t)t * 4096 + ch;
          const u32x4 xc = *(const u32x4*)src;
          u32x4 xp = {0u, 0u, 0u, 0u}, xn = {0u, 0u, 0u, 0u};
          if (i > 0 || has_prev) xp = *(const u32x4*)(src - 4096);
          if (i < 63 || has_next) xn = *(const u32x4*)(src + 4096);
          float y[8];
#pragma unroll
          for (int e = 0; e < 4; ++e) {
            float a = w0[2 * e] * bflo(xp[e]) + w1[2 * e] * bflo(xc[e]) + w2[2 * e] * bflo(xn[e]);
            float b = w0[2 * e + 1] * bfhi(xp[e]) + w1[2 * e + 1] * bfhi(xc[e]) + w2[2 * e + 1] * bfhi(xn[e]);
            y[2 * e] = a / (1.f + __expf(-a)); y[2 * e + 1] = b / (1.f + __expf(-b));
          }
          if (part < 2) {
            float ss = 0.f;
#pragma unroll
            for (int e = 0; e < 8; ++e) ss += y[e] * y[e];
            ss += __shfl_xor(ss, 1); ss += __shfl_xor(ss, 2); ss += __shfl_xor(ss, 4); ss += __shfl_xor(ss, 8);
            const float rs = rsqrtf(ss + EPS) * (part == 0 ? 0.08838834764831845f : 1.f);
#pragma unroll
            for (int e = 0; e < 8; ++e) y[e] *= rs;
          }
          u32x4 o; o[0] = pack2(y[0], y[1]); o[1] = pack2(y[2], y[3]); o[2] = pack2(y[4], y[5]); o[3] = pack2(y[6], y[7]);
          *(u32x4*)(dstb + (size_t)t * 1024 + h * 128 + cc) = o;
          if (part == 1) *(u32x4*)(sK + i * 136 + cc) = o;
        }
      }
    }
    if (tid < 128) {
      const int dir = tid >> 6, L = tid & 63;
      const int i = dir ? 63 - L : L;
      const float* gb = gbuf + (size_t)(t0 + i) * 32;
      const float gin = gb[dir * 8 + h], bin = gb[16 + dir * 8 + h];
      const float x = gin + dt_bias[dir * 8 + h];
      const float sp = fmaxf(x, 0.f) + log1pf(expf(-fabsf(x)));
      float gv = -expf(a_log[dir * 8 + h]) * sp;
      const float bt = 1.f / (1.f + expf(-bin));
#pragma unroll
      for (int off = 1; off < 64; off <<= 1) { const float v = __shfl_up(gv, off); if (L >= off) gv += v; }
      sG[dir * 64 + i] = gv; sBt[dir * 64 + i] = bt;
      gcb[((size_t)(t0 + i) * 8 + h) * 2 + dir] = gv; betab[((size_t)(t0 + i) * 8 + h) * 2 + dir] = bt;
    }
    __syncthreads();
    {
      f32x4 ga[4];
#pragma unroll
      for (int mt = 0; mt < 4; ++mt) { ga[mt][0] = 0.f; ga[mt][1] = 0.f; ga[mt][2] = 0.f; ga[mt][3] = 0.f; }
#pragma unroll
      for (int ks = 0; ks < 4; ++ks) {
        const bf16x8 a = ld8(sK + (wid * 16 + l15) * 136 + ks * 32 + g * 8);
#pragma unroll
        for (int mt = 0; mt < 4; ++mt) { const bf16x8 b = ld8(sK + (mt * 16 + l15) * 136 + ks * 32 + g * 8); ga[mt] = mma(a, b, ga[mt]); }
      }
#pragma unroll
      for (int dir = 0; dir < 2; ++dir)
#pragma unroll
        for (int mt = 0; mt < 4; ++mt)
#pragma unroll
          for (int r = 0; r < 4; ++r) {
            const int i = wid * 16 + g * 4 + r, m = mt * 16 + l15;
            const bool valid = dir ? (i < m) : (i > m);
            const float val = valid ? sBt[dir * 64 + i] * ga[mt][r] * __expf(sG[dir * 64 + i] - sG[dir * 64 + m]) : 0.f;
            const int ii = dir ? 63 - i : i, mm = dir ? 63 - m : m;
            sA[dir * 4096 + ii * 64 + mm] = val;
          }
    }
    __syncthreads();
    if (wid < 2) {
      const int dir = wid;
      float* Am = sA + dir * 4096;
      for (int i = 0; i < 64; ++i) {
        float a = (i == lane) ? 1.f : 0.f;
        int m = 0;
        for (; m + 8 <= i; m += 8) {
          const float4 a0 = *(const float4*)(Am + i * 64 + m), a1 = *(const float4*)(Am + i * 64 + m + 4);
          float tv[8];
#pragma unroll
          for (int e = 0; e < 8; ++e) tv[e] = Am[(m + e) * 64 + lane];
          a -= a0.x * tv[0]; a -= a0.y * tv[1]; a -= a0.z * tv[2]; a -= a0.w * tv[3];
          a -= a1.x * tv[4]; a -= a1.y * tv[5]; a -= a1.z * tv[6]; a -= a1.w * tv[7];
        }
        for (; m < i; ++m) a -= Am[i * 64 + m] * Am[m * 64 + lane];
        Am[i * 64 + lane] = a;
      }
      const int mn = dir ? 63 - lane : lane;
      const float bm = sBt[dir * 64 + mn];
      u16* Td = Tbuf + ((size_t)unit * 2 + dir) * 4096;
#pragma unroll 4
      for (int i = 0; i < 64; ++i) { const int in_ = dir ? 63 - i : i; Td[in_ * 64 + mn] = f2bf(Am[i * 64 + lane] * bm); }
    }
  }
}

DI void gdn_scan_phase(const P& p, int j, char* smem_raw) {
  const int bid = opaque_bid();
  char* const ws = opaque_ptr(p.ws);
  u16* sK = (u16*)smem_raw;
  u16* sKT = sK + 64 * 136;
  u16* sVT = sKT + 128 * 72;
  u16* sST = sVT + 32 * 72;
  u16* sVN = sST + 32 * 136;
  u16* sVD = sVN + 32 * 72;
  float* sGc = (float*)(sVD + 32 * 72);
  const int tid = opaque_tid(), lane = tid & 63, w = tid >> 6, l15 = lane & 15, g = lane >> 4;
  const u16* qn = (const u16*)(ws + WS_HBUF); const u16* kn = (const u16*)(ws + WS_OBUF); const u16* vb = (const u16*)(ws + WS_R + R_VBUF);
  const u16* Tbuf = (const u16*)(ws + WS_R + R_TBUF);
  const float* gcb = (const float*)(ws + WS_R + R_GCB);
  u16* obase = (u16*)(ws + WS_R + R_PROJ);
  for (int wk = bid; wk < 1536; wk += gridDim.x) {
    int seq, rem;
    if (wk < 512) { seq = 16 + (wk >> 6); rem = wk & 63; } else { seq = (wk - 512) >> 6; rem = (wk - 512) & 63; }
    const int h = rem >> 3, dir = (rem >> 2) & 1, dvq = rem & 3;
    const int nch = seq < 16 ? 4 : 32;
    const int cgb = seq < 16 ? seq * 4 : 64 + (seq - 16) * 32;
    f32x4 S[2][2];
    if (seq >= 16) {
      const float* s0 = p.in[2 + dir] + (((size_t)(seq - 16) * 2 + j) * 8 + h) * 16384;
#pragma unroll
      for (int dt = 0; dt < 2; ++dt)
#pragma unroll
        for (int et = 0; et < 2; ++et)
#pragma unroll
          for (int r = 0; r < 4; ++r) S[dt][et][r] = s0[(size_t)(w * 32 + dt * 16 + g * 4 + r) * 128 + dvq * 32 + et * 16 + l15];
    } else {
#pragma unroll
      for (int dt = 0; dt < 2; ++dt)
#pragma unroll
        for (int et = 0; et < 2; ++et) { S[dt][et][0] = 0.f; S[dt][et][1] = 0.f; S[dt][et][2] = 0.f; S[dt][et][3] = 0.f; }
    }
    __syncthreads();
#pragma unroll
    for (int dt = 0; dt < 2; ++dt)
#pragma unroll
      for (int et = 0; et < 2; ++et) st4bf(sST + (et * 16 + l15) * 136 + w * 32 + dt * 16 + g * 4, S[dt][et][0], S[dt][et][1], S[dt][et][2], S[dt][et][3]);
    u32x4 pk[4], pv; bf16x8 pq[4], pt[2]; float pg = 0.f;
#define SCAN_PREFETCH(cc) do { \
      const int t0n_ = (cgb + (cc)) * 64; const int unitn_ = (cgb + (cc)) * 8 + h; \
      _Pragma("unroll") for (int i = 0; i < 4; ++i) { const int row = tid & 63, dc = ((tid >> 6) + 4 * i) * 8; pk[i] = *(const u32x4*)(kn + (size_t)(t0n_ + row) * 1024 + h * 128 + dc); } \
      { const int row = tid & 63, ec = (tid >> 6) * 8; pv = *(const u32x4*)(vb + (size_t)(t0n_ + row) * 1024 + h * 128 + dvq * 32 + ec); } \
      if (tid < 64) pg = gcb[((size_t)(t0n_ + tid) * 8 + h) * 2 + dir]; \
      _Pragma("unroll") for (int ks = 0; ks < 4; ++ks) pq[ks] = ld8(qn + (size_t)(t0n_ + w * 16 + l15) * 1024 + h * 128 + ks * 32 + g * 8); \
      _Pragma("unroll") for (int ks = 0; ks < 2; ++ks) pt[ks] = ld8(Tbuf + ((size_t)unitn_ * 2 + dir) * 4096 + (w * 16 + l15) * 64 + ks * 32 + g * 8); \
    } while (0)
    SCAN_PREFETCH(dir ? nch - 1 : 0);
    for (int step = 0; step < nch; ++step) {
      const int c = dir ? nch - 1 - step : step;
      const int t0 = (cgb + c) * 64;
      const int unit = (cgb + c) * 8 + h;
#pragma unroll
      for (int i = 0; i < 4; ++i) {
        const int row = tid & 63, dc = ((tid >> 6) + 4 * i) * 8;
        const u32x4 v = pk[i];
        *(u32x4*)(sK + row * 136 + dc) = v;
#pragma unroll
        for (int e = 0; e < 4; ++e) { sKT[(dc + 2 * e) * 72 + row] = (u16)(v[e] & 0xffffu); sKT[(dc + 2 * e + 1) * 72 + row] = (u16)(v[e] >> 16); }
      }
      {
        const int row = tid & 63, ec = (tid >> 6) * 8;
        const u32x4 v = pv;
#pragma unroll
        for (int e = 0; e < 4; ++e) { sVT[(ec + 2 * e) * 72 + row] = (u16)(v[e] & 0xffffu); sVT[(ec + 2 * e + 1) * 72 + row] = (u16)(v[e] >> 16); }
      }
      if (tid < 64) sGc[tid] = pg;
      bf16x8 qf[4], tf[2];
#pragma unroll
      for (int ks = 0; ks < 4; ++ks) qf[ks] = pq[ks];
#pragma unroll
      for (int ks = 0; ks < 2; ++ks) tf[ks] = pt[ks];
      __syncthreads();
      if (step + 1 < nch) { const int cn = dir ? nch - 2 - step : step + 1; SCAN_PREFETCH(cn); }
      const float gl = dir ? sGc[0] : sGc[63];
      f32x4 ua[2];
#pragma unroll
      for (int et = 0; et < 2; ++et) {
        ua[et][0] = 0.f; ua[et][1] = 0.f; ua[et][2] = 0.f; ua[et][3] = 0.f;
#pragma unroll
        for (int ks = 0; ks < 2; ++ks) ua[et] = mma(tf[ks], ld8(sVT + (et * 16 + l15) * 72 + ks * 32 + g * 8), ua[et]);
      }
      bf16x8 tf2[2];
#pragma unroll
      for (int ks = 0; ks < 2; ++ks) {
        const u32x4 tw = __builtin_bit_cast(u32x4, tf[ks]);
        u32x4 o;
#pragma unroll
        for (int e = 0; e < 4; ++e) {
          const int m = ks * 32 + g * 8 + 2 * e;
          o[e] = pack2(bflo(tw[e]) * __expf(sGc[m]), bfhi(tw[e]) * __expf(sGc[m + 1]));
        }
        tf2[ks] = __builtin_bit_cast(bf16x8, o);
      }
      bf16x8 wf[4];
#pragma unroll
      for (int kq = 0; kq < 4; ++kq) {
        f32x4 wa[2];
#pragma unroll
        for (int hh = 0; hh < 2; ++hh) {
          const int dt = kq * 2 + hh;
          wa[hh][0] = 0.f; wa[hh][1] = 0.f; wa[hh][2] = 0.f; wa[hh][3] = 0.f;
#pragma unroll
          for (int ks = 0; ks < 2; ++ks) wa[hh] = mma(ld8(sKT + (dt * 16 + l15) * 72 + ks * 32 + g * 8), tf2[ks], wa[hh]);
        }
        wf[kq] = pack8(wa[0], wa[1]);
      }
      f32x4 vn[2];
#pragma unroll
      for (int et = 0; et < 2; ++et) {
        f32x4 a; a[0] = 0.f; a[1] = 0.f; a[2] = 0.f; a[3] = 0.f;
#pragma unroll
        for (int kq = 0; kq < 4; ++kq) { const u16* sp = sST + (et * 16 + l15) * 136 + kq * 32 + g * 4; a = mma(wf[kq], ld44(sp, sp + 16), a); }
        vn[et][0] = ua[et][0] - a[0]; vn[et][1] = ua[et][1] - a[1]; vn[et][2] = ua[et][2] - a[2]; vn[et][3] = ua[et][3] - a[3];
      }
      bf16x8 qkf[2];
      {
        const int iq = w * 16 + l15;
        const float gi = sGc[iq];
#pragma unroll
        for (int kk = 0; kk < 2; ++kk) {
          f32x4 ka[2];
#pragma unroll
          for (int hh = 0; hh < 2; ++hh) {
            const int mt = kk * 2 + hh;
            ka[hh][0] = 0.f; ka[hh][1] = 0.f; ka[hh][2] = 0.f; ka[hh][3] = 0.f;
#pragma unroll
            for (int ks = 0; ks < 4; ++ks) ka[hh] = mma(ld8(sK + (mt * 16 + l15) * 136 + ks * 32 + g * 8), qf[ks], ka[hh]);
#pragma unroll
            for (int r = 0; r < 4; ++r) {
              const int m = mt * 16 + g * 4 + r;
              const bool valid = dir ? (iq <= m) : (iq >= m);
              ka[hh][r] = valid ? ka[hh][r] * __expf(gi - sGc[m]) : 0.f;
            }
          }
          qkf[kk] = pack8(ka[0], ka[1]);
        }
      }
#pragma unroll
      for (int et = 0; et < 2; ++et) {
        const int i0 = w * 16 + g * 4;
        st4bf(sVN + (et * 16 + l15) * 72 + i0, vn[et][0], vn[et][1], vn[et][2], vn[et][3]);
        st4bf(sVD + (et * 16 + l15) * 72 + i0, vn[et][0] * __expf(gl - sGc[i0]), vn[et][1] * __expf(gl - sGc[i0 + 1]), vn[et][2] * __expf(gl - sGc[i0 + 2]), vn[et][3] * __expf(gl - sGc[i0 + 3]));
      }
      __syncthreads();
#pragma unroll
      for (int et = 0; et < 2; ++et) {
        f32x4 a1; a1[0] = 0.f; a1[1] = 0.f; a1[2] = 0.f; a1[3] = 0.f;
#pragma unroll
        for (int ks = 0; ks < 4; ++ks) a1 = mma(qf[ks], ld8(sST + (et * 16 + l15) * 136 + ks * 32 + g * 8), a1);
        f32x4 a2; a2[0] = 0.f; a2[1] = 0.f; a2[2] = 0.f; a2[3] = 0.f;
#pragma unroll
        for (int kk = 0; kk < 2; ++kk) { const u16* sp = sVN + (et * 16 + l15) * 72 + kk * 32 + g * 4; a2 = mma(qkf[kk], ld44(sp, sp + 16), a2); }
#pragma unroll
        for (int r = 0; r < 4; ++r) {
          const int i = w * 16 + g * 4 + r;
          const float o = a1[r] * __expf(sGc[i]) + a2[r];
          obase[(size_t)(t0 + i) * 4096 + dir * 1024 + h * 128 + dvq * 32 + et * 16 + l15] = f2bf(o);
        }
      }
      {
        const float eg = __expf(gl);
#pragma unroll
        for (int dt = 0; dt < 2; ++dt)
#pragma unroll
          for (int et = 0; et < 2; ++et) {
            f32x4 a; a[0] = S[dt][et][0] * eg; a[1] = S[dt][et][1] * eg; a[2] = S[dt][et][2] * eg; a[3] = S[dt][et][3] * eg;
#pragma unroll
            for (int kk = 0; kk < 2; ++kk) a = mma(ld8(sKT + (w * 32 + dt * 16 + l15) * 72 + kk * 32 + g * 8), ld8(sVD + (et * 16 + l15) * 72 + kk * 32 + g * 8), a);
            S[dt][et] = a;
          }
      }
      __syncthreads();
#pragma unroll
      for (int dt = 0; dt < 2; ++dt)
#pragma unroll
        for (int et = 0; et < 2; ++et) st4bf(sST + (et * 16 + l15) * 136 + w * 32 + dt * 16 + g * 4, S[dt][et][0], S[dt][et][1], S[dt][et][2], S[dt][et][3]);
    }
    if (seq < 16) {
      float* so = p.out + (dir ? O_SB : O_SF) + (((size_t)seq * 2 + j) * 8 + h) * 16384;
#pragma unroll
      for (int dt = 0; dt < 2; ++dt)
#pragma unroll
        for (int et = 0; et < 2; ++et)
#pragma unroll
          for (int r = 0; r < 4; ++r) so[(size_t)(w * 32 + dt * 16 + g * 4 + r) * 128 + dvq * 32 + et * 16 + l15] = S[dt][et][r];
    }
  }
}

#define XB_TMO      128
#define XB_XCNT(j)  (256  + 64 * (j))
#define XB_XSUB(j)  (1280 + 64 * (j))
#define XB_XGEN(j)  (2304 + 64 * (j))
#define XB_TOP      3328
#define XB_TOPGEN   3392
#define XCD_BAR_WORDS 3456
#define XB_SPIN_CAP (1u << 20)
#define LAS __attribute__((address_space(3)))
DI unsigned xb_ld(unsigned* p)              { return __hip_atomic_load(p, __ATOMIC_RELAXED, __HIP_MEMORY_SCOPE_AGENT); }
DI unsigned xb_add(unsigned* p, unsigned v) { return __hip_atomic_fetch_add(p, v, __ATOMIC_RELAXED, __HIP_MEMORY_SCOPE_AGENT); }
DI unsigned xb_xcc_id() { return (unsigned)__builtin_amdgcn_s_getreg((3 << 11) | 20) & 0xFu; }
#define XB_SPIN(cond, bar) do { unsigned _sp = 0; while (cond) { __builtin_amdgcn_s_sleep(1); \
    if ((++_sp & 255u) == 0u) { if (xb_ld(&(bar)[XB_TMO])) break; if (_sp > XB_SPIN_CAP) { atomicAdd(&(bar)[XB_TMO], 1u); break; } } } } while (0)
struct XcdBarrier { unsigned* bar; unsigned x; volatile LAS unsigned* st; };
DI XcdBarrier xcd_barrier_post(unsigned* bar, volatile LAS unsigned* st) {
  XcdBarrier b; b.bar = bar; b.x = xb_xcc_id(); b.st = st;
  if (threadIdx.x == 0) (void)xb_add(&bar[XB_XCNT(b.x)], 1u);
  return b;
}
DI void xcd_barrier_complete(unsigned* bar, unsigned x, unsigned& nloc, unsigned& nx) {
  const unsigned Gn = gridDim.x * gridDim.y * gridDim.z;
  unsigned sum, cnt, mine, sp = 0u;
  for (;;) {
    sum = 0u; cnt = 0u; mine = 0u;
#pragma unroll
    for (unsigned j = 0; j < 16; ++j) { const unsigned c = xb_ld(&bar[XB_XCNT(j)]); sum += c; cnt += (c > 0u) ? 1u : 0u; mine = (j == x) ? c : mine; }
    if (sum == Gn) break;
    __builtin_amdgcn_s_sleep(1);
    if ((++sp & 255u) == 0u) { if (xb_ld(&bar[XB_TMO])) break; if (sp > XB_SPIN_CAP) { atomicAdd(&bar[XB_TMO], 1u); break; } }
  }
  nloc = mine > 0u ? mine : 1u; nx = cnt > 0u ? cnt : 1u;
}
DI void xcd_barrier(const XcdBarrier& b) {
  asm volatile("s_waitcnt vmcnt(0)" ::: "memory");
  __syncthreads();
  if (threadIdx.x == 0) {
    unsigned* bar = b.bar;
    __builtin_amdgcn_s_waitcnt(0);
    unsigned nloc = b.st[0], nx = b.st[1];
    if (nloc == 0u) { xcd_barrier_complete(bar, b.x, nloc, nx); b.st[0] = nloc; b.st[1] = nx; }
    const unsigned old = xb_add(&bar[XB_XSUB(b.x)], 1u);
    const unsigned gen = old / nloc;
    if (old + 1u == (gen + 1u) * nloc) {
      __builtin_amdgcn_fence(__ATOMIC_RELEASE, "agent");
      asm volatile("s_waitcnt vmcnt(0)" ::: "memory");
      const unsigned og = xb_add(&bar[XB_TOP], 1u);
      const unsigned tg = og / nx;
      if (og + 1u == (tg + 1u) * nx) xb_add(&bar[XB_TOPGEN], 1u);
      else XB_SPIN(xb_ld(&bar[XB_TOPGEN]) == tg, bar);
      __builtin_amdgcn_fence(__ATOMIC_ACQUIRE, "agent");
      xb_add(&bar[XB_XGEN(b.x)], 1u);
      asm volatile("s_waitcnt vmcnt(0)" ::: "memory");
    } else {
      XB_SPIN(xb_ld(&bar[XB_XGEN(b.x)]) == gen, bar);
      __builtin_amdgcn_fence(__ATOMIC_ACQUIRE, "agent");
      asm volatile("s_waitcnt vmcnt(0)" ::: "memory");
    }
  }
  __syncthreads();
}

__global__ void __launch_bounds__(256, 2) fwd_megakernel(P p) {
  cg::grid_group grid = cg::this_grid();
  __shared__ __attribute__((aligned(16))) char smem[60416];
  const int tid = opaque_tid(), lane = tid & 63, wid = tid >> 6;
  const int G = gridDim.x;
  __shared__ uint4 xb_words;
  if (threadIdx.x == 0) xb_words = make_uint4(0u, 0u, 0u, 0u);
  __syncthreads();
  (void)xcd_barrier_post((unsigned*)(p.ws + WS_BAR), (volatile LAS unsigned*)&xb_words);
#define GSYNC() do { XcdBarrier xb_; xb_.bar = (unsigned*)(opaque_ptr(p.ws) + WS_BAR); xb_.x = xb_xcc_id(); xb_.st = (volatile LAS unsigned*)&xb_words; xcd_barrier(xb_); } while (0)
  const int bid0 = opaque_bid();
  {
  char* const ws0 = opaque_ptr(p.ws);
  float* mods = (float*)(ws0 + WS_MODS);
  float* ropeT = (float*)(ws0 + WS_ROPE);
  float* cosG = ropeT, *sinG = ropeT + 2048, *cosM = ropeT + 4096, *sinM = ropeT + 5120;

  {
    float* sc = (float*)smem;
    float* red = sc + 9 * 128;
    float* part = (float*)(ws0 + WS_R);
    for (int item = bid0; item < 3072; item += G) {
      const int ks = item & 7, cgp = (item >> 3) % 96, layer = item / 768;
      __syncthreads();
      for (int e = tid; e < 9 * 128; e += 256) {
        const int ci = e >> 7, k = ks * 128 + (e & 127);
        const float v = ci == 0 ? p.in[9][k] : p.in[8][(ci - 1) * 1024 + k];
        sc[e] = v / (1.f + expf(-v));
      }
      __syncthreads();
      const int col = tid & 63, kg = tid >> 6;
      const float* wp = p.in[12] + ((size_t)layer * 1024 + ks * 128 + kg * 32) * 6144 + cgp * 64 + col;
      float acc[9];
#pragma unroll
      for (int ci = 0; ci < 9; ++ci) acc[ci] = 0.f;
#pragma unroll 8
      for (int kk = 0; kk < 32; ++kk) {
        const float wv = wp[(size_t)kk * 6144];
#pragma unroll
        for (int ci = 0; ci < 9; ++ci) acc[ci] += sc[ci * 128 + kg * 32 + kk] * wv;
      }
#pragma unroll
      for (int ci = 0; ci < 9; ++ci) red[(kg * 64 + col) * 9 + ci] = acc[ci];
      __syncthreads();
      if (kg == 0) {
        const int n = cgp * 64 + col;
        const float bias = ks == 0 ? p.in[13][(size_t)layer * 6144 + n] : 0.f;
#pragma unroll
        for (int ci = 0; ci < 9; ++ci) {
          const float s = red[col * 9 + ci] + red[(64 + col) * 9 + ci] + red[(128 + col) * 9 + ci] + red[(192 + col) * 9 + ci] + bias;
          part[(size_t)ks * 221184 + ((size_t)layer * 9 + ci) * 6144 + n] = s;
        }
      }
    }
    if (bid0 == G - 1) {
      for (int e = tid; e < 2048; e += 256) { const int pos = e >> 5, f = e & 31; const float fr = powf(10000.f, -(float)f / 32.f); const float a = (float)pos * fr; cosG[e] = cosf(a); sinG[e] = sinf(a); }
      for (int e = tid; e < 1024; e += 256) { const int pos = e >> 4, f = e & 15; const float fr = powf(10000.f, -(float)f / 16.f); const float a = (float)pos * fr; cosM[e] = cosf(a); sinM[e] = sinf(a); }
    }
  }
  grid.sync();
  {
    const float* part = (const float*)(ws0 + WS_R);
    for (int e = bid0 * 256 + tid; e < 221184; e += G * 256) {
      float sacc = 0.f;
#pragma unroll
      for (int ks = 0; ks < 8; ++ks) sacc += part[(size_t)ks * 221184 + e];
      mods[e] = sacc;
    }
  }
  }
  GSYNC();

#pragma unroll 1
  for (int layer = 0; layer < 4; ++layer) {
    const int kind = layer % 3, j = layer / 3;
    const int bid = opaque_bid();
    char* const ws = opaque_ptr(p.ws);
    float* mods = (float*)(ws + WS_MODS);
    float* ropeT = (float*)(ws + WS_ROPE);
    float* cosG = ropeT, *sinG = ropeT + 2048, *cosM = ropeT + 4096, *sinM = ropeT + 5120;
    u16* hbuf = (u16*)(ws + WS_HBUF);
    u16* obuf = (u16*)(ws + WS_OBUF);
    u16* wmix = (u16*)(ws + WS_WMIX);
    u16* wmlp = (u16*)(ws + WS_WMLP);
    char* R = ws + WS_R;
    const float* lmods = mods + (size_t)layer * 9 * 6144;
    {
      for (int it = bid; it < 5120; it += G) norm_rows(p, layer, layer == 0, it, p.in[10] + layer * 1024, 0, 1);
      float* sT = (float*)smem;
      for (int it = bid; it < 2048; it += G) {
        if (it < 1024) convert_tile(p.in[14] + (size_t)layer * 1024 * 4096, 1024, 4096, wmlp, it, 0, sT);
        else convert_tile(p.in[15] + (size_t)layer * 4096 * 1024, 4096, 1024, wmlp + 4194304, it - 1024, 0, sT);
      }
      if (kind == 0) {
        for (int it = bid; it < 1056 + 256; it += G) {
          if (it < 1056) convert_tile(p.in[16] + (size_t)j * 1024 * 4128, 1024, 4128, wmix + WM_IN, it, 0, sT);
          else convert_tile(p.in[21] + (size_t)j * 1024 * 1024, 1024, 1024, wmix + WM_OUT, it - 1056, 0, sT);
        }
      } else if (kind == 1) {
        for (int it = bid; it < 192 + 144 + 128 + 256; it += G) {
          if (it < 192) convert_tile(p.in[22], 1024, 704, wmix + WM_IN, it, 0, sT);
          else if (it < 336) convert_tile(p.in[25], 384, 1536, wmix + WM_UQ, it - 192, 1, sT);
          else if (it < 464) convert_tile(p.in[26], 256, 2048, wmix + WM_UKV, it - 336, 0, sT);
          else convert_tile(p.in[31], 1024, 1024, wmix + WM_OUT, it - 464, 0, sT);
        }
      } else {
        for (int it = bid; it < 384 + 256; it += G) {
          if (it < 384) convert_tile(p.in[32], 1024, 1536, wmix + WM_IN, it, 0, sT);
          else convert_tile(p.in[35], 1024, 1024, wmix + WM_OUT, it - 384, 0, sT);
        }
        u16* Kg = (u16*)(R + R_KG); u16* Vg = (u16*)(R + R_VTG);
        const int tid = opaque_tid();
        for (int it = bid; it < 512; it += G) {
          const int b = it >> 6, s0 = (it & 63) * 8;
          const int ch = tid;
          float kv[8], vv[8];
#pragma unroll
          for (int e = 0; e < 8; ++e) { kv[e] = p.in[6][((size_t)b * 512 + s0 + e) * 256 + ch]; vv[e] = p.in[7][((size_t)b * 512 + s0 + e) * 256 + ch]; }
#pragma unroll
          for (int e = 0; e < 8; ++e) Kg[(size_t)(NPROMPT + b * 2560 + s0 + e) * 256 + ch] = f2bf(kv[e]);
          u32x4 o; o[0] = pack2(vv[0], vv[1]); o[1] = pack2(vv[2], vv[3]); o[2] = pack2(vv[4], vv[5]); o[3] = pack2(vv[6], vv[7]);
          *(u32x4*)(Vg + (size_t)(NPROMPT + b * 2560) * 256 + (size_t)ch * 2560 + s0) = o;
        }
      }
    }
    GSYNC();

    if (kind == 0) {
      {
        EpiGdnIn epi; epi.proj = (u16*)(R + R_PROJ); epi.gbuf = (float*)(R + R_GBUF);
        for (int it = bid; it < 160 * 33; it += G) { const int mt = it / 33, nt = it % 33; gemm_tile<4>(hbuf, 1024, wmix + WM_IN, 1024, 1024, mt * 128, nt * 128, (u16*)smem, epi); }
      }
      GSYNC();
      gdn_chunk_phase(p, j, smem);
      GSYNC();
      gdn_scan_phase(p, j, smem);
      GSYNC();
      {
        const u16* pr = (const u16*)(R + R_PROJ);
        const float* on = p.in[20] + j * 128;
        const int tid = opaque_tid();
        for (int t = bid; t < NTOK; t += G) {
          const int h = tid >> 5, c = (tid & 31) * 4;
          const u16* row = pr + (size_t)t * 4096;
          const u32x2 f = *(const u32x2*)(row + h * 128 + c), b = *(const u32x2*)(row + 1024 + h * 128 + c), z = *(const u32x2*)(row + 3072 + h * 128 + c);
          float o[4] = {bflo(f[0]) + bflo(b[0]), bfhi(f[0]) + bfhi(b[0]), bflo(f[1]) + bflo(b[1]), bfhi(f[1]) + bfhi(b[1])};
          float zz[4] = {bflo(z[0]), bfhi(z[0]), bflo(z[1]), bfhi(z[1])};
          float ss = o[0] * o[0] + o[1] * o[1] + o[2] * o[2] + o[3] * o[3];
          ss += __shfl_xor(ss, 1); ss += __shfl_xor(ss, 2); ss += __shfl_xor(ss, 4); ss += __shfl_xor(ss, 8); ss += __shfl_xor(ss, 16);
          const float rs = rsqrtf(ss * (1.f / 128.f) + EPS);
          const float4 gn = *(const float4*)(on + c);
          const float gg[4] = {gn.x, gn.y, gn.z, gn.w};
          float y[4];
#pragma unroll
          for (int e = 0; e < 4; ++e) y[e] = o[e] * rs * gg[e] * (zz[e] / (1.f + __expf(-zz[e])));
          st4bf(obuf + (size_t)t * 1024 + h * 128 + c, y[0], y[1], y[2], y[3]);
        }
      }
      GSYNC();
    } else if (kind == 1) {
      {
        EpiF32 epi; epi.dst = (float*)(R + R_DPROJ); epi.ld = 768;
        for (int it = bid; it < 160 * 6; it += G) { const int mt = it / 6, nt = it % 6; gemm_tile<4>(hbuf, 1024, wmix + WM_IN, 1024, 1024, mt * 128, nt * 128, (u16*)smem, epi); }
      }
      GSYNC();
      {
        const float* dproj = (const float*)(R + R_DPROJ);
        u16* cq = (u16*)(R + R_CQ); u16* ckv = (u16*)(R + R_CKV); u16* Km = (u16*)(R + R_KM);
        const int tid = opaque_tid(), lane = tid & 63, wid = tid >> 6;
        for (int it = bid; it < 6144; it += G) {
          const int row = it * 4 + wid;
          if (row < NTOK) {
            const int t = row;
            const float* pr = dproj + (size_t)t * 768;
            float v[6]; float ss = 0.f;
#pragma unroll
            for (int e = 0; e < 6; ++e) { v[e] = pr[lane + 64 * e]; ss += v[e] * v[e]; }
            ss = wave_sum(ss);
            float rs = rsqrtf(ss * (1.f / 384.f) + EPS);
#pragma unroll
            for (int e = 0; e < 6; ++e) cq[(size_t)t * 384 + lane + 64 * e] = f2bf(v[e] * rs * p.in[23][lane + 64 * e]);
            const int kvrow = kvrow_of_tok(t);
            float wv[4]; ss = 0.f;
#pragma unroll
            for (int e = 0; e < 4; ++e) { wv[e] = pr[384 + lane + 64 * e]; ss += wv[e] * wv[e]; }
            ss = wave_sum(ss);
            rs = rsqrtf(ss * (1.f / 256.f) + EPS);
#pragma unroll
            for (int e = 0; e < 4; ++e) {
              const float o = wv[e] * rs * p.in[24][lane + 64 * e];
              ckv[(size_t)kvrow * 256 + lane + 64 * e] = f2bf(o);
              if (t < NPROMPT) p.out[O_CKV + (size_t)t * 256 + lane + 64 * e] = o;
            }
            const float x = pr[640 + lane];
            ss = wave_sum(x * x);
            float kr = x * rsqrtf(ss * (1.f / 64.f) + EPS) * p.in[30][lane];
            if (t < NPROMPT) p.out[O_KR + (size_t)t * 64 + lane] = kr;
            else {
              const int s = (t - NPROMPT) & 2047;
              const int pos = lane < 32 ? (s >> 6) : (s & 63);
              const float cs = cosM[pos * 16 + (lane & 15)], sn = sinM[pos * 16 + (lane & 15)];
              const float partner = __shfl_xor(kr, 16);
              kr = ((lane & 16) == 0) ? kr * cs - partner * sn : partner * sn + kr * cs;
            }
            const u16 kb = f2bf(kr);
#pragma unroll
            for (int hh = 0; hh < 8; ++hh) Km[(size_t)kvrow * 1536 + hh * 192 + 128 + lane] = kb;
          } else {
            const int r = row - NTOK; const int b = r >> 9, s = r & 511;
            const int kvrow = NPROMPT + b * 2560 + s;
#pragma unroll
            for (int e = 0; e < 4; ++e) ckv[(size_t)kvrow * 256 + lane + 64 * e] = f2bf(p.in[4][((size_t)b * 512 + s) * 256 + lane + 64 * e]);
            const u16 kb = f2bf(p.in[5][((size_t)b * 512 + s) * 64 + lane]);
#pragma unroll
            for (int hh = 0; hh < 8; ++hh) Km[(size_t)kvrow * 1536 + hh * 192 + 128 + lane] = kb;
          }
        }
      }
      GSYNC();
      {
        EpiMlaUq e1; e1.Q = (u16*)(R + R_Q); e1.gnope = p.in[27]; e1.grope = p.in[28]; e1.cosT = cosM; e1.sinT = sinM;
        for (int it = bid; it < 160 * 12; it += G) { const int mt = it / 12, nt = it % 12; gemm_tile<8>((const u16*)(R + R_CQ), 384, wmix + WM_UQ, 384, 384, mt * 128, nt * 128, (u16*)smem, e1); }
        EpiMlaUkv e2; e2.Kb = (u16*)(R + R_KM); e2.Vt = (u16*)(R + R_VTM); e2.gnope = p.in[29];
        for (int it = bid; it < 192 * 16; it += G) { const int mt = it / 16, nt = it % 16; gemm_tile<8>((const u16*)(R + R_CKV), 256, wmix + WM_UKV, 256, 256, mt * 128, nt * 128, (u16*)smem, e2); }
      }
      GSYNC();
      attn_phase<192, 8>((const u16*)(R + R_Q), (const u16*)(R + R_KM), (const u16*)(R + R_VTM), obuf, smem);
      GSYNC();
    } else {
      {
        EpiGqaIn epi; epi.Q = (u16*)(R + R_Q); epi.Kb = (u16*)(R + R_KG); epi.Vt = (u16*)(R + R_VTG); epi.qg = p.in[33]; epi.kg = p.in[34]; epi.cosT = cosG; epi.sinT = sinG; epi.out = p.out;
        for (int it = bid; it < 160 * 12; it += G) { const int mt = it / 12, nt = it % 12; gemm_tile<8>(hbuf, 1024, wmix + WM_IN, 1024, 1024, mt * 128, nt * 128, (u16*)smem, epi); }
      }
      GSYNC();
      attn_phase<128, 2>((const u16*)(R + R_Q), (const u16*)(R + R_KG), (const u16*)(R + R_VTG), obuf, smem);
      GSYNC();
    }

    for (int it = bid; it < 160 * 8; it += G) {
      const int mt = it >> 3, nt = it & 7; const int m0 = mt * 128;
      EpiResid epi;
      epi.xin = (layer == 0) ? (m0 < NPROMPT ? p.in[0] : p.in[1] - (size_t)NPROMPT * 1024) : p.out;
      epi.xout = p.out; epi.gate = lmods + (size_t)cond_of(m0) * 6144 + 2 * 1024;
      gemm_tile<4>(obuf, 1024, wmix + WM_OUT, 1024, 1024, m0, nt * 128, (u16*)smem, epi);
    }
    GSYNC();
    for (int it = bid; it < 5120; it += G) norm_rows(p, layer, false, it, p.in[11] + layer * 1024, 3, 4);
    GSYNC();
    {
      EpiMlpIn epi; epi.abuf = (u16*)(R + R_ABUF);
      for (int it = bid; it < 160 * 32; it += G) { const int mt = it >> 5, nt = it & 31; gemm_tile<4>(hbuf, 1024, wmlp, 1024, 1024, mt * 128, nt * 128, (u16*)smem, epi); }
    }
    GSYNC();
    for (int it = bid; it < 160 * 8; it += G) {
      const int mt = it >> 3, nt = it & 7; const int m0 = mt * 128;
      EpiResid epi; epi.xin = p.out; epi.xout = p.out; epi.gate = lmods + (size_t)cond_of(m0) * 6144 + 5 * 1024;
      gemm_tile<4>((const u16*)(R + R_ABUF), 4096, wmlp + 4194304, 4096, 4096, m0, nt * 128, (u16*)smem, epi);
    }
    GSYNC();
  }
}

extern "C" void kernel_launch(void* const* d_in, const int* in_sizes, int n_in, void* d_out, int out_size, void* d_ws, size_t ws_size, hipStream_t stream) {
  static int grid_blocks = 0;
  if (!grid_blocks) {
    int dev = 0, cus = 0, per_cu = 0;
    hipGetDevice(&dev);
    hipDeviceGetAttribute(&cus, hipDeviceAttributeMultiprocessorCount, dev);
    hipOccupancyMaxActiveBlocksPerMultiprocessor(&per_cu, fwd_megakernel, 256, 0);
    if (per_cu < 1) per_cu = 1;
    if (per_cu > 2) per_cu = 2;
    grid_blocks = cus * per_cu;
  }
  P p{};
  for (int i = 0; i < 36; ++i) p.in[i] = (const float*)d_in[i];
  p.out = (float*)d_out;
  p.ws = (char*)d_ws;
  (void)hipMemsetAsync((char*)d_ws + WS_BAR, 0, XCD_BAR_WORDS * 4, stream);
  void* args[] = {&p};
  hipError_t e = hipLaunchCooperativeKernel((void*)fwd_megakernel, dim3(grid_blocks), dim3(256), args, 0, stream);
  if (e != hipSuccess) fprintf(stderr, "cooperative launch failed: %s (grid %d)\n", hipGetErrorString(e), grid_blocks);
}
```

```cpp
#include <hip/hip_runtime.h>
#include <hip/hip_cooperative_groups.h>
#include <cstdio>
namespace cg = cooperative_groups;

typedef unsigned short u16;
typedef __attribute__((ext_vector_type(8))) short bf16x8;
typedef __attribute__((ext_vector_type(4))) short bf16x4;
typedef __attribute__((ext_vector_type(4))) float f32x4;
typedef __attribute__((ext_vector_type(4))) unsigned u32x4;
typedef __attribute__((ext_vector_type(2))) unsigned u32x2;

#define DI __device__ __forceinline__

constexpr int NTOK = 20480;
constexpr int NPROMPT = 4096;
constexpr float EPS = 1e-6f;

constexpr size_t WS_MODS = 0;
constexpr size_t MODS_BYTES = 4ull * 9 * 6144 * 4;
constexpr size_t WS_BAR = 917504;
constexpr size_t WS_ROPE = 1048576;
constexpr size_t WS_WMIX = 1114112;
constexpr size_t WS_WMLP = 14090240;
constexpr size_t WS_HBUF = 30867456;
constexpr size_t WS_OBUF = 72810496;
constexpr size_t WS_R    = 114753536;
constexpr size_t R_ABUF = 0;
constexpr size_t R_PROJ = 0;
constexpr size_t R_VBUF = 167772160;
constexpr size_t R_TBUF = 209715200;
constexpr size_t R_GBUF = 251658240;
constexpr size_t R_GCB  = 254279680;
constexpr size_t R_BETA = 255590400;
constexpr size_t R_DPROJ = 0;
constexpr size_t R_Q    = 0;
constexpr size_t R_CQ   = 62914560;
constexpr size_t R_CKV  = 78643200;
constexpr size_t R_KM   = 91226112;
constexpr size_t R_VTM  = 166723584;
constexpr size_t R_KG   = 41943040;
constexpr size_t R_VTG  = 54525952;
constexpr size_t WM_IN = 0;
constexpr size_t WM_OUT = 4325376;
constexpr size_t WM_UQ = 5373952;
constexpr size_t WM_UKV = 5963776;
constexpr size_t O_SF = 20971520, O_SB = 25165824, O_CKV = 29360128, O_KR = 30408704, O_GK = 30670848, O_GV = 31719424;

struct P {
  const float* in[36];
  float* out;
  char* ws;
};

typedef __attribute__((ext_vector_type(2))) float f32x2_t;
typedef __attribute__((ext_vector_type(2))) __bf16 bf16x2_t;
DI u16 f2bf(float x) { return __builtin_bit_cast(u16, (__bf16)x); }
DI float bf2f(u16 h) { return __uint_as_float(((unsigned)h) << 16); }
DI unsigned pack2(float a, float b) { f32x2_t v; v[0] = a; v[1] = b; return __builtin_bit_cast(unsigned, __builtin_convertvector(v, bf16x2_t)); }
DI float bflo(unsigned w) { return __uint_as_float(w << 16); }
DI float bfhi(unsigned w) { return __uint_as_float(w & 0xffff0000u); }
DI f32x4 mma(bf16x8 a, bf16x8 b, f32x4 c) { return __builtin_amdgcn_mfma_f32_16x16x32_bf16(a, b, c, 0, 0, 0); }
DI bf16x8 pack8(f32x4 a, f32x4 b) {
  u32x4 p; p[0] = pack2(a[0], a[1]); p[1] = pack2(a[2], a[3]); p[2] = pack2(b[0], b[1]); p[3] = pack2(b[2], b[3]);
  return __builtin_bit_cast(bf16x8, p);
}
DI bf16x8 ld8(const u16* p) { return *(const bf16x8*)p; }
DI bf16x8 ld44(const u16* p0, const u16* p1) {
  u32x2 a = *(const u32x2*)p0; u32x2 b = *(const u32x2*)p1;
  u32x4 r; r[0] = a[0]; r[1] = a[1]; r[2] = b[0]; r[3] = b[1];
  return __builtin_bit_cast(bf16x8, r);
}
DI void st4bf(u16* p, float a, float b, float c, float d) { u32x2 v; v[0] = pack2(a, b); v[1] = pack2(c, d); *(u32x2*)p = v; }
DI float wave_sum(float v) {
  v += __shfl_xor(v, 1); v += __shfl_xor(v, 2); v += __shfl_xor(v, 4); v += __shfl_xor(v, 8); v += __shfl_xor(v, 16); v += __shfl_xor(v, 32);
  return v;
}
DI float sum_g(float v) { v += __shfl_xor(v, 16); v += __shfl_xor(v, 32); return v; }
DI int opaque_tid() { int t = threadIdx.x; asm volatile("" : "+v"(t)); return t; }
DI int opaque_bid() { int t = __builtin_amdgcn_readfirstlane((int)blockIdx.x); asm volatile("" : "+s"(t)); return t; }
DI char* opaque_ptr(char* q) {
  unsigned lo = __builtin_amdgcn_readfirstlane((unsigned)(size_t)q), hi = __builtin_amdgcn_readfirstlane((unsigned)((size_t)q >> 32));
  asm volatile("" : "+s"(lo), "+s"(hi));
  typedef __attribute__((address_space(1))) char gchar_t;
  return (char*)(gchar_t*)(((size_t)hi << 32) | (size_t)lo);
}
template <class T> DI T* as_global(T* q) { typedef __attribute__((address_space(1))) T gT; return (T*)(gT*)q; }
#define GIN(i) as_global(p.in[i])
#define GOUT as_global(p.out)
DI int cond_of(int t) { return t < NPROMPT ? 0 : 1 + ((t - NPROMPT) >> 11); }
DI int kvrow_of_tok(int t) { return t < NPROMPT ? t : NPROMPT + ((t - NPROMPT) >> 11) * 2560 + 512 + ((t - NPROMPT) & 2047); }

template <int NI, class Epi>
DI void gemm_tile(const u16* __restrict__ A, int lda, const u16* __restrict__ Bt, int ldb, int K, int m0, int n0, u16* smem, Epi& epi) {
  constexpr int MI = 16 / NI;
  constexpr int WN = 8 / NI;
  const int tid = opaque_tid(), lane = tid & 63, wid = tid >> 6, l15 = lane & 15, g = lane >> 4;
  const int wm = wid / WN, wn = wid % WN;
  u16* sA = smem; u16* sB = smem + 128 * 64;
  f32x4 acc[MI][NI];
#pragma unroll
  for (int mi = 0; mi < MI; ++mi)
#pragma unroll
    for (int ni = 0; ni < NI; ++ni) { acc[mi][ni][0] = 0.f; acc[mi][ni][1] = 0.f; acc[mi][ni][2] = 0.f; acc[mi][ni][3] = 0.f; }
  const int lrow = tid >> 3, lkc = (tid & 7) * 8;
  const int wofs = lrow * 64 + (((tid & 7) ^ ((lrow >> 1) & 7)) * 8);
  const int rsw = (l15 >> 1) & 7;
  const int rofs0 = l15 * 64 + ((g ^ rsw) * 8), rofs1 = l15 * 64 + (((4 + g) ^ rsw) * 8);
  const u16* pa = A + (size_t)(m0 + lrow) * lda + lkc;
  const u16* pb = Bt + (size_t)(n0 + lrow) * ldb + lkc;
  u32x4 ra[2][4], rb[2][4];
  const int nk = K >> 6;
#pragma unroll
  for (int i = 0; i < 4; ++i) { ra[0][i] = *(const u32x4*)(pa + (size_t)i * 32 * lda); rb[0][i] = *(const u32x4*)(pb + (size_t)i * 32 * ldb); }
#pragma unroll
  for (int i = 0; i < 4; ++i) { ra[1][i] = *(const u32x4*)(pa + (size_t)i * 32 * lda + 64); rb[1][i] = *(const u32x4*)(pb + (size_t)i * 32 * ldb + 64); }
  for (int kt = 0; kt < nk; kt += 2) {
#pragma unroll
    for (int half = 0; half < 2; ++half) {
      __syncthreads();
#pragma unroll
      for (int i = 0; i < 4; ++i) { *(u32x4*)(sA + wofs + i * 32 * 64) = ra[half][i]; *(u32x4*)(sB + wofs + i * 32 * 64) = rb[half][i]; }
      __syncthreads();
      if (kt + half + 2 < nk) {
        const int ko = (kt + half + 2) * 64;
#pragma unroll
        for (int i = 0; i < 4; ++i) { ra[half][i] = *(const u32x4*)(pa + (size_t)i * 32 * lda + ko); rb[half][i] = *(const u32x4*)(pb + (size_t)i * 32 * ldb + ko); }
      }
#pragma unroll
      for (int ks = 0; ks < 2; ++ks) {
        const int ro = ks ? rofs1 : rofs0;
        bf16x8 af[MI], bfv[NI];
#pragma unroll
        for (int mi = 0; mi < MI; ++mi) af[mi] = ld8(sA + (wm * MI * 16 + mi * 16) * 64 + ro);
#pragma unroll
        for (int ni = 0; ni < NI; ++ni) bfv[ni] = ld8(sB + (wn * NI * 16 + ni * 16) * 64 + ro);
#pragma unroll
        for (int mi = 0; mi < MI; ++mi)
#pragma unroll
          for (int ni = 0; ni < NI; ++ni) acc[mi][ni] = mma(bfv[ni], af[mi], acc[mi][ni]);
      }
    }
  }
  epi.template run<MI, NI>(acc, m0 + wm * MI * 16, n0 + wn * NI * 16, l15, g);
}

struct EpiResid {
  const float* xin; float* xout; const float* gate;
  template <int MI, int NI> DI void run(f32x4 (&acc)[MI][NI], int mr, int nc, int l15, int g) {
#pragma unroll
    for (int mi = 0; mi < MI; ++mi)
#pragma unroll
      for (int ni = 0; ni < NI; ++ni) {
        const int m = mr + mi * 16 + l15, n = nc + ni * 16 + g * 4;
        const float4 xi = *(const float4*)(xin + (size_t)m * 1024 + n);
        const float4 gt = *(const float4*)(gate + n);
        float4 o; o.x = xi.x + gt.x * acc[mi][ni][0]; o.y = xi.y + gt.y * acc[mi][ni][1]; o.z = xi.z + gt.z * acc[mi][ni][2]; o.w = xi.w + gt.w * acc[mi][ni][3];
        *(float4*)(xout + (size_t)m * 1024 + n) = o;
      }
  }
};
struct EpiGdnIn {
  u16* proj; float* gbuf;
  template <int MI, int NI> DI void run(f32x4 (&acc)[MI][NI], int mr, int nc, int l15, int g) {
#pragma unroll
    for (int mi = 0; mi < MI; ++mi)
#pragma unroll
      for (int ni = 0; ni < NI; ++ni) {
        const int m = mr + mi * 16 + l15, n = nc + ni * 16 + g * 4;
        if (n < 4096) st4bf(proj + (size_t)m * 4096 + n, acc[mi][ni][0], acc[mi][ni][1], acc[mi][ni][2], acc[mi][ni][3]);
        else if (n < 4128) { float4 o; o.x = acc[mi][ni][0]; o.y = acc[mi][ni][1]; o.z = acc[mi][ni][2]; o.w = acc[mi][ni][3]; *(float4*)(gbuf + (size_t)m * 32 + (n - 4096)) = o; }
      }
  }
};
struct EpiMlpIn {
  u16* abuf;
  template <int MI, int NI> DI void run(f32x4 (&acc)[MI][NI], int mr, int nc, int l15, int g) {
#pragma unroll
    for (int mi = 0; mi < MI; ++mi)
#pragma unroll
      for (int ni = 0; ni < NI; ++ni) {
        const int m = mr + mi * 16 + l15, n = nc + ni * 16 + g * 4;
        float a = fmaxf(acc[mi][ni][0], 0.f), b = fmaxf(acc[mi][ni][1], 0.f), c = fmaxf(acc[mi][ni][2], 0.f), d = fmaxf(acc[mi][ni][3], 0.f);
        st4bf(abuf + (size_t)m * 4096 + n, a * a, b * b, c * c, d * d);
      }
  }
};
struct EpiF32 {
  float* dst; int ld;
  template <int MI, int NI> DI void run(f32x4 (&acc)[MI][NI], int mr, int nc, int l15, int g) {
#pragma unroll
    for (int mi = 0; mi < MI; ++mi)
#pragma unroll
      for (int ni = 0; ni < NI; ++ni) {
        const int m = mr + mi * 16 + l15, n = nc + ni * 16 + g * 4;
        float4 o; o.x = acc[mi][ni][0]; o.y = acc[mi][ni][1]; o.z = acc[mi][ni][2]; o.w = acc[mi][ni][3];
        *(float4*)(dst + (size_t)m * ld + n) = o;
      }
  }
};

DI void rope128(f32x4 (&v)[8], int rowp, int colp, int g, const float* cosT, const float* sinT) {
#pragma unroll
  for (int hf = 0; hf < 2; ++hf) {
    const int pos = hf ? colp : rowp;
#pragma unroll
    for (int a = 0; a < 2; ++a) {
      const int n1 = hf * 4 + a, n2 = n1 + 2;
      const float4 cs = *(const float4*)(cosT + pos * 32 + a * 16 + g * 4);
      const float4 sn = *(const float4*)(sinT + pos * 32 + a * 16 + g * 4);
      const float c4[4] = {cs.x, cs.y, cs.z, cs.w}, s4[4] = {sn.x, sn.y, sn.z, sn.w};
#pragma unroll
      for (int j = 0; j < 4; ++j) { const float x1 = v[n1][j], x2 = v[n2][j]; v[n1][j] = x1 * c4[j] - x2 * s4[j]; v[n2][j] = x1 * s4[j] + x2 * c4[j]; }
    }
  }
}
DI void rope64(f32x4* v, int rowp, int colp, int g, const float* cosT, const float* sinT) {
#pragma unroll
  for (int hf = 0; hf < 2; ++hf) {
    const int pos = hf ? colp : rowp;
    const int n1 = hf * 2, n2 = n1 + 1;
    const float4 cs = *(const float4*)(cosT + pos * 16 + g * 4);
    const float4 sn = *(const float4*)(sinT + pos * 16 + g * 4);
    const float c4[4] = {cs.x, cs.y, cs.z, cs.w}, s4[4] = {sn.x, sn.y, sn.z, sn.w};
#pragma unroll
    for (int j = 0; j < 4; ++j) { const float x1 = v[n1][j], x2 = v[n2][j]; v[n1][j] = x1 * c4[j] - x2 * s4[j]; v[n2][j] = x1 * s4[j] + x2 * c4[j]; }
  }
}

struct EpiGqaIn {
  u16* Q; u16* Kb; u16* Vt; const float* qg; const float* kg; const float* cosT; const float* sinT; float* out;
  template <int MI, int NI> DI void run(f32x4 (&acc)[MI][NI], int mr, int nc, int l15, int g) {
    const int nt = nc >> 7;
#pragma unroll
    for (int mi = 0; mi < MI; ++mi) {
      const int m = mr + mi * 16 + l15;
      const bool prompt = m < NPROMPT;
      const int s = prompt ? (m & 255) : ((m - NPROMPT) & 2047);
      const int rowp = s >> 6, colp = s & 63;
      const int kvrow = kvrow_of_tok(m);
      if (nt < 10) {
        float ss = 0.f;
#pragma unroll
        for (int ni = 0; ni < NI; ++ni)
#pragma unroll
          for (int j = 0; j < 4; ++j) ss += acc[mi][ni][j] * acc[mi][ni][j];
        ss = sum_g(ss);
        const float rs = rsqrtf(ss * (1.f / 128.f) + EPS);
        const float* gn = nt < 8 ? qg : kg;
#pragma unroll
        for (int ni = 0; ni < NI; ++ni) {
          const float4 gv = *(const float4*)(gn + ni * 16 + g * 4);
          acc[mi][ni][0] *= rs * gv.x; acc[mi][ni][1] *= rs * gv.y; acc[mi][ni][2] *= rs * gv.z; acc[mi][ni][3] *= rs * gv.w;
        }
        if (nt >= 8 && prompt) {
#pragma unroll
          for (int ni = 0; ni < NI; ++ni) { float4 o; o.x = acc[mi][ni][0]; o.y = acc[mi][ni][1]; o.z = acc[mi][ni][2]; o.w = acc[mi][ni][3]; *(float4*)(out + O_GK + (size_t)m * 256 + (nt - 8) * 128 + ni * 16 + g * 4) = o; }
        }
        if (!prompt) rope128(acc[mi], rowp, colp, g, cosT, sinT);
        u16* dst = nt < 8 ? Q + (size_t)m * 1024 + nt * 128 : Kb + (size_t)kvrow * 256 + (nt - 8) * 128;
#pragma unroll
        for (int ni = 0; ni < NI; ++ni) st4bf(dst + ni * 16 + g * 4, acc[mi][ni][0], acc[mi][ni][1], acc[mi][ni][2], acc[mi][ni][3]);
      } else {
        const int kvh = nt - 10;
        if (prompt) {
#pragma unroll
          for (int ni = 0; ni < NI; ++ni) { float4 o; o.x = acc[mi][ni][0]; o.y = acc[mi][ni][1]; o.z = acc[mi][ni][2]; o.w = acc[mi][ni][3]; *(float4*)(out + O_GV + (size_t)m * 256 + kvh * 128 + ni * 16 + g * 4) = o; }
        }
        size_t base; int kvlen, pos;
        if (prompt) { base = (size_t)(m >> 8) * 256 * 256; kvlen = 256; pos = m & 255; }
        else { const int b = (m - NPROMPT) >> 11; base = (size_t)(NPROMPT + b * 2560) * 256; kvlen = 2560; pos = 512 + s; }
#pragma unroll
        for (int ni = 0; ni < NI; ++ni)
#pragma unroll
          for (int j = 0; j < 4; ++j) Vt[base + (size_t)(kvh * 128 + ni * 16 + g * 4 + j) * kvlen + pos] = f2bf(acc[mi][ni][j]);
      }
    }
  }
};
struct EpiMlaUq {
  u16* Q; const float* gnope; const float* grope; const float* cosT; const float* sinT;
  template <int MI, int NI> DI void run(f32x4 (&acc)[MI][NI], int mr, int nc, int l15, int g) {
    const int nt = nc >> 7;
#pragma unroll
    for (int mi = 0; mi < MI; ++mi) {
      const int m = mr + mi * 16 + l15;
      const bool prompt = m < NPROMPT;
      const int s = prompt ? (m & 255) : ((m - NPROMPT) & 2047);
      const int rowp = s >> 6, colp = s & 63;
      if (nt < 8) {
        float ss = 0.f;
#pragma unroll
        for (int ni = 0; ni < NI; ++ni)
#pragma unroll
          for (int j = 0; j < 4; ++j) ss += acc[mi][ni][j] * acc[mi][ni][j];
        ss = sum_g(ss);
        const float rs = rsqrtf(ss * (1.f / 128.f) + EPS);
#pragma unroll
        for (int ni = 0; ni < NI; ++ni) {
          const float4 gv = *(const float4*)(gnope + ni * 16 + g * 4);
          st4bf(Q + (size_t)m * 1536 + nt * 192 + ni * 16 + g * 4, acc[mi][ni][0] * rs * gv.x, acc[mi][ni][1] * rs * gv.y, acc[mi][ni][2] * rs * gv.z, acc[mi][ni][3] * rs * gv.w);
        }
      } else {
#pragma unroll
        for (int hh = 0; hh < 2; ++hh) {
          const int h = (nt - 8) * 2 + hh;
          float ss = 0.f;
#pragma unroll
          for (int ni = 0; ni < 4; ++ni)
#pragma unroll
            for (int j = 0; j < 4; ++j) ss += acc[mi][hh * 4 + ni][j] * acc[mi][hh * 4 + ni][j];
          ss = sum_g(ss);
          const float rs = rsqrtf(ss * (1.f / 64.f) + EPS);
#pragma unroll
          for (int ni = 0; ni < 4; ++ni) {
            const float4 gv = *(const float4*)(grope + ni * 16 + g * 4);
            acc[mi][hh * 4 + ni][0] *= rs * gv.x; acc[mi][hh * 4 + ni][1] *= rs * gv.y; acc[mi][hh * 4 + ni][2] *= rs * gv.z; acc[mi][hh * 4 + ni][3] *= rs * gv.w;
          }
          if (!prompt) rope64(&acc[mi][hh * 4], rowp, colp, g, cosT, sinT);
#pragma unroll
          for (int ni = 0; ni < 4; ++ni)
            st4bf(Q + (size_t)m * 1536 + h * 192 + 128 + ni * 16 + g * 4, acc[mi][hh * 4 + ni][0], acc[mi][hh * 4 + ni][1], acc[mi][hh * 4 + ni][2], acc[mi][hh * 4 + ni][3]);
        }
      }
    }
  }
};
struct EpiMlaUkv {
  u16* Kb; u16* Vt; const float* gnope;
  template <int MI, int NI> DI void run(f32x4 (&acc)[MI][NI], int mr, int nc, int l15, int g) {
    const int nt = nc >> 7, h = nt >> 1;
#pragma unroll
    for (int mi = 0; mi < MI; ++mi) {
      const int m = mr + mi * 16 + l15;
      if ((nt & 1) == 0) {
        float ss = 0.f;
#pragma unroll
        for (int ni = 0; ni < NI; ++ni)
#pragma unroll
          for (int j = 0; j < 4; ++j) ss += acc[mi][ni][j] * acc[mi][ni][j];
        ss = sum_g(ss);
        const float rs = rsqrtf(ss * (1.f / 128.f) + EPS);
#pragma unroll
        for (int ni = 0; ni < NI; ++ni) {
          const float4 gv = *(const float4*)(gnope + ni * 16 + g * 4);
          st4bf(Kb + (size_t)m * 1536 + h * 192 + ni * 16 + g * 4, acc[mi][ni][0] * rs * gv.x, acc[mi][ni][1] * rs * gv.y, acc[mi][ni][2] * rs * gv.z, acc[mi][ni][3] * rs * gv.w);
        }
      } else {
        size_t base; int kvlen, pos;
        if (m < NPROMPT) { base = (size_t)(m >> 8) * 256 * 1024; kvlen = 256; pos = m & 255; }
        else { const int r = m - NPROMPT; const int b = r / 2560; base = (size_t)(NPROMPT + b * 2560) * 1024; kvlen = 2560; pos = r - b * 2560; }
#pragma unroll
        for (int ni = 0; ni < NI; ++ni)
#pragma unroll
          for (int j = 0; j < 4; ++j) Vt[base + (size_t)(h * 128 + ni * 16 + g * 4 + j) * kvlen + pos] = f2bf(acc[mi][ni][j]);
      }
    }
  }
};

DI void convert_tile(const float* __restrict__ W, int K, int N, u16* __restrict__ Bt, int tile, int perm, float* sT) {
  const int nkt = K >> 6;
  const int kt = tile % nkt, nt = tile / nkt;
  const int k0 = kt * 64, n0 = nt * 64;
  const int tid = opaque_tid();
  __syncthreads();
  {
    const int n = tid & 63, kq = tid >> 6;
    int nd = n0 + n, ns = nd;
    if (perm == 1) { if (nd < 1024) ns = (nd >> 7) * 192 + (nd & 127); else { const int x = nd - 1024; ns = (x >> 6) * 192 + 128 + (x & 63); } }
    const bool ok = nd < N;
#pragma unroll
    for (int r = 0; r < 16; ++r) { const int k = r * 4 + kq; sT[k * 65 + n] = ok ? W[(size_t)(k0 + k) * N + ns] : 0.f; }
  }
  __syncthreads();
  {
    const int n = tid >> 2, kq = (tid & 3) * 16;
    u32x4 a, b;
#pragma unroll
    for (int e = 0; e < 4; ++e) { a[e] = pack2(sT[(kq + 2 * e) * 65 + n], sT[(kq + 2 * e + 1) * 65 + n]); b[e] = pack2(sT[(kq + 8 + 2 * e) * 65 + n], sT[(kq + 9 + 2 * e) * 65 + n]); }
    u16* dst = Bt + (size_t)(n0 + n) * K + k0 + kq;
    *(u32x4*)dst = a; *(u32x4*)(dst + 8) = b;
  }
}

DI void norm_rows(const P& p, int layer, bool from_input, int item, const float* gnorm, int shift_idx, int scale_idx) {
  const int tidn = opaque_tid();
  char* const ws = opaque_ptr(as_global(p.ws));
  const int lane = tidn & 63, wid = tidn >> 6;
  const int t = item * 4 + wid;
  const float* x = from_input ? (t < NPROMPT ? GIN(0) + (size_t)t * 1024 : GIN(1) + (size_t)(t - NPROMPT) * 1024) : GOUT + (size_t)t * 1024;
  const float* mods = (const float*)(ws + WS_MODS) + ((size_t)layer * 9 + cond_of(t)) * 6144;
  u16* h = (u16*)(ws + WS_HBUF) + (size_t)t * 1024;
  float4 v[4]; float ss = 0.f;
#pragma unroll
  for (int e = 0; e < 4; ++e) { v[e] = *(const float4*)(x + e * 256 + lane * 4); ss += v[e].x * v[e].x + v[e].y * v[e].y + v[e].z * v[e].z + v[e].w * v[e].w; }
  ss = wave_sum(ss);
  const float rs = rsqrtf(ss * (1.f / 1024.f) + EPS);
#pragma unroll
  for (int e = 0; e < 4; ++e) {
    const int c = e * 256 + lane * 4;
    const float4 gv = *(const float4*)(gnorm + c);
    const float4 sc = *(const float4*)(mods + scale_idx * 1024 + c);
    const float4 sh = *(const float4*)(mods + shift_idx * 1024 + c);
    st4bf(h + c, v[e].x * rs * gv.x * (1.f + sc.x) + sh.x, v[e].y * rs * gv.y * (1.f + sc.y) + sh.y, v[e].z * rs * gv.z * (1.f + sc.z) + sh.z, v[e].w * rs * gv.w * (1.f + sc.w) + sh.w);
  }
}

template <int DK, int HK>
DI void attn_phase(const u16* __restrict__ Q, const u16* __restrict__ Kb, const u16* __restrict__ Vt, u16* __restrict__ obuf, char* smem_raw) {
  const int bid = opaque_bid();
  constexpr int KS = DK / 32, KSTR = DK, QSTR = 8 * DK, KROW = HK * DK, GRP = 8 / HK;
  constexpr int CPR = DK / 8;
  constexpr int KCH = 64 * CPR / 256;
  u16* sK = (u16*)smem_raw;
  u16* sV = sK + 64 * KSTR;
  const int tid = opaque_tid(), lane = tid & 63, wid = tid >> 6, l15 = lane & 15, g = lane >> 4;
  const float sc = rsqrtf((float)DK) * 1.4426950408889634f;
  for (int item = bid; item < 1280; item += gridDim.x) {
    int qb, h, kvlen, tokbase, kvbase;
    if (item < 1024) { const int b = item >> 7, rem = item & 127; h = rem & 7; qb = rem >> 3; kvlen = 2560; tokbase = NPROMPT + b * 2048; kvbase = NPROMPT + b * 2560; }
    else { const int it2 = item - 1024; const int b = it2 >> 4, rem = it2 & 15; h = rem & 7; qb = rem >> 3; kvlen = 256; tokbase = b * 256; kvbase = b * 256; }
    const int kvh = h / GRP;
    const u16* Kp = Kb + (size_t)kvbase * KROW + kvh * DK;
    const u16* Vp = Vt + (size_t)kvbase * (HK * 128) + (size_t)kvh * 128 * kvlen;
    const int qrow0 = tokbase + qb * 128 + wid * 32;
    bf16x8 qf[2][KS];
#pragma unroll
    for (int qi = 0; qi < 2; ++qi)
#pragma unroll
      for (int ks = 0; ks < KS; ++ks) qf[qi][ks] = ld8(Q + (size_t)(qrow0 + qi * 16 + l15) * QSTR + h * DK + ks * 32 + g * 8);
    f32x4 ot[2][8];
#pragma unroll
    for (int qi = 0; qi < 2; ++qi)
#pragma unroll
      for (int dj = 0; dj < 8; ++dj) { ot[qi][dj][0] = 0.f; ot[qi][dj][1] = 0.f; ot[qi][dj][2] = 0.f; ot[qi][dj][3] = 0.f; }
    float mrun[2] = {-1e30f, -1e30f}, lrun[2] = {0.f, 0.f};
    const int ntiles = kvlen >> 6;
    const unsigned toffK = (unsigned)((tid >> 3) * KROW + (tid & 7) * 8), toffV = (unsigned)((tid >> 3) * kvlen + (tid & 7) * 8);
    const int kx = tid >> 3;
    const int kperm = ((kx >> 2) & 1) * 16 + (kx >> 3) * 4 + (kx & 3);
    const int kswz = (CPR == 16) ? (kperm & 15) : ((kperm >> 1) & 7);
    const int ldsoffK = kperm * KSTR;
    const int ldsoffV = (tid >> 3) * 64 + (((tid & 7) ^ (((tid >> 3) >> 1) & 7)) * 8);
    u32x4 rk[KCH], rv[4];
#pragma unroll
    for (int i = 0; i < KCH; ++i) { const int rh = i & 1, cgp = i >> 1; rk[i] = *(const u32x4*)(Kp + (size_t)(rh * 32 * KROW + cgp * 64) + toffK); }
#pragma unroll
    for (int i = 0; i < 4; ++i) rv[i] = *(const u32x4*)(Vp + (size_t)i * 32 * kvlen + toffV);
    for (int kt = 0; kt < ntiles; ++kt) {
      const u16* Kt = Kp + (size_t)(kt + 1) * 64 * KROW;
      const u16* Vtp = Vp + (kt + 1) * 64;
      const bool more = kt + 1 < ntiles;
      __syncthreads();
#pragma unroll
      for (int i = 0; i < KCH; ++i) { const int rh = i & 1, cgp = i >> 1; const int c = (tid & 7) + 8 * cgp; const int pos = (CPR == 16) ? (c ^ kswz) : ((c & ~7) | ((c & 7) ^ kswz)); *(u32x4*)(sK + ldsoffK + rh * 32 * KSTR + pos * 8) = rk[i]; }
#pragma unroll
      for (int i = 0; i < 4; ++i) *(u32x4*)(sV + ldsoffV + i * 32 * 64) = rv[i];
      __syncthreads();
      if (more) {
#pragma unroll
        for (int i = 0; i < KCH; ++i) { const int rh = i & 1, cgp = i >> 1; rk[i] = *(const u32x4*)(Kt + (size_t)(rh * 32 * KROW + cgp * 64) + toffK); }
      }
      __builtin_amdgcn_sched_barrier(0);
      f32x4 st[2][4];
#pragma unroll
      for (int qi = 0; qi < 2; ++qi)
#pragma unroll
        for (int kj = 0; kj < 4; ++kj) { st[qi][kj][0] = 0.f; st[qi][kj][1] = 0.f; st[qi][kj][2] = 0.f; st[qi][kj][3] = 0.f; }
#pragma unroll
      for (int ks = 0; ks < KS; ++ks) {
#pragma unroll
        for (int kj = 0; kj < 4; ++kj) {
          const int kc = ks * 4 + g;
          const int kpos = (CPR == 16) ? (kc ^ l15) : ((kc & ~7) | ((kc & 7) ^ ((l15 >> 1) & 7)));
          const bf16x8 ka = ld8(sK + (kj * 16 + l15) * KSTR + kpos * 8);
          st[0][kj] = mma(ka, qf[0][ks], st[0][kj]);
          st[1][kj] = mma(ka, qf[1][ks], st[1][kj]);
        }
        __builtin_amdgcn_sched_barrier(0);
      }
      bf16x8 pf[2][2];
#pragma unroll
      for (int qi = 0; qi < 2; ++qi) {
        float mx = -1e30f;
#pragma unroll
        for (int kj = 0; kj < 4; ++kj)
#pragma unroll
          for (int r = 0; r < 4; ++r) mx = fmaxf(mx, st[qi][kj][r]);
        mx = fmaxf(mx, __shfl_xor(mx, 16)); mx = fmaxf(mx, __shfl_xor(mx, 32));
        const float mnew = fmaxf(mrun[qi], mx);
        const float alpha = __builtin_amdgcn_exp2f((mrun[qi] - mnew) * sc);
        mrun[qi] = mnew;
        float ps = 0.f;
        const float mneg = -mnew * sc;
#pragma unroll
        for (int kj = 0; kj < 4; ++kj)
#pragma unroll
          for (int r = 0; r < 4; ++r) { const float pv = __builtin_amdgcn_exp2f(fmaf(st[qi][kj][r], sc, mneg)); st[qi][kj][r] = pv; ps += pv; }
        lrun[qi] = lrun[qi] * alpha + ps;
#pragma unroll
        for (int dj = 0; dj < 8; ++dj) { ot[qi][dj][0] *= alpha; ot[qi][dj][1] *= alpha; ot[qi][dj][2] *= alpha; ot[qi][dj][3] *= alpha; }
        pf[qi][0] = pack8(st[qi][0], st[qi][1]);
        pf[qi][1] = pack8(st[qi][2], st[qi][3]);
        __builtin_amdgcn_sched_barrier(0);
      }
      if (more) {
#pragma unroll
        for (int i = 0; i < 4; ++i) rv[i] = *(const u32x4*)(Vtp + (size_t)i * 32 * kvlen + toffV);
      }
      __builtin_amdgcn_sched_barrier(0);
#pragma unroll
      for (int kk = 0; kk < 2; ++kk)
#pragma unroll
        for (int dj = 0; dj < 8; ++dj) {
          const bf16x8 va = ld8(sV + (dj * 16 + l15) * 64 + (((kk * 4 + g) ^ ((l15 >> 1) & 7)) * 8));
          ot[0][dj] = mma(va, pf[0][kk], ot[0][dj]);
          ot[1][dj] = mma(va, pf[1][kk], ot[1][dj]);
          if ((dj & 3) == 3) __builtin_amdgcn_sched_barrier(0);
        }
    }
#pragma unroll
    for (int qi = 0; qi < 2; ++qi) {
      const float inv = 1.f / sum_g(lrun[qi]);
      u16* dst = obuf + (size_t)(qrow0 + qi * 16 + l15) * 1024 + h * 128 + g * 4;
#pragma unroll
      for (int dj = 0; dj < 8; ++dj) st4bf(dst + dj * 16, ot[qi][dj][0] * inv, ot[qi][dj][1] * inv, ot[qi][dj][2] * inv, ot[qi][dj][3] * inv);
    }
  }
}

DI void gdn_chunk_phase(const P& p, int j, char* smem_raw) {
  const int bid = opaque_bid();
  char* const ws = opaque_ptr(as_global(p.ws));
  u16* sK = (u16*)smem_raw;
  float* sA = (float*)(smem_raw + 17408);
  float* sG = (float*)(smem_raw + 17408 + 32768);
  float* sBt = sG + 128;
  const int tid = opaque_tid(), lane = tid & 63, wid = tid >> 6, l15 = lane & 15, g = lane >> 4;
  const u16* proj = (const u16*)(ws + WS_R + R_PROJ);
  u16* qn = (u16*)(ws + WS_HBUF); u16* kn = (u16*)(ws + WS_OBUF); u16* vb = (u16*)(ws + WS_R + R_VBUF);
  u16* Tbuf = (u16*)(ws + WS_R + R_TBUF);
  const float* gbuf = (const float*)(ws + WS_R + R_GBUF);
  float* gcb = (float*)(ws + WS_R + R_GCB); float* betab = (float*)(ws + WS_R + R_BETA);
  const float* conv = GIN(17) + (size_t)j * 3 * 3072;
  const float* a_log = GIN(18) + j * 16; const float* dt_bias = GIN(19) + j * 16;
  for (int unit = bid; unit < 2560; unit += gridDim.x) {
    const int cgi = unit >> 3, h = unit & 7;
    int c, nch; if (cgi < 64) { c = cgi & 3; nch = 4; } else { c = (cgi - 64) & 31; nch = 32; }
    const int t0 = cgi * 64;
    const bool has_prev = c > 0, has_next = c < nch - 1;
    __syncthreads();
    {
      const int r = tid >> 4, cc = (tid & 15) * 8;
#pragma unroll
      for (int part = 0; part < 3; ++part) {
        const int ch = part * 1024 + h * 128 + cc;
        float w0[8], w1[8], w2[8];
#pragma unroll
        for (int e = 0; e < 8; ++e) { w0[e] = conv[ch + e]; w1[e] = conv[3072 + ch + e]; w2[e] = conv[6144 + ch + e]; }
        u16* dstb = part == 0 ? qn : (part == 1 ? kn : vb);
        for (int it = 0; it < 4; ++it) {
          const int i = it * 16 + r, t = t0 + i;
          const u16* src = proj + (size_t)t * 4096 + ch;
          const u32x4 xc = *(const u32x4*)src;
          u32x4 xp = {0u, 0u, 0u, 0u}, xn = {0u, 0u, 0u, 0u};
          if (i > 0 || has_prev) xp = *(const u32x4*)(src - 4096);
          if (i < 63 || has_next) xn = *(const u32x4*)(src + 4096);
          float y[8];
#pragma unroll
          for (int e = 0; e < 4; ++e) {
            float a = w0[2 * e] * bflo(xp[e]) + w1[2 * e] * bflo(xc[e]) + w2[2 * e] * bflo(xn[e]);
            float b = w0[2 * e + 1] * bfhi(xp[e]) + w1[2 * e + 1] * bfhi(xc[e]) + w2[2 * e + 1] * bfhi(xn[e]);
            y[2 * e] = a / (1.f + __expf(-a)); y[2 * e + 1] = b / (1.f + __expf(-b));
          }
          if (part < 2) {
            float ss = 0.f;
#pragma unroll
            for (int e = 0; e < 8; ++e) ss += y[e] * y[e];
            ss += __shfl_xor(ss, 1); ss += __shfl_xor(ss, 2); ss += __shfl_xor(ss, 4); ss += __shfl_xor(ss, 8);
            const float rs = rsqrtf(ss + EPS) * (part == 0 ? 0.08838834764831845f : 1.f);
#pragma unroll
            for (int e = 0; e < 8; ++e) y[e] *= rs;
          }
          u32x4 o; o[0] = pack2(y[0], y[1]); o[1] = pack2(y[2], y[3]); o[2] = pack2(y[4], y[5]); o[3] = pack2(y[6], y[7]);
          *(u32x4*)(dstb + (size_t)t * 1024 + h * 128 + cc) = o;
          if (part == 1) *(u32x4*)(sK + i * 136 + cc) = o;
        }
      }
    }
    if (tid < 128) {
      const int dir = tid >> 6, L = tid & 63;
      const int i = dir ? 63 - L : L;
      const float* gb = gbuf + (size_t)(t0 + i) * 32;
      const float gin = gb[dir * 8 + h], bin = gb[16 + dir * 8 + h];
      const float x = gin + dt_bias[dir * 8 + h];
      const float sp = fmaxf(x, 0.f) + log1pf(expf(-fabsf(x)));
      float gv = -expf(a_log[dir * 8 + h]) * sp;
      const float bt = 1.f / (1.f + expf(-bin));
#pragma unroll
      for (int off = 1; off < 64; off <<= 1) { const float v = __shfl_up(gv, off); if (L >= off) gv += v; }
      sG[dir * 64 + i] = gv; sBt[dir * 64 + i] = bt;
      gcb[((size_t)(t0 + i) * 8 + h) * 2 + dir] = gv; betab[((size_t)(t0 + i) * 8 + h) * 2 + dir] = bt;
    }
    __syncthreads();
    {
      f32x4 ga[4];
#pragma unroll
      for (int mt = 0; mt < 4; ++mt) { ga[mt][0] = 0.f; ga[mt][1] = 0.f; ga[mt][2] = 0.f; ga[mt][3] = 0.f; }
#pragma unroll
      for (int ks = 0; ks < 4; ++ks) {
        const bf16x8 a = ld8(sK + (wid * 16 + l15) * 136 + ks * 32 + g * 8);
#pragma unroll
        for (int mt = 0; mt < 4; ++mt) { const bf16x8 b = ld8(sK + (mt * 16 + l15) * 136 + ks * 32 + g * 8); ga[mt] = mma(a, b, ga[mt]); }
      }
#pragma unroll
      for (int dir = 0; dir < 2; ++dir)
#pragma unroll
        for (int mt = 0; mt < 4; ++mt)
#pragma unroll
          for (int r = 0; r < 4; ++r) {
            const int i = wid * 16 + g * 4 + r, m = mt * 16 + l15;
            const bool valid = dir ? (i < m) : (i > m);
            const float val = valid ? sBt[dir * 64 + i] * ga[mt][r] * __expf(sG[dir * 64 + i] - sG[dir * 64 + m]) : 0.f;
            const int ii = dir ? 63 - i : i, mm = dir ? 63 - m : m;
            sA[dir * 4096 + ii * 64 + mm] = val;
          }
    }
    __syncthreads();
    if (wid < 2) {
      const int dir = wid;
      float* Am = sA + dir * 4096;
      for (int i = 0; i < 64; ++i) {
        float a = (i == lane) ? 1.f : 0.f;
        int m = 0;
        for (; m + 8 <= i; m += 8) {
          const float4 a0 = *(const float4*)(Am + i * 64 + m), a1 = *(const float4*)(Am + i * 64 + m + 4);
          float tv[8];
#pragma unroll
          for (int e = 0; e < 8; ++e) tv[e] = Am[(m + e) * 64 + lane];
          a -= a0.x * tv[0]; a -= a0.y * tv[1]; a -= a0.z * tv[2]; a -= a0.w * tv[3];
          a -= a1.x * tv[4]; a -= a1.y * tv[5]; a -= a1.z * tv[6]; a -= a1.w * tv[7];
        }
        for (; m < i; ++m) a -= Am[i * 64 + m] * Am[m * 64 + lane];
        Am[i * 64 + lane] = a;
      }
      const int mn = dir ? 63 - lane : lane;
      const float bm = sBt[dir * 64 + mn];
      u16* Td = Tbuf + ((size_t)unit * 2 + dir) * 4096;
#pragma unroll 4
      for (int i = 0; i < 64; ++i) { const int in_ = dir ? 63 - i : i; Td[in_ * 64 + mn] = f2bf(Am[i * 64 + lane] * bm); }
    }
  }
}

DI void gdn_scan_phase(const P& p, int j, char* smem_raw) {
  const int bid = opaque_bid();
  char* const ws = opaque_ptr(as_global(p.ws));
  u16* sK = (u16*)smem_raw;
  u16* sKT = sK + 64 * 136;
  u16* sVT = sKT + 128 * 72;
  u16* sST = sVT + 32 * 72;
  u16* sVN = sST + 32 * 136;
  u16* sVD = sVN + 32 * 72;
  float* sGc = (float*)(sVD + 32 * 72);
  const int tid = opaque_tid(), lane = tid & 63, w = tid >> 6, l15 = lane & 15, g = lane >> 4;
  const u16* qn = (const u16*)(ws + WS_HBUF); const u16* kn = (const u16*)(ws + WS_OBUF); const u16* vb = (const u16*)(ws + WS_R + R_VBUF);
  const u16* Tbuf = (const u16*)(ws + WS_R + R_TBUF);
  const float* gcb = (const float*)(ws + WS_R + R_GCB);
  u16* obase = (u16*)(ws + WS_R + R_PROJ);
  for (int wk = bid; wk < 1536; wk += gridDim.x) {
    int seq, rem;
    if (wk < 512) { seq = 16 + (wk >> 6); rem = wk & 63; } else { seq = (wk - 512) >> 6; rem = (wk - 512) & 63; }
    const int h = rem >> 3, dir = (rem >> 2) & 1, dvq = rem & 3;
    const int nch = seq < 16 ? 4 : 32;
    const int cgb = seq < 16 ? seq * 4 : 64 + (seq - 16) * 32;
    f32x4 S[2][2];
    if (seq >= 16) {
      const float* s0 = GIN(2 + dir) + (((size_t)(seq - 16) * 2 + j) * 8 + h) * 16384;
#pragma unroll
      for (int dt = 0; dt < 2; ++dt)
#pragma unroll
        for (int et = 0; et < 2; ++et)
#pragma unroll
          for (int r = 0; r < 4; ++r) S[dt][et][r] = s0[(size_t)(w * 32 + dt * 16 + g * 4 + r) * 128 + dvq * 32 + et * 16 + l15];
    } else {
#pragma unroll
      for (int dt = 0; dt < 2; ++dt)
#pragma unroll
        for (int et = 0; et < 2; ++et) { S[dt][et][0] = 0.f; S[dt][et][1] = 0.f; S[dt][et][2] = 0.f; S[dt][et][3] = 0.f; }
    }
    __syncthreads();
#pragma unroll
    for (int dt = 0; dt < 2; ++dt)
#pragma unroll
      for (int et = 0; et < 2; ++et) st4bf(sST + (et * 16 + l15) * 136 + w * 32 + dt * 16 + g * 4, S[dt][et][0], S[dt][et][1], S[dt][et][2], S[dt][et][3]);
    u32x4 pk[4], pv; bf16x8 pq[4], pt[2]; float pg = 0.f;
#define SCAN_PREFETCH(cc) do { \
      const int t0n_ = (cgb + (cc)) * 64; const int unitn_ = (cgb + (cc)) * 8 + h; \
      _Pragma("unroll") for (int i = 0; i < 4; ++i) { const int row = tid & 63, dc = ((tid >> 6) + 4 * i) * 8; pk[i] = *(const u32x4*)(kn + (size_t)(t0n_ + row) * 1024 + h * 128 + dc); } \
      { const int row = tid & 63, ec = (tid >> 6) * 8; pv = *(const u32x4*)(vb + (size_t)(t0n_ + row) * 1024 + h * 128 + dvq * 32 + ec); } \
      if (tid < 64) pg = gcb[((size_t)(t0n_ + tid) * 8 + h) * 2 + dir]; \
      _Pragma("unroll") for (int ks = 0; ks < 4; ++ks) pq[ks] = ld8(qn + (size_t)(t0n_ + w * 16 + l15) * 1024 + h * 128 + ks * 32 + g * 8); \
      _Pragma("unroll") for (int ks = 0; ks < 2; ++ks) pt[ks] = ld8(Tbuf + ((size_t)unitn_ * 2 + dir) * 4096 + (w * 16 + l15) * 64 + ks * 32 + g * 8); \
    } while (0)
    SCAN_PREFETCH(dir ? nch - 1 : 0);
    for (int step = 0; step < nch; ++step) {
      const int c = dir ? nch - 1 - step : step;
      const int t0 = (cgb + c) * 64;
      const int unit = (cgb + c) * 8 + h;
#pragma unroll
      for (int i = 0; i < 4; ++i) {
        const int row = tid & 63, dc = ((tid >> 6) + 4 * i) * 8;
        const u32x4 v = pk[i];
        *(u32x4*)(sK + row * 136 + dc) = v;
#pragma unroll
        for (int e = 0; e < 4; ++e) { sKT[(dc + 2 * e) * 72 + row] = (u16)(v[e] & 0xffffu); sKT[(dc + 2 * e + 1) * 72 + row] = (u16)(v[e] >> 16); }
      }
      {
        const int row = tid & 63, ec = (tid >> 6) * 8;
        const u32x4 v = pv;
#pragma unroll
        for (int e = 0; e < 4; ++e) { sVT[(ec + 2 * e) * 72 + row] = (u16)(v[e] & 0xffffu); sVT[(ec + 2 * e + 1) * 72 + row] = (u16)(v[e] >> 16); }
      }
      if (tid < 64) sGc[tid] = pg;
      bf16x8 qf[4], tf[2];
#pragma unroll
      for (int ks = 0; ks < 4; ++ks) qf[ks] = pq[ks];
#pragma unroll
      for (int ks = 0; ks < 2; ++ks) tf[ks] = pt[ks];
      __syncthreads();
      if (step + 1 < nch) { const int cn = dir ? nch - 2 - step : step + 1; SCAN_PREFETCH(cn); }
      const float gl = dir ? sGc[0] : sGc[63];
      f32x4 ua[2];
#pragma unroll
      for (int et = 0; et < 2; ++et) {
        ua[et][0] = 0.f; ua[et][1] = 0.f; ua[et][2] = 0.f; ua[et][3] = 0.f;
#pragma unroll
        for (int ks = 0; ks < 2; ++ks) ua[et] = mma(tf[ks], ld8(sVT + (et * 16 + l15) * 72 + ks * 32 + g * 8), ua[et]);
      }
      bf16x8 tf2[2];
#pragma unroll
      for (int ks = 0; ks < 2; ++ks) {
        const u32x4 tw = __builtin_bit_cast(u32x4, tf[ks]);
        u32x4 o;
#pragma unroll
        for (int e = 0; e < 4; ++e) {
          const int m = ks * 32 + g * 8 + 2 * e;
          o[e] = pack2(bflo(tw[e]) * __expf(sGc[m]), bfhi(tw[e]) * __expf(sGc[m + 1]));
        }
        tf2[ks] = __builtin_bit_cast(bf16x8, o);
      }
      bf16x8 wf[4];
#pragma unroll
      for (int kq = 0; kq < 4; ++kq) {
        f32x4 wa[2];
#pragma unroll
        for (int hh = 0; hh < 2; ++hh) {
          const int dt = kq * 2 + hh;
          wa[hh][0] = 0.f; wa[hh][1] = 0.f; wa[hh][2] = 0.f; wa[hh][3] = 0.f;
#pragma unroll
          for (int ks = 0; ks < 2; ++ks) wa[hh] = mma(ld8(sKT + (dt * 16 + l15) * 72 + ks * 32 + g * 8), tf2[ks], wa[hh]);
        }
        wf[kq] = pack8(wa[0], wa[1]);
      }
      f32x4 vn[2];
#pragma unroll
      for (int et = 0; et < 2; ++et) {
        f32x4 a; a[0] = 0.f; a[1] = 0.f; a[2] = 0.f; a[3] = 0.f;
#pragma unroll
        for (int kq = 0; kq < 4; ++kq) { const u16* sp = sST + (et * 16 + l15) * 136 + kq * 32 + g * 4; a = mma(wf[kq], ld44(sp, sp + 16), a); }
        vn[et][0] = ua[et][0] - a[0]; vn[et][1] = ua[et][1] - a[1]; vn[et][2] = ua[et][2] - a[2]; vn[et][3] = ua[et][3] - a[3];
      }
      bf16x8 qkf[2];
      {
        const int iq = w * 16 + l15;
        const float gi = sGc[iq];
#pragma unroll
        for (int kk = 0; kk < 2; ++kk) {
          f32x4 ka[2];
#pragma unroll
          for (int hh = 0; hh < 2; ++hh) {
            const int mt = kk * 2 + hh;
            ka[hh][0] = 0.f; ka[hh][1] = 0.f; ka[hh][2] = 0.f; ka[hh][3] = 0.f;
#pragma unroll
            for (int ks = 0; ks < 4; ++ks) ka[hh] = mma(ld8(sK + (mt * 16 + l15) * 136 + ks * 32 + g * 8), qf[ks], ka[hh]);
#pragma unroll
            for (int r = 0; r < 4; ++r) {
              const int m = mt * 16 + g * 4 + r;
              const bool valid = dir ? (iq <= m) : (iq >= m);
              ka[hh][r] = valid ? ka[hh][r] * __expf(gi - sGc[m]) : 0.f;
            }
          }
          qkf[kk] = pack8(ka[0], ka[1]);
        }
      }
#pragma unroll
      for (int et = 0; et < 2; ++et) {
        const int i0 = w * 16 + g * 4;
        st4bf(sVN + (et * 16 + l15) * 72 + i0, vn[et][0], vn[et][1], vn[et][2], vn[et][3]);
        st4bf(sVD + (et * 16 + l15) * 72 + i0, vn[et][0] * __expf(gl - sGc[i0]), vn[et][1] * __expf(gl - sGc[i0 + 1]), vn[et][2] * __expf(gl - sGc[i0 + 2]), vn[et][3] * __expf(gl - sGc[i0 + 3]));
      }
      __syncthreads();
#pragma unroll
      for (int et = 0; et < 2; ++et) {
        f32x4 a1; a1[0] = 0.f; a1[1] = 0.f; a1[2] = 0.f; a1[3] = 0.f;
#pragma unroll
        for (int ks = 0; ks < 4; ++ks) a1 = mma(qf[ks], ld8(sST + (et * 16 + l15) * 136 + ks * 32 + g * 8), a1);
        f32x4 a2; a2[0] = 0.f; a2[1] = 0.f; a2[2] = 0.f; a2[3] = 0.f;
#pragma unroll
        for (int kk = 0; kk < 2; ++kk) { const u16* sp = sVN + (et * 16 + l15) * 72 + kk * 32 + g * 4; a2 = mma(qkf[kk], ld44(sp, sp + 16), a2); }
#pragma unroll
        for (int r = 0; r < 4; ++r) {
          const int i = w * 16 + g * 4 + r;
          const float o = a1[r] * __expf(sGc[i]) + a2[r];
          obase[(size_t)(t0 + i) * 4096 + dir * 1024 + h * 128 + dvq * 32 + et * 16 + l15] = f2bf(o);
        }
      }
      {
        const float eg = __expf(gl);
#pragma unroll
        for (int dt = 0; dt < 2; ++dt)
#pragma unroll
          for (int et = 0; et < 2; ++et) {
            f32x4 a; a[0] = S[dt][et][0] * eg; a[1] = S[dt][et][1] * eg; a[2] = S[dt][et][2] * eg; a[3] = S[dt][et][3] * eg;
#pragma unroll
            for (int kk = 0; kk < 2; ++kk) a = mma(ld8(sKT + (w * 32 + dt * 16 + l15) * 72 + kk * 32 + g * 8), ld8(sVD + (et * 16 + l15) * 72 + kk * 32 + g * 8), a);
            S[dt][et] = a;
          }
      }
      __syncthreads();
#pragma unroll
      for (int dt = 0; dt < 2; ++dt)
#pragma unroll
        for (int et = 0; et < 2; ++et) st4bf(sST + (et * 16 + l15) * 136 + w * 32 + dt * 16 + g * 4, S[dt][et][0], S[dt][et][1], S[dt][et][2], S[dt][et][3]);
    }
    if (seq < 16) {
      float* so = GOUT + (dir ? O_SB : O_SF) + (((size_t)seq * 2 + j) * 8 + h) * 16384;
#pragma unroll
      for (int dt = 0; dt < 2; ++dt)
#pragma unroll
        for (int et = 0; et < 2; ++et)
#pragma unroll
          for (int r = 0; r < 4; ++r) so[(size_t)(w * 32 + dt * 16 + g * 4 + r) * 128 + dvq * 32 + et * 16 + l15] = S[dt][et][r];
    }
  }
}

#define XB_TMO      128
#define XB_XCNT(j)  (256  + 64 * (j))
#define XB_XSUB(j)  (1280 + 64 * (j))
#define XB_XGEN(j)  (2304 + 64 * (j))
#define XB_TOP      3328
#define XB_TOPGEN   3392
#define XCD_BAR_WORDS 3456
#define XB_SPIN_CAP (1u << 20)
#define LAS __attribute__((address_space(3)))
DI unsigned xb_ld(unsigned* p)              { return __hip_atomic_load(p, __ATOMIC_RELAXED, __HIP_MEMORY_SCOPE_AGENT); }
DI unsigned xb_add(unsigned* p, unsigned v) { return __hip_atomic_fetch_add(p, v, __ATOMIC_RELAXED, __HIP_MEMORY_SCOPE_AGENT); }
DI unsigned xb_xcc_id() { return (unsigned)__builtin_amdgcn_s_getreg((3 << 11) | 20) & 0xFu; }
#define XB_SPIN(cond, bar) do { unsigned _sp = 0; while (cond) { __builtin_amdgcn_s_sleep(1); \
    if ((++_sp & 255u) == 0u) { if (xb_ld(&(bar)[XB_TMO])) break; if (_sp > XB_SPIN_CAP) { atomicAdd(&(bar)[XB_TMO], 1u); break; } } } } while (0)
struct XcdBarrier { unsigned* bar; unsigned x; volatile LAS unsigned* st; };
DI XcdBarrier xcd_barrier_post(unsigned* bar, volatile LAS unsigned* st) {
  XcdBarrier b; b.bar = bar; b.x = xb_xcc_id(); b.st = st;
  if (threadIdx.x == 0) (void)xb_add(&bar[XB_XCNT(b.x)], 1u);
  return b;
}
DI void xcd_barrier_complete(unsigned* bar, unsigned x, unsigned& nloc, unsigned& nx) {
  const unsigned Gn = gridDim.x * gridDim.y * gridDim.z;
  unsigned sum, cnt, mine, sp = 0u;
  for (;;) {
    sum = 0u; cnt = 0u; mine = 0u;
#pragma unroll
    for (unsigned j = 0; j < 16; ++j) { const unsigned c = xb_ld(&bar[XB_XCNT(j)]); sum += c; cnt += (c > 0u) ? 1u : 0u; mine = (j == x) ? c : mine; }
    if (sum == Gn) break;
    __builtin_amdgcn_s_sleep(1);
    if ((++sp & 255u) == 0u) { if (xb_ld(&bar[XB_TMO])) break; if (sp > XB_SPIN_CAP) { atomicAdd(&bar[XB_TMO], 1u); break; } }
  }
  nloc = mine > 0u ? mine : 1u; nx = cnt > 0u ? cnt : 1u;
}
DI void xcd_barrier(const XcdBarrier& b) {
  asm volatile("s_waitcnt vmcnt(0)" ::: "memory");
  __syncthreads();
  if (threadIdx.x == 0) {
    unsigned* bar = b.bar;
    __builtin_amdgcn_s_waitcnt(0);
    unsigned nloc = b.st[0], nx = b.st[1];
    if (nloc == 0u) { xcd_barrier_complete(bar, b.x, nloc, nx); b.st[0] = nloc; b.st[1] = nx; }
    const unsigned old = xb_add(&bar[XB_XSUB(b.x)], 1u);
    const unsigned gen = old / nloc;
    if (old + 1u == (gen + 1u) * nloc) {
      __builtin_amdgcn_fence(__ATOMIC_RELEASE, "agent");
      asm volatile("s_waitcnt vmcnt(0)" ::: "memory");
      const unsigned og = xb_add(&bar[XB_TOP], 1u);
      const unsigned tg = og / nx;
      if (og + 1u == (tg + 1u) * nx) xb_add(&bar[XB_TOPGEN], 1u);
      else XB_SPIN(xb_ld(&bar[XB_TOPGEN]) == tg, bar);
      __builtin_amdgcn_fence(__ATOMIC_ACQUIRE, "agent");
      xb_add(&bar[XB_XGEN(b.x)], 1u);
      asm volatile("s_waitcnt vmcnt(0)" ::: "memory");
    } else {
      XB_SPIN(xb_ld(&bar[XB_XGEN(b.x)]) == gen, bar);
      __builtin_amdgcn_fence(__ATOMIC_ACQUIRE, "agent");
      asm volatile("s_waitcnt vmcnt(0)" ::: "memory");
    }
  }
  __syncthreads();
}

__global__ void __launch_bounds__(256, 2) fwd_megakernel(P p) {
  cg::grid_group grid = cg::this_grid();
  __shared__ __attribute__((aligned(16))) char smem[60416];
  const int tid = opaque_tid(), lane = tid & 63, wid = tid >> 6;
  const int G = gridDim.x;
  __shared__ uint4 xb_words;
  if (threadIdx.x == 0) xb_words = make_uint4(0u, 0u, 0u, 0u);
  __syncthreads();
  (void)xcd_barrier_post((unsigned*)(as_global(p.ws) + WS_BAR), (volatile LAS unsigned*)&xb_words);
#define GSYNC() do { XcdBarrier xb_; xb_.bar = (unsigned*)(opaque_ptr(as_global(p.ws)) + WS_BAR); xb_.x = xb_xcc_id(); xb_.st = (volatile LAS unsigned*)&xb_words; xcd_barrier(xb_); } while (0)
  const int bid0 = opaque_bid();
  {
  char* const ws0 = opaque_ptr(as_global(p.ws));
  float* mods = (float*)(ws0 + WS_MODS);
  float* ropeT = (float*)(ws0 + WS_ROPE);
  float* cosG = ropeT, *sinG = ropeT + 2048, *cosM = ropeT + 4096, *sinM = ropeT + 5120;

  {
    float* sc = (float*)smem;
    float* red = sc + 9 * 128;
    float* part = (float*)(ws0 + WS_R);
    for (int item = bid0; item < 3072; item += G) {
      const int ks = item & 7, cgp = (item >> 3) % 96, layer = item / 768;
      __syncthreads();
      for (int e = tid; e < 9 * 128; e += 256) {
        const int ci = e >> 7, k = ks * 128 + (e & 127);
        const float v = ci == 0 ? GIN(9)[k] : GIN(8)[(ci - 1) * 1024 + k];
        sc[e] = v / (1.f + expf(-v));
      }
      __syncthreads();
      const int col = tid & 63, kg = tid >> 6;
      const float* wp = GIN(12) + ((size_t)layer * 1024 + ks * 128 + kg * 32) * 6144 + cgp * 64 + col;
      float acc[9];
#pragma unroll
      for (int ci = 0; ci < 9; ++ci) acc[ci] = 0.f;
#pragma unroll 8
      for (int kk = 0; kk < 32; ++kk) {
        const float wv = wp[(size_t)kk * 6144];
#pragma unroll
        for (int ci = 0; ci < 9; ++ci) acc[ci] += sc[ci * 128 + kg * 32 + kk] * wv;
      }
#pragma unroll
      for (int ci = 0; ci < 9; ++ci) red[(kg * 64 + col) * 9 + ci] = acc[ci];
      __syncthreads();
      if (kg == 0) {
        const int n = cgp * 64 + col;
        const float bias = ks == 0 ? GIN(13)[(size_t)layer * 6144 + n] : 0.f;
#pragma unroll
        for (int ci = 0; ci < 9; ++ci) {
          const float s = red[col * 9 + ci] + red[(64 + col) * 9 + ci] + red[(128 + col) * 9 + ci] + red[(192 + col) * 9 + ci] + bias;
          part[(size_t)ks * 221184 + ((size_t)layer * 9 + ci) * 6144 + n] = s;
        }
      }
    }
    if (bid0 == G - 1) {
      for (int e = tid; e < 2048; e += 256) { const int pos = e >> 5, f = e & 31; const float fr = powf(10000.f, -(float)f / 32.f); const float a = (float)pos * fr; cosG[e] = cosf(a); sinG[e] = sinf(a); }
      for (int e = tid; e < 1024; e += 256) { const int pos = e >> 4, f = e & 15; const float fr = powf(10000.f, -(float)f / 16.f); const float a = (float)pos * fr; cosM[e] = cosf(a); sinM[e] = sinf(a); }
    }
  }
  if (gridDim.x == 0x7fffffffu) grid.sync();
  GSYNC();
  {
    const float* part = (const float*)(ws0 + WS_R);
    for (int e = bid0 * 256 + tid; e < 221184; e += G * 256) {
      float sacc = 0.f;
#pragma unroll
      for (int ks = 0; ks < 8; ++ks) sacc += part[(size_t)ks * 221184 + e];
      mods[e] = sacc;
    }
  }
  }
  GSYNC();

#pragma unroll 1
  for (int layer = 0; layer < 4; ++layer) {
    const int kind = layer % 3, j = layer / 3;
    const int bid = opaque_bid();
    char* const ws = opaque_ptr(as_global(p.ws));
    float* mods = (float*)(ws + WS_MODS);
    float* ropeT = (float*)(ws + WS_ROPE);
    float* cosG = ropeT, *sinG = ropeT + 2048, *cosM = ropeT + 4096, *sinM = ropeT + 5120;
    u16* hbuf = (u16*)(ws + WS_HBUF);
    u16* obuf = (u16*)(ws + WS_OBUF);
    u16* wmix = (u16*)(ws + WS_WMIX);
    u16* wmlp = (u16*)(ws + WS_WMLP);
    char* R = ws + WS_R;
    const float* lmods = mods + (size_t)layer * 9 * 6144;
    {
      for (int it = bid; it < 5120; it += G) norm_rows(p, layer, layer == 0, it, GIN(10) + layer * 1024, 0, 1);
      float* sT = (float*)smem;
      for (int it = bid; it < 2048; it += G) {
        if (it < 1024) convert_tile(GIN(14) + (size_t)layer * 1024 * 4096, 1024, 4096, wmlp, it, 0, sT);
        else convert_tile(GIN(15) + (size_t)layer * 4096 * 1024, 4096, 1024, wmlp + 4194304, it - 1024, 0, sT);
      }
      if (kind == 0) {
        for (int it = bid; it < 1056 + 256; it += G) {
          if (it < 1056) convert_tile(GIN(16) + (size_t)j * 1024 * 4128, 1024, 4128, wmix + WM_IN, it, 0, sT);
          else convert_tile(GIN(21) + (size_t)j * 1024 * 1024, 1024, 1024, wmix + WM_OUT, it - 1056, 0, sT);
        }
      } else if (kind == 1) {
        for (int it = bid; it < 192 + 144 + 128 + 256; it += G) {
          if (it < 192) convert_tile(GIN(22), 1024, 704, wmix + WM_IN, it, 0, sT);
          else if (it < 336) convert_tile(GIN(25), 384, 1536, wmix + WM_UQ, it - 192, 1, sT);
          else if (it < 464) convert_tile(GIN(26), 256, 2048, wmix + WM_UKV, it - 336, 0, sT);
          else convert_tile(GIN(31), 1024, 1024, wmix + WM_OUT, it - 464, 0, sT);
        }
      } else {
        for (int it = bid; it < 384 + 256; it += G) {
          if (it < 384) convert_tile(GIN(32), 1024, 1536, wmix + WM_IN, it, 0, sT);
          else convert_tile(GIN(35), 1024, 1024, wmix + WM_OUT, it - 384, 0, sT);
        }
        u16* Kg = (u16*)(R + R_KG); u16* Vg = (u16*)(R + R_VTG);
        const int tid = opaque_tid();
        for (int it = bid; it < 512; it += G) {
          const int b = it >> 6, s0 = (it & 63) * 8;
          const int ch = tid;
          float kv[8], vv[8];
#pragma unroll
          for (int e = 0; e < 8; ++e) { kv[e] = GIN(6)[((size_t)b * 512 + s0 + e) * 256 + ch]; vv[e] = GIN(7)[((size_t)b * 512 + s0 + e) * 256 + ch]; }
#pragma unroll
          for (int e = 0; e < 8; ++e) Kg[(size_t)(NPROMPT + b * 2560 + s0 + e) * 256 + ch] = f2bf(kv[e]);
          u32x4 o; o[0] = pack2(vv[0], vv[1]); o[1] = pack2(vv[2], vv[3]); o[2] = pack2(vv[4], vv[5]); o[3] = pack2(vv[6], vv[7]);
          *(u32x4*)(Vg + (size_t)(NPROMPT + b * 2560) * 256 + (size_t)ch * 2560 + s0) = o;
        }
      }
    }
    GSYNC();

    if (kind == 0) {
      {
        EpiGdnIn epi; epi.proj = (u16*)(R + R_PROJ); epi.gbuf = (float*)(R + R_GBUF);
        for (int it = bid; it < 160 * 33; it += G) { const int mt = it / 33, nt = it % 33; gemm_tile<4>(hbuf, 1024, wmix + WM_IN, 1024, 1024, mt * 128, nt * 128, (u16*)smem, epi); }
      }
      GSYNC();
      gdn_chunk_phase(p, j, smem);
      GSYNC();
      gdn_scan_phase(p, j, smem);
      GSYNC();
      {
        const u16* pr = (const u16*)(R + R_PROJ);
        const float* on = GIN(20) + j * 128;
        const int tid = opaque_tid();
        for (int t = bid; t < NTOK; t += G) {
          const int h = tid >> 5, c = (tid & 31) * 4;
          const u16* row = pr + (size_t)t * 4096;
          const u32x2 f = *(const u32x2*)(row + h * 128 + c), b = *(const u32x2*)(row + 1024 + h * 128 + c), z = *(const u32x2*)(row + 3072 + h * 128 + c);
          float o[4] = {bflo(f[0]) + bflo(b[0]), bfhi(f[0]) + bfhi(b[0]), bflo(f[1]) + bflo(b[1]), bfhi(f[1]) + bfhi(b[1])};
          float zz[4] = {bflo(z[0]), bfhi(z[0]), bflo(z[1]), bfhi(z[1])};
          float ss = o[0] * o[0] + o[1] * o[1] + o[2] * o[2] + o[3] * o[3];
          ss += __shfl_xor(ss, 1); ss += __shfl_xor(ss, 2); ss += __shfl_xor(ss, 4); ss += __shfl_xor(ss, 8); ss += __shfl_xor(ss, 16);
          const float rs = rsqrtf(ss * (1.f / 128.f) + EPS);
          const float4 gn = *(const float4*)(on + c);
          const float gg[4] = {gn.x, gn.y, gn.z, gn.w};
          float y[4];
#pragma unroll
          for (int e = 0; e < 4; ++e) y[e] = o[e] * rs * gg[e] * (zz[e] / (1.f + __expf(-zz[e])));
          st4bf(obuf + (size_t)t * 1024 + h * 128 + c, y[0], y[1], y[2], y[3]);
        }
      }
      GSYNC();
    } else if (kind == 1) {
      {
        EpiF32 epi; epi.dst = (float*)(R + R_DPROJ); epi.ld = 768;
        for (int it = bid; it < 160 * 6; it += G) { const int mt = it / 6, nt = it % 6; gemm_tile<4>(hbuf, 1024, wmix + WM_IN, 1024, 1024, mt * 128, nt * 128, (u16*)smem, epi); }
      }
      GSYNC();
      {
        const float* dproj = (const float*)(R + R_DPROJ);
        u16* cq = (u16*)(R + R_CQ); u16* ckv = (u16*)(R + R_CKV); u16* Km = (u16*)(R + R_KM);
        const int tid = opaque_tid(), lane = tid & 63, wid = tid >> 6;
        for (int it = bid; it < 6144; it += G) {
          const int row = it * 4 + wid;
          if (row < NTOK) {
            const int t = row;
            const float* pr = dproj + (size_t)t * 768;
            float v[6]; float ss = 0.f;
#pragma unroll
            for (int e = 0; e < 6; ++e) { v[e] = pr[lane + 64 * e]; ss += v[e] * v[e]; }
            ss = wave_sum(ss);
            float rs = rsqrtf(ss * (1.f / 384.f) + EPS);
#pragma unroll
            for (int e = 0; e < 6; ++e) cq[(size_t)t * 384 + lane + 64 * e] = f2bf(v[e] * rs * GIN(23)[lane + 64 * e]);
            const int kvrow = kvrow_of_tok(t);
            float wv[4]; ss = 0.f;
#pragma unroll
            for (int e = 0; e < 4; ++e) { wv[e] = pr[384 + lane + 64 * e]; ss += wv[e] * wv[e]; }
            ss = wave_sum(ss);
            rs = rsqrtf(ss * (1.f / 256.f) + EPS);
#pragma unroll
            for (int e = 0; e < 4; ++e) {
              const float o = wv[e] * rs * GIN(24)[lane + 64 * e];
              ckv[(size_t)kvrow * 256 + lane + 64 * e] = f2bf(o);
              if (t < NPROMPT) GOUT[O_CKV + (size_t)t * 256 + lane + 64 * e] = o;
            }
            const float x = pr[640 + lane];
            ss = wave_sum(x * x);
            float kr = x * rsqrtf(ss * (1.f / 64.f) + EPS) * GIN(30)[lane];
            if (t < NPROMPT) GOUT[O_KR + (size_t)t * 64 + lane] = kr;
            else {
              const int s = (t - NPROMPT) & 2047;
              const int pos = lane < 32 ? (s >> 6) : (s & 63);
              const float cs = cosM[pos * 16 + (lane & 15)], sn = sinM[pos * 16 + (lane & 15)];
              const float partner = __shfl_xor(kr, 16);
              kr = ((lane & 16) == 0) ? kr * cs - partner * sn : partner * sn + kr * cs;
            }
            const u16 kb = f2bf(kr);
#pragma unroll
            for (int hh = 0; hh < 8; ++hh) Km[(size_t)kvrow * 1536 + hh * 192 + 128 + lane] = kb;
          } else {
            const int r = row - NTOK; const int b = r >> 9, s = r & 511;
            const int kvrow = NPROMPT + b * 2560 + s;
#pragma unroll
            for (int e = 0; e < 4; ++e) ckv[(size_t)kvrow * 256 + lane + 64 * e] = f2bf(GIN(4)[((size_t)b * 512 + s) * 256 + lane + 64 * e]);
            const u16 kb = f2bf(GIN(5)[((size_t)b * 512 + s) * 64 + lane]);
#pragma unroll
            for (int hh = 0; hh < 8; ++hh) Km[(size_t)kvrow * 1536 + hh * 192 + 128 + lane] = kb;
          }
        }
      }
      GSYNC();
      {
        EpiMlaUq e1; e1.Q = (u16*)(R + R_Q); e1.gnope = GIN(27); e1.grope = GIN(28); e1.cosT = cosM; e1.sinT = sinM;
        for (int it = bid; it < 160 * 12; it += G) { const int mt = it / 12, nt = it % 12; gemm_tile<8>((const u16*)(R + R_CQ), 384, wmix + WM_UQ, 384, 384, mt * 128, nt * 128, (u16*)smem, e1); }
        EpiMlaUkv e2; e2.Kb = (u16*)(R + R_KM); e2.Vt = (u16*)(R + R_VTM); e2.gnope = GIN(29);
        for (int it = bid; it < 192 * 16; it += G) { const int mt = it / 16, nt = it % 16; gemm_tile<8>((const u16*)(R + R_CKV), 256, wmix + WM_UKV, 256, 256, mt * 128, nt * 128, (u16*)smem, e2); }
      }
      GSYNC();
      attn_phase<192, 8>((const u16*)(R + R_Q), (const u16*)(R + R_KM), (const u16*)(R + R_VTM), obuf, smem);
      GSYNC();
    } else {
      {
        EpiGqaIn epi; epi.Q = (u16*)(R + R_Q); epi.Kb = (u16*)(R + R_KG); epi.Vt = (u16*)(R + R_VTG); epi.qg = GIN(33); epi.kg = GIN(34); epi.cosT = cosG; epi.sinT = sinG; epi.out = GOUT;
        for (int it = bid; it < 160 * 12; it += G) { const int mt = it / 12, nt = it % 12; gemm_tile<8>(hbuf, 1024, wmix + WM_IN, 1024, 1024, mt * 128, nt * 128, (u16*)smem, epi); }
      }
      GSYNC();
      attn_phase<128, 2>((const u16*)(R + R_Q), (const u16*)(R + R_KG), (const u16*)(R + R_VTG), obuf, smem);
      GSYNC();
    }

    for (int it = bid; it < 160 * 8; it += G) {
      const int mt = it >> 3, nt = it & 7; const int m0 = mt * 128;
      EpiResid epi;
      epi.xin = (layer == 0) ? (m0 < NPROMPT ? GIN(0) : GIN(1) - (size_t)NPROMPT * 1024) : GOUT;
      epi.xout = GOUT; epi.gate = lmods + (size_t)cond_of(m0) * 6144 + 2 * 1024;
      gemm_tile<4>(obuf, 1024, wmix + WM_OUT, 1024, 1024, m0, nt * 128, (u16*)smem, epi);
    }
    GSYNC();
    for (int it = bid; it < 5120; it += G) norm_rows(p, layer, false, it, GIN(11) + layer * 1024, 3, 4);
    GSYNC();
    {
      EpiMlpIn epi; epi.abuf = (u16*)(R + R_ABUF);
      for (int it = bid; it < 160 * 32; it += G) { const int mt = it >> 5, nt = it & 31; gemm_tile<4>(hbuf, 1024, wmlp, 1024, 1024, mt * 128, nt * 128, (u16*)smem, epi); }
    }
    GSYNC();
    for (int it = bid; it < 160 * 8; it += G) {
      const int mt = it >> 3, nt = it & 7; const int m0 = mt * 128;
      EpiResid epi; epi.xin = GOUT; epi.xout = GOUT; epi.gate = lmods + (size_t)cond_of(m0) * 6144 + 5 * 1024;
      gemm_tile<4>((const u16*)(R + R_ABUF), 4096, wmlp + 4194304, 4096, 4096, m0, nt * 128, (u16*)smem, epi);
    }
    GSYNC();
  }
}

extern "C" void kernel_launch(void* const* d_in, const int* in_sizes, int n_in, void* d_out, int out_size, void* d_ws, size_t ws_size, hipStream_t stream) {
  static int grid_blocks = 0;
  if (!grid_blocks) {
    int dev = 0, cus = 0, per_cu = 0;
    hipGetDevice(&dev);
    hipDeviceGetAttribute(&cus, hipDeviceAttributeMultiprocessorCount, dev);
    hipOccupancyMaxActiveBlocksPerMultiprocessor(&per_cu, fwd_megakernel, 256, 0);
    if (per_cu < 1) per_cu = 1;
    if (per_cu > 2) per_cu = 2;
    grid_blocks = cus * per_cu;
  }
  P p{};
  for (int i = 0; i < 36; ++i) p.in[i] = (const float*)d_in[i];
  p.out = (float*)d_out;
  p.ws = (char*)d_ws;
  (void)hipMemsetAsync((char*)d_ws + WS_BAR, 0, XCD_BAR_WORDS * 4, stream);
  void* args[] = {&p};
  hipError_t e = hipLaunchCooperativeKernel((void*)fwd_megakernel, dim3(grid_blocks), dim3(256), args, 0, stream);
  if (e != hipSuccess) fprintf(stderr, "cooperative launch failed: %s (grid %d)\n", hipGetErrorString(e), grid_blocks);
}
```

```cpp
#include <hip/hip_runtime.h>
#include <hip/hip_cooperative_groups.h>
#include <cstdio>
namespace cg = cooperative_groups;

typedef unsigned short u16;
typedef __attribute__((ext_vector_type(8))) short bf16x8;
typedef __attribute__((ext_vector_type(4))) short bf16x4;
typedef __attribute__((ext_vector_type(4))) float f32x4;
typedef __attribute__((ext_vector_type(4))) unsigned u32x4;
typedef __attribute__((ext_vector_type(2))) unsigned u32x2;

#define DI __device__ __forceinline__

constexpr int NTOK = 20480;
constexpr int NPROMPT = 4096;
constexpr float EPS = 1e-6f;

constexpr size_t WS_MODS = 0;
constexpr size_t MODS_BYTES = 4ull * 9 * 6144 * 4;
constexpr size_t WS_BAR = 917504;
constexpr size_t WS_ROPE = 1048576;
constexpr size_t WS_WMIX = 1114112;
constexpr size_t WS_WMLP = 14090240;
constexpr size_t WS_HBUF = 30867456;
constexpr size_t WS_OBUF = 72810496;
constexpr size_t WS_R    = 114753536;
constexpr size_t R_ABUF = 0;
constexpr size_t R_PROJ = 0;
constexpr size_t R_VBUF = 167772160;
constexpr size_t R_TBUF = 209715200;
constexpr size_t R_GBUF = 251658240;
constexpr size_t R_GCB  = 254279680;
constexpr size_t R_BETA = 255590400;
constexpr size_t R_DPROJ = 0;
constexpr size_t R_Q    = 0;
constexpr size_t R_CQ   = 62914560;
constexpr size_t R_CKV  = 78643200;
constexpr size_t R_KM   = 91226112;
constexpr size_t R_VTM  = 166723584;
constexpr size_t R_KG   = 41943040;
constexpr size_t R_VTG  = 54525952;
constexpr size_t WM_IN = 0;
constexpr size_t WM_OUT = 4325376;
constexpr size_t WM_UQ = 5373952;
constexpr size_t WM_UKV = 5963776;
constexpr size_t O_SF = 20971520, O_SB = 25165824, O_CKV = 29360128, O_KR = 30408704, O_GK = 30670848, O_GV = 31719424;

struct P {
  const float* in[36];
  float* out;
  char* ws;
};

typedef __attribute__((ext_vector_type(2))) float f32x2_t;
typedef __attribute__((ext_vector_type(2))) __bf16 bf16x2_t;
DI u16 f2bf(float x) { return __builtin_bit_cast(u16, (__bf16)x); }
DI float bf2f(u16 h) { return __uint_as_float(((unsigned)h) << 16); }
DI unsigned pack2(float a, float b) { f32x2_t v; v[0] = a; v[1] = b; return __builtin_bit_cast(unsigned, __builtin_convertvector(v, bf16x2_t)); }
DI float bflo(unsigned w) { return __uint_as_float(w << 16); }
DI float bfhi(unsigned w) { return __uint_as_float(w & 0xffff0000u); }
DI f32x4 mma(bf16x8 a, bf16x8 b, f32x4 c) { return __builtin_amdgcn_mfma_f32_16x16x32_bf16(a, b, c, 0, 0, 0); }
DI bf16x8 pack8(f32x4 a, f32x4 b) {
  u32x4 p; p[0] = pack2(a[0], a[1]); p[1] = pack2(a[2], a[3]); p[2] = pack2(b[0], b[1]); p[3] = pack2(b[2], b[3]);
  return __builtin_bit_cast(bf16x8, p);
}
DI bf16x8 ld8(const u16* p) { return *(const bf16x8*)p; }
DI bf16x8 ld44(const u16* p0, const u16* p1) {
  u32x2 a = *(const u32x2*)p0; u32x2 b = *(const u32x2*)p1;
  u32x4 r; r[0] = a[0]; r[1] = a[1]; r[2] = b[0]; r[3] = b[1];
  return __builtin_bit_cast(bf16x8, r);
}
DI void st4bf(u16* p, float a, float b, float c, float d) { u32x2 v; v[0] = pack2(a, b); v[1] = pack2(c, d); *(u32x2*)p = v; }
DI float wave_sum(float v) {
  v += __shfl_xor(v, 1); v += __shfl_xor(v, 2); v += __shfl_xor(v, 4); v += __shfl_xor(v, 8); v += __shfl_xor(v, 16); v += __shfl_xor(v, 32);
  return v;
}
DI float sum_g(float v) { v += __shfl_xor(v, 16); v += __shfl_xor(v, 32); return v; }
DI int opaque_tid() { int t = threadIdx.x; asm volatile("" : "+v"(t)); return t; }
DI int opaque_bid() { int t = __builtin_amdgcn_readfirstlane((int)blockIdx.x); asm volatile("" : "+s"(t)); return t; }
DI char* opaque_ptr(char* q) {
  unsigned lo = __builtin_amdgcn_readfirstlane((unsigned)(size_t)q), hi = __builtin_amdgcn_readfirstlane((unsigned)((size_t)q >> 32));
  asm volatile("" : "+s"(lo), "+s"(hi));
  typedef __attribute__((address_space(1))) char gchar_t;
  return (char*)(gchar_t*)(((size_t)hi << 32) | (size_t)lo);
}
template <class T> DI T* as_global(T* q) { typedef __attribute__((address_space(1))) T gT; return (T*)(gT*)q; }
#define GIN(i) as_global(p.in[i])
#define GOUT as_global(p.out)
DI int cond_of(int t) { return t < NPROMPT ? 0 : 1 + ((t - NPROMPT) >> 11); }
DI int kvrow_of_tok(int t) { return t < NPROMPT ? t : NPROMPT + ((t - NPROMPT) >> 11) * 2560 + 512 + ((t - NPROMPT) & 2047); }

template <int NI, class Epi>
DI void gemm_tile(const u16* __restrict__ A, int lda, const u16* __restrict__ Bt, int ldb, int K, int m0, int n0, u16* smem, Epi& epi) {
  constexpr int MI = 16 / NI;
  constexpr int WN = 8 / NI;
  const int tid = opaque_tid(), lane = tid & 63, wid = tid >> 6, l15 = lane & 15, g = lane >> 4;
  const int wm = wid / WN, wn = wid % WN;
  u16* sA = smem; u16* sB = smem + 128 * 64;
  f32x4 acc[MI][NI];
#pragma unroll
  for (int mi = 0; mi < MI; ++mi)
#pragma unroll
    for (int ni = 0; ni < NI; ++ni) { acc[mi][ni][0] = 0.f; acc[mi][ni][1] = 0.f; acc[mi][ni][2] = 0.f; acc[mi][ni][3] = 0.f; }
  const int lrow = tid >> 3, lkc = (tid & 7) * 8;
  const int wofs = lrow * 64 + (((tid & 7) ^ ((lrow >> 1) & 7)) * 8);
  const int rsw = (l15 >> 1) & 7;
  const int rofs0 = l15 * 64 + ((g ^ rsw) * 8), rofs1 = l15 * 64 + (((4 + g) ^ rsw) * 8);
  const u16* pa = A + (size_t)(m0 + lrow) * lda + lkc;
  const u16* pb = Bt + (size_t)(n0 + lrow) * ldb + lkc;
  u32x4 ra[2][4], rb[2][4];
  const int nk = K >> 6;
#pragma unroll
  for (int i = 0; i < 4; ++i) { ra[0][i] = *(const u32x4*)(pa + (size_t)i * 32 * lda); rb[0][i] = *(const u32x4*)(pb + (size_t)i * 32 * ldb); }
#pragma unroll
  for (int i = 0; i < 4; ++i) { ra[1][i] = *(const u32x4*)(pa + (size_t)i * 32 * lda + 64); rb[1][i] = *(const u32x4*)(pb + (size_t)i * 32 * ldb + 64); }
  for (int kt = 0; kt < nk; kt += 2) {
#pragma unroll
    for (int half = 0; half < 2; ++half) {
      __syncthreads();
#pragma unroll
      for (int i = 0; i < 4; ++i) { *(u32x4*)(sA + wofs + i * 32 * 64) = ra[half][i]; *(u32x4*)(sB + wofs + i * 32 * 64) = rb[half][i]; }
      __syncthreads();
      if (kt + half + 2 < nk) {
        const int ko = (kt + half + 2) * 64;
#pragma unroll
        for (int i = 0; i < 4; ++i) { ra[half][i] = *(const u32x4*)(pa + (size_t)i * 32 * lda + ko); rb[half][i] = *(const u32x4*)(pb + (size_t)i * 32 * ldb + ko); }
      }
#pragma unroll
      for (int ks = 0; ks < 2; ++ks) {
        const int ro = ks ? rofs1 : rofs0;
        bf16x8 af[MI], bfv[NI];
#pragma unroll
        for (int mi = 0; mi < MI; ++mi) af[mi] = ld8(sA + (wm * MI * 16 + mi * 16) * 64 + ro);
#pragma unroll
        for (int ni = 0; ni < NI; ++ni) bfv[ni] = ld8(sB + (wn * NI * 16 + ni * 16) * 64 + ro);
        __builtin_amdgcn_s_setprio(1);
#pragma unroll
        for (int mi = 0; mi < MI; ++mi)
#pragma unroll
          for (int ni = 0; ni < NI; ++ni) acc[mi][ni] = mma(bfv[ni], af[mi], acc[mi][ni]);
        __builtin_amdgcn_s_setprio(0);
      }
    }
  }
  epi.template run<MI, NI>(acc, m0 + wm * MI * 16, n0 + wn * NI * 16, l15, g);
}

struct EpiResid {
  const float* xin; float* xout; const float* gate;
  template <int MI, int NI> DI void run(f32x4 (&acc)[MI][NI], int mr, int nc, int l15, int g) {
#pragma unroll
    for (int mi = 0; mi < MI; ++mi)
#pragma unroll
      for (int ni = 0; ni < NI; ++ni) {
        const int m = mr + mi * 16 + l15, n = nc + ni * 16 + g * 4;
        const float4 xi = *(const float4*)(xin + (size_t)m * 1024 + n);
        const float4 gt = *(const float4*)(gate + n);
        float4 o; o.x = xi.x + gt.x * acc[mi][ni][0]; o.y = xi.y + gt.y * acc[mi][ni][1]; o.z = xi.z + gt.z * acc[mi][ni][2]; o.w = xi.w + gt.w * acc[mi][ni][3];
        *(float4*)(xout + (size_t)m * 1024 + n) = o;
      }
  }
};
struct EpiGdnIn {
  u16* proj; float* gbuf;
  template <int MI, int NI> DI void run(f32x4 (&acc)[MI][NI], int mr, int nc, int l15, int g) {
#pragma unroll
    for (int mi = 0; mi < MI; ++mi)
#pragma unroll
      for (int ni = 0; ni < NI; ++ni) {
        const int m = mr + mi * 16 + l15, n = nc + ni * 16 + g * 4;
        if (n < 4096) st4bf(proj + (size_t)m * 4096 + n, acc[mi][ni][0], acc[mi][ni][1], acc[mi][ni][2], acc[mi][ni][3]);
        else if (n < 4128) { float4 o; o.x = acc[mi][ni][0]; o.y = acc[mi][ni][1]; o.z = acc[mi][ni][2]; o.w = acc[mi][ni][3]; *(float4*)(gbuf + (size_t)m * 32 + (n - 4096)) = o; }
      }
  }
};
struct EpiMlpIn {
  u16* abuf;
  template <int MI, int NI> DI void run(f32x4 (&acc)[MI][NI], int mr, int nc, int l15, int g) {
#pragma unroll
    for (int mi = 0; mi < MI; ++mi)
#pragma unroll
      for (int ni = 0; ni < NI; ++ni) {
        const int m = mr + mi * 16 + l15, n = nc + ni * 16 + g * 4;
        float a = fmaxf(acc[mi][ni][0], 0.f), b = fmaxf(acc[mi][ni][1], 0.f), c = fmaxf(acc[mi][ni][2], 0.f), d = fmaxf(acc[mi][ni][3], 0.f);
        st4bf(abuf + (size_t)m * 4096 + n, a * a, b * b, c * c, d * d);
      }
  }
};
struct EpiF32 {
  float* dst; int ld;
  template <int MI, int NI> DI void run(f32x4 (&acc)[MI][NI], int mr, int nc, int l15, int g) {
#pragma unroll
    for (int mi = 0; mi < MI; ++mi)
#pragma unroll
      for (int ni = 0; ni < NI; ++ni) {
        const int m = mr + mi * 16 + l15, n = nc + ni * 16 + g * 4;
        float4 o; o.x = acc[mi][ni][0]; o.y = acc[mi][ni][1]; o.z = acc[mi][ni][2]; o.w = acc[mi][ni][3];
        *(float4*)(dst + (size_t)m * ld + n) = o;
      }
  }
};

DI void rope128(f32x4 (&v)[8], int rowp, int colp, int g, const float* cosT, const float* sinT) {
#pragma unroll
  for (int hf = 0; hf < 2; ++hf) {
    const int pos = hf ? colp : rowp;
#pragma unroll
    for (int a = 0; a < 2; ++a) {
      const int n1 = hf * 4 + a, n2 = n1 + 2;
      const float4 cs = *(const float4*)(cosT + pos * 32 + a * 16 + g * 4);
      const float4 sn = *(const float4*)(sinT + pos * 32 + a * 16 + g * 4);
      const float c4[4] = {cs.x, cs.y, cs.z, cs.w}, s4[4] = {sn.x, sn.y, sn.z, sn.w};
#pragma unroll
      for (int j = 0; j < 4; ++j) { const float x1 = v[n1][j], x2 = v[n2][j]; v[n1][j] = x1 * c4[j] - x2 * s4[j]; v[n2][j] = x1 * s4[j] + x2 * c4[j]; }
    }
  }
}
DI void rope64(f32x4* v, int rowp, int colp, int g, const float* cosT, const float* sinT) {
#pragma unroll
  for (int hf = 0; hf < 2; ++hf) {
    const int pos = hf ? colp : rowp;
    const int n1 = hf * 2, n2 = n1 + 1;
    const float4 cs = *(const float4*)(cosT + pos * 16 + g * 4);
    const float4 sn = *(const float4*)(sinT + pos * 16 + g * 4);
    const float c4[4] = {cs.x, cs.y, cs.z, cs.w}, s4[4] = {sn.x, sn.y, sn.z, sn.w};
#pragma unroll
    for (int j = 0; j < 4; ++j) { const float x1 = v[n1][j], x2 = v[n2][j]; v[n1][j] = x1 * c4[j] - x2 * s4[j]; v[n2][j] = x1 * s4[j] + x2 * c4[j]; }
  }
}

struct EpiGqaIn {
  u16* Q; u16* Kb; u16* Vt; const float* qg; const float* kg; const float* cosT; const float* sinT; float* out;
  template <int MI, int NI> DI void run(f32x4 (&acc)[MI][NI], int mr, int nc, int l15, int g) {
    const int nt = nc >> 7;
#pragma unroll
    for (int mi = 0; mi < MI; ++mi) {
      const int m = mr + mi * 16 + l15;
      const bool prompt = m < NPROMPT;
      const int s = prompt ? (m & 255) : ((m - NPROMPT) & 2047);
      const int rowp = s >> 6, colp = s & 63;
      const int kvrow = kvrow_of_tok(m);
      if (nt < 10) {
        float ss = 0.f;
#pragma unroll
        for (int ni = 0; ni < NI; ++ni)
#pragma unroll
          for (int j = 0; j < 4; ++j) ss += acc[mi][ni][j] * acc[mi][ni][j];
        ss = sum_g(ss);
        const float rs = rsqrtf(ss * (1.f / 128.f) + EPS);
        const float* gn = nt < 8 ? qg : kg;
#pragma unroll
        for (int ni = 0; ni < NI; ++ni) {
          const float4 gv = *(const float4*)(gn + ni * 16 + g * 4);
          acc[mi][ni][0] *= rs * gv.x; acc[mi][ni][1] *= rs * gv.y; acc[mi][ni][2] *= rs * gv.z; acc[mi][ni][3] *= rs * gv.w;
        }
        if (nt >= 8 && prompt) {
#pragma unroll
          for (int ni = 0; ni < NI; ++ni) { float4 o; o.x = acc[mi][ni][0]; o.y = acc[mi][ni][1]; o.z = acc[mi][ni][2]; o.w = acc[mi][ni][3]; *(float4*)(out + O_GK + (size_t)m * 256 + (nt - 8) * 128 + ni * 16 + g * 4) = o; }
        }
        if (!prompt) rope128(acc[mi], rowp, colp, g, cosT, sinT);
        u16* dst = nt < 8 ? Q + (size_t)m * 1024 + nt * 128 : Kb + (size_t)kvrow * 256 + (nt - 8) * 128;
#pragma unroll
        for (int ni = 0; ni < NI; ++ni) st4bf(dst + ni * 16 + g * 4, acc[mi][ni][0], acc[mi][ni][1], acc[mi][ni][2], acc[mi][ni][3]);
      } else {
        const int kvh = nt - 10;
        if (prompt) {
#pragma unroll
          for (int ni = 0; ni < NI; ++ni) { float4 o; o.x = acc[mi][ni][0]; o.y = acc[mi][ni][1]; o.z = acc[mi][ni][2]; o.w = acc[mi][ni][3]; *(float4*)(out + O_GV + (size_t)m * 256 + kvh * 128 + ni * 16 + g * 4) = o; }
        }
        size_t base; int kvlen, pos;
        if (prompt) { base = (size_t)(m >> 8) * 256 * 256; kvlen = 256; pos = m & 255; }
        else { const int b = (m - NPROMPT) >> 11; base = (size_t)(NPROMPT + b * 2560) * 256; kvlen = 2560; pos = 512 + s; }
#pragma unroll
        for (int ni = 0; ni < NI; ++ni)
#pragma unroll
          for (int j = 0; j < 4; ++j) Vt[base + (size_t)(kvh * 128 + ni * 16 + g * 4 + j) * kvlen + pos] = f2bf(acc[mi][ni][j]);
      }
    }
  }
};
struct EpiMlaUq {
  u16* Q; const float* gnope; const float* grope; const float* cosT; const float* sinT;
  template <int MI, int NI> DI void run(f32x4 (&acc)[MI][NI], int mr, int nc, int l15, int g) {
    const int nt = nc >> 7;
#pragma unroll
    for (int mi = 0; mi < MI; ++mi) {
      const int m = mr + mi * 16 + l15;
      const bool prompt = m < NPROMPT;
      const int s = prompt ? (m & 255) : ((m - NPROMPT) & 2047);
      const int rowp = s >> 6, colp = s & 63;
      if (nt < 8) {
        float ss = 0.f;
#pragma unroll
        for (int ni = 0; ni < NI; ++ni)
#pragma unroll
          for (int j = 0; j < 4; ++j) ss += acc[mi][ni][j] * acc[mi][ni][j];
        ss = sum_g(ss);
        const float rs = rsqrtf(ss * (1.f / 128.f) + EPS);
#pragma unroll
        for (int ni = 0; ni < NI; ++ni) {
          const float4 gv = *(const float4*)(gnope + ni * 16 + g * 4);
          st4bf(Q + (size_t)m * 1536 + nt * 192 + ni * 16 + g * 4, acc[mi][ni][0] * rs * gv.x, acc[mi][ni][1] * rs * gv.y, acc[mi][ni][2] * rs * gv.z, acc[mi][ni][3] * rs * gv.w);
        }
      } else {
#pragma unroll
        for (int hh = 0; hh < 2; ++hh) {
          const int h = (nt - 8) * 2 + hh;
          float ss = 0.f;
#pragma unroll
          for (int ni = 0; ni < 4; ++ni)
#pragma unroll
            for (int j = 0; j < 4; ++j) ss += acc[mi][hh * 4 + ni][j] * acc[mi][hh * 4 + ni][j];
          ss = sum_g(ss);
          const float rs = rsqrtf(ss * (1.f / 64.f) + EPS);
#pragma unroll
          for (int ni = 0; ni < 4; ++ni) {
            const float4 gv = *(const float4*)(grope + ni * 16 + g * 4);
            acc[mi][hh * 4 + ni][0] *= rs * gv.x; acc[mi][hh * 4 + ni][1] *= rs * gv.y; acc[mi][hh * 4 + ni][2] *= rs * gv.z; acc[mi][hh * 4 + ni][3] *= rs * gv.w;
          }
          if (!prompt) rope64(&acc[mi][hh * 4], rowp, colp, g, cosT, sinT);
#pragma unroll
          for (int ni = 0; ni < 4; ++ni)
            st4bf(Q + (size_t)m * 1536 + h * 192 + 128 + ni * 16 + g * 4, acc[mi][hh * 4 + ni][0], acc[mi][hh * 4 + ni][1], acc[mi][hh * 4 + ni][2], acc[mi][hh * 4 + ni][3]);
        }
      }
    }
  }
};
struct EpiMlaUkv {
  u16* Kb; u16* Vt; const float* gnope;
  template <int MI, int NI> DI void run(f32x4 (&acc)[MI][NI], int mr, int nc, int l15, int g) {
    const int nt = nc >> 7, h = nt >> 1;
#pragma unroll
    for (int mi = 0; mi < MI; ++mi) {
      const int m = mr + mi * 16 + l15;
      if ((nt & 1) == 0) {
        float ss = 0.f;
#pragma unroll
        for (int ni = 0; ni < NI; ++ni)
#pragma unroll
          for (int j = 0; j < 4; ++j) ss += acc[mi][ni][j] * acc[mi][ni][j];
        ss = sum_g(ss);
        const float rs = rsqrtf(ss * (1.f / 128.f) + EPS);
#pragma unroll
        for (int ni = 0; ni < NI; ++ni) {
          const float4 gv = *(const float4*)(gnope + ni * 16 + g * 4);
          st4bf(Kb + (size_t)m * 1536 + h * 192 + ni * 16 + g * 4, acc[mi][ni][0] * rs * gv.x, acc[mi][ni][1] * rs * gv.y, acc[mi][ni][2] * rs * gv.z, acc[mi][ni][3] * rs * gv.w);
        }
      } else {
        size_t base; int kvlen, pos;
        if (m < NPROMPT) { base = (size_t)(m >> 8) * 256 * 1024; kvlen = 256; pos = m & 255; }
        else { const int r = m - NPROMPT; const int b = r / 2560; base = (size_t)(NPROMPT + b * 2560) * 1024; kvlen = 2560; pos = r - b * 2560; }
#pragma unroll
        for (int ni = 0; ni < NI; ++ni)
#pragma unroll
          for (int j = 0; j < 4; ++j) Vt[base + (size_t)(h * 128 + ni * 16 + g * 4 + j) * kvlen + pos] = f2bf(acc[mi][ni][j]);
      }
    }
  }
};

DI void convert_tile(const float* __restrict__ W, int K, int N, u16* __restrict__ Bt, int tile, int perm, float* sT) {
  const int nkt = K >> 6;
  const int kt = tile % nkt, nt = tile / nkt;
  const int k0 = kt * 64, n0 = nt * 64;
  const int tid = opaque_tid();
  __syncthreads();
  {
    const int n = tid & 63, kq = tid >> 6;
    int nd = n0 + n, ns = nd;
    if (perm == 1) { if (nd < 1024) ns = (nd >> 7) * 192 + (nd & 127); else { const int x = nd - 1024; ns = (x >> 6) * 192 + 128 + (x & 63); } }
    const bool ok = nd < N;
#pragma unroll
    for (int r = 0; r < 16; ++r) { const int k = r * 4 + kq; sT[k * 65 + n] = ok ? W[(size_t)(k0 + k) * N + ns] : 0.f; }
  }
  __syncthreads();
  {
    const int n = tid >> 2, kq = (tid & 3) * 16;
    u32x4 a, b;
#pragma unroll
    for (int e = 0; e < 4; ++e) { a[e] = pack2(sT[(kq + 2 * e) * 65 + n], sT[(kq + 2 * e + 1) * 65 + n]); b[e] = pack2(sT[(kq + 8 + 2 * e) * 65 + n], sT[(kq + 9 + 2 * e) * 65 + n]); }
    u16* dst = Bt + (size_t)(n0 + n) * K + k0 + kq;
    *(u32x4*)dst = a; *(u32x4*)(dst + 8) = b;
  }
}

DI void norm_rows(const P& p, int layer, bool from_input, int item, const float* gnorm, int shift_idx, int scale_idx) {
  const int tidn = opaque_tid();
  char* const ws = opaque_ptr(as_global(p.ws));
  const int lane = tidn & 63, wid = tidn >> 6;
  const int t = item * 4 + wid;
  const float* x = from_input ? (t < NPROMPT ? GIN(0) + (size_t)t * 1024 : GIN(1) + (size_t)(t - NPROMPT) * 1024) : GOUT + (size_t)t * 1024;
  const float* mods = (const float*)(ws + WS_MODS) + ((size_t)layer * 9 + cond_of(t)) * 6144;
  u16* h = (u16*)(ws + WS_HBUF) + (size_t)t * 1024;
  float4 v[4]; float ss = 0.f;
#pragma unroll
  for (int e = 0; e < 4; ++e) { v[e] = *(const float4*)(x + e * 256 + lane * 4); ss += v[e].x * v[e].x + v[e].y * v[e].y + v[e].z * v[e].z + v[e].w * v[e].w; }
  ss = wave_sum(ss);
  const float rs = rsqrtf(ss * (1.f / 1024.f) + EPS);
#pragma unroll
  for (int e = 0; e < 4; ++e) {
    const int c = e * 256 + lane * 4;
    const float4 gv = *(const float4*)(gnorm + c);
    const float4 sc = *(const float4*)(mods + scale_idx * 1024 + c);
    const float4 sh = *(const float4*)(mods + shift_idx * 1024 + c);
    st4bf(h + c, v[e].x * rs * gv.x * (1.f + sc.x) + sh.x, v[e].y * rs * gv.y * (1.f + sc.y) + sh.y, v[e].z * rs * gv.z * (1.f + sc.z) + sh.z, v[e].w * rs * gv.w * (1.f + sc.w) + sh.w);
  }
}

template <int DK, int HK>
DI void attn_phase(const u16* __restrict__ Q, const u16* __restrict__ Kb, const u16* __restrict__ Vt, u16* __restrict__ obuf, char* smem_raw) {
  const int bid = opaque_bid();
  constexpr int KS = DK / 32, KSTR = DK, QSTR = 8 * DK, KROW = HK * DK, GRP = 8 / HK;
  constexpr int CPR = DK / 8;
  constexpr int KCH = 64 * CPR / 256;
  u16* sK = (u16*)smem_raw;
  u16* sV = sK + 64 * KSTR;
  const int tid = opaque_tid(), lane = tid & 63, wid = tid >> 6, l15 = lane & 15, g = lane >> 4;
  const float sc = rsqrtf((float)DK) * 1.4426950408889634f;
  for (int item = bid; item < 1280; item += gridDim.x) {
    int qb, h, kvlen, tokbase, kvbase;
    if (item < 1024) { const int b = item >> 7, rem = item & 127; h = rem & 7; qb = rem >> 3; kvlen = 2560; tokbase = NPROMPT + b * 2048; kvbase = NPROMPT + b * 2560; }
    else { const int it2 = item - 1024; const int b = it2 >> 4, rem = it2 & 15; h = rem & 7; qb = rem >> 3; kvlen = 256; tokbase = b * 256; kvbase = b * 256; }
    const int kvh = h / GRP;
    const u16* Kp = Kb + (size_t)kvbase * KROW + kvh * DK;
    const u16* Vp = Vt + (size_t)kvbase * (HK * 128) + (size_t)kvh * 128 * kvlen;
    const int qrow0 = tokbase + qb * 128 + wid * 32;
    bf16x8 qf[2][KS];
#pragma unroll
    for (int qi = 0; qi < 2; ++qi)
#pragma unroll
      for (int ks = 0; ks < KS; ++ks) qf[qi][ks] = ld8(Q + (size_t)(qrow0 + qi * 16 + l15) * QSTR + h * DK + ks * 32 + g * 8);
    f32x4 ot[2][8];
#pragma unroll
    for (int qi = 0; qi < 2; ++qi)
#pragma unroll
      for (int dj = 0; dj < 8; ++dj) { ot[qi][dj][0] = 0.f; ot[qi][dj][1] = 0.f; ot[qi][dj][2] = 0.f; ot[qi][dj][3] = 0.f; }
    float mrun[2] = {-1e30f, -1e30f}, lrun[2] = {0.f, 0.f};
    const int ntiles = kvlen >> 6;
    const unsigned toffK = (unsigned)((tid >> 3) * KROW + (tid & 7) * 8), toffV = (unsigned)((tid >> 3) * kvlen + (tid & 7) * 8);
    const int kx = tid >> 3;
    const int kperm = ((kx >> 2) & 1) * 16 + (kx >> 3) * 4 + (kx & 3);
    const int kswz = (CPR == 16) ? (kperm & 15) : ((kperm >> 1) & 7);
    const int ldsoffK = kperm * KSTR;
    const int ldsoffV = (tid >> 3) * 64 + (((tid & 7) ^ (((tid >> 3) >> 1) & 7)) * 8);
    u32x4 rk[KCH], rv[4];
#pragma unroll
    for (int i = 0; i < KCH; ++i) { const int rh = i & 1, cgp = i >> 1; rk[i] = *(const u32x4*)(Kp + (size_t)(rh * 32 * KROW + cgp * 64) + toffK); }
#pragma unroll
    for (int i = 0; i < 4; ++i) rv[i] = *(const u32x4*)(Vp + (size_t)i * 32 * kvlen + toffV);
    for (int kt = 0; kt < ntiles; ++kt) {
      const u16* Kt = Kp + (size_t)(kt + 1) * 64 * KROW;
      const u16* Vtp = Vp + (kt + 1) * 64;
      const bool more = kt + 1 < ntiles;
      __syncthreads();
#pragma unroll
      for (int i = 0; i < KCH; ++i) { const int rh = i & 1, cgp = i >> 1; const int c = (tid & 7) + 8 * cgp; const int pos = (CPR == 16) ? (c ^ kswz) : ((c & ~7) | ((c & 7) ^ kswz)); *(u32x4*)(sK + ldsoffK + rh * 32 * KSTR + pos * 8) = rk[i]; }
#pragma unroll
      for (int i = 0; i < 4; ++i) *(u32x4*)(sV + ldsoffV + i * 32 * 64) = rv[i];
      __syncthreads();
      if (more) {
#pragma unroll
        for (int i = 0; i < KCH; ++i) { const int rh = i & 1, cgp = i >> 1; rk[i] = *(const u32x4*)(Kt + (size_t)(rh * 32 * KROW + cgp * 64) + toffK); }
      }
      __builtin_amdgcn_sched_barrier(0);
      f32x4 st[2][4];
#pragma unroll
      for (int qi = 0; qi < 2; ++qi)
#pragma unroll
        for (int kj = 0; kj < 4; ++kj) { st[qi][kj][0] = 0.f; st[qi][kj][1] = 0.f; st[qi][kj][2] = 0.f; st[qi][kj][3] = 0.f; }
#pragma unroll
      for (int ks = 0; ks < KS; ++ks) {
#pragma unroll
        for (int kj = 0; kj < 4; ++kj) {
          const int kc = ks * 4 + g;
          const int kpos = (CPR == 16) ? (kc ^ l15) : ((kc & ~7) | ((kc & 7) ^ ((l15 >> 1) & 7)));
          const bf16x8 ka = ld8(sK + (kj * 16 + l15) * KSTR + kpos * 8);
          st[0][kj] = mma(ka, qf[0][ks], st[0][kj]);
          st[1][kj] = mma(ka, qf[1][ks], st[1][kj]);
        }
        __builtin_amdgcn_sched_barrier(0);
      }
      bf16x8 pf[2][2];
#pragma unroll
      for (int qi = 0; qi < 2; ++qi) {
        float mx = -1e30f;
#pragma unroll
        for (int kj = 0; kj < 4; ++kj)
#pragma unroll
          for (int r = 0; r < 4; ++r) mx = fmaxf(mx, st[qi][kj][r]);
        mx = fmaxf(mx, __shfl_xor(mx, 16)); mx = fmaxf(mx, __shfl_xor(mx, 32));
        const float mnew = fmaxf(mrun[qi], mx);
        const float alpha = __builtin_amdgcn_exp2f((mrun[qi] - mnew) * sc);
        mrun[qi] = mnew;
        float ps = 0.f;
        const float mneg = -mnew * sc;
#pragma unroll
        for (int kj = 0; kj < 4; ++kj)
#pragma unroll
          for (int r = 0; r < 4; ++r) { const float pv = __builtin_amdgcn_exp2f(fmaf(st[qi][kj][r], sc, mneg)); st[qi][kj][r] = pv; ps += pv; }
        lrun[qi] = lrun[qi] * alpha + ps;
#pragma unroll
        for (int dj = 0; dj < 8; ++dj) { ot[qi][dj][0] *= alpha; ot[qi][dj][1] *= alpha; ot[qi][dj][2] *= alpha; ot[qi][dj][3] *= alpha; }
        pf[qi][0] = pack8(st[qi][0], st[qi][1]);
        pf[qi][1] = pack8(st[qi][2], st[qi][3]);
        __builtin_amdgcn_sched_barrier(0);
      }
      if (more) {
#pragma unroll
        for (int i = 0; i < 4; ++i) rv[i] = *(const u32x4*)(Vtp + (size_t)i * 32 * kvlen + toffV);
      }
      __builtin_amdgcn_sched_barrier(0);
#pragma unroll
      for (int kk = 0; kk < 2; ++kk)
#pragma unroll
        for (int dj = 0; dj < 8; ++dj) {
          const bf16x8 va = ld8(sV + (dj * 16 + l15) * 64 + (((kk * 4 + g) ^ ((l15 >> 1) & 7)) * 8));
          ot[0][dj] = mma(va, pf[0][kk], ot[0][dj]);
          ot[1][dj] = mma(va, pf[1][kk], ot[1][dj]);
          if ((dj & 3) == 3) __builtin_amdgcn_sched_barrier(0);
        }
    }
#pragma unroll
    for (int qi = 0; qi < 2; ++qi) {
      const float inv = 1.f / sum_g(lrun[qi]);
      u16* dst = obuf + (size_t)(qrow0 + qi * 16 + l15) * 1024 + h * 128 + g * 4;
#pragma unroll
      for (int dj = 0; dj < 8; ++dj) st4bf(dst + dj * 16, ot[qi][dj][0] * inv, ot[qi][dj][1] * inv, ot[qi][dj][2] * inv, ot[qi][dj][3] * inv);
    }
  }
}

DI void gdn_chunk_phase(const P& p, int j, char* smem_raw) {
  const int bid = opaque_bid();
  char* const ws = opaque_ptr(as_global(p.ws));
  u16* sK = (u16*)smem_raw;
  float* sA = (float*)(smem_raw + 17408);
  float* sG = (float*)(smem_raw + 17408 + 32768);
  float* sBt = sG + 128;
  const int tid = opaque_tid(), lane = tid & 63, wid = tid >> 6, l15 = lane & 15, g = lane >> 4;
  const u16* proj = (const u16*)(ws + WS_R + R_PROJ);
  u16* qn = (u16*)(ws + WS_HBUF); u16* kn = (u16*)(ws + WS_OBUF); u16* vb = (u16*)(ws + WS_R + R_VBUF);
  u16* Tbuf = (u16*)(ws + WS_R + R_TBUF);
  const float* gbuf = (const float*)(ws + WS_R + R_GBUF);
  float* gcb = (float*)(ws + WS_R + R_GCB); float* betab = (float*)(ws + WS_R + R_BETA);
  const float* conv = GIN(17) + (size_t)j * 3 * 3072;
  const float* a_log = GIN(18) + j * 16; const float* dt_bias = GIN(19) + j * 16;
  for (int unit = bid; unit < 2560; unit += gridDim.x) {
    const int cgi = unit >> 3, h = unit & 7;
    int c, nch; if (cgi < 64) { c = cgi & 3; nch = 4; } else { c = (cgi - 64) & 31; nch = 32; }
    const int t0 = cgi * 64;
    const bool has_prev = c > 0, has_next = c < nch - 1;
    __syncthreads();
    {
      const int r = tid >> 4, cc = (tid & 15) * 8;
#pragma unroll
      for (int part = 0; part < 3; ++part) {
        const int ch = part * 1024 + h * 128 + cc;
        float w0[8], w1[8], w2[8];
#pragma unroll
        for (int e = 0; e < 8; ++e) { w0[e] = conv[ch + e]; w1[e] = conv[3072 + ch + e]; w2[e] = conv[6144 + ch + e]; }
        u16* dstb = part == 0 ? qn : (part == 1 ? kn : vb);
        for (int it = 0; it < 4; ++it) {
          const int i = it * 16 + r, t = t0 + i;
          const u16* src = proj + (size_t)t * 4096 + ch;
          const u32x4 xc = *(const u32x4*)src;
          u32x4 xp = {0u, 0u, 0u, 0u}, xn = {0u, 0u, 0u, 0u};
          if (i > 0 || has_prev) xp = *(const u32x4*)(src - 4096);
          if (i < 63 || has_next) xn = *(const u32x4*)(src + 4096);
          float y[8];
#pragma unroll
          for (int e = 0; e < 4; ++e) {
            float a = w0[2 * e] * bflo(xp[e]) + w1[2 * e] * bflo(xc[e]) + w2[2 * e] * bflo(xn[e]);
            float b = w0[2 * e + 1] * bfhi(xp[e]) + w1[2 * e + 1] * bfhi(xc[e]) + w2[2 * e + 1] * bfhi(xn[e]);
            y[2 * e] = a / (1.f + __expf(-a)); y[2 * e + 1] = b / (1.f + __expf(-b));
          }
          if (part < 2) {
            float ss = 0.f;
#pragma unroll
            for (int e = 0; e < 8; ++e) ss += y[e] * y[e];
            ss += __shfl_xor(ss, 1); ss += __shfl_xor(ss, 2); ss += __shfl_xor(ss, 4); ss += __shfl_xor(ss, 8);
            const float rs = rsqrtf(ss + EPS) * (part == 0 ? 0.08838834764831845f : 1.f);
#pragma unroll
            for (int e = 0; e < 8; ++e) y[e] *= rs;
          }
          u32x4 o; o[0] = pack2(y[0], y[1]); o[1] = pack2(y[2], y[3]); o[2] = pack2(y[4], y[5]); o[3] = pack2(y[6], y[7]);
          *(u32x4*)(dstb + (size_t)t * 1024 + h * 128 + cc) = o;
          if (part == 1) *(u32x4*)(sK + i * 136 + cc) = o;
        }
      }
    }
    if (tid < 128) {
      const int dir = tid >> 6, L = tid & 63;
      const int i = dir ? 63 - L : L;
      const float* gb = gbuf + (size_t)(t0 + i) * 32;
      const float gin = gb[dir * 8 + h], bin = gb[16 + dir * 8 + h];
      const float x = gin + dt_bias[dir * 8 + h];
      const float sp = fmaxf(x, 0.f) + log1pf(expf(-fabsf(x)));
      float gv = -expf(a_log[dir * 8 + h]) * sp;
      const float bt = 1.f / (1.f + expf(-bin));
#pragma unroll
      for (int off = 1; off < 64; off <<= 1) { const float v = __shfl_up(gv, off); if (L >= off) gv += v; }
      sG[dir * 64 + i] = gv; sBt[dir * 64 + i] = bt;
      gcb[((size_t)(t0 + i) * 8 + h) * 2 + dir] = gv; betab[((size_t)(t0 + i) * 8 + h) * 2 + dir] = bt;
    }
    __syncthreads();
    {
      f32x4 ga[4];
#pragma unroll
      for (int mt = 0; mt < 4; ++mt) { ga[mt][0] = 0.f; ga[mt][1] = 0.f; ga[mt][2] = 0.f; ga[mt][3] = 0.f; }
#pragma unroll
      for (int ks = 0; ks < 4; ++ks) {
        const bf16x8 a = ld8(sK + (wid * 16 + l15) * 136 + ks * 32 + g * 8);
#pragma unroll
        for (int mt = 0; mt < 4; ++mt) { const bf16x8 b = ld8(sK + (mt * 16 + l15) * 136 + ks * 32 + g * 8); ga[mt] = mma(a, b, ga[mt]); }
      }
#pragma unroll
      for (int dir = 0; dir < 2; ++dir)
#pragma unroll
        for (int mt = 0; mt < 4; ++mt)
#pragma unroll
          for (int r = 0; r < 4; ++r) {
            const int i = wid * 16 + g * 4 + r, m = mt * 16 + l15;
            const bool valid = dir ? (i < m) : (i > m);
            const float val = valid ? sBt[dir * 64 + i] * ga[mt][r] * __expf(sG[dir * 64 + i] - sG[dir * 64 + m]) : 0.f;
            const int ii = dir ? 63 - i : i, mm = dir ? 63 - m : m;
            sA[dir * 4096 + ii * 64 + mm] = val;
          }
    }
    __syncthreads();
    if (wid < 2) {
      const int dir = wid;
      float* Am = sA + dir * 4096;
      for (int i = 0; i < 64; ++i) {
        float a = (i == lane) ? 1.f : 0.f;
        int m = 0;
        for (; m + 8 <= i; m += 8) {
          const float4 a0 = *(const float4*)(Am + i * 64 + m), a1 = *(const float4*)(Am + i * 64 + m + 4);
          float tv[8];
#pragma unroll
          for (int e = 0; e < 8; ++e) tv[e] = Am[(m + e) * 64 + lane];
          a -= a0.x * tv[0]; a -= a0.y * tv[1]; a -= a0.z * tv[2]; a -= a0.w * tv[3];
          a -= a1.x * tv[4]; a -= a1.y * tv[5]; a -= a1.z * tv[6]; a -= a1.w * tv[7];
        }
        for (; m < i; ++m) a -= Am[i * 64 + m] * Am[m * 64 + lane];
        Am[i * 64 + lane] = a;
      }
      const int mn = dir ? 63 - lane : lane;
      const float bm = sBt[dir * 64 + mn];
      u16* Td = Tbuf + ((size_t)unit * 2 + dir) * 4096;
#pragma unroll 4
      for (int i = 0; i < 64; ++i) { const int in_ = dir ? 63 - i : i; Td[in_ * 64 + mn] = f2bf(Am[i * 64 + lane] * bm); }
    }
  }
}

DI void gdn_scan_phase(const P& p, int j, char* smem_raw) {
  const int bid = opaque_bid();
  char* const ws = opaque_ptr(as_global(p.ws));
  u16* sK = (u16*)smem_raw;
  u16* sKT = sK + 64 * 136;
  u16* sVT = sKT + 128 * 72;
  u16* sST = sVT + 32 * 72;
  u16* sVN = sST + 32 * 136;
  u16* sVD = sVN + 32 * 72;
  float* sGc = (float*)(sVD + 32 * 72);
  const int tid = opaque_tid(), lane = tid & 63, w = tid >> 6, l15 = lane & 15, g = lane >> 4;
  const u16* qn = (const u16*)(ws + WS_HBUF); const u16* kn = (const u16*)(ws + WS_OBUF); const u16* vb = (const u16*)(ws + WS_R + R_VBUF);
  const u16* Tbuf = (const u16*)(ws + WS_R + R_TBUF);
  const float* gcb = (const float*)(ws + WS_R + R_GCB);
  u16* obase = (u16*)(ws + WS_R + R_PROJ);
  for (int wk = bid; wk < 1536; wk += gridDim.x) {
    int seq, rem;
    if (wk < 512) { seq = 16 + (wk >> 6); rem = wk & 63; } else { seq = (wk - 512) >> 6; rem = (wk - 512) & 63; }
    const int h = rem >> 3, dir = (rem >> 2) & 1, dvq = rem & 3;
    const int nch = seq < 16 ? 4 : 32;
    const int cgb = seq < 16 ? seq * 4 : 64 + (seq - 16) * 32;
    f32x4 S[2][2];
    if (seq >= 16) {
      const float* s0 = GIN(2 + dir) + (((size_t)(seq - 16) * 2 + j) * 8 + h) * 16384;
#pragma unroll
      for (int dt = 0; dt < 2; ++dt)
#pragma unroll
        for (int et = 0; et < 2; ++et)
#pragma unroll
          for (int r = 0; r < 4; ++r) S[dt][et][r] = s0[(size_t)(w * 32 + dt * 16 + g * 4 + r) * 128 + dvq * 32 + et * 16 + l15];
    } else {
#pragma unroll
      for (int dt = 0; dt < 2; ++dt)
#pragma unroll
        for (int et = 0; et < 2; ++et) { S[dt][et][0] = 0.f; S[dt][et][1] = 0.f; S[dt][et][2] = 0.f; S[dt][et][3] = 0.f; }
    }
    __syncthreads();
#pragma unroll
    for (int dt = 0; dt < 2; ++dt)
#pragma unroll
      for (int et = 0; et < 2; ++et) st4bf(sST + (et * 16 + l15) * 136 + w * 32 + dt * 16 + g * 4, S[dt][et][0], S[dt][et][1], S[dt][et][2], S[dt][et][3]);
    u32x4 pk[4], pv; bf16x8 pq[4], pt[2]; float pg = 0.f;
#define SCAN_PREFETCH(cc) do { \
      const int t0n_ = (cgb + (cc)) * 64; const int unitn_ = (cgb + (cc)) * 8 + h; \
      _Pragma("unroll") for (int i = 0; i < 4; ++i) { const int row = tid & 63, dc = ((tid >> 6) + 4 * i) * 8; pk[i] = *(const u32x4*)(kn + (size_t)(t0n_ + row) * 1024 + h * 128 + dc); } \
      { const int row = tid & 63, ec = (tid >> 6) * 8; pv = *(const u32x4*)(vb + (size_t)(t0n_ + row) * 1024 + h * 128 + dvq * 32 + ec); } \
      if (tid < 64) pg = gcb[((size_t)(t0n_ + tid) * 8 + h) * 2 + dir]; \
      _Pragma("unroll") for (int ks = 0; ks < 4; ++ks) pq[ks] = ld8(qn + (size_t)(t0n_ + w * 16 + l15) * 1024 + h * 128 + ks * 32 + g * 8); \
      _Pragma("unroll") for (int ks = 0; ks < 2; ++ks) pt[ks] = ld8(Tbuf + ((size_t)unitn_ * 2 + dir) * 4096 + (w * 16 + l15) * 64 + ks * 32 + g * 8); \
    } while (0)
    SCAN_PREFETCH(dir ? nch - 1 : 0);
    for (int step = 0; step < nch; ++step) {
      const int c = dir ? nch - 1 - step : step;
      const int t0 = (cgb + c) * 64;
      const int unit = (cgb + c) * 8 + h;
#pragma unroll
      for (int i = 0; i < 4; ++i) {
        const int row = tid & 63, dc = ((tid >> 6) + 4 * i) * 8;
        const u32x4 v = pk[i];
        *(u32x4*)(sK + row * 136 + dc) = v;
#pragma unroll
        for (int e = 0; e < 4; ++e) { sKT[(dc + 2 * e) * 72 + row] = (u16)(v[e] & 0xffffu); sKT[(dc + 2 * e + 1) * 72 + row] = (u16)(v[e] >> 16); }
      }
      {
        const int row = tid & 63, ec = (tid >> 6) * 8;
        const u32x4 v = pv;
#pragma unroll
        for (int e = 0; e < 4; ++e) { sVT[(ec + 2 * e) * 72 + row] = (u16)(v[e] & 0xffffu); sVT[(ec + 2 * e + 1) * 72 + row] = (u16)(v[e] >> 16); }
      }
      if (tid < 64) sGc[tid] = pg;
      bf16x8 qf[4], tf[2];
#pragma unroll
      for (int ks = 0; ks < 4; ++ks) qf[ks] = pq[ks];
#pragma unroll
      for (int ks = 0; ks < 2; ++ks) tf[ks] = pt[ks];
      __syncthreads();
      if (step + 1 < nch) { const int cn = dir ? nch - 2 - step : step + 1; SCAN_PREFETCH(cn); }
      const float gl = dir ? sGc[0] : sGc[63];
      f32x4 ua[2];
#pragma unroll
      for (int et = 0; et < 2; ++et) {
        ua[et][0] = 0.f; ua[et][1] = 0.f; ua[et][2] = 0.f; ua[et][3] = 0.f;
#pragma unroll
        for (int ks = 0; ks < 2; ++ks) ua[et] = mma(tf[ks], ld8(sVT + (et * 16 + l15) * 72 + ks * 32 + g * 8), ua[et]);
      }
      bf16x8 tf2[2];
#pragma unroll
      for (int ks = 0; ks < 2; ++ks) {
        const u32x4 tw = __builtin_bit_cast(u32x4, tf[ks]);
        u32x4 o;
#pragma unroll
        for (int e = 0; e < 4; ++e) {
          const int m = ks * 32 + g * 8 + 2 * e;
          o[e] = pack2(bflo(tw[e]) * __expf(sGc[m]), bfhi(tw[e]) * __expf(sGc[m + 1]));
        }
        tf2[ks] = __builtin_bit_cast(bf16x8, o);
      }
      bf16x8 wf[4];
#pragma unroll
      for (int kq = 0; kq < 4; ++kq) {
        f32x4 wa[2];
#pragma unroll
        for (int hh = 0; hh < 2; ++hh) {
          const int dt = kq * 2 + hh;
          wa[hh][0] = 0.f; wa[hh][1] = 0.f; wa[hh][2] = 0.f; wa[hh][3] = 0.f;
#pragma unroll
          for (int ks = 0; ks < 2; ++ks) wa[hh] = mma(ld8(sKT + (dt * 16 + l15) * 72 + ks * 32 + g * 8), tf2[ks], wa[hh]);
        }
        wf[kq] = pack8(wa[0], wa[1]);
      }
      f32x4 vn[2];
#pragma unroll
      for (int et = 0; et < 2; ++et) {
        f32x4 a; a[0] = 0.f; a[1] = 0.f; a[2] = 0.f; a[3] = 0.f;
#pragma unroll
        for (int kq = 0; kq < 4; ++kq) { const u16* sp = sST + (et * 16 + l15) * 136 + kq * 32 + g * 4; a = mma(wf[kq], ld44(sp, sp + 16), a); }
        vn[et][0] = ua[et][0] - a[0]; vn[et][1] = ua[et][1] - a[1]; vn[et][2] = ua[et][2] - a[2]; vn[et][3] = ua[et][3] - a[3];
      }
      bf16x8 qkf[2];
      {
        const int iq = w * 16 + l15;
        const float gi = sGc[iq];
#pragma unroll
        for (int kk = 0; kk < 2; ++kk) {
          f32x4 ka[2];
#pragma unroll
          for (int hh = 0; hh < 2; ++hh) {
            const int mt = kk * 2 + hh;
            ka[hh][0] = 0.f; ka[hh][1] = 0.f; ka[hh][2] = 0.f; ka[hh][3] = 0.f;
#pragma unroll
            for (int ks = 0; ks < 4; ++ks) ka[hh] = mma(ld8(sK + (mt * 16 + l15) * 136 + ks * 32 + g * 8), qf[ks], ka[hh]);
#pragma unroll
            for (int r = 0; r < 4; ++r) {
              const int m = mt * 16 + g * 4 + r;
              const bool valid = dir ? (iq <= m) : (iq >= m);
              ka[hh][r] = valid ? ka[hh][r] * __expf(gi - sGc[m]) : 0.f;
            }
          }
          qkf[kk] = pack8(ka[0], ka[1]);
        }
      }
#pragma unroll
      for (int et = 0; et < 2; ++et) {
        const int i0 = w * 16 + g * 4;
        st4bf(sVN + (et * 16 + l15) * 72 + i0, vn[et][0], vn[et][1], vn[et][2], vn[et][3]);
        st4bf(sVD + (et * 16 + l15) * 72 + i0, vn[et][0] * __expf(gl - sGc[i0]), vn[et][1] * __expf(gl - sGc[i0 + 1]), vn[et][2] * __expf(gl - sGc[i0 + 2]), vn[et][3] * __expf(gl - sGc[i0 + 3]));
      }
      __syncthreads();
#pragma unroll
      for (int et = 0; et < 2; ++et) {
        f32x4 a1; a1[0] = 0.f; a1[1] = 0.f; a1[2] = 0.f; a1[3] = 0.f;
#pragma unroll
        for (int ks = 0; ks < 4; ++ks) a1 = mma(qf[ks], ld8(sST + (et * 16 + l15) * 136 + ks * 32 + g * 8), a1);
        f32x4 a2; a2[0] = 0.f; a2[1] = 0.f; a2[2] = 0.f; a2[3] = 0.f;
#pragma unroll
        for (int kk = 0; kk < 2; ++kk) { const u16* sp = sVN + (et * 16 + l15) * 72 + kk * 32 + g * 4; a2 = mma(qkf[kk], ld44(sp, sp + 16), a2); }
#pragma unroll
        for (int r = 0; r < 4; ++r) {
          const int i = w * 16 + g * 4 + r;
          const float o = a1[r] * __expf(sGc[i]) + a2[r];
          obase[(size_t)(t0 + i) * 4096 + dir * 1024 + h * 128 + dvq * 32 + et * 16 + l15] = f2bf(o);
        }
      }
      {
        const float eg = __expf(gl);
#pragma unroll
        for (int dt = 0; dt < 2; ++dt)
#pragma unroll
          for (int et = 0; et < 2; ++et) {
            f32x4 a; a[0] = S[dt][et][0] * eg; a[1] = S[dt][et][1] * eg; a[2] = S[dt][et][2] * eg; a[3] = S[dt][et][3] * eg;
#pragma unroll
            for (int kk = 0; kk < 2; ++kk) a = mma(ld8(sKT + (w * 32 + dt * 16 + l15) * 72 + kk * 32 + g * 8), ld8(sVD + (et * 16 + l15) * 72 + kk * 32 + g * 8), a);
            S[dt][et] = a;
          }
      }
      __syncthreads();
#pragma unroll
      for (int dt = 0; dt < 2; ++dt)
#pragma unroll
        for (int et = 0; et < 2; ++et) st4bf(sST + (et * 16 + l15) * 136 + w * 32 + dt * 16 + g * 4, S[dt][et][0], S[dt][et][1], S[dt][et][2], S[dt][et][3]);
    }
    if (seq < 16) {
      float* so = GOUT + (dir ? O_SB : O_SF) + (((size_t)seq * 2 + j) * 8 + h) * 16384;
#pragma unroll
      for (int dt = 0; dt < 2; ++dt)
#pragma unroll
        for (int et = 0; et < 2; ++et)
#pragma unroll
          for (int r = 0; r < 4; ++r) so[(size_t)(w * 32 + dt * 16 + g * 4 + r) * 128 + dvq * 32 + et * 16 + l15] = S[dt][et][r];
    }
  }
}

#define XB_TMO      128
#define XB_XCNT(j)  (256  + 64 * (j))
#define XB_XSUB(j)  (1280 + 64 * (j))
#define XB_XGEN(j)  (2304 + 64 * (j))
#define XB_TOP      3328
#define XB_TOPGEN   3392
#define XCD_BAR_WORDS 3456
#define XB_SPIN_CAP (1u << 20)
#define LAS __attribute__((address_space(3)))
DI unsigned xb_ld(unsigned* p)              { return __hip_atomic_load(p, __ATOMIC_RELAXED, __HIP_MEMORY_SCOPE_AGENT); }
DI unsigned xb_add(unsigned* p, unsigned v) { return __hip_atomic_fetch_add(p, v, __ATOMIC_RELAXED, __HIP_MEMORY_SCOPE_AGENT); }
DI unsigned xb_xcc_id() { return (unsigned)__builtin_amdgcn_s_getreg((3 << 11) | 20) & 0xFu; }
#define XB_SPIN(cond, bar) do { unsigned _sp = 0; while (cond) { __builtin_amdgcn_s_sleep(1); \
    if ((++_sp & 255u) == 0u) { if (xb_ld(&(bar)[XB_TMO])) break; if (_sp > XB_SPIN_CAP) { atomicAdd(&(bar)[XB_TMO], 1u); break; } } } } while (0)
struct XcdBarrier { unsigned* bar; unsigned x; volatile LAS unsigned* st; };
DI XcdBarrier xcd_barrier_post(unsigned* bar, volatile LAS unsigned* st) {
  XcdBarrier b; b.bar = bar; b.x = xb_xcc_id(); b.st = st;
  if (threadIdx.x == 0) (void)xb_add(&bar[XB_XCNT(b.x)], 1u);
  return b;
}
DI void xcd_barrier_complete(unsigned* bar, unsigned x, unsigned& nloc, unsigned& nx) {
  const unsigned Gn = gridDim.x * gridDim.y * gridDim.z;
  unsigned sum, cnt, mine, sp = 0u;
  for (;;) {
    sum = 0u; cnt = 0u; mine = 0u;
#pragma unroll
    for (unsigned j = 0; j < 16; ++j) { const unsigned c = xb_ld(&bar[XB_XCNT(j)]); sum += c; cnt += (c > 0u) ? 1u : 0u; mine = (j == x) ? c : mine; }
    if (sum == Gn) break;
    __builtin_amdgcn_s_sleep(1);
    if ((++sp & 255u) == 0u) { if (xb_ld(&bar[XB_TMO])) break; if (sp > XB_SPIN_CAP) { atomicAdd(&bar[XB_TMO], 1u); break; } }
  }
  nloc = mine > 0u ? mine : 1u; nx = cnt > 0u ? cnt : 1u;
}
DI void xcd_barrier(const XcdBarrier& b) {
  asm volatile("s_waitcnt vmcnt(0)" ::: "memory");
  __syncthreads();
  if (threadIdx.x == 0) {
    unsigned* bar = b.bar;
    __builtin_amdgcn_s_waitcnt(0);
    unsigned nloc = b.st[0], nx = b.st[1];
    if (nloc == 0u) { xcd_barrier_complete(bar, b.x, nloc, nx); b.st[0] = nloc; b.st[1] = nx; }
    const unsigned old = xb_add(&bar[XB_XSUB(b.x)], 1u);
    const unsigned gen = old / nloc;
    if (old + 1u == (gen + 1u) * nloc) {
      __builtin_amdgcn_fence(__ATOMIC_RELEASE, "agent");
      asm volatile("s_waitcnt vmcnt(0)" ::: "memory");
      const unsigned og = xb_add(&bar[XB_TOP], 1u);
      const unsigned tg = og / nx;
      if (og + 1u == (tg + 1u) * nx) xb_add(&bar[XB_TOPGEN], 1u);
      else XB_SPIN(xb_ld(&bar[XB_TOPGEN]) == tg, bar);
      __builtin_amdgcn_fence(__ATOMIC_ACQUIRE, "agent");
      xb_add(&bar[XB_XGEN(b.x)], 1u);
      asm volatile("s_waitcnt vmcnt(0)" ::: "memory");
    } else {
      XB_SPIN(xb_ld(&bar[XB_XGEN(b.x)]) == gen, bar);
      __builtin_amdgcn_fence(__ATOMIC_ACQUIRE, "agent");
      asm volatile("s_waitcnt vmcnt(0)" ::: "memory");
    }
  }
  __syncthreads();
}

__global__ void __launch_bounds__(256, 2) fwd_megakernel(P p) {
  cg::grid_group grid = cg::this_grid();
  __shared__ __attribute__((aligned(16))) char smem[60416];
  const int tid = opaque_tid(), lane = tid & 63, wid = tid >> 6;
  const int G = gridDim.x;
  __shared__ uint4 xb_words;
  if (threadIdx.x == 0) xb_words = make_uint4(0u, 0u, 0u, 0u);
  __syncthreads();
  (void)xcd_barrier_post((unsigned*)(as_global(p.ws) + WS_BAR), (volatile LAS unsigned*)&xb_words);
#define GSYNC() do { XcdBarrier xb_; xb_.bar = (unsigned*)(opaque_ptr(as_global(p.ws)) + WS_BAR); xb_.x = xb_xcc_id(); xb_.st = (volatile LAS unsigned*)&xb_words; xcd_barrier(xb_); } while (0)
  const int bid0 = opaque_bid();
  {
  char* const ws0 = opaque_ptr(as_global(p.ws));
  float* mods = (float*)(ws0 + WS_MODS);
  float* ropeT = (float*)(ws0 + WS_ROPE);
  float* cosG = ropeT, *sinG = ropeT + 2048, *cosM = ropeT + 4096, *sinM = ropeT + 5120;

  {
    float* sc = (float*)smem;
    float* red = sc + 9 * 128;
    float* part = (float*)(ws0 + WS_R);
    for (int item = bid0; item < 3072; item += G) {
      const int ks = item & 7, cgp = (item >> 3) % 96, layer = item / 768;
      __syncthreads();
      for (int e = tid; e < 9 * 128; e += 256) {
        const int ci = e >> 7, k = ks * 128 + (e & 127);
        const float v = ci == 0 ? GIN(9)[k] : GIN(8)[(ci - 1) * 1024 + k];
        sc[e] = v / (1.f + expf(-v));
      }
      __syncthreads();
      const int col = tid & 63, kg = tid >> 6;
      const float* wp = GIN(12) + ((size_t)layer * 1024 + ks * 128 + kg * 32) * 6144 + cgp * 64 + col;
      float acc[9];
#pragma unroll
      for (int ci = 0; ci < 9; ++ci) acc[ci] = 0.f;
#pragma unroll 8
      for (int kk = 0; kk < 32; ++kk) {
        const float wv = wp[(size_t)kk * 6144];
#pragma unroll
        for (int ci = 0; ci < 9; ++ci) acc[ci] += sc[ci * 128 + kg * 32 + kk] * wv;
      }
#pragma unroll
      for (int ci = 0; ci < 9; ++ci) red[(kg * 64 + col) * 9 + ci] = acc[ci];
      __syncthreads();
      if (kg == 0) {
        const int n = cgp * 64 + col;
        const float bias = ks == 0 ? GIN(13)[(size_t)layer * 6144 + n] : 0.f;
#pragma unroll
        for (int ci = 0; ci < 9; ++ci) {
          const float s = red[col * 9 + ci] + red[(64 + col) * 9 + ci] + red[(128 + col) * 9 + ci] + red[(192 + col) * 9 + ci] + bias;
          part[(size_t)ks * 221184 + ((size_t)layer * 9 + ci) * 6144 + n] = s;
        }
      }
    }
    if (bid0 == G - 1) {
      for (int e = tid; e < 2048; e += 256) { const int pos = e >> 5, f = e & 31; const float fr = powf(10000.f, -(float)f / 32.f); const float a = (float)pos * fr; cosG[e] = cosf(a); sinG[e] = sinf(a); }
      for (int e = tid; e < 1024; e += 256) { const int pos = e >> 4, f = e & 15; const float fr = powf(10000.f, -(float)f / 16.f); const float a = (float)pos * fr; cosM[e] = cosf(a); sinM[e] = sinf(a); }
    }
  }
  if (gridDim.x == 0x7fffffffu) grid.sync();
  GSYNC();
  {
    const float* part = (const float*)(ws0 + WS_R);
    for (int e = bid0 * 256 + tid; e < 221184; e += G * 256) {
      float sacc = 0.f;
#pragma unroll
      for (int ks = 0; ks < 8; ++ks) sacc += part[(size_t)ks * 221184 + e];
      mods[e] = sacc;
    }
  }
  }
  GSYNC();

#pragma unroll 1
  for (int layer = 0; layer < 4; ++layer) {
    const int kind = layer % 3, j = layer / 3;
    const int bid = opaque_bid();
    char* const ws = opaque_ptr(as_global(p.ws));
    float* mods = (float*)(ws + WS_MODS);
    float* ropeT = (float*)(ws + WS_ROPE);
    float* cosG = ropeT, *sinG = ropeT + 2048, *cosM = ropeT + 4096, *sinM = ropeT + 5120;
    u16* hbuf = (u16*)(ws + WS_HBUF);
    u16* obuf = (u16*)(ws + WS_OBUF);
    u16* wmix = (u16*)(ws + WS_WMIX);
    u16* wmlp = (u16*)(ws + WS_WMLP);
    char* R = ws + WS_R;
    const float* lmods = mods + (size_t)layer * 9 * 6144;
    {
      for (int it = bid; it < 5120; it += G) norm_rows(p, layer, layer == 0, it, GIN(10) + layer * 1024, 0, 1);
      float* sT = (float*)smem;
      for (int it = bid; it < 2048; it += G) {
        if (it < 1024) convert_tile(GIN(14) + (size_t)layer * 1024 * 4096, 1024, 4096, wmlp, it, 0, sT);
        else convert_tile(GIN(15) + (size_t)layer * 4096 * 1024, 4096, 1024, wmlp + 4194304, it - 1024, 0, sT);
      }
      if (kind == 0) {
        for (int it = bid; it < 1056 + 256; it += G) {
          if (it < 1056) convert_tile(GIN(16) + (size_t)j * 1024 * 4128, 1024, 4128, wmix + WM_IN, it, 0, sT);
          else convert_tile(GIN(21) + (size_t)j * 1024 * 1024, 1024, 1024, wmix + WM_OUT, it - 1056, 0, sT);
        }
      } else if (kind == 1) {
        for (int it = bid; it < 192 + 144 + 128 + 256; it += G) {
          if (it < 192) convert_tile(GIN(22), 1024, 704, wmix + WM_IN, it, 0, sT);
          else if (it < 336) convert_tile(GIN(25), 384, 1536, wmix + WM_UQ, it - 192, 1, sT);
          else if (it < 464) convert_tile(GIN(26), 256, 2048, wmix + WM_UKV, it - 336, 0, sT);
          else convert_tile(GIN(31), 1024, 1024, wmix + WM_OUT, it - 464, 0, sT);
        }
      } else {
        for (int it = bid; it < 384 + 256; it += G) {
          if (it < 384) convert_tile(GIN(32), 1024, 1536, wmix + WM_IN, it, 0, sT);
          else convert_tile(GIN(35), 1024, 1024, wmix + WM_OUT, it - 384, 0, sT);
        }
        u16* Kg = (u16*)(R + R_KG); u16* Vg = (u16*)(R + R_VTG);
        const int tid = opaque_tid();
        for (int it = bid; it < 512; it += G) {
          const int b = it >> 6, s0 = (it & 63) * 8;
          const int ch = tid;
          float kv[8], vv[8];
#pragma unroll
          for (int e = 0; e < 8; ++e) { kv[e] = GIN(6)[((size_t)b * 512 + s0 + e) * 256 + ch]; vv[e] = GIN(7)[((size_t)b * 512 + s0 + e) * 256 + ch]; }
#pragma unroll
          for (int e = 0; e < 8; ++e) Kg[(size_t)(NPROMPT + b * 2560 + s0 + e) * 256 + ch] = f2bf(kv[e]);
          u32x4 o; o[0] = pack2(vv[0], vv[1]); o[1] = pack2(vv[2], vv[3]); o[2] = pack2(vv[4], vv[5]); o[3] = pack2(vv[6], vv[7]);
          *(u32x4*)(Vg + (size_t)(NPROMPT + b * 2560) * 256 + (size_t)ch * 2560 + s0) = o;
        }
      }
    }
    GSYNC();

    if (kind == 0) {
      {
        EpiGdnIn epi; epi.proj = (u16*)(R + R_PROJ); epi.gbuf = (float*)(R + R_GBUF);
        for (int it = bid; it < 160 * 33; it += G) { const int mt = it / 33, nt = it % 33; gemm_tile<4>(hbuf, 1024, wmix + WM_IN, 1024, 1024, mt * 128, nt * 128, (u16*)smem, epi); }
      }
      GSYNC();
      gdn_chunk_phase(p, j, smem);
      GSYNC();
      gdn_scan_phase(p, j, smem);
      GSYNC();
      {
        const u16* pr = (const u16*)(R + R_PROJ);
        const float* on = GIN(20) + j * 128;
        const int tid = opaque_tid();
        for (int t = bid; t < NTOK; t += G) {
          const int h = tid >> 5, c = (tid & 31) * 4;
          const u16* row = pr + (size_t)t * 4096;
          const u32x2 f = *(const u32x2*)(row + h * 128 + c), b = *(const u32x2*)(row + 1024 + h * 128 + c), z = *(const u32x2*)(row + 3072 + h * 128 + c);
          float o[4] = {bflo(f[0]) + bflo(b[0]), bfhi(f[0]) + bfhi(b[0]), bflo(f[1]) + bflo(b[1]), bfhi(f[1]) + bfhi(b[1])};
          float zz[4] = {bflo(z[0]), bfhi(z[0]), bflo(z[1]), bfhi(z[1])};
          float ss = o[0] * o[0] + o[1] * o[1] + o[2] * o[2] + o[3] * o[3];
          ss += __shfl_xor(ss, 1); ss += __shfl_xor(ss, 2); ss += __shfl_xor(ss, 4); ss += __shfl_xor(ss, 8); ss += __shfl_xor(ss, 16);
          const float rs = rsqrtf(ss * (1.f / 128.f) + EPS);
          const float4 gn = *(const float4*)(on + c);
          const float gg[4] = {gn.x, gn.y, gn.z, gn.w};
          float y[4];
#pragma unroll
          for (int e = 0; e < 4; ++e) y[e] = o[e] * rs * gg[e] * (zz[e] / (1.f + __expf(-zz[e])));
          st4bf(obuf + (size_t)t * 1024 + h * 128 + c, y[0], y[1], y[2], y[3]);
        }
      }
      GSYNC();
    } else if (kind == 1) {
      {
        EpiF32 epi; epi.dst = (float*)(R + R_DPROJ); epi.ld = 768;
        for (int it = bid; it < 160 * 6; it += G) { const int mt = it / 6, nt = it % 6; gemm_tile<4>(hbuf, 1024, wmix + WM_IN, 1024, 1024, mt * 128, nt * 128, (u16*)smem, epi); }
      }
      GSYNC();
      {
        const float* dproj = (const float*)(R + R_DPROJ);
        u16* cq = (u16*)(R + R_CQ); u16* ckv = (u16*)(R + R_CKV); u16* Km = (u16*)(R + R_KM);
        const int tid = opaque_tid(), lane = tid & 63, wid = tid >> 6;
        for (int it = bid; it < 6144; it += G) {
          const int row = it * 4 + wid;
          if (row < NTOK) {
            const int t = row;
            const float* pr = dproj + (size_t)t * 768;
            float v[6]; float ss = 0.f;
#pragma unroll
            for (int e = 0; e < 6; ++e) { v[e] = pr[lane + 64 * e]; ss += v[e] * v[e]; }
            ss = wave_sum(ss);
            float rs = rsqrtf(ss * (1.f / 384.f) + EPS);
#pragma unroll
            for (int e = 0; e < 6; ++e) cq[(size_t)t * 384 + lane + 64 * e] = f2bf(v[e] * rs * GIN(23)[lane + 64 * e]);
            const int kvrow = kvrow_of_tok(t);
            float wv[4]; ss = 0.f;
#pragma unroll
            for (int e = 0; e < 4; ++e) { wv[e] = pr[384 + lane + 64 * e]; ss += wv[e] * wv[e]; }
            ss = wave_sum(ss);
            rs = rsqrtf(ss * (1.f / 256.f) + EPS);
#pragma unroll
            for (int e = 0; e < 4; ++e) {
              const float o = wv[e] * rs * GIN(24)[lane + 64 * e];
              ckv[(size_t)kvrow * 256 + lane + 64 * e] = f2bf(o);
              if (t < NPROMPT) GOUT[O_CKV + (size_t)t * 256 + lane + 64 * e] = o;
            }
            const float x = pr[640 + lane];
            ss = wave_sum(x * x);
            float kr = x * rsqrtf(ss * (1.f / 64.f) + EPS) * GIN(30)[lane];
            if (t < NPROMPT) GOUT[O_KR + (size_t)t * 64 + lane] = kr;
            else {
              const int s = (t - NPROMPT) & 2047;
              const int pos = lane < 32 ? (s >> 6) : (s & 63);
              const float cs = cosM[pos * 16 + (lane & 15)], sn = sinM[pos * 16 + (lane & 15)];
              const float partner = __shfl_xor(kr, 16);
              kr = ((lane & 16) == 0) ? kr * cs - partner * sn : partner * sn + kr * cs;
            }
            const u16 kb = f2bf(kr);
#pragma unroll
            for (int hh = 0; hh < 8; ++hh) Km[(size_t)kvrow * 1536 + hh * 192 + 128 + lane] = kb;
          } else {
            const int r = row - NTOK; const int b = r >> 9, s = r & 511;
            const int kvrow = NPROMPT + b * 2560 + s;
#pragma unroll
            for (int e = 0; e < 4; ++e) ckv[(size_t)kvrow * 256 + lane + 64 * e] = f2bf(GIN(4)[((size_t)b * 512 + s) * 256 + lane + 64 * e]);
            const u16 kb = f2bf(GIN(5)[((size_t)b * 512 + s) * 64 + lane]);
#pragma unroll
            for (int hh = 0; hh < 8; ++hh) Km[(size_t)kvrow * 1536 + hh * 192 + 128 + lane] = kb;
          }
        }
      }
      GSYNC();
      {
        EpiMlaUq e1; e1.Q = (u16*)(R + R_Q); e1.gnope = GIN(27); e1.grope = GIN(28); e1.cosT = cosM; e1.sinT = sinM;
        for (int it = bid; it < 160 * 12; it += G) { const int mt = it / 12, nt = it % 12; gemm_tile<8>((const u16*)(R + R_CQ), 384, wmix + WM_UQ, 384, 384, mt * 128, nt * 128, (u16*)smem, e1); }
        EpiMlaUkv e2; e2.Kb = (u16*)(R + R_KM); e2.Vt = (u16*)(R + R_VTM); e2.gnope = GIN(29);
        for (int it = bid; it < 192 * 16; it += G) { const int mt = it / 16, nt = it % 16; gemm_tile<8>((const u16*)(R + R_CKV), 256, wmix + WM_UKV, 256, 256, mt * 128, nt * 128, (u16*)smem, e2); }
      }
      GSYNC();
      attn_phase<192, 8>((const u16*)(R + R_Q), (const u16*)(R + R_KM), (const u16*)(R + R_VTM), obuf, smem);
      GSYNC();
    } else {
      {
        EpiGqaIn epi; epi.Q = (u16*)(R + R_Q); epi.Kb = (u16*)(R + R_KG); epi.Vt = (u16*)(R + R_VTG); epi.qg = GIN(33); epi.kg = GIN(34); epi.cosT = cosG; epi.sinT = sinG; epi.out = GOUT;
        for (int it = bid; it < 160 * 12; it += G) { const int mt = it / 12, nt = it % 12; gemm_tile<8>(hbuf, 1024, wmix + WM_IN, 1024, 1024, mt * 128, nt * 128, (u16*)smem, epi); }
      }
      GSYNC();
      attn_phase<128, 2>((const u16*)(R + R_Q), (const u16*)(R + R_KG), (const u16*)(R + R_VTG), obuf, smem);
      GSYNC();
    }

    for (int it = bid; it < 160 * 8; it += G) {
      const int mt = it >> 3, nt = it & 7; const int m0 = mt * 128;
      EpiResid epi;
      epi.xin = (layer == 0) ? (m0 < NPROMPT ? GIN(0) : GIN(1) - (size_t)NPROMPT * 1024) : GOUT;
      epi.xout = GOUT; epi.gate = lmods + (size_t)cond_of(m0) * 6144 + 2 * 1024;
      gemm_tile<4>(obuf, 1024, wmix + WM_OUT, 1024, 1024, m0, nt * 128, (u16*)smem, epi);
    }
    GSYNC();
    for (int it = bid; it < 5120; it += G) norm_rows(p, layer, false, it, GIN(11) + layer * 1024, 3, 4);
    GSYNC();
    {
      EpiMlpIn epi; epi.abuf = (u16*)(R + R_ABUF);
      for (int it = bid; it < 160 * 32; it += G) { const int mt = it >> 5, nt = it & 31; gemm_tile<4>(hbuf, 1024, wmlp, 1024, 1024, mt * 128, nt * 128, (u16*)smem, epi); }
    }
    GSYNC();
    for (int it = bid; it < 160 * 8; it += G) {
      const int mt = it >> 3, nt = it & 7; const int m0 = mt * 128;
      EpiResid epi; epi.xin = GOUT; epi.xout = GOUT; epi.gate = lmods + (size_t)cond_of(m0) * 6144 + 5 * 1024;
      gemm_tile<4>((const u16*)(R + R_ABUF), 4096, wmlp + 4194304, 4096, 4096, m0, nt * 128, (u16*)smem, epi);
    }
    GSYNC();
  }
}

extern "C" void kernel_launch(void* const* d_in, const int* in_sizes, int n_in, void* d_out, int out_size, void* d_ws, size_t ws_size, hipStream_t stream) {
  static int grid_blocks = 0;
  if (!grid_blocks) {
    int dev = 0, cus = 0, per_cu = 0;
    hipGetDevice(&dev);
    hipDeviceGetAttribute(&cus, hipDeviceAttributeMultiprocessorCount, dev);
    hipOccupancyMaxActiveBlocksPerMultiprocessor(&per_cu, fwd_megakernel, 256, 0);
    if (per_cu < 1) per_cu = 1;
    if (per_cu > 2) per_cu = 2;
    grid_blocks = cus * per_cu;
  }
  P p{};
  for (int i = 0; i < 36; ++i) p.in[i] = (const float*)d_in[i];
  p.out = (float*)d_out;
  p.ws = (char*)d_ws;
  (void)hipMemsetAsync((char*)d_ws + WS_BAR, 0, XCD_BAR_WORDS * 4, stream);
  void* args[] = {&p};
  hipError_t e = hipLaunchCooperativeKernel((void*)fwd_megakernel, dim3(grid_blocks), dim3(256), args, 0, stream);
  if (e != hipSuccess) fprintf(stderr, "cooperative launch failed: %s (grid %d)\n", hipGetErrorString(e), grid_blocks);
}
```

```cpp
#include <hip/hip_runtime.h>
#include <hip/hip_cooperative_groups.h>
#include <cstdio>
namespace cg = cooperative_groups;

typedef unsigned short u16;
typedef __attribute__((ext_vector_type(8))) short bf16x8;
typedef __attribute__((ext_vector_type(4))) short bf16x4;
typedef __attribute__((ext_vector_type(4))) float f32x4;
typedef __attribute__((ext_vector_type(4))) unsigned u32x4;
typedef __attribute__((ext_vector_type(2))) unsigned u32x2;

#define DI __device__ __forceinline__

constexpr int NTOK = 20480;
constexpr int NPROMPT = 4096;
constexpr float EPS = 1e-6f;

constexpr size_t WS_MODS = 0;
constexpr size_t MODS_BYTES = 4ull * 9 * 6144 * 4;
constexpr size_t WS_BAR = 917504;
constexpr size_t WS_ROPE = 1048576;
constexpr size_t WS_WMIX = 1114112;
constexpr size_t WS_WMLP = 14090240;
constexpr size_t WS_HBUF = 30867456;
constexpr size_t WS_OBUF = 72810496;
constexpr size_t WS_R    = 114753536;
constexpr size_t R_ABUF = 0;
constexpr size_t R_PROJ = 0;
constexpr size_t R_VBUF = 167772160;
constexpr size_t R_TBUF = 209715200;
constexpr size_t R_GBUF = 251658240;
constexpr size_t R_GCB  = 254279680;
constexpr size_t R_BETA = 255590400;
constexpr size_t R_DPROJ = 0;
constexpr size_t R_Q    = 0;
constexpr size_t R_CQ   = 62914560;
constexpr size_t R_CKV  = 78643200;
constexpr size_t R_KM   = 91226112;
constexpr size_t R_VTM  = 166723584;
constexpr size_t R_KG   = 41943040;
constexpr size_t R_VTG  = 54525952;
constexpr size_t WM_IN = 0;
constexpr size_t WM_OUT = 4325376;
constexpr size_t WM_UQ = 5373952;
constexpr size_t WM_UKV = 5963776;
constexpr size_t O_SF = 20971520, O_SB = 25165824, O_CKV = 29360128, O_KR = 30408704, O_GK = 30670848, O_GV = 31719424;

struct P {
  const float* in[36];
  float* out;
  char* ws;
};

typedef __attribute__((ext_vector_type(2))) float f32x2_t;
typedef __attribute__((ext_vector_type(2))) __bf16 bf16x2_t;
DI u16 f2bf(float x) { return __builtin_bit_cast(u16, (__bf16)x); }
DI float bf2f(u16 h) { return __uint_as_float(((unsigned)h) << 16); }
DI unsigned pack2(float a, float b) { f32x2_t v; v[0] = a; v[1] = b; return __builtin_bit_cast(unsigned, __builtin_convertvector(v, bf16x2_t)); }
DI float bflo(unsigned w) { return __uint_as_float(w << 16); }
DI float bfhi(unsigned w) { return __uint_as_float(w & 0xffff0000u); }
DI f32x4 mma(bf16x8 a, bf16x8 b, f32x4 c) { return __builtin_amdgcn_mfma_f32_16x16x32_bf16(a, b, c, 0, 0, 0); }
DI bf16x8 pack8(f32x4 a, f32x4 b) {
  u32x4 p; p[0] = pack2(a[0], a[1]); p[1] = pack2(a[2], a[3]); p[2] = pack2(b[0], b[1]); p[3] = pack2(b[2], b[3]);
  return __builtin_bit_cast(bf16x8, p);
}
DI bf16x8 ld8(const u16* p) { return *(const bf16x8*)p; }
DI bf16x8 ld44(const u16* p0, const u16* p1) {
  u32x2 a = *(const u32x2*)p0; u32x2 b = *(const u32x2*)p1;
  u32x4 r; r[0] = a[0]; r[1] = a[1]; r[2] = b[0]; r[3] = b[1];
  return __builtin_bit_cast(bf16x8, r);
}
DI void st4bf(u16* p, float a, float b, float c, float d) { u32x2 v; v[0] = pack2(a, b); v[1] = pack2(c, d); *(u32x2*)p = v; }
DI float wave_sum(float v) {
  v += __shfl_xor(v, 1); v += __shfl_xor(v, 2); v += __shfl_xor(v, 4); v += __shfl_xor(v, 8); v += __shfl_xor(v, 16); v += __shfl_xor(v, 32);
  return v;
}
DI float sum_g(float v) { v += __shfl_xor(v, 16); v += __shfl_xor(v, 32); return v; }
DI int opaque_tid() { int t = threadIdx.x; asm volatile("" : "+v"(t)); return t; }
DI int opaque_bid() { int t = __builtin_amdgcn_readfirstlane((int)blockIdx.x); asm volatile("" : "+s"(t)); return t; }
DI char* opaque_ptr(char* q) {
  unsigned lo = __builtin_amdgcn_readfirstlane((unsigned)(size_t)q), hi = __builtin_amdgcn_readfirstlane((unsigned)((size_t)q >> 32));
  asm volatile("" : "+s"(lo), "+s"(hi));
  typedef __attribute__((address_space(1))) char gchar_t;
  return (char*)(gchar_t*)(((size_t)hi << 32) | (size_t)lo);
}
template <class T> DI T* as_global(T* q) { typedef __attribute__((address_space(1))) T gT; return (T*)(gT*)q; }
#define GIN(i) as_global(p.in[i])
#define GOUT as_global(p.out)
DI int cond_of(int t) { return t < NPROMPT ? 0 : 1 + ((t - NPROMPT) >> 11); }
DI int kvrow_of_tok(int t) { return t < NPROMPT ? t : NPROMPT + ((t - NPROMPT) >> 11) * 2560 + 512 + ((t - NPROMPT) & 2047); }

template <int NI, class Epi>
DI void gemm_tile(const u16* __restrict__ A, int lda, const u16* __restrict__ Bt, int ldb, int K, int m0, int n0, u16* smem, Epi& epi) {
  constexpr int MI = 16 / NI;
  constexpr int WN = 8 / NI;
  const int tid = opaque_tid(), lane = tid & 63, wid = tid >> 6, l15 = lane & 15, g = lane >> 4;
  const int wm = wid / WN, wn = wid % WN;
  u16* sA = smem; u16* sB = smem + 128 * 64;
  f32x4 acc[MI][NI];
#pragma unroll
  for (int mi = 0; mi < MI; ++mi)
#pragma unroll
    for (int ni = 0; ni < NI; ++ni) { acc[mi][ni][0] = 0.f; acc[mi][ni][1] = 0.f; acc[mi][ni][2] = 0.f; acc[mi][ni][3] = 0.f; }
  const int lrow = tid >> 3, lkc = (tid & 7) * 8;
  const int wofs = lrow * 64 + (((tid & 7) ^ ((lrow >> 1) & 7)) * 8);
  const int rsw = (l15 >> 1) & 7;
  const int rofs0 = l15 * 64 + ((g ^ rsw) * 8), rofs1 = l15 * 64 + (((4 + g) ^ rsw) * 8);
  const u16* pa = A + (size_t)(m0 + lrow) * lda + lkc;
  const u16* pb = Bt + (size_t)(n0 + lrow) * ldb + lkc;
  u32x4 ra[2][4], rb[2][4];
  const int nk = K >> 6;
#pragma unroll
  for (int i = 0; i < 4; ++i) { ra[0][i] = *(const u32x4*)(pa + (size_t)i * 32 * lda); rb[0][i] = *(const u32x4*)(pb + (size_t)i * 32 * ldb); }
#pragma unroll
  for (int i = 0; i < 4; ++i) { ra[1][i] = *(const u32x4*)(pa + (size_t)i * 32 * lda + 64); rb[1][i] = *(const u32x4*)(pb + (size_t)i * 32 * ldb + 64); }
  for (int kt = 0; kt < nk; kt += 2) {
#pragma unroll
    for (int half = 0; half < 2; ++half) {
      __syncthreads();
#pragma unroll
      for (int i = 0; i < 4; ++i) { *(u32x4*)(sA + wofs + i * 32 * 64) = ra[half][i]; *(u32x4*)(sB + wofs + i * 32 * 64) = rb[half][i]; }
      __syncthreads();
      if (kt + half + 2 < nk) {
        const int ko = (kt + half + 2) * 64;
#pragma unroll
        for (int i = 0; i < 4; ++i) { ra[half][i] = *(const u32x4*)(pa + (size_t)i * 32 * lda + ko); rb[half][i] = *(const u32x4*)(pb + (size_t)i * 32 * ldb + ko); }
      }
#pragma unroll
      for (int ks = 0; ks < 2; ++ks) {
        const int ro = ks ? rofs1 : rofs0;
        bf16x8 af[MI], bfv[NI];
#pragma unroll
        for (int mi = 0; mi < MI; ++mi) af[mi] = ld8(sA + (wm * MI * 16 + mi * 16) * 64 + ro);
#pragma unroll
        for (int ni = 0; ni < NI; ++ni) bfv[ni] = ld8(sB + (wn * NI * 16 + ni * 16) * 64 + ro);
        __builtin_amdgcn_s_setprio(1);
#pragma unroll
        for (int mi = 0; mi < MI; ++mi)
#pragma unroll
          for (int ni = 0; ni < NI; ++ni) acc[mi][ni] = mma(bfv[ni], af[mi], acc[mi][ni]);
        __builtin_amdgcn_s_setprio(0);
      }
    }
  }
  epi.template run<MI, NI>(acc, m0 + wm * MI * 16, n0 + wn * NI * 16, l15, g);
}

struct EpiResid {
  const float* xin; float* xout; const float* gate;
  template <int MI, int NI> DI void run(f32x4 (&acc)[MI][NI], int mr, int nc, int l15, int g) {
#pragma unroll
    for (int mi = 0; mi < MI; ++mi)
#pragma unroll
      for (int ni = 0; ni < NI; ++ni) {
        const int m = mr + mi * 16 + l15, n = nc + ni * 16 + g * 4;
        const float4 xi = *(const float4*)(xin + (size_t)m * 1024 + n);
        const float4 gt = *(const float4*)(gate + n);
        float4 o; o.x = xi.x + gt.x * acc[mi][ni][0]; o.y = xi.y + gt.y * acc[mi][ni][1]; o.z = xi.z + gt.z * acc[mi][ni][2]; o.w = xi.w + gt.w * acc[mi][ni][3];
        *(float4*)(xout + (size_t)m * 1024 + n) = o;
      }
  }
};
struct EpiGdnIn {
  u16* proj; float* gbuf;
  template <int MI, int NI> DI void run(f32x4 (&acc)[MI][NI], int mr, int nc, int l15, int g) {
#pragma unroll
    for (int mi = 0; mi < MI; ++mi)
#pragma unroll
      for (int ni = 0; ni < NI; ++ni) {
        const int m = mr + mi * 16 + l15, n = nc + ni * 16 + g * 4;
        if (n < 4096) st4bf(proj + (size_t)m * 4096 + n, acc[mi][ni][0], acc[mi][ni][1], acc[mi][ni][2], acc[mi][ni][3]);
        else if (n < 4128) { float4 o; o.x = acc[mi][ni][0]; o.y = acc[mi][ni][1]; o.z = acc[mi][ni][2]; o.w = acc[mi][ni][3]; *(float4*)(gbuf + (size_t)m * 32 + (n - 4096)) = o; }
      }
  }
};
struct EpiMlpIn {
  u16* abuf;
  template <int MI, int NI> DI void run(f32x4 (&acc)[MI][NI], int mr, int nc, int l15, int g) {
#pragma unroll
    for (int mi = 0; mi < MI; ++mi)
#pragma unroll
      for (int ni = 0; ni < NI; ++ni) {
        const int m = mr + mi * 16 + l15, n = nc + ni * 16 + g * 4;
        float a = fmaxf(acc[mi][ni][0], 0.f), b = fmaxf(acc[mi][ni][1], 0.f), c = fmaxf(acc[mi][ni][2], 0.f), d = fmaxf(acc[mi][ni][3], 0.f);
        st4bf(abuf + (size_t)m * 4096 + n, a * a, b * b, c * c, d * d);
      }
  }
};
struct EpiF32 {
  float* dst; int ld;
  template <int MI, int NI> DI void run(f32x4 (&acc)[MI][NI], int mr, int nc, int l15, int g) {
#pragma unroll
    for (int mi = 0; mi < MI; ++mi)
#pragma unroll
      for (int ni = 0; ni < NI; ++ni) {
        const int m = mr + mi * 16 + l15, n = nc + ni * 16 + g * 4;
        float4 o; o.x = acc[mi][ni][0]; o.y = acc[mi][ni][1]; o.z = acc[mi][ni][2]; o.w = acc[mi][ni][3];
        *(float4*)(dst + (size_t)m * ld + n) = o;
      }
  }
};

DI void rope128(f32x4 (&v)[8], int rowp, int colp, int g, const float* cosT, const float* sinT) {
#pragma unroll
  for (int hf = 0; hf < 2; ++hf) {
    const int pos = hf ? colp : rowp;
#pragma unroll
    for (int a = 0; a < 2; ++a) {
      const int n1 = hf * 4 + a, n2 = n1 + 2;
      const float4 cs = *(const float4*)(cosT + pos * 32 + a * 16 + g * 4);
      const float4 sn = *(const float4*)(sinT + pos * 32 + a * 16 + g * 4);
      const float c4[4] = {cs.x, cs.y, cs.z, cs.w}, s4[4] = {sn.x, sn.y, sn.z, sn.w};
#pragma unroll
      for (int j = 0; j < 4; ++j) { const float x1 = v[n1][j], x2 = v[n2][j]; v[n1][j] = x1 * c4[j] - x2 * s4[j]; v[n2][j] = x1 * s4[j] + x2 * c4[j]; }
    }
  }
}
DI void rope64(f32x4* v, int rowp, int colp, int g, const float* cosT, const float* sinT) {
#pragma unroll
  for (int hf = 0; hf < 2; ++hf) {
    const int pos = hf ? colp : rowp;
    const int n1 = hf * 2, n2 = n1 + 1;
    const float4 cs = *(const float4*)(cosT + pos * 16 + g * 4);
    const float4 sn = *(const float4*)(sinT + pos * 16 + g * 4);
    const float c4[4] = {cs.x, cs.y, cs.z, cs.w}, s4[4] = {sn.x, sn.y, sn.z, sn.w};
#pragma unroll
    for (int j = 0; j < 4; ++j) { const float x1 = v[n1][j], x2 = v[n2][j]; v[n1][j] = x1 * c4[j] - x2 * s4[j]; v[n2][j] = x1 * s4[j] + x2 * c4[j]; }
  }
}

struct EpiGqaIn {
  u16* Q; u16* Kb; u16* Vt; const float* qg; const float* kg; const float* cosT; const float* sinT; float* out;
  template <int MI, int NI> DI void run(f32x4 (&acc)[MI][NI], int mr, int nc, int l15, int g) {
    const int nt = nc >> 7;
#pragma unroll
    for (int mi = 0; mi < MI; ++mi) {
      const int m = mr + mi * 16 + l15;
      const bool prompt = m < NPROMPT;
      const int s = prompt ? (m & 255) : ((m - NPROMPT) & 2047);
      const int rowp = s >> 6, colp = s & 63;
      const int kvrow = kvrow_of_tok(m);
      if (nt < 10) {
        float ss = 0.f;
#pragma unroll
        for (int ni = 0; ni < NI; ++ni)
#pragma unroll
          for (int j = 0; j < 4; ++j) ss += acc[mi][ni][j] * acc[mi][ni][j];
        ss = sum_g(ss);
        const float rs = rsqrtf(ss * (1.f / 128.f) + EPS);
        const float* gn = nt < 8 ? qg : kg;
#pragma unroll
        for (int ni = 0; ni < NI; ++ni) {
          const float4 gv = *(const float4*)(gn + ni * 16 + g * 4);
          acc[mi][ni][0] *= rs * gv.x; acc[mi][ni][1] *= rs * gv.y; acc[mi][ni][2] *= rs * gv.z; acc[mi][ni][3] *= rs * gv.w;
        }
        if (nt >= 8 && prompt) {
#pragma unroll
          for (int ni = 0; ni < NI; ++ni) { float4 o; o.x = acc[mi][ni][0]; o.y = acc[mi][ni][1]; o.z = acc[mi][ni][2]; o.w = acc[mi][ni][3]; *(float4*)(out + O_GK + (size_t)m * 256 + (nt - 8) * 128 + ni * 16 + g * 4) = o; }
        }
        if (!prompt) rope128(acc[mi], rowp, colp, g, cosT, sinT);
        u16* dst = nt < 8 ? Q + (size_t)m * 1024 + nt * 128 : Kb + (size_t)kvrow * 256 + (nt - 8) * 128;
#pragma unroll
        for (int ni = 0; ni < NI; ++ni) st4bf(dst + ni * 16 + g * 4, acc[mi][ni][0], acc[mi][ni][1], acc[mi][ni][2], acc[mi][ni][3]);
      } else {
        const int kvh = nt - 10;
        if (prompt) {
#pragma unroll
          for (int ni = 0; ni < NI; ++ni) { float4 o; o.x = acc[mi][ni][0]; o.y = acc[mi][ni][1]; o.z = acc[mi][ni][2]; o.w = acc[mi][ni][3]; *(float4*)(out + O_GV + (size_t)m * 256 + kvh * 128 + ni * 16 + g * 4) = o; }
        }
        size_t base; int kvlen, pos;
        if (prompt) { base = (size_t)(m >> 8) * 256 * 256; kvlen = 256; pos = m & 255; }
        else { const int b = (m - NPROMPT) >> 11; base = (size_t)(NPROMPT + b * 2560) * 256; kvlen = 2560; pos = 512 + s; }
#pragma unroll
        for (int ni = 0; ni < NI; ++ni)
#pragma unroll
          for (int j = 0; j < 4; ++j) Vt[base + (size_t)(kvh * 128 + ni * 16 + g * 4 + j) * kvlen + pos] = f2bf(acc[mi][ni][j]);
      }
    }
  }
};
struct EpiMlaUq {
  u16* Q; const float* gnope; const float* grope; const float* cosT; const float* sinT;
  template <int MI, int NI> DI void run(f32x4 (&acc)[MI][NI], int mr, int nc, int l15, int g) {
    const int nt = nc >> 7;
#pragma unroll
    for (int mi = 0; mi < MI; ++mi) {
      const int m = mr + mi * 16 + l15;
      const bool prompt = m < NPROMPT;
      const int s = prompt ? (m & 255) : ((m - NPROMPT) & 2047);
      const int rowp = s >> 6, colp = s & 63;
      if (nt < 8) {
        float ss = 0.f;
#pragma unroll
        for (int ni = 0; ni < NI; ++ni)
#pragma unroll
          for (int j = 0; j < 4; ++j) ss += acc[mi][ni][j] * acc[mi][ni][j];
        ss = sum_g(ss);
        const float rs = rsqrtf(ss * (1.f / 128.f) + EPS);
#pragma unroll
        for (int ni = 0; ni < NI; ++ni) {
          const float4 gv = *(const float4*)(gnope + ni * 16 + g * 4);
          st4bf(Q + (size_t)m * 1536 + nt * 192 + ni * 16 + g * 4, acc[mi][ni][0] * rs * gv.x, acc[mi][ni][1] * rs * gv.y, acc[mi][ni][2] * rs * gv.z, acc[mi][ni][3] * rs * gv.w);
        }
      } else {
#pragma unroll
        for (int hh = 0; hh < 2; ++hh) {
          const int h = (nt - 8) * 2 + hh;
          float ss = 0.f;
#pragma unroll
          for (int ni = 0; ni < 4; ++ni)
#pragma unroll
            for (int j = 0; j < 4; ++j) ss += acc[mi][hh * 4 + ni][j] * acc[mi][hh * 4 + ni][j];
          ss = sum_g(ss);
          const float rs = rsqrtf(ss * (1.f / 64.f) + EPS);
#pragma unroll
          for (int ni = 0; ni < 4; ++ni) {
            const float4 gv = *(const float4*)(grope + ni * 16 + g * 4);
            acc[mi][hh * 4 + ni][0] *= rs * gv.x; acc[mi][hh * 4 + ni][1] *= rs * gv.y; acc[mi][hh * 4 + ni][2] *= rs * gv.z; acc[mi][hh * 4 + ni][3] *= rs * gv.w;
          }
          if (!prompt) rope64(&acc[mi][hh * 4], rowp, colp, g, cosT, sinT);
#pragma unroll
          for (int ni = 0; ni < 4; ++ni)
            st4bf(Q + (size_t)m * 1536 + h * 192 + 128 + ni * 16 + g * 4, acc[mi][hh * 4 + ni][0], acc[mi][hh * 4 + ni][1], acc[mi][hh * 4 + ni][2], acc[mi][hh * 4 + ni][3]);
        }
      }
    }
  }
};
struct EpiMlaUkv {
  u16* Kb; u16* Vt; const float* gnope;
  template <int MI, int NI> DI void run(f32x4 (&acc)[MI][NI], int mr, int nc, int l15, int g) {
    const int nt = nc >> 7, h = nt >> 1;
#pragma unroll
    for (int mi = 0; mi < MI; ++mi) {
      const int m = mr + mi * 16 + l15;
      if ((nt & 1) == 0) {
        float ss = 0.f;
#pragma unroll
        for (int ni = 0; ni < NI; ++ni)
#pragma unroll
          for (int j = 0; j < 4; ++j) ss += acc[mi][ni][j] * acc[mi][ni][j];
        ss = sum_g(ss);
        const float rs = rsqrtf(ss * (1.f / 128.f) + EPS);
#pragma unroll
        for (int ni = 0; ni < NI; ++ni) {
          const float4 gv = *(const float4*)(gnope + ni * 16 + g * 4);
          st4bf(Kb + (size_t)m * 1536 + h * 192 + ni * 16 + g * 4, acc[mi][ni][0] * rs * gv.x, acc[mi][ni][1] * rs * gv.y, acc[mi][ni][2] * rs * gv.z, acc[mi][ni][3] * rs * gv.w);
        }
      } else {
        size_t base; int kvlen, pos;
        if (m < NPROMPT) { base = (size_t)(m >> 8) * 256 * 1024; kvlen = 256; pos = m & 255; }
        else { const int r = m - NPROMPT; const int b = r / 2560; base = (size_t)(NPROMPT + b * 2560) * 1024; kvlen = 2560; pos = r - b * 2560; }
#pragma unroll
        for (int ni = 0; ni < NI; ++ni)
#pragma unroll
          for (int j = 0; j < 4; ++j) Vt[base + (size_t)(h * 128 + ni * 16 + g * 4 + j) * kvlen + pos] = f2bf(acc[mi][ni][j]);
      }
    }
  }
};

DI void convert_tile(const float* __restrict__ W, int K, int N, u16* __restrict__ Bt, int tile, int perm, float* sT) {
  const int nkt = K >> 6;
  const int kt = tile % nkt, nt = tile / nkt;
  const int k0 = kt * 64, n0 = nt * 64;
  const int tid = opaque_tid();
  __syncthreads();
  {
    const int n = tid & 63, kq = tid >> 6;
    int nd = n0 + n, ns = nd;
    if (perm == 1) { if (nd < 1024) ns = (nd >> 7) * 192 + (nd & 127); else { const int x = nd - 1024; ns = (x >> 6) * 192 + 128 + (x & 63); } }
    const bool ok = nd < N;
#pragma unroll
    for (int r = 0; r < 16; ++r) { const int k = r * 4 + kq; sT[k * 65 + n] = ok ? W[(size_t)(k0 + k) * N + ns] : 0.f; }
  }
  __syncthreads();
  {
    const int n = tid >> 2, kq = (tid & 3) * 16;
    u32x4 a, b;
#pragma unroll
    for (int e = 0; e < 4; ++e) { a[e] = pack2(sT[(kq + 2 * e) * 65 + n], sT[(kq + 2 * e + 1) * 65 + n]); b[e] = pack2(sT[(kq + 8 + 2 * e) * 65 + n], sT[(kq + 9 + 2 * e) * 65 + n]); }
    u16* dst = Bt + (size_t)(n0 + n) * K + k0 + kq;
    *(u32x4*)dst = a; *(u32x4*)(dst + 8) = b;
  }
}

DI void norm_rows(const P& p, int layer, bool from_input, int item, const float* gnorm, int shift_idx, int scale_idx) {
  const int tidn = opaque_tid();
  char* const ws = opaque_ptr(as_global(p.ws));
  const int lane = tidn & 63, wid = tidn >> 6;
  const int t = item * 4 + wid;
  const float* x = from_input ? (t < NPROMPT ? GIN(0) + (size_t)t * 1024 : GIN(1) + (size_t)(t - NPROMPT) * 1024) : GOUT + (size_t)t * 1024;
  const float* mods = (const float*)(ws + WS_MODS) + ((size_t)layer * 9 + cond_of(t)) * 6144;
  u16* h = (u16*)(ws + WS_HBUF) + (size_t)t * 1024;
  float4 v[4]; float ss = 0.f;
#pragma unroll
  for (int e = 0; e < 4; ++e) { v[e] = *(const float4*)(x + e * 256 + lane * 4); ss += v[e].x * v[e].x + v[e].y * v[e].y + v[e].z * v[e].z + v[e].w * v[e].w; }
  ss = wave_sum(ss);
  const float rs = rsqrtf(ss * (1.f / 1024.f) + EPS);
#pragma unroll
  for (int e = 0; e < 4; ++e) {
    const int c = e * 256 + lane * 4;
    const float4 gv = *(const float4*)(gnorm + c);
    const float4 sc = *(const float4*)(mods + scale_idx * 1024 + c);
    const float4 sh = *(const float4*)(mods + shift_idx * 1024 + c);
    st4bf(h + c, v[e].x * rs * gv.x * (1.f + sc.x) + sh.x, v[e].y * rs * gv.y * (1.f + sc.y) + sh.y, v[e].z * rs * gv.z * (1.f + sc.z) + sh.z, v[e].w * rs * gv.w * (1.f + sc.w) + sh.w);
  }
}

template <int DK, int HK>
DI void attn_phase(const u16* __restrict__ Q, const u16* __restrict__ Kb, const u16* __restrict__ Vt, u16* __restrict__ obuf, char* smem_raw) {
  const int bid = opaque_bid();
  constexpr int KS = DK / 32, KSTR = DK, QSTR = 8 * DK, KROW = HK * DK, GRP = 8 / HK;
  constexpr int CPR = DK / 8;
  constexpr int KCH = 64 * CPR / 256;
  u16* sK = (u16*)smem_raw;
  u16* sV = sK + 64 * KSTR;
  const int tid = opaque_tid(), lane = tid & 63, wid = tid >> 6, l15 = lane & 15, g = lane >> 4;
  const float sc = rsqrtf((float)DK) * 1.4426950408889634f;
  for (int item = bid; item < 1280; item += gridDim.x) {
    int qb, h, kvlen, tokbase, kvbase;
    if (item < 1024) { const int b = item >> 7, rem = item & 127; h = rem & 7; qb = rem >> 3; kvlen = 2560; tokbase = NPROMPT + b * 2048; kvbase = NPROMPT + b * 2560; }
    else { const int it2 = item - 1024; const int b = it2 >> 4, rem = it2 & 15; h = rem & 7; qb = rem >> 3; kvlen = 256; tokbase = b * 256; kvbase = b * 256; }
    const int kvh = h / GRP;
    const u16* Kp = Kb + (size_t)kvbase * KROW + kvh * DK;
    const u16* Vp = Vt + (size_t)kvbase * (HK * 128) + (size_t)kvh * 128 * kvlen;
    const int qrow0 = tokbase + qb * 128 + wid * 32;
    bf16x8 qf[2][KS];
#pragma unroll
    for (int qi = 0; qi < 2; ++qi)
#pragma unroll
      for (int ks = 0; ks < KS; ++ks) qf[qi][ks] = ld8(Q + (size_t)(qrow0 + qi * 16 + l15) * QSTR + h * DK + ks * 32 + g * 8);
    f32x4 ot[2][8];
#pragma unroll
    for (int qi = 0; qi < 2; ++qi)
#pragma unroll
      for (int dj = 0; dj < 8; ++dj) { ot[qi][dj][0] = 0.f; ot[qi][dj][1] = 0.f; ot[qi][dj][2] = 0.f; ot[qi][dj][3] = 0.f; }
    float mrun[2] = {-1e30f, -1e30f}, lrun[2] = {0.f, 0.f};
    const int ntiles = kvlen >> 6;
    const unsigned toffK = (unsigned)((tid >> 3) * KROW + (tid & 7) * 8), toffV = (unsigned)((tid >> 3) * kvlen + (tid & 7) * 8);
    const int kx = tid >> 3;
    const int kperm = ((kx >> 2) & 1) * 16 + (kx >> 3) * 4 + (kx & 3);
    const int kswz = (CPR == 16) ? (kperm & 15) : ((kperm >> 1) & 7);
    const int ldsoffK = kperm * KSTR;
    const int ldsoffV = (tid >> 3) * 64 + (((tid & 7) ^ (((tid >> 3) >> 1) & 7)) * 8);
    u32x4 rk[KCH], rv[4];
#pragma unroll
    for (int i = 0; i < KCH; ++i) { const int rh = i & 1, cgp = i >> 1; rk[i] = *(const u32x4*)(Kp + (size_t)(rh * 32 * KROW + cgp * 64) + toffK); }
#pragma unroll
    for (int i = 0; i < 4; ++i) rv[i] = *(const u32x4*)(Vp + (size_t)i * 32 * kvlen + toffV);
    for (int kt = 0; kt < ntiles; ++kt) {
      const u16* Kt = Kp + (size_t)(kt + 1) * 64 * KROW;
      const u16* Vtp = Vp + (kt + 1) * 64;
      const bool more = kt + 1 < ntiles;
      __syncthreads();
#pragma unroll
      for (int i = 0; i < KCH; ++i) { const int rh = i & 1, cgp = i >> 1; const int c = (tid & 7) + 8 * cgp; const int pos = (CPR == 16) ? (c ^ kswz) : ((c & ~7) | ((c & 7) ^ kswz)); *(u32x4*)(sK + ldsoffK + rh * 32 * KSTR + pos * 8) = rk[i]; }
#pragma unroll
      for (int i = 0; i < 4; ++i) *(u32x4*)(sV + ldsoffV + i * 32 * 64) = rv[i];
      __syncthreads();
      if (more) {
#pragma unroll
        for (int i = 0; i < KCH; ++i) { const int rh = i & 1, cgp = i >> 1; rk[i] = *(const u32x4*)(Kt + (size_t)(rh * 32 * KROW + cgp * 64) + toffK); }
      }
      __builtin_amdgcn_sched_barrier(0);
      f32x4 st[2][4];
#pragma unroll
      for (int qi = 0; qi < 2; ++qi)
#pragma unroll
        for (int kj = 0; kj < 4; ++kj) { st[qi][kj][0] = 0.f; st[qi][kj][1] = 0.f; st[qi][kj][2] = 0.f; st[qi][kj][3] = 0.f; }
#pragma unroll
      for (int ks = 0; ks < KS; ++ks) {
#pragma unroll
        for (int kj = 0; kj < 4; ++kj) {
          const int kc = ks * 4 + g;
          const int kpos = (CPR == 16) ? (kc ^ l15) : ((kc & ~7) | ((kc & 7) ^ ((l15 >> 1) & 7)));
          const bf16x8 ka = ld8(sK + (kj * 16 + l15) * KSTR + kpos * 8);
          __builtin_amdgcn_s_setprio(1);
          st[0][kj] = mma(ka, qf[0][ks], st[0][kj]);
          st[1][kj] = mma(ka, qf[1][ks], st[1][kj]);
          __builtin_amdgcn_s_setprio(0);
        }
        __builtin_amdgcn_sched_barrier(0);
      }
      bf16x8 pf[2][2];
#pragma unroll
      for (int qi = 0; qi < 2; ++qi) {
        float mx = -1e30f;
#pragma unroll
        for (int kj = 0; kj < 4; ++kj)
#pragma unroll
          for (int r = 0; r < 4; ++r) mx = fmaxf(mx, st[qi][kj][r]);
        mx = fmaxf(mx, __shfl_xor(mx, 16)); mx = fmaxf(mx, __shfl_xor(mx, 32));
        const float mnew = fmaxf(mrun[qi], mx);
        const float alpha = __builtin_amdgcn_exp2f((mrun[qi] - mnew) * sc);
        mrun[qi] = mnew;
        float ps = 0.f;
        const float mneg = -mnew * sc;
#pragma unroll
        for (int kj = 0; kj < 4; ++kj)
#pragma unroll
          for (int r = 0; r < 4; ++r) { const float pv = __builtin_amdgcn_exp2f(fmaf(st[qi][kj][r], sc, mneg)); st[qi][kj][r] = pv; ps += pv; }
        lrun[qi] = lrun[qi] * alpha + ps;
#pragma unroll
        for (int dj = 0; dj < 8; ++dj) { ot[qi][dj][0] *= alpha; ot[qi][dj][1] *= alpha; ot[qi][dj][2] *= alpha; ot[qi][dj][3] *= alpha; }
        pf[qi][0] = pack8(st[qi][0], st[qi][1]);
        pf[qi][1] = pack8(st[qi][2], st[qi][3]);
        __builtin_amdgcn_sched_barrier(0);
      }
      if (more) {
#pragma unroll
        for (int i = 0; i < 4; ++i) rv[i] = *(const u32x4*)(Vtp + (size_t)i * 32 * kvlen + toffV);
      }
      __builtin_amdgcn_sched_barrier(0);
#pragma unroll
      for (int kk = 0; kk < 2; ++kk)
#pragma unroll
        for (int dj = 0; dj < 8; ++dj) {
          const bf16x8 va = ld8(sV + (dj * 16 + l15) * 64 + (((kk * 4 + g) ^ ((l15 >> 1) & 7)) * 8));
          __builtin_amdgcn_s_setprio(1);
          ot[0][dj] = mma(va, pf[0][kk], ot[0][dj]);
          ot[1][dj] = mma(va, pf[1][kk], ot[1][dj]);
          __builtin_amdgcn_s_setprio(0);
          if ((dj & 3) == 3) __builtin_amdgcn_sched_barrier(0);
        }
    }
#pragma unroll
    for (int qi = 0; qi < 2; ++qi) {
      const float inv = 1.f / sum_g(lrun[qi]);
      u16* dst = obuf + (size_t)(qrow0 + qi * 16 + l15) * 1024 + h * 128 + g * 4;
#pragma unroll
      for (int dj = 0; dj < 8; ++dj) st4bf(dst + dj * 16, ot[qi][dj][0] * inv, ot[qi][dj][1] * inv, ot[qi][dj][2] * inv, ot[qi][dj][3] * inv);
    }
  }
}

DI void gdn_chunk_phase(const P& p, int j, char* smem_raw) {
  const int bid = opaque_bid();
  char* const ws = opaque_ptr(as_global(p.ws));
  u16* sK = (u16*)smem_raw;
  float* sA = (float*)(smem_raw + 17408);
  float* sG = (float*)(smem_raw + 17408 + 32768);
  float* sBt = sG + 128;
  const int tid = opaque_tid(), lane = tid & 63, wid = tid >> 6, l15 = lane & 15, g = lane >> 4;
  const u16* proj = (const u16*)(ws + WS_R + R_PROJ);
  u16* qn = (u16*)(ws + WS_HBUF); u16* kn = (u16*)(ws + WS_OBUF); u16* vb = (u16*)(ws + WS_R + R_VBUF);
  u16* Tbuf = (u16*)(ws + WS_R + R_TBUF);
  const float* gbuf = (const float*)(ws + WS_R + R_GBUF);
  float* gcb = (float*)(ws + WS_R + R_GCB); float* betab = (float*)(ws + WS_R + R_BETA);
  const float* conv = GIN(17) + (size_t)j * 3 * 3072;
  const float* a_log = GIN(18) + j * 16; const float* dt_bias = GIN(19) + j * 16;
  for (int unit = bid; unit < 2560; unit += gridDim.x) {
    const int cgi = unit >> 3, h = unit & 7;
    int c, nch; if (cgi < 64) { c = cgi & 3; nch = 4; } else { c = (cgi - 64) & 31; nch = 32; }
    const int t0 = cgi * 64;
    const bool has_prev = c > 0, has_next = c < nch - 1;
    __syncthreads();
    {
      const int r = tid >> 4, cc = (tid & 15) * 8;
#pragma unroll
      for (int part = 0; part < 3; ++part) {
        const int ch = part * 1024 + h * 128 + cc;
        float w0[8], w1[8], w2[8];
#pragma unroll
        for (int e = 0; e < 8; ++e) { w0[e] = conv[ch + e]; w1[e] = conv[3072 + ch + e]; w2[e] = conv[6144 + ch + e]; }
        u16* dstb = part == 0 ? qn : (part == 1 ? kn : vb);
        for (int it = 0; it < 4; ++it) {
          const int i = it * 16 + r, t = t0 + i;
          const u16* src = proj + (size_t)t * 4096 + ch;
          const u32x4 xc = *(const u32x4*)src;
          u32x4 xp = {0u, 0u, 0u, 0u}, xn = {0u, 0u, 0u, 0u};
          if (i > 0 || has_prev) xp = *(const u32x4*)(src - 4096);
          if (i < 63 || has_next) xn = *(const u32x4*)(src + 4096);
          float y[8];
#pragma unroll
          for (int e = 0; e < 4; ++e) {
            float a = w0[2 * e] * bflo(xp[e]) + w1[2 * e] * bflo(xc[e]) + w2[2 * e] * bflo(xn[e]);
            float b = w0[2 * e + 1] * bfhi(xp[e]) + w1[2 * e + 1] * bfhi(xc[e]) + w2[2 * e + 1] * bfhi(xn[e]);
            y[2 * e] = a / (1.f + __expf(-a)); y[2 * e + 1] = b / (1.f + __expf(-b));
          }
          if (part < 2) {
            float ss = 0.f;
#pragma unroll
            for (int e = 0; e < 8; ++e) ss += y[e] * y[e];
            ss += __shfl_xor(ss, 1); ss += __shfl_xor(ss, 2); ss += __shfl_xor(ss, 4); ss += __shfl_xor(ss, 8);
            const float rs = rsqrtf(ss + EPS) * (part == 0 ? 0.08838834764831845f : 1.f);
#pragma unroll
            for (int e = 0; e < 8; ++e) y[e] *= rs;
          }
          u32x4 o; o[0] = pack2(y[0], y[1]); o[1] = pack2(y[2], y[3]); o[2] = pack2(y[4], y[5]); o[3] = pack2(y[6], y[7]);
          *(u32x4*)(dstb + (size_t)t * 1024 + h * 128 + cc) = o;
          if (part == 1) *(u32x4*)(sK + i * 136 + cc) = o;
        }
      }
    }
    if (tid < 128) {
      const int dir = tid >> 6, L = tid & 63;
      const int i = dir ? 63 - L : L;
      const float* gb = gbuf + (size_t)(t0 + i) * 32;
      const float gin = gb[dir * 8 + h], bin = gb[16 + dir * 8 + h];
      const float x = gin + dt_bias[dir * 8 + h];
      const float sp = fmaxf(x, 0.f) + log1pf(expf(-fabsf(x)));
      float gv = -expf(a_log[dir * 8 + h]) * sp;
      const float bt = 1.f / (1.f + expf(-bin));
#pragma unroll
      for (int off = 1; off < 64; off <<= 1) { const float v = __shfl_up(gv, off); if (L >= off) gv += v; }
      sG[dir * 64 + i] = gv; sBt[dir * 64 + i] = bt;
      gcb[((size_t)(t0 + i) * 8 + h) * 2 + dir] = gv; betab[((size_t)(t0 + i) * 8 + h) * 2 + dir] = bt;
    }
    __syncthreads();
    {
      f32x4 ga[4];
#pragma unroll
      for (int mt = 0; mt < 4; ++mt) { ga[mt][0] = 0.f; ga[mt][1] = 0.f; ga[mt][2] = 0.f; ga[mt][3] = 0.f; }
#pragma unroll
      for (int ks = 0; ks < 4; ++ks) {
        const bf16x8 a = ld8(sK + (wid * 16 + l15) * 136 + ks * 32 + g * 8);
#pragma unroll
        for (int mt = 0; mt < 4; ++mt) { const bf16x8 b = ld8(sK + (mt * 16 + l15) * 136 + ks * 32 + g * 8); ga[mt] = mma(a, b, ga[mt]); }
      }
#pragma unroll
      for (int dir = 0; dir < 2; ++dir)
#pragma unroll
        for (int mt = 0; mt < 4; ++mt)
#pragma unroll
          for (int r = 0; r < 4; ++r) {
            const int i = wid * 16 + g * 4 + r, m = mt * 16 + l15;
            const bool valid = dir ? (i < m) : (i > m);
            const float val = valid ? sBt[dir * 64 + i] * ga[mt][r] * __expf(sG[dir * 64 + i] - sG[dir * 64 + m]) : 0.f;
            const int ii = dir ? 63 - i : i, mm = dir ? 63 - m : m;
            sA[dir * 4096 + ii * 64 + mm] = val;
          }
    }
    __syncthreads();
    if (wid < 2) {
      const int dir = wid;
      float* Am = sA + dir * 4096;
      for (int i = 0; i < 64; ++i) {
        float a = (i == lane) ? 1.f : 0.f;
        int m = 0;
        for (; m + 8 <= i; m += 8) {
          const float4 a0 = *(const float4*)(Am + i * 64 + m), a1 = *(const float4*)(Am + i * 64 + m + 4);
          float tv[8];
#pragma unroll
          for (int e = 0; e < 8; ++e) tv[e] = Am[(m + e) * 64 + lane];
          a -= a0.x * tv[0]; a -= a0.y * tv[1]; a -= a0.z * tv[2]; a -= a0.w * tv[3];
          a -= a1.x * tv[4]; a -= a1.y * tv[5]; a -= a1.z * tv[6]; a -= a1.w * tv[7];
        }
        for (; m < i; ++m) a -= Am[i * 64 + m] * Am[m * 64 + lane];
        Am[i * 64 + lane] = a;
      }
      const int mn = dir ? 63 - lane : lane;
      const float bm = sBt[dir * 64 + mn];
      u16* Td = Tbuf + ((size_t)unit * 2 + dir) * 4096;
#pragma unroll 4
      for (int i = 0; i < 64; ++i) { const int in_ = dir ? 63 - i : i; Td[in_ * 64 + mn] = f2bf(Am[i * 64 + lane] * bm); }
    }
  }
}

DI void gdn_scan_phase(const P& p, int j, char* smem_raw) {
  const int bid = opaque_bid();
  char* const ws = opaque_ptr(as_global(p.ws));
  u16* sK = (u16*)smem_raw;
  u16* sKT = sK + 64 * 136;
  u16* sVT = sKT + 128 * 72;
  u16* sST = sVT + 32 * 72;
  u16* sVN = sST + 32 * 136;
  u16* sVD = sVN + 32 * 72;
  float* sGc = (float*)(sVD + 32 * 72);
  const int tid = opaque_tid(), lane = tid & 63, w = tid >> 6, l15 = lane & 15, g = lane >> 4;
  const u16* qn = (const u16*)(ws + WS_HBUF); const u16* kn = (const u16*)(ws + WS_OBUF); const u16* vb = (const u16*)(ws + WS_R + R_VBUF);
  const u16* Tbuf = (const u16*)(ws + WS_R + R_TBUF);
  const float* gcb = (const float*)(ws + WS_R + R_GCB);
  u16* obase = (u16*)(ws + WS_R + R_PROJ);
  for (int wk = bid; wk < 1536; wk += gridDim.x) {
    int seq, rem;
    if (wk < 512) { seq = 16 + (wk >> 6); rem = wk & 63; } else { seq = (wk - 512) >> 6; rem = (wk - 512) & 63; }
    const int h = rem >> 3, dir = (rem >> 2) & 1, dvq = rem & 3;
    const int nch = seq < 16 ? 4 : 32;
    const int cgb = seq < 16 ? seq * 4 : 64 + (seq - 16) * 32;
    f32x4 S[2][2];
    if (seq >= 16) {
      const float* s0 = GIN(2 + dir) + (((size_t)(seq - 16) * 2 + j) * 8 + h) * 16384;
#pragma unroll
      for (int dt = 0; dt < 2; ++dt)
#pragma unroll
        for (int et = 0; et < 2; ++et)
#pragma unroll
          for (int r = 0; r < 4; ++r) S[dt][et][r] = s0[(size_t)(w * 32 + dt * 16 + g * 4 + r) * 128 + dvq * 32 + et * 16 + l15];
    } else {
#pragma unroll
      for (int dt = 0; dt < 2; ++dt)
#pragma unroll
        for (int et = 0; et < 2; ++et) { S[dt][et][0] = 0.f; S[dt][et][1] = 0.f; S[dt][et][2] = 0.f; S[dt][et][3] = 0.f; }
    }
    __syncthreads();
#pragma unroll
    for (int dt = 0; dt < 2; ++dt)
#pragma unroll
      for (int et = 0; et < 2; ++et) st4bf(sST + (et * 16 + l15) * 136 + w * 32 + dt * 16 + g * 4, S[dt][et][0], S[dt][et][1], S[dt][et][2], S[dt][et][3]);
    u32x4 pk[4], pv; bf16x8 pq[4], pt[2]; float pg = 0.f;
#define SCAN_PREFETCH(cc) do { \
      const int t0n_ = (cgb + (cc)) * 64; const int unitn_ = (cgb + (cc)) * 8 + h; \
      _Pragma("unroll") for (int i = 0; i < 4; ++i) { const int row = tid & 63, dc = ((tid >> 6) + 4 * i) * 8; pk[i] = *(const u32x4*)(kn + (size_t)(t0n_ + row) * 1024 + h * 128 + dc); } \
      { const int row = tid & 63, ec = (tid >> 6) * 8; pv = *(const u32x4*)(vb + (size_t)(t0n_ + row) * 1024 + h * 128 + dvq * 32 + ec); } \
      if (tid < 64) pg = gcb[((size_t)(t0n_ + tid) * 8 + h) * 2 + dir]; \
      _Pragma("unroll") for (int ks = 0; ks < 4; ++ks) pq[ks] = ld8(qn + (size_t)(t0n_ + w * 16 + l15) * 1024 + h * 128 + ks * 32 + g * 8); \
      _Pragma("unroll") for (int ks = 0; ks < 2; ++ks) pt[ks] = ld8(Tbuf + ((size_t)unitn_ * 2 + dir) * 4096 + (w * 16 + l15) * 64 + ks * 32 + g * 8); \
    } while (0)
    SCAN_PREFETCH(dir ? nch - 1 : 0);
    for (int step = 0; step < nch; ++step) {
      const int c = dir ? nch - 1 - step : step;
      const int t0 = (cgb + c) * 64;
      const int unit = (cgb + c) * 8 + h;
#pragma unroll
      for (int i = 0; i < 4; ++i) {
        const int row = tid & 63, dc = ((tid >> 6) + 4 * i) * 8;
        const u32x4 v = pk[i];
        *(u32x4*)(sK + row * 136 + dc) = v;
#pragma unroll
        for (int e = 0; e < 4; ++e) { sKT[(dc + 2 * e) * 72 + row] = (u16)(v[e] & 0xffffu); sKT[(dc + 2 * e + 1) * 72 + row] = (u16)(v[e] >> 16); }
      }
      {
        const int row = tid & 63, ec = (tid >> 6) * 8;
        const u32x4 v = pv;
#pragma unroll
        for (int e = 0; e < 4; ++e) { sVT[(ec + 2 * e) * 72 + row] = (u16)(v[e] & 0xffffu); sVT[(ec + 2 * e + 1) * 72 + row] = (u16)(v[e] >> 16); }
      }
      if (tid < 64) sGc[tid] = pg;
      bf16x8 qf[4], tf[2];
#pragma unroll
      for (int ks = 0; ks < 4; ++ks) qf[ks] = pq[ks];
#pragma unroll
      for (int ks = 0; ks < 2; ++ks) tf[ks] = pt[ks];
      __syncthreads();
      if (step + 1 < nch) { const int cn = dir ? nch - 2 - step : step + 1; SCAN_PREFETCH(cn); }
      const float gl = dir ? sGc[0] : sGc[63];
      f32x4 ua[2];
#pragma unroll
      for (int et = 0; et < 2; ++et) {
        ua[et][0] = 0.f; ua[et][1] = 0.f; ua[et][2] = 0.f; ua[et][3] = 0.f;
#pragma unroll
        for (int ks = 0; ks < 2; ++ks) ua[et] = mma(tf[ks], ld8(sVT + (et * 16 + l15) * 72 + ks * 32 + g * 8), ua[et]);
      }
      bf16x8 tf2[2];
#pragma unroll
      for (int ks = 0; ks < 2; ++ks) {
        const u32x4 tw = __builtin_bit_cast(u32x4, tf[ks]);
        u32x4 o;
#pragma unroll
        for (int e = 0; e < 4; ++e) {
          const int m = ks * 32 + g * 8 + 2 * e;
          o[e] = pack2(bflo(tw[e]) * __expf(sGc[m]), bfhi(tw[e]) * __expf(sGc[m + 1]));
        }
        tf2[ks] = __builtin_bit_cast(bf16x8, o);
      }
      bf16x8 wf[4];
#pragma unroll
      for (int kq = 0; kq < 4; ++kq) {
        f32x4 wa[2];
#pragma unroll
        for (int hh = 0; hh < 2; ++hh) {
          const int dt = kq * 2 + hh;
          wa[hh][0] = 0.f; wa[hh][1] = 0.f; wa[hh][2] = 0.f; wa[hh][3] = 0.f;
#pragma unroll
          for (int ks = 0; ks < 2; ++ks) wa[hh] = mma(ld8(sKT + (dt * 16 + l15) * 72 + ks * 32 + g * 8), tf2[ks], wa[hh]);
        }
        wf[kq] = pack8(wa[0], wa[1]);
      }
      f32x4 vn[2];
#pragma unroll
      for (int et = 0; et < 2; ++et) {
        f32x4 a; a[0] = 0.f; a[1] = 0.f; a[2] = 0.f; a[3] = 0.f;
#pragma unroll
        for (int kq = 0; kq < 4; ++kq) { const u16* sp = sST + (et * 16 + l15) * 136 + kq * 32 + g * 4; a = mma(wf[kq], ld44(sp, sp + 16), a); }
        vn[et][0] = ua[et][0] - a[0]; vn[et][1] = ua[et][1] - a[1]; vn[et][2] = ua[et][2] - a[2]; vn[et][3] = ua[et][3] - a[3];
      }
      bf16x8 qkf[2];
      {
        const int iq = w * 16 + l15;
        const float gi = sGc[iq];
#pragma unroll
        for (int kk = 0; kk < 2; ++kk) {
          f32x4 ka[2];
#pragma unroll
          for (int hh = 0; hh < 2; ++hh) {
            const int mt = kk * 2 + hh;
            ka[hh][0] = 0.f; ka[hh][1] = 0.f; ka[hh][2] = 0.f; ka[hh][3] = 0.f;
#pragma unroll
            for (int ks = 0; ks < 4; ++ks) ka[hh] = mma(ld8(sK + (mt * 16 + l15) * 136 + ks * 32 + g * 8), qf[ks], ka[hh]);
#pragma unroll
            for (int r = 0; r < 4; ++r) {
              const int m = mt * 16 + g * 4 + r;
              const bool valid = dir ? (iq <= m) : (iq >= m);
              ka[hh][r] = valid ? ka[hh][r] * __expf(gi - sGc[m]) : 0.f;
            }
          }
          qkf[kk] = pack8(ka[0], ka[1]);
        }
      }
#pragma unroll
      for (int et = 0; et < 2; ++et) {
        const int i0 = w * 16 + g * 4;
        st4bf(sVN + (et * 16 + l15) * 72 + i0, vn[et][0], vn[et][1], vn[et][2], vn[et][3]);
        st4bf(sVD + (et * 16 + l15) * 72 + i0, vn[et][0] * __expf(gl - sGc[i0]), vn[et][1] * __expf(gl - sGc[i0 + 1]), vn[et][2] * __expf(gl - sGc[i0 + 2]), vn[et][3] * __expf(gl - sGc[i0 + 3]));
      }
      __syncthreads();
#pragma unroll
      for (int et = 0; et < 2; ++et) {
        f32x4 a1; a1[0] = 0.f; a1[1] = 0.f; a1[2] = 0.f; a1[3] = 0.f;
#pragma unroll
        for (int ks = 0; ks < 4; ++ks) a1 = mma(qf[ks], ld8(sST + (et * 16 + l15) * 136 + ks * 32 + g * 8), a1);
        f32x4 a2; a2[0] = 0.f; a2[1] = 0.f; a2[2] = 0.f; a2[3] = 0.f;
#pragma unroll
        for (int kk = 0; kk < 2; ++kk) { const u16* sp = sVN + (et * 16 + l15) * 72 + kk * 32 + g * 4; a2 = mma(qkf[kk], ld44(sp, sp + 16), a2); }
#pragma unroll
        for (int r = 0; r < 4; ++r) {
          const int i = w * 16 + g * 4 + r;
          const float o = a1[r] * __expf(sGc[i]) + a2[r];
          obase[(size_t)(t0 + i) * 4096 + dir * 1024 + h * 128 + dvq * 32 + et * 16 + l15] = f2bf(o);
        }
      }
      {
        const float eg = __expf(gl);
#pragma unroll
        for (int dt = 0; dt < 2; ++dt)
#pragma unroll
          for (int et = 0; et < 2; ++et) {
            f32x4 a; a[0] = S[dt][et][0] * eg; a[1] = S[dt][et][1] * eg; a[2] = S[dt][et][2] * eg; a[3] = S[dt][et][3] * eg;
#pragma unroll
            for (int kk = 0; kk < 2; ++kk) a = mma(ld8(sKT + (w * 32 + dt * 16 + l15) * 72 + kk * 32 + g * 8), ld8(sVD + (et * 16 + l15) * 72 + kk * 32 + g * 8), a);
            S[dt][et] = a;
          }
      }
      __syncthreads();
#pragma unroll
      for (int dt = 0; dt < 2; ++dt)
#pragma unroll
        for (int et = 0; et < 2; ++et) st4bf(sST + (et * 16 + l15) * 136 + w * 32 + dt * 16 + g * 4, S[dt][et][0], S[dt][et][1], S[dt][et][2], S[dt][et][3]);
    }
    if (seq < 16) {
      float* so = GOUT + (dir ? O_SB : O_SF) + (((size_t)seq * 2 + j) * 8 + h) * 16384;
#pragma unroll
      for (int dt = 0; dt < 2; ++dt)
#pragma unroll
        for (int et = 0; et < 2; ++et)
#pragma unroll
          for (int r = 0; r < 4; ++r) so[(size_t)(w * 32 + dt * 16 + g * 4 + r) * 128 + dvq * 32 + et * 16 + l15] = S[dt][et][r];
    }
  }
}

#define XB_TMO      128
#define XB_XCNT(j)  (256  + 64 * (j))
#define XB_XSUB(j)  (1280 + 64 * (j))
#define XB_XGEN(j)  (2304 + 64 * (j))
#define XB_TOP      3328
#define XB_TOPGEN   3392
#define XCD_BAR_WORDS 3456
#define XB_SPIN_CAP (1u << 20)
#define LAS __attribute__((address_space(3)))
DI unsigned xb_ld(unsigned* p)              { return __hip_atomic_load(p, __ATOMIC_RELAXED, __HIP_MEMORY_SCOPE_AGENT); }
DI unsigned xb_add(unsigned* p, unsigned v) { return __hip_atomic_fetch_add(p, v, __ATOMIC_RELAXED, __HIP_MEMORY_SCOPE_AGENT); }
DI unsigned xb_xcc_id() { return (unsigned)__builtin_amdgcn_s_getreg((3 << 11) | 20) & 0xFu; }
#define XB_SPIN(cond, bar) do { unsigned _sp = 0; while (cond) { __builtin_amdgcn_s_sleep(1); \
    if ((++_sp & 255u) == 0u) { if (xb_ld(&(bar)[XB_TMO])) break; if (_sp > XB_SPIN_CAP) { atomicAdd(&(bar)[XB_TMO], 1u); break; } } } } while (0)
struct XcdBarrier { unsigned* bar; unsigned x; volatile LAS unsigned* st; };
DI XcdBarrier xcd_barrier_post(unsigned* bar, volatile LAS unsigned* st) {
  XcdBarrier b; b.bar = bar; b.x = xb_xcc_id(); b.st = st;
  if (threadIdx.x == 0) (void)xb_add(&bar[XB_XCNT(b.x)], 1u);
  return b;
}
DI void xcd_barrier_complete(unsigned* bar, unsigned x, unsigned& nloc, unsigned& nx) {
  const unsigned Gn = gridDim.x * gridDim.y * gridDim.z;
  unsigned sum, cnt, mine, sp = 0u;
  for (;;) {
    sum = 0u; cnt = 0u; mine = 0u;
#pragma unroll
    for (unsigned j = 0; j < 16; ++j) { const unsigned c = xb_ld(&bar[XB_XCNT(j)]); sum += c; cnt += (c > 0u) ? 1u : 0u; mine = (j == x) ? c : mine; }
    if (sum == Gn) break;
    __builtin_amdgcn_s_sleep(1);
    if ((++sp & 255u) == 0u) { if (xb_ld(&bar[XB_TMO])) break; if (sp > XB_SPIN_CAP) { atomicAdd(&bar[XB_TMO], 1u); break; } }
  }
  nloc = mine > 0u ? mine : 1u; nx = cnt > 0u ? cnt : 1u;
}
DI void xcd_barrier(const XcdBarrier& b) {
  asm volatile("s_waitcnt vmcnt(0)" ::: "memory");
  __syncthreads();
  if (threadIdx.x == 0) {
    unsigned* bar = b.bar;
    __builtin_amdgcn_s_waitcnt(0);
    unsigned nloc = b.st[0], nx = b.st[1];
    if (nloc == 0u) { xcd_barrier_complete(bar, b.x, nloc, nx); b.st[0] = nloc; b.st[1] = nx; }
    const unsigned old = xb_add(&bar[XB_XSUB(b.x)], 1u);
    const unsigned gen = old / nloc;
    if (old + 1u == (gen + 1u) * nloc) {
      __builtin_amdgcn_fence(__ATOMIC_RELEASE, "agent");
      asm volatile("s_waitcnt vmcnt(0)" ::: "memory");
      const unsigned og = xb_add(&bar[XB_TOP], 1u);
      const unsigned tg = og / nx;
      if (og + 1u == (tg + 1u) * nx) xb_add(&bar[XB_TOPGEN], 1u);
      else XB_SPIN(xb_ld(&bar[XB_TOPGEN]) == tg, bar);
      __builtin_amdgcn_fence(__ATOMIC_ACQUIRE, "agent");
      xb_add(&bar[XB_XGEN(b.x)], 1u);
      asm volatile("s_waitcnt vmcnt(0)" ::: "memory");
    } else {
      XB_SPIN(xb_ld(&bar[XB_XGEN(b.x)]) == gen, bar);
      __builtin_amdgcn_fence(__ATOMIC_ACQUIRE, "agent");
      asm volatile("s_waitcnt vmcnt(0)" ::: "memory");
    }
  }
  __syncthreads();
}

__global__ void __launch_bounds__(256, 2) fwd_megakernel(P p) {
  cg::grid_group grid = cg::this_grid();
  __shared__ __attribute__((aligned(16))) char smem[60416];
  const int tid = opaque_tid(), lane = tid & 63, wid = tid >> 6;
  const int G = gridDim.x;
  __shared__ uint4 xb_words;
  if (threadIdx.x == 0) xb_words = make_uint4(0u, 0u, 0u, 0u);
  __syncthreads();
  (void)xcd_barrier_post((unsigned*)(as_global(p.ws) + WS_BAR), (volatile LAS unsigned*)&xb_words);
#define GSYNC() do { XcdBarrier xb_; xb_.bar = (unsigned*)(opaque_ptr(as_global(p.ws)) + WS_BAR); xb_.x = xb_xcc_id(); xb_.st = (volatile LAS unsigned*)&xb_words; xcd_barrier(xb_); } while (0)
  const int bid0 = opaque_bid();
  {
  char* const ws0 = opaque_ptr(as_global(p.ws));
  float* mods = (float*)(ws0 + WS_MODS);
  float* ropeT = (float*)(ws0 + WS_ROPE);
  float* cosG = ropeT, *sinG = ropeT + 2048, *cosM = ropeT + 4096, *sinM = ropeT + 5120;

  {
    float* sc = (float*)smem;
    float* red = sc + 9 * 128;
    float* part = (float*)(ws0 + WS_R);
    for (int item = bid0; item < 3072; item += G) {
      const int ks = item & 7, cgp = (item >> 3) % 96, layer = item / 768;
      __syncthreads();
      for (int e = tid; e < 9 * 128; e += 256) {
        const int ci = e >> 7, k = ks * 128 + (e & 127);
        const float v = ci == 0 ? GIN(9)[k] : GIN(8)[(ci - 1) * 1024 + k];
        sc[e] = v / (1.f + expf(-v));
      }
      __syncthreads();
      const int col = tid & 63, kg = tid >> 6;
      const float* wp = GIN(12) + ((size_t)layer * 1024 + ks * 128 + kg * 32) * 6144 + cgp * 64 + col;
      float acc[9];
#pragma unroll
      for (int ci = 0; ci < 9; ++ci) acc[ci] = 0.f;
#pragma unroll 8
      for (int kk = 0; kk < 32; ++kk) {
        const float wv = wp[(size_t)kk * 6144];
#pragma unroll
        for (int ci = 0; ci < 9; ++ci) acc[ci] += sc[ci * 128 + kg * 32 + kk] * wv;
      }
#pragma unroll
      for (int ci = 0; ci < 9; ++ci) red[(kg * 64 + col) * 9 + ci] = acc[ci];
      __syncthreads();
      if (kg == 0) {
        const int n = cgp * 64 + col;
        const float bias = ks == 0 ? GIN(13)[(size_t)layer * 6144 + n] : 0.f;
#pragma unroll
        for (int ci = 0; ci < 9; ++ci) {
          const float s = red[col * 9 + ci] + red[(64 + col) * 9 + ci] + red[(128 + col) * 9 + ci] + red[(192 + col) * 9 + ci] + bias;
          part[(size_t)ks * 221184 + ((size_t)layer * 9 + ci) * 6144 + n] = s;
        }
      }
    }
    if (bid0 == G - 1) {
      for (int e = tid; e < 2048; e += 256) { const int pos = e >> 5, f = e & 31; const float fr = powf(10000.f, -(float)f / 32.f); const float a = (float)pos * fr; cosG[e] = cosf(a); sinG[e] = sinf(a); }
      for (int e = tid; e < 1024; e += 256) { const int pos = e >> 4, f = e & 15; const float fr = powf(10000.f, -(float)f / 16.f); const float a = (float)pos * fr; cosM[e] = cosf(a); sinM[e] = sinf(a); }
    }
  }
  if (gridDim.x == 0x7fffffffu) grid.sync();
  GSYNC();
  {
    const float* part = (const float*)(ws0 + WS_R);
    for (int e = bid0 * 256 + tid; e < 221184; e += G * 256) {
      float sacc = 0.f;
#pragma unroll
      for (int ks = 0; ks < 8; ++ks) sacc += part[(size_t)ks * 221184 + e];
      mods[e] = sacc;
    }
  }
  }
  GSYNC();

#pragma unroll 1
  for (int layer = 0; layer < 4; ++layer) {
    const int kind = layer % 3, j = layer / 3;
    const int bid = opaque_bid();
    char* const ws = opaque_ptr(as_global(p.ws));
    float* mods = (float*)(ws + WS_MODS);
    float* ropeT = (float*)(ws + WS_ROPE);
    float* cosG = ropeT, *sinG = ropeT + 2048, *cosM = ropeT + 4096, *sinM = ropeT + 5120;
    u16* hbuf = (u16*)(ws + WS_HBUF);
    u16* obuf = (u16*)(ws + WS_OBUF);
    u16* wmix = (u16*)(ws + WS_WMIX);
    u16* wmlp = (u16*)(ws + WS_WMLP);
    char* R = ws + WS_R;
    const float* lmods = mods + (size_t)layer * 9 * 6144;
    {
      for (int it = bid; it < 5120; it += G) norm_rows(p, layer, layer == 0, it, GIN(10) + layer * 1024, 0, 1);
      float* sT = (float*)smem;
      for (int it = bid; it < 2048; it += G) {
        if (it < 1024) convert_tile(GIN(14) + (size_t)layer * 1024 * 4096, 1024, 4096, wmlp, it, 0, sT);
        else convert_tile(GIN(15) + (size_t)layer * 4096 * 1024, 4096, 1024, wmlp + 4194304, it - 1024, 0, sT);
      }
      if (kind == 0) {
        for (int it = bid; it < 1056 + 256; it += G) {
          if (it < 1056) convert_tile(GIN(16) + (size_t)j * 1024 * 4128, 1024, 4128, wmix + WM_IN, it, 0, sT);
          else convert_tile(GIN(21) + (size_t)j * 1024 * 1024, 1024, 1024, wmix + WM_OUT, it - 1056, 0, sT);
        }
      } else if (kind == 1) {
        for (int it = bid; it < 192 + 144 + 128 + 256; it += G) {
          if (it < 192) convert_tile(GIN(22), 1024, 704, wmix + WM_IN, it, 0, sT);
          else if (it < 336) convert_tile(GIN(25), 384, 1536, wmix + WM_UQ, it - 192, 1, sT);
          else if (it < 464) convert_tile(GIN(26), 256, 2048, wmix + WM_UKV, it - 336, 0, sT);
          else convert_tile(GIN(31), 1024, 1024, wmix + WM_OUT, it - 464, 0, sT);
        }
      } else {
        for (int it = bid; it < 384 + 256; it += G) {
          if (it < 384) convert_tile(GIN(32), 1024, 1536, wmix + WM_IN, it, 0, sT);
          else convert_tile(GIN(35), 1024, 1024, wmix + WM_OUT, it - 384, 0, sT);
        }
        u16* Kg = (u16*)(R + R_KG); u16* Vg = (u16*)(R + R_VTG);
        const int tid = opaque_tid();
        for (int it = bid; it < 512; it += G) {
          const int b = it >> 6, s0 = (it & 63) * 8;
          const int ch = tid;
          float kv[8], vv[8];
#pragma unroll
          for (int e = 0; e < 8; ++e) { kv[e] = GIN(6)[((size_t)b * 512 + s0 + e) * 256 + ch]; vv[e] = GIN(7)[((size_t)b * 512 + s0 + e) * 256 + ch]; }
#pragma unroll
          for (int e = 0; e < 8; ++e) Kg[(size_t)(NPROMPT + b * 2560 + s0 + e) * 256 + ch] = f2bf(kv[e]);
          u32x4 o; o[0] = pack2(vv[0], vv[1]); o[1] = pack2(vv[2], vv[3]); o[2] = pack2(vv[4], vv[5]); o[3] = pack2(vv[6], vv[7]);
          *(u32x4*)(Vg + (size_t)(NPROMPT + b * 2560) * 256 + (size_t)ch * 2560 + s0) = o;
        }
      }
    }
    GSYNC();

    if (kind == 0) {
      {
        EpiGdnIn epi; epi.proj = (u16*)(R + R_PROJ); epi.gbuf = (float*)(R + R_GBUF);
        for (int it = bid; it < 160 * 33; it += G) { const int mt = it / 33, nt = it % 33; gemm_tile<4>(hbuf, 1024, wmix + WM_IN, 1024, 1024, mt * 128, nt * 128, (u16*)smem, epi); }
      }
      GSYNC();
      gdn_chunk_phase(p, j, smem);
      GSYNC();
      gdn_scan_phase(p, j, smem);
      GSYNC();
      {
        const u16* pr = (const u16*)(R + R_PROJ);
        const float* on = GIN(20) + j * 128;
        const int tid = opaque_tid();
        for (int t = bid; t < NTOK; t += G) {
          const int h = tid >> 5, c = (tid & 31) * 4;
          const u16* row = pr + (size_t)t * 4096;
          const u32x2 f = *(const u32x2*)(row + h * 128 + c), b = *(const u32x2*)(row + 1024 + h * 128 + c), z = *(const u32x2*)(row + 3072 + h * 128 + c);
          float o[4] = {bflo(f[0]) + bflo(b[0]), bfhi(f[0]) + bfhi(b[0]), bflo(f[1]) + bflo(b[1]), bfhi(f[1]) + bfhi(b[1])};
          float zz[4] = {bflo(z[0]), bfhi(z[0]), bflo(z[1]), bfhi(z[1])};
          float ss = o[0] * o[0] + o[1] * o[1] + o[2] * o[2] + o[3] * o[3];
          ss += __shfl_xor(ss, 1); ss += __shfl_xor(ss, 2); ss += __shfl_xor(ss, 4); ss += __shfl_xor(ss, 8); ss += __shfl_xor(ss, 16);
          const float rs = rsqrtf(ss * (1.f / 128.f) + EPS);
          const float4 gn = *(const float4*)(on + c);
          const float gg[4] = {gn.x, gn.y, gn.z, gn.w};
          float y[4];
#pragma unroll
          for (int e = 0; e < 4; ++e) y[e] = o[e] * rs * gg[e] * (zz[e] / (1.f + __expf(-zz[e])));
          st4bf(obuf + (size_t)t * 1024 + h * 128 + c, y[0], y[1], y[2], y[3]);
        }
      }
      GSYNC();
    } else if (kind == 1) {
      {
        EpiF32 epi; epi.dst = (float*)(R + R_DPROJ); epi.ld = 768;
        for (int it = bid; it < 160 * 6; it += G) { const int mt = it / 6, nt = it % 6; gemm_tile<4>(hbuf, 1024, wmix + WM_IN, 1024, 1024, mt * 128, nt * 128, (u16*)smem, epi); }
      }
      GSYNC();
      {
        const float* dproj = (const float*)(R + R_DPROJ);
        u16* cq = (u16*)(R + R_CQ); u16* ckv = (u16*)(R + R_CKV); u16* Km = (u16*)(R + R_KM);
        const int tid = opaque_tid(), lane = tid & 63, wid = tid >> 6;
        for (int it = bid; it < 6144; it += G) {
          const int row = it * 4 + wid;
          if (row < NTOK) {
            const int t = row;
            const float* pr = dproj + (size_t)t * 768;
            float v[6]; float ss = 0.f;
#pragma unroll
            for (int e = 0; e < 6; ++e) { v[e] = pr[lane + 64 * e]; ss += v[e] * v[e]; }
            ss = wave_sum(ss);
            float rs = rsqrtf(ss * (1.f / 384.f) + EPS);
#pragma unroll
            for (int e = 0; e < 6; ++e) cq[(size_t)t * 384 + lane + 64 * e] = f2bf(v[e] * rs * GIN(23)[lane + 64 * e]);
            const int kvrow = kvrow_of_tok(t);
            float wv[4]; ss = 0.f;
#pragma unroll
            for (int e = 0; e < 4; ++e) { wv[e] = pr[384 + lane + 64 * e]; ss += wv[e] * wv[e]; }
            ss = wave_sum(ss);
            rs = rsqrtf(ss * (1.f / 256.f) + EPS);
#pragma unroll
            for (int e = 0; e < 4; ++e) {
              const float o = wv[e] * rs * GIN(24)[lane + 64 * e];
              ckv[(size_t)kvrow * 256 + lane + 64 * e] = f2bf(o);
              if (t < NPROMPT) GOUT[O_CKV + (size_t)t * 256 + lane + 64 * e] = o;
            }
            const float x = pr[640 + lane];
            ss = wave_sum(x * x);
            float kr = x * rsqrtf(ss * (1.f / 64.f) + EPS) * GIN(30)[lane];
            if (t < NPROMPT) GOUT[O_KR + (size_t)t * 64 + lane] = kr;
            else {
              const int s = (t - NPROMPT) & 2047;
              const int pos = lane < 32 ? (s >> 6) : (s & 63);
              const float cs = cosM[pos * 16 + (lane & 15)], sn = sinM[pos * 16 + (lane & 15)];
              const float partner = __shfl_xor(kr, 16);
              kr = ((lane & 16) == 0) ? kr * cs - partner * sn : partner * sn + kr * cs;
            }
            const u16 kb = f2bf(kr);
#pragma unroll
            for (int hh = 0; hh < 8; ++hh) Km[(size_t)kvrow * 1536 + hh * 192 + 128 + lane] = kb;
          } else {
            const int r = row - NTOK; const int b = r >> 9, s = r & 511;
            const int kvrow = NPROMPT + b * 2560 + s;
#pragma unroll
            for (int e = 0; e < 4; ++e) ckv[(size_t)kvrow * 256 + lane + 64 * e] = f2bf(GIN(4)[((size_t)b * 512 + s) * 256 + lane + 64 * e]);
            const u16 kb = f2bf(GIN(5)[((size_t)b * 512 + s) * 64 + lane]);
#pragma unroll
            for (int hh = 0; hh < 8; ++hh) Km[(size_t)kvrow * 1536 + hh * 192 + 128 + lane] = kb;
          }
        }
      }
      GSYNC();
      {
        EpiMlaUq e1; e1.Q = (u16*)(R + R_Q); e1.gnope = GIN(27); e1.grope = GIN(28); e1.cosT = cosM; e1.sinT = sinM;
        for (int it = bid; it < 160 * 12; it += G) { const int mt = it / 12, nt = it % 12; gemm_tile<8>((const u16*)(R + R_CQ), 384, wmix + WM_UQ, 384, 384, mt * 128, nt * 128, (u16*)smem, e1); }
        EpiMlaUkv e2; e2.Kb = (u16*)(R + R_KM); e2.Vt = (u16*)(R + R_VTM); e2.gnope = GIN(29);
        for (int it = bid; it < 192 * 16; it += G) { const int mt = it / 16, nt = it % 16; gemm_tile<8>((const u16*)(R + R_CKV), 256, wmix + WM_UKV, 256, 256, mt * 128, nt * 128, (u16*)smem, e2); }
      }
      GSYNC();
      attn_phase<192, 8>((const u16*)(R + R_Q), (const u16*)(R + R_KM), (const u16*)(R + R_VTM), obuf, smem);
      GSYNC();
    } else {
      {
        EpiGqaIn epi; epi.Q = (u16*)(R + R_Q); epi.Kb = (u16*)(R + R_KG); epi.Vt = (u16*)(R + R_VTG); epi.qg = GIN(33); epi.kg = GIN(34); epi.cosT = cosG; epi.sinT = sinG; epi.out = GOUT;
        for (int it = bid; it < 160 * 12; it += G) { const int mt = it / 12, nt = it % 12; gemm_tile<8>(hbuf, 1024, wmix + WM_IN, 1024, 1024, mt * 128, nt * 128, (u16*)smem, epi); }
      }
      GSYNC();
      attn_phase<128, 2>((const u16*)(R + R_Q), (const u16*)(R + R_KG), (const u16*)(R + R_VTG), obuf, smem);
      GSYNC();
    }

    for (int it = bid; it < 160 * 8; it += G) {
      const int mt = it >> 3, nt = it & 7; const int m0 = mt * 128;
      EpiResid epi;
      epi.xin = (layer == 0) ? (m0 < NPROMPT ? GIN(0) : GIN(1) - (size_t)NPROMPT * 1024) : GOUT;
      epi.xout = GOUT; epi.gate = lmods + (size_t)cond_of(m0) * 6144 + 2 * 1024;
      gemm_tile<4>(obuf, 1024, wmix + WM_OUT, 1024, 1024, m0, nt * 128, (u16*)smem, epi);
    }
    GSYNC();
    for (int it = bid; it < 5120; it += G) norm_rows(p, layer, false, it, GIN(11) + layer * 1024, 3, 4);
    GSYNC();
    {
      EpiMlpIn epi; epi.abuf = (u16*)(R + R_ABUF);
      for (int it = bid; it < 160 * 32; it += G) { const int mt = it >> 5, nt = it & 31; gemm_tile<4>(hbuf, 1024, wmlp, 1024, 1024, mt * 128, nt * 128, (u16*)smem, epi); }
    }
    GSYNC();
    for (int it = bid; it < 160 * 8; it += G) {
      const int mt = it >> 3, nt = it & 7; const int m0 = mt * 128;
      EpiResid epi; epi.xin = GOUT; epi.xout = GOUT; epi.gate = lmods + (size_t)cond_of(m0) * 6144 + 5 * 1024;
      gemm_tile<4>((const u16*)(R + R_ABUF), 4096, wmlp + 4194304, 4096, 4096, m0, nt * 128, (u16*)smem, epi);
    }
    GSYNC();
  }
}

extern "C" void kernel_launch(void* const* d_in, const int* in_sizes, int n_in, void* d_out, int out_size, void* d_ws, size_t ws_size, hipStream_t stream) {
  static int grid_blocks = 0;
  if (!grid_blocks) {
    int dev = 0, cus = 0, per_cu = 0;
    hipGetDevice(&dev);
    hipDeviceGetAttribute(&cus, hipDeviceAttributeMultiprocessorCount, dev);
    hipOccupancyMaxActiveBlocksPerMultiprocessor(&per_cu, fwd_megakernel, 256, 0);
    if (per_cu < 1) per_cu = 1;
    if (per_cu > 2) per_cu = 2;
    grid_blocks = cus * per_cu;
  }
  P p{};
  for (int i = 0; i < 36; ++i) p.in[i] = (const float*)d_in[i];
  p.out = (float*)d_out;
  p.ws = (char*)d_ws;
  (void)hipMemsetAsync((char*)d_ws + WS_BAR, 0, XCD_BAR_WORDS * 4, stream);
  void* args[] = {&p};
  hipError_t e = hipLaunchCooperativeKernel((void*)fwd_megakernel, dim3(grid_blocks), dim3(256), args, 0, stream);
  if (e != hipSuccess) fprintf(stderr, "cooperative launch failed: %s (grid %d)\n", hipGetErrorString(e), grid_blocks);
}
```

```cpp
#include <hip/hip_runtime.h>
#include <hip/hip_cooperative_groups.h>
#include <cstdio>
namespace cg = cooperative_groups;

typedef unsigned short u16;
typedef __attribute__((ext_vector_type(8))) short bf16x8;
typedef __attribute__((ext_vector_type(4))) short bf16x4;
typedef __attribute__((ext_vector_type(4))) float f32x4;
typedef __attribute__((ext_vector_type(4))) unsigned u32x4;
typedef __attribute__((ext_vector_type(2))) unsigned u32x2;

#define DI __device__ __forceinline__

constexpr int NTOK = 20480;
constexpr int NPROMPT = 4096;
constexpr float EPS = 1e-6f;

constexpr size_t WS_MODS = 0;
constexpr size_t MODS_BYTES = 4ull * 9 * 6144 * 4;
constexpr size_t WS_BAR = 917504;
constexpr size_t WS_ROPE = 1048576;
constexpr size_t WS_WMIX = 1114112;
constexpr size_t WS_WMLP = 14090240;
constexpr size_t WS_HBUF = 30867456;
constexpr size_t WS_OBUF = 72810496;
constexpr size_t WS_R    = 114753536;
constexpr size_t R_ABUF = 0;
constexpr size_t R_PROJ = 0;
constexpr size_t R_VBUF = 167772160;
constexpr size_t R_TBUF = 209715200;
constexpr size_t R_GBUF = 251658240;
constexpr size_t R_GCB  = 254279680;
constexpr size_t R_BETA = 255590400;
constexpr size_t R_EG   = 256901120;
constexpr size_t R_ED   = 258211840;
constexpr size_t R_DPROJ = 0;
constexpr size_t R_Q    = 0;
constexpr size_t R_CQ   = 62914560;
constexpr size_t R_CKV  = 78643200;
constexpr size_t R_KM   = 91226112;
constexpr size_t R_VTM  = 166723584;
constexpr size_t R_KG   = 41943040;
constexpr size_t R_VTG  = 54525952;
constexpr size_t WM_IN = 0;
constexpr size_t WM_OUT = 4325376;
constexpr size_t WM_UQ = 5373952;
constexpr size_t WM_UKV = 5963776;
constexpr size_t O_SF = 20971520, O_SB = 25165824, O_CKV = 29360128, O_KR = 30408704, O_GK = 30670848, O_GV = 31719424;

struct P {
  const float* in[36];
  float* out;
  char* ws;
};

typedef __attribute__((ext_vector_type(2))) float f32x2_t;
typedef __attribute__((ext_vector_type(2))) __bf16 bf16x2_t;
DI u16 f2bf(float x) { return __builtin_bit_cast(u16, (__bf16)x); }
DI float bf2f(u16 h) { return __uint_as_float(((unsigned)h) << 16); }
DI unsigned pack2(float a, float b) { f32x2_t v; v[0] = a; v[1] = b; return __builtin_bit_cast(unsigned, __builtin_convertvector(v, bf16x2_t)); }
DI float bflo(unsigned w) { return __uint_as_float(w << 16); }
DI float bfhi(unsigned w) { return __uint_as_float(w & 0xffff0000u); }
DI f32x4 mma(bf16x8 a, bf16x8 b, f32x4 c) { return __builtin_amdgcn_mfma_f32_16x16x32_bf16(a, b, c, 0, 0, 0); }
DI bf16x8 pack8(f32x4 a, f32x4 b) {
  u32x4 p; p[0] = pack2(a[0], a[1]); p[1] = pack2(a[2], a[3]); p[2] = pack2(b[0], b[1]); p[3] = pack2(b[2], b[3]);
  return __builtin_bit_cast(bf16x8, p);
}
DI bf16x8 ld8(const u16* p) { return *(const bf16x8*)p; }
DI bf16x8 ld44(const u16* p0, const u16* p1) {
  u32x2 a = *(const u32x2*)p0; u32x2 b = *(const u32x2*)p1;
  u32x4 r; r[0] = a[0]; r[1] = a[1]; r[2] = b[0]; r[3] = b[1];
  return __builtin_bit_cast(bf16x8, r);
}
DI void st4bf(u16* p, float a, float b, float c, float d) { u32x2 v; v[0] = pack2(a, b); v[1] = pack2(c, d); *(u32x2*)p = v; }
DI float wave_sum(float v) {
  v += __shfl_xor(v, 1); v += __shfl_xor(v, 2); v += __shfl_xor(v, 4); v += __shfl_xor(v, 8); v += __shfl_xor(v, 16); v += __shfl_xor(v, 32);
  return v;
}
DI float sum_g(float v) { v += __shfl_xor(v, 16); v += __shfl_xor(v, 32); return v; }
DI int opaque_tid() { int t = threadIdx.x; asm volatile("" : "+v"(t)); return t; }
DI int opaque_bid() { int t = __builtin_amdgcn_readfirstlane((int)blockIdx.x); asm volatile("" : "+s"(t)); return t; }
DI char* opaque_ptr(char* q) {
  unsigned lo = __builtin_amdgcn_readfirstlane((unsigned)(size_t)q), hi = __builtin_amdgcn_readfirstlane((unsigned)((size_t)q >> 32));
  asm volatile("" : "+s"(lo), "+s"(hi));
  typedef __attribute__((address_space(1))) char gchar_t;
  return (char*)(gchar_t*)(((size_t)hi << 32) | (size_t)lo);
}
template <class T> DI T* as_global(T* q) { typedef __attribute__((address_space(1))) T gT; return (T*)(gT*)q; }
#define GIN(i) as_global(p.in[i])
#define GOUT as_global(p.out)
DI int cond_of(int t) { return t < NPROMPT ? 0 : 1 + ((t - NPROMPT) >> 11); }
DI int kvrow_of_tok(int t) { return t < NPROMPT ? t : NPROMPT + ((t - NPROMPT) >> 11) * 2560 + 512 + ((t - NPROMPT) & 2047); }

template <int NI, class Epi>
DI void gemm_tile(const u16* __restrict__ A, int lda, const u16* __restrict__ Bt, int ldb, int K, int m0, int n0, u16* smem, Epi& epi) {
  constexpr int MI = 16 / NI;
  constexpr int WN = 8 / NI;
  const int tid = opaque_tid(), lane = tid & 63, wid = tid >> 6, l15 = lane & 15, g = lane >> 4;
  const int wm = wid / WN, wn = wid % WN;
  u16* sA = smem; u16* sB = smem + 128 * 64;
  f32x4 acc[MI][NI];
#pragma unroll
  for (int mi = 0; mi < MI; ++mi)
#pragma unroll
    for (int ni = 0; ni < NI; ++ni) { acc[mi][ni][0] = 0.f; acc[mi][ni][1] = 0.f; acc[mi][ni][2] = 0.f; acc[mi][ni][3] = 0.f; }
  const int lrow = tid >> 3, lkc = (tid & 7) * 8;
  const int wofs = lrow * 64 + (((tid & 7) ^ ((lrow >> 1) & 7)) * 8);
  const int rsw = (l15 >> 1) & 7;
  const int rofs0 = l15 * 64 + ((g ^ rsw) * 8), rofs1 = l15 * 64 + (((4 + g) ^ rsw) * 8);
  const u16* pa = A + (size_t)(m0 + lrow) * lda + lkc;
  const u16* pb = Bt + (size_t)(n0 + lrow) * ldb + lkc;
  u32x4 ra[2][4], rb[2][4];
  const int nk = K >> 6;
#pragma unroll
  for (int i = 0; i < 4; ++i) { ra[0][i] = *(const u32x4*)(pa + (size_t)i * 32 * lda); rb[0][i] = *(const u32x4*)(pb + (size_t)i * 32 * ldb); }
#pragma unroll
  for (int i = 0; i < 4; ++i) { ra[1][i] = *(const u32x4*)(pa + (size_t)i * 32 * lda + 64); rb[1][i] = *(const u32x4*)(pb + (size_t)i * 32 * ldb + 64); }
  for (int kt = 0; kt < nk; kt += 2) {
#pragma unroll
    for (int half = 0; half < 2; ++half) {
      __syncthreads();
#pragma unroll
      for (int i = 0; i < 4; ++i) { *(u32x4*)(sA + wofs + i * 32 * 64) = ra[half][i]; *(u32x4*)(sB + wofs + i * 32 * 64) = rb[half][i]; }
      __syncthreads();
      if (kt + half + 2 < nk) {
        const int ko = (kt + half + 2) * 64;
#pragma unroll
        for (int i = 0; i < 4; ++i) { ra[half][i] = *(const u32x4*)(pa + (size_t)i * 32 * lda + ko); rb[half][i] = *(const u32x4*)(pb + (size_t)i * 32 * ldb + ko); }
      }
#pragma unroll
      for (int ks = 0; ks < 2; ++ks) {
        const int ro = ks ? rofs1 : rofs0;
        bf16x8 af[MI], bfv[NI];
#pragma unroll
        for (int mi = 0; mi < MI; ++mi) af[mi] = ld8(sA + (wm * MI * 16 + mi * 16) * 64 + ro);
#pragma unroll
        for (int ni = 0; ni < NI; ++ni) bfv[ni] = ld8(sB + (wn * NI * 16 + ni * 16) * 64 + ro);
        __builtin_amdgcn_s_setprio(1);
#pragma unroll
        for (int mi = 0; mi < MI; ++mi)
#pragma unroll
          for (int ni = 0; ni < NI; ++ni) acc[mi][ni] = mma(bfv[ni], af[mi], acc[mi][ni]);
        __builtin_amdgcn_s_setprio(0);
      }
    }
  }
  epi.template run<MI, NI>(acc, m0 + wm * MI * 16, n0 + wn * NI * 16, l15, g);
}

struct EpiResid {
  const float* xin; float* xout; const float* gate;
  template <int MI, int NI> DI void run(f32x4 (&acc)[MI][NI], int mr, int nc, int l15, int g) {
#pragma unroll
    for (int mi = 0; mi < MI; ++mi)
#pragma unroll
      for (int ni = 0; ni < NI; ++ni) {
        const int m = mr + mi * 16 + l15, n = nc + ni * 16 + g * 4;
        const float4 xi = *(const float4*)(xin + (size_t)m * 1024 + n);
        const float4 gt = *(const float4*)(gate + n);
        float4 o; o.x = xi.x + gt.x * acc[mi][ni][0]; o.y = xi.y + gt.y * acc[mi][ni][1]; o.z = xi.z + gt.z * acc[mi][ni][2]; o.w = xi.w + gt.w * acc[mi][ni][3];
        *(float4*)(xout + (size_t)m * 1024 + n) = o;
      }
  }
};
struct EpiGdnIn {
  u16* proj; float* gbuf;
  template <int MI, int NI> DI void run(f32x4 (&acc)[MI][NI], int mr, int nc, int l15, int g) {
#pragma unroll
    for (int mi = 0; mi < MI; ++mi)
#pragma unroll
      for (int ni = 0; ni < NI; ++ni) {
        const int m = mr + mi * 16 + l15, n = nc + ni * 16 + g * 4;
        if (n < 4096) st4bf(proj + (size_t)m * 4096 + n, acc[mi][ni][0], acc[mi][ni][1], acc[mi][ni][2], acc[mi][ni][3]);
        else if (n < 4128) { float4 o; o.x = acc[mi][ni][0]; o.y = acc[mi][ni][1]; o.z = acc[mi][ni][2]; o.w = acc[mi][ni][3]; *(float4*)(gbuf + (size_t)m * 32 + (n - 4096)) = o; }
      }
  }
};
struct EpiMlpIn {
  u16* abuf;
  template <int MI, int NI> DI void run(f32x4 (&acc)[MI][NI], int mr, int nc, int l15, int g) {
#pragma unroll
    for (int mi = 0; mi < MI; ++mi)
#pragma unroll
      for (int ni = 0; ni < NI; ++ni) {
        const int m = mr + mi * 16 + l15, n = nc + ni * 16 + g * 4;
        float a = fmaxf(acc[mi][ni][0], 0.f), b = fmaxf(acc[mi][ni][1], 0.f), c = fmaxf(acc[mi][ni][2], 0.f), d = fmaxf(acc[mi][ni][3], 0.f);
        st4bf(abuf + (size_t)m * 4096 + n, a * a, b * b, c * c, d * d);
      }
  }
};
struct EpiF32 {
  float* dst; int ld;
  template <int MI, int NI> DI void run(f32x4 (&acc)[MI][NI], int mr, int nc, int l15, int g) {
#pragma unroll
    for (int mi = 0; mi < MI; ++mi)
#pragma unroll
      for (int ni = 0; ni < NI; ++ni) {
        const int m = mr + mi * 16 + l15, n = nc + ni * 16 + g * 4;
        float4 o; o.x = acc[mi][ni][0]; o.y = acc[mi][ni][1]; o.z = acc[mi][ni][2]; o.w = acc[mi][ni][3];
        *(float4*)(dst + (size_t)m * ld + n) = o;
      }
  }
};

DI void rope128(f32x4 (&v)[8], int rowp, int colp, int g, const float* cosT, const float* sinT) {
#pragma unroll
  for (int hf = 0; hf < 2; ++hf) {
    const int pos = hf ? colp : rowp;
#pragma unroll
    for (int a = 0; a < 2; ++a) {
      const int n1 = hf * 4 + a, n2 = n1 + 2;
      const float4 cs = *(const float4*)(cosT + pos * 32 + a * 16 + g * 4);
      const float4 sn = *(const float4*)(sinT + pos * 32 + a * 16 + g * 4);
      const float c4[4] = {cs.x, cs.y, cs.z, cs.w}, s4[4] = {sn.x, sn.y, sn.z, sn.w};
#pragma unroll
      for (int j = 0; j < 4; ++j) { const float x1 = v[n1][j], x2 = v[n2][j]; v[n1][j] = x1 * c4[j] - x2 * s4[j]; v[n2][j] = x1 * s4[j] + x2 * c4[j]; }
    }
  }
}
DI void rope64(f32x4* v, int rowp, int colp, int g, const float* cosT, const float* sinT) {
#pragma unroll
  for (int hf = 0; hf < 2; ++hf) {
    const int pos = hf ? colp : rowp;
    const int n1 = hf * 2, n2 = n1 + 1;
    const float4 cs = *(const float4*)(cosT + pos * 16 + g * 4);
    const float4 sn = *(const float4*)(sinT + pos * 16 + g * 4);
    const float c4[4] = {cs.x, cs.y, cs.z, cs.w}, s4[4] = {sn.x, sn.y, sn.z, sn.w};
#pragma unroll
    for (int j = 0; j < 4; ++j) { const float x1 = v[n1][j], x2 = v[n2][j]; v[n1][j] = x1 * c4[j] - x2 * s4[j]; v[n2][j] = x1 * s4[j] + x2 * c4[j]; }
  }
}

struct EpiGqaIn {
  u16* Q; u16* Kb; u16* Vt; const float* qg; const float* kg; const float* cosT; const float* sinT; float* out;
  template <int MI, int NI> DI void run(f32x4 (&acc)[MI][NI], int mr, int nc, int l15, int g) {
    const int nt = nc >> 7;
#pragma unroll
    for (int mi = 0; mi < MI; ++mi) {
      const int m = mr + mi * 16 + l15;
      const bool prompt = m < NPROMPT;
      const int s = prompt ? (m & 255) : ((m - NPROMPT) & 2047);
      const int rowp = s >> 6, colp = s & 63;
      const int kvrow = kvrow_of_tok(m);
      if (nt < 10) {
        float ss = 0.f;
#pragma unroll
        for (int ni = 0; ni < NI; ++ni)
#pragma unroll
          for (int j = 0; j < 4; ++j) ss += acc[mi][ni][j] * acc[mi][ni][j];
        ss = sum_g(ss);
        const float rs = rsqrtf(ss * (1.f / 128.f) + EPS);
        const float* gn = nt < 8 ? qg : kg;
#pragma unroll
        for (int ni = 0; ni < NI; ++ni) {
          const float4 gv = *(const float4*)(gn + ni * 16 + g * 4);
          acc[mi][ni][0] *= rs * gv.x; acc[mi][ni][1] *= rs * gv.y; acc[mi][ni][2] *= rs * gv.z; acc[mi][ni][3] *= rs * gv.w;
        }
        if (nt >= 8 && prompt) {
#pragma unroll
          for (int ni = 0; ni < NI; ++ni) { float4 o; o.x = acc[mi][ni][0]; o.y = acc[mi][ni][1]; o.z = acc[mi][ni][2]; o.w = acc[mi][ni][3]; *(float4*)(out + O_GK + (size_t)m * 256 + (nt - 8) * 128 + ni * 16 + g * 4) = o; }
        }
        if (!prompt) rope128(acc[mi], rowp, colp, g, cosT, sinT);
        u16* dst = nt < 8 ? Q + (size_t)m * 1024 + nt * 128 : Kb + (size_t)kvrow * 256 + (nt - 8) * 128;
#pragma unroll
        for (int ni = 0; ni < NI; ++ni) st4bf(dst + ni * 16 + g * 4, acc[mi][ni][0], acc[mi][ni][1], acc[mi][ni][2], acc[mi][ni][3]);
      } else {
        const int kvh = nt - 10;
        if (prompt) {
#pragma unroll
          for (int ni = 0; ni < NI; ++ni) { float4 o; o.x = acc[mi][ni][0]; o.y = acc[mi][ni][1]; o.z = acc[mi][ni][2]; o.w = acc[mi][ni][3]; *(float4*)(out + O_GV + (size_t)m * 256 + kvh * 128 + ni * 16 + g * 4) = o; }
        }
        size_t base; int kvlen, pos;
        if (prompt) { base = (size_t)(m >> 8) * 256 * 256; kvlen = 256; pos = m & 255; }
        else { const int b = (m - NPROMPT) >> 11; base = (size_t)(NPROMPT + b * 2560) * 256; kvlen = 2560; pos = 512 + s; }
#pragma unroll
        for (int ni = 0; ni < NI; ++ni)
#pragma unroll
          for (int j = 0; j < 4; ++j) Vt[base + (size_t)(kvh * 128 + ni * 16 + g * 4 + j) * kvlen + pos] = f2bf(acc[mi][ni][j]);
      }
    }
  }
};
struct EpiMlaUq {
  u16* Q; const float* gnope; const float* grope; const float* cosT; const float* sinT;
  template <int MI, int NI> DI void run(f32x4 (&acc)[MI][NI], int mr, int nc, int l15, int g) {
    const int nt = nc >> 7;
#pragma unroll
    for (int mi = 0; mi < MI; ++mi) {
      const int m = mr + mi * 16 + l15;
      const bool prompt = m < NPROMPT;
      const int s = prompt ? (m & 255) : ((m - NPROMPT) & 2047);
      const int rowp = s >> 6, colp = s & 63;
      if (nt < 8) {
        float ss = 0.f;
#pragma unroll
        for (int ni = 0; ni < NI; ++ni)
#pragma unroll
          for (int j = 0; j < 4; ++j) ss += acc[mi][ni][j] * acc[mi][ni][j];
        ss = sum_g(ss);
        const float rs = rsqrtf(ss * (1.f / 128.f) + EPS);
#pragma unroll
        for (int ni = 0; ni < NI; ++ni) {
          const float4 gv = *(const float4*)(gnope + ni * 16 + g * 4);
          st4bf(Q + (size_t)m * 1536 + nt * 192 + ni * 16 + g * 4, acc[mi][ni][0] * rs * gv.x, acc[mi][ni][1] * rs * gv.y, acc[mi][ni][2] * rs * gv.z, acc[mi][ni][3] * rs * gv.w);
        }
      } else {
#pragma unroll
        for (int hh = 0; hh < 2; ++hh) {
          const int h = (nt - 8) * 2 + hh;
          float ss = 0.f;
#pragma unroll
          for (int ni = 0; ni < 4; ++ni)
#pragma unroll
            for (int j = 0; j < 4; ++j) ss += acc[mi][hh * 4 + ni][j] * acc[mi][hh * 4 + ni][j];
          ss = sum_g(ss);
          const float rs = rsqrtf(ss * (1.f / 64.f) + EPS);
#pragma unroll
          for (int ni = 0; ni < 4; ++ni) {
            const float4 gv = *(const float4*)(grope + ni * 16 + g * 4);
            acc[mi][hh * 4 + ni][0] *= rs * gv.x; acc[mi][hh * 4 + ni][1] *= rs * gv.y; acc[mi][hh * 4 + ni][2] *= rs * gv.z; acc[mi][hh * 4 + ni][3] *= rs * gv.w;
          }
          if (!prompt) rope64(&acc[mi][hh * 4], rowp, colp, g, cosT, sinT);
#pragma unroll
          for (int ni = 0; ni < 4; ++ni)
            st4bf(Q + (size_t)m * 1536 + h * 192 + 128 + ni * 16 + g * 4, acc[mi][hh * 4 + ni][0], acc[mi][hh * 4 + ni][1], acc[mi][hh * 4 + ni][2], acc[mi][hh * 4 + ni][3]);
        }
      }
    }
  }
};
struct EpiMlaUkv {
  u16* Kb; u16* Vt; const float* gnope;
  template <int MI, int NI> DI void run(f32x4 (&acc)[MI][NI], int mr, int nc, int l15, int g) {
    const int nt = nc >> 7, h = nt >> 1;
#pragma unroll
    for (int mi = 0; mi < MI; ++mi) {
      const int m = mr + mi * 16 + l15;
      if ((nt & 1) == 0) {
        float ss = 0.f;
#pragma unroll
        for (int ni = 0; ni < NI; ++ni)
#pragma unroll
          for (int j = 0; j < 4; ++j) ss += acc[mi][ni][j] * acc[mi][ni][j];
        ss = sum_g(ss);
        const float rs = rsqrtf(ss * (1.f / 128.f) + EPS);
#pragma unroll
        for (int ni = 0; ni < NI; ++ni) {
          const float4 gv = *(const float4*)(gnope + ni * 16 + g * 4);
          st4bf(Kb + (size_t)m * 1536 + h * 192 + ni * 16 + g * 4, acc[mi][ni][0] * rs * gv.x, acc[mi][ni][1] * rs * gv.y, acc[mi][ni][2] * rs * gv.z, acc[mi][ni][3] * rs * gv.w);
        }
      } else {
        size_t base; int kvlen, pos;
        if (m < NPROMPT) { base = (size_t)(m >> 8) * 256 * 1024; kvlen = 256; pos = m & 255; }
        else { const int r = m - NPROMPT; const int b = r / 2560; base = (size_t)(NPROMPT + b * 2560) * 1024; kvlen = 2560; pos = r - b * 2560; }
#pragma unroll
        for (int ni = 0; ni < NI; ++ni)
#pragma unroll
          for (int j = 0; j < 4; ++j) Vt[base + (size_t)(h * 128 + ni * 16 + g * 4 + j) * kvlen + pos] = f2bf(acc[mi][ni][j]);
      }
    }
  }
};

DI void convert_tile(const float* __restrict__ W, int K, int N, u16* __restrict__ Bt, int tile, int perm, float* sT) {
  const int nkt = K >> 6;
  const int kt = tile % nkt, nt = tile / nkt;
  const int k0 = kt * 64, n0 = nt * 64;
  const int tid = opaque_tid();
  __syncthreads();
  {
    const int n = tid & 63, kq = tid >> 6;
    int nd = n0 + n, ns = nd;
    if (perm == 1) { if (nd < 1024) ns = (nd >> 7) * 192 + (nd & 127); else { const int x = nd - 1024; ns = (x >> 6) * 192 + 128 + (x & 63); } }
    const bool ok = nd < N;
#pragma unroll
    for (int r = 0; r < 16; ++r) { const int k = r * 4 + kq; sT[k * 65 + n] = ok ? W[(size_t)(k0 + k) * N + ns] : 0.f; }
  }
  __syncthreads();
  {
    const int n = tid >> 2, kq = (tid & 3) * 16;
    u32x4 a, b;
#pragma unroll
    for (int e = 0; e < 4; ++e) { a[e] = pack2(sT[(kq + 2 * e) * 65 + n], sT[(kq + 2 * e + 1) * 65 + n]); b[e] = pack2(sT[(kq + 8 + 2 * e) * 65 + n], sT[(kq + 9 + 2 * e) * 65 + n]); }
    u16* dst = Bt + (size_t)(n0 + n) * K + k0 + kq;
    *(u32x4*)dst = a; *(u32x4*)(dst + 8) = b;
  }
}

DI void norm_rows(const P& p, int layer, bool from_input, int item, const float* gnorm, int shift_idx, int scale_idx) {
  const int tidn = opaque_tid();
  char* const ws = opaque_ptr(as_global(p.ws));
  const int lane = tidn & 63, wid = tidn >> 6;
  const int t = item * 4 + wid;
  const float* x = from_input ? (t < NPROMPT ? GIN(0) + (size_t)t * 1024 : GIN(1) + (size_t)(t - NPROMPT) * 1024) : GOUT + (size_t)t * 1024;
  const float* mods = (const float*)(ws + WS_MODS) + ((size_t)layer * 9 + cond_of(t)) * 6144;
  u16* h = (u16*)(ws + WS_HBUF) + (size_t)t * 1024;
  float4 v[4]; float ss = 0.f;
#pragma unroll
  for (int e = 0; e < 4; ++e) { v[e] = *(const float4*)(x + e * 256 + lane * 4); ss += v[e].x * v[e].x + v[e].y * v[e].y + v[e].z * v[e].z + v[e].w * v[e].w; }
  ss = wave_sum(ss);
  const float rs = rsqrtf(ss * (1.f / 1024.f) + EPS);
#pragma unroll
  for (int e = 0; e < 4; ++e) {
    const int c = e * 256 + lane * 4;
    const float4 gv = *(const float4*)(gnorm + c);
    const float4 sc = *(const float4*)(mods + scale_idx * 1024 + c);
    const float4 sh = *(const float4*)(mods + shift_idx * 1024 + c);
    st4bf(h + c, v[e].x * rs * gv.x * (1.f + sc.x) + sh.x, v[e].y * rs * gv.y * (1.f + sc.y) + sh.y, v[e].z * rs * gv.z * (1.f + sc.z) + sh.z, v[e].w * rs * gv.w * (1.f + sc.w) + sh.w);
  }
}

template <int DK, int HK>
DI void attn_phase(const u16* __restrict__ Q, const u16* __restrict__ Kb, const u16* __restrict__ Vt, u16* __restrict__ obuf, char* smem_raw) {
  const int bid = opaque_bid();
  constexpr int KS = DK / 32, KSTR = DK, QSTR = 8 * DK, KROW = HK * DK, GRP = 8 / HK;
  constexpr int CPR = DK / 8;
  constexpr int KCH = 64 * CPR / 256;
  u16* sK = (u16*)smem_raw;
  u16* sV = sK + 64 * KSTR;
  const int tid = opaque_tid(), lane = tid & 63, wid = tid >> 6, l15 = lane & 15, g = lane >> 4;
  const float sc = rsqrtf((float)DK) * 1.4426950408889634f;
  for (int item = bid; item < 1280; item += gridDim.x) {
    int qb, h, kvlen, tokbase, kvbase;
    if (item < 1024) { const int b = item >> 7, rem = item & 127; h = rem & 7; qb = rem >> 3; kvlen = 2560; tokbase = NPROMPT + b * 2048; kvbase = NPROMPT + b * 2560; }
    else { const int it2 = item - 1024; const int b = it2 >> 4, rem = it2 & 15; h = rem & 7; qb = rem >> 3; kvlen = 256; tokbase = b * 256; kvbase = b * 256; }
    const int kvh = h / GRP;
    const u16* Kp = Kb + (size_t)kvbase * KROW + kvh * DK;
    const u16* Vp = Vt + (size_t)kvbase * (HK * 128) + (size_t)kvh * 128 * kvlen;
    const int qrow0 = tokbase + qb * 128 + wid * 32;
    bf16x8 qf[2][KS];
#pragma unroll
    for (int qi = 0; qi < 2; ++qi)
#pragma unroll
      for (int ks = 0; ks < KS; ++ks) qf[qi][ks] = ld8(Q + (size_t)(qrow0 + qi * 16 + l15) * QSTR + h * DK + ks * 32 + g * 8);
    f32x4 ot[2][8];
#pragma unroll
    for (int qi = 0; qi < 2; ++qi)
#pragma unroll
      for (int dj = 0; dj < 8; ++dj) { ot[qi][dj][0] = 0.f; ot[qi][dj][1] = 0.f; ot[qi][dj][2] = 0.f; ot[qi][dj][3] = 0.f; }
    float mrun[2] = {-1e30f, -1e30f}, lrun[2] = {0.f, 0.f};
    const int ntiles = kvlen >> 6;
    const unsigned toffK = (unsigned)((tid >> 3) * KROW + (tid & 7) * 8), toffV = (unsigned)((tid >> 3) * kvlen + (tid & 7) * 8);
    const int kx = tid >> 3;
    const int kperm = ((kx >> 2) & 1) * 16 + (kx >> 3) * 4 + (kx & 3);
    const int kswz = (CPR == 16) ? (kperm & 15) : ((kperm >> 1) & 7);
    const int ldsoffK = kperm * KSTR;
    const int ldsoffV = (tid >> 3) * 64 + (((tid & 7) ^ (((tid >> 3) >> 1) & 7)) * 8);
    u32x4 rk[KCH], rv[4];
#pragma unroll
    for (int i = 0; i < KCH; ++i) { const int rh = i & 1, cgp = i >> 1; rk[i] = *(const u32x4*)(Kp + (size_t)(rh * 32 * KROW + cgp * 64) + toffK); }
#pragma unroll
    for (int i = 0; i < 4; ++i) rv[i] = *(const u32x4*)(Vp + (size_t)i * 32 * kvlen + toffV);
    for (int kt = 0; kt < ntiles; ++kt) {
      const u16* Kt = Kp + (size_t)(kt + 1) * 64 * KROW;
      const u16* Vtp = Vp + (kt + 1) * 64;
      const bool more = kt + 1 < ntiles;
      __syncthreads();
#pragma unroll
      for (int i = 0; i < KCH; ++i) { const int rh = i & 1, cgp = i >> 1; const int c = (tid & 7) + 8 * cgp; const int pos = (CPR == 16) ? (c ^ kswz) : ((c & ~7) | ((c & 7) ^ kswz)); *(u32x4*)(sK + ldsoffK + rh * 32 * KSTR + pos * 8) = rk[i]; }
#pragma unroll
      for (int i = 0; i < 4; ++i) *(u32x4*)(sV + ldsoffV + i * 32 * 64) = rv[i];
      __syncthreads();
      if (more) {
#pragma unroll
        for (int i = 0; i < KCH; ++i) { const int rh = i & 1, cgp = i >> 1; rk[i] = *(const u32x4*)(Kt + (size_t)(rh * 32 * KROW + cgp * 64) + toffK); }
      }
      __builtin_amdgcn_sched_barrier(0);
      f32x4 st[2][4];
#pragma unroll
      for (int qi = 0; qi < 2; ++qi)
#pragma unroll
        for (int kj = 0; kj < 4; ++kj) { st[qi][kj][0] = 0.f; st[qi][kj][1] = 0.f; st[qi][kj][2] = 0.f; st[qi][kj][3] = 0.f; }
#pragma unroll
      for (int ks = 0; ks < KS; ++ks) {
#pragma unroll
        for (int kj = 0; kj < 4; ++kj) {
          const int kc = ks * 4 + g;
          const int kpos = (CPR == 16) ? (kc ^ l15) : ((kc & ~7) | ((kc & 7) ^ ((l15 >> 1) & 7)));
          const bf16x8 ka = ld8(sK + (kj * 16 + l15) * KSTR + kpos * 8);
          __builtin_amdgcn_s_setprio(1);
          st[0][kj] = mma(ka, qf[0][ks], st[0][kj]);
          st[1][kj] = mma(ka, qf[1][ks], st[1][kj]);
          __builtin_amdgcn_s_setprio(0);
        }
        __builtin_amdgcn_sched_barrier(0);
      }
      bf16x8 pf[2][2];
#pragma unroll
      for (int qi = 0; qi < 2; ++qi) {
        float mx = -1e30f;
#pragma unroll
        for (int kj = 0; kj < 4; ++kj)
#pragma unroll
          for (int r = 0; r < 4; ++r) mx = fmaxf(mx, st[qi][kj][r]);
        mx = fmaxf(mx, __shfl_xor(mx, 16)); mx = fmaxf(mx, __shfl_xor(mx, 32));
        const float mnew = fmaxf(mrun[qi], mx);
        const float alpha = __builtin_amdgcn_exp2f((mrun[qi] - mnew) * sc);
        mrun[qi] = mnew;
        float ps = 0.f;
        const float mneg = -mnew * sc;
#pragma unroll
        for (int kj = 0; kj < 4; ++kj)
#pragma unroll
          for (int r = 0; r < 4; ++r) { const float pv = __builtin_amdgcn_exp2f(fmaf(st[qi][kj][r], sc, mneg)); st[qi][kj][r] = pv; ps += pv; }
        lrun[qi] = lrun[qi] * alpha + ps;
#pragma unroll
        for (int dj = 0; dj < 8; ++dj) { ot[qi][dj][0] *= alpha; ot[qi][dj][1] *= alpha; ot[qi][dj][2] *= alpha; ot[qi][dj][3] *= alpha; }
        pf[qi][0] = pack8(st[qi][0], st[qi][1]);
        pf[qi][1] = pack8(st[qi][2], st[qi][3]);
        __builtin_amdgcn_sched_barrier(0);
      }
      if (more) {
#pragma unroll
        for (int i = 0; i < 4; ++i) rv[i] = *(const u32x4*)(Vtp + (size_t)i * 32 * kvlen + toffV);
      }
      __builtin_amdgcn_sched_barrier(0);
#pragma unroll
      for (int kk = 0; kk < 2; ++kk)
#pragma unroll
        for (int dj = 0; dj < 8; ++dj) {
          const bf16x8 va = ld8(sV + (dj * 16 + l15) * 64 + (((kk * 4 + g) ^ ((l15 >> 1) & 7)) * 8));
          __builtin_amdgcn_s_setprio(1);
          ot[0][dj] = mma(va, pf[0][kk], ot[0][dj]);
          ot[1][dj] = mma(va, pf[1][kk], ot[1][dj]);
          __builtin_amdgcn_s_setprio(0);
          if ((dj & 3) == 3) __builtin_amdgcn_sched_barrier(0);
        }
    }
#pragma unroll
    for (int qi = 0; qi < 2; ++qi) {
      const float inv = 1.f / sum_g(lrun[qi]);
      u16* dst = obuf + (size_t)(qrow0 + qi * 16 + l15) * 1024 + h * 128 + g * 4;
#pragma unroll
      for (int dj = 0; dj < 8; ++dj) st4bf(dst + dj * 16, ot[qi][dj][0] * inv, ot[qi][dj][1] * inv, ot[qi][dj][2] * inv, ot[qi][dj][3] * inv);
    }
  }
}

DI void gdn_chunk_phase(const P& p, int j, char* smem_raw) {
  const int bid = opaque_bid();
  char* const ws = opaque_ptr(as_global(p.ws));
  u16* sK = (u16*)smem_raw;
  float* sA = (float*)(smem_raw + 17408);
  float* sG = (float*)(smem_raw + 17408 + 32768);
  float* sBt = sG + 128;
  const int tid = opaque_tid(), lane = tid & 63, wid = tid >> 6, l15 = lane & 15, g = lane >> 4;
  const u16* proj = (const u16*)(ws + WS_R + R_PROJ);
  u16* qn = (u16*)(ws + WS_HBUF); u16* kn = (u16*)(ws + WS_OBUF); u16* vb = (u16*)(ws + WS_R + R_VBUF);
  u16* Tbuf = (u16*)(ws + WS_R + R_TBUF);
  const float* gbuf = (const float*)(ws + WS_R + R_GBUF);
  float* gcb = (float*)(ws + WS_R + R_GCB); float* betab = (float*)(ws + WS_R + R_BETA);
  float* egb = (float*)(ws + WS_R + R_EG); float* edb = (float*)(ws + WS_R + R_ED);
  const float* conv = GIN(17) + (size_t)j * 3 * 3072;
  const float* a_log = GIN(18) + j * 16; const float* dt_bias = GIN(19) + j * 16;
  for (int unit = bid; unit < 2560; unit += gridDim.x) {
    const int cgi = unit >> 3, h = unit & 7;
    int c, nch; if (cgi < 64) { c = cgi & 3; nch = 4; } else { c = (cgi - 64) & 31; nch = 32; }
    const int t0 = cgi * 64;
    const bool has_prev = c > 0, has_next = c < nch - 1;
    __syncthreads();
    {
      const int r = tid >> 4, cc = (tid & 15) * 8;
#pragma unroll
      for (int part = 0; part < 3; ++part) {
        const int ch = part * 1024 + h * 128 + cc;
        float w0[8], w1[8], w2[8];
#pragma unroll
        for (int e = 0; e < 8; ++e) { w0[e] = conv[ch + e]; w1[e] = conv[3072 + ch + e]; w2[e] = conv[6144 + ch + e]; }
        u16* dstb = part == 0 ? qn : (part == 1 ? kn : vb);
        for (int it = 0; it < 4; ++it) {
          const int i = it * 16 + r, t = t0 + i;
          const u16* src = proj + (size_t)t * 4096 + ch;
          const u32x4 xc = *(const u32x4*)src;
          u32x4 xp = {0u, 0u, 0u, 0u}, xn = {0u, 0u, 0u, 0u};
          if (i > 0 || has_prev) xp = *(const u32x4*)(src - 4096);
          if (i < 63 || has_next) xn = *(const u32x4*)(src + 4096);
          float y[8];
#pragma unroll
          for (int e = 0; e < 4; ++e) {
            float a = w0[2 * e] * bflo(xp[e]) + w1[2 * e] * bflo(xc[e]) + w2[2 * e] * bflo(xn[e]);
            float b = w0[2 * e + 1] * bfhi(xp[e]) + w1[2 * e + 1] * bfhi(xc[e]) + w2[2 * e + 1] * bfhi(xn[e]);
            y[2 * e] = a / (1.f + __expf(-a)); y[2 * e + 1] = b / (1.f + __expf(-b));
          }
          if (part < 2) {
            float ss = 0.f;
#pragma unroll
            for (int e = 0; e < 8; ++e) ss += y[e] * y[e];
            ss += __shfl_xor(ss, 1); ss += __shfl_xor(ss, 2); ss += __shfl_xor(ss, 4); ss += __shfl_xor(ss, 8);
            const float rs = rsqrtf(ss + EPS) * (part == 0 ? 0.08838834764831845f : 1.f);
#pragma unroll
            for (int e = 0; e < 8; ++e) y[e] *= rs;
          }
          u32x4 o; o[0] = pack2(y[0], y[1]); o[1] = pack2(y[2], y[3]); o[2] = pack2(y[4], y[5]); o[3] = pack2(y[6], y[7]);
          *(u32x4*)(dstb + (size_t)t * 1024 + h * 128 + cc) = o;
          if (part == 1) *(u32x4*)(sK + i * 136 + cc) = o;
        }
      }
    }
    if (tid < 128) {
      const int dir = tid >> 6, L = tid & 63;
      const int i = dir ? 63 - L : L;
      const float* gb = gbuf + (size_t)(t0 + i) * 32;
      const float gin = gb[dir * 8 + h], bin = gb[16 + dir * 8 + h];
      const float x = gin + dt_bias[dir * 8 + h];
      const float sp = fmaxf(x, 0.f) + log1pf(expf(-fabsf(x)));
      float gv = -expf(a_log[dir * 8 + h]) * sp;
      const float bt = 1.f / (1.f + expf(-bin));
#pragma unroll
      for (int off = 1; off < 64; off <<= 1) { const float v = __shfl_up(gv, off); if (L >= off) gv += v; }
      sG[dir * 64 + i] = gv; sBt[dir * 64 + i] = bt;
      gcb[((size_t)(t0 + i) * 8 + h) * 2 + dir] = gv; betab[((size_t)(t0 + i) * 8 + h) * 2 + dir] = bt;
      { const float gtot = __shfl(gv, 63); egb[((size_t)(t0 + i) * 8 + h) * 2 + dir] = expf(gv); edb[((size_t)(t0 + i) * 8 + h) * 2 + dir] = expf(gtot - gv); }
    }
    __syncthreads();
    {
      f32x4 ga[4];
#pragma unroll
      for (int mt = 0; mt < 4; ++mt) { ga[mt][0] = 0.f; ga[mt][1] = 0.f; ga[mt][2] = 0.f; ga[mt][3] = 0.f; }
#pragma unroll
      for (int ks = 0; ks < 4; ++ks) {
        const bf16x8 a = ld8(sK + (wid * 16 + l15) * 136 + ks * 32 + g * 8);
#pragma unroll
        for (int mt = 0; mt < 4; ++mt) { const bf16x8 b = ld8(sK + (mt * 16 + l15) * 136 + ks * 32 + g * 8); ga[mt] = mma(a, b, ga[mt]); }
      }
#pragma unroll
      for (int dir = 0; dir < 2; ++dir)
#pragma unroll
        for (int mt = 0; mt < 4; ++mt)
#pragma unroll
          for (int r = 0; r < 4; ++r) {
            const int i = wid * 16 + g * 4 + r, m = mt * 16 + l15;
            const bool valid = dir ? (i < m) : (i > m);
            const float val = valid ? sBt[dir * 64 + i] * ga[mt][r] * __expf(sG[dir * 64 + i] - sG[dir * 64 + m]) : 0.f;
            const int ii = dir ? 63 - i : i, mm = dir ? 63 - m : m;
            sA[dir * 4096 + ii * 64 + mm] = val;
          }
    }
    __syncthreads();
    if (wid < 2) {
      const int dir = wid;
      float* Am = sA + dir * 4096;
      for (int i = 0; i < 64; ++i) {
        float a = (i == lane) ? 1.f : 0.f;
        int m = 0;
        for (; m + 8 <= i; m += 8) {
          const float4 a0 = *(const float4*)(Am + i * 64 + m), a1 = *(const float4*)(Am + i * 64 + m + 4);
          float tv[8];
#pragma unroll
          for (int e = 0; e < 8; ++e) tv[e] = Am[(m + e) * 64 + lane];
          a -= a0.x * tv[0]; a -= a0.y * tv[1]; a -= a0.z * tv[2]; a -= a0.w * tv[3];
          a -= a1.x * tv[4]; a -= a1.y * tv[5]; a -= a1.z * tv[6]; a -= a1.w * tv[7];
        }
        for (; m < i; ++m) a -= Am[i * 64 + m] * Am[m * 64 + lane];
        Am[i * 64 + lane] = a;
      }
      const int mn = dir ? 63 - lane : lane;
      const float bm = sBt[dir * 64 + mn];
      u16* Td = Tbuf + ((size_t)unit * 2 + dir) * 4096;
#pragma unroll 4
      for (int i = 0; i < 64; ++i) { const int in_ = dir ? 63 - i : i; Td[in_ * 64 + mn] = f2bf(Am[i * 64 + lane] * bm); }
    }
  }
}

DI void gdn_scan_phase(const P& p, int j, char* smem_raw) {
  const int bid = opaque_bid();
  char* const ws = opaque_ptr(as_global(p.ws));
  u16* sK = (u16*)smem_raw;
  u16* sKT = sK + 64 * 136;
  u16* sVT = sKT + 128 * 72;
  u16* sST = sVT + 32 * 72;
  u16* sVN = sST + 32 * 136;
  u16* sVD = sVN + 32 * 72;
  float* sGc = (float*)(sVD + 32 * 72);
  float* sE = sGc + 64;
  float* sD = sE + 64;
  const int tid = opaque_tid(), lane = tid & 63, w = tid >> 6, l15 = lane & 15, g = lane >> 4;
  const u16* qn = (const u16*)(ws + WS_HBUF); const u16* kn = (const u16*)(ws + WS_OBUF); const u16* vb = (const u16*)(ws + WS_R + R_VBUF);
  const u16* Tbuf = (const u16*)(ws + WS_R + R_TBUF);
  const float* gcb = (const float*)(ws + WS_R + R_GCB);
  const float* egb = (const float*)(ws + WS_R + R_EG); const float* edb = (const float*)(ws + WS_R + R_ED);
  u16* obase = (u16*)(ws + WS_R + R_PROJ);
  for (int wk = bid; wk < 1536; wk += gridDim.x) {
    int seq, rem;
    if (wk < 512) { seq = 16 + (wk >> 6); rem = wk & 63; } else { seq = (wk - 512) >> 6; rem = (wk - 512) & 63; }
    const int h = rem & 7, dir = (rem >> 5) & 1, dvq = (rem >> 3) & 3;
    const int nch = seq < 16 ? 4 : 32;
    const int cgb = seq < 16 ? seq * 4 : 64 + (seq - 16) * 32;
    f32x4 S[2][2];
    if (seq >= 16) {
      const float* s0 = GIN(2 + dir) + (((size_t)(seq - 16) * 2 + j) * 8 + h) * 16384;
#pragma unroll
      for (int dt = 0; dt < 2; ++dt)
#pragma unroll
        for (int et = 0; et < 2; ++et)
#pragma unroll
          for (int r = 0; r < 4; ++r) S[dt][et][r] = s0[(size_t)(w * 32 + dt * 16 + g * 4 + r) * 128 + dvq * 32 + et * 16 + l15];
    } else {
#pragma unroll
      for (int dt = 0; dt < 2; ++dt)
#pragma unroll
        for (int et = 0; et < 2; ++et) { S[dt][et][0] = 0.f; S[dt][et][1] = 0.f; S[dt][et][2] = 0.f; S[dt][et][3] = 0.f; }
    }
    __syncthreads();
#pragma unroll
    for (int dt = 0; dt < 2; ++dt)
#pragma unroll
      for (int et = 0; et < 2; ++et) st4bf(sST + (et * 16 + l15) * 136 + w * 32 + dt * 16 + g * 4, S[dt][et][0], S[dt][et][1], S[dt][et][2], S[dt][et][3]);
    u32x4 pk[4], pv; bf16x8 pt[2]; float pg = 0.f, pe = 0.f, pd = 0.f;
#define SCAN_PREFETCH(cc) do { \
      const int t0n_ = (cgb + (cc)) * 64; const int unitn_ = (cgb + (cc)) * 8 + h; \
      _Pragma("unroll") for (int i = 0; i < 4; ++i) { const int row = tid & 63, dc = ((tid >> 6) + 4 * i) * 8; pk[i] = *(const u32x4*)(kn + (size_t)(t0n_ + row) * 1024 + h * 128 + dc); } \
      { const int row = tid & 63, ec = (tid >> 6) * 8; pv = *(const u32x4*)(vb + (size_t)(t0n_ + row) * 1024 + h * 128 + dvq * 32 + ec); } \
      if (tid < 64) { const size_t gi_ = ((size_t)(t0n_ + tid) * 8 + h) * 2 + dir; pg = gcb[gi_]; pe = egb[gi_]; pd = edb[gi_]; } \
      _Pragma("unroll") for (int ks = 0; ks < 2; ++ks) pt[ks] = ld8(Tbuf + ((size_t)unitn_ * 2 + dir) * 4096 + (w * 16 + l15) * 64 + ks * 32 + g * 8); \
    } while (0)
    SCAN_PREFETCH(dir ? nch - 1 : 0);
    for (int step = 0; step < nch; ++step) {
      const int c = dir ? nch - 1 - step : step;
      const int t0 = (cgb + c) * 64;
      const int unit = (cgb + c) * 8 + h;
#pragma unroll
      for (int i = 0; i < 4; ++i) {
        const int row = tid & 63, dc = ((tid >> 6) + 4 * i) * 8;
        const u32x4 v = pk[i];
        *(u32x4*)(sK + row * 136 + dc) = v;
#pragma unroll
        for (int e = 0; e < 4; ++e) { sKT[(dc + 2 * e) * 72 + row] = (u16)(v[e] & 0xffffu); sKT[(dc + 2 * e + 1) * 72 + row] = (u16)(v[e] >> 16); }
      }
      {
        const int row = tid & 63, ec = (tid >> 6) * 8;
        const u32x4 v = pv;
#pragma unroll
        for (int e = 0; e < 4; ++e) { sVT[(ec + 2 * e) * 72 + row] = (u16)(v[e] & 0xffffu); sVT[(ec + 2 * e + 1) * 72 + row] = (u16)(v[e] >> 16); }
      }
      if (tid < 64) { sGc[tid] = pg; sE[tid] = pe; sD[tid] = pd; }
      bf16x8 qf[4], tf[2];
#pragma unroll
      for (int ks = 0; ks < 4; ++ks) qf[ks] = ld8(qn + (size_t)(t0 + w * 16 + l15) * 1024 + h * 128 + ks * 32 + g * 8);
#pragma unroll
      for (int ks = 0; ks < 2; ++ks) tf[ks] = pt[ks];
      __syncthreads();
      if (step + 1 < nch) { const int cn = dir ? nch - 2 - step : step + 1; SCAN_PREFETCH(cn); }
      const float gl = dir ? sGc[0] : sGc[63];
      bf16x8 wf[4];
      f32x4 ua[2];
      {
        bf16x8 vtf[2][2], ktf[4][2];
        f32x4 egm[2][2];
#pragma unroll
        for (int et = 0; et < 2; ++et)
#pragma unroll
          for (int ks = 0; ks < 2; ++ks) vtf[et][ks] = ld8(sVT + (et * 16 + l15) * 72 + ks * 32 + g * 8);
#pragma unroll
        for (int ks = 0; ks < 2; ++ks) { egm[ks][0] = *(const f32x4*)(sE + ks * 32 + g * 8); egm[ks][1] = *(const f32x4*)(sE + ks * 32 + g * 8 + 4); }
#pragma unroll
        for (int dt = 0; dt < 4; ++dt)
#pragma unroll
          for (int ks = 0; ks < 2; ++ks) ktf[dt][ks] = ld8(sKT + (dt * 16 + l15) * 72 + ks * 32 + g * 8);
        __builtin_amdgcn_sched_barrier(0);
#pragma unroll
        for (int et = 0; et < 2; ++et) {
          ua[et][0] = 0.f; ua[et][1] = 0.f; ua[et][2] = 0.f; ua[et][3] = 0.f;
#pragma unroll
          for (int ks = 0; ks < 2; ++ks) ua[et] = mma(tf[ks], vtf[et][ks], ua[et]);
        }
#pragma unroll
        for (int ks = 0; ks < 2; ++ks) {
          const u32x4 tw = __builtin_bit_cast(u32x4, tf[ks]);
          u32x4 o;
#pragma unroll
          for (int e = 0; e < 4; ++e) o[e] = pack2(bflo(tw[e]) * egm[ks][e >> 1][(2 * e) & 3], bfhi(tw[e]) * egm[ks][e >> 1][(2 * e + 1) & 3]);
          tf[ks] = __builtin_bit_cast(bf16x8, o);
        }
#pragma unroll
        for (int kq = 0; kq < 2; ++kq) {
          f32x4 wa[2];
#pragma unroll
          for (int hh = 0; hh < 2; ++hh) {
            wa[hh][0] = 0.f; wa[hh][1] = 0.f; wa[hh][2] = 0.f; wa[hh][3] = 0.f;
#pragma unroll
            for (int ks = 0; ks < 2; ++ks) wa[hh] = mma(ktf[kq * 2 + hh][ks], tf[ks], wa[hh]);
          }
          wf[kq] = pack8(wa[0], wa[1]);
        }
        __builtin_amdgcn_sched_barrier(0);
      }
      {
        bf16x8 ktf[4][2];
#pragma unroll
        for (int dt = 0; dt < 4; ++dt)
#pragma unroll
          for (int ks = 0; ks < 2; ++ks) ktf[dt][ks] = ld8(sKT + ((4 + dt) * 16 + l15) * 72 + ks * 32 + g * 8);
        __builtin_amdgcn_sched_barrier(0);
#pragma unroll
        for (int kq = 2; kq < 4; ++kq) {
          f32x4 wa[2];
#pragma unroll
          for (int hh = 0; hh < 2; ++hh) {
            wa[hh][0] = 0.f; wa[hh][1] = 0.f; wa[hh][2] = 0.f; wa[hh][3] = 0.f;
#pragma unroll
            for (int ks = 0; ks < 2; ++ks) wa[hh] = mma(ktf[(kq - 2) * 2 + hh][ks], tf[ks], wa[hh]);
          }
          wf[kq] = pack8(wa[0], wa[1]);
        }
        __builtin_amdgcn_sched_barrier(0);
      }
      const int iq = w * 16 + l15;
      const float gi = sGc[iq];
      const f32x4 dvec = *(const f32x4*)(sD + w * 16 + g * 4);
      f32x4 vn[2];
      bf16x8 qkf[2];
#pragma unroll
      for (int kk = 0; kk < 2; ++kk) {
        bf16x8 kf[2][4];
        f32x4 gcm[2];
#pragma unroll
        for (int hh = 0; hh < 2; ++hh)
#pragma unroll
          for (int ks = 0; ks < 4; ++ks) kf[hh][ks] = ld8(sK + ((kk * 2 + hh) * 16 + l15) * 136 + ks * 32 + g * 8);
#pragma unroll
        for (int hh = 0; hh < 2; ++hh) gcm[hh] = *(const f32x4*)(sGc + (kk * 2 + hh) * 16 + g * 4);
        bf16x8 stp[2][4];
        if (kk == 0) {
#pragma unroll
          for (int et = 0; et < 2; ++et)
#pragma unroll
            for (int kq = 0; kq < 4; ++kq) { const u16* sp = sST + (et * 16 + l15) * 136 + kq * 32 + g * 4; stp[et][kq] = ld44(sp, sp + 16); }
        }
        __builtin_amdgcn_sched_barrier(0);
        if (kk == 0) {
#pragma unroll
          for (int et = 0; et < 2; ++et) {
            f32x4 a; a[0] = 0.f; a[1] = 0.f; a[2] = 0.f; a[3] = 0.f;
#pragma unroll
            for (int kq = 0; kq < 4; ++kq) a = mma(wf[kq], stp[et][kq], a);
            vn[et][0] = ua[et][0] - a[0]; vn[et][1] = ua[et][1] - a[1]; vn[et][2] = ua[et][2] - a[2]; vn[et][3] = ua[et][3] - a[3];
          }
        }
        f32x4 ka[2];
#pragma unroll
        for (int hh = 0; hh < 2; ++hh) {
          const int mt = kk * 2 + hh;
          ka[hh][0] = 0.f; ka[hh][1] = 0.f; ka[hh][2] = 0.f; ka[hh][3] = 0.f;
#pragma unroll
          for (int ks = 0; ks < 4; ++ks) ka[hh] = mma(kf[hh][ks], qf[ks], ka[hh]);
#pragma unroll
          for (int r = 0; r < 4; ++r) {
            const int m = mt * 16 + g * 4 + r;
            const bool valid = dir ? (iq <= m) : (iq >= m);
            ka[hh][r] = ka[hh][r] * __expf(valid ? gi - gcm[hh][r] : -1e30f);
          }
        }
        qkf[kk] = pack8(ka[0], ka[1]);
        __builtin_amdgcn_sched_barrier(0);
      }
#pragma unroll
      for (int et = 0; et < 2; ++et) {
        const int i0 = w * 16 + g * 4;
        st4bf(sVN + (et * 16 + l15) * 72 + i0, vn[et][0], vn[et][1], vn[et][2], vn[et][3]);
        st4bf(sVD + (et * 16 + l15) * 72 + i0, vn[et][0] * dvec[0], vn[et][1] * dvec[1], vn[et][2] * dvec[2], vn[et][3] * dvec[3]);
      }
      __syncthreads();
      {
        bf16x8 stn[2][4], vnp[2][2];
#pragma unroll
        for (int et = 0; et < 2; ++et)
#pragma unroll
          for (int ks = 0; ks < 4; ++ks) stn[et][ks] = ld8(sST + (et * 16 + l15) * 136 + ks * 32 + g * 8);
#pragma unroll
        for (int et = 0; et < 2; ++et)
#pragma unroll
          for (int kk = 0; kk < 2; ++kk) { const u16* sp = sVN + (et * 16 + l15) * 72 + kk * 32 + g * 4; vnp[et][kk] = ld44(sp, sp + 16); }
        const f32x4 egi = *(const f32x4*)(sE + w * 16 + g * 4);
        __builtin_amdgcn_sched_barrier(0);
#pragma unroll
        for (int et = 0; et < 2; ++et) {
          f32x4 a1; a1[0] = 0.f; a1[1] = 0.f; a1[2] = 0.f; a1[3] = 0.f;
#pragma unroll
          for (int ks = 0; ks < 4; ++ks) a1 = mma(qf[ks], stn[et][ks], a1);
          f32x4 a2; a2[0] = 0.f; a2[1] = 0.f; a2[2] = 0.f; a2[3] = 0.f;
#pragma unroll
          for (int kk = 0; kk < 2; ++kk) a2 = mma(qkf[kk], vnp[et][kk], a2);
#pragma unroll
          for (int r = 0; r < 4; ++r) {
            const int i = w * 16 + g * 4 + r;
            const float o = a1[r] * egi[r] + a2[r];
            obase[(size_t)(t0 + i) * 4096 + dir * 1024 + h * 128 + dvq * 32 + et * 16 + l15] = f2bf(o);
          }
        }
        __builtin_amdgcn_sched_barrier(0);
      }
      {
        bf16x8 ktf2[2][2], vdf[2][2];
#pragma unroll
        for (int dt = 0; dt < 2; ++dt)
#pragma unroll
          for (int kk = 0; kk < 2; ++kk) { ktf2[dt][kk] = ld8(sKT + (w * 32 + dt * 16 + l15) * 72 + kk * 32 + g * 8); vdf[dt][kk] = ld8(sVD + (dt * 16 + l15) * 72 + kk * 32 + g * 8); }
        __builtin_amdgcn_sched_barrier(0);
        const float eg = __expf(gl);
#pragma unroll
        for (int dt = 0; dt < 2; ++dt)
#pragma unroll
          for (int et = 0; et < 2; ++et) {
            f32x4 a; a[0] = S[dt][et][0] * eg; a[1] = S[dt][et][1] * eg; a[2] = S[dt][et][2] * eg; a[3] = S[dt][et][3] * eg;
#pragma unroll
            for (int kk = 0; kk < 2; ++kk) a = mma(ktf2[dt][kk], vdf[et][kk], a);
            S[dt][et] = a;
          }
      }
      __syncthreads();
#pragma unroll
      for (int dt = 0; dt < 2; ++dt)
#pragma unroll
        for (int et = 0; et < 2; ++et) st4bf(sST + (et * 16 + l15) * 136 + w * 32 + dt * 16 + g * 4, S[dt][et][0], S[dt][et][1], S[dt][et][2], S[dt][et][3]);
    }
    if (seq < 16) {
      float* so = GOUT + (dir ? O_SB : O_SF) + (((size_t)seq * 2 + j) * 8 + h) * 16384;
#pragma unroll
      for (int dt = 0; dt < 2; ++dt)
#pragma unroll
        for (int et = 0; et < 2; ++et)
#pragma unroll
          for (int r = 0; r < 4; ++r) so[(size_t)(w * 32 + dt * 16 + g * 4 + r) * 128 + dvq * 32 + et * 16 + l15] = S[dt][et][r];
    }
  }
}

#define XB_TMO      128
#define XB_XCNT(j)  (256  + 64 * (j))
#define XB_XSUB(j)  (1280 + 64 * (j))
#define XB_XGEN(j)  (2304 + 64 * (j))
#define XB_TOP      3328
#define XB_TOPGEN   3392
#define XCD_BAR_WORDS 3456
#define XB_SPIN_CAP (1u << 20)
#define LAS __attribute__((address_space(3)))
DI unsigned xb_ld(unsigned* p)              { return __hip_atomic_load(p, __ATOMIC_RELAXED, __HIP_MEMORY_SCOPE_AGENT); }
DI unsigned xb_add(unsigned* p, unsigned v) { return __hip_atomic_fetch_add(p, v, __ATOMIC_RELAXED, __HIP_MEMORY_SCOPE_AGENT); }
DI unsigned xb_xcc_id() { return (unsigned)__builtin_amdgcn_s_getreg((3 << 11) | 20) & 0xFu; }
#define XB_SPIN(cond, bar) do { unsigned _sp = 0; while (cond) { __builtin_amdgcn_s_sleep(1); \
    if ((++_sp & 255u) == 0u) { if (xb_ld(&(bar)[XB_TMO])) break; if (_sp > XB_SPIN_CAP) { atomicAdd(&(bar)[XB_TMO], 1u); break; } } } } while (0)
struct XcdBarrier { unsigned* bar; unsigned x; volatile LAS unsigned* st; };
DI XcdBarrier xcd_barrier_post(unsigned* bar, volatile LAS unsigned* st) {
  XcdBarrier b; b.bar = bar; b.x = xb_xcc_id(); b.st = st;
  if (threadIdx.x == 0) (void)xb_add(&bar[XB_XCNT(b.x)], 1u);
  return b;
}
DI void xcd_barrier_complete(unsigned* bar, unsigned x, unsigned& nloc, unsigned& nx) {
  const unsigned Gn = gridDim.x * gridDim.y * gridDim.z;
  unsigned sum, cnt, mine, sp = 0u;
  for (;;) {
    sum = 0u; cnt = 0u; mine = 0u;
#pragma unroll
    for (unsigned j = 0; j < 16; ++j) { const unsigned c = xb_ld(&bar[XB_XCNT(j)]); sum += c; cnt += (c > 0u) ? 1u : 0u; mine = (j == x) ? c : mine; }
    if (sum == Gn) break;
    __builtin_amdgcn_s_sleep(1);
    if ((++sp & 255u) == 0u) { if (xb_ld(&bar[XB_TMO])) break; if (sp > XB_SPIN_CAP) { atomicAdd(&bar[XB_TMO], 1u); break; } }
  }
  nloc = mine > 0u ? mine : 1u; nx = cnt > 0u ? cnt : 1u;
}
DI void xcd_barrier(const XcdBarrier& b) {
  asm volatile("s_waitcnt vmcnt(0)" ::: "memory");
  __syncthreads();
  if (threadIdx.x == 0) {
    unsigned* bar = b.bar;
    __builtin_amdgcn_s_waitcnt(0);
    unsigned nloc = b.st[0], nx = b.st[1];
    if (nloc == 0u) { xcd_barrier_complete(bar, b.x, nloc, nx); b.st[0] = nloc; b.st[1] = nx; }
    const unsigned old = xb_add(&bar[XB_XSUB(b.x)], 1u);
    const unsigned gen = old / nloc;
    if (old + 1u == (gen + 1u) * nloc) {
      __builtin_amdgcn_fence(__ATOMIC_RELEASE, "agent");
      asm volatile("s_waitcnt vmcnt(0)" ::: "memory");
      const unsigned og = xb_add(&bar[XB_TOP], 1u);
      const unsigned tg = og / nx;
      if (og + 1u == (tg + 1u) * nx) xb_add(&bar[XB_TOPGEN], 1u);
      else XB_SPIN(xb_ld(&bar[XB_TOPGEN]) == tg, bar);
      __builtin_amdgcn_fence(__ATOMIC_ACQUIRE, "agent");
      xb_add(&bar[XB_XGEN(b.x)], 1u);
      asm volatile("s_waitcnt vmcnt(0)" ::: "memory");
    } else {
      XB_SPIN(xb_ld(&bar[XB_XGEN(b.x)]) == gen, bar);
      __builtin_amdgcn_fence(__ATOMIC_ACQUIRE, "agent");
      asm volatile("s_waitcnt vmcnt(0)" ::: "memory");
    }
  }
  __syncthreads();
}

__global__ void __launch_bounds__(256, 2) fwd_megakernel(P p) {
  cg::grid_group grid = cg::this_grid();
  __shared__ __attribute__((aligned(16))) char smem[60416];
  const int tid = opaque_tid(), lane = tid & 63, wid = tid >> 6;
  const int G = gridDim.x;
  __shared__ uint4 xb_words;
  if (threadIdx.x == 0) xb_words = make_uint4(0u, 0u, 0u, 0u);
  __syncthreads();
  (void)xcd_barrier_post((unsigned*)(as_global(p.ws) + WS_BAR), (volatile LAS unsigned*)&xb_words);
#define GSYNC() do { XcdBarrier xb_; xb_.bar = (unsigned*)(opaque_ptr(as_global(p.ws)) + WS_BAR); xb_.x = xb_xcc_id(); xb_.st = (volatile LAS unsigned*)&xb_words; xcd_barrier(xb_); } while (0)
  const int bid0 = opaque_bid();
  {
  char* const ws0 = opaque_ptr(as_global(p.ws));
  float* mods = (float*)(ws0 + WS_MODS);
  float* ropeT = (float*)(ws0 + WS_ROPE);
  float* cosG = ropeT, *sinG = ropeT + 2048, *cosM = ropeT + 4096, *sinM = ropeT + 5120;

  {
    float* sc = (float*)smem;
    float* red = sc + 9 * 128;
    float* part = (float*)(ws0 + WS_R);
    for (int item = bid0; item < 3072; item += G) {
      const int ks = item & 7, cgp = (item >> 3) % 96, layer = item / 768;
      __syncthreads();
      for (int e = tid; e < 9 * 128; e += 256) {
        const int ci = e >> 7, k = ks * 128 + (e & 127);
        const float v = ci == 0 ? GIN(9)[k] : GIN(8)[(ci - 1) * 1024 + k];
        sc[e] = v / (1.f + expf(-v));
      }
      __syncthreads();
      const int col = tid & 63, kg = tid >> 6;
      const float* wp = GIN(12) + ((size_t)layer * 1024 + ks * 128 + kg * 32) * 6144 + cgp * 64 + col;
      float acc[9];
#pragma unroll
      for (int ci = 0; ci < 9; ++ci) acc[ci] = 0.f;
#pragma unroll 8
      for (int kk = 0; kk < 32; ++kk) {
        const float wv = wp[(size_t)kk * 6144];
#pragma unroll
        for (int ci = 0; ci < 9; ++ci) acc[ci] += sc[ci * 128 + kg * 32 + kk] * wv;
      }
#pragma unroll
      for (int ci = 0; ci < 9; ++ci) red[(kg * 64 + col) * 9 + ci] = acc[ci];
      __syncthreads();
      if (kg == 0) {
        const int n = cgp * 64 + col;
        const float bias = ks == 0 ? GIN(13)[(size_t)layer * 6144 + n] : 0.f;
#pragma unroll
        for (int ci = 0; ci < 9; ++ci) {
          const float s = red[col * 9 + ci] + red[(64 + col) * 9 + ci] + red[(128 + col) * 9 + ci] + red[(192 + col) * 9 + ci] + bias;
          part[(size_t)ks * 221184 + ((size_t)layer * 9 + ci) * 6144 + n] = s;
        }
      }
    }
    if (bid0 == G - 1) {
      for (int e = tid; e < 2048; e += 256) { const int pos = e >> 5, f = e & 31; const float fr = powf(10000.f, -(float)f / 32.f); const float a = (float)pos * fr; cosG[e] = cosf(a); sinG[e] = sinf(a); }
      for (int e = tid; e < 1024; e += 256) { const int pos = e >> 4, f = e & 15; const float fr = powf(10000.f, -(float)f / 16.f); const float a = (float)pos * fr; cosM[e] = cosf(a); sinM[e] = sinf(a); }
    }
  }
  if (gridDim.x == 0x7fffffffu) grid.sync();
  GSYNC();
  {
    const float* part = (const float*)(ws0 + WS_R);
    for (int e = bid0 * 256 + tid; e < 221184; e += G * 256) {
      float sacc = 0.f;
#pragma unroll
      for (int ks = 0; ks < 8; ++ks) sacc += part[(size_t)ks * 221184 + e];
      mods[e] = sacc;
    }
  }
  }
  GSYNC();

#pragma unroll 1
  for (int layer = 0; layer < 4; ++layer) {
    const int kind = layer % 3, j = layer / 3;
    const int bid = opaque_bid();
    char* const ws = opaque_ptr(as_global(p.ws));
    float* mods = (float*)(ws + WS_MODS);
    float* ropeT = (float*)(ws + WS_ROPE);
    float* cosG = ropeT, *sinG = ropeT + 2048, *cosM = ropeT + 4096, *sinM = ropeT + 5120;
    u16* hbuf = (u16*)(ws + WS_HBUF);
    u16* obuf = (u16*)(ws + WS_OBUF);
    u16* wmix = (u16*)(ws + WS_WMIX);
    u16* wmlp = (u16*)(ws + WS_WMLP);
    char* R = ws + WS_R;
    const float* lmods = mods + (size_t)layer * 9 * 6144;
    {
      for (int it = bid; it < 5120; it += G) norm_rows(p, layer, layer == 0, it, GIN(10) + layer * 1024, 0, 1);
      float* sT = (float*)smem;
      for (int it = bid; it < 2048; it += G) {
        if (it < 1024) convert_tile(GIN(14) + (size_t)layer * 1024 * 4096, 1024, 4096, wmlp, it, 0, sT);
        else convert_tile(GIN(15) + (size_t)layer * 4096 * 1024, 4096, 1024, wmlp + 4194304, it - 1024, 0, sT);
      }
      if (kind == 0) {
        for (int it = bid; it < 1056 + 256; it += G) {
          if (it < 1056) convert_tile(GIN(16) + (size_t)j * 1024 * 4128, 1024, 4128, wmix + WM_IN, it, 0, sT);
          else convert_tile(GIN(21) + (size_t)j * 1024 * 1024, 1024, 1024, wmix + WM_OUT, it - 1056, 0, sT);
        }
      } else if (kind == 1) {
        for (int it = bid; it < 192 + 144 + 128 + 256; it += G) {
          if (it < 192) convert_tile(GIN(22), 1024, 704, wmix + WM_IN, it, 0, sT);
          else if (it < 336) convert_tile(GIN(25), 384, 1536, wmix + WM_UQ, it - 192, 1, sT);
          else if (it < 464) convert_tile(GIN(26), 256, 2048, wmix + WM_UKV, it - 336, 0, sT);
          else convert_tile(GIN(31), 1024, 1024, wmix + WM_OUT, it - 464, 0, sT);
        }
      } else {
        for (int it = bid; it < 384 + 256; it += G) {
          if (it < 384) convert_tile(GIN(32), 1024, 1536, wmix + WM_IN, it, 0, sT);
          else convert_tile(GIN(35), 1024, 1024, wmix + WM_OUT, it - 384, 0, sT);
        }
        u16* Kg = (u16*)(R + R_KG); u16* Vg = (u16*)(R + R_VTG);
        const int tid = opaque_tid();
        for (int it = bid; it < 512; it += G) {
          const int b = it >> 6, s0 = (it & 63) * 8;
          const int ch = tid;
          float kv[8], vv[8];
#pragma unroll
          for (int e = 0; e < 8; ++e) { kv[e] = GIN(6)[((size_t)b * 512 + s0 + e) * 256 + ch]; vv[e] = GIN(7)[((size_t)b * 512 + s0 + e) * 256 + ch]; }
#pragma unroll
          for (int e = 0; e < 8; ++e) Kg[(size_t)(NPROMPT + b * 2560 + s0 + e) * 256 + ch] = f2bf(kv[e]);
          u32x4 o; o[0] = pack2(vv[0], vv[1]); o[1] = pack2(vv[2], vv[3]); o[2] = pack2(vv[4], vv[5]); o[3] = pack2(vv[6], vv[7]);
          *(u32x4*)(Vg + (size_t)(NPROMPT + b * 2560) * 256 + (size_t)ch * 2560 + s0) = o;
        }
      }
    }
    GSYNC();

    if (kind == 0) {
      {
        EpiGdnIn epi; epi.proj = (u16*)(R + R_PROJ); epi.gbuf = (float*)(R + R_GBUF);
        for (int it = bid; it < 160 * 33; it += G) { const int mt = it / 33, nt = it % 33; gemm_tile<4>(hbuf, 1024, wmix + WM_IN, 1024, 1024, mt * 128, nt * 128, (u16*)smem, epi); }
      }
      GSYNC();
      gdn_chunk_phase(p, j, smem);
      GSYNC();
      gdn_scan_phase(p, j, smem);
      GSYNC();
      {
        const u16* pr = (const u16*)(R + R_PROJ);
        const float* on = GIN(20) + j * 128;
        const int tid = opaque_tid();
        for (int t = bid; t < NTOK; t += G) {
          const int h = tid >> 5, c = (tid & 31) * 4;
          const u16* row = pr + (size_t)t * 4096;
          const u32x2 f = *(const u32x2*)(row + h * 128 + c), b = *(const u32x2*)(row + 1024 + h * 128 + c), z = *(const u32x2*)(row + 3072 + h * 128 + c);
          float o[4] = {bflo(f[0]) + bflo(b[0]), bfhi(f[0]) + bfhi(b[0]), bflo(f[1]) + bflo(b[1]), bfhi(f[1]) + bfhi(b[1])};
          float zz[4] = {bflo(z[0]), bfhi(z[0]), bflo(z[1]), bfhi(z[1])};
          float ss = o[0] * o[0] + o[1] * o[1] + o[2] * o[2] + o[3] * o[3];
          ss += __shfl_xor(ss, 1); ss += __shfl_xor(ss, 2); ss += __shfl_xor(ss, 4); ss += __shfl_xor(ss, 8); ss += __shfl_xor(ss, 16);
          const float rs = rsqrtf(ss * (1.f / 128.f) + EPS);
          const float4 gn = *(const float4*)(on + c);
          const float gg[4] = {gn.x, gn.y, gn.z, gn.w};
          float y[4];
#pragma unroll
          for (int e = 0; e < 4; ++e) y[e] = o[e] * rs * gg[e] * (zz[e] / (1.f + __expf(-zz[e])));
          st4bf(obuf + (size_t)t * 1024 + h * 128 + c, y[0], y[1], y[2], y[3]);
        }
      }
      GSYNC();
    } else if (kind == 1) {
      {
        EpiF32 epi; epi.dst = (float*)(R + R_DPROJ); epi.ld = 768;
        for (int it = bid; it < 160 * 6; it += G) { const int mt = it / 6, nt = it % 6; gemm_tile<4>(hbuf, 1024, wmix + WM_IN, 1024, 1024, mt * 128, nt * 128, (u16*)smem, epi); }
      }
      GSYNC();
      {
        const float* dproj = (const float*)(R + R_DPROJ);
        u16* cq = (u16*)(R + R_CQ); u16* ckv = (u16*)(R + R_CKV); u16* Km = (u16*)(R + R_KM);
        const int tid = opaque_tid(), lane = tid & 63, wid = tid >> 6;
        for (int it = bid; it < 6144; it += G) {
          const int row = it * 4 + wid;
          if (row < NTOK) {
            const int t = row;
            const float* pr = dproj + (size_t)t * 768;
            float v[6]; float ss = 0.f;
#pragma unroll
            for (int e = 0; e < 6; ++e) { v[e] = pr[lane + 64 * e]; ss += v[e] * v[e]; }
            ss = wave_sum(ss);
            float rs = rsqrtf(ss * (1.f / 384.f) + EPS);
#pragma unroll
            for (int e = 0; e < 6; ++e) cq[(size_t)t * 384 + lane + 64 * e] = f2bf(v[e] * rs * GIN(23)[lane + 64 * e]);
            const int kvrow = kvrow_of_tok(t);
            float wv[4]; ss = 0.f;
#pragma unroll
            for (int e = 0; e < 4; ++e) { wv[e] = pr[384 + lane + 64 * e]; ss += wv[e] * wv[e]; }
            ss = wave_sum(ss);
            rs = rsqrtf(ss * (1.f / 256.f) + EPS);
#pragma unroll
            for (int e = 0; e < 4; ++e) {
              const float o = wv[e] * rs * GIN(24)[lane + 64 * e];
              ckv[(size_t)kvrow * 256 + lane + 64 * e] = f2bf(o);
              if (t < NPROMPT) GOUT[O_CKV + (size_t)t * 256 + lane + 64 * e] = o;
            }
            const float x = pr[640 + lane];
            ss = wave_sum(x * x);
            float kr = x * rsqrtf(ss * (1.f / 64.f) + EPS) * GIN(30)[lane];
            if (t < NPROMPT) GOUT[O_KR + (size_t)t * 64 + lane] = kr;
            else {
              const int s = (t - NPROMPT) & 2047;
              const int pos = lane < 32 ? (s >> 6) : (s & 63);
              const float cs = cosM[pos * 16 + (lane & 15)], sn = sinM[pos * 16 + (lane & 15)];
              const float partner = __shfl_xor(kr, 16);
              kr = ((lane & 16) == 0) ? kr * cs - partner * sn : partner * sn + kr * cs;
            }
            const u16 kb = f2bf(kr);
#pragma unroll
            for (int hh = 0; hh < 8; ++hh) Km[(size_t)kvrow * 1536 + hh * 192 + 128 + lane] = kb;
          } else {
            const int r = row - NTOK; const int b = r >> 9, s = r & 511;
            const int kvrow = NPROMPT + b * 2560 + s;
#pragma unroll
            for (int e = 0; e < 4; ++e) ckv[(size_t)kvrow * 256 + lane + 64 * e] = f2bf(GIN(4)[((size_t)b * 512 + s) * 256 + lane + 64 * e]);
            const u16 kb = f2bf(GIN(5)[((size_t)b * 512 + s) * 64 + lane]);
#pragma unroll
            for (int hh = 0; hh < 8; ++hh) Km[(size_t)kvrow * 1536 + hh * 192 + 128 + lane] = kb;
          }
        }
      }
      GSYNC();
      {
        EpiMlaUq e1; e1.Q = (u16*)(R + R_Q); e1.gnope = GIN(27); e1.grope = GIN(28); e1.cosT = cosM; e1.sinT = sinM;
        for (int it = bid; it < 160 * 12; it += G) { const int mt = it / 12, nt = it % 12; gemm_tile<8>((const u16*)(R + R_CQ), 384, wmix + WM_UQ, 384, 384, mt * 128, nt * 128, (u16*)smem, e1); }
        EpiMlaUkv e2; e2.Kb = (u16*)(R + R_KM); e2.Vt = (u16*)(R + R_VTM); e2.gnope = GIN(29);
        for (int it = bid; it < 192 * 16; it += G) { const int mt = it / 16, nt = it % 16; gemm_tile<8>((const u16*)(R + R_CKV), 256, wmix + WM_UKV, 256, 256, mt * 128, nt * 128, (u16*)smem, e2); }
      }
      GSYNC();
      attn_phase<192, 8>((const u16*)(R + R_Q), (const u16*)(R + R_KM), (const u16*)(R + R_VTM), obuf, smem);
      GSYNC();
    } else {
      {
        EpiGqaIn epi; epi.Q = (u16*)(R + R_Q); epi.Kb = (u16*)(R + R_KG); epi.Vt = (u16*)(R + R_VTG); epi.qg = GIN(33); epi.kg = GIN(34); epi.cosT = cosG; epi.sinT = sinG; epi.out = GOUT;
        for (int it = bid; it < 160 * 12; it += G) { const int mt = it / 12, nt = it % 12; gemm_tile<8>(hbuf, 1024, wmix + WM_IN, 1024, 1024, mt * 128, nt * 128, (u16*)smem, epi); }
      }
      GSYNC();
      attn_phase<128, 2>((const u16*)(R + R_Q), (const u16*)(R + R_KG), (const u16*)(R + R_VTG), obuf, smem);
      GSYNC();
    }

    for (int it = bid; it < 160 * 8; it += G) {
      const int mt = it >> 3, nt = it & 7; const int m0 = mt * 128;
      EpiResid epi;
      epi.xin = (layer == 0) ? (m0 < NPROMPT ? GIN(0) : GIN(1) - (size_t)NPROMPT * 1024) : GOUT;
      epi.xout = GOUT; epi.gate = lmods + (size_t)cond_of(m0) * 6144 + 2 * 1024;
      gemm_tile<4>(obuf, 1024, wmix + WM_OUT, 1024, 1024, m0, nt * 128, (u16*)smem, epi);
    }
    GSYNC();
    for (int it = bid; it < 5120; it += G) norm_rows(p, layer, false, it, GIN(11) + layer * 1024, 3, 4);
    GSYNC();
    {
      EpiMlpIn epi; epi.abuf = (u16*)(R + R_ABUF);
      for (int it = bid; it < 160 * 32; it += G) { const int mt = it >> 5, nt = it & 31; gemm_tile<4>(hbuf, 1024, wmlp, 1024, 1024, mt * 128, nt * 128, (u16*)smem, epi); }
    }
    GSYNC();
    for (int it = bid; it < 160 * 8; it += G) {
      const int mt = it >> 3, nt = it & 7; const int m0 = mt * 128;
      EpiResid epi; epi.xin = GOUT; epi.xout = GOUT; epi.gate = lmods + (size_t)cond_of(m0) * 6144 + 5 * 1024;
      gemm_tile<4>((const u16*)(R + R_ABUF), 4096, wmlp + 4194304, 4096, 4096, m0, nt * 128, (u16*)smem, epi);
    }
    GSYNC();
  }
}

extern "C" void kernel_launch(void* const* d_in, const int* in_sizes, int n_in, void* d_out, int out_size, void* d_ws, size_t ws_size, hipStream_t stream) {
  static int grid_blocks = 0;
  if (!grid_blocks) {
    int dev = 0, cus = 0, per_cu = 0;
    hipGetDevice(&dev);
    hipDeviceGetAttribute(&cus, hipDeviceAttributeMultiprocessorCount, dev);
    hipOccupancyMaxActiveBlocksPerMultiprocessor(&per_cu, fwd_megakernel, 256, 0);
    if (per_cu < 1) per_cu = 1;
    if (per_cu > 2) per_cu = 2;
    grid_blocks = cus * per_cu;
  }
  P p{};
  for (int i = 0; i < 36; ++i) p.in[i] = (const float*)d_in[i];
  p.out = (float*)d_out;
  p.ws = (char*)d_ws;
  (void)hipMemsetAsync((char*)d_ws + WS_BAR, 0, XCD_BAR_WORDS * 4, stream);
  void* args[] = {&p};
  hipError_t e = hipLaunchCooperativeKernel((void*)fwd_megakernel, dim3(grid_blocks), dim3(256), args, 0, stream);
  if (e != hipSuccess) fprintf(stderr, "cooperative launch failed: %s (grid %d)\n", hipGetErrorString(e), grid_blocks);
}
```

```cpp
#include <hip/hip_runtime.h>
#include <hip/hip_cooperative_groups.h>
#include <cstdio>
namespace cg = cooperative_groups;

typedef unsigned short u16;
typedef __attribute__((ext_vector_type(8))) short bf16x8;
typedef __attribute__((ext_vector_type(4))) short bf16x4;
typedef __attribute__((ext_vector_type(4))) float f32x4;
typedef __attribute__((ext_vector_type(4))) unsigned u32x4;
typedef __attribute__((ext_vector_type(2))) unsigned u32x2;

#define DI __device__ __forceinline__

constexpr int NTOK = 20480;
constexpr int NPROMPT = 4096;
constexpr float EPS = 1e-6f;

constexpr size_t WS_MODS = 0;
constexpr size_t MODS_BYTES = 4ull * 9 * 6144 * 4;
constexpr size_t WS_BAR = 917504;
constexpr size_t WS_ROPE = 1048576;
constexpr size_t WS_WMIX = 1114112;
constexpr size_t WS_WMLP = 14090240;
constexpr size_t WS_HBUF = 30867456;
constexpr size_t WS_OBUF = 72810496;
constexpr size_t WS_R    = 114753536;
constexpr size_t R_ABUF = 0;
constexpr size_t R_PROJ = 0;
constexpr size_t R_VBUF = 167772160;
constexpr size_t R_TBUF = 209715200;
constexpr size_t R_GBUF = 251658240;
constexpr size_t R_GCB  = 254279680;
constexpr size_t R_BETA = 255590400;
constexpr size_t R_EG   = 256901120;
constexpr size_t R_ED   = 258211840;
constexpr size_t R_DPROJ = 0;
constexpr size_t R_Q    = 0;
constexpr size_t R_CQ   = 62914560;
constexpr size_t R_CKV  = 78643200;
constexpr size_t R_KM   = 91226112;
constexpr size_t R_VTM  = 166723584;
constexpr size_t R_KG   = 41943040;
constexpr size_t R_VTG  = 54525952;
constexpr size_t WM_IN = 0;
constexpr size_t WM_OUT = 4325376;
constexpr size_t WM_UQ = 5373952;
constexpr size_t WM_UKV = 5963776;
constexpr size_t O_SF = 20971520, O_SB = 25165824, O_CKV = 29360128, O_KR = 30408704, O_GK = 30670848, O_GV = 31719424;

struct P {
  const float* in[36];
  float* out;
  char* ws;
};

typedef __attribute__((ext_vector_type(2))) float f32x2_t;
typedef __attribute__((ext_vector_type(2))) __bf16 bf16x2_t;
DI u16 f2bf(float x) { return __builtin_bit_cast(u16, (__bf16)x); }
DI float bf2f(u16 h) { return __uint_as_float(((unsigned)h) << 16); }
DI unsigned pack2(float a, float b) { f32x2_t v; v[0] = a; v[1] = b; return __builtin_bit_cast(unsigned, __builtin_convertvector(v, bf16x2_t)); }
DI float bflo(unsigned w) { return __uint_as_float(w << 16); }
DI float bfhi(unsigned w) { return __uint_as_float(w & 0xffff0000u); }
DI f32x4 mma(bf16x8 a, bf16x8 b, f32x4 c) { return __builtin_amdgcn_mfma_f32_16x16x32_bf16(a, b, c, 0, 0, 0); }
DI bf16x8 pack8(f32x4 a, f32x4 b) {
  u32x4 p; p[0] = pack2(a[0], a[1]); p[1] = pack2(a[2], a[3]); p[2] = pack2(b[0], b[1]); p[3] = pack2(b[2], b[3]);
  return __builtin_bit_cast(bf16x8, p);
}
DI bf16x8 ld8(const u16* p) { return *(const bf16x8*)p; }
DI bf16x8 ld44(const u16* p0, const u16* p1) {
  u32x2 a = *(const u32x2*)p0; u32x2 b = *(const u32x2*)p1;
  u32x4 r; r[0] = a[0]; r[1] = a[1]; r[2] = b[0]; r[3] = b[1];
  return __builtin_bit_cast(bf16x8, r);
}
DI void st4bf(u16* p, float a, float b, float c, float d) { u32x2 v; v[0] = pack2(a, b); v[1] = pack2(c, d); *(u32x2*)p = v; }
DI float wave_sum(float v) {
  v += __shfl_xor(v, 1); v += __shfl_xor(v, 2); v += __shfl_xor(v, 4); v += __shfl_xor(v, 8); v += __shfl_xor(v, 16); v += __shfl_xor(v, 32);
  return v;
}
DI float sum_g(float v) { v += __shfl_xor(v, 16); v += __shfl_xor(v, 32); return v; }
DI int opaque_tid() { int t = threadIdx.x; asm volatile("" : "+v"(t)); return t; }
DI int opaque_bid() { int t = __builtin_amdgcn_readfirstlane((int)blockIdx.x); asm volatile("" : "+s"(t)); return t; }
DI char* opaque_ptr(char* q) {
  unsigned lo = __builtin_amdgcn_readfirstlane((unsigned)(size_t)q), hi = __builtin_amdgcn_readfirstlane((unsigned)((size_t)q >> 32));
  asm volatile("" : "+s"(lo), "+s"(hi));
  typedef __attribute__((address_space(1))) char gchar_t;
  return (char*)(gchar_t*)(((size_t)hi << 32) | (size_t)lo);
}
template <class T> DI T* as_global(T* q) { typedef __attribute__((address_space(1))) T gT; return (T*)(gT*)q; }
#define GIN(i) as_global(p.in[i])
#define GOUT as_global(p.out)
DI int cond_of(int t) { return t < NPROMPT ? 0 : 1 + ((t - NPROMPT) >> 11); }
DI int kvrow_of_tok(int t) { return t < NPROMPT ? t : NPROMPT + ((t - NPROMPT) >> 11) * 2560 + 512 + ((t - NPROMPT) & 2047); }

template <int NI, class Epi>
DI void gemm_tile(const u16* __restrict__ A, int lda, const u16* __restrict__ Bt, int ldb, int K, int m0, int n0, u16* smem, Epi& epi) {
  constexpr int MI = 16 / NI;
  constexpr int WN = 8 / NI;
  const int tid = opaque_tid(), lane = tid & 63, wid = tid >> 6, l15 = lane & 15, g = lane >> 4;
  const int wm = wid / WN, wn = wid % WN;
  u16* sA = smem; u16* sB = smem + 128 * 64;
  f32x4 acc[MI][NI];
#pragma unroll
  for (int mi = 0; mi < MI; ++mi)
#pragma unroll
    for (int ni = 0; ni < NI; ++ni) { acc[mi][ni][0] = 0.f; acc[mi][ni][1] = 0.f; acc[mi][ni][2] = 0.f; acc[mi][ni][3] = 0.f; }
  const int lrow = tid >> 3, lkc = (tid & 7) * 8;
  const int wofs = lrow * 64 + (((tid & 7) ^ ((lrow >> 1) & 7)) * 8);
  const int rsw = (l15 >> 1) & 7;
  const int rofs0 = l15 * 64 + ((g ^ rsw) * 8), rofs1 = l15 * 64 + (((4 + g) ^ rsw) * 8);
  const u16* pa = A + (size_t)(m0 + lrow) * lda + lkc;
  const u16* pb = Bt + (size_t)(n0 + lrow) * ldb + lkc;
  u32x4 ra[2][4], rb[2][4];
  const int nk = K >> 6;
#pragma unroll
  for (int i = 0; i < 4; ++i) { ra[0][i] = *(const u32x4*)(pa + (size_t)i * 32 * lda); rb[0][i] = *(const u32x4*)(pb + (size_t)i * 32 * ldb); }
#pragma unroll
  for (int i = 0; i < 4; ++i) { ra[1][i] = *(const u32x4*)(pa + (size_t)i * 32 * lda + 64); rb[1][i] = *(const u32x4*)(pb + (size_t)i * 32 * ldb + 64); }
  for (int kt = 0; kt < nk; kt += 2) {
#pragma unroll
    for (int half = 0; half < 2; ++half) {
      __syncthreads();
#pragma unroll
      for (int i = 0; i < 4; ++i) { *(u32x4*)(sA + wofs + i * 32 * 64) = ra[half][i]; *(u32x4*)(sB + wofs + i * 32 * 64) = rb[half][i]; }
      __syncthreads();
      if (kt + half + 2 < nk) {
        const int ko = (kt + half + 2) * 64;
#pragma unroll
        for (int i = 0; i < 4; ++i) { ra[half][i] = *(const u32x4*)(pa + (size_t)i * 32 * lda + ko); rb[half][i] = *(const u32x4*)(pb + (size_t)i * 32 * ldb + ko); }
      }
#pragma unroll
      for (int ks = 0; ks < 2; ++ks) {
        const int ro = ks ? rofs1 : rofs0;
        bf16x8 af[MI], bfv[NI];
#pragma unroll
        for (int mi = 0; mi < MI; ++mi) af[mi] = ld8(sA + (wm * MI * 16 + mi * 16) * 64 + ro);
#pragma unroll
        for (int ni = 0; ni < NI; ++ni) bfv[ni] = ld8(sB + (wn * NI * 16 + ni * 16) * 64 + ro);
        __builtin_amdgcn_s_setprio(1);
#pragma unroll
        for (int mi = 0; mi < MI; ++mi)
#pragma unroll
          for (int ni = 0; ni < NI; ++ni) acc[mi][ni] = mma(bfv[ni], af[mi], acc[mi][ni]);
        __builtin_amdgcn_s_setprio(0);
      }
    }
  }
  epi.template run<MI, NI>(acc, m0 + wm * MI * 16, n0 + wn * NI * 16, l15, g);
}

template <class Epi>
DI void gemm_tile_wide(const u16* __restrict__ A, int lda, const u16* __restrict__ Bt, int ldb, int K, int m0, int n0, u16* smem, Epi& epi) {
  constexpr int MI = 4, NI = 8;
  const int tid = opaque_tid(), lane = tid & 63, wid = tid >> 6, l15 = lane & 15, g = lane >> 4;
  const int wm = wid >> 1, wn = wid & 1;
  u16* sA = smem; u16* sB = smem + 128 * 64;
  f32x4 acc[MI][NI];
#pragma unroll
  for (int mi = 0; mi < MI; ++mi)
#pragma unroll
    for (int ni = 0; ni < NI; ++ni) { acc[mi][ni][0] = 0.f; acc[mi][ni][1] = 0.f; acc[mi][ni][2] = 0.f; acc[mi][ni][3] = 0.f; }
  const int lrow = tid >> 3, lkc = (tid & 7) * 8;
  const int wofs = lrow * 64 + (((tid & 7) ^ ((lrow >> 1) & 7)) * 8);
  const int rsw = (l15 >> 1) & 7;
  const int rofs0 = l15 * 64 + ((g ^ rsw) * 8), rofs1 = l15 * 64 + (((4 + g) ^ rsw) * 8);
  const u16* pa = A + (size_t)(m0 + lrow) * lda + lkc;
  const u16* pb = Bt + (size_t)(n0 + lrow) * ldb + lkc;
  u32x4 ra[4], rb[8];
  const int nk = K >> 6;
#pragma unroll
  for (int i = 0; i < 4; ++i) ra[i] = *(const u32x4*)(pa + (size_t)i * 32 * lda);
#pragma unroll
  for (int i = 0; i < 8; ++i) rb[i] = *(const u32x4*)(pb + (size_t)i * 32 * ldb);
  for (int kt = 0; kt < nk; ++kt) {
    __syncthreads();
#pragma unroll
    for (int i = 0; i < 4; ++i) *(u32x4*)(sA + wofs + i * 32 * 64) = ra[i];
#pragma unroll
    for (int i = 0; i < 8; ++i) *(u32x4*)(sB + wofs + i * 32 * 64) = rb[i];
    __syncthreads();
    if (kt + 1 < nk) {
      const int ko = (kt + 1) * 64;
#pragma unroll
      for (int i = 0; i < 4; ++i) ra[i] = *(const u32x4*)(pa + (size_t)i * 32 * lda + ko);
#pragma unroll
      for (int i = 0; i < 8; ++i) rb[i] = *(const u32x4*)(pb + (size_t)i * 32 * ldb + ko);
    }
#pragma unroll
    for (int ks = 0; ks < 2; ++ks) {
      const int ro = ks ? rofs1 : rofs0;
      bf16x8 af[MI];
#pragma unroll
      for (int mi = 0; mi < MI; ++mi) af[mi] = ld8(sA + (wm * 64 + mi * 16) * 64 + ro);
#pragma unroll
      for (int nh = 0; nh < 2; ++nh) {
        bf16x8 bfv[4];
#pragma unroll
        for (int ni = 0; ni < 4; ++ni) bfv[ni] = ld8(sB + (wn * 128 + (nh * 4 + ni) * 16) * 64 + ro);
        __builtin_amdgcn_s_setprio(1);
#pragma unroll
        for (int mi = 0; mi < MI; ++mi)
#pragma unroll
          for (int ni = 0; ni < 4; ++ni) acc[mi][nh * 4 + ni] = mma(bfv[ni], af[mi], acc[mi][nh * 4 + ni]);
        __builtin_amdgcn_s_setprio(0);
        __builtin_amdgcn_sched_barrier(0);
      }
    }
  }
  epi.template run<MI, NI>(acc, m0 + wm * 64, n0 + wn * 128, l15, g);
}

struct EpiResid {
  const float* xin; float* xout; const float* gate;
  template <int MI, int NI> DI void run(f32x4 (&acc)[MI][NI], int mr, int nc, int l15, int g) {
#pragma unroll
    for (int mi = 0; mi < MI; ++mi)
#pragma unroll
      for (int ni = 0; ni < NI; ++ni) {
        const int m = mr + mi * 16 + l15, n = nc + ni * 16 + g * 4;
        const float4 xi = *(const float4*)(xin + (size_t)m * 1024 + n);
        const float4 gt = *(const float4*)(gate + n);
        float4 o; o.x = xi.x + gt.x * acc[mi][ni][0]; o.y = xi.y + gt.y * acc[mi][ni][1]; o.z = xi.z + gt.z * acc[mi][ni][2]; o.w = xi.w + gt.w * acc[mi][ni][3];
        *(float4*)(xout + (size_t)m * 1024 + n) = o;
      }
  }
};
struct EpiGdnIn {
  u16* proj; float* gbuf;
  template <int MI, int NI> DI void run(f32x4 (&acc)[MI][NI], int mr, int nc, int l15, int g) {
#pragma unroll
    for (int mi = 0; mi < MI; ++mi)
#pragma unroll
      for (int ni = 0; ni < NI; ++ni) {
        const int m = mr + mi * 16 + l15, n = nc + ni * 16 + g * 4;
        if (n < 4096) st4bf(proj + (size_t)m * 4096 + n, acc[mi][ni][0], acc[mi][ni][1], acc[mi][ni][2], acc[mi][ni][3]);
        else if (n < 4128) { float4 o; o.x = acc[mi][ni][0]; o.y = acc[mi][ni][1]; o.z = acc[mi][ni][2]; o.w = acc[mi][ni][3]; *(float4*)(gbuf + (size_t)m * 32 + (n - 4096)) = o; }
      }
  }
};
struct EpiMlpIn {
  u16* abuf;
  template <int MI, int NI> DI void run(f32x4 (&acc)[MI][NI], int mr, int nc, int l15, int g) {
#pragma unroll
    for (int mi = 0; mi < MI; ++mi)
#pragma unroll
      for (int ni = 0; ni < NI; ++ni) {
        const int m = mr + mi * 16 + l15, n = nc + ni * 16 + g * 4;
        float a = fmaxf(acc[mi][ni][0], 0.f), b = fmaxf(acc[mi][ni][1], 0.f), c = fmaxf(acc[mi][ni][2], 0.f), d = fmaxf(acc[mi][ni][3], 0.f);
        st4bf(abuf + (size_t)m * 4096 + n, a * a, b * b, c * c, d * d);
      }
  }
};
struct EpiF32 {
  float* dst; int ld;
  template <int MI, int NI> DI void run(f32x4 (&acc)[MI][NI], int mr, int nc, int l15, int g) {
#pragma unroll
    for (int mi = 0; mi < MI; ++mi)
#pragma unroll
      for (int ni = 0; ni < NI; ++ni) {
        const int m = mr + mi * 16 + l15, n = nc + ni * 16 + g * 4;
        float4 o; o.x = acc[mi][ni][0]; o.y = acc[mi][ni][1]; o.z = acc[mi][ni][2]; o.w = acc[mi][ni][3];
        *(float4*)(dst + (size_t)m * ld + n) = o;
      }
  }
};

DI void rope128(f32x4 (&v)[8], int rowp, int colp, int g, const float* cosT, const float* sinT) {
#pragma unroll
  for (int hf = 0; hf < 2; ++hf) {
    const int pos = hf ? colp : rowp;
#pragma unroll
    for (int a = 0; a < 2; ++a) {
      const int n1 = hf * 4 + a, n2 = n1 + 2;
      const float4 cs = *(const float4*)(cosT + pos * 32 + a * 16 + g * 4);
      const float4 sn = *(const float4*)(sinT + pos * 32 + a * 16 + g * 4);
      const float c4[4] = {cs.x, cs.y, cs.z, cs.w}, s4[4] = {sn.x, sn.y, sn.z, sn.w};
#pragma unroll
      for (int j = 0; j < 4; ++j) { const float x1 = v[n1][j], x2 = v[n2][j]; v[n1][j] = x1 * c4[j] - x2 * s4[j]; v[n2][j] = x1 * s4[j] + x2 * c4[j]; }
    }
  }
}
DI void rope64(f32x4* v, int rowp, int colp, int g, const float* cosT, const float* sinT) {
#pragma unroll
  for (int hf = 0; hf < 2; ++hf) {
    const int pos = hf ? colp : rowp;
    const int n1 = hf * 2, n2 = n1 + 1;
    const float4 cs = *(const float4*)(cosT + pos * 16 + g * 4);
    const float4 sn = *(const float4*)(sinT + pos * 16 + g * 4);
    const float c4[4] = {cs.x, cs.y, cs.z, cs.w}, s4[4] = {sn.x, sn.y, sn.z, sn.w};
#pragma unroll
    for (int j = 0; j < 4; ++j) { const float x1 = v[n1][j], x2 = v[n2][j]; v[n1][j] = x1 * c4[j] - x2 * s4[j]; v[n2][j] = x1 * s4[j] + x2 * c4[j]; }
  }
}

struct EpiGqaIn {
  u16* Q; u16* Kb; u16* Vt; const float* qg; const float* kg; const float* cosT; const float* sinT; float* out;
  template <int MI, int NI> DI void run(f32x4 (&acc)[MI][NI], int mr, int nc, int l15, int g) {
    const int nt = nc >> 7;
#pragma unroll
    for (int mi = 0; mi < MI; ++mi) {
      const int m = mr + mi * 16 + l15;
      const bool prompt = m < NPROMPT;
      const int s = prompt ? (m & 255) : ((m - NPROMPT) & 2047);
      const int rowp = s >> 6, colp = s & 63;
      const int kvrow = kvrow_of_tok(m);
      if (nt < 10) {
        float ss = 0.f;
#pragma unroll
        for (int ni = 0; ni < NI; ++ni)
#pragma unroll
          for (int j = 0; j < 4; ++j) ss += acc[mi][ni][j] * acc[mi][ni][j];
        ss = sum_g(ss);
        const float rs = rsqrtf(ss * (1.f / 128.f) + EPS);
        const float* gn = nt < 8 ? qg : kg;
#pragma unroll
        for (int ni = 0; ni < NI; ++ni) {
          const float4 gv = *(const float4*)(gn + ni * 16 + g * 4);
          acc[mi][ni][0] *= rs * gv.x; acc[mi][ni][1] *= rs * gv.y; acc[mi][ni][2] *= rs * gv.z; acc[mi][ni][3] *= rs * gv.w;
        }
        if (nt >= 8 && prompt) {
#pragma unroll
          for (int ni = 0; ni < NI; ++ni) { float4 o; o.x = acc[mi][ni][0]; o.y = acc[mi][ni][1]; o.z = acc[mi][ni][2]; o.w = acc[mi][ni][3]; *(float4*)(out + O_GK + (size_t)m * 256 + (nt - 8) * 128 + ni * 16 + g * 4) = o; }
        }
        if (!prompt) rope128(acc[mi], rowp, colp, g, cosT, sinT);
        u16* dst = nt < 8 ? Q + (size_t)m * 1024 + nt * 128 : Kb + (size_t)kvrow * 256 + (nt - 8) * 128;
#pragma unroll
        for (int ni = 0; ni < NI; ++ni) st4bf(dst + ni * 16 + g * 4, acc[mi][ni][0], acc[mi][ni][1], acc[mi][ni][2], acc[mi][ni][3]);
      } else {
        const int kvh = nt - 10;
        if (prompt) {
#pragma unroll
          for (int ni = 0; ni < NI; ++ni) { float4 o; o.x = acc[mi][ni][0]; o.y = acc[mi][ni][1]; o.z = acc[mi][ni][2]; o.w = acc[mi][ni][3]; *(float4*)(out + O_GV + (size_t)m * 256 + kvh * 128 + ni * 16 + g * 4) = o; }
        }
        size_t base; int kvlen, pos;
        if (prompt) { base = (size_t)(m >> 8) * 256 * 256; kvlen = 256; pos = m & 255; }
        else { const int b = (m - NPROMPT) >> 11; base = (size_t)(NPROMPT + b * 2560) * 256; kvlen = 2560; pos = 512 + s; }
#pragma unroll
        for (int ni = 0; ni < NI; ++ni)
#pragma unroll
          for (int j = 0; j < 4; ++j) Vt[base + (size_t)(kvh * 128 + ni * 16 + g * 4 + j) * kvlen + pos] = f2bf(acc[mi][ni][j]);
      }
    }
  }
};
struct EpiMlaUq {
  u16* Q; const float* gnope; const float* grope; const float* cosT; const float* sinT;
  template <int MI, int NI> DI void run(f32x4 (&acc)[MI][NI], int mr, int nc, int l15, int g) {
    const int nt = nc >> 7;
#pragma unroll
    for (int mi = 0; mi < MI; ++mi) {
      const int m = mr + mi * 16 + l15;
      const bool prompt = m < NPROMPT;
      const int s = prompt ? (m & 255) : ((m - NPROMPT) & 2047);
      const int rowp = s >> 6, colp = s & 63;
      if (nt < 8) {
        float ss = 0.f;
#pragma unroll
        for (int ni = 0; ni < NI; ++ni)
#pragma unroll
          for (int j = 0; j < 4; ++j) ss += acc[mi][ni][j] * acc[mi][ni][j];
        ss = sum_g(ss);
        const float rs = rsqrtf(ss * (1.f / 128.f) + EPS);
#pragma unroll
        for (int ni = 0; ni < NI; ++ni) {
          const float4 gv = *(const float4*)(gnope + ni * 16 + g * 4);
          st4bf(Q + (size_t)m * 1536 + nt * 192 + ni * 16 + g * 4, acc[mi][ni][0] * rs * gv.x, acc[mi][ni][1] * rs * gv.y, acc[mi][ni][2] * rs * gv.z, acc[mi][ni][3] * rs * gv.w);
        }
      } else {
#pragma unroll
        for (int hh = 0; hh < 2; ++hh) {
          const int h = (nt - 8) * 2 + hh;
          float ss = 0.f;
#pragma unroll
          for (int ni = 0; ni < 4; ++ni)
#pragma unroll
            for (int j = 0; j < 4; ++j) ss += acc[mi][hh * 4 + ni][j] * acc[mi][hh * 4 + ni][j];
          ss = sum_g(ss);
          const float rs = rsqrtf(ss * (1.f / 64.f) + EPS);
#pragma unroll
          for (int ni = 0; ni < 4; ++ni) {
            const float4 gv = *(const float4*)(grope + ni * 16 + g * 4);
            acc[mi][hh * 4 + ni][0] *= rs * gv.x; acc[mi][hh * 4 + ni][1] *= rs * gv.y; acc[mi][hh * 4 + ni][2] *= rs * gv.z; acc[mi][hh * 4 + ni][3] *= rs * gv.w;
          }
          if (!prompt) rope64(&acc[mi][hh * 4], rowp, colp, g, cosT, sinT);
#pragma unroll
          for (int ni = 0; ni < 4; ++ni)
            st4bf(Q + (size_t)m * 1536 + h * 192 + 128 + ni * 16 + g * 4, acc[mi][hh * 4 + ni][0], acc[mi][hh * 4 + ni][1], acc[mi][hh * 4 + ni][2], acc[mi][hh * 4 + ni][3]);
        }
      }
    }
  }
};
struct EpiMlaUkv {
  u16* Kb; u16* Vt; const float* gnope;
  template <int MI, int NI> DI void run(f32x4 (&acc)[MI][NI], int mr, int nc, int l15, int g) {
    const int nt = nc >> 7, h = nt >> 1;
#pragma unroll
    for (int mi = 0; mi < MI; ++mi) {
      const int m = mr + mi * 16 + l15;
      if ((nt & 1) == 0) {
        float ss = 0.f;
#pragma unroll
        for (int ni = 0; ni < NI; ++ni)
#pragma unroll
          for (int j = 0; j < 4; ++j) ss += acc[mi][ni][j] * acc[mi][ni][j];
        ss = sum_g(ss);
        const float rs = rsqrtf(ss * (1.f / 128.f) + EPS);
#pragma unroll
        for (int ni = 0; ni < NI; ++ni) {
          const float4 gv = *(const float4*)(gnope + ni * 16 + g * 4);
          st4bf(Kb + (size_t)m * 1536 + h * 192 + ni * 16 + g * 4, acc[mi][ni][0] * rs * gv.x, acc[mi][ni][1] * rs * gv.y, acc[mi][ni][2] * rs * gv.z, acc[mi][ni][3] * rs * gv.w);
        }
      } else {
        size_t base; int kvlen, pos;
        if (m < NPROMPT) { base = (size_t)(m >> 8) * 256 * 1024; kvlen = 256; pos = m & 255; }
        else { const int r = m - NPROMPT; const int b = r / 2560; base = (size_t)(NPROMPT + b * 2560) * 1024; kvlen = 2560; pos = r - b * 2560; }
#pragma unroll
        for (int ni = 0; ni < NI; ++ni)
#pragma unroll
          for (int j = 0; j < 4; ++j) Vt[base + (size_t)(h * 128 + ni * 16 + g * 4 + j) * kvlen + pos] = f2bf(acc[mi][ni][j]);
      }
    }
  }
};

DI void convert_tile(const float* __restrict__ W, int K, int N, u16* __restrict__ Bt, int tile, int perm, float* sT) {
  const int nkt = K >> 6;
  const int kt = tile % nkt, nt = tile / nkt;
  const int k0 = kt * 64, n0 = nt * 64;
  const int tid = opaque_tid();
  __syncthreads();
  {
    const int n = tid & 63, kq = tid >> 6;
    int nd = n0 + n, ns = nd;
    if (perm == 1) { if (nd < 1024) ns = (nd >> 7) * 192 + (nd & 127); else { const int x = nd - 1024; ns = (x >> 6) * 192 + 128 + (x & 63); } }
    const bool ok = nd < N;
#pragma unroll
    for (int r = 0; r < 16; ++r) { const int k = r * 4 + kq; sT[k * 65 + n] = ok ? W[(size_t)(k0 + k) * N + ns] : 0.f; }
  }
  __syncthreads();
  {
    const int n = tid >> 2, kq = (tid & 3) * 16;
    u32x4 a, b;
#pragma unroll
    for (int e = 0; e < 4; ++e) { a[e] = pack2(sT[(kq + 2 * e) * 65 + n], sT[(kq + 2 * e + 1) * 65 + n]); b[e] = pack2(sT[(kq + 8 + 2 * e) * 65 + n], sT[(kq + 9 + 2 * e) * 65 + n]); }
    u16* dst = Bt + (size_t)(n0 + n) * K + k0 + kq;
    *(u32x4*)dst = a; *(u32x4*)(dst + 8) = b;
  }
}

DI void norm_rows(const P& p, int layer, bool from_input, int item, const float* gnorm, int shift_idx, int scale_idx) {
  const int tidn = opaque_tid();
  char* const ws = opaque_ptr(as_global(p.ws));
  const int lane = tidn & 63, wid = tidn >> 6;
  const int t = item * 4 + wid;
  const float* x = from_input ? (t < NPROMPT ? GIN(0) + (size_t)t * 1024 : GIN(1) + (size_t)(t - NPROMPT) * 1024) : GOUT + (size_t)t * 1024;
  const float* mods = (const float*)(ws + WS_MODS) + ((size_t)layer * 9 + cond_of(t)) * 6144;
  u16* h = (u16*)(ws + WS_HBUF) + (size_t)t * 1024;
  float4 v[4]; float ss = 0.f;
#pragma unroll
  for (int e = 0; e < 4; ++e) { v[e] = *(const float4*)(x + e * 256 + lane * 4); ss += v[e].x * v[e].x + v[e].y * v[e].y + v[e].z * v[e].z + v[e].w * v[e].w; }
  ss = wave_sum(ss);
  const float rs = rsqrtf(ss * (1.f / 1024.f) + EPS);
#pragma unroll
  for (int e = 0; e < 4; ++e) {
    const int c = e * 256 + lane * 4;
    const float4 gv = *(const float4*)(gnorm + c);
    const float4 sc = *(const float4*)(mods + scale_idx * 1024 + c);
    const float4 sh = *(const float4*)(mods + shift_idx * 1024 + c);
    st4bf(h + c, v[e].x * rs * gv.x * (1.f + sc.x) + sh.x, v[e].y * rs * gv.y * (1.f + sc.y) + sh.y, v[e].z * rs * gv.z * (1.f + sc.z) + sh.z, v[e].w * rs * gv.w * (1.f + sc.w) + sh.w);
  }
}

template <int DK, int HK>
DI void attn_phase(const u16* __restrict__ Q, const u16* __restrict__ Kb, const u16* __restrict__ Vt, u16* __restrict__ obuf, char* smem_raw) {
  const int bid = opaque_bid();
  constexpr int KS = DK / 32, KSTR = DK, QSTR = 8 * DK, KROW = HK * DK, GRP = 8 / HK;
  constexpr int CPR = DK / 8;
  constexpr int KCH = 64 * CPR / 256;
  u16* sK = (u16*)smem_raw;
  u16* sV = sK + 64 * KSTR;
  const int tid = opaque_tid(), lane = tid & 63, wid = tid >> 6, l15 = lane & 15, g = lane >> 4;
  const float sc = rsqrtf((float)DK) * 1.4426950408889634f;
  for (int item = bid; item < 1280; item += gridDim.x) {
    int qb, h, kvlen, tokbase, kvbase;
    if (item < 1024) { const int b = item >> 7, rem = item & 127; h = rem & 7; qb = rem >> 3; kvlen = 2560; tokbase = NPROMPT + b * 2048; kvbase = NPROMPT + b * 2560; }
    else { const int it2 = item - 1024; const int b = it2 >> 4, rem = it2 & 15; h = rem & 7; qb = rem >> 3; kvlen = 256; tokbase = b * 256; kvbase = b * 256; }
    const int kvh = h / GRP;
    const u16* Kp = Kb + (size_t)kvbase * KROW + kvh * DK;
    const u16* Vp = Vt + (size_t)kvbase * (HK * 128) + (size_t)kvh * 128 * kvlen;
    const int qrow0 = tokbase + qb * 128 + wid * 32;
    bf16x8 qf[2][KS];
#pragma unroll
    for (int qi = 0; qi < 2; ++qi)
#pragma unroll
      for (int ks = 0; ks < KS; ++ks) qf[qi][ks] = ld8(Q + (size_t)(qrow0 + qi * 16 + l15) * QSTR + h * DK + ks * 32 + g * 8);
    f32x4 ot[2][8];
#pragma unroll
    for (int qi = 0; qi < 2; ++qi)
#pragma unroll
      for (int dj = 0; dj < 8; ++dj) { ot[qi][dj][0] = 0.f; ot[qi][dj][1] = 0.f; ot[qi][dj][2] = 0.f; ot[qi][dj][3] = 0.f; }
    float mrun[2] = {-1e30f, -1e30f}, lrun[2] = {0.f, 0.f};
    const int ntiles = kvlen >> 6;
    const unsigned toffK = (unsigned)((tid >> 3) * KROW + (tid & 7) * 8), toffV = (unsigned)((tid >> 3) * kvlen + (tid & 7) * 8);
    const int kx = tid >> 3;
    const int kperm = ((kx >> 2) & 1) * 16 + (kx >> 3) * 4 + (kx & 3);
    const int kswz = (CPR == 16) ? (kperm & 15) : ((kperm >> 1) & 7);
    const int ldsoffK = kperm * KSTR;
    const int ldsoffV = (tid >> 3) * 64 + (((tid & 7) ^ (((tid >> 3) >> 1) & 7)) * 8);
    u32x4 rk[KCH], rv[4];
#pragma unroll
    for (int i = 0; i < KCH; ++i) { const int rh = i & 1, cgp = i >> 1; rk[i] = *(const u32x4*)(Kp + (size_t)(rh * 32 * KROW + cgp * 64) + toffK); }
#pragma unroll
    for (int i = 0; i < 4; ++i) rv[i] = *(const u32x4*)(Vp + (size_t)i * 32 * kvlen + toffV);
    for (int kt = 0; kt < ntiles; ++kt) {
      const u16* Kt = Kp + (size_t)(kt + 1) * 64 * KROW;
      const u16* Vtp = Vp + (kt + 1) * 64;
      const bool more = kt + 1 < ntiles;
      __syncthreads();
#pragma unroll
      for (int i = 0; i < KCH; ++i) { const int rh = i & 1, cgp = i >> 1; const int c = (tid & 7) + 8 * cgp; const int pos = (CPR == 16) ? (c ^ kswz) : ((c & ~7) | ((c & 7) ^ kswz)); *(u32x4*)(sK + ldsoffK + rh * 32 * KSTR + pos * 8) = rk[i]; }
#pragma unroll
      for (int i = 0; i < 4; ++i) *(u32x4*)(sV + ldsoffV + i * 32 * 64) = rv[i];
      __syncthreads();
      if (more) {
#pragma unroll
        for (int i = 0; i < KCH; ++i) { const int rh = i & 1, cgp = i >> 1; rk[i] = *(const u32x4*)(Kt + (size_t)(rh * 32 * KROW + cgp * 64) + toffK); }
      }
      __builtin_amdgcn_sched_barrier(0);
      f32x4 st[2][4];
#pragma unroll
      for (int qi = 0; qi < 2; ++qi)
#pragma unroll
        for (int kj = 0; kj < 4; ++kj) { st[qi][kj][0] = 0.f; st[qi][kj][1] = 0.f; st[qi][kj][2] = 0.f; st[qi][kj][3] = 0.f; }
#pragma unroll
      for (int ks = 0; ks < KS; ++ks) {
#pragma unroll
        for (int kj = 0; kj < 4; ++kj) {
          const int kc = ks * 4 + g;
          const int kpos = (CPR == 16) ? (kc ^ l15) : ((kc & ~7) | ((kc & 7) ^ ((l15 >> 1) & 7)));
          const bf16x8 ka = ld8(sK + (kj * 16 + l15) * KSTR + kpos * 8);
          __builtin_amdgcn_s_setprio(1);
          st[0][kj] = mma(ka, qf[0][ks], st[0][kj]);
          st[1][kj] = mma(ka, qf[1][ks], st[1][kj]);
          __builtin_amdgcn_s_setprio(0);
        }
        __builtin_amdgcn_sched_barrier(0);
      }
      bf16x8 pf[2][2];
#pragma unroll
      for (int qi = 0; qi < 2; ++qi) {
        float mx = -1e30f;
#pragma unroll
        for (int kj = 0; kj < 4; ++kj)
#pragma unroll
          for (int r = 0; r < 4; ++r) mx = fmaxf(mx, st[qi][kj][r]);
        mx = fmaxf(mx, __shfl_xor(mx, 16)); mx = fmaxf(mx, __shfl_xor(mx, 32));
        const float mnew = fmaxf(mrun[qi], mx);
        const float alpha = __builtin_amdgcn_exp2f((mrun[qi] - mnew) * sc);
        mrun[qi] = mnew;
        float ps = 0.f;
        const float mneg = -mnew * sc;
#pragma unroll
        for (int kj = 0; kj < 4; ++kj)
#pragma unroll
          for (int r = 0; r < 4; ++r) { const float pv = __builtin_amdgcn_exp2f(fmaf(st[qi][kj][r], sc, mneg)); st[qi][kj][r] = pv; ps += pv; }
        lrun[qi] = lrun[qi] * alpha + ps;
#pragma unroll
        for (int dj = 0; dj < 8; ++dj) { ot[qi][dj][0] *= alpha; ot[qi][dj][1] *= alpha; ot[qi][dj][2] *= alpha; ot[qi][dj][3] *= alpha; }
        pf[qi][0] = pack8(st[qi][0], st[qi][1]);
        pf[qi][1] = pack8(st[qi][2], st[qi][3]);
        __builtin_amdgcn_sched_barrier(0);
      }
      if (more) {
#pragma unroll
        for (int i = 0; i < 4; ++i) rv[i] = *(const u32x4*)(Vtp + (size_t)i * 32 * kvlen + toffV);
      }
      __builtin_amdgcn_sched_barrier(0);
#pragma unroll
      for (int kk = 0; kk < 2; ++kk)
#pragma unroll
        for (int dj = 0; dj < 8; ++dj) {
          const bf16x8 va = ld8(sV + (dj * 16 + l15) * 64 + (((kk * 4 + g) ^ ((l15 >> 1) & 7)) * 8));
          __builtin_amdgcn_s_setprio(1);
          ot[0][dj] = mma(va, pf[0][kk], ot[0][dj]);
          ot[1][dj] = mma(va, pf[1][kk], ot[1][dj]);
          __builtin_amdgcn_s_setprio(0);
          if ((dj & 3) == 3) __builtin_amdgcn_sched_barrier(0);
        }
    }
#pragma unroll
    for (int qi = 0; qi < 2; ++qi) {
      const float inv = 1.f / sum_g(lrun[qi]);
      u16* dst = obuf + (size_t)(qrow0 + qi * 16 + l15) * 1024 + h * 128 + g * 4;
#pragma unroll
      for (int dj = 0; dj < 8; ++dj) st4bf(dst + dj * 16, ot[qi][dj][0] * inv, ot[qi][dj][1] * inv, ot[qi][dj][2] * inv, ot[qi][dj][3] * inv);
    }
  }
}

DI void gdn_chunk_phase(const P& p, int j, char* smem_raw) {
  const int bid = opaque_bid();
  char* const ws = opaque_ptr(as_global(p.ws));
  u16* sK = (u16*)smem_raw;
  float* sA = (float*)(smem_raw + 17408);
  float* sG = (float*)(smem_raw + 17408 + 32768);
  float* sBt = sG + 128;
  const int tid = opaque_tid(), lane = tid & 63, wid = tid >> 6, l15 = lane & 15, g = lane >> 4;
  const u16* proj = (const u16*)(ws + WS_R + R_PROJ);
  u16* qn = (u16*)(ws + WS_HBUF); u16* kn = (u16*)(ws + WS_OBUF); u16* vb = (u16*)(ws + WS_R + R_VBUF);
  u16* Tbuf = (u16*)(ws + WS_R + R_TBUF);
  const float* gbuf = (const float*)(ws + WS_R + R_GBUF);
  float* gcb = (float*)(ws + WS_R + R_GCB); float* betab = (float*)(ws + WS_R + R_BETA);
  float* egb = (float*)(ws + WS_R + R_EG); float* edb = (float*)(ws + WS_R + R_ED);
  const float* conv = GIN(17) + (size_t)j * 3 * 3072;
  const float* a_log = GIN(18) + j * 16; const float* dt_bias = GIN(19) + j * 16;
  for (int unit = bid; unit < 2560; unit += gridDim.x) {
    const int cgi = unit >> 3, h = unit & 7;
    int c, nch; if (cgi < 64) { c = cgi & 3; nch = 4; } else { c = (cgi - 64) & 31; nch = 32; }
    const int t0 = cgi * 64;
    const bool has_prev = c > 0, has_next = c < nch - 1;
    __syncthreads();
    {
      const int r = tid >> 4, cc = (tid & 15) * 8;
#pragma unroll
      for (int part = 0; part < 3; ++part) {
        const int ch = part * 1024 + h * 128 + cc;
        float w0[8], w1[8], w2[8];
#pragma unroll
        for (int e = 0; e < 8; ++e) { w0[e] = conv[ch + e]; w1[e] = conv[3072 + ch + e]; w2[e] = conv[6144 + ch + e]; }
        u16* dstb = part == 0 ? qn : (part == 1 ? kn : vb);
        for (int it = 0; it < 4; ++it) {
          const int i = it * 16 + r, t = t0 + i;
          const u16* src = proj + (size_t)t * 4096 + ch;
          const u32x4 xc = *(const u32x4*)src;
          u32x4 xp = {0u, 0u, 0u, 0u}, xn = {0u, 0u, 0u, 0u};
          if (i > 0 || has_prev) xp = *(const u32x4*)(src - 4096);
          if (i < 63 || has_next) xn = *(const u32x4*)(src + 4096);
          float y[8];
#pragma unroll
          for (int e = 0; e < 4; ++e) {
            float a = w0[2 * e] * bflo(xp[e]) + w1[2 * e] * bflo(xc[e]) + w2[2 * e] * bflo(xn[e]);
            float b = w0[2 * e + 1] * bfhi(xp[e]) + w1[2 * e + 1] * bfhi(xc[e]) + w2[2 * e + 1] * bfhi(xn[e]);
            y[2 * e] = a / (1.f + __expf(-a)); y[2 * e + 1] = b / (1.f + __expf(-b));
          }
          if (part < 2) {
            float ss = 0.f;
#pragma unroll
            for (int e = 0; e < 8; ++e) ss += y[e] * y[e];
            ss += __shfl_xor(ss, 1); ss += __shfl_xor(ss, 2); ss += __shfl_xor(ss, 4); ss += __shfl_xor(ss, 8);
            const float rs = rsqrtf(ss + EPS) * (part == 0 ? 0.08838834764831845f : 1.f);
#pragma unroll
            for (int e = 0; e < 8; ++e) y[e] *= rs;
          }
          u32x4 o; o[0] = pack2(y[0], y[1]); o[1] = pack2(y[2], y[3]); o[2] = pack2(y[4], y[5]); o[3] = pack2(y[6], y[7]);
          *(u32x4*)(dstb + (size_t)t * 1024 + h * 128 + cc) = o;
          if (part == 1) *(u32x4*)(sK + i * 136 + cc) = o;
        }
      }
    }
    if (tid < 128) {
      const int dir = tid >> 6, L = tid & 63;
      const int i = dir ? 63 - L : L;
      const float* gb = gbuf + (size_t)(t0 + i) * 32;
      const float gin = gb[dir * 8 + h], bin = gb[16 + dir * 8 + h];
      const float x = gin + dt_bias[dir * 8 + h];
      const float sp = fmaxf(x, 0.f) + log1pf(expf(-fabsf(x)));
      float gv = -expf(a_log[dir * 8 + h]) * sp;
      const float bt = 1.f / (1.f + expf(-bin));
#pragma unroll
      for (int off = 1; off < 64; off <<= 1) { const float v = __shfl_up(gv, off); if (L >= off) gv += v; }
      sG[dir * 64 + i] = gv; sBt[dir * 64 + i] = bt;
      gcb[((size_t)(t0 + i) * 8 + h) * 2 + dir] = gv; betab[((size_t)(t0 + i) * 8 + h) * 2 + dir] = bt;
      { const float gtot = __shfl(gv, 63); egb[((size_t)(t0 + i) * 8 + h) * 2 + dir] = expf(gv); edb[((size_t)(t0 + i) * 8 + h) * 2 + dir] = expf(gtot - gv); }
    }
    __syncthreads();
    {
      f32x4 ga[4];
#pragma unroll
      for (int mt = 0; mt < 4; ++mt) { ga[mt][0] = 0.f; ga[mt][1] = 0.f; ga[mt][2] = 0.f; ga[mt][3] = 0.f; }
#pragma unroll
      for (int ks = 0; ks < 4; ++ks) {
        const bf16x8 a = ld8(sK + (wid * 16 + l15) * 136 + ks * 32 + g * 8);
#pragma unroll
        for (int mt = 0; mt < 4; ++mt) { const bf16x8 b = ld8(sK + (mt * 16 + l15) * 136 + ks * 32 + g * 8); ga[mt] = mma(a, b, ga[mt]); }
      }
#pragma unroll
      for (int dir = 0; dir < 2; ++dir)
#pragma unroll
        for (int mt = 0; mt < 4; ++mt)
#pragma unroll
          for (int r = 0; r < 4; ++r) {
            const int i = wid * 16 + g * 4 + r, m = mt * 16 + l15;
            const bool valid = dir ? (i < m) : (i > m);
            const float val = valid ? sBt[dir * 64 + i] * ga[mt][r] * __expf(sG[dir * 64 + i] - sG[dir * 64 + m]) : 0.f;
            const int ii = dir ? 63 - i : i, mm = dir ? 63 - m : m;
            sA[dir * 4096 + ii * 64 + mm] = val;
          }
    }
    __syncthreads();
    if (wid < 2) {
      const int dir = wid;
      float* Am = sA + dir * 4096;
      for (int i = 0; i < 64; ++i) {
        float a = (i == lane) ? 1.f : 0.f;
        int m = 0;
        for (; m + 8 <= i; m += 8) {
          const float4 a0 = *(const float4*)(Am + i * 64 + m), a1 = *(const float4*)(Am + i * 64 + m + 4);
          float tv[8];
#pragma unroll
          for (int e = 0; e < 8; ++e) tv[e] = Am[(m + e) * 64 + lane];
          a -= a0.x * tv[0]; a -= a0.y * tv[1]; a -= a0.z * tv[2]; a -= a0.w * tv[3];
          a -= a1.x * tv[4]; a -= a1.y * tv[5]; a -= a1.z * tv[6]; a -= a1.w * tv[7];
        }
        for (; m < i; ++m) a -= Am[i * 64 + m] * Am[m * 64 + lane];
        Am[i * 64 + lane] = a;
      }
      const int mn = dir ? 63 - lane : lane;
      const float bm = sBt[dir * 64 + mn];
      u16* Td = Tbuf + ((size_t)unit * 2 + dir) * 4096;
#pragma unroll 4
      for (int i = 0; i < 64; ++i) { const int in_ = dir ? 63 - i : i; Td[in_ * 64 + mn] = f2bf(Am[i * 64 + lane] * bm); }
    }
  }
}

DI void gdn_scan_phase(const P& p, int j, char* smem_raw) {
  const int bid = opaque_bid();
  char* const ws = opaque_ptr(as_global(p.ws));
  u16* sK = (u16*)smem_raw;
  u16* sKT = sK + 64 * 136;
  u16* sVT = sKT + 128 * 72;
  u16* sST = sVT + 32 * 72;
  u16* sVN = sST + 32 * 136;
  u16* sVD = sVN + 32 * 72;
  float* sGc = (float*)(sVD + 32 * 72);
  float* sE = sGc + 64;
  float* sD = sE + 64;
  const int tid = opaque_tid(), lane = tid & 63, w = tid >> 6, l15 = lane & 15, g = lane >> 4;
  const u16* qn = (const u16*)(ws + WS_HBUF); const u16* kn = (const u16*)(ws + WS_OBUF); const u16* vb = (const u16*)(ws + WS_R + R_VBUF);
  const u16* Tbuf = (const u16*)(ws + WS_R + R_TBUF);
  const float* gcb = (const float*)(ws + WS_R + R_GCB);
  const float* egb = (const float*)(ws + WS_R + R_EG); const float* edb = (const float*)(ws + WS_R + R_ED);
  u16* obase = (u16*)(ws + WS_R + R_PROJ);
  for (int wk = bid; wk < 1536; wk += gridDim.x) {
    int seq, rem;
    if (wk < 512) { seq = 16 + (wk >> 6); rem = wk & 63; } else { seq = (wk - 512) >> 6; rem = (wk - 512) & 63; }
    const int h = rem & 7, dir = (rem >> 5) & 1, dvq = (rem >> 3) & 3;
    const int nch = seq < 16 ? 4 : 32;
    const int cgb = seq < 16 ? seq * 4 : 64 + (seq - 16) * 32;
    f32x4 S[2][2];
    if (seq >= 16) {
      const float* s0 = GIN(2 + dir) + (((size_t)(seq - 16) * 2 + j) * 8 + h) * 16384;
#pragma unroll
      for (int dt = 0; dt < 2; ++dt)
#pragma unroll
        for (int et = 0; et < 2; ++et)
#pragma unroll
          for (int r = 0; r < 4; ++r) S[dt][et][r] = s0[(size_t)(w * 32 + dt * 16 + g * 4 + r) * 128 + dvq * 32 + et * 16 + l15];
    } else {
#pragma unroll
      for (int dt = 0; dt < 2; ++dt)
#pragma unroll
        for (int et = 0; et < 2; ++et) { S[dt][et][0] = 0.f; S[dt][et][1] = 0.f; S[dt][et][2] = 0.f; S[dt][et][3] = 0.f; }
    }
    __syncthreads();
#pragma unroll
    for (int dt = 0; dt < 2; ++dt)
#pragma unroll
      for (int et = 0; et < 2; ++et) st4bf(sST + (et * 16 + l15) * 136 + w * 32 + dt * 16 + g * 4, S[dt][et][0], S[dt][et][1], S[dt][et][2], S[dt][et][3]);
    u32x4 pk[4], pv; bf16x8 pt[2]; float pg = 0.f, pe = 0.f, pd = 0.f;
#define SCAN_PREFETCH(cc) do { \
      const int t0n_ = (cgb + (cc)) * 64; const int unitn_ = (cgb + (cc)) * 8 + h; \
      _Pragma("unroll") for (int i = 0; i < 4; ++i) { const int row = tid & 63, dc = ((tid >> 6) + 4 * i) * 8; pk[i] = *(const u32x4*)(kn + (size_t)(t0n_ + row) * 1024 + h * 128 + dc); } \
      { const int row = tid & 63, ec = (tid >> 6) * 8; pv = *(const u32x4*)(vb + (size_t)(t0n_ + row) * 1024 + h * 128 + dvq * 32 + ec); } \
      if (tid < 64) { const size_t gi_ = ((size_t)(t0n_ + tid) * 8 + h) * 2 + dir; pg = gcb[gi_]; pe = egb[gi_]; pd = edb[gi_]; } \
      _Pragma("unroll") for (int ks = 0; ks < 2; ++ks) pt[ks] = ld8(Tbuf + ((size_t)unitn_ * 2 + dir) * 4096 + (w * 16 + l15) * 64 + ks * 32 + g * 8); \
    } while (0)
    SCAN_PREFETCH(dir ? nch - 1 : 0);
    for (int step = 0; step < nch; ++step) {
      const int c = dir ? nch - 1 - step : step;
      const int t0 = (cgb + c) * 64;
      const int unit = (cgb + c) * 8 + h;
#pragma unroll
      for (int i = 0; i < 4; ++i) {
        const int row = tid & 63, dc = ((tid >> 6) + 4 * i) * 8;
        const u32x4 v = pk[i];
        *(u32x4*)(sK + row * 136 + dc) = v;
#pragma unroll
        for (int e = 0; e < 4; ++e) { sKT[(dc + 2 * e) * 72 + row] = (u16)(v[e] & 0xffffu); sKT[(dc + 2 * e + 1) * 72 + row] = (u16)(v[e] >> 16); }
      }
      {
        const int row = tid & 63, ec = (tid >> 6) * 8;
        const u32x4 v = pv;
#pragma unroll
        for (int e = 0; e < 4; ++e) { sVT[(ec + 2 * e) * 72 + row] = (u16)(v[e] & 0xffffu); sVT[(ec + 2 * e + 1) * 72 + row] = (u16)(v[e] >> 16); }
      }
      if (tid < 64) { sGc[tid] = pg; sE[tid] = pe; sD[tid] = pd; }
      bf16x8 qf[4], tf[2];
#pragma unroll
      for (int ks = 0; ks < 4; ++ks) qf[ks] = ld8(qn + (size_t)(t0 + w * 16 + l15) * 1024 + h * 128 + ks * 32 + g * 8);
#pragma unroll
      for (int ks = 0; ks < 2; ++ks) tf[ks] = pt[ks];
      __syncthreads();
      if (step + 1 < nch) { const int cn = dir ? nch - 2 - step : step + 1; SCAN_PREFETCH(cn); }
      const float gl = dir ? sGc[0] : sGc[63];
      bf16x8 wf[4];
      f32x4 ua[2];
      {
        bf16x8 vtf[2][2], ktf[4][2];
        f32x4 egm[2][2];
#pragma unroll
        for (int et = 0; et < 2; ++et)
#pragma unroll
          for (int ks = 0; ks < 2; ++ks) vtf[et][ks] = ld8(sVT + (et * 16 + l15) * 72 + ks * 32 + g * 8);
#pragma unroll
        for (int ks = 0; ks < 2; ++ks) { egm[ks][0] = *(const f32x4*)(sE + ks * 32 + g * 8); egm[ks][1] = *(const f32x4*)(sE + ks * 32 + g * 8 + 4); }
#pragma unroll
        for (int dt = 0; dt < 4; ++dt)
#pragma unroll
          for (int ks = 0; ks < 2; ++ks) ktf[dt][ks] = ld8(sKT + (dt * 16 + l15) * 72 + ks * 32 + g * 8);
        __builtin_amdgcn_sched_barrier(0);
#pragma unroll
        for (int et = 0; et < 2; ++et) {
          ua[et][0] = 0.f; ua[et][1] = 0.f; ua[et][2] = 0.f; ua[et][3] = 0.f;
#pragma unroll
          for (int ks = 0; ks < 2; ++ks) ua[et] = mma(tf[ks], vtf[et][ks], ua[et]);
        }
#pragma unroll
        for (int ks = 0; ks < 2; ++ks) {
          const u32x4 tw = __builtin_bit_cast(u32x4, tf[ks]);
          u32x4 o;
#pragma unroll
          for (int e = 0; e < 4; ++e) o[e] = pack2(bflo(tw[e]) * egm[ks][e >> 1][(2 * e) & 3], bfhi(tw[e]) * egm[ks][e >> 1][(2 * e + 1) & 3]);
          tf[ks] = __builtin_bit_cast(bf16x8, o);
        }
#pragma unroll
        for (int kq = 0; kq < 2; ++kq) {
          f32x4 wa[2];
#pragma unroll
          for (int hh = 0; hh < 2; ++hh) {
            wa[hh][0] = 0.f; wa[hh][1] = 0.f; wa[hh][2] = 0.f; wa[hh][3] = 0.f;
#pragma unroll
            for (int ks = 0; ks < 2; ++ks) wa[hh] = mma(ktf[kq * 2 + hh][ks], tf[ks], wa[hh]);
          }
          wf[kq] = pack8(wa[0], wa[1]);
        }
        __builtin_amdgcn_sched_barrier(0);
      }
      {
        bf16x8 ktf[4][2];
#pragma unroll
        for (int dt = 0; dt < 4; ++dt)
#pragma unroll
          for (int ks = 0; ks < 2; ++ks) ktf[dt][ks] = ld8(sKT + ((4 + dt) * 16 + l15) * 72 + ks * 32 + g * 8);
        __builtin_amdgcn_sched_barrier(0);
#pragma unroll
        for (int kq = 2; kq < 4; ++kq) {
          f32x4 wa[2];
#pragma unroll
          for (int hh = 0; hh < 2; ++hh) {
            wa[hh][0] = 0.f; wa[hh][1] = 0.f; wa[hh][2] = 0.f; wa[hh][3] = 0.f;
#pragma unroll
            for (int ks = 0; ks < 2; ++ks) wa[hh] = mma(ktf[(kq - 2) * 2 + hh][ks], tf[ks], wa[hh]);
          }
          wf[kq] = pack8(wa[0], wa[1]);
        }
        __builtin_amdgcn_sched_barrier(0);
      }
      const int iq = w * 16 + l15;
      const float gi = sGc[iq];
      const f32x4 dvec = *(const f32x4*)(sD + w * 16 + g * 4);
      f32x4 vn[2];
      bf16x8 qkf[2];
#pragma unroll
      for (int kk = 0; kk < 2; ++kk) {
        bf16x8 kf[2][4];
        f32x4 gcm[2];
#pragma unroll
        for (int hh = 0; hh < 2; ++hh)
#pragma unroll
          for (int ks = 0; ks < 4; ++ks) kf[hh][ks] = ld8(sK + ((kk * 2 + hh) * 16 + l15) * 136 + ks * 32 + g * 8);
#pragma unroll
        for (int hh = 0; hh < 2; ++hh) gcm[hh] = *(const f32x4*)(sGc + (kk * 2 + hh) * 16 + g * 4);
        bf16x8 stp[2][4];
        if (kk == 0) {
#pragma unroll
          for (int et = 0; et < 2; ++et)
#pragma unroll
            for (int kq = 0; kq < 4; ++kq) { const u16* sp = sST + (et * 16 + l15) * 136 + kq * 32 + g * 4; stp[et][kq] = ld44(sp, sp + 16); }
        }
        __builtin_amdgcn_sched_barrier(0);
        if (kk == 0) {
#pragma unroll
          for (int et = 0; et < 2; ++et) {
            f32x4 a; a[0] = 0.f; a[1] = 0.f; a[2] = 0.f; a[3] = 0.f;
#pragma unroll
            for (int kq = 0; kq < 4; ++kq) a = mma(wf[kq], stp[et][kq], a);
            vn[et][0] = ua[et][0] - a[0]; vn[et][1] = ua[et][1] - a[1]; vn[et][2] = ua[et][2] - a[2]; vn[et][3] = ua[et][3] - a[3];
          }
        }
        f32x4 ka[2];
#pragma unroll
        for (int hh = 0; hh < 2; ++hh) {
          const int mt = kk * 2 + hh;
          ka[hh][0] = 0.f; ka[hh][1] = 0.f; ka[hh][2] = 0.f; ka[hh][3] = 0.f;
#pragma unroll
          for (int ks = 0; ks < 4; ++ks) ka[hh] = mma(kf[hh][ks], qf[ks], ka[hh]);
#pragma unroll
          for (int r = 0; r < 4; ++r) {
            const int m = mt * 16 + g * 4 + r;
            const bool valid = dir ? (iq <= m) : (iq >= m);
            ka[hh][r] = ka[hh][r] * __expf(valid ? gi - gcm[hh][r] : -1e30f);
          }
        }
        qkf[kk] = pack8(ka[0], ka[1]);
        __builtin_amdgcn_sched_barrier(0);
      }
#pragma unroll
      for (int et = 0; et < 2; ++et) {
        const int i0 = w * 16 + g * 4;
        st4bf(sVN + (et * 16 + l15) * 72 + i0, vn[et][0], vn[et][1], vn[et][2], vn[et][3]);
        st4bf(sVD + (et * 16 + l15) * 72 + i0, vn[et][0] * dvec[0], vn[et][1] * dvec[1], vn[et][2] * dvec[2], vn[et][3] * dvec[3]);
      }
      __syncthreads();
      {
        bf16x8 stn[2][4], vnp[2][2];
#pragma unroll
        for (int et = 0; et < 2; ++et)
#pragma unroll
          for (int ks = 0; ks < 4; ++ks) stn[et][ks] = ld8(sST + (et * 16 + l15) * 136 + ks * 32 + g * 8);
#pragma unroll
        for (int et = 0; et < 2; ++et)
#pragma unroll
          for (int kk = 0; kk < 2; ++kk) { const u16* sp = sVN + (et * 16 + l15) * 72 + kk * 32 + g * 4; vnp[et][kk] = ld44(sp, sp + 16); }
        const f32x4 egi = *(const f32x4*)(sE + w * 16 + g * 4);
        __builtin_amdgcn_sched_barrier(0);
#pragma unroll
        for (int et = 0; et < 2; ++et) {
          f32x4 a1; a1[0] = 0.f; a1[1] = 0.f; a1[2] = 0.f; a1[3] = 0.f;
#pragma unroll
          for (int ks = 0; ks < 4; ++ks) a1 = mma(qf[ks], stn[et][ks], a1);
          f32x4 a2; a2[0] = 0.f; a2[1] = 0.f; a2[2] = 0.f; a2[3] = 0.f;
#pragma unroll
          for (int kk = 0; kk < 2; ++kk) a2 = mma(qkf[kk], vnp[et][kk], a2);
#pragma unroll
          for (int r = 0; r < 4; ++r) {
            const int i = w * 16 + g * 4 + r;
            const float o = a1[r] * egi[r] + a2[r];
            obase[(size_t)(t0 + i) * 4096 + dir * 1024 + h * 128 + dvq * 32 + et * 16 + l15] = f2bf(o);
          }
        }
        __builtin_amdgcn_sched_barrier(0);
      }
      {
        bf16x8 ktf2[2][2], vdf[2][2];
#pragma unroll
        for (int dt = 0; dt < 2; ++dt)
#pragma unroll
          for (int kk = 0; kk < 2; ++kk) { ktf2[dt][kk] = ld8(sKT + (w * 32 + dt * 16 + l15) * 72 + kk * 32 + g * 8); vdf[dt][kk] = ld8(sVD + (dt * 16 + l15) * 72 + kk * 32 + g * 8); }
        __builtin_amdgcn_sched_barrier(0);
        const float eg = __expf(gl);
#pragma unroll
        for (int dt = 0; dt < 2; ++dt)
#pragma unroll
          for (int et = 0; et < 2; ++et) {
            f32x4 a; a[0] = S[dt][et][0] * eg; a[1] = S[dt][et][1] * eg; a[2] = S[dt][et][2] * eg; a[3] = S[dt][et][3] * eg;
#pragma unroll
            for (int kk = 0; kk < 2; ++kk) a = mma(ktf2[dt][kk], vdf[et][kk], a);
            S[dt][et] = a;
          }
      }
      __syncthreads();
#pragma unroll
      for (int dt = 0; dt < 2; ++dt)
#pragma unroll
        for (int et = 0; et < 2; ++et) st4bf(sST + (et * 16 + l15) * 136 + w * 32 + dt * 16 + g * 4, S[dt][et][0], S[dt][et][1], S[dt][et][2], S[dt][et][3]);
    }
    if (seq < 16) {
      float* so = GOUT + (dir ? O_SB : O_SF) + (((size_t)seq * 2 + j) * 8 + h) * 16384;
#pragma unroll
      for (int dt = 0; dt < 2; ++dt)
#pragma unroll
        for (int et = 0; et < 2; ++et)
#pragma unroll
          for (int r = 0; r < 4; ++r) so[(size_t)(w * 32 + dt * 16 + g * 4 + r) * 128 + dvq * 32 + et * 16 + l15] = S[dt][et][r];
    }
  }
}

#define XB_TMO      128
#define XB_XCNT(j)  (256  + 64 * (j))
#define XB_XSUB(j)  (1280 + 64 * (j))
#define XB_XGEN(j)  (2304 + 64 * (j))
#define XB_TOP      3328
#define XB_TOPGEN   3392
#define XCD_BAR_WORDS 3456
#define XB_SPIN_CAP (1u << 20)
#define LAS __attribute__((address_space(3)))
DI unsigned xb_ld(unsigned* p)              { return __hip_atomic_load(p, __ATOMIC_RELAXED, __HIP_MEMORY_SCOPE_AGENT); }
DI unsigned xb_add(unsigned* p, unsigned v) { return __hip_atomic_fetch_add(p, v, __ATOMIC_RELAXED, __HIP_MEMORY_SCOPE_AGENT); }
DI unsigned xb_xcc_id() { return (unsigned)__builtin_amdgcn_s_getreg((3 << 11) | 20) & 0xFu; }
#define XB_SPIN(cond, bar) do { unsigned _sp = 0; while (cond) { __builtin_amdgcn_s_sleep(1); \
    if ((++_sp & 255u) == 0u) { if (xb_ld(&(bar)[XB_TMO])) break; if (_sp > XB_SPIN_CAP) { atomicAdd(&(bar)[XB_TMO], 1u); break; } } } } while (0)
struct XcdBarrier { unsigned* bar; unsigned x; volatile LAS unsigned* st; };
DI XcdBarrier xcd_barrier_post(unsigned* bar, volatile LAS unsigned* st) {
  XcdBarrier b; b.bar = bar; b.x = xb_xcc_id(); b.st = st;
  if (threadIdx.x == 0) (void)xb_add(&bar[XB_XCNT(b.x)], 1u);
  return b;
}
DI void xcd_barrier_complete(unsigned* bar, unsigned x, unsigned& nloc, unsigned& nx) {
  const unsigned Gn = gridDim.x * gridDim.y * gridDim.z;
  unsigned sum, cnt, mine, sp = 0u;
  for (;;) {
    sum = 0u; cnt = 0u; mine = 0u;
#pragma unroll
    for (unsigned j = 0; j < 16; ++j) { const unsigned c = xb_ld(&bar[XB_XCNT(j)]); sum += c; cnt += (c > 0u) ? 1u : 0u; mine = (j == x) ? c : mine; }
    if (sum == Gn) break;
    __builtin_amdgcn_s_sleep(1);
    if ((++sp & 255u) == 0u) { if (xb_ld(&bar[XB_TMO])) break; if (sp > XB_SPIN_CAP) { atomicAdd(&bar[XB_TMO], 1u); break; } }
  }
  nloc = mine > 0u ? mine : 1u; nx = cnt > 0u ? cnt : 1u;
}
DI void xcd_barrier(const XcdBarrier& b) {
  asm volatile("s_waitcnt vmcnt(0)" ::: "memory");
  __syncthreads();
  if (threadIdx.x == 0) {
    unsigned* bar = b.bar;
    __builtin_amdgcn_s_waitcnt(0);
    unsigned nloc = b.st[0], nx = b.st[1];
    if (nloc == 0u) { xcd_barrier_complete(bar, b.x, nloc, nx); b.st[0] = nloc; b.st[1] = nx; }
    const unsigned old = xb_add(&bar[XB_XSUB(b.x)], 1u);
    const unsigned gen = old / nloc;
    if (old + 1u == (gen + 1u) * nloc) {
      __builtin_amdgcn_fence(__ATOMIC_RELEASE, "agent");
      asm volatile("s_waitcnt vmcnt(0)" ::: "memory");
      const unsigned og = xb_add(&bar[XB_TOP], 1u);
      const unsigned tg = og / nx;
      if (og + 1u == (tg + 1u) * nx) xb_add(&bar[XB_TOPGEN], 1u);
      else XB_SPIN(xb_ld(&bar[XB_TOPGEN]) == tg, bar);
      __builtin_amdgcn_fence(__ATOMIC_ACQUIRE, "agent");
      xb_add(&bar[XB_XGEN(b.x)], 1u);
      asm volatile("s_waitcnt vmcnt(0)" ::: "memory");
    } else {
      XB_SPIN(xb_ld(&bar[XB_XGEN(b.x)]) == gen, bar);
      __builtin_amdgcn_fence(__ATOMIC_ACQUIRE, "agent");
      asm volatile("s_waitcnt vmcnt(0)" ::: "memory");
    }
  }
  __syncthreads();
}

__global__ void __launch_bounds__(256, 2) fwd_megakernel(P p) {
  cg::grid_group grid = cg::this_grid();
  __shared__ __attribute__((aligned(16))) char smem[60416];
  const int tid = opaque_tid(), lane = tid & 63, wid = tid >> 6;
  const int G = gridDim.x;
  __shared__ uint4 xb_words;
  if (threadIdx.x == 0) xb_words = make_uint4(0u, 0u, 0u, 0u);
  __syncthreads();
  (void)xcd_barrier_post((unsigned*)(as_global(p.ws) + WS_BAR), (volatile LAS unsigned*)&xb_words);
#define GSYNC() do { XcdBarrier xb_; xb_.bar = (unsigned*)(opaque_ptr(as_global(p.ws)) + WS_BAR); xb_.x = xb_xcc_id(); xb_.st = (volatile LAS unsigned*)&xb_words; xcd_barrier(xb_); } while (0)
  const int bid0 = opaque_bid();
  {
  char* const ws0 = opaque_ptr(as_global(p.ws));
  float* mods = (float*)(ws0 + WS_MODS);
  float* ropeT = (float*)(ws0 + WS_ROPE);
  float* cosG = ropeT, *sinG = ropeT + 2048, *cosM = ropeT + 4096, *sinM = ropeT + 5120;

  {
    float* sc = (float*)smem;
    float* red = sc + 9 * 128;
    float* part = (float*)(ws0 + WS_R);
    for (int item = bid0; item < 3072; item += G) {
      const int ks = item & 7, cgp = (item >> 3) % 96, layer = item / 768;
      __syncthreads();
      for (int e = tid; e < 9 * 128; e += 256) {
        const int ci = e >> 7, k = ks * 128 + (e & 127);
        const float v = ci == 0 ? GIN(9)[k] : GIN(8)[(ci - 1) * 1024 + k];
        sc[e] = v / (1.f + expf(-v));
      }
      __syncthreads();
      const int col = tid & 63, kg = tid >> 6;
      const float* wp = GIN(12) + ((size_t)layer * 1024 + ks * 128 + kg * 32) * 6144 + cgp * 64 + col;
      float acc[9];
#pragma unroll
      for (int ci = 0; ci < 9; ++ci) acc[ci] = 0.f;
#pragma unroll 8
      for (int kk = 0; kk < 32; ++kk) {
        const float wv = wp[(size_t)kk * 6144];
#pragma unroll
        for (int ci = 0; ci < 9; ++ci) acc[ci] += sc[ci * 128 + kg * 32 + kk] * wv;
      }
#pragma unroll
      for (int ci = 0; ci < 9; ++ci) red[(kg * 64 + col) * 9 + ci] = acc[ci];
      __syncthreads();
      if (kg == 0) {
        const int n = cgp * 64 + col;
        const float bias = ks == 0 ? GIN(13)[(size_t)layer * 6144 + n] : 0.f;
#pragma unroll
        for (int ci = 0; ci < 9; ++ci) {
          const float s = red[col * 9 + ci] + red[(64 + col) * 9 + ci] + red[(128 + col) * 9 + ci] + red[(192 + col) * 9 + ci] + bias;
          part[(size_t)ks * 221184 + ((size_t)layer * 9 + ci) * 6144 + n] = s;
        }
      }
    }
    if (bid0 == G - 1) {
      for (int e = tid; e < 2048; e += 256) { const int pos = e >> 5, f = e & 31; const float fr = powf(10000.f, -(float)f / 32.f); const float a = (float)pos * fr; cosG[e] = cosf(a); sinG[e] = sinf(a); }
      for (int e = tid; e < 1024; e += 256) { const int pos = e >> 4, f = e & 15; const float fr = powf(10000.f, -(float)f / 16.f); const float a = (float)pos * fr; cosM[e] = cosf(a); sinM[e] = sinf(a); }
    }
  }
  if (gridDim.x == 0x7fffffffu) grid.sync();
  GSYNC();
  {
    const float* part = (const float*)(ws0 + WS_R);
    for (int e = bid0 * 256 + tid; e < 221184; e += G * 256) {
      float sacc = 0.f;
#pragma unroll
      for (int ks = 0; ks < 8; ++ks) sacc += part[(size_t)ks * 221184 + e];
      mods[e] = sacc;
    }
  }
  }
  GSYNC();

#pragma unroll 1
  for (int layer = 0; layer < 4; ++layer) {
    const int kind = layer % 3, j = layer / 3;
    const int bid = opaque_bid();
    char* const ws = opaque_ptr(as_global(p.ws));
    float* mods = (float*)(ws + WS_MODS);
    float* ropeT = (float*)(ws + WS_ROPE);
    float* cosG = ropeT, *sinG = ropeT + 2048, *cosM = ropeT + 4096, *sinM = ropeT + 5120;
    u16* hbuf = (u16*)(ws + WS_HBUF);
    u16* obuf = (u16*)(ws + WS_OBUF);
    u16* wmix = (u16*)(ws + WS_WMIX);
    u16* wmlp = (u16*)(ws + WS_WMLP);
    char* R = ws + WS_R;
    const float* lmods = mods + (size_t)layer * 9 * 6144;
    {
      for (int it = bid; it < 5120; it += G) norm_rows(p, layer, layer == 0, it, GIN(10) + layer * 1024, 0, 1);
      float* sT = (float*)smem;
      for (int it = bid; it < 2048; it += G) {
        if (it < 1024) convert_tile(GIN(14) + (size_t)layer * 1024 * 4096, 1024, 4096, wmlp, it, 0, sT);
        else convert_tile(GIN(15) + (size_t)layer * 4096 * 1024, 4096, 1024, wmlp + 4194304, it - 1024, 0, sT);
      }
      if (kind == 0) {
        for (int it = bid; it < 1056 + 256; it += G) {
          if (it < 1056) convert_tile(GIN(16) + (size_t)j * 1024 * 4128, 1024, 4128, wmix + WM_IN, it, 0, sT);
          else convert_tile(GIN(21) + (size_t)j * 1024 * 1024, 1024, 1024, wmix + WM_OUT, it - 1056, 0, sT);
        }
      } else if (kind == 1) {
        for (int it = bid; it < 192 + 144 + 128 + 256; it += G) {
          if (it < 192) convert_tile(GIN(22), 1024, 704, wmix + WM_IN, it, 0, sT);
          else if (it < 336) convert_tile(GIN(25), 384, 1536, wmix + WM_UQ, it - 192, 1, sT);
          else if (it < 464) convert_tile(GIN(26), 256, 2048, wmix + WM_UKV, it - 336, 0, sT);
          else convert_tile(GIN(31), 1024, 1024, wmix + WM_OUT, it - 464, 0, sT);
        }
      } else {
        for (int it = bid; it < 384 + 256; it += G) {
          if (it < 384) convert_tile(GIN(32), 1024, 1536, wmix + WM_IN, it, 0, sT);
          else convert_tile(GIN(35), 1024, 1024, wmix + WM_OUT, it - 384, 0, sT);
        }
        u16* Kg = (u16*)(R + R_KG); u16* Vg = (u16*)(R + R_VTG);
        const int tid = opaque_tid();
        for (int it = bid; it < 512; it += G) {
          const int b = it >> 6, s0 = (it & 63) * 8;
          const int ch = tid;
          float kv[8], vv[8];
#pragma unroll
          for (int e = 0; e < 8; ++e) { kv[e] = GIN(6)[((size_t)b * 512 + s0 + e) * 256 + ch]; vv[e] = GIN(7)[((size_t)b * 512 + s0 + e) * 256 + ch]; }
#pragma unroll
          for (int e = 0; e < 8; ++e) Kg[(size_t)(NPROMPT + b * 2560 + s0 + e) * 256 + ch] = f2bf(kv[e]);
          u32x4 o; o[0] = pack2(vv[0], vv[1]); o[1] = pack2(vv[2], vv[3]); o[2] = pack2(vv[4], vv[5]); o[3] = pack2(vv[6], vv[7]);
          *(u32x4*)(Vg + (size_t)(NPROMPT + b * 2560) * 256 + (size_t)ch * 2560 + s0) = o;
        }
      }
    }
    GSYNC();

    if (kind == 0) {
      {
        EpiGdnIn epi; epi.proj = (u16*)(R + R_PROJ); epi.gbuf = (float*)(R + R_GBUF);
        for (int it = bid; it < 160 * 16; it += G) { const int mt = it >> 4, nt = it & 15; gemm_tile_wide(hbuf, 1024, wmix + WM_IN, 1024, 1024, mt * 128, nt * 256, (u16*)smem, epi); }
        for (int it = bid; it < 160; it += G) gemm_tile<4>(hbuf, 1024, wmix + WM_IN, 1024, 1024, it * 128, 4096, (u16*)smem, epi);
      }
      GSYNC();
      gdn_chunk_phase(p, j, smem);
      GSYNC();
      gdn_scan_phase(p, j, smem);
      GSYNC();
      {
        const u16* pr = (const u16*)(R + R_PROJ);
        const float* on = GIN(20) + j * 128;
        const int tid = opaque_tid();
        for (int t = bid; t < NTOK; t += G) {
          const int h = tid >> 5, c = (tid & 31) * 4;
          const u16* row = pr + (size_t)t * 4096;
          const u32x2 f = *(const u32x2*)(row + h * 128 + c), b = *(const u32x2*)(row + 1024 + h * 128 + c), z = *(const u32x2*)(row + 3072 + h * 128 + c);
          float o[4] = {bflo(f[0]) + bflo(b[0]), bfhi(f[0]) + bfhi(b[0]), bflo(f[1]) + bflo(b[1]), bfhi(f[1]) + bfhi(b[1])};
          float zz[4] = {bflo(z[0]), bfhi(z[0]), bflo(z[1]), bfhi(z[1])};
          float ss = o[0] * o[0] + o[1] * o[1] + o[2] * o[2] + o[3] * o[3];
          ss += __shfl_xor(ss, 1); ss += __shfl_xor(ss, 2); ss += __shfl_xor(ss, 4); ss += __shfl_xor(ss, 8); ss += __shfl_xor(ss, 16);
          const float rs = rsqrtf(ss * (1.f / 128.f) + EPS);
          const float4 gn = *(const float4*)(on + c);
          const float gg[4] = {gn.x, gn.y, gn.z, gn.w};
          float y[4];
#pragma unroll
          for (int e = 0; e < 4; ++e) y[e] = o[e] * rs * gg[e] * (zz[e] / (1.f + __expf(-zz[e])));
          st4bf(obuf + (size_t)t * 1024 + h * 128 + c, y[0], y[1], y[2], y[3]);
        }
      }
      GSYNC();
    } else if (kind == 1) {
      {
        EpiF32 epi; epi.dst = (float*)(R + R_DPROJ); epi.ld = 768;
        for (int it = bid; it < 160 * 6; it += G) { const int mt = it / 6, nt = it % 6; gemm_tile<4>(hbuf, 1024, wmix + WM_IN, 1024, 1024, mt * 128, nt * 128, (u16*)smem, epi); }
      }
      GSYNC();
      {
        const float* dproj = (const float*)(R + R_DPROJ);
        u16* cq = (u16*)(R + R_CQ); u16* ckv = (u16*)(R + R_CKV); u16* Km = (u16*)(R + R_KM);
        const int tid = opaque_tid(), lane = tid & 63, wid = tid >> 6;
        for (int it = bid; it < 6144; it += G) {
          const int row = it * 4 + wid;
          if (row < NTOK) {
            const int t = row;
            const float* pr = dproj + (size_t)t * 768;
            float v[6]; float ss = 0.f;
#pragma unroll
            for (int e = 0; e < 6; ++e) { v[e] = pr[lane + 64 * e]; ss += v[e] * v[e]; }
            ss = wave_sum(ss);
            float rs = rsqrtf(ss * (1.f / 384.f) + EPS);
#pragma unroll
            for (int e = 0; e < 6; ++e) cq[(size_t)t * 384 + lane + 64 * e] = f2bf(v[e] * rs * GIN(23)[lane + 64 * e]);
            const int kvrow = kvrow_of_tok(t);
            float wv[4]; ss = 0.f;
#pragma unroll
            for (int e = 0; e < 4; ++e) { wv[e] = pr[384 + lane + 64 * e]; ss += wv[e] * wv[e]; }
            ss = wave_sum(ss);
            rs = rsqrtf(ss * (1.f / 256.f) + EPS);
#pragma unroll
            for (int e = 0; e < 4; ++e) {
              const float o = wv[e] * rs * GIN(24)[lane + 64 * e];
              ckv[(size_t)kvrow * 256 + lane + 64 * e] = f2bf(o);
              if (t < NPROMPT) GOUT[O_CKV + (size_t)t * 256 + lane + 64 * e] = o;
            }
            const float x = pr[640 + lane];
            ss = wave_sum(x * x);
            float kr = x * rsqrtf(ss * (1.f / 64.f) + EPS) * GIN(30)[lane];
            if (t < NPROMPT) GOUT[O_KR + (size_t)t * 64 + lane] = kr;
            else {
              const int s = (t - NPROMPT) & 2047;
              const int pos = lane < 32 ? (s >> 6) : (s & 63);
              const float cs = cosM[pos * 16 + (lane & 15)], sn = sinM[pos * 16 + (lane & 15)];
              const float partner = __shfl_xor(kr, 16);
              kr = ((lane & 16) == 0) ? kr * cs - partner * sn : partner * sn + kr * cs;
            }
            const u16 kb = f2bf(kr);
#pragma unroll
            for (int hh = 0; hh < 8; ++hh) Km[(size_t)kvrow * 1536 + hh * 192 + 128 + lane] = kb;
          } else {
            const int r = row - NTOK; const int b = r >> 9, s = r & 511;
            const int kvrow = NPROMPT + b * 2560 + s;
#pragma unroll
            for (int e = 0; e < 4; ++e) ckv[(size_t)kvrow * 256 + lane + 64 * e] = f2bf(GIN(4)[((size_t)b * 512 + s) * 256 + lane + 64 * e]);
            const u16 kb = f2bf(GIN(5)[((size_t)b * 512 + s) * 64 + lane]);
#pragma unroll
            for (int hh = 0; hh < 8; ++hh) Km[(size_t)kvrow * 1536 + hh * 192 + 128 + lane] = kb;
          }
        }
      }
      GSYNC();
      {
        EpiMlaUq e1; e1.Q = (u16*)(R + R_Q); e1.gnope = GIN(27); e1.grope = GIN(28); e1.cosT = cosM; e1.sinT = sinM;
        for (int it = bid; it < 160 * 12; it += G) { const int mt = it / 12, nt = it % 12; gemm_tile<8>((const u16*)(R + R_CQ), 384, wmix + WM_UQ, 384, 384, mt * 128, nt * 128, (u16*)smem, e1); }
        EpiMlaUkv e2; e2.Kb = (u16*)(R + R_KM); e2.Vt = (u16*)(R + R_VTM); e2.gnope = GIN(29);
        for (int it = bid; it < 192 * 16; it += G) { const int mt = it / 16, nt = it % 16; gemm_tile<8>((const u16*)(R + R_CKV), 256, wmix + WM_UKV, 256, 256, mt * 128, nt * 128, (u16*)smem, e2); }
      }
      GSYNC();
      attn_phase<192, 8>((const u16*)(R + R_Q), (const u16*)(R + R_KM), (const u16*)(R + R_VTM), obuf, smem);
      GSYNC();
    } else {
      {
        EpiGqaIn epi; epi.Q = (u16*)(R + R_Q); epi.Kb = (u16*)(R + R_KG); epi.Vt = (u16*)(R + R_VTG); epi.qg = GIN(33); epi.kg = GIN(34); epi.cosT = cosG; epi.sinT = sinG; epi.out = GOUT;
        for (int it = bid; it < 160 * 12; it += G) { const int mt = it / 12, nt = it % 12; gemm_tile<8>(hbuf, 1024, wmix + WM_IN, 1024, 1024, mt * 128, nt * 128, (u16*)smem, epi); }
      }
      GSYNC();
      attn_phase<128, 2>((const u16*)(R + R_Q), (const u16*)(R + R_KG), (const u16*)(R + R_VTG), obuf, smem);
      GSYNC();
    }

    for (int it = bid; it < 160 * 8; it += G) {
      const int mt = it >> 3, nt = it & 7; const int m0 = mt * 128;
      EpiResid epi;
      epi.xin = (layer == 0) ? (m0 < NPROMPT ? GIN(0) : GIN(1) - (size_t)NPROMPT * 1024) : GOUT;
      epi.xout = GOUT; epi.gate = lmods + (size_t)cond_of(m0) * 6144 + 2 * 1024;
      gemm_tile<4>(obuf, 1024, wmix + WM_OUT, 1024, 1024, m0, nt * 128, (u16*)smem, epi);
    }
    GSYNC();
    for (int it = bid; it < 5120; it += G) norm_rows(p, layer, false, it, GIN(11) + layer * 1024, 3, 4);
    GSYNC();
    {
      EpiMlpIn epi; epi.abuf = (u16*)(R + R_ABUF);
      for (int it = bid; it < 160 * 16; it += G) { const int mt = it >> 4, nt = it & 15; gemm_tile_wide(hbuf, 1024, wmlp, 1024, 1024, mt * 128, nt * 256, (u16*)smem, epi); }
    }
    GSYNC();
    for (int it = bid; it < 160 * 8; it += G) {
      const int mt = it >> 3, nt = it & 7; const int m0 = mt * 128;
      EpiResid epi; epi.xin = GOUT; epi.xout = GOUT; epi.gate = lmods + (size_t)cond_of(m0) * 6144 + 5 * 1024;
      gemm_tile<4>((const u16*)(R + R_ABUF), 4096, wmlp + 4194304, 4096, 4096, m0, nt * 128, (u16*)smem, epi);
    }
    GSYNC();
  }
}

extern "C" void kernel_launch(void* const* d_in, const int* in_sizes, int n_in, void* d_out, int out_size, void* d_ws, size_t ws_size, hipStream_t stream) {
  static int grid_blocks = 0;
  if (!grid_blocks) {
    int dev = 0, cus = 0, per_cu = 0;
    hipGetDevice(&dev);
    hipDeviceGetAttribute(&cus, hipDeviceAttributeMultiprocessorCount, dev);
    hipOccupancyMaxActiveBlocksPerMultiprocessor(&per_cu, fwd_megakernel, 256, 0);
    if (per_cu < 1) per_cu = 1;
    if (per_cu > 2) per_cu = 2;
    grid_blocks = cus * per_cu;
  }
  P p{};
  for (int i = 0; i < 36; ++i) p.in[i] = (const float*)d_in[i];
  p.out = (float*)d_out;
  p.ws = (char*)d_ws;
  (void)hipMemsetAsync((char*)d_ws + WS_BAR, 0, XCD_BAR_WORDS * 4, stream);
  void* args[] = {&p};
  hipError_t e = hipLaunchCooperativeKernel((void*)fwd_megakernel, dim3(grid_blocks), dim3(256), args, 0, stream);
  if (e != hipSuccess) fprintf(stderr, "cooperative launch failed: %s (grid %d)\n", hipGetErrorString(e), grid_blocks);
}
```

```cpp
#include <hip/hip_runtime.h>
#include <hip/hip_cooperative_groups.h>
#include <cstdio>
namespace cg = cooperative_groups;

typedef unsigned short u16;
typedef __attribute__((ext_vector_type(8))) short bf16x8;
typedef __attribute__((ext_vector_type(4))) short bf16x4;
typedef __attribute__((ext_vector_type(4))) float f32x4;
typedef __attribute__((ext_vector_type(4))) unsigned u32x4;
typedef __attribute__((ext_vector_type(2))) unsigned u32x2;

#define DI __device__ __forceinline__

constexpr int NTOK = 20480;
constexpr int NPROMPT = 4096;
constexpr float EPS = 1e-6f;

constexpr size_t WS_MODS = 0;
constexpr size_t MODS_BYTES = 4ull * 9 * 6144 * 4;
constexpr size_t WS_BAR = 917504;
constexpr size_t WS_ROPE = 1048576;
constexpr size_t WS_WMIX = 1114112;
constexpr size_t WS_WMLP = 14090240;
constexpr size_t WS_HBUF = 30867456;
constexpr size_t WS_OBUF = 72810496;
constexpr size_t WS_R    = 114753536;
constexpr size_t R_ABUF = 0;
constexpr size_t R_PROJ = 0;
constexpr size_t R_VBUF = 167772160;
constexpr size_t R_TBUF = 209715200;
constexpr size_t R_GBUF = 251658240;
constexpr size_t R_GCB  = 254279680;
constexpr size_t R_BETA = 255590400;
constexpr size_t R_EG   = 256901120;
constexpr size_t R_ED   = 258211840;
constexpr size_t R_DPROJ = 0;
constexpr size_t R_Q    = 0;
constexpr size_t R_CQ   = 62914560;
constexpr size_t R_CKV  = 78643200;
constexpr size_t R_KM   = 91226112;
constexpr size_t R_VTM  = 166723584;
constexpr size_t R_KG   = 41943040;
constexpr size_t R_VTG  = 54525952;
constexpr size_t WM_IN = 0;
constexpr size_t WM_OUT = 4325376;
constexpr size_t WM_UQ = 5373952;
constexpr size_t WM_UKV = 5963776;
constexpr size_t O_SF = 20971520, O_SB = 25165824, O_CKV = 29360128, O_KR = 30408704, O_GK = 30670848, O_GV = 31719424;

struct P {
  const float* in[36];
  float* out;
  char* ws;
};

typedef __attribute__((ext_vector_type(2))) float f32x2_t;
typedef __attribute__((ext_vector_type(2))) __bf16 bf16x2_t;
DI u16 f2bf(float x) { return __builtin_bit_cast(u16, (__bf16)x); }
DI float bf2f(u16 h) { return __uint_as_float(((unsigned)h) << 16); }
DI unsigned pack2(float a, float b) { f32x2_t v; v[0] = a; v[1] = b; return __builtin_bit_cast(unsigned, __builtin_convertvector(v, bf16x2_t)); }
DI float bflo(unsigned w) { return __uint_as_float(w << 16); }
DI float bfhi(unsigned w) { return __uint_as_float(w & 0xffff0000u); }
DI f32x4 mma(bf16x8 a, bf16x8 b, f32x4 c) { return __builtin_amdgcn_mfma_f32_16x16x32_bf16(a, b, c, 0, 0, 0); }
DI bf16x8 pack8(f32x4 a, f32x4 b) {
  u32x4 p; p[0] = pack2(a[0], a[1]); p[1] = pack2(a[2], a[3]); p[2] = pack2(b[0], b[1]); p[3] = pack2(b[2], b[3]);
  return __builtin_bit_cast(bf16x8, p);
}
DI bf16x8 ld8(const u16* p) { return *(const bf16x8*)p; }
DI bf16x8 ld44(const u16* p0, const u16* p1) {
  u32x2 a = *(const u32x2*)p0; u32x2 b = *(const u32x2*)p1;
  u32x4 r; r[0] = a[0]; r[1] = a[1]; r[2] = b[0]; r[3] = b[1];
  return __builtin_bit_cast(bf16x8, r);
}
DI void st4bf(u16* p, float a, float b, float c, float d) { u32x2 v; v[0] = pack2(a, b); v[1] = pack2(c, d); *(u32x2*)p = v; }
DI float wave_sum(float v) {
  v += __shfl_xor(v, 1); v += __shfl_xor(v, 2); v += __shfl_xor(v, 4); v += __shfl_xor(v, 8); v += __shfl_xor(v, 16); v += __shfl_xor(v, 32);
  return v;
}
DI float sum_g(float v) { v += __shfl_xor(v, 16); v += __shfl_xor(v, 32); return v; }
DI int opaque_tid() { int t = threadIdx.x; asm volatile("" : "+v"(t)); return t; }
DI int opaque_bid() { int t = __builtin_amdgcn_readfirstlane((int)blockIdx.x); asm volatile("" : "+s"(t)); return t; }
DI char* opaque_ptr(char* q) {
  unsigned lo = __builtin_amdgcn_readfirstlane((unsigned)(size_t)q), hi = __builtin_amdgcn_readfirstlane((unsigned)((size_t)q >> 32));
  asm volatile("" : "+s"(lo), "+s"(hi));
  typedef __attribute__((address_space(1))) char gchar_t;
  return (char*)(gchar_t*)(((size_t)hi << 32) | (size_t)lo);
}
template <class T> DI T* as_global(T* q) { typedef __attribute__((address_space(1))) T gT; return (T*)(gT*)q; }
#define GIN(i) as_global(p.in[i])
#define GOUT as_global(p.out)
DI int cond_of(int t) { return t < NPROMPT ? 0 : 1 + ((t - NPROMPT) >> 11); }
DI int kvrow_of_tok(int t) { return t < NPROMPT ? t : NPROMPT + ((t - NPROMPT) >> 11) * 2560 + 512 + ((t - NPROMPT) & 2047); }

template <int NI, class Epi>
DI void gemm_tile(const u16* __restrict__ A, int lda, const u16* __restrict__ Bt, int ldb, int K, int m0, int n0, u16* smem, Epi& epi) {
  constexpr int MI = 16 / NI;
  constexpr int WN = 8 / NI;
  const int tid = opaque_tid(), lane = tid & 63, wid = tid >> 6, l15 = lane & 15, g = lane >> 4;
  const int wm = wid / WN, wn = wid % WN;
  u16* sA = smem; u16* sB = smem + 128 * 64;
  f32x4 acc[MI][NI];
#pragma unroll
  for (int mi = 0; mi < MI; ++mi)
#pragma unroll
    for (int ni = 0; ni < NI; ++ni) { acc[mi][ni][0] = 0.f; acc[mi][ni][1] = 0.f; acc[mi][ni][2] = 0.f; acc[mi][ni][3] = 0.f; }
  const int lrow = tid >> 3, lkc = (tid & 7) * 8;
  const int wofs = lrow * 64 + (((tid & 7) ^ ((lrow >> 1) & 7)) * 8);
  const int rsw = (l15 >> 1) & 7;
  const int rofs0 = l15 * 64 + ((g ^ rsw) * 8), rofs1 = l15 * 64 + (((4 + g) ^ rsw) * 8);
  const u16* pa = A + (size_t)(m0 + lrow) * lda + lkc;
  const u16* pb = Bt + (size_t)(n0 + lrow) * ldb + lkc;
  u32x4 ra[2][4], rb[2][4];
  const int nk = K >> 6;
#pragma unroll
  for (int i = 0; i < 4; ++i) { ra[0][i] = *(const u32x4*)(pa + (size_t)i * 32 * lda); rb[0][i] = *(const u32x4*)(pb + (size_t)i * 32 * ldb); }
#pragma unroll
  for (int i = 0; i < 4; ++i) { ra[1][i] = *(const u32x4*)(pa + (size_t)i * 32 * lda + 64); rb[1][i] = *(const u32x4*)(pb + (size_t)i * 32 * ldb + 64); }
  for (int kt = 0; kt < nk; kt += 2) {
#pragma unroll
    for (int half = 0; half < 2; ++half) {
      __syncthreads();
#pragma unroll
      for (int i = 0; i < 4; ++i) { *(u32x4*)(sA + wofs + i * 32 * 64) = ra[half][i]; *(u32x4*)(sB + wofs + i * 32 * 64) = rb[half][i]; }
      __syncthreads();
      if (kt + half + 2 < nk) {
        const int ko = (kt + half + 2) * 64;
#pragma unroll
        for (int i = 0; i < 4; ++i) { ra[half][i] = *(const u32x4*)(pa + (size_t)i * 32 * lda + ko); rb[half][i] = *(const u32x4*)(pb + (size_t)i * 32 * ldb + ko); }
      }
#pragma unroll
      for (int ks = 0; ks < 2; ++ks) {
        const int ro = ks ? rofs1 : rofs0;
        bf16x8 af[MI], bfv[NI];
#pragma unroll
        for (int mi = 0; mi < MI; ++mi) af[mi] = ld8(sA + (wm * MI * 16 + mi * 16) * 64 + ro);
#pragma unroll
        for (int ni = 0; ni < NI; ++ni) bfv[ni] = ld8(sB + (wn * NI * 16 + ni * 16) * 64 + ro);
        __builtin_amdgcn_s_setprio(1);
#pragma unroll
        for (int mi = 0; mi < MI; ++mi)
#pragma unroll
          for (int ni = 0; ni < NI; ++ni) acc[mi][ni] = mma(bfv[ni], af[mi], acc[mi][ni]);
        __builtin_amdgcn_s_setprio(0);
      }
    }
  }
  epi.template run<MI, NI>(acc, m0 + wm * MI * 16, n0 + wn * NI * 16, l15, g);
}

template <class Epi>
DI void gemm_tile_wide(const u16* __restrict__ A, int lda, const u16* __restrict__ Bt, int ldb, int K, int m0, int n0, u16* smem, Epi& epi) {
  constexpr int MI = 4, NI = 8;
  const int tid = opaque_tid(), lane = tid & 63, wid = tid >> 6, l15 = lane & 15, g = lane >> 4;
  const int wm = wid >> 1, wn = wid & 1;
  u16* sA = smem; u16* sB = smem + 128 * 64;
  f32x4 acc[MI][NI];
#pragma unroll
  for (int mi = 0; mi < MI; ++mi)
#pragma unroll
    for (int ni = 0; ni < NI; ++ni) { acc[mi][ni][0] = 0.f; acc[mi][ni][1] = 0.f; acc[mi][ni][2] = 0.f; acc[mi][ni][3] = 0.f; }
  const int lrow = tid >> 3, lkc = (tid & 7) * 8;
  const int wofs = lrow * 64 + (((tid & 7) ^ ((lrow >> 1) & 7)) * 8);
  const int rsw = (l15 >> 1) & 7;
  const int rofs0 = l15 * 64 + ((g ^ rsw) * 8), rofs1 = l15 * 64 + (((4 + g) ^ rsw) * 8);
  const u16* pa = A + (size_t)(m0 + lrow) * lda + lkc;
  const u16* pb = Bt + (size_t)(n0 + lrow) * ldb + lkc;
  u32x4 ra[4], rb[8];
  const int nk = K >> 6;
#pragma unroll
  for (int i = 0; i < 4; ++i) ra[i] = *(const u32x4*)(pa + (size_t)i * 32 * lda);
#pragma unroll
  for (int i = 0; i < 8; ++i) rb[i] = *(const u32x4*)(pb + (size_t)i * 32 * ldb);
  for (int kt = 0; kt < nk; ++kt) {
    __syncthreads();
#pragma unroll
    for (int i = 0; i < 4; ++i) *(u32x4*)(sA + wofs + i * 32 * 64) = ra[i];
#pragma unroll
    for (int i = 0; i < 8; ++i) *(u32x4*)(sB + wofs + i * 32 * 64) = rb[i];
    __syncthreads();
    if (kt + 1 < nk) {
      const int ko = (kt + 1) * 64;
#pragma unroll
      for (int i = 0; i < 4; ++i) ra[i] = *(const u32x4*)(pa + (size_t)i * 32 * lda + ko);
#pragma unroll
      for (int i = 0; i < 8; ++i) rb[i] = *(const u32x4*)(pb + (size_t)i * 32 * ldb + ko);
    }
#pragma unroll
    for (int ks = 0; ks < 2; ++ks) {
      const int ro = ks ? rofs1 : rofs0;
      bf16x8 af[MI];
#pragma unroll
      for (int mi = 0; mi < MI; ++mi) af[mi] = ld8(sA + (wm * 64 + mi * 16) * 64 + ro);
#pragma unroll
      for (int nh = 0; nh < 2; ++nh) {
        bf16x8 bfv[4];
#pragma unroll
        for (int ni = 0; ni < 4; ++ni) bfv[ni] = ld8(sB + (wn * 128 + (nh * 4 + ni) * 16) * 64 + ro);
        __builtin_amdgcn_s_setprio(1);
#pragma unroll
        for (int mi = 0; mi < MI; ++mi)
#pragma unroll
          for (int ni = 0; ni < 4; ++ni) acc[mi][nh * 4 + ni] = mma(bfv[ni], af[mi], acc[mi][nh * 4 + ni]);
        __builtin_amdgcn_s_setprio(0);
        __builtin_amdgcn_sched_barrier(0);
      }
    }
  }
  epi.template run<MI, NI>(acc, m0 + wm * 64, n0 + wn * 128, l15, g);
}

struct EpiResid {
  const float* xin; float* xout; const float* gate;
  template <int MI, int NI> DI void run(f32x4 (&acc)[MI][NI], int mr, int nc, int l15, int g) {
#pragma unroll
    for (int mi = 0; mi < MI; ++mi)
#pragma unroll
      for (int ni = 0; ni < NI; ++ni) {
        const int m = mr + mi * 16 + l15, n = nc + ni * 16 + g * 4;
        const float4 xi = *(const float4*)(xin + (size_t)m * 1024 + n);
        const float4 gt = *(const float4*)(gate + n);
        float4 o; o.x = xi.x + gt.x * acc[mi][ni][0]; o.y = xi.y + gt.y * acc[mi][ni][1]; o.z = xi.z + gt.z * acc[mi][ni][2]; o.w = xi.w + gt.w * acc[mi][ni][3];
        *(float4*)(xout + (size_t)m * 1024 + n) = o;
      }
  }
};
struct EpiGdnIn {
  u16* proj; float* gbuf;
  template <int MI, int NI> DI void run(f32x4 (&acc)[MI][NI], int mr, int nc, int l15, int g) {
#pragma unroll
    for (int mi = 0; mi < MI; ++mi)
#pragma unroll
      for (int ni = 0; ni < NI; ++ni) {
        const int m = mr + mi * 16 + l15, n = nc + ni * 16 + g * 4;
        if (n < 4096) st4bf(proj + (size_t)m * 4096 + n, acc[mi][ni][0], acc[mi][ni][1], acc[mi][ni][2], acc[mi][ni][3]);
        else if (n < 4128) { float4 o; o.x = acc[mi][ni][0]; o.y = acc[mi][ni][1]; o.z = acc[mi][ni][2]; o.w = acc[mi][ni][3]; *(float4*)(gbuf + (size_t)m * 32 + (n - 4096)) = o; }
      }
  }
};
struct EpiMlpIn {
  u16* abuf;
  template <int MI, int NI> DI void run(f32x4 (&acc)[MI][NI], int mr, int nc, int l15, int g) {
#pragma unroll
    for (int mi = 0; mi < MI; ++mi)
#pragma unroll
      for (int ni = 0; ni < NI; ++ni) {
        const int m = mr + mi * 16 + l15, n = nc + ni * 16 + g * 4;
        float a = fmaxf(acc[mi][ni][0], 0.f), b = fmaxf(acc[mi][ni][1], 0.f), c = fmaxf(acc[mi][ni][2], 0.f), d = fmaxf(acc[mi][ni][3], 0.f);
        st4bf(abuf + (size_t)m * 4096 + n, a * a, b * b, c * c, d * d);
      }
  }
};
struct EpiF32 {
  float* dst; int ld;
  template <int MI, int NI> DI void run(f32x4 (&acc)[MI][NI], int mr, int nc, int l15, int g) {
#pragma unroll
    for (int mi = 0; mi < MI; ++mi)
#pragma unroll
      for (int ni = 0; ni < NI; ++ni) {
        const int m = mr + mi * 16 + l15, n = nc + ni * 16 + g * 4;
        float4 o; o.x = acc[mi][ni][0]; o.y = acc[mi][ni][1]; o.z = acc[mi][ni][2]; o.w = acc[mi][ni][3];
        *(float4*)(dst + (size_t)m * ld + n) = o;
      }
  }
};

DI void rope128(f32x4 (&v)[8], int rowp, int colp, int g, const float* cosT, const float* sinT) {
#pragma unroll
  for (int hf = 0; hf < 2; ++hf) {
    const int pos = hf ? colp : rowp;
#pragma unroll
    for (int a = 0; a < 2; ++a) {
      const int n1 = hf * 4 + a, n2 = n1 + 2;
      const float4 cs = *(const float4*)(cosT + pos * 32 + a * 16 + g * 4);
      const float4 sn = *(const float4*)(sinT + pos * 32 + a * 16 + g * 4);
      const float c4[4] = {cs.x, cs.y, cs.z, cs.w}, s4[4] = {sn.x, sn.y, sn.z, sn.w};
#pragma unroll
      for (int j = 0; j < 4; ++j) { const float x1 = v[n1][j], x2 = v[n2][j]; v[n1][j] = x1 * c4[j] - x2 * s4[j]; v[n2][j] = x1 * s4[j] + x2 * c4[j]; }
    }
  }
}
DI void rope64(f32x4* v, int rowp, int colp, int g, const float* cosT, const float* sinT) {
#pragma unroll
  for (int hf = 0; hf < 2; ++hf) {
    const int pos = hf ? colp : rowp;
    const int n1 = hf * 2, n2 = n1 + 1;
    const float4 cs = *(const float4*)(cosT + pos * 16 + g * 4);
    const float4 sn = *(const float4*)(sinT + pos * 16 + g * 4);
    const float c4[4] = {cs.x, cs.y, cs.z, cs.w}, s4[4] = {sn.x, sn.y, sn.z, sn.w};
#pragma unroll
    for (int j = 0; j < 4; ++j) { const float x1 = v[n1][j], x2 = v[n2][j]; v[n1][j] = x1 * c4[j] - x2 * s4[j]; v[n2][j] = x1 * s4[j] + x2 * c4[j]; }
  }
}

struct EpiGqaIn {
  u16* Q; u16* Kb; u16* Vt; const float* qg; const float* kg; const float* cosT; const float* sinT; float* out;
  template <int MI, int NI> DI void run(f32x4 (&acc)[MI][NI], int mr, int nc, int l15, int g) {
    const int nt = nc >> 7;
#pragma unroll
    for (int mi = 0; mi < MI; ++mi) {
      const int m = mr + mi * 16 + l15;
      const bool prompt = m < NPROMPT;
      const int s = prompt ? (m & 255) : ((m - NPROMPT) & 2047);
      const int rowp = s >> 6, colp = s & 63;
      const int kvrow = kvrow_of_tok(m);
      if (nt < 10) {
        float ss = 0.f;
#pragma unroll
        for (int ni = 0; ni < NI; ++ni)
#pragma unroll
          for (int j = 0; j < 4; ++j) ss += acc[mi][ni][j] * acc[mi][ni][j];
        ss = sum_g(ss);
        const float rs = rsqrtf(ss * (1.f / 128.f) + EPS);
        const float* gn = nt < 8 ? qg : kg;
#pragma unroll
        for (int ni = 0; ni < NI; ++ni) {
          const float4 gv = *(const float4*)(gn + ni * 16 + g * 4);
          acc[mi][ni][0] *= rs * gv.x; acc[mi][ni][1] *= rs * gv.y; acc[mi][ni][2] *= rs * gv.z; acc[mi][ni][3] *= rs * gv.w;
        }
        if (nt >= 8 && prompt) {
#pragma unroll
          for (int ni = 0; ni < NI; ++ni) { float4 o; o.x = acc[mi][ni][0]; o.y = acc[mi][ni][1]; o.z = acc[mi][ni][2]; o.w = acc[mi][ni][3]; *(float4*)(out + O_GK + (size_t)m * 256 + (nt - 8) * 128 + ni * 16 + g * 4) = o; }
        }
        if (!prompt) rope128(acc[mi], rowp, colp, g, cosT, sinT);
        u16* dst = nt < 8 ? Q + (size_t)m * 1024 + nt * 128 : Kb + (size_t)kvrow * 256 + (nt - 8) * 128;
#pragma unroll
        for (int ni = 0; ni < NI; ++ni) st4bf(dst + ni * 16 + g * 4, acc[mi][ni][0], acc[mi][ni][1], acc[mi][ni][2], acc[mi][ni][3]);
      } else {
        const int kvh = nt - 10;
        if (prompt) {
#pragma unroll
          for (int ni = 0; ni < NI; ++ni) { float4 o; o.x = acc[mi][ni][0]; o.y = acc[mi][ni][1]; o.z = acc[mi][ni][2]; o.w = acc[mi][ni][3]; *(float4*)(out + O_GV + (size_t)m * 256 + kvh * 128 + ni * 16 + g * 4) = o; }
        }
        size_t base; int kvlen, pos;
        if (prompt) { base = (size_t)(m >> 8) * 256 * 256; kvlen = 256; pos = m & 255; }
        else { const int b = (m - NPROMPT) >> 11; base = (size_t)(NPROMPT + b * 2560) * 256; kvlen = 2560; pos = 512 + s; }
#pragma unroll
        for (int ni = 0; ni < NI; ++ni)
#pragma unroll
          for (int j = 0; j < 4; ++j) Vt[base + (size_t)(kvh * 128 + ni * 16 + g * 4 + j) * kvlen + pos] = f2bf(acc[mi][ni][j]);
      }
    }
  }
};
struct EpiMlaUq {
  u16* Q; const float* gnope; const float* grope; const float* cosT; const float* sinT;
  template <int MI, int NI> DI void run(f32x4 (&acc)[MI][NI], int mr, int nc, int l15, int g) {
    const int nt = nc >> 7;
#pragma unroll
    for (int mi = 0; mi < MI; ++mi) {
      const int m = mr + mi * 16 + l15;
      const bool prompt = m < NPROMPT;
      const int s = prompt ? (m & 255) : ((m - NPROMPT) & 2047);
      const int rowp = s >> 6, colp = s & 63;
      if (nt < 8) {
        float ss = 0.f;
#pragma unroll
        for (int ni = 0; ni < NI; ++ni)
#pragma unroll
          for (int j = 0; j < 4; ++j) ss += acc[mi][ni][j] * acc[mi][ni][j];
        ss = sum_g(ss);
        const float rs = rsqrtf(ss * (1.f / 128.f) + EPS);
#pragma unroll
        for (int ni = 0; ni < NI; ++ni) {
          const float4 gv = *(const float4*)(gnope + ni * 16 + g * 4);
          st4bf(Q + (size_t)m * 1536 + nt * 192 + ni * 16 + g * 4, acc[mi][ni][0] * rs * gv.x, acc[mi][ni][1] * rs * gv.y, acc[mi][ni][2] * rs * gv.z, acc[mi][ni][3] * rs * gv.w);
        }
      } else {
#pragma unroll
        for (int hh = 0; hh < 2; ++hh) {
          const int h = (nt - 8) * 2 + hh;
          float ss = 0.f;
#pragma unroll
          for (int ni = 0; ni < 4; ++ni)
#pragma unroll
            for (int j = 0; j < 4; ++j) ss += acc[mi][hh * 4 + ni][j] * acc[mi][hh * 4 + ni][j];
          ss = sum_g(ss);
          const float rs = rsqrtf(ss * (1.f / 64.f) + EPS);
#pragma unroll
          for (int ni = 0; ni < 4; ++ni) {
            const float4 gv = *(const float4*)(grope + ni * 16 + g * 4);
            acc[mi][hh * 4 + ni][0] *= rs * gv.x; acc[mi][hh * 4 + ni][1] *= rs * gv.y; acc[mi][hh * 4 + ni][2] *= rs * gv.z; acc[mi][hh * 4 + ni][3] *= rs * gv.w;
          }
          if (!prompt) rope64(&acc[mi][hh * 4], rowp, colp, g, cosT, sinT);
#pragma unroll
          for (int ni = 0; ni < 4; ++ni)
            st4bf(Q + (size_t)m * 1536 + h * 192 + 128 + ni * 16 + g * 4, acc[mi][hh * 4 + ni][0], acc[mi][hh * 4 + ni][1], acc[mi][hh * 4 + ni][2], acc[mi][hh * 4 + ni][3]);
        }
      }
    }
  }
};
struct EpiMlaUkv {
  u16* Kb; u16* Vt; const float* gnope;
  template <int MI, int NI> DI void run(f32x4 (&acc)[MI][NI], int mr, int nc, int l15, int g) {
    const int nt = nc >> 7, h = nt >> 1;
#pragma unroll
    for (int mi = 0; mi < MI; ++mi) {
      const int m = mr + mi * 16 + l15;
      if ((nt & 1) == 0) {
        float ss = 0.f;
#pragma unroll
        for (int ni = 0; ni < NI; ++ni)
#pragma unroll
          for (int j = 0; j < 4; ++j) ss += acc[mi][ni][j] * acc[mi][ni][j];
        ss = sum_g(ss);
        const float rs = rsqrtf(ss * (1.f / 128.f) + EPS);
#pragma unroll
        for (int ni = 0; ni < NI; ++ni) {
          const float4 gv = *(const float4*)(gnope + ni * 16 + g * 4);
          st4bf(Kb + (size_t)m * 1536 + h * 192 + ni * 16 + g * 4, acc[mi][ni][0] * rs * gv.x, acc[mi][ni][1] * rs * gv.y, acc[mi][ni][2] * rs * gv.z, acc[mi][ni][3] * rs * gv.w);
        }
      } else {
        size_t base; int kvlen, pos;
        if (m < NPROMPT) { base = (size_t)(m >> 8) * 256 * 1024; kvlen = 256; pos = m & 255; }
        else { const int r = m - NPROMPT; const int b = r / 2560; base = (size_t)(NPROMPT + b * 2560) * 1024; kvlen = 2560; pos = r - b * 2560; }
#pragma unroll
        for (int ni = 0; ni < NI; ++ni)
#pragma unroll
          for (int j = 0; j < 4; ++j) Vt[base + (size_t)(h * 128 + ni * 16 + g * 4 + j) * kvlen + pos] = f2bf(acc[mi][ni][j]);
      }
    }
  }
};

DI void convert_tile(const float* __restrict__ W, int K, int N, u16* __restrict__ Bt, int tile, int perm, float* sT) {
  const int nkt = K >> 6;
  const int kt = tile % nkt, nt = tile / nkt;
  const int k0 = kt * 64, n0 = nt * 64;
  const int tid = opaque_tid();
  __syncthreads();
  {
    const int n = tid & 63, kq = tid >> 6;
    int nd = n0 + n, ns = nd;
    if (perm == 1) { if (nd < 1024) ns = (nd >> 7) * 192 + (nd & 127); else { const int x = nd - 1024; ns = (x >> 6) * 192 + 128 + (x & 63); } }
    const bool ok = nd < N;
#pragma unroll
    for (int r = 0; r < 16; ++r) { const int k = r * 4 + kq; sT[k * 65 + n] = ok ? W[(size_t)(k0 + k) * N + ns] : 0.f; }
  }
  __syncthreads();
  {
    const int n = tid >> 2, kq = (tid & 3) * 16;
    u32x4 a, b;
#pragma unroll
    for (int e = 0; e < 4; ++e) { a[e] = pack2(sT[(kq + 2 * e) * 65 + n], sT[(kq + 2 * e + 1) * 65 + n]); b[e] = pack2(sT[(kq + 8 + 2 * e) * 65 + n], sT[(kq + 9 + 2 * e) * 65 + n]); }
    u16* dst = Bt + (size_t)(n0 + n) * K + k0 + kq;
    *(u32x4*)dst = a; *(u32x4*)(dst + 8) = b;
  }
}

DI void norm_rows(const P& p, int layer, bool from_input, int item, const float* gnorm, int shift_idx, int scale_idx) {
  const int tidn = opaque_tid();
  char* const ws = opaque_ptr(as_global(p.ws));
  const int lane = tidn & 63, wid = tidn >> 6;
  const int t = item * 4 + wid;
  const float* x = from_input ? (t < NPROMPT ? GIN(0) + (size_t)t * 1024 : GIN(1) + (size_t)(t - NPROMPT) * 1024) : GOUT + (size_t)t * 1024;
  const float* mods = (const float*)(ws + WS_MODS) + ((size_t)layer * 9 + cond_of(t)) * 6144;
  u16* h = (u16*)(ws + WS_HBUF) + (size_t)t * 1024;
  float4 v[4]; float ss = 0.f;
#pragma unroll
  for (int e = 0; e < 4; ++e) { v[e] = *(const float4*)(x + e * 256 + lane * 4); ss += v[e].x * v[e].x + v[e].y * v[e].y + v[e].z * v[e].z + v[e].w * v[e].w; }
  ss = wave_sum(ss);
  const float rs = rsqrtf(ss * (1.f / 1024.f) + EPS);
#pragma unroll
  for (int e = 0; e < 4; ++e) {
    const int c = e * 256 + lane * 4;
    const float4 gv = *(const float4*)(gnorm + c);
    const float4 sc = *(const float4*)(mods + scale_idx * 1024 + c);
    const float4 sh = *(const float4*)(mods + shift_idx * 1024 + c);
    st4bf(h + c, v[e].x * rs * gv.x * (1.f + sc.x) + sh.x, v[e].y * rs * gv.y * (1.f + sc.y) + sh.y, v[e].z * rs * gv.z * (1.f + sc.z) + sh.z, v[e].w * rs * gv.w * (1.f + sc.w) + sh.w);
  }
}

template <int DK, int HK>
DI void attn_phase(const u16* __restrict__ Q, const u16* __restrict__ Kb, const u16* __restrict__ Vt, u16* __restrict__ obuf, char* smem_raw) {
  const int bid = opaque_bid();
  constexpr int KS = DK / 32, KSTR = DK, QSTR = 8 * DK, KROW = HK * DK, GRP = 8 / HK;
  constexpr int CPR = DK / 8;
  constexpr int KCH = 64 * CPR / 256;
  u16* sK = (u16*)smem_raw;
  u16* sV = sK + 64 * KSTR;
  const int tid = opaque_tid(), lane = tid & 63, wid = tid >> 6, l15 = lane & 15, g = lane >> 4;
  const float sc = rsqrtf((float)DK) * 1.4426950408889634f;
  for (int item = bid; item < 1280; item += gridDim.x) {
    int qb, h, kvlen, tokbase, kvbase;
    if (item < 1024) { const int b = item >> 7, rem = item & 127; h = rem & 7; qb = rem >> 3; kvlen = 2560; tokbase = NPROMPT + b * 2048; kvbase = NPROMPT + b * 2560; }
    else { const int it2 = item - 1024; const int b = it2 >> 4, rem = it2 & 15; h = rem & 7; qb = rem >> 3; kvlen = 256; tokbase = b * 256; kvbase = b * 256; }
    const int kvh = h / GRP;
    const u16* Kp = Kb + (size_t)kvbase * KROW + kvh * DK;
    const u16* Vp = Vt + (size_t)kvbase * (HK * 128) + (size_t)kvh * 128 * kvlen;
    const int qrow0 = tokbase + qb * 128 + wid * 32;
    bf16x8 qf[2][KS];
#pragma unroll
    for (int qi = 0; qi < 2; ++qi)
#pragma unroll
      for (int ks = 0; ks < KS; ++ks) qf[qi][ks] = ld8(Q + (size_t)(qrow0 + qi * 16 + l15) * QSTR + h * DK + ks * 32 + g * 8);
    f32x4 ot[2][8];
#pragma unroll
    for (int qi = 0; qi < 2; ++qi)
#pragma unroll
      for (int dj = 0; dj < 8; ++dj) { ot[qi][dj][0] = 0.f; ot[qi][dj][1] = 0.f; ot[qi][dj][2] = 0.f; ot[qi][dj][3] = 0.f; }
    float mrun[2] = {-1e30f, -1e30f}, lrun[2] = {0.f, 0.f};
    const int ntiles = kvlen >> 6;
    const unsigned toffK = (unsigned)((tid >> 3) * KROW + (tid & 7) * 8), toffV = (unsigned)((tid >> 3) * kvlen + (tid & 7) * 8);
    const int kx = tid >> 3;
    const int kperm = ((kx >> 2) & 1) * 16 + (kx >> 3) * 4 + (kx & 3);
    const int kswz = (CPR == 16) ? (kperm & 15) : ((kperm >> 1) & 7);
    const int ldsoffK = kperm * KSTR;
    const int ldsoffV = (tid >> 3) * 64 + (((tid & 7) ^ (((tid >> 3) >> 1) & 7)) * 8);
    u32x4 rk[KCH], rv[4];
#pragma unroll
    for (int i = 0; i < KCH; ++i) { const int rh = i & 1, cgp = i >> 1; rk[i] = *(const u32x4*)(Kp + (size_t)(rh * 32 * KROW + cgp * 64) + toffK); }
#pragma unroll
    for (int i = 0; i < 4; ++i) rv[i] = *(const u32x4*)(Vp + (size_t)i * 32 * kvlen + toffV);
    for (int kt = 0; kt < ntiles; ++kt) {
      const u16* Kt = Kp + (size_t)(kt + 1) * 64 * KROW;
      const u16* Vtp = Vp + (kt + 1) * 64;
      const bool more = kt + 1 < ntiles;
      __syncthreads();
#pragma unroll
      for (int i = 0; i < KCH; ++i) { const int rh = i & 1, cgp = i >> 1; const int c = (tid & 7) + 8 * cgp; const int pos = (CPR == 16) ? (c ^ kswz) : ((c & ~7) | ((c & 7) ^ kswz)); *(u32x4*)(sK + ldsoffK + rh * 32 * KSTR + pos * 8) = rk[i]; }
#pragma unroll
      for (int i = 0; i < 4; ++i) *(u32x4*)(sV + ldsoffV + i * 32 * 64) = rv[i];
      __syncthreads();
      if (more) {
#pragma unroll
        for (int i = 0; i < KCH; ++i) { const int rh = i & 1, cgp = i >> 1; rk[i] = *(const u32x4*)(Kt + (size_t)(rh * 32 * KROW + cgp * 64) + toffK); }
      }
      __builtin_amdgcn_sched_barrier(0);
      f32x4 st[2][4];
#pragma unroll
      for (int qi = 0; qi < 2; ++qi)
#pragma unroll
        for (int kj = 0; kj < 4; ++kj) { st[qi][kj][0] = 0.f; st[qi][kj][1] = 0.f; st[qi][kj][2] = 0.f; st[qi][kj][3] = 0.f; }
#pragma unroll
      for (int ks = 0; ks < KS; ++ks) {
#pragma unroll
        for (int kj = 0; kj < 4; ++kj) {
          const int kc = ks * 4 + g;
          const int kpos = (CPR == 16) ? (kc ^ l15) : ((kc & ~7) | ((kc & 7) ^ ((l15 >> 1) & 7)));
          const bf16x8 ka = ld8(sK + (kj * 16 + l15) * KSTR + kpos * 8);
          __builtin_amdgcn_s_setprio(1);
          st[0][kj] = mma(ka, qf[0][ks], st[0][kj]);
          st[1][kj] = mma(ka, qf[1][ks], st[1][kj]);
          __builtin_amdgcn_s_setprio(0);
        }
        __builtin_amdgcn_sched_barrier(0);
      }
      bf16x8 pf[2][2];
#pragma unroll
      for (int qi = 0; qi < 2; ++qi) {
        float mx = -1e30f;
#pragma unroll
        for (int kj = 0; kj < 4; ++kj)
#pragma unroll
          for (int r = 0; r < 4; ++r) mx = fmaxf(mx, st[qi][kj][r]);
        mx = fmaxf(mx, __shfl_xor(mx, 16)); mx = fmaxf(mx, __shfl_xor(mx, 32));
        const float mnew = fmaxf(mrun[qi], mx);
        const float alpha = __builtin_amdgcn_exp2f((mrun[qi] - mnew) * sc);
        mrun[qi] = mnew;
        float ps = 0.f;
        const float mneg = -mnew * sc;
#pragma unroll
        for (int kj = 0; kj < 4; ++kj)
#pragma unroll
          for (int r = 0; r < 4; ++r) { const float pv = __builtin_amdgcn_exp2f(fmaf(st[qi][kj][r], sc, mneg)); st[qi][kj][r] = pv; ps += pv; }
        lrun[qi] = lrun[qi] * alpha + ps;
#pragma unroll
        for (int dj = 0; dj < 8; ++dj) { ot[qi][dj][0] *= alpha; ot[qi][dj][1] *= alpha; ot[qi][dj][2] *= alpha; ot[qi][dj][3] *= alpha; }
        pf[qi][0] = pack8(st[qi][0], st[qi][1]);
        pf[qi][1] = pack8(st[qi][2], st[qi][3]);
        __builtin_amdgcn_sched_barrier(0);
      }
      if (more) {
#pragma unroll
        for (int i = 0; i < 4; ++i) rv[i] = *(const u32x4*)(Vtp + (size_t)i * 32 * kvlen + toffV);
      }
      __builtin_amdgcn_sched_barrier(0);
#pragma unroll
      for (int kk = 0; kk < 2; ++kk)
#pragma unroll
        for (int dj = 0; dj < 8; ++dj) {
          const bf16x8 va = ld8(sV + (dj * 16 + l15) * 64 + (((kk * 4 + g) ^ ((l15 >> 1) & 7)) * 8));
          __builtin_amdgcn_s_setprio(1);
          ot[0][dj] = mma(va, pf[0][kk], ot[0][dj]);
          ot[1][dj] = mma(va, pf[1][kk], ot[1][dj]);
          __builtin_amdgcn_s_setprio(0);
          if ((dj & 3) == 3) __builtin_amdgcn_sched_barrier(0);
        }
    }
#pragma unroll
    for (int qi = 0; qi < 2; ++qi) {
      const float inv = 1.f / sum_g(lrun[qi]);
      u16* dst = obuf + (size_t)(qrow0 + qi * 16 + l15) * 1024 + h * 128 + g * 4;
#pragma unroll
      for (int dj = 0; dj < 8; ++dj) st4bf(dst + dj * 16, ot[qi][dj][0] * inv, ot[qi][dj][1] * inv, ot[qi][dj][2] * inv, ot[qi][dj][3] * inv);
    }
  }
}

DI void gdn_chunk_phase(const P& p, int j, char* smem_raw) {
  const int bid = opaque_bid();
  char* const ws = opaque_ptr(as_global(p.ws));
  u16* sK = (u16*)smem_raw;
  float* sA = (float*)(smem_raw + 17408);
  float* sG = (float*)(smem_raw + 17408 + 32768);
  float* sBt = sG + 128;
  const int tid = opaque_tid(), lane = tid & 63, wid = tid >> 6, l15 = lane & 15, g = lane >> 4;
  const u16* proj = (const u16*)(ws + WS_R + R_PROJ);
  u16* qn = (u16*)(ws + WS_HBUF); u16* kn = (u16*)(ws + WS_OBUF); u16* vb = (u16*)(ws + WS_R + R_VBUF);
  u16* Tbuf = (u16*)(ws + WS_R + R_TBUF);
  const float* gbuf = (const float*)(ws + WS_R + R_GBUF);
  float* gcb = (float*)(ws + WS_R + R_GCB); float* betab = (float*)(ws + WS_R + R_BETA);
  float* egb = (float*)(ws + WS_R + R_EG); float* edb = (float*)(ws + WS_R + R_ED);
  const float* conv = GIN(17) + (size_t)j * 3 * 3072;
  const float* a_log = GIN(18) + j * 16; const float* dt_bias = GIN(19) + j * 16;
  for (int unit = bid; unit < 2560; unit += gridDim.x) {
    const int cgi = unit >> 3, h = unit & 7;
    int c, nch; if (cgi < 64) { c = cgi & 3; nch = 4; } else { c = (cgi - 64) & 31; nch = 32; }
    const int t0 = cgi * 64;
    const bool has_prev = c > 0, has_next = c < nch - 1;
    __syncthreads();
    {
      const int r = tid >> 4, cc = (tid & 15) * 8;
#pragma unroll
      for (int part = 0; part < 3; ++part) {
        const int ch = part * 1024 + h * 128 + cc;
        float w0[8], w1[8], w2[8];
#pragma unroll
        for (int e = 0; e < 8; ++e) { w0[e] = conv[ch + e]; w1[e] = conv[3072 + ch + e]; w2[e] = conv[6144 + ch + e]; }
        u16* dstb = part == 0 ? qn : (part == 1 ? kn : vb);
        for (int it = 0; it < 4; ++it) {
          const int i = it * 16 + r, t = t0 + i;
          const u16* src = proj + (size_t)t * 4096 + ch;
          const u32x4 xc = *(const u32x4*)src;
          u32x4 xp = {0u, 0u, 0u, 0u}, xn = {0u, 0u, 0u, 0u};
          if (i > 0 || has_prev) xp = *(const u32x4*)(src - 4096);
          if (i < 63 || has_next) xn = *(const u32x4*)(src + 4096);
          float y[8];
#pragma unroll
          for (int e = 0; e < 4; ++e) {
            float a = w0[2 * e] * bflo(xp[e]) + w1[2 * e] * bflo(xc[e]) + w2[2 * e] * bflo(xn[e]);
            float b = w0[2 * e + 1] * bfhi(xp[e]) + w1[2 * e + 1] * bfhi(xc[e]) + w2[2 * e + 1] * bfhi(xn[e]);
            y[2 * e] = a / (1.f + __expf(-a)); y[2 * e + 1] = b / (1.f + __expf(-b));
          }
          if (part < 2) {
            float ss = 0.f;
#pragma unroll
            for (int e = 0; e < 8; ++e) ss += y[e] * y[e];
            ss += __shfl_xor(ss, 1); ss += __shfl_xor(ss, 2); ss += __shfl_xor(ss, 4); ss += __shfl_xor(ss, 8);
            const float rs = rsqrtf(ss + EPS) * (part == 0 ? 0.08838834764831845f : 1.f);
#pragma unroll
            for (int e = 0; e < 8; ++e) y[e] *= rs;
          }
          u32x4 o; o[0] = pack2(y[0], y[1]); o[1] = pack2(y[2], y[3]); o[2] = pack2(y[4], y[5]); o[3] = pack2(y[6], y[7]);
          *(u32x4*)(dstb + (size_t)t * 1024 + h * 128 + cc) = o;
          if (part == 1) *(u32x4*)(sK + i * 136 + cc) = o;
        }
      }
    }
    if (tid < 128) {
      const int dir = tid >> 6, L = tid & 63;
      const int i = dir ? 63 - L : L;
      const float* gb = gbuf + (size_t)(t0 + i) * 32;
      const float gin = gb[dir * 8 + h], bin = gb[16 + dir * 8 + h];
      const float x = gin + dt_bias[dir * 8 + h];
      const float sp = fmaxf(x, 0.f) + log1pf(expf(-fabsf(x)));
      float gv = -expf(a_log[dir * 8 + h]) * sp;
      const float bt = 1.f / (1.f + expf(-bin));
#pragma unroll
      for (int off = 1; off < 64; off <<= 1) { const float v = __shfl_up(gv, off); if (L >= off) gv += v; }
      sG[dir * 64 + i] = gv; sBt[dir * 64 + i] = bt;
      gcb[((size_t)(t0 + i) * 8 + h) * 2 + dir] = gv; betab[((size_t)(t0 + i) * 8 + h) * 2 + dir] = bt;
      { const float gtot = __shfl(gv, 63); egb[((size_t)(t0 + i) * 8 + h) * 2 + dir] = expf(gv); edb[((size_t)(t0 + i) * 8 + h) * 2 + dir] = expf(gtot - gv); }
    }
    __syncthreads();
    {
      f32x4 ga[4];
#pragma unroll
      for (int mt = 0; mt < 4; ++mt) { ga[mt][0] = 0.f; ga[mt][1] = 0.f; ga[mt][2] = 0.f; ga[mt][3] = 0.f; }
#pragma unroll
      for (int ks = 0; ks < 4; ++ks) {
        const bf16x8 a = ld8(sK + (wid * 16 + l15) * 136 + ks * 32 + g * 8);
#pragma unroll
        for (int mt = 0; mt < 4; ++mt) { const bf16x8 b = ld8(sK + (mt * 16 + l15) * 136 + ks * 32 + g * 8); ga[mt] = mma(a, b, ga[mt]); }
      }
#pragma unroll
      for (int dir = 0; dir < 2; ++dir)
#pragma unroll
        for (int mt = 0; mt < 4; ++mt)
#pragma unroll
          for (int r = 0; r < 4; ++r) {
            const int i = wid * 16 + g * 4 + r, m = mt * 16 + l15;
            const bool valid = dir ? (i < m) : (i > m);
            const float val = valid ? sBt[dir * 64 + i] * ga[mt][r] * __expf(sG[dir * 64 + i] - sG[dir * 64 + m]) : 0.f;
            const int ii = dir ? 63 - i : i, mm = dir ? 63 - m : m;
            sA[dir * 4096 + ii * 64 + mm] = val;
          }
    }
    __syncthreads();
    if (wid < 2) {
      const int dir = wid;
      float* Am = sA + dir * 4096;
      for (int i = 0; i < 64; ++i) {
        float a = (i == lane) ? 1.f : 0.f;
        int m = 0;
        for (; m + 8 <= i; m += 8) {
          const float4 a0 = *(const float4*)(Am + i * 64 + m), a1 = *(const float4*)(Am + i * 64 + m + 4);
          float tv[8];
#pragma unroll
          for (int e = 0; e < 8; ++e) tv[e] = Am[(m + e) * 64 + lane];
          a -= a0.x * tv[0]; a -= a0.y * tv[1]; a -= a0.z * tv[2]; a -= a0.w * tv[3];
          a -= a1.x * tv[4]; a -= a1.y * tv[5]; a -= a1.z * tv[6]; a -= a1.w * tv[7];
        }
        for (; m < i; ++m) a -= Am[i * 64 + m] * Am[m * 64 + lane];
        Am[i * 64 + lane] = a;
      }
      const int mn = dir ? 63 - lane : lane;
      const float bm = sBt[dir * 64 + mn];
      u16* Td = Tbuf + ((size_t)unit * 2 + dir) * 4096;
#pragma unroll 4
      for (int i = 0; i < 64; ++i) { const int in_ = dir ? 63 - i : i; Td[in_ * 64 + mn] = f2bf(Am[i * 64 + lane] * bm); }
    }
  }
}

DI void gdn_scan_phase(const P& p, int j, char* smem_raw) {
  const int bid = opaque_bid();
  char* const ws = opaque_ptr(as_global(p.ws));
  u16* sK = (u16*)smem_raw;
  u16* sKT = sK + 64 * 136;
  u16* sVT = sKT + 128 * 72;
  u16* sST = sVT + 32 * 72;
  u16* sVN = sST + 32 * 136;
  u16* sVD = sVN + 32 * 72;
  float* sGc = (float*)(sVD + 32 * 72);
  float* sE = sGc + 64;
  float* sD = sE + 64;
  const int tid = opaque_tid(), lane = tid & 63, w = tid >> 6, l15 = lane & 15, g = lane >> 4;
  const u16* qn = (const u16*)(ws + WS_HBUF); const u16* kn = (const u16*)(ws + WS_OBUF); const u16* vb = (const u16*)(ws + WS_R + R_VBUF);
  const u16* Tbuf = (const u16*)(ws + WS_R + R_TBUF);
  const float* gcb = (const float*)(ws + WS_R + R_GCB);
  const float* egb = (const float*)(ws + WS_R + R_EG); const float* edb = (const float*)(ws + WS_R + R_ED);
  u16* obase = (u16*)(ws + WS_R + R_PROJ);
  for (int wk = bid; wk < 1536; wk += gridDim.x) {
    int seq, rem;
    if (wk < 512) { seq = 16 + (wk >> 6); rem = wk & 63; } else { seq = (wk - 512) >> 6; rem = (wk - 512) & 63; }
    const int h = rem & 7, dir = (rem >> 5) & 1, dvq = (rem >> 3) & 3;
    const int nch = seq < 16 ? 4 : 32;
    const int cgb = seq < 16 ? seq * 4 : 64 + (seq - 16) * 32;
    f32x4 S[2][2];
    if (seq >= 16) {
      const float* s0 = GIN(2 + dir) + (((size_t)(seq - 16) * 2 + j) * 8 + h) * 16384;
#pragma unroll
      for (int dt = 0; dt < 2; ++dt)
#pragma unroll
        for (int et = 0; et < 2; ++et)
#pragma unroll
          for (int r = 0; r < 4; ++r) S[dt][et][r] = s0[(size_t)(w * 32 + dt * 16 + g * 4 + r) * 128 + dvq * 32 + et * 16 + l15];
    } else {
#pragma unroll
      for (int dt = 0; dt < 2; ++dt)
#pragma unroll
        for (int et = 0; et < 2; ++et) { S[dt][et][0] = 0.f; S[dt][et][1] = 0.f; S[dt][et][2] = 0.f; S[dt][et][3] = 0.f; }
    }
    __syncthreads();
#pragma unroll
    for (int dt = 0; dt < 2; ++dt)
#pragma unroll
      for (int et = 0; et < 2; ++et) st4bf(sST + (et * 16 + l15) * 136 + w * 32 + dt * 16 + g * 4, S[dt][et][0], S[dt][et][1], S[dt][et][2], S[dt][et][3]);
    u32x4 pk[4], pv; bf16x8 pt[2]; float pg = 0.f, pe = 0.f, pd = 0.f;
#define SCAN_PREFETCH(cc) do { \
      const int t0n_ = (cgb + (cc)) * 64; const int unitn_ = (cgb + (cc)) * 8 + h; \
      _Pragma("unroll") for (int i = 0; i < 4; ++i) { const int row = tid & 63, dc = ((tid >> 6) + 4 * i) * 8; pk[i] = *(const u32x4*)(kn + (size_t)(t0n_ + row) * 1024 + h * 128 + dc); } \
      { const int row = tid & 63, ec = (tid >> 6) * 8; pv = *(const u32x4*)(vb + (size_t)(t0n_ + row) * 1024 + h * 128 + dvq * 32 + ec); } \
      if (tid < 64) { const size_t gi_ = ((size_t)(t0n_ + tid) * 8 + h) * 2 + dir; pg = gcb[gi_]; pe = egb[gi_]; pd = edb[gi_]; } \
      _Pragma("unroll") for (int ks = 0; ks < 2; ++ks) pt[ks] = ld8(Tbuf + ((size_t)unitn_ * 2 + dir) * 4096 + (w * 16 + l15) * 64 + ks * 32 + g * 8); \
    } while (0)
    SCAN_PREFETCH(dir ? nch - 1 : 0);
    for (int step = 0; step < nch; ++step) {
      const int c = dir ? nch - 1 - step : step;
      const int t0 = (cgb + c) * 64;
      const int unit = (cgb + c) * 8 + h;
#pragma unroll
      for (int i = 0; i < 4; ++i) {
        const int row = tid & 63, dc = ((tid >> 6) + 4 * i) * 8;
        const u32x4 v = pk[i];
        *(u32x4*)(sK + row * 136 + dc) = v;
#pragma unroll
        for (int e = 0; e < 4; ++e) { sKT[(dc + 2 * e) * 72 + row] = (u16)(v[e] & 0xffffu); sKT[(dc + 2 * e + 1) * 72 + row] = (u16)(v[e] >> 16); }
      }
      {
        const int row = tid & 63, ec = (tid >> 6) * 8;
        const u32x4 v = pv;
#pragma unroll
        for (int e = 0; e < 4; ++e) { sVT[(ec + 2 * e) * 72 + row] = (u16)(v[e] & 0xffffu); sVT[(ec + 2 * e + 1) * 72 + row] = (u16)(v[e] >> 16); }
      }
      if (tid < 64) { sGc[tid] = pg; sE[tid] = pe; sD[tid] = pd; }
      bf16x8 qf[4], tf[2];
#pragma unroll
      for (int ks = 0; ks < 4; ++ks) qf[ks] = ld8(qn + (size_t)(t0 + w * 16 + l15) * 1024 + h * 128 + ks * 32 + g * 8);
#pragma unroll
      for (int ks = 0; ks < 2; ++ks) tf[ks] = pt[ks];
      __syncthreads();
      if (step + 1 < nch) { const int cn = dir ? nch - 2 - step : step + 1; SCAN_PREFETCH(cn); }
      const float gl = dir ? sGc[0] : sGc[63];
      bf16x8 wf[4];
      f32x4 ua[2];
      {
        bf16x8 vtf[2][2], ktf[4][2];
        f32x4 egm[2][2];
#pragma unroll
        for (int et = 0; et < 2; ++et)
#pragma unroll
          for (int ks = 0; ks < 2; ++ks) vtf[et][ks] = ld8(sVT + (et * 16 + l15) * 72 + ks * 32 + g * 8);
#pragma unroll
        for (int ks = 0; ks < 2; ++ks) { egm[ks][0] = *(const f32x4*)(sE + ks * 32 + g * 8); egm[ks][1] = *(const f32x4*)(sE + ks * 32 + g * 8 + 4); }
#pragma unroll
        for (int dt = 0; dt < 4; ++dt)
#pragma unroll
          for (int ks = 0; ks < 2; ++ks) ktf[dt][ks] = ld8(sKT + (dt * 16 + l15) * 72 + ks * 32 + g * 8);
        __builtin_amdgcn_sched_barrier(0);
#pragma unroll
        for (int et = 0; et < 2; ++et) {
          ua[et][0] = 0.f; ua[et][1] = 0.f; ua[et][2] = 0.f; ua[et][3] = 0.f;
#pragma unroll
          for (int ks = 0; ks < 2; ++ks) ua[et] = mma(tf[ks], vtf[et][ks], ua[et]);
        }
#pragma unroll
        for (int ks = 0; ks < 2; ++ks) {
          const u32x4 tw = __builtin_bit_cast(u32x4, tf[ks]);
          u32x4 o;
#pragma unroll
          for (int e = 0; e < 4; ++e) o[e] = pack2(bflo(tw[e]) * egm[ks][e >> 1][(2 * e) & 3], bfhi(tw[e]) * egm[ks][e >> 1][(2 * e + 1) & 3]);
          tf[ks] = __builtin_bit_cast(bf16x8, o);
        }
#pragma unroll
        for (int kq = 0; kq < 2; ++kq) {
          f32x4 wa[2];
#pragma unroll
          for (int hh = 0; hh < 2; ++hh) {
            wa[hh][0] = 0.f; wa[hh][1] = 0.f; wa[hh][2] = 0.f; wa[hh][3] = 0.f;
#pragma unroll
            for (int ks = 0; ks < 2; ++ks) wa[hh] = mma(ktf[kq * 2 + hh][ks], tf[ks], wa[hh]);
          }
          wf[kq] = pack8(wa[0], wa[1]);
        }
        __builtin_amdgcn_sched_barrier(0);
      }
      {
        bf16x8 ktf[4][2];
#pragma unroll
        for (int dt = 0; dt < 4; ++dt)
#pragma unroll
          for (int ks = 0; ks < 2; ++ks) ktf[dt][ks] = ld8(sKT + ((4 + dt) * 16 + l15) * 72 + ks * 32 + g * 8);
        __builtin_amdgcn_sched_barrier(0);
#pragma unroll
        for (int kq = 2; kq < 4; ++kq) {
          f32x4 wa[2];
#pragma unroll
          for (int hh = 0; hh < 2; ++hh) {
            wa[hh][0] = 0.f; wa[hh][1] = 0.f; wa[hh][2] = 0.f; wa[hh][3] = 0.f;
#pragma unroll
            for (int ks = 0; ks < 2; ++ks) wa[hh] = mma(ktf[(kq - 2) * 2 + hh][ks], tf[ks], wa[hh]);
          }
          wf[kq] = pack8(wa[0], wa[1]);
        }
        __builtin_amdgcn_sched_barrier(0);
      }
      const int iq = w * 16 + l15;
      const float gi = sGc[iq];
      const f32x4 dvec = *(const f32x4*)(sD + w * 16 + g * 4);
      f32x4 vn[2];
      bf16x8 qkf[2];
#pragma unroll
      for (int kk = 0; kk < 2; ++kk) {
        bf16x8 kf[2][4];
        f32x4 gcm[2];
#pragma unroll
        for (int hh = 0; hh < 2; ++hh)
#pragma unroll
          for (int ks = 0; ks < 4; ++ks) kf[hh][ks] = ld8(sK + ((kk * 2 + hh) * 16 + l15) * 136 + ks * 32 + g * 8);
#pragma unroll
        for (int hh = 0; hh < 2; ++hh) gcm[hh] = *(const f32x4*)(sGc + (kk * 2 + hh) * 16 + g * 4);
        bf16x8 stp[2][4];
        if (kk == 0) {
#pragma unroll
          for (int et = 0; et < 2; ++et)
#pragma unroll
            for (int kq = 0; kq < 4; ++kq) { const u16* sp = sST + (et * 16 + l15) * 136 + kq * 32 + g * 4; stp[et][kq] = ld44(sp, sp + 16); }
        }
        __builtin_amdgcn_sched_barrier(0);
        if (kk == 0) {
#pragma unroll
          for (int et = 0; et < 2; ++et) {
            f32x4 a; a[0] = 0.f; a[1] = 0.f; a[2] = 0.f; a[3] = 0.f;
#pragma unroll
            for (int kq = 0; kq < 4; ++kq) a = mma(wf[kq], stp[et][kq], a);
            vn[et][0] = ua[et][0] - a[0]; vn[et][1] = ua[et][1] - a[1]; vn[et][2] = ua[et][2] - a[2]; vn[et][3] = ua[et][3] - a[3];
          }
        }
        f32x4 ka[2];
#pragma unroll
        for (int hh = 0; hh < 2; ++hh) {
          const int mt = kk * 2 + hh;
          ka[hh][0] = 0.f; ka[hh][1] = 0.f; ka[hh][2] = 0.f; ka[hh][3] = 0.f;
#pragma unroll
          for (int ks = 0; ks < 4; ++ks) ka[hh] = mma(kf[hh][ks], qf[ks], ka[hh]);
#pragma unroll
          for (int r = 0; r < 4; ++r) {
            const int m = mt * 16 + g * 4 + r;
            const bool valid = dir ? (iq <= m) : (iq >= m);
            ka[hh][r] = ka[hh][r] * __expf(valid ? gi - gcm[hh][r] : -1e30f);
          }
        }
        qkf[kk] = pack8(ka[0], ka[1]);
        __builtin_amdgcn_sched_barrier(0);
      }
#pragma unroll
      for (int et = 0; et < 2; ++et) {
        const int i0 = w * 16 + g * 4;
        st4bf(sVN + (et * 16 + l15) * 72 + i0, vn[et][0], vn[et][1], vn[et][2], vn[et][3]);
        st4bf(sVD + (et * 16 + l15) * 72 + i0, vn[et][0] * dvec[0], vn[et][1] * dvec[1], vn[et][2] * dvec[2], vn[et][3] * dvec[3]);
      }
      __syncthreads();
      {
        bf16x8 stn[2][4], vnp[2][2];
#pragma unroll
        for (int et = 0; et < 2; ++et)
#pragma unroll
          for (int ks = 0; ks < 4; ++ks) stn[et][ks] = ld8(sST + (et * 16 + l15) * 136 + ks * 32 + g * 8);
#pragma unroll
        for (int et = 0; et < 2; ++et)
#pragma unroll
          for (int kk = 0; kk < 2; ++kk) { const u16* sp = sVN + (et * 16 + l15) * 72 + kk * 32 + g * 4; vnp[et][kk] = ld44(sp, sp + 16); }
        const f32x4 egi = *(const f32x4*)(sE + w * 16 + g * 4);
        __builtin_amdgcn_sched_barrier(0);
#pragma unroll
        for (int et = 0; et < 2; ++et) {
          f32x4 a1; a1[0] = 0.f; a1[1] = 0.f; a1[2] = 0.f; a1[3] = 0.f;
#pragma unroll
          for (int ks = 0; ks < 4; ++ks) a1 = mma(qf[ks], stn[et][ks], a1);
          f32x4 a2; a2[0] = 0.f; a2[1] = 0.f; a2[2] = 0.f; a2[3] = 0.f;
#pragma unroll
          for (int kk = 0; kk < 2; ++kk) a2 = mma(qkf[kk], vnp[et][kk], a2);
#pragma unroll
          for (int r = 0; r < 4; ++r) {
            const int i = w * 16 + g * 4 + r;
            const float o = a1[r] * egi[r] + a2[r];
            obase[(size_t)(t0 + i) * 4096 + dir * 1024 + h * 128 + dvq * 32 + et * 16 + l15] = f2bf(o);
          }
        }
        __builtin_amdgcn_sched_barrier(0);
      }
      {
        bf16x8 ktf2[2][2], vdf[2][2];
#pragma unroll
        for (int dt = 0; dt < 2; ++dt)
#pragma unroll
          for (int kk = 0; kk < 2; ++kk) { ktf2[dt][kk] = ld8(sKT + (w * 32 + dt * 16 + l15) * 72 + kk * 32 + g * 8); vdf[dt][kk] = ld8(sVD + (dt * 16 + l15) * 72 + kk * 32 + g * 8); }
        __builtin_amdgcn_sched_barrier(0);
        const float eg = __expf(gl);
#pragma unroll
        for (int dt = 0; dt < 2; ++dt)
#pragma unroll
          for (int et = 0; et < 2; ++et) {
            f32x4 a; a[0] = S[dt][et][0] * eg; a[1] = S[dt][et][1] * eg; a[2] = S[dt][et][2] * eg; a[3] = S[dt][et][3] * eg;
#pragma unroll
            for (int kk = 0; kk < 2; ++kk) a = mma(ktf2[dt][kk], vdf[et][kk], a);
            S[dt][et] = a;
          }
      }
      __syncthreads();
#pragma unroll
      for (int dt = 0; dt < 2; ++dt)
#pragma unroll
        for (int et = 0; et < 2; ++et) st4bf(sST + (et * 16 + l15) * 136 + w * 32 + dt * 16 + g * 4, S[dt][et][0], S[dt][et][1], S[dt][et][2], S[dt][et][3]);
    }
    if (seq < 16) {
      float* so = GOUT + (dir ? O_SB : O_SF) + (((size_t)seq * 2 + j) * 8 + h) * 16384;
#pragma unroll
      for (int dt = 0; dt < 2; ++dt)
#pragma unroll
        for (int et = 0; et < 2; ++et)
#pragma unroll
          for (int r = 0; r < 4; ++r) so[(size_t)(w * 32 + dt * 16 + g * 4 + r) * 128 + dvq * 32 + et * 16 + l15] = S[dt][et][r];
    }
  }
}

#define XB_TMO      128
#define XB_XCNT(j)  (256  + 64 * (j))
#define XB_XSUB(j)  (1280 + 64 * (j))
#define XB_XGEN(j)  (2304 + 64 * (j))
#define XB_TOP      3328
#define XB_TOPGEN   3392
#define XCD_BAR_WORDS 3456
#define XB_SPIN_CAP (1u << 20)
#define LAS __attribute__((address_space(3)))
DI unsigned xb_ld(unsigned* p)              { return __hip_atomic_load(p, __ATOMIC_RELAXED, __HIP_MEMORY_SCOPE_AGENT); }
DI unsigned xb_add(unsigned* p, unsigned v) { return __hip_atomic_fetch_add(p, v, __ATOMIC_RELAXED, __HIP_MEMORY_SCOPE_AGENT); }
DI unsigned xb_xcc_id() { return (unsigned)__builtin_amdgcn_s_getreg((3 << 11) | 20) & 0xFu; }
#define XB_SPIN(cond, bar) do { unsigned _sp = 0; while (cond) { __builtin_amdgcn_s_sleep(1); \
    if ((++_sp & 255u) == 0u) { if (xb_ld(&(bar)[XB_TMO])) break; if (_sp > XB_SPIN_CAP) { atomicAdd(&(bar)[XB_TMO], 1u); break; } } } } while (0)
struct XcdBarrier { unsigned* bar; unsigned x; volatile LAS unsigned* st; };
DI XcdBarrier xcd_barrier_post(unsigned* bar, volatile LAS unsigned* st) {
  XcdBarrier b; b.bar = bar; b.x = xb_xcc_id(); b.st = st;
  if (threadIdx.x == 0) (void)xb_add(&bar[XB_XCNT(b.x)], 1u);
  return b;
}
DI void xcd_barrier_complete(unsigned* bar, unsigned x, unsigned& nloc, unsigned& nx) {
  const unsigned Gn = gridDim.x * gridDim.y * gridDim.z;
  unsigned sum, cnt, mine, sp = 0u;
  for (;;) {
    sum = 0u; cnt = 0u; mine = 0u;
#pragma unroll
    for (unsigned j = 0; j < 16; ++j) { const unsigned c = xb_ld(&bar[XB_XCNT(j)]); sum += c; cnt += (c > 0u) ? 1u : 0u; mine = (j == x) ? c : mine; }
    if (sum == Gn) break;
    __builtin_amdgcn_s_sleep(1);
    if ((++sp & 255u) == 0u) { if (xb_ld(&bar[XB_TMO])) break; if (sp > XB_SPIN_CAP) { atomicAdd(&bar[XB_TMO], 1u); break; } }
  }
  nloc = mine > 0u ? mine : 1u; nx = cnt > 0u ? cnt : 1u;
}
DI void xcd_barrier(const XcdBarrier& b) {
  asm volatile("s_waitcnt vmcnt(0)" ::: "memory");
  __syncthreads();
  if (threadIdx.x == 0) {
    unsigned* bar = b.bar;
    __builtin_amdgcn_s_waitcnt(0);
    unsigned nloc = b.st[0], nx = b.st[1];
    if (nloc == 0u) { xcd_barrier_complete(bar, b.x, nloc, nx); b.st[0] = nloc; b.st[1] = nx; }
    const unsigned old = xb_add(&bar[XB_XSUB(b.x)], 1u);
    const unsigned gen = old / nloc;
    if (old + 1u == (gen + 1u) * nloc) {
      __builtin_amdgcn_fence(__ATOMIC_RELEASE, "agent");
      asm volatile("s_waitcnt vmcnt(0)" ::: "memory");
      const unsigned og = xb_add(&bar[XB_TOP], 1u);
      const unsigned tg = og / nx;
      if (og + 1u == (tg + 1u) * nx) xb_add(&bar[XB_TOPGEN], 1u);
      else XB_SPIN(xb_ld(&bar[XB_TOPGEN]) == tg, bar);
      __builtin_amdgcn_fence(__ATOMIC_ACQUIRE, "agent");
      xb_add(&bar[XB_XGEN(b.x)], 1u);
      asm volatile("s_waitcnt vmcnt(0)" ::: "memory");
    } else {
      XB_SPIN(xb_ld(&bar[XB_XGEN(b.x)]) == gen, bar);
      __builtin_amdgcn_fence(__ATOMIC_ACQUIRE, "agent");
      asm volatile("s_waitcnt vmcnt(0)" ::: "memory");
    }
  }
  __syncthreads();
}

__global__ void __launch_bounds__(256, 2) fwd_megakernel(P p) {
  cg::grid_group grid = cg::this_grid();
  __shared__ __attribute__((aligned(16))) char smem[60416];
  const int tid = opaque_tid(), lane = tid & 63, wid = tid >> 6;
  const int G = gridDim.x;
  __shared__ uint4 xb_words;
  if (threadIdx.x == 0) xb_words = make_uint4(0u, 0u, 0u, 0u);
  __syncthreads();
  (void)xcd_barrier_post((unsigned*)(as_global(p.ws) + WS_BAR), (volatile LAS unsigned*)&xb_words);
#define GSYNC() do { XcdBarrier xb_; xb_.bar = (unsigned*)(opaque_ptr(as_global(p.ws)) + WS_BAR); xb_.x = xb_xcc_id(); xb_.st = (volatile LAS unsigned*)&xb_words; xcd_barrier(xb_); } while (0)
  const int bid0 = opaque_bid();
  {
  char* const ws0 = opaque_ptr(as_global(p.ws));
  float* mods = (float*)(ws0 + WS_MODS);
  float* ropeT = (float*)(ws0 + WS_ROPE);
  float* cosG = ropeT, *sinG = ropeT + 2048, *cosM = ropeT + 4096, *sinM = ropeT + 5120;

  {
    float* sc = (float*)smem;
    float* red = sc + 9 * 128;
    float* part = (float*)(ws0 + WS_R);
    for (int item = bid0; item < 3072; item += G) {
      const int ks = item & 7, cgp = (item >> 3) % 96, layer = item / 768;
      __syncthreads();
      for (int e = tid; e < 9 * 128; e += 256) {
        const int ci = e >> 7, k = ks * 128 + (e & 127);
        const float v = ci == 0 ? GIN(9)[k] : GIN(8)[(ci - 1) * 1024 + k];
        sc[e] = v / (1.f + expf(-v));
      }
      __syncthreads();
      const int col = tid & 63, kg = tid >> 6;
      const float* wp = GIN(12) + ((size_t)layer * 1024 + ks * 128 + kg * 32) * 6144 + cgp * 64 + col;
      float acc[9];
#pragma unroll
      for (int ci = 0; ci < 9; ++ci) acc[ci] = 0.f;
#pragma unroll 8
      for (int kk = 0; kk < 32; ++kk) {
        const float wv = wp[(size_t)kk * 6144];
#pragma unroll
        for (int ci = 0; ci < 9; ++ci) acc[ci] += sc[ci * 128 + kg * 32 + kk] * wv;
      }
#pragma unroll
      for (int ci = 0; ci < 9; ++ci) red[(kg * 64 + col) * 9 + ci] = acc[ci];
      __syncthreads();
      if (kg == 0) {
        const int n = cgp * 64 + col;
        const float bias = ks == 0 ? GIN(13)[(size_t)layer * 6144 + n] : 0.f;
#pragma unroll
        for (int ci = 0; ci < 9; ++ci) {
          const float s = red[col * 9 + ci] + red[(64 + col) * 9 + ci] + red[(128 + col) * 9 + ci] + red[(192 + col) * 9 + ci] + bias;
          part[(size_t)ks * 221184 + ((size_t)layer * 9 + ci) * 6144 + n] = s;
        }
      }
    }
    if (bid0 == G - 1) {
      for (int e = tid; e < 2048; e += 256) { const int pos = e >> 5, f = e & 31; const float fr = powf(10000.f, -(float)f / 32.f); const float a = (float)pos * fr; cosG[e] = cosf(a); sinG[e] = sinf(a); }
      for (int e = tid; e < 1024; e += 256) { const int pos = e >> 4, f = e & 15; const float fr = powf(10000.f, -(float)f / 16.f); const float a = (float)pos * fr; cosM[e] = cosf(a); sinM[e] = sinf(a); }
    }
  }
  if (gridDim.x == 0x7fffffffu) grid.sync();
  GSYNC();
  {
    const float* part = (const float*)(ws0 + WS_R);
    for (int e = bid0 * 256 + tid; e < 221184; e += G * 256) {
      float sacc = 0.f;
#pragma unroll
      for (int ks = 0; ks < 8; ++ks) sacc += part[(size_t)ks * 221184 + e];
      mods[e] = sacc;
    }
  }
  }
  GSYNC();

#pragma unroll 1
  for (int layer = 0; layer < 4; ++layer) {
    const int kind = layer % 3, j = layer / 3;
    const int bid = opaque_bid();
    char* const ws = opaque_ptr(as_global(p.ws));
    float* mods = (float*)(ws + WS_MODS);
    float* ropeT = (float*)(ws + WS_ROPE);
    float* cosG = ropeT, *sinG = ropeT + 2048, *cosM = ropeT + 4096, *sinM = ropeT + 5120;
    u16* hbuf = (u16*)(ws + WS_HBUF);
    u16* obuf = (u16*)(ws + WS_OBUF);
    u16* wmix = (u16*)(ws + WS_WMIX);
    u16* wmlp = (u16*)(ws + WS_WMLP);
    char* R = ws + WS_R;
    const float* lmods = mods + (size_t)layer * 9 * 6144;
    {
      for (int it = bid; it < 5120; it += G) norm_rows(p, layer, layer == 0, it, GIN(10) + layer * 1024, 0, 1);
      float* sT = (float*)smem;
      for (int it = bid; it < 2048; it += G) {
        if (it < 1024) convert_tile(GIN(14) + (size_t)layer * 1024 * 4096, 1024, 4096, wmlp, it, 0, sT);
        else convert_tile(GIN(15) + (size_t)layer * 4096 * 1024, 4096, 1024, wmlp + 4194304, it - 1024, 0, sT);
      }
      if (kind == 0) {
        for (int it = bid; it < 1056 + 256; it += G) {
          if (it < 1056) convert_tile(GIN(16) + (size_t)j * 1024 * 4128, 1024, 4128, wmix + WM_IN, it, 0, sT);
          else convert_tile(GIN(21) + (size_t)j * 1024 * 1024, 1024, 1024, wmix + WM_OUT, it - 1056, 0, sT);
        }
      } else if (kind == 1) {
        for (int it = bid; it < 192 + 144 + 128 + 256; it += G) {
          if (it < 192) convert_tile(GIN(22), 1024, 704, wmix + WM_IN, it, 0, sT);
          else if (it < 336) convert_tile(GIN(25), 384, 1536, wmix + WM_UQ, it - 192, 1, sT);
          else if (it < 464) convert_tile(GIN(26), 256, 2048, wmix + WM_UKV, it - 336, 0, sT);
          else convert_tile(GIN(31), 1024, 1024, wmix + WM_OUT, it - 464, 0, sT);
        }
      } else {
        for (int it = bid; it < 384 + 256; it += G) {
          if (it < 384) convert_tile(GIN(32), 1024, 1536, wmix + WM_IN, it, 0, sT);
          else convert_tile(GIN(35), 1024, 1024, wmix + WM_OUT, it - 384, 0, sT);
        }
        u16* Kg = (u16*)(R + R_KG); u16* Vg = (u16*)(R + R_VTG);
        const int tid = opaque_tid();
        for (int it = bid; it < 512; it += G) {
          const int b = it >> 6, s0 = (it & 63) * 8;
          const int ch = tid;
          float kv[8], vv[8];
#pragma unroll
          for (int e = 0; e < 8; ++e) { kv[e] = GIN(6)[((size_t)b * 512 + s0 + e) * 256 + ch]; vv[e] = GIN(7)[((size_t)b * 512 + s0 + e) * 256 + ch]; }
#pragma unroll
          for (int e = 0; e < 8; ++e) Kg[(size_t)(NPROMPT + b * 2560 + s0 + e) * 256 + ch] = f2bf(kv[e]);
          u32x4 o; o[0] = pack2(vv[0], vv[1]); o[1] = pack2(vv[2], vv[3]); o[2] = pack2(vv[4], vv[5]); o[3] = pack2(vv[6], vv[7]);
          *(u32x4*)(Vg + (size_t)(NPROMPT + b * 2560) * 256 + (size_t)ch * 2560 + s0) = o;
        }
      }
    }
    GSYNC();

    if (kind == 0) {
      {
        EpiGdnIn epi; epi.proj = (u16*)(R + R_PROJ); epi.gbuf = (float*)(R + R_GBUF);
        for (int it = bid; it < 160 * 16; it += G) { const int mt = it >> 4, nt = it & 15; gemm_tile_wide(hbuf, 1024, wmix + WM_IN, 1024, 1024, mt * 128, nt * 256, (u16*)smem, epi); }
        for (int it = bid; it < 160; it += G) gemm_tile<4>(hbuf, 1024, wmix + WM_IN, 1024, 1024, it * 128, 4096, (u16*)smem, epi);
      }
      GSYNC();
      gdn_chunk_phase(p, j, smem);
      GSYNC();
      gdn_scan_phase(p, j, smem);
      GSYNC();
      {
        const u16* pr = (const u16*)(R + R_PROJ);
        const float* on = GIN(20) + j * 128;
        const int tid = opaque_tid();
        for (int t = bid; t < NTOK; t += G) {
          const int h = tid >> 5, c = (tid & 31) * 4;
          const u16* row = pr + (size_t)t * 4096;
          const u32x2 f = *(const u32x2*)(row + h * 128 + c), b = *(const u32x2*)(row + 1024 + h * 128 + c), z = *(const u32x2*)(row + 3072 + h * 128 + c);
          float o[4] = {bflo(f[0]) + bflo(b[0]), bfhi(f[0]) + bfhi(b[0]), bflo(f[1]) + bflo(b[1]), bfhi(f[1]) + bfhi(b[1])};
          float zz[4] = {bflo(z[0]), bfhi(z[0]), bflo(z[1]), bfhi(z[1])};
          float ss = o[0] * o[0] + o[1] * o[1] + o[2] * o[2] + o[3] * o[3];
          ss += __shfl_xor(ss, 1); ss += __shfl_xor(ss, 2); ss += __shfl_xor(ss, 4); ss += __shfl_xor(ss, 8); ss += __shfl_xor(ss, 16);
          const float rs = rsqrtf(ss * (1.f / 128.f) + EPS);
          const float4 gn = *(const float4*)(on + c);
          const float gg[4] = {gn.x, gn.y, gn.z, gn.w};
          float y[4];
#pragma unroll
          for (int e = 0; e < 4; ++e) y[e] = o[e] * rs * gg[e] * (zz[e] / (1.f + __expf(-zz[e])));
          st4bf(obuf + (size_t)t * 1024 + h * 128 + c, y[0], y[1], y[2], y[3]);
        }
      }
      GSYNC();
    } else if (kind == 1) {
      {
        EpiF32 epi; epi.dst = (float*)(R + R_DPROJ); epi.ld = 768;
        for (int it = bid; it < 160 * 6; it += G) { const int mt = it / 6, nt = it % 6; gemm_tile<4>(hbuf, 1024, wmix + WM_IN, 1024, 1024, mt * 128, nt * 128, (u16*)smem, epi); }
      }
      GSYNC();
      {
        const float* dproj = (const float*)(R + R_DPROJ);
        u16* cq = (u16*)(R + R_CQ); u16* ckv = (u16*)(R + R_CKV); u16* Km = (u16*)(R + R_KM);
        const int tid = opaque_tid(), lane = tid & 63, wid = tid >> 6;
        for (int it = bid; it < 6144; it += G) {
          const int row = it * 4 + wid;
          if (row < NTOK) {
            const int t = row;
            const float* pr = dproj + (size_t)t * 768;
            float v[6]; float ss = 0.f;
#pragma unroll
            for (int e = 0; e < 6; ++e) { v[e] = pr[lane + 64 * e]; ss += v[e] * v[e]; }
            ss = wave_sum(ss);
            float rs = rsqrtf(ss * (1.f / 384.f) + EPS);
#pragma unroll
            for (int e = 0; e < 6; ++e) cq[(size_t)t * 384 + lane + 64 * e] = f2bf(v[e] * rs * GIN(23)[lane + 64 * e]);
            const int kvrow = kvrow_of_tok(t);
            float wv[4]; ss = 0.f;
#pragma unroll
            for (int e = 0; e < 4; ++e) { wv[e] = pr[384 + lane + 64 * e]; ss += wv[e] * wv[e]; }
            ss = wave_sum(ss);
            rs = rsqrtf(ss * (1.f / 256.f) + EPS);
#pragma unroll
            for (int e = 0; e < 4; ++e) {
              const float o = wv[e] * rs * GIN(24)[lane + 64 * e];
              ckv[(size_t)kvrow * 256 + lane + 64 * e] = f2bf(o);
              if (t < NPROMPT) GOUT[O_CKV + (size_t)t * 256 + lane + 64 * e] = o;
            }
            const float x = pr[640 + lane];
            ss = wave_sum(x * x);
            float kr = x * rsqrtf(ss * (1.f / 64.f) + EPS) * GIN(30)[lane];
            if (t < NPROMPT) GOUT[O_KR + (size_t)t * 64 + lane] = kr;
            else {
              const int s = (t - NPROMPT) & 2047;
              const int pos = lane < 32 ? (s >> 6) : (s & 63);
              const float cs = cosM[pos * 16 + (lane & 15)], sn = sinM[pos * 16 + (lane & 15)];
              const float partner = __shfl_xor(kr, 16);
              kr = ((lane & 16) == 0) ? kr * cs - partner * sn : partner * sn + kr * cs;
            }
            const u16 kb = f2bf(kr);
#pragma unroll
            for (int hh = 0; hh < 8; ++hh) Km[(size_t)kvrow * 1536 + hh * 192 + 128 + lane] = kb;
          } else {
            const int r = row - NTOK; const int b = r >> 9, s = r & 511;
            const int kvrow = NPROMPT + b * 2560 + s;
#pragma unroll
            for (int e = 0; e < 4; ++e) ckv[(size_t)kvrow * 256 + lane + 64 * e] = f2bf(GIN(4)[((size_t)b * 512 + s) * 256 + lane + 64 * e]);
            const u16 kb = f2bf(GIN(5)[((size_t)b * 512 + s) * 64 + lane]);
#pragma unroll
            for (int hh = 0; hh < 8; ++hh) Km[(size_t)kvrow * 1536 + hh * 192 + 128 + lane] = kb;
          }
        }
      }
      GSYNC();
      {
        EpiMlaUq e1; e1.Q = (u16*)(R + R_Q); e1.gnope = GIN(27); e1.grope = GIN(28); e1.cosT = cosM; e1.sinT = sinM;
        for (int it = bid; it < 160 * 12; it += G) { const int mt = it / 12, nt = it % 12; gemm_tile<8>((const u16*)(R + R_CQ), 384, wmix + WM_UQ, 384, 384, mt * 128, nt * 128, (u16*)smem, e1); }
        EpiMlaUkv e2; e2.Kb = (u16*)(R + R_KM); e2.Vt = (u16*)(R + R_VTM); e2.gnope = GIN(29);
        for (int it = bid; it < 192 * 16; it += G) { const int mt = it / 16, nt = it % 16; gemm_tile<8>((const u16*)(R + R_CKV), 256, wmix + WM_UKV, 256, 256, mt * 128, nt * 128, (u16*)smem, e2); }
      }
      GSYNC();
      attn_phase<192, 8>((const u16*)(R + R_Q), (const u16*)(R + R_KM), (const u16*)(R + R_VTM), obuf, smem);
      GSYNC();
    } else {
      {
        EpiGqaIn epi; epi.Q = (u16*)(R + R_Q); epi.Kb = (u16*)(R + R_KG); epi.Vt = (u16*)(R + R_VTG); epi.qg = GIN(33); epi.kg = GIN(34); epi.cosT = cosG; epi.sinT = sinG; epi.out = GOUT;
        for (int it = bid; it < 160 * 12; it += G) { const int mt = it / 12, nt = it % 12; gemm_tile<8>(hbuf, 1024, wmix + WM_IN, 1024, 1024, mt * 128, nt * 128, (u16*)smem, epi); }
      }
      GSYNC();
      attn_phase<128, 2>((const u16*)(R + R_Q), (const u16*)(R + R_KG), (const u16*)(R + R_VTG), obuf, smem);
      GSYNC();
    }

    for (int it = bid; it < 768; it += G) {
      const bool wide = it < 512;
      int m0, n0;
      if (wide) { m0 = (it >> 2) * 128; n0 = (it & 3) * 256; } else { const int ix = it - 512; m0 = (128 + (ix >> 3)) * 128; n0 = (ix & 7) * 128; }
      EpiResid epi;
      epi.xin = (layer == 0) ? (m0 < NPROMPT ? GIN(0) : GIN(1) - (size_t)NPROMPT * 1024) : GOUT;
      epi.xout = GOUT; epi.gate = lmods + (size_t)cond_of(m0) * 6144 + 2 * 1024;
      if (wide) gemm_tile_wide(obuf, 1024, wmix + WM_OUT, 1024, 1024, m0, n0, (u16*)smem, epi);
      else gemm_tile<4>(obuf, 1024, wmix + WM_OUT, 1024, 1024, m0, n0, (u16*)smem, epi);
    }
    GSYNC();
    for (int it = bid; it < 5120; it += G) norm_rows(p, layer, false, it, GIN(11) + layer * 1024, 3, 4);
    GSYNC();
    {
      EpiMlpIn epi; epi.abuf = (u16*)(R + R_ABUF);
      for (int it = bid; it < 160 * 16; it += G) { const int mt = it >> 4, nt = it & 15; gemm_tile_wide(hbuf, 1024, wmlp, 1024, 1024, mt * 128, nt * 256, (u16*)smem, epi); }
    }
    GSYNC();
    for (int it = bid; it < 768; it += G) {
      const bool wide = it < 512;
      int m0, n0;
      if (wide) { m0 = (it >> 2) * 128; n0 = (it & 3) * 256; } else { const int ix = it - 512; m0 = (128 + (ix >> 3)) * 128; n0 = (ix & 7) * 128; }
      EpiResid epi; epi.xin = GOUT; epi.xout = GOUT; epi.gate = lmods + (size_t)cond_of(m0) * 6144 + 5 * 1024;
      if (wide) gemm_tile_wide((const u16*)(R + R_ABUF), 4096, wmlp + 4194304, 4096, 4096, m0, n0, (u16*)smem, epi);
      else gemm_tile<4>((const u16*)(R + R_ABUF), 4096, wmlp + 4194304, 4096, 4096, m0, n0, (u16*)smem, epi);
    }
    GSYNC();
  }
}

extern "C" void kernel_launch(void* const* d_in, const int* in_sizes, int n_in, void* d_out, int out_size, void* d_ws, size_t ws_size, hipStream_t stream) {
  static int grid_blocks = 0;
  if (!grid_blocks) {
    int dev = 0, cus = 0, per_cu = 0;
    hipGetDevice(&dev);
    hipDeviceGetAttribute(&cus, hipDeviceAttributeMultiprocessorCount, dev);
    hipOccupancyMaxActiveBlocksPerMultiprocessor(&per_cu, fwd_megakernel, 256, 0);
    if (per_cu < 1) per_cu = 1;
    if (per_cu > 2) per_cu = 2;
    grid_blocks = cus * per_cu;
  }
  P p{};
  for (int i = 0; i < 36; ++i) p.in[i] = (const float*)d_in[i];
  p.out = (float*)d_out;
  p.ws = (char*)d_ws;
  (void)hipMemsetAsync((char*)d_ws + WS_BAR, 0, XCD_BAR_WORDS * 4, stream);
  void* args[] = {&p};
  hipError_t e = hipLaunchCooperativeKernel((void*)fwd_megakernel, dim3(grid_blocks), dim3(256), args, 0, stream);
  if (e != hipSuccess) fprintf(stderr, "cooperative launch failed: %s (grid %d)\n", hipGetErrorString(e), grid_blocks);
}
```

```cpp
#include <hip/hip_runtime.h>
#include <hip/hip_cooperative_groups.h>
#include <cstdio>
namespace cg = cooperative_groups;

typedef unsigned short u16;
typedef __attribute__((ext_vector_type(8))) short bf16x8;
typedef __attribute__((ext_vector_type(4))) short bf16x4;
typedef __attribute__((ext_vector_type(4))) float f32x4;
typedef __attribute__((ext_vector_type(4))) unsigned u32x4;
typedef __attribute__((ext_vector_type(2))) unsigned u32x2;

#define DI __device__ __forceinline__

constexpr int NTOK = 20480;
constexpr int NPROMPT = 4096;
constexpr float EPS = 1e-6f;

constexpr size_t WS_MODS = 0;
constexpr size_t MODS_BYTES = 4ull * 9 * 6144 * 4;
constexpr size_t WS_BAR = 917504;
constexpr size_t WS_ROPE = 1048576;
constexpr size_t WS_WMIX = 1114112;
constexpr size_t WS_WMLP = 14090240;
constexpr size_t WS_HBUF = 30867456;
constexpr size_t WS_OBUF = 72810496;
constexpr size_t WS_R    = 114753536;
constexpr size_t R_ABUF = 0;
constexpr size_t R_PROJ = 0;
constexpr size_t R_VBUF = 167772160;
constexpr size_t R_TBUF = 209715200;
constexpr size_t R_GBUF = 251658240;
constexpr size_t R_GCB  = 254279680;
constexpr size_t R_BETA = 255590400;
constexpr size_t R_EG   = 256901120;
constexpr size_t R_ED   = 258211840;
constexpr size_t R_DPROJ = 0;
constexpr size_t R_Q    = 0;
constexpr size_t R_CQ   = 62914560;
constexpr size_t R_CKV  = 78643200;
constexpr size_t R_KM   = 91226112;
constexpr size_t R_VTM  = 166723584;
constexpr size_t R_KG   = 41943040;
constexpr size_t R_VTG  = 54525952;
constexpr size_t WM_IN = 0;
constexpr size_t WM_OUT = 4325376;
constexpr size_t WM_UQ = 5373952;
constexpr size_t WM_UKV = 5963776;
constexpr size_t O_SF = 20971520, O_SB = 25165824, O_CKV = 29360128, O_KR = 30408704, O_GK = 30670848, O_GV = 31719424;

struct P {
  const float* in[36];
  float* out;
  char* ws;
};

typedef __attribute__((ext_vector_type(2))) float f32x2_t;
typedef __attribute__((ext_vector_type(2))) __bf16 bf16x2_t;
DI u16 f2bf(float x) { return __builtin_bit_cast(u16, (__bf16)x); }
DI float bf2f(u16 h) { return __uint_as_float(((unsigned)h) << 16); }
DI unsigned pack2(float a, float b) { f32x2_t v; v[0] = a; v[1] = b; return __builtin_bit_cast(unsigned, __builtin_convertvector(v, bf16x2_t)); }
DI float bflo(unsigned w) { return __uint_as_float(w << 16); }
DI float bfhi(unsigned w) { return __uint_as_float(w & 0xffff0000u); }
DI f32x4 mma(bf16x8 a, bf16x8 b, f32x4 c) { return __builtin_amdgcn_mfma_f32_16x16x32_bf16(a, b, c, 0, 0, 0); }
DI bf16x8 pack8(f32x4 a, f32x4 b) {
  u32x4 p; p[0] = pack2(a[0], a[1]); p[1] = pack2(a[2], a[3]); p[2] = pack2(b[0], b[1]); p[3] = pack2(b[2], b[3]);
  return __builtin_bit_cast(bf16x8, p);
}
DI bf16x8 ld8(const u16* p) { return *(const bf16x8*)p; }
DI bf16x8 ld44(const u16* p0, const u16* p1) {
  u32x2 a = *(const u32x2*)p0; u32x2 b = *(const u32x2*)p1;
  u32x4 r; r[0] = a[0]; r[1] = a[1]; r[2] = b[0]; r[3] = b[1];
  return __builtin_bit_cast(bf16x8, r);
}
typedef __attribute__((ext_vector_type(4))) short s16x4_t;
DI bf16x8 ldtr(const u16* p, int row4_off) {
  typedef __attribute__((address_space(3))) s16x4_t lds4_t;
  const s16x4_t lo = __builtin_amdgcn_ds_read_tr16_b64_v4i16((lds4_t*)p);
  const s16x4_t hi = __builtin_amdgcn_ds_read_tr16_b64_v4i16((lds4_t*)(p + row4_off));
  return __builtin_shufflevector(lo, hi, 0, 1, 2, 3, 4, 5, 6, 7);
}
DI void st4bf(u16* p, float a, float b, float c, float d) { u32x2 v; v[0] = pack2(a, b); v[1] = pack2(c, d); *(u32x2*)p = v; }
DI float wave_sum(float v) {
  v += __shfl_xor(v, 1); v += __shfl_xor(v, 2); v += __shfl_xor(v, 4); v += __shfl_xor(v, 8); v += __shfl_xor(v, 16); v += __shfl_xor(v, 32);
  return v;
}
DI float sum_g(float v) { v += __shfl_xor(v, 16); v += __shfl_xor(v, 32); return v; }
DI int opaque_tid() { int t = threadIdx.x; asm volatile("" : "+v"(t)); return t; }
DI int opaque_bid() { int t = __builtin_amdgcn_readfirstlane((int)blockIdx.x); asm volatile("" : "+s"(t)); return t; }
DI char* opaque_ptr(char* q) {
  unsigned lo = __builtin_amdgcn_readfirstlane((unsigned)(size_t)q), hi = __builtin_amdgcn_readfirstlane((unsigned)((size_t)q >> 32));
  asm volatile("" : "+s"(lo), "+s"(hi));
  typedef __attribute__((address_space(1))) char gchar_t;
  return (char*)(gchar_t*)(((size_t)hi << 32) | (size_t)lo);
}
template <class T> DI T* as_global(T* q) { typedef __attribute__((address_space(1))) T gT; return (T*)(gT*)q; }
#define GIN(i) as_global(p.in[i])
#define GOUT as_global(p.out)
DI int cond_of(int t) { return t < NPROMPT ? 0 : 1 + ((t - NPROMPT) >> 11); }
DI int kvrow_of_tok(int t) { return t < NPROMPT ? t : NPROMPT + ((t - NPROMPT) >> 11) * 2560 + 512 + ((t - NPROMPT) & 2047); }

template <int NI, class Epi>
DI void gemm_tile(const u16* __restrict__ A, int lda, const u16* __restrict__ Bt, int ldb, int K, int m0, int n0, u16* smem, Epi& epi) {
  constexpr int MI = 16 / NI;
  constexpr int WN = 8 / NI;
  const int tid = opaque_tid(), lane = tid & 63, wid = tid >> 6, l15 = lane & 15, g = lane >> 4;
  const int wm = wid / WN, wn = wid % WN;
  u16* sA = smem; u16* sB = smem + 128 * 64;
  f32x4 acc[MI][NI];
#pragma unroll
  for (int mi = 0; mi < MI; ++mi)
#pragma unroll
    for (int ni = 0; ni < NI; ++ni) { acc[mi][ni][0] = 0.f; acc[mi][ni][1] = 0.f; acc[mi][ni][2] = 0.f; acc[mi][ni][3] = 0.f; }
  const int lrow = tid >> 3, lkc = (tid & 7) * 8;
  const int wofs = lrow * 64 + (((tid & 7) ^ ((lrow >> 1) & 7)) * 8);
  const int rsw = (l15 >> 1) & 7;
  const int rofs0 = l15 * 64 + ((g ^ rsw) * 8), rofs1 = l15 * 64 + (((4 + g) ^ rsw) * 8);
  const u16* pa = A + (size_t)(m0 + lrow) * lda + lkc;
  const u16* pb = Bt + (size_t)(n0 + lrow) * ldb + lkc;
  u32x4 ra[2][4], rb[2][4];
  const int nk = K >> 6;
#pragma unroll
  for (int i = 0; i < 4; ++i) { ra[0][i] = *(const u32x4*)(pa + (size_t)i * 32 * lda); rb[0][i] = *(const u32x4*)(pb + (size_t)i * 32 * ldb); }
#pragma unroll
  for (int i = 0; i < 4; ++i) { ra[1][i] = *(const u32x4*)(pa + (size_t)i * 32 * lda + 64); rb[1][i] = *(const u32x4*)(pb + (size_t)i * 32 * ldb + 64); }
  for (int kt = 0; kt < nk; kt += 2) {
#pragma unroll
    for (int half = 0; half < 2; ++half) {
      __syncthreads();
#pragma unroll
      for (int i = 0; i < 4; ++i) { *(u32x4*)(sA + wofs + i * 32 * 64) = ra[half][i]; *(u32x4*)(sB + wofs + i * 32 * 64) = rb[half][i]; }
      __syncthreads();
      if (kt + half + 2 < nk) {
        const int ko = (kt + half + 2) * 64;
#pragma unroll
        for (int i = 0; i < 4; ++i) { ra[half][i] = *(const u32x4*)(pa + (size_t)i * 32 * lda + ko); rb[half][i] = *(const u32x4*)(pb + (size_t)i * 32 * ldb + ko); }
      }
#pragma unroll
      for (int ks = 0; ks < 2; ++ks) {
        const int ro = ks ? rofs1 : rofs0;
        bf16x8 af[MI], bfv[NI];
#pragma unroll
        for (int mi = 0; mi < MI; ++mi) af[mi] = ld8(sA + (wm * MI * 16 + mi * 16) * 64 + ro);
#pragma unroll
        for (int ni = 0; ni < NI; ++ni) bfv[ni] = ld8(sB + (wn * NI * 16 + ni * 16) * 64 + ro);
        __builtin_amdgcn_s_setprio(1);
#pragma unroll
        for (int mi = 0; mi < MI; ++mi)
#pragma unroll
          for (int ni = 0; ni < NI; ++ni) acc[mi][ni] = mma(bfv[ni], af[mi], acc[mi][ni]);
        __builtin_amdgcn_s_setprio(0);
      }
    }
  }
  epi.template run<MI, NI>(acc, m0 + wm * MI * 16, n0 + wn * NI * 16, l15, g);
}

template <class Epi>
DI void gemm_tile_wide(const u16* __restrict__ A, int lda, const u16* __restrict__ Bt, int ldb, int K, int m0, int n0, u16* smem, Epi& epi) {
  constexpr int MI = 4, NI = 8;
  const int tid = opaque_tid(), lane = tid & 63, wid = tid >> 6, l15 = lane & 15, g = lane >> 4;
  const int wm = wid >> 1, wn = wid & 1;
  u16* sA = smem; u16* sB = smem + 128 * 64;
  f32x4 acc[MI][NI];
#pragma unroll
  for (int mi = 0; mi < MI; ++mi)
#pragma unroll
    for (int ni = 0; ni < NI; ++ni) { acc[mi][ni][0] = 0.f; acc[mi][ni][1] = 0.f; acc[mi][ni][2] = 0.f; acc[mi][ni][3] = 0.f; }
  const int lrow = tid >> 3, lkc = (tid & 7) * 8;
  const int wofs = lrow * 64 + (((tid & 7) ^ ((lrow >> 1) & 7)) * 8);
  const int rsw = (l15 >> 1) & 7;
  const int rofs0 = l15 * 64 + ((g ^ rsw) * 8), rofs1 = l15 * 64 + (((4 + g) ^ rsw) * 8);
  const u16* pa = A + (size_t)(m0 + lrow) * lda + lkc;
  const u16* pb = Bt + (size_t)(n0 + lrow) * ldb + lkc;
  u32x4 ra[4], rb[8];
  const int nk = K >> 6;
#pragma unroll
  for (int i = 0; i < 4; ++i) ra[i] = *(const u32x4*)(pa + (size_t)i * 32 * lda);
#pragma unroll
  for (int i = 0; i < 8; ++i) rb[i] = *(const u32x4*)(pb + (size_t)i * 32 * ldb);
  for (int kt = 0; kt < nk; ++kt) {
    __syncthreads();
#pragma unroll
    for (int i = 0; i < 4; ++i) *(u32x4*)(sA + wofs + i * 32 * 64) = ra[i];
#pragma unroll
    for (int i = 0; i < 8; ++i) *(u32x4*)(sB + wofs + i * 32 * 64) = rb[i];
    __syncthreads();
    if (kt + 1 < nk) {
      const int ko = (kt + 1) * 64;
#pragma unroll
      for (int i = 0; i < 4; ++i) ra[i] = *(const u32x4*)(pa + (size_t)i * 32 * lda + ko);
#pragma unroll
      for (int i = 0; i < 8; ++i) rb[i] = *(const u32x4*)(pb + (size_t)i * 32 * ldb + ko);
    }
#pragma unroll
    for (int ks = 0; ks < 2; ++ks) {
      const int ro = ks ? rofs1 : rofs0;
      bf16x8 af[MI];
#pragma unroll
      for (int mi = 0; mi < MI; ++mi) af[mi] = ld8(sA + (wm * 64 + mi * 16) * 64 + ro);
#pragma unroll
      for (int nh = 0; nh < 2; ++nh) {
        bf16x8 bfv[4];
#pragma unroll
        for (int ni = 0; ni < 4; ++ni) bfv[ni] = ld8(sB + (wn * 128 + (nh * 4 + ni) * 16) * 64 + ro);
        __builtin_amdgcn_s_setprio(1);
#pragma unroll
        for (int mi = 0; mi < MI; ++mi)
#pragma unroll
          for (int ni = 0; ni < 4; ++ni) acc[mi][nh * 4 + ni] = mma(bfv[ni], af[mi], acc[mi][nh * 4 + ni]);
        __builtin_amdgcn_s_setprio(0);
        __builtin_amdgcn_sched_barrier(0);
      }
    }
  }
  epi.template run<MI, NI>(acc, m0 + wm * 64, n0 + wn * 128, l15, g);
}

struct EpiResid {
  const float* xin; float* xout; const float* gate;
  template <int MI, int NI> DI void run(f32x4 (&acc)[MI][NI], int mr, int nc, int l15, int g) {
#pragma unroll
    for (int mi = 0; mi < MI; ++mi)
#pragma unroll
      for (int ni = 0; ni < NI; ++ni) {
        const int m = mr + mi * 16 + l15, n = nc + ni * 16 + g * 4;
        const float4 xi = *(const float4*)(xin + (size_t)m * 1024 + n);
        const float4 gt = *(const float4*)(gate + n);
        float4 o; o.x = xi.x + gt.x * acc[mi][ni][0]; o.y = xi.y + gt.y * acc[mi][ni][1]; o.z = xi.z + gt.z * acc[mi][ni][2]; o.w = xi.w + gt.w * acc[mi][ni][3];
        *(float4*)(xout + (size_t)m * 1024 + n) = o;
      }
  }
};
struct EpiGdnIn {
  u16* proj; float* gbuf;
  template <int MI, int NI> DI void run(f32x4 (&acc)[MI][NI], int mr, int nc, int l15, int g) {
#pragma unroll
    for (int mi = 0; mi < MI; ++mi)
#pragma unroll
      for (int ni = 0; ni < NI; ++ni) {
        const int m = mr + mi * 16 + l15, n = nc + ni * 16 + g * 4;
        if (n < 4096) st4bf(proj + (size_t)m * 4096 + n, acc[mi][ni][0], acc[mi][ni][1], acc[mi][ni][2], acc[mi][ni][3]);
        else if (n < 4128) { float4 o; o.x = acc[mi][ni][0]; o.y = acc[mi][ni][1]; o.z = acc[mi][ni][2]; o.w = acc[mi][ni][3]; *(float4*)(gbuf + (size_t)m * 32 + (n - 4096)) = o; }
      }
  }
};
struct EpiMlpIn {
  u16* abuf;
  template <int MI, int NI> DI void run(f32x4 (&acc)[MI][NI], int mr, int nc, int l15, int g) {
#pragma unroll
    for (int mi = 0; mi < MI; ++mi)
#pragma unroll
      for (int ni = 0; ni < NI; ++ni) {
        const int m = mr + mi * 16 + l15, n = nc + ni * 16 + g * 4;
        float a = fmaxf(acc[mi][ni][0], 0.f), b = fmaxf(acc[mi][ni][1], 0.f), c = fmaxf(acc[mi][ni][2], 0.f), d = fmaxf(acc[mi][ni][3], 0.f);
        st4bf(abuf + (size_t)m * 4096 + n, a * a, b * b, c * c, d * d);
      }
  }
};
struct EpiF32 {
  float* dst; int ld;
  template <int MI, int NI> DI void run(f32x4 (&acc)[MI][NI], int mr, int nc, int l15, int g) {
#pragma unroll
    for (int mi = 0; mi < MI; ++mi)
#pragma unroll
      for (int ni = 0; ni < NI; ++ni) {
        const int m = mr + mi * 16 + l15, n = nc + ni * 16 + g * 4;
        float4 o; o.x = acc[mi][ni][0]; o.y = acc[mi][ni][1]; o.z = acc[mi][ni][2]; o.w = acc[mi][ni][3];
        *(float4*)(dst + (size_t)m * ld + n) = o;
      }
  }
};

DI void rope128(f32x4 (&v)[8], int rowp, int colp, int g, const float* cosT, const float* sinT) {
#pragma unroll
  for (int hf = 0; hf < 2; ++hf) {
    const int pos = hf ? colp : rowp;
#pragma unroll
    for (int a = 0; a < 2; ++a) {
      const int n1 = hf * 4 + a, n2 = n1 + 2;
      const float4 cs = *(const float4*)(cosT + pos * 32 + a * 16 + g * 4);
      const float4 sn = *(const float4*)(sinT + pos * 32 + a * 16 + g * 4);
      const float c4[4] = {cs.x, cs.y, cs.z, cs.w}, s4[4] = {sn.x, sn.y, sn.z, sn.w};
#pragma unroll
      for (int j = 0; j < 4; ++j) { const float x1 = v[n1][j], x2 = v[n2][j]; v[n1][j] = x1 * c4[j] - x2 * s4[j]; v[n2][j] = x1 * s4[j] + x2 * c4[j]; }
    }
  }
}
DI void rope64(f32x4* v, int rowp, int colp, int g, const float* cosT, const float* sinT) {
#pragma unroll
  for (int hf = 0; hf < 2; ++hf) {
    const int pos = hf ? colp : rowp;
    const int n1 = hf * 2, n2 = n1 + 1;
    const float4 cs = *(const float4*)(cosT + pos * 16 + g * 4);
    const float4 sn = *(const float4*)(sinT + pos * 16 + g * 4);
    const float c4[4] = {cs.x, cs.y, cs.z, cs.w}, s4[4] = {sn.x, sn.y, sn.z, sn.w};
#pragma unroll
    for (int j = 0; j < 4; ++j) { const float x1 = v[n1][j], x2 = v[n2][j]; v[n1][j] = x1 * c4[j] - x2 * s4[j]; v[n2][j] = x1 * s4[j] + x2 * c4[j]; }
  }
}

struct EpiGqaIn {
  u16* Q; u16* Kb; u16* Vt; const float* qg; const float* kg; const float* cosT; const float* sinT; float* out;
  template <int MI, int NI> DI void run(f32x4 (&acc)[MI][NI], int mr, int nc, int l15, int g) {
    const int nt = nc >> 7;
#pragma unroll
    for (int mi = 0; mi < MI; ++mi) {
      const int m = mr + mi * 16 + l15;
      const bool prompt = m < NPROMPT;
      const int s = prompt ? (m & 255) : ((m - NPROMPT) & 2047);
      const int rowp = s >> 6, colp = s & 63;
      const int kvrow = kvrow_of_tok(m);
      if (nt < 10) {
        float ss = 0.f;
#pragma unroll
        for (int ni = 0; ni < NI; ++ni)
#pragma unroll
          for (int j = 0; j < 4; ++j) ss += acc[mi][ni][j] * acc[mi][ni][j];
        ss = sum_g(ss);
        const float rs = rsqrtf(ss * (1.f / 128.f) + EPS);
        const float* gn = nt < 8 ? qg : kg;
#pragma unroll
        for (int ni = 0; ni < NI; ++ni) {
          const float4 gv = *(const float4*)(gn + ni * 16 + g * 4);
          acc[mi][ni][0] *= rs * gv.x; acc[mi][ni][1] *= rs * gv.y; acc[mi][ni][2] *= rs * gv.z; acc[mi][ni][3] *= rs * gv.w;
        }
        if (nt >= 8 && prompt) {
#pragma unroll
          for (int ni = 0; ni < NI; ++ni) { float4 o; o.x = acc[mi][ni][0]; o.y = acc[mi][ni][1]; o.z = acc[mi][ni][2]; o.w = acc[mi][ni][3]; *(float4*)(out + O_GK + (size_t)m * 256 + (nt - 8) * 128 + ni * 16 + g * 4) = o; }
        }
        if (!prompt) rope128(acc[mi], rowp, colp, g, cosT, sinT);
        u16* dst = nt < 8 ? Q + (size_t)m * 1024 + nt * 128 : Kb + (size_t)kvrow * 256 + (nt - 8) * 128;
#pragma unroll
        for (int ni = 0; ni < NI; ++ni) st4bf(dst + ni * 16 + g * 4, acc[mi][ni][0], acc[mi][ni][1], acc[mi][ni][2], acc[mi][ni][3]);
      } else {
        const int kvh = nt - 10;
        if (prompt) {
#pragma unroll
          for (int ni = 0; ni < NI; ++ni) { float4 o; o.x = acc[mi][ni][0]; o.y = acc[mi][ni][1]; o.z = acc[mi][ni][2]; o.w = acc[mi][ni][3]; *(float4*)(out + O_GV + (size_t)m * 256 + kvh * 128 + ni * 16 + g * 4) = o; }
        }
        size_t base; int kvlen, pos;
        if (prompt) { base = (size_t)(m >> 8) * 256 * 256; kvlen = 256; pos = m & 255; }
        else { const int b = (m - NPROMPT) >> 11; base = (size_t)(NPROMPT + b * 2560) * 256; kvlen = 2560; pos = 512 + s; }
#pragma unroll
        for (int ni = 0; ni < NI; ++ni)
#pragma unroll
          for (int j = 0; j < 4; ++j) Vt[base + (size_t)(kvh * 128 + ni * 16 + g * 4 + j) * kvlen + pos] = f2bf(acc[mi][ni][j]);
      }
    }
  }
};
struct EpiMlaUq {
  u16* Q; const float* gnope; const float* grope; const float* cosT; const float* sinT;
  template <int MI, int NI> DI void run(f32x4 (&acc)[MI][NI], int mr, int nc, int l15, int g) {
    const int nt = nc >> 7;
#pragma unroll
    for (int mi = 0; mi < MI; ++mi) {
      const int m = mr + mi * 16 + l15;
      const bool prompt = m < NPROMPT;
      const int s = prompt ? (m & 255) : ((m - NPROMPT) & 2047);
      const int rowp = s >> 6, colp = s & 63;
      if (nt < 8) {
        float ss = 0.f;
#pragma unroll
        for (int ni = 0; ni < NI; ++ni)
#pragma unroll
          for (int j = 0; j < 4; ++j) ss += acc[mi][ni][j] * acc[mi][ni][j];
        ss = sum_g(ss);
        const float rs = rsqrtf(ss * (1.f / 128.f) + EPS);
#pragma unroll
        for (int ni = 0; ni < NI; ++ni) {
          const float4 gv = *(const float4*)(gnope + ni * 16 + g * 4);
          st4bf(Q + (size_t)m * 1536 + nt * 192 + ni * 16 + g * 4, acc[mi][ni][0] * rs * gv.x, acc[mi][ni][1] * rs * gv.y, acc[mi][ni][2] * rs * gv.z, acc[mi][ni][3] * rs * gv.w);
        }
      } else {
#pragma unroll
        for (int hh = 0; hh < 2; ++hh) {
          const int h = (nt - 8) * 2 + hh;
          float ss = 0.f;
#pragma unroll
          for (int ni = 0; ni < 4; ++ni)
#pragma unroll
            for (int j = 0; j < 4; ++j) ss += acc[mi][hh * 4 + ni][j] * acc[mi][hh * 4 + ni][j];
          ss = sum_g(ss);
          const float rs = rsqrtf(ss * (1.f / 64.f) + EPS);
#pragma unroll
          for (int ni = 0; ni < 4; ++ni) {
            const float4 gv = *(const float4*)(grope + ni * 16 + g * 4);
            acc[mi][hh * 4 + ni][0] *= rs * gv.x; acc[mi][hh * 4 + ni][1] *= rs * gv.y; acc[mi][hh * 4 + ni][2] *= rs * gv.z; acc[mi][hh * 4 + ni][3] *= rs * gv.w;
          }
          if (!prompt) rope64(&acc[mi][hh * 4], rowp, colp, g, cosT, sinT);
#pragma unroll
          for (int ni = 0; ni < 4; ++ni)
            st4bf(Q + (size_t)m * 1536 + h * 192 + 128 + ni * 16 + g * 4, acc[mi][hh * 4 + ni][0], acc[mi][hh * 4 + ni][1], acc[mi][hh * 4 + ni][2], acc[mi][hh * 4 + ni][3]);
        }
      }
    }
  }
};
struct EpiMlaUkv {
  u16* Kb; u16* Vt; const float* gnope;
  template <int MI, int NI> DI void run(f32x4 (&acc)[MI][NI], int mr, int nc, int l15, int g) {
    const int nt = nc >> 7, h = nt >> 1;
#pragma unroll
    for (int mi = 0; mi < MI; ++mi) {
      const int m = mr + mi * 16 + l15;
      if ((nt & 1) == 0) {
        float ss = 0.f;
#pragma unroll
        for (int ni = 0; ni < NI; ++ni)
#pragma unroll
          for (int j = 0; j < 4; ++j) ss += acc[mi][ni][j] * acc[mi][ni][j];
        ss = sum_g(ss);
        const float rs = rsqrtf(ss * (1.f / 128.f) + EPS);
#pragma unroll
        for (int ni = 0; ni < NI; ++ni) {
          const float4 gv = *(const float4*)(gnope + ni * 16 + g * 4);
          st4bf(Kb + (size_t)m * 1536 + h * 192 + ni * 16 + g * 4, acc[mi][ni][0] * rs * gv.x, acc[mi][ni][1] * rs * gv.y, acc[mi][ni][2] * rs * gv.z, acc[mi][ni][3] * rs * gv.w);
        }
      } else {
        size_t base; int kvlen, pos;
        if (m < NPROMPT) { base = (size_t)(m >> 8) * 256 * 1024; kvlen = 256; pos = m & 255; }
        else { const int r = m - NPROMPT; const int b = r / 2560; base = (size_t)(NPROMPT + b * 2560) * 1024; kvlen = 2560; pos = r - b * 2560; }
#pragma unroll
        for (int ni = 0; ni < NI; ++ni)
#pragma unroll
          for (int j = 0; j < 4; ++j) Vt[base + (size_t)(h * 128 + ni * 16 + g * 4 + j) * kvlen + pos] = f2bf(acc[mi][ni][j]);
      }
    }
  }
};

DI void convert_tile(const float* __restrict__ W, int K, int N, u16* __restrict__ Bt, int tile, int perm, float* sT) {
  const int nkt = K >> 6;
  const int kt = tile % nkt, nt = tile / nkt;
  const int k0 = kt * 64, n0 = nt * 64;
  const int tid = opaque_tid();
  __syncthreads();
  {
    const int n = tid & 63, kq = tid >> 6;
    int nd = n0 + n, ns = nd;
    if (perm == 1) { if (nd < 1024) ns = (nd >> 7) * 192 + (nd & 127); else { const int x = nd - 1024; ns = (x >> 6) * 192 + 128 + (x & 63); } }
    const bool ok = nd < N;
#pragma unroll
    for (int r = 0; r < 16; ++r) { const int k = r * 4 + kq; sT[k * 65 + n] = ok ? W[(size_t)(k0 + k) * N + ns] : 0.f; }
  }
  __syncthreads();
  {
    const int n = tid >> 2, kq = (tid & 3) * 16;
    u32x4 a, b;
#pragma unroll
    for (int e = 0; e < 4; ++e) { a[e] = pack2(sT[(kq + 2 * e) * 65 + n], sT[(kq + 2 * e + 1) * 65 + n]); b[e] = pack2(sT[(kq + 8 + 2 * e) * 65 + n], sT[(kq + 9 + 2 * e) * 65 + n]); }
    u16* dst = Bt + (size_t)(n0 + n) * K + k0 + kq;
    *(u32x4*)dst = a; *(u32x4*)(dst + 8) = b;
  }
}

DI void norm_rows(const P& p, int layer, bool from_input, int item, const float* gnorm, int shift_idx, int scale_idx) {
  const int tidn = opaque_tid();
  char* const ws = opaque_ptr(as_global(p.ws));
  const int lane = tidn & 63, wid = tidn >> 6;
  const int t = item * 4 + wid;
  const float* x = from_input ? (t < NPROMPT ? GIN(0) + (size_t)t * 1024 : GIN(1) + (size_t)(t - NPROMPT) * 1024) : GOUT + (size_t)t * 1024;
  const float* mods = (const float*)(ws + WS_MODS) + ((size_t)layer * 9 + cond_of(t)) * 6144;
  u16* h = (u16*)(ws + WS_HBUF) + (size_t)t * 1024;
  float4 v[4]; float ss = 0.f;
#pragma unroll
  for (int e = 0; e < 4; ++e) { v[e] = *(const float4*)(x + e * 256 + lane * 4); ss += v[e].x * v[e].x + v[e].y * v[e].y + v[e].z * v[e].z + v[e].w * v[e].w; }
  ss = wave_sum(ss);
  const float rs = rsqrtf(ss * (1.f / 1024.f) + EPS);
#pragma unroll
  for (int e = 0; e < 4; ++e) {
    const int c = e * 256 + lane * 4;
    const float4 gv = *(const float4*)(gnorm + c);
    const float4 sc = *(const float4*)(mods + scale_idx * 1024 + c);
    const float4 sh = *(const float4*)(mods + shift_idx * 1024 + c);
    st4bf(h + c, v[e].x * rs * gv.x * (1.f + sc.x) + sh.x, v[e].y * rs * gv.y * (1.f + sc.y) + sh.y, v[e].z * rs * gv.z * (1.f + sc.z) + sh.z, v[e].w * rs * gv.w * (1.f + sc.w) + sh.w);
  }
}

template <int DK, int HK>
DI void attn_phase(const u16* __restrict__ Q, const u16* __restrict__ Kb, const u16* __restrict__ Vt, u16* __restrict__ obuf, char* smem_raw) {
  const int bid = opaque_bid();
  constexpr int KS = DK / 32, KSTR = DK, QSTR = 8 * DK, KROW = HK * DK, GRP = 8 / HK;
  constexpr int CPR = DK / 8;
  constexpr int KCH = 64 * CPR / 256;
  u16* sK = (u16*)smem_raw;
  u16* sV = sK + 64 * KSTR;
  const int tid = opaque_tid(), lane = tid & 63, wid = tid >> 6, l15 = lane & 15, g = lane >> 4;
  const float sc = rsqrtf((float)DK) * 1.4426950408889634f;
  for (int item = bid; item < 1280; item += gridDim.x) {
    int qb, h, kvlen, tokbase, kvbase;
    if (item < 1024) { const int b = item >> 7, rem = item & 127; h = rem & 7; qb = rem >> 3; kvlen = 2560; tokbase = NPROMPT + b * 2048; kvbase = NPROMPT + b * 2560; }
    else { const int it2 = item - 1024; const int b = it2 >> 4, rem = it2 & 15; h = rem & 7; qb = rem >> 3; kvlen = 256; tokbase = b * 256; kvbase = b * 256; }
    const int kvh = h / GRP;
    const u16* Kp = Kb + (size_t)kvbase * KROW + kvh * DK;
    const u16* Vp = Vt + (size_t)kvbase * (HK * 128) + (size_t)kvh * 128 * kvlen;
    const int qrow0 = tokbase + qb * 128 + wid * 32;
    bf16x8 qf[2][KS];
#pragma unroll
    for (int qi = 0; qi < 2; ++qi)
#pragma unroll
      for (int ks = 0; ks < KS; ++ks) qf[qi][ks] = ld8(Q + (size_t)(qrow0 + qi * 16 + l15) * QSTR + h * DK + ks * 32 + g * 8);
    f32x4 ot[2][8];
#pragma unroll
    for (int qi = 0; qi < 2; ++qi)
#pragma unroll
      for (int dj = 0; dj < 8; ++dj) { ot[qi][dj][0] = 0.f; ot[qi][dj][1] = 0.f; ot[qi][dj][2] = 0.f; ot[qi][dj][3] = 0.f; }
    float mrun[2] = {-1e30f, -1e30f}, lrun[2] = {0.f, 0.f};
    const int ntiles = kvlen >> 6;
    const unsigned toffK = (unsigned)((tid >> 3) * KROW + (tid & 7) * 8), toffV = (unsigned)((tid >> 3) * kvlen + (tid & 7) * 8);
    const int kx = tid >> 3;
    const int kperm = ((kx >> 2) & 1) * 16 + (kx >> 3) * 4 + (kx & 3);
    const int kswz = (CPR == 16) ? (kperm & 15) : ((kperm >> 1) & 7);
    const int ldsoffK = kperm * KSTR;
    const int ldsoffV = (tid >> 3) * 64 + (((tid & 7) ^ (((tid >> 3) >> 1) & 7)) * 8);
    u32x4 rk[KCH], rv[4];
#pragma unroll
    for (int i = 0; i < KCH; ++i) { const int rh = i & 1, cgp = i >> 1; rk[i] = *(const u32x4*)(Kp + (size_t)(rh * 32 * KROW + cgp * 64) + toffK); }
#pragma unroll
    for (int i = 0; i < 4; ++i) rv[i] = *(const u32x4*)(Vp + (size_t)i * 32 * kvlen + toffV);
    for (int kt = 0; kt < ntiles; ++kt) {
      const u16* Kt = Kp + (size_t)(kt + 1) * 64 * KROW;
      const u16* Vtp = Vp + (kt + 1) * 64;
      const bool more = kt + 1 < ntiles;
      __syncthreads();
#pragma unroll
      for (int i = 0; i < KCH; ++i) { const int rh = i & 1, cgp = i >> 1; const int c = (tid & 7) + 8 * cgp; const int pos = (CPR == 16) ? (c ^ kswz) : ((c & ~7) | ((c & 7) ^ kswz)); *(u32x4*)(sK + ldsoffK + rh * 32 * KSTR + pos * 8) = rk[i]; }
#pragma unroll
      for (int i = 0; i < 4; ++i) *(u32x4*)(sV + ldsoffV + i * 32 * 64) = rv[i];
      __syncthreads();
      if (more) {
#pragma unroll
        for (int i = 0; i < KCH; ++i) { const int rh = i & 1, cgp = i >> 1; rk[i] = *(const u32x4*)(Kt + (size_t)(rh * 32 * KROW + cgp * 64) + toffK); }
      }
      __builtin_amdgcn_sched_barrier(0);
      f32x4 st[2][4];
#pragma unroll
      for (int qi = 0; qi < 2; ++qi)
#pragma unroll
        for (int kj = 0; kj < 4; ++kj) { st[qi][kj][0] = 0.f; st[qi][kj][1] = 0.f; st[qi][kj][2] = 0.f; st[qi][kj][3] = 0.f; }
#pragma unroll
      for (int ks = 0; ks < KS; ++ks) {
#pragma unroll
        for (int kj = 0; kj < 4; ++kj) {
          const int kc = ks * 4 + g;
          const int kpos = (CPR == 16) ? (kc ^ l15) : ((kc & ~7) | ((kc & 7) ^ ((l15 >> 1) & 7)));
          const bf16x8 ka = ld8(sK + (kj * 16 + l15) * KSTR + kpos * 8);
          __builtin_amdgcn_s_setprio(1);
          st[0][kj] = mma(ka, qf[0][ks], st[0][kj]);
          st[1][kj] = mma(ka, qf[1][ks], st[1][kj]);
          __builtin_amdgcn_s_setprio(0);
        }
        __builtin_amdgcn_sched_barrier(0);
      }
      bf16x8 pf[2][2];
#pragma unroll
      for (int qi = 0; qi < 2; ++qi) {
        float mx = -1e30f;
#pragma unroll
        for (int kj = 0; kj < 4; ++kj)
#pragma unroll
          for (int r = 0; r < 4; ++r) mx = fmaxf(mx, st[qi][kj][r]);
        mx = fmaxf(mx, __shfl_xor(mx, 16)); mx = fmaxf(mx, __shfl_xor(mx, 32));
        const float mnew = fmaxf(mrun[qi], mx);
        const float alpha = __builtin_amdgcn_exp2f((mrun[qi] - mnew) * sc);
        mrun[qi] = mnew;
        float ps = 0.f;
        const float mneg = -mnew * sc;
#pragma unroll
        for (int kj = 0; kj < 4; ++kj)
#pragma unroll
          for (int r = 0; r < 4; ++r) { const float pv = __builtin_amdgcn_exp2f(fmaf(st[qi][kj][r], sc, mneg)); st[qi][kj][r] = pv; ps += pv; }
        lrun[qi] = lrun[qi] * alpha + ps;
#pragma unroll
        for (int dj = 0; dj < 8; ++dj) { ot[qi][dj][0] *= alpha; ot[qi][dj][1] *= alpha; ot[qi][dj][2] *= alpha; ot[qi][dj][3] *= alpha; }
        pf[qi][0] = pack8(st[qi][0], st[qi][1]);
        pf[qi][1] = pack8(st[qi][2], st[qi][3]);
        __builtin_amdgcn_sched_barrier(0);
      }
      if (more) {
#pragma unroll
        for (int i = 0; i < 4; ++i) rv[i] = *(const u32x4*)(Vtp + (size_t)i * 32 * kvlen + toffV);
      }
      __builtin_amdgcn_sched_barrier(0);
#pragma unroll
      for (int kk = 0; kk < 2; ++kk)
#pragma unroll
        for (int dj = 0; dj < 8; ++dj) {
          const bf16x8 va = ld8(sV + (dj * 16 + l15) * 64 + (((kk * 4 + g) ^ ((l15 >> 1) & 7)) * 8));
          __builtin_amdgcn_s_setprio(1);
          ot[0][dj] = mma(va, pf[0][kk], ot[0][dj]);
          ot[1][dj] = mma(va, pf[1][kk], ot[1][dj]);
          __builtin_amdgcn_s_setprio(0);
          if ((dj & 3) == 3) __builtin_amdgcn_sched_barrier(0);
        }
    }
#pragma unroll
    for (int qi = 0; qi < 2; ++qi) {
      const float inv = 1.f / sum_g(lrun[qi]);
      u16* dst = obuf + (size_t)(qrow0 + qi * 16 + l15) * 1024 + h * 128 + g * 4;
#pragma unroll
      for (int dj = 0; dj < 8; ++dj) st4bf(dst + dj * 16, ot[qi][dj][0] * inv, ot[qi][dj][1] * inv, ot[qi][dj][2] * inv, ot[qi][dj][3] * inv);
    }
  }
}

DI void gdn_chunk_phase(const P& p, int j, char* smem_raw) {
  const int bid = opaque_bid();
  char* const ws = opaque_ptr(as_global(p.ws));
  u16* sK = (u16*)smem_raw;
  float* sA = (float*)(smem_raw + 17408);
  float* sG = (float*)(smem_raw + 17408 + 32768);
  float* sBt = sG + 128;
  const int tid = opaque_tid(), lane = tid & 63, wid = tid >> 6, l15 = lane & 15, g = lane >> 4;
  const u16* proj = (const u16*)(ws + WS_R + R_PROJ);
  u16* qn = (u16*)(ws + WS_HBUF); u16* kn = (u16*)(ws + WS_OBUF); u16* vb = (u16*)(ws + WS_R + R_VBUF);
  u16* Tbuf = (u16*)(ws + WS_R + R_TBUF);
  const float* gbuf = (const float*)(ws + WS_R + R_GBUF);
  float* gcb = (float*)(ws + WS_R + R_GCB); float* betab = (float*)(ws + WS_R + R_BETA);
  float* egb = (float*)(ws + WS_R + R_EG); float* edb = (float*)(ws + WS_R + R_ED);
  const float* conv = GIN(17) + (size_t)j * 3 * 3072;
  const float* a_log = GIN(18) + j * 16; const float* dt_bias = GIN(19) + j * 16;
  for (int unit = bid; unit < 2560; unit += gridDim.x) {
    const int cgi = unit >> 3, h = unit & 7;
    int c, nch; if (cgi < 64) { c = cgi & 3; nch = 4; } else { c = (cgi - 64) & 31; nch = 32; }
    const int t0 = cgi * 64;
    const bool has_prev = c > 0, has_next = c < nch - 1;
    __syncthreads();
    {
      const int r = tid >> 4, cc = (tid & 15) * 8;
#pragma unroll
      for (int part = 0; part < 3; ++part) {
        const int ch = part * 1024 + h * 128 + cc;
        float w0[8], w1[8], w2[8];
#pragma unroll
        for (int e = 0; e < 8; ++e) { w0[e] = conv[ch + e]; w1[e] = conv[3072 + ch + e]; w2[e] = conv[6144 + ch + e]; }
        u16* dstb = part == 0 ? qn : (part == 1 ? kn : vb);
        for (int it = 0; it < 4; ++it) {
          const int i = it * 16 + r, t = t0 + i;
          const u16* src = proj + (size_t)t * 4096 + ch;
          const u32x4 xc = *(const u32x4*)src;
          u32x4 xp = {0u, 0u, 0u, 0u}, xn = {0u, 0u, 0u, 0u};
          if (i > 0 || has_prev) xp = *(const u32x4*)(src - 4096);
          if (i < 63 || has_next) xn = *(const u32x4*)(src + 4096);
          float y[8];
#pragma unroll
          for (int e = 0; e < 4; ++e) {
            float a = w0[2 * e] * bflo(xp[e]) + w1[2 * e] * bflo(xc[e]) + w2[2 * e] * bflo(xn[e]);
            float b = w0[2 * e + 1] * bfhi(xp[e]) + w1[2 * e + 1] * bfhi(xc[e]) + w2[2 * e + 1] * bfhi(xn[e]);
            y[2 * e] = a / (1.f + __expf(-a)); y[2 * e + 1] = b / (1.f + __expf(-b));
          }
          if (part < 2) {
            float ss = 0.f;
#pragma unroll
            for (int e = 0; e < 8; ++e) ss += y[e] * y[e];
            ss += __shfl_xor(ss, 1); ss += __shfl_xor(ss, 2); ss += __shfl_xor(ss, 4); ss += __shfl_xor(ss, 8);
            const float rs = rsqrtf(ss + EPS) * (part == 0 ? 0.08838834764831845f : 1.f);
#pragma unroll
            for (int e = 0; e < 8; ++e) y[e] *= rs;
          }
          u32x4 o; o[0] = pack2(y[0], y[1]); o[1] = pack2(y[2], y[3]); o[2] = pack2(y[4], y[5]); o[3] = pack2(y[6], y[7]);
          *(u32x4*)(dstb + (size_t)t * 1024 + h * 128 + cc) = o;
          if (part == 1) *(u32x4*)(sK + i * 136 + cc) = o;
        }
      }
    }
    if (tid < 128) {
      const int dir = tid >> 6, L = tid & 63;
      const int i = dir ? 63 - L : L;
      const float* gb = gbuf + (size_t)(t0 + i) * 32;
      const float gin = gb[dir * 8 + h], bin = gb[16 + dir * 8 + h];
      const float x = gin + dt_bias[dir * 8 + h];
      const float sp = fmaxf(x, 0.f) + log1pf(expf(-fabsf(x)));
      float gv = -expf(a_log[dir * 8 + h]) * sp;
      const float bt = 1.f / (1.f + expf(-bin));
#pragma unroll
      for (int off = 1; off < 64; off <<= 1) { const float v = __shfl_up(gv, off); if (L >= off) gv += v; }
      sG[dir * 64 + i] = gv; sBt[dir * 64 + i] = bt;
      gcb[((size_t)(t0 + i) * 8 + h) * 2 + dir] = gv; betab[((size_t)(t0 + i) * 8 + h) * 2 + dir] = bt;
      { const float gtot = __shfl(gv, 63); egb[((size_t)(t0 + i) * 8 + h) * 2 + dir] = expf(gv); edb[((size_t)(t0 + i) * 8 + h) * 2 + dir] = expf(gtot - gv); }
    }
    __syncthreads();
    {
      f32x4 ga[4];
#pragma unroll
      for (int mt = 0; mt < 4; ++mt) { ga[mt][0] = 0.f; ga[mt][1] = 0.f; ga[mt][2] = 0.f; ga[mt][3] = 0.f; }
#pragma unroll
      for (int ks = 0; ks < 4; ++ks) {
        const bf16x8 a = ld8(sK + (wid * 16 + l15) * 136 + ks * 32 + g * 8);
#pragma unroll
        for (int mt = 0; mt < 4; ++mt) { const bf16x8 b = ld8(sK + (mt * 16 + l15) * 136 + ks * 32 + g * 8); ga[mt] = mma(a, b, ga[mt]); }
      }
#pragma unroll
      for (int dir = 0; dir < 2; ++dir)
#pragma unroll
        for (int mt = 0; mt < 4; ++mt)
#pragma unroll
          for (int r = 0; r < 4; ++r) {
            const int i = wid * 16 + g * 4 + r, m = mt * 16 + l15;
            const bool valid = dir ? (i < m) : (i > m);
            const float val = valid ? sBt[dir * 64 + i] * ga[mt][r] * __expf(sG[dir * 64 + i] - sG[dir * 64 + m]) : 0.f;
            const int ii = dir ? 63 - i : i, mm = dir ? 63 - m : m;
            sA[dir * 4096 + ii * 64 + mm] = val;
          }
    }
    __syncthreads();
    if (wid < 2) {
      const int dir = wid;
      float* Am = sA + dir * 4096;
      for (int i = 0; i < 64; ++i) {
        float a = (i == lane) ? 1.f : 0.f;
        int m = 0;
        for (; m + 8 <= i; m += 8) {
          const float4 a0 = *(const float4*)(Am + i * 64 + m), a1 = *(const float4*)(Am + i * 64 + m + 4);
          float tv[8];
#pragma unroll
          for (int e = 0; e < 8; ++e) tv[e] = Am[(m + e) * 64 + lane];
          a -= a0.x * tv[0]; a -= a0.y * tv[1]; a -= a0.z * tv[2]; a -= a0.w * tv[3];
          a -= a1.x * tv[4]; a -= a1.y * tv[5]; a -= a1.z * tv[6]; a -= a1.w * tv[7];
        }
        for (; m < i; ++m) a -= Am[i * 64 + m] * Am[m * 64 + lane];
        Am[i * 64 + lane] = a;
      }
      const int mn = dir ? 63 - lane : lane;
      const float bm = sBt[dir * 64 + mn];
      u16* Td = Tbuf + ((size_t)unit * 2 + dir) * 4096;
#pragma unroll 4
      for (int i = 0; i < 64; ++i) { const int in_ = dir ? 63 - i : i; Td[in_ * 64 + mn] = f2bf(Am[i * 64 + lane] * bm); }
    }
  }
}

DI void gdn_scan_phase(const P& p, int j, char* smem_raw) {
  const int bid = opaque_bid();
  char* const ws = opaque_ptr(as_global(p.ws));
  u16* sK = (u16*)smem_raw;
  u16* sV = sK + 64 * 136;
  u16* sST = sV + 64 * 40;
  u16* sVN = sST + 32 * 136;
  u16* sVD = sVN + 32 * 72;
  float* sGc = (float*)(sVD + 32 * 72);
  float* sE = sGc + 64;
  float* sD = sE + 64;
  const int tid = opaque_tid(), lane = tid & 63, w = tid >> 6, l15 = lane & 15, g = lane >> 4;
  const u16* qn = (const u16*)(ws + WS_HBUF); const u16* kn = (const u16*)(ws + WS_OBUF); const u16* vb = (const u16*)(ws + WS_R + R_VBUF);
  const u16* Tbuf = (const u16*)(ws + WS_R + R_TBUF);
  const float* gcb = (const float*)(ws + WS_R + R_GCB);
  const float* egb = (const float*)(ws + WS_R + R_EG); const float* edb = (const float*)(ws + WS_R + R_ED);
  u16* obase = (u16*)(ws + WS_R + R_PROJ);
  for (int wk = bid; wk < 1536; wk += gridDim.x) {
    int seq, rem;
    if (wk < 512) { seq = 16 + (wk >> 6); rem = wk & 63; } else { seq = (wk - 512) >> 6; rem = (wk - 512) & 63; }
    const int h = rem & 7, dir = (rem >> 5) & 1, dvq = (rem >> 3) & 3;
    const int nch = seq < 16 ? 4 : 32;
    const int cgb = seq < 16 ? seq * 4 : 64 + (seq - 16) * 32;
    f32x4 S[2][2];
    if (seq >= 16) {
      const float* s0 = GIN(2 + dir) + (((size_t)(seq - 16) * 2 + j) * 8 + h) * 16384;
#pragma unroll
      for (int dt = 0; dt < 2; ++dt)
#pragma unroll
        for (int et = 0; et < 2; ++et)
#pragma unroll
          for (int r = 0; r < 4; ++r) S[dt][et][r] = s0[(size_t)(w * 32 + dt * 16 + g * 4 + r) * 128 + dvq * 32 + et * 16 + l15];
    } else {
#pragma unroll
      for (int dt = 0; dt < 2; ++dt)
#pragma unroll
        for (int et = 0; et < 2; ++et) { S[dt][et][0] = 0.f; S[dt][et][1] = 0.f; S[dt][et][2] = 0.f; S[dt][et][3] = 0.f; }
    }
    __syncthreads();
#pragma unroll
    for (int dt = 0; dt < 2; ++dt)
#pragma unroll
      for (int et = 0; et < 2; ++et) st4bf(sST + (et * 16 + l15) * 136 + w * 32 + dt * 16 + g * 4, S[dt][et][0], S[dt][et][1], S[dt][et][2], S[dt][et][3]);
    u32x4 pk[4], pv; float pg = 0.f, pe = 0.f, pd = 0.f;
#define SCAN_PREFETCH(cc) do { \
      const int t0n_ = (cgb + (cc)) * 64; \
      _Pragma("unroll") for (int i = 0; i < 4; ++i) { const int ci = tid + 256 * i; const int row = ci >> 4, dc = (ci & 15) * 8; pk[i] = *(const u32x4*)(kn + (size_t)(t0n_ + row) * 1024 + h * 128 + dc); } \
      { const int row = tid >> 2, ec = (tid & 3) * 8; pv = *(const u32x4*)(vb + (size_t)(t0n_ + row) * 1024 + h * 128 + dvq * 32 + ec); } \
      if (tid < 64) { const size_t gi_ = ((size_t)(t0n_ + tid) * 8 + h) * 2 + dir; pg = gcb[gi_]; pe = egb[gi_]; pd = edb[gi_]; } \
    } while (0)
    SCAN_PREFETCH(dir ? nch - 1 : 0);
    for (int step = 0; step < nch; ++step) {
      const int c = dir ? nch - 1 - step : step;
      const int t0 = (cgb + c) * 64;
      const int unit = (cgb + c) * 8 + h;
#pragma unroll
      for (int i = 0; i < 4; ++i) {
        const int ci = tid + 256 * i; const int row = ci >> 4, dc = (ci & 15) * 8;
        *(u32x4*)(sK + row * 136 + dc) = pk[i];
      }
      { const int row = tid >> 2, ec = (tid & 3) * 8; *(u32x4*)(sV + row * 40 + ec) = pv; }
      if (tid < 64) { sGc[tid] = pg; sE[tid] = pe; sD[tid] = pd; }
      bf16x8 qf[4], tf[2];
#pragma unroll
      for (int ks = 0; ks < 4; ++ks) qf[ks] = ld8(qn + (size_t)(t0 + w * 16 + l15) * 1024 + h * 128 + ks * 32 + g * 8);
#pragma unroll
      for (int ks = 0; ks < 2; ++ks) tf[ks] = ld8(Tbuf + ((size_t)unit * 2 + dir) * 4096 + (w * 16 + l15) * 64 + ks * 32 + g * 8);
      __syncthreads();
      if (step + 1 < nch) { const int cn = dir ? nch - 2 - step : step + 1; SCAN_PREFETCH(cn); }
      const float gl = dir ? sGc[0] : sGc[63];
      bf16x8 wf[4];
      f32x4 ua[2];
      {
        bf16x8 vtf[2][2], ktf[4][2];
        f32x4 egm[2][2];
#pragma unroll
        for (int et = 0; et < 2; ++et)
#pragma unroll
          for (int ks = 0; ks < 2; ++ks) vtf[et][ks] = ldtr(sV + (ks * 32 + g * 8 + (l15 >> 2)) * 40 + et * 16 + (l15 & 3) * 4, 4 * 40);
#pragma unroll
        for (int ks = 0; ks < 2; ++ks) { egm[ks][0] = *(const f32x4*)(sE + ks * 32 + g * 8); egm[ks][1] = *(const f32x4*)(sE + ks * 32 + g * 8 + 4); }
#pragma unroll
        for (int dt = 0; dt < 4; ++dt)
#pragma unroll
          for (int ks = 0; ks < 2; ++ks) ktf[dt][ks] = ldtr(sK + (ks * 32 + g * 8 + (l15 >> 2)) * 136 + dt * 16 + (l15 & 3) * 4, 4 * 136);
        __builtin_amdgcn_sched_barrier(0);
#pragma unroll
        for (int et = 0; et < 2; ++et) {
          ua[et][0] = 0.f; ua[et][1] = 0.f; ua[et][2] = 0.f; ua[et][3] = 0.f;
#pragma unroll
          for (int ks = 0; ks < 2; ++ks) ua[et] = mma(tf[ks], vtf[et][ks], ua[et]);
        }
#pragma unroll
        for (int ks = 0; ks < 2; ++ks) {
          const u32x4 tw = __builtin_bit_cast(u32x4, tf[ks]);
          u32x4 o;
#pragma unroll
          for (int e = 0; e < 4; ++e) o[e] = pack2(bflo(tw[e]) * egm[ks][e >> 1][(2 * e) & 3], bfhi(tw[e]) * egm[ks][e >> 1][(2 * e + 1) & 3]);
          tf[ks] = __builtin_bit_cast(bf16x8, o);
        }
#pragma unroll
        for (int kq = 0; kq < 2; ++kq) {
          f32x4 wa[2];
#pragma unroll
          for (int hh = 0; hh < 2; ++hh) {
            wa[hh][0] = 0.f; wa[hh][1] = 0.f; wa[hh][2] = 0.f; wa[hh][3] = 0.f;
#pragma unroll
            for (int ks = 0; ks < 2; ++ks) wa[hh] = mma(ktf[kq * 2 + hh][ks], tf[ks], wa[hh]);
          }
          wf[kq] = pack8(wa[0], wa[1]);
        }
        __builtin_amdgcn_sched_barrier(0);
      }
      {
        bf16x8 ktf[4][2];
#pragma unroll
        for (int dt = 0; dt < 4; ++dt)
#pragma unroll
          for (int ks = 0; ks < 2; ++ks) ktf[dt][ks] = ldtr(sK + (ks * 32 + g * 8 + (l15 >> 2)) * 136 + (4 + dt) * 16 + (l15 & 3) * 4, 4 * 136);
        __builtin_amdgcn_sched_barrier(0);
#pragma unroll
        for (int kq = 2; kq < 4; ++kq) {
          f32x4 wa[2];
#pragma unroll
          for (int hh = 0; hh < 2; ++hh) {
            wa[hh][0] = 0.f; wa[hh][1] = 0.f; wa[hh][2] = 0.f; wa[hh][3] = 0.f;
#pragma unroll
            for (int ks = 0; ks < 2; ++ks) wa[hh] = mma(ktf[(kq - 2) * 2 + hh][ks], tf[ks], wa[hh]);
          }
          wf[kq] = pack8(wa[0], wa[1]);
        }
        __builtin_amdgcn_sched_barrier(0);
      }
      const int iq = w * 16 + l15;
      const float gi = sGc[iq];
      const f32x4 dvec = *(const f32x4*)(sD + w * 16 + g * 4);
      f32x4 vn[2];
      bf16x8 qkf[2];
#pragma unroll
      for (int kk = 0; kk < 2; ++kk) {
        bf16x8 kf[2][4];
        f32x4 gcm[2];
#pragma unroll
        for (int hh = 0; hh < 2; ++hh)
#pragma unroll
          for (int ks = 0; ks < 4; ++ks) kf[hh][ks] = ld8(sK + ((kk * 2 + hh) * 16 + l15) * 136 + ks * 32 + g * 8);
#pragma unroll
        for (int hh = 0; hh < 2; ++hh) gcm[hh] = *(const f32x4*)(sGc + (kk * 2 + hh) * 16 + g * 4);
        bf16x8 stp[2][4];
        if (kk == 0) {
#pragma unroll
          for (int et = 0; et < 2; ++et)
#pragma unroll
            for (int kq = 0; kq < 4; ++kq) { const u16* sp = sST + (et * 16 + l15) * 136 + kq * 32 + g * 4; stp[et][kq] = ld44(sp, sp + 16); }
        }
        __builtin_amdgcn_sched_barrier(0);
        if (kk == 0) {
#pragma unroll
          for (int et = 0; et < 2; ++et) {
            f32x4 a; a[0] = 0.f; a[1] = 0.f; a[2] = 0.f; a[3] = 0.f;
#pragma unroll
            for (int kq = 0; kq < 4; ++kq) a = mma(wf[kq], stp[et][kq], a);
            vn[et][0] = ua[et][0] - a[0]; vn[et][1] = ua[et][1] - a[1]; vn[et][2] = ua[et][2] - a[2]; vn[et][3] = ua[et][3] - a[3];
          }
        }
        f32x4 ka[2];
#pragma unroll
        for (int hh = 0; hh < 2; ++hh) {
          const int mt = kk * 2 + hh;
          ka[hh][0] = 0.f; ka[hh][1] = 0.f; ka[hh][2] = 0.f; ka[hh][3] = 0.f;
#pragma unroll
          for (int ks = 0; ks < 4; ++ks) ka[hh] = mma(kf[hh][ks], qf[ks], ka[hh]);
#pragma unroll
          for (int r = 0; r < 4; ++r) {
            const int m = mt * 16 + g * 4 + r;
            const bool valid = dir ? (iq <= m) : (iq >= m);
            ka[hh][r] = ka[hh][r] * __expf(valid ? gi - gcm[hh][r] : -1e30f);
          }
        }
        qkf[kk] = pack8(ka[0], ka[1]);
        __builtin_amdgcn_sched_barrier(0);
      }
#pragma unroll
      for (int et = 0; et < 2; ++et) {
        const int i0 = w * 16 + g * 4;
        st4bf(sVN + (et * 16 + l15) * 72 + i0, vn[et][0], vn[et][1], vn[et][2], vn[et][3]);
        st4bf(sVD + (et * 16 + l15) * 72 + i0, vn[et][0] * dvec[0], vn[et][1] * dvec[1], vn[et][2] * dvec[2], vn[et][3] * dvec[3]);
      }
      __syncthreads();
      {
        bf16x8 stn[2][4], vnp[2][2];
#pragma unroll
        for (int et = 0; et < 2; ++et)
#pragma unroll
          for (int ks = 0; ks < 4; ++ks) stn[et][ks] = ld8(sST + (et * 16 + l15) * 136 + ks * 32 + g * 8);
#pragma unroll
        for (int et = 0; et < 2; ++et)
#pragma unroll
          for (int kk = 0; kk < 2; ++kk) { const u16* sp = sVN + (et * 16 + l15) * 72 + kk * 32 + g * 4; vnp[et][kk] = ld44(sp, sp + 16); }
        const f32x4 egi = *(const f32x4*)(sE + w * 16 + g * 4);
        __builtin_amdgcn_sched_barrier(0);
#pragma unroll
        for (int et = 0; et < 2; ++et) {
          f32x4 a1; a1[0] = 0.f; a1[1] = 0.f; a1[2] = 0.f; a1[3] = 0.f;
#pragma unroll
          for (int ks = 0; ks < 4; ++ks) a1 = mma(qf[ks], stn[et][ks], a1);
          f32x4 a2; a2[0] = 0.f; a2[1] = 0.f; a2[2] = 0.f; a2[3] = 0.f;
#pragma unroll
          for (int kk = 0; kk < 2; ++kk) a2 = mma(qkf[kk], vnp[et][kk], a2);
#pragma unroll
          for (int r = 0; r < 4; ++r) {
            const int i = w * 16 + g * 4 + r;
            const float o = a1[r] * egi[r] + a2[r];
            obase[(size_t)(t0 + i) * 4096 + dir * 1024 + h * 128 + dvq * 32 + et * 16 + l15] = f2bf(o);
          }
        }
        __builtin_amdgcn_sched_barrier(0);
      }
      {
        bf16x8 ktf2[2][2], vdf[2][2];
#pragma unroll
        for (int dt = 0; dt < 2; ++dt)
#pragma unroll
          for (int kk = 0; kk < 2; ++kk) { ktf2[dt][kk] = ldtr(sK + (kk * 32 + g * 8 + (l15 >> 2)) * 136 + w * 32 + dt * 16 + (l15 & 3) * 4, 4 * 136); vdf[dt][kk] = ld8(sVD + (dt * 16 + l15) * 72 + kk * 32 + g * 8); }
        __builtin_amdgcn_sched_barrier(0);
        const float eg = __expf(gl);
#pragma unroll
        for (int dt = 0; dt < 2; ++dt)
#pragma unroll
          for (int et = 0; et < 2; ++et) {
            f32x4 a; a[0] = S[dt][et][0] * eg; a[1] = S[dt][et][1] * eg; a[2] = S[dt][et][2] * eg; a[3] = S[dt][et][3] * eg;
#pragma unroll
            for (int kk = 0; kk < 2; ++kk) a = mma(ktf2[dt][kk], vdf[et][kk], a);
            S[dt][et] = a;
          }
      }
      __syncthreads();
#pragma unroll
      for (int dt = 0; dt < 2; ++dt)
#pragma unroll
        for (int et = 0; et < 2; ++et) st4bf(sST + (et * 16 + l15) * 136 + w * 32 + dt * 16 + g * 4, S[dt][et][0], S[dt][et][1], S[dt][et][2], S[dt][et][3]);
    }
    if (seq < 16) {
      float* so = GOUT + (dir ? O_SB : O_SF) + (((size_t)seq * 2 + j) * 8 + h) * 16384;
#pragma unroll
      for (int dt = 0; dt < 2; ++dt)
#pragma unroll
        for (int et = 0; et < 2; ++et)
#pragma unroll
          for (int r = 0; r < 4; ++r) so[(size_t)(w * 32 + dt * 16 + g * 4 + r) * 128 + dvq * 32 + et * 16 + l15] = S[dt][et][r];
    }
  }
}

#define XB_TMO      128
#define XB_XCNT(j)  (256  + 64 * (j))
#define XB_XSUB(j)  (1280 + 64 * (j))
#define XB_XGEN(j)  (2304 + 64 * (j))
#define XB_TOP      3328
#define XB_TOPGEN   3392
#define XCD_BAR_WORDS 3456
#define XB_SPIN_CAP (1u << 20)
#define LAS __attribute__((address_space(3)))
DI unsigned xb_ld(unsigned* p)              { return __hip_atomic_load(p, __ATOMIC_RELAXED, __HIP_MEMORY_SCOPE_AGENT); }
DI unsigned xb_add(unsigned* p, unsigned v) { return __hip_atomic_fetch_add(p, v, __ATOMIC_RELAXED, __HIP_MEMORY_SCOPE_AGENT); }
DI unsigned xb_xcc_id() { return (unsigned)__builtin_amdgcn_s_getreg((3 << 11) | 20) & 0xFu; }
#define XB_SPIN(cond, bar) do { unsigned _sp = 0; while (cond) { __builtin_amdgcn_s_sleep(1); \
    if ((++_sp & 255u) == 0u) { if (xb_ld(&(bar)[XB_TMO])) break; if (_sp > XB_SPIN_CAP) { atomicAdd(&(bar)[XB_TMO], 1u); break; } } } } while (0)
struct XcdBarrier { unsigned* bar; unsigned x; volatile LAS unsigned* st; };
DI XcdBarrier xcd_barrier_post(unsigned* bar, volatile LAS unsigned* st) {
  XcdBarrier b; b.bar = bar; b.x = xb_xcc_id(); b.st = st;
  if (threadIdx.x == 0) (void)xb_add(&bar[XB_XCNT(b.x)], 1u);
  return b;
}
DI void xcd_barrier_complete(unsigned* bar, unsigned x, unsigned& nloc, unsigned& nx) {
  const unsigned Gn = gridDim.x * gridDim.y * gridDim.z;
  unsigned sum, cnt, mine, sp = 0u;
  for (;;) {
    sum = 0u; cnt = 0u; mine = 0u;
#pragma unroll
    for (unsigned j = 0; j < 16; ++j) { const unsigned c = xb_ld(&bar[XB_XCNT(j)]); sum += c; cnt += (c > 0u) ? 1u : 0u; mine = (j == x) ? c : mine; }
    if (sum == Gn) break;
    __builtin_amdgcn_s_sleep(1);
    if ((++sp & 255u) == 0u) { if (xb_ld(&bar[XB_TMO])) break; if (sp > XB_SPIN_CAP) { atomicAdd(&bar[XB_TMO], 1u); break; } }
  }
  nloc = mine > 0u ? mine : 1u; nx = cnt > 0u ? cnt : 1u;
}
DI void xcd_barrier(const XcdBarrier& b) {
  asm volatile("s_waitcnt vmcnt(0)" ::: "memory");
  __syncthreads();
  if (threadIdx.x == 0) {
    unsigned* bar = b.bar;
    __builtin_amdgcn_s_waitcnt(0);
    unsigned nloc = b.st[0], nx = b.st[1];
    if (nloc == 0u) { xcd_barrier_complete(bar, b.x, nloc, nx); b.st[0] = nloc; b.st[1] = nx; }
    const unsigned old = xb_add(&bar[XB_XSUB(b.x)], 1u);
    const unsigned gen = old / nloc;
    if (old + 1u == (gen + 1u) * nloc) {
      __builtin_amdgcn_fence(__ATOMIC_RELEASE, "agent");
      asm volatile("s_waitcnt vmcnt(0)" ::: "memory");
      const unsigned og = xb_add(&bar[XB_TOP], 1u);
      const unsigned tg = og / nx;
      if (og + 1u == (tg + 1u) * nx) xb_add(&bar[XB_TOPGEN], 1u);
      else XB_SPIN(xb_ld(&bar[XB_TOPGEN]) == tg, bar);
      __builtin_amdgcn_fence(__ATOMIC_ACQUIRE, "agent");
      xb_add(&bar[XB_XGEN(b.x)], 1u);
      asm volatile("s_waitcnt vmcnt(0)" ::: "memory");
    } else {
      XB_SPIN(xb_ld(&bar[XB_XGEN(b.x)]) == gen, bar);
      __builtin_amdgcn_fence(__ATOMIC_ACQUIRE, "agent");
      asm volatile("s_waitcnt vmcnt(0)" ::: "memory");
    }
  }
  __syncthreads();
}

__global__ void __launch_bounds__(256, 2) fwd_megakernel(P p) {
  cg::grid_group grid = cg::this_grid();
  __shared__ __attribute__((aligned(16))) char smem[60416];
  const int tid = opaque_tid(), lane = tid & 63, wid = tid >> 6;
  const int G = gridDim.x;
  __shared__ uint4 xb_words;
  if (threadIdx.x == 0) xb_words = make_uint4(0u, 0u, 0u, 0u);
  __syncthreads();
  (void)xcd_barrier_post((unsigned*)(as_global(p.ws) + WS_BAR), (volatile LAS unsigned*)&xb_words);
#define GSYNC() do { XcdBarrier xb_; xb_.bar = (unsigned*)(opaque_ptr(as_global(p.ws)) + WS_BAR); xb_.x = xb_xcc_id(); xb_.st = (volatile LAS unsigned*)&xb_words; xcd_barrier(xb_); } while (0)
  const int bid0 = opaque_bid();
  {
  char* const ws0 = opaque_ptr(as_global(p.ws));
  float* mods = (float*)(ws0 + WS_MODS);
  float* ropeT = (float*)(ws0 + WS_ROPE);
  float* cosG = ropeT, *sinG = ropeT + 2048, *cosM = ropeT + 4096, *sinM = ropeT + 5120;

  {
    float* sc = (float*)smem;
    float* red = sc + 9 * 128;
    float* part = (float*)(ws0 + WS_R);
    for (int item = bid0; item < 3072; item += G) {
      const int ks = item & 7, cgp = (item >> 3) % 96, layer = item / 768;
      __syncthreads();
      for (int e = tid; e < 9 * 128; e += 256) {
        const int ci = e >> 7, k = ks * 128 + (e & 127);
        const float v = ci == 0 ? GIN(9)[k] : GIN(8)[(ci - 1) * 1024 + k];
        sc[e] = v / (1.f + expf(-v));
      }
      __syncthreads();
      const int col = tid & 63, kg = tid >> 6;
      const float* wp = GIN(12) + ((size_t)layer * 1024 + ks * 128 + kg * 32) * 6144 + cgp * 64 + col;
      float acc[9];
#pragma unroll
      for (int ci = 0; ci < 9; ++ci) acc[ci] = 0.f;
#pragma unroll 8
      for (int kk = 0; kk < 32; ++kk) {
        const float wv = wp[(size_t)kk * 6144];
#pragma unroll
        for (int ci = 0; ci < 9; ++ci) acc[ci] += sc[ci * 128 + kg * 32 + kk] * wv;
      }
#pragma unroll
      for (int ci = 0; ci < 9; ++ci) red[(kg * 64 + col) * 9 + ci] = acc[ci];
      __syncthreads();
      if (kg == 0) {
        const int n = cgp * 64 + col;
        const float bias = ks == 0 ? GIN(13)[(size_t)layer * 6144 + n] : 0.f;
#pragma unroll
        for (int ci = 0; ci < 9; ++ci) {
          const float s = red[col * 9 + ci] + red[(64 + col) * 9 + ci] + red[(128 + col) * 9 + ci] + red[(192 + col) * 9 + ci] + bias;
          part[(size_t)ks * 221184 + ((size_t)layer * 9 + ci) * 6144 + n] = s;
        }
      }
    }
    if (bid0 == G - 1) {
      for (int e = tid; e < 2048; e += 256) { const int pos = e >> 5, f = e & 31; const float fr = powf(10000.f, -(float)f / 32.f); const float a = (float)pos * fr; cosG[e] = cosf(a); sinG[e] = sinf(a); }
      for (int e = tid; e < 1024; e += 256) { const int pos = e >> 4, f = e & 15; const float fr = powf(10000.f, -(float)f / 16.f); const float a = (float)pos * fr; cosM[e] = cosf(a); sinM[e] = sinf(a); }
    }
  }
  if (gridDim.x == 0x7fffffffu) grid.sync();
  GSYNC();
  {
    const float* part = (const float*)(ws0 + WS_R);
    for (int e = bid0 * 256 + tid; e < 221184; e += G * 256) {
      float sacc = 0.f;
#pragma unroll
      for (int ks = 0; ks < 8; ++ks) sacc += part[(size_t)ks * 221184 + e];
      mods[e] = sacc;
    }
  }
  }
  GSYNC();

#pragma unroll 1
  for (int layer = 0; layer < 4; ++layer) {
    const int kind = layer % 3, j = layer / 3;
    const int bid = opaque_bid();
    char* const ws = opaque_ptr(as_global(p.ws));
    float* mods = (float*)(ws + WS_MODS);
    float* ropeT = (float*)(ws + WS_ROPE);
    float* cosG = ropeT, *sinG = ropeT + 2048, *cosM = ropeT + 4096, *sinM = ropeT + 5120;
    u16* hbuf = (u16*)(ws + WS_HBUF);
    u16* obuf = (u16*)(ws + WS_OBUF);
    u16* wmix = (u16*)(ws + WS_WMIX);
    u16* wmlp = (u16*)(ws + WS_WMLP);
    char* R = ws + WS_R;
    const float* lmods = mods + (size_t)layer * 9 * 6144;
    {
      for (int it = bid; it < 5120; it += G) norm_rows(p, layer, layer == 0, it, GIN(10) + layer * 1024, 0, 1);
      float* sT = (float*)smem;
      for (int it = bid; it < 2048; it += G) {
        if (it < 1024) convert_tile(GIN(14) + (size_t)layer * 1024 * 4096, 1024, 4096, wmlp, it, 0, sT);
        else convert_tile(GIN(15) + (size_t)layer * 4096 * 1024, 4096, 1024, wmlp + 4194304, it - 1024, 0, sT);
      }
      if (kind == 0) {
        for (int it = bid; it < 1056 + 256; it += G) {
          if (it < 1056) convert_tile(GIN(16) + (size_t)j * 1024 * 4128, 1024, 4128, wmix + WM_IN, it, 0, sT);
          else convert_tile(GIN(21) + (size_t)j * 1024 * 1024, 1024, 1024, wmix + WM_OUT, it - 1056, 0, sT);
        }
      } else if (kind == 1) {
        for (int it = bid; it < 192 + 144 + 128 + 256; it += G) {
          if (it < 192) convert_tile(GIN(22), 1024, 704, wmix + WM_IN, it, 0, sT);
          else if (it < 336) convert_tile(GIN(25), 384, 1536, wmix + WM_UQ, it - 192, 1, sT);
          else if (it < 464) convert_tile(GIN(26), 256, 2048, wmix + WM_UKV, it - 336, 0, sT);
          else convert_tile(GIN(31), 1024, 1024, wmix + WM_OUT, it - 464, 0, sT);
        }
      } else {
        for (int it = bid; it < 384 + 256; it += G) {
          if (it < 384) convert_tile(GIN(32), 1024, 1536, wmix + WM_IN, it, 0, sT);
          else convert_tile(GIN(35), 1024, 1024, wmix + WM_OUT, it - 384, 0, sT);
        }
        u16* Kg = (u16*)(R + R_KG); u16* Vg = (u16*)(R + R_VTG);
        const int tid = opaque_tid();
        for (int it = bid; it < 512; it += G) {
          const int b = it >> 6, s0 = (it & 63) * 8;
          const int ch = tid;
          float kv[8], vv[8];
#pragma unroll
          for (int e = 0; e < 8; ++e) { kv[e] = GIN(6)[((size_t)b * 512 + s0 + e) * 256 + ch]; vv[e] = GIN(7)[((size_t)b * 512 + s0 + e) * 256 + ch]; }
#pragma unroll
          for (int e = 0; e < 8; ++e) Kg[(size_t)(NPROMPT + b * 2560 + s0 + e) * 256 + ch] = f2bf(kv[e]);
          u32x4 o; o[0] = pack2(vv[0], vv[1]); o[1] = pack2(vv[2], vv[3]); o[2] = pack2(vv[4], vv[5]); o[3] = pack2(vv[6], vv[7]);
          *(u32x4*)(Vg + (size_t)(NPROMPT + b * 2560) * 256 + (size_t)ch * 2560 + s0) = o;
        }
      }
    }
    GSYNC();

    if (kind == 0) {
      {
        EpiGdnIn epi; epi.proj = (u16*)(R + R_PROJ); epi.gbuf = (float*)(R + R_GBUF);
        for (int it = bid; it < 160 * 16; it += G) { const int mt = it >> 4, nt = it & 15; gemm_tile_wide(hbuf, 1024, wmix + WM_IN, 1024, 1024, mt * 128, nt * 256, (u16*)smem, epi); }
        for (int it = bid; it < 160; it += G) gemm_tile<4>(hbuf, 1024, wmix + WM_IN, 1024, 1024, it * 128, 4096, (u16*)smem, epi);
      }
      GSYNC();
      gdn_chunk_phase(p, j, smem);
      GSYNC();
      gdn_scan_phase(p, j, smem);
      GSYNC();
      {
        const u16* pr = (const u16*)(R + R_PROJ);
        const float* on = GIN(20) + j * 128;
        const int tid = opaque_tid();
        for (int t = bid; t < NTOK; t += G) {
          const int h = tid >> 5, c = (tid & 31) * 4;
          const u16* row = pr + (size_t)t * 4096;
          const u32x2 f = *(const u32x2*)(row + h * 128 + c), b = *(const u32x2*)(row + 1024 + h * 128 + c), z = *(const u32x2*)(row + 3072 + h * 128 + c);
          float o[4] = {bflo(f[0]) + bflo(b[0]), bfhi(f[0]) + bfhi(b[0]), bflo(f[1]) + bflo(b[1]), bfhi(f[1]) + bfhi(b[1])};
          float zz[4] = {bflo(z[0]), bfhi(z[0]), bflo(z[1]), bfhi(z[1])};
          float ss = o[0] * o[0] + o[1] * o[1] + o[2] * o[2] + o[3] * o[3];
          ss += __shfl_xor(ss, 1); ss += __shfl_xor(ss, 2); ss += __shfl_xor(ss, 4); ss += __shfl_xor(ss, 8); ss += __shfl_xor(ss, 16);
          const float rs = rsqrtf(ss * (1.f / 128.f) + EPS);
          const float4 gn = *(const float4*)(on + c);
          const float gg[4] = {gn.x, gn.y, gn.z, gn.w};
          float y[4];
#pragma unroll
          for (int e = 0; e < 4; ++e) y[e] = o[e] * rs * gg[e] * (zz[e] / (1.f + __expf(-zz[e])));
          st4bf(obuf + (size_t)t * 1024 + h * 128 + c, y[0], y[1], y[2], y[3]);
        }
      }
      GSYNC();
    } else if (kind == 1) {
      {
        EpiF32 epi; epi.dst = (float*)(R + R_DPROJ); epi.ld = 768;
        for (int it = bid; it < 160 * 6; it += G) { const int mt = it / 6, nt = it % 6; gemm_tile<4>(hbuf, 1024, wmix + WM_IN, 1024, 1024, mt * 128, nt * 128, (u16*)smem, epi); }
      }
      GSYNC();
      {
        const float* dproj = (const float*)(R + R_DPROJ);
        u16* cq = (u16*)(R + R_CQ); u16* ckv = (u16*)(R + R_CKV); u16* Km = (u16*)(R + R_KM);
        const int tid = opaque_tid(), lane = tid & 63, wid = tid >> 6;
        for (int it = bid; it < 6144; it += G) {
          const int row = it * 4 + wid;
          if (row < NTOK) {
            const int t = row;
            const float* pr = dproj + (size_t)t * 768;
            float v[6]; float ss = 0.f;
#pragma unroll
            for (int e = 0; e < 6; ++e) { v[e] = pr[lane + 64 * e]; ss += v[e] * v[e]; }
            ss = wave_sum(ss);
            float rs = rsqrtf(ss * (1.f / 384.f) + EPS);
#pragma unroll
            for (int e = 0; e < 6; ++e) cq[(size_t)t * 384 + lane + 64 * e] = f2bf(v[e] * rs * GIN(23)[lane + 64 * e]);
            const int kvrow = kvrow_of_tok(t);
            float wv[4]; ss = 0.f;
#pragma unroll
            for (int e = 0; e < 4; ++e) { wv[e] = pr[384 + lane + 64 * e]; ss += wv[e] * wv[e]; }
            ss = wave_sum(ss);
            rs = rsqrtf(ss * (1.f / 256.f) + EPS);
#pragma unroll
            for (int e = 0; e < 4; ++e) {
              const float o = wv[e] * rs * GIN(24)[lane + 64 * e];
              ckv[(size_t)kvrow * 256 + lane + 64 * e] = f2bf(o);
              if (t < NPROMPT) GOUT[O_CKV + (size_t)t * 256 + lane + 64 * e] = o;
            }
            const float x = pr[640 + lane];
            ss = wave_sum(x * x);
            float kr = x * rsqrtf(ss * (1.f / 64.f) + EPS) * GIN(30)[lane];
            if (t < NPROMPT) GOUT[O_KR + (size_t)t * 64 + lane] = kr;
            else {
              const int s = (t - NPROMPT) & 2047;
              const int pos = lane < 32 ? (s >> 6) : (s & 63);
              const float cs = cosM[pos * 16 + (lane & 15)], sn = sinM[pos * 16 + (lane & 15)];
              const float partner = __shfl_xor(kr, 16);
              kr = ((lane & 16) == 0) ? kr * cs - partner * sn : partner * sn + kr * cs;
            }
            const u16 kb = f2bf(kr);
#pragma unroll
            for (int hh = 0; hh < 8; ++hh) Km[(size_t)kvrow * 1536 + hh * 192 + 128 + lane] = kb;
          } else {
            const int r = row - NTOK; const int b = r >> 9, s = r & 511;
            const int kvrow = NPROMPT + b * 2560 + s;
#pragma unroll
            for (int e = 0; e < 4; ++e) ckv[(size_t)kvrow * 256 + lane + 64 * e] = f2bf(GIN(4)[((size_t)b * 512 + s) * 256 + lane + 64 * e]);
            const u16 kb = f2bf(GIN(5)[((size_t)b * 512 + s) * 64 + lane]);
#pragma unroll
            for (int hh = 0; hh < 8; ++hh) Km[(size_t)kvrow * 1536 + hh * 192 + 128 + lane] = kb;
          }
        }
      }
      GSYNC();
      {
        EpiMlaUq e1; e1.Q = (u16*)(R + R_Q); e1.gnope = GIN(27); e1.grope = GIN(28); e1.cosT = cosM; e1.sinT = sinM;
        for (int it = bid; it < 160 * 12; it += G) { const int mt = it / 12, nt = it % 12; gemm_tile<8>((const u16*)(R + R_CQ), 384, wmix + WM_UQ, 384, 384, mt * 128, nt * 128, (u16*)smem, e1); }
        EpiMlaUkv e2; e2.Kb = (u16*)(R + R_KM); e2.Vt = (u16*)(R + R_VTM); e2.gnope = GIN(29);
        for (int it = bid; it < 192 * 16; it += G) { const int mt = it / 16, nt = it % 16; gemm_tile<8>((const u16*)(R + R_CKV), 256, wmix + WM_UKV, 256, 256, mt * 128, nt * 128, (u16*)smem, e2); }
      }
      GSYNC();
      attn_phase<192, 8>((const u16*)(R + R_Q), (const u16*)(R + R_KM), (const u16*)(R + R_VTM), obuf, smem);
      GSYNC();
    } else {
      {
        EpiGqaIn epi; epi.Q = (u16*)(R + R_Q); epi.Kb = (u16*)(R + R_KG); epi.Vt = (u16*)(R + R_VTG); epi.qg = GIN(33); epi.kg = GIN(34); epi.cosT = cosG; epi.sinT = sinG; epi.out = GOUT;
        for (int it = bid; it < 160 * 12; it += G) { const int mt = it / 12, nt = it % 12; gemm_tile<8>(hbuf, 1024, wmix + WM_IN, 1024, 1024, mt * 128, nt * 128, (u16*)smem, epi); }
      }
      GSYNC();
      attn_phase<128, 2>((const u16*)(R + R_Q), (const u16*)(R + R_KG), (const u16*)(R + R_VTG), obuf, smem);
      GSYNC();
    }

    for (int it = bid; it < 768; it += G) {
      const bool wide = it < 512;
      int m0, n0;
      if (wide) { m0 = (it >> 2) * 128; n0 = (it & 3) * 256; } else { const int ix = it - 512; m0 = (128 + (ix >> 3)) * 128; n0 = (ix & 7) * 128; }
      EpiResid epi;
      epi.xin = (layer == 0) ? (m0 < NPROMPT ? GIN(0) : GIN(1) - (size_t)NPROMPT * 1024) : GOUT;
      epi.xout = GOUT; epi.gate = lmods + (size_t)cond_of(m0) * 6144 + 2 * 1024;
      if (wide) gemm_tile_wide(obuf, 1024, wmix + WM_OUT, 1024, 1024, m0, n0, (u16*)smem, epi);
      else gemm_tile<4>(obuf, 1024, wmix + WM_OUT, 1024, 1024, m0, n0, (u16*)smem, epi);
    }
    GSYNC();
    for (int it = bid; it < 5120; it += G) norm_rows(p, layer, false, it, GIN(11) + layer * 1024, 3, 4);
    GSYNC();
    {
      EpiMlpIn epi; epi.abuf = (u16*)(R + R_ABUF);
      for (int it = bid; it < 160 * 16; it += G) { const int mt = it >> 4, nt = it & 15; gemm_tile_wide(hbuf, 1024, wmlp, 1024, 1024, mt * 128, nt * 256, (u16*)smem, epi); }
    }
    GSYNC();
    for (int it = bid; it < 768; it += G) {
      const bool wide = it < 512;
      int m0, n0;
      if (wide) { m0 = (it >> 2) * 128; n0 = (it & 3) * 256; } else { const int ix = it - 512; m0 = (128 + (ix >> 3)) * 128; n0 = (ix & 7) * 128; }
      EpiResid epi; epi.xin = GOUT; epi.xout = GOUT; epi.gate = lmods + (size_t)cond_of(m0) * 6144 + 5 * 1024;
      if (wide) gemm_tile_wide((const u16*)(R + R_ABUF), 4096, wmlp + 4194304, 4096, 4096, m0, n0, (u16*)smem, epi);
      else gemm_tile<4>((const u16*)(R + R_ABUF), 4096, wmlp + 4194304, 4096, 4096, m0, n0, (u16*)smem, epi);
    }
    GSYNC();
  }
}

extern "C" void kernel_launch(void* const* d_in, const int* in_sizes, int n_in, void* d_out, int out_size, void* d_ws, size_t ws_size, hipStream_t stream) {
  static int grid_blocks = 0;
  if (!grid_blocks) {
    int dev = 0, cus = 0, per_cu = 0;
    hipGetDevice(&dev);
    hipDeviceGetAttribute(&cus, hipDeviceAttributeMultiprocessorCount, dev);
    hipOccupancyMaxActiveBlocksPerMultiprocessor(&per_cu, fwd_megakernel, 256, 0);
    if (per_cu < 1) per_cu = 1;
    if (per_cu > 2) per_cu = 2;
    grid_blocks = cus * per_cu;
  }
  P p{};
  for (int i = 0; i < 36; ++i) p.in[i] = (const float*)d_in[i];
  p.out = (float*)d_out;
  p.ws = (char*)d_ws;
  (void)hipMemsetAsync((char*)d_ws + WS_BAR, 0, XCD_BAR_WORDS * 4, stream);
  void* args[] = {&p};
  hipError_t e = hipLaunchCooperativeKernel((void*)fwd_megakernel, dim3(grid_blocks), dim3(256), args, 0, stream);
  if (e != hipSuccess) fprintf(stderr, "cooperative launch failed: %s (grid %d)\n", hipGetErrorString(e), grid_blocks);
}
```

```cpp
#include <hip/hip_runtime.h>
#include <hip/hip_cooperative_groups.h>
#include <cstdio>
namespace cg = cooperative_groups;

typedef unsigned short u16;
typedef __attribute__((ext_vector_type(8))) short bf16x8;
typedef __attribute__((ext_vector_type(4))) short bf16x4;
typedef __attribute__((ext_vector_type(4))) float f32x4;
typedef __attribute__((ext_vector_type(4))) unsigned u32x4;
typedef __attribute__((ext_vector_type(2))) unsigned u32x2;

#define DI __device__ __forceinline__

constexpr int NTOK = 20480;
constexpr int NPROMPT = 4096;
constexpr float EPS = 1e-6f;

constexpr size_t WS_MODS = 0;
constexpr size_t MODS_BYTES = 4ull * 9 * 6144 * 4;
constexpr size_t WS_BAR = 917504;
constexpr size_t WS_ROPE = 1048576;
constexpr size_t WS_WMIX = 1114112;
constexpr size_t WS_WMLP = 14090240;
constexpr size_t WS_HBUF = 30867456;
constexpr size_t WS_OBUF = 72810496;
constexpr size_t WS_R    = 114753536;
constexpr size_t R_ABUF = 0;
constexpr size_t R_PROJ = 0;
constexpr size_t R_VBUF = 167772160;
constexpr size_t R_TBUF = 209715200;
constexpr size_t R_GBUF = 251658240;
constexpr size_t R_GCB  = 254279680;
constexpr size_t R_BETA = 255590400;
constexpr size_t R_EG   = 256901120;
constexpr size_t R_ED   = 258211840;
constexpr size_t R_DPROJ = 0;
constexpr size_t R_Q    = 0;
constexpr size_t R_CQ   = 62914560;
constexpr size_t R_CKV  = 78643200;
constexpr size_t R_KM   = 91226112;
constexpr size_t R_VTM  = 166723584;
constexpr size_t R_KG   = 41943040;
constexpr size_t R_VTG  = 54525952;
constexpr size_t WM_IN = 0;
constexpr size_t WM_OUT = 4325376;
constexpr size_t WM_UQ = 5373952;
constexpr size_t WM_UKV = 5963776;
constexpr size_t O_SF = 20971520, O_SB = 25165824, O_CKV = 29360128, O_KR = 30408704, O_GK = 30670848, O_GV = 31719424;

struct P {
  const float* in[36];
  float* out;
  char* ws;
};

typedef __attribute__((ext_vector_type(2))) float f32x2_t;
typedef __attribute__((ext_vector_type(2))) __bf16 bf16x2_t;
DI u16 f2bf(float x) { return __builtin_bit_cast(u16, (__bf16)x); }
DI float bf2f(u16 h) { return __uint_as_float(((unsigned)h) << 16); }
DI unsigned pack2(float a, float b) { f32x2_t v; v[0] = a; v[1] = b; return __builtin_bit_cast(unsigned, __builtin_convertvector(v, bf16x2_t)); }
DI float bflo(unsigned w) { return __uint_as_float(w << 16); }
DI float bfhi(unsigned w) { return __uint_as_float(w & 0xffff0000u); }
DI f32x4 mma(bf16x8 a, bf16x8 b, f32x4 c) { return __builtin_amdgcn_mfma_f32_16x16x32_bf16(a, b, c, 0, 0, 0); }
DI bf16x8 pack8(f32x4 a, f32x4 b) {
  u32x4 p; p[0] = pack2(a[0], a[1]); p[1] = pack2(a[2], a[3]); p[2] = pack2(b[0], b[1]); p[3] = pack2(b[2], b[3]);
  return __builtin_bit_cast(bf16x8, p);
}
DI bf16x8 ld8(const u16* p) { return *(const bf16x8*)p; }
DI bf16x8 ld44(const u16* p0, const u16* p1) {
  u32x2 a = *(const u32x2*)p0; u32x2 b = *(const u32x2*)p1;
  u32x4 r; r[0] = a[0]; r[1] = a[1]; r[2] = b[0]; r[3] = b[1];
  return __builtin_bit_cast(bf16x8, r);
}
typedef __attribute__((ext_vector_type(4))) short s16x4_t;
DI bf16x8 ldtr(const u16* p, int row4_off) {
  typedef __attribute__((address_space(3))) s16x4_t lds4_t;
  const s16x4_t lo = __builtin_amdgcn_ds_read_tr16_b64_v4i16((lds4_t*)p);
  const s16x4_t hi = __builtin_amdgcn_ds_read_tr16_b64_v4i16((lds4_t*)(p + row4_off));
  return __builtin_shufflevector(lo, hi, 0, 1, 2, 3, 4, 5, 6, 7);
}
DI void st4bf(u16* p, float a, float b, float c, float d) { u32x2 v; v[0] = pack2(a, b); v[1] = pack2(c, d); *(u32x2*)p = v; }
DI float wave_sum(float v) {
  v += __shfl_xor(v, 1); v += __shfl_xor(v, 2); v += __shfl_xor(v, 4); v += __shfl_xor(v, 8); v += __shfl_xor(v, 16); v += __shfl_xor(v, 32);
  return v;
}
DI float sum_g(float v) { v += __shfl_xor(v, 16); v += __shfl_xor(v, 32); return v; }
DI int opaque_tid() { int t = threadIdx.x; asm volatile("" : "+v"(t)); return t; }
DI int opaque_bid() { int t = __builtin_amdgcn_readfirstlane((int)blockIdx.x); asm volatile("" : "+s"(t)); return t; }
DI char* opaque_ptr(char* q) {
  unsigned lo = __builtin_amdgcn_readfirstlane((unsigned)(size_t)q), hi = __builtin_amdgcn_readfirstlane((unsigned)((size_t)q >> 32));
  asm volatile("" : "+s"(lo), "+s"(hi));
  typedef __attribute__((address_space(1))) char gchar_t;
  return (char*)(gchar_t*)(((size_t)hi << 32) | (size_t)lo);
}
template <class T> DI T* as_global(T* q) { typedef __attribute__((address_space(1))) T gT; return (T*)(gT*)q; }
#define GIN(i) as_global(p.in[i])
#define GOUT as_global(p.out)
DI int cond_of(int t) { return t < NPROMPT ? 0 : 1 + ((t - NPROMPT) >> 11); }
DI int kvrow_of_tok(int t) { return t < NPROMPT ? t : NPROMPT + ((t - NPROMPT) >> 11) * 2560 + 512 + ((t - NPROMPT) & 2047); }

template <int NI, class Epi>
DI void gemm_tile(const u16* __restrict__ A, int lda, const u16* __restrict__ Bt, int ldb, int K, int m0, int n0, u16* smem, Epi& epi) {
  constexpr int MI = 16 / NI;
  constexpr int WN = 8 / NI;
  const int tid = opaque_tid(), lane = tid & 63, wid = tid >> 6, l15 = lane & 15, g = lane >> 4;
  const int wm = wid / WN, wn = wid % WN;
  u16* sA = smem; u16* sB = smem + 128 * 64;
  f32x4 acc[MI][NI];
#pragma unroll
  for (int mi = 0; mi < MI; ++mi)
#pragma unroll
    for (int ni = 0; ni < NI; ++ni) { acc[mi][ni][0] = 0.f; acc[mi][ni][1] = 0.f; acc[mi][ni][2] = 0.f; acc[mi][ni][3] = 0.f; }
  const int lrow = tid >> 3, lkc = (tid & 7) * 8;
  const int wofs = lrow * 64 + (((tid & 7) ^ ((lrow >> 1) & 7)) * 8);
  const int rsw = (l15 >> 1) & 7;
  const int rofs0 = l15 * 64 + ((g ^ rsw) * 8), rofs1 = l15 * 64 + (((4 + g) ^ rsw) * 8);
  const u16* pa = A + (size_t)(m0 + lrow) * lda + lkc;
  const u16* pb = Bt + (size_t)(n0 + lrow) * ldb + lkc;
  u32x4 ra[2][4], rb[2][4];
  const int nk = K >> 6;
#pragma unroll
  for (int i = 0; i < 4; ++i) { ra[0][i] = *(const u32x4*)(pa + (size_t)i * 32 * lda); rb[0][i] = *(const u32x4*)(pb + (size_t)i * 32 * ldb); }
#pragma unroll
  for (int i = 0; i < 4; ++i) { ra[1][i] = *(const u32x4*)(pa + (size_t)i * 32 * lda + 64); rb[1][i] = *(const u32x4*)(pb + (size_t)i * 32 * ldb + 64); }
  for (int kt = 0; kt < nk; kt += 2) {
#pragma unroll
    for (int half = 0; half < 2; ++half) {
      __syncthreads();
#pragma unroll
      for (int i = 0; i < 4; ++i) { *(u32x4*)(sA + wofs + i * 32 * 64) = ra[half][i]; *(u32x4*)(sB + wofs + i * 32 * 64) = rb[half][i]; }
      __syncthreads();
      if (kt + half + 2 < nk) {
        const int ko = (kt + half + 2) * 64;
#pragma unroll
        for (int i = 0; i < 4; ++i) { ra[half][i] = *(const u32x4*)(pa + (size_t)i * 32 * lda + ko); rb[half][i] = *(const u32x4*)(pb + (size_t)i * 32 * ldb + ko); }
      }
#pragma unroll
      for (int ks = 0; ks < 2; ++ks) {
        const int ro = ks ? rofs1 : rofs0;
        bf16x8 af[MI], bfv[NI];
#pragma unroll
        for (int mi = 0; mi < MI; ++mi) af[mi] = ld8(sA + (wm * MI * 16 + mi * 16) * 64 + ro);
#pragma unroll
        for (int ni = 0; ni < NI; ++ni) bfv[ni] = ld8(sB + (wn * NI * 16 + ni * 16) * 64 + ro);
        __builtin_amdgcn_s_setprio(1);
#pragma unroll
        for (int mi = 0; mi < MI; ++mi)
#pragma unroll
          for (int ni = 0; ni < NI; ++ni) acc[mi][ni] = mma(bfv[ni], af[mi], acc[mi][ni]);
        __builtin_amdgcn_s_setprio(0);
      }
    }
  }
  epi.template run<MI, NI>(acc, m0 + wm * MI * 16, n0 + wn * NI * 16, l15, g);
}

template <class Epi>
DI void gemm_tile_wide(const u16* __restrict__ A, int lda, const u16* __restrict__ Bt, int ldb, int K, int m0, int n0, u16* smem, Epi& epi) {
  constexpr int MI = 4, NI = 8;
  const int tid = opaque_tid(), lane = tid & 63, wid = tid >> 6, l15 = lane & 15, g = lane >> 4;
  const int wm = wid >> 1, wn = wid & 1;
  u16* sA = smem; u16* sB = smem + 128 * 64;
  f32x4 acc[MI][NI];
#pragma unroll
  for (int mi = 0; mi < MI; ++mi)
#pragma unroll
    for (int ni = 0; ni < NI; ++ni) { acc[mi][ni][0] = 0.f; acc[mi][ni][1] = 0.f; acc[mi][ni][2] = 0.f; acc[mi][ni][3] = 0.f; }
  const int lrow = tid >> 3, lkc = (tid & 7) * 8;
  const int wofs = lrow * 64 + (((tid & 7) ^ ((lrow >> 1) & 7)) * 8);
  const int rsw = (l15 >> 1) & 7;
  const int rofs0 = l15 * 64 + ((g ^ rsw) * 8), rofs1 = l15 * 64 + (((4 + g) ^ rsw) * 8);
  const u16* pa = A + (size_t)(m0 + lrow) * lda + lkc;
  const u16* pb = Bt + (size_t)(n0 + lrow) * ldb + lkc;
  u32x4 ra[4], rb[8];
  const int nk = K >> 6;
#pragma unroll
  for (int i = 0; i < 4; ++i) ra[i] = *(const u32x4*)(pa + (size_t)i * 32 * lda);
#pragma unroll
  for (int i = 0; i < 8; ++i) rb[i] = *(const u32x4*)(pb + (size_t)i * 32 * ldb);
  for (int kt = 0; kt < nk; ++kt) {
    __syncthreads();
#pragma unroll
    for (int i = 0; i < 4; ++i) *(u32x4*)(sA + wofs + i * 32 * 64) = ra[i];
#pragma unroll
    for (int i = 0; i < 8; ++i) *(u32x4*)(sB + wofs + i * 32 * 64) = rb[i];
    __syncthreads();
    if (kt + 1 < nk) {
      const int ko = (kt + 1) * 64;
#pragma unroll
      for (int i = 0; i < 4; ++i) ra[i] = *(const u32x4*)(pa + (size_t)i * 32 * lda + ko);
#pragma unroll
      for (int i = 0; i < 8; ++i) rb[i] = *(const u32x4*)(pb + (size_t)i * 32 * ldb + ko);
    }
#pragma unroll
    for (int ks = 0; ks < 2; ++ks) {
      const int ro = ks ? rofs1 : rofs0;
      bf16x8 af[MI];
#pragma unroll
      for (int mi = 0; mi < MI; ++mi) af[mi] = ld8(sA + (wm * 64 + mi * 16) * 64 + ro);
#pragma unroll
      for (int nh = 0; nh < 2; ++nh) {
        bf16x8 bfv[4];
#pragma unroll
        for (int ni = 0; ni < 4; ++ni) bfv[ni] = ld8(sB + (wn * 128 + (nh * 4 + ni) * 16) * 64 + ro);
        __builtin_amdgcn_s_setprio(1);
#pragma unroll
        for (int mi = 0; mi < MI; ++mi)
#pragma unroll
          for (int ni = 0; ni < 4; ++ni) acc[mi][nh * 4 + ni] = mma(bfv[ni], af[mi], acc[mi][nh * 4 + ni]);
        __builtin_amdgcn_s_setprio(0);
        __builtin_amdgcn_sched_barrier(0);
      }
    }
  }
  epi.template run<MI, NI>(acc, m0 + wm * 64, n0 + wn * 128, l15, g);
}

struct EpiResid {
  const float* xin; float* xout; const float* gate;
  template <int MI, int NI> DI void run(f32x4 (&acc)[MI][NI], int mr, int nc, int l15, int g) {
#pragma unroll
    for (int mi = 0; mi < MI; ++mi)
#pragma unroll
      for (int ni = 0; ni < NI; ++ni) {
        const int m = mr + mi * 16 + l15, n = nc + ni * 16 + g * 4;
        const float4 xi = *(const float4*)(xin + (size_t)m * 1024 + n);
        const float4 gt = *(const float4*)(gate + n);
        float4 o; o.x = xi.x + gt.x * acc[mi][ni][0]; o.y = xi.y + gt.y * acc[mi][ni][1]; o.z = xi.z + gt.z * acc[mi][ni][2]; o.w = xi.w + gt.w * acc[mi][ni][3];
        *(float4*)(xout + (size_t)m * 1024 + n) = o;
      }
  }
};
struct EpiGdnIn {
  u16* proj; float* gbuf;
  template <int MI, int NI> DI void run(f32x4 (&acc)[MI][NI], int mr, int nc, int l15, int g) {
#pragma unroll
    for (int mi = 0; mi < MI; ++mi)
#pragma unroll
      for (int ni = 0; ni < NI; ++ni) {
        const int m = mr + mi * 16 + l15, n = nc + ni * 16 + g * 4;
        if (n < 4096) st4bf(proj + (size_t)m * 4096 + n, acc[mi][ni][0], acc[mi][ni][1], acc[mi][ni][2], acc[mi][ni][3]);
        else if (n < 4128) { float4 o; o.x = acc[mi][ni][0]; o.y = acc[mi][ni][1]; o.z = acc[mi][ni][2]; o.w = acc[mi][ni][3]; *(float4*)(gbuf + (size_t)m * 32 + (n - 4096)) = o; }
      }
  }
};
struct EpiMlpIn {
  u16* abuf;
  template <int MI, int NI> DI void run(f32x4 (&acc)[MI][NI], int mr, int nc, int l15, int g) {
#pragma unroll
    for (int mi = 0; mi < MI; ++mi)
#pragma unroll
      for (int ni = 0; ni < NI; ++ni) {
        const int m = mr + mi * 16 + l15, n = nc + ni * 16 + g * 4;
        float a = fmaxf(acc[mi][ni][0], 0.f), b = fmaxf(acc[mi][ni][1], 0.f), c = fmaxf(acc[mi][ni][2], 0.f), d = fmaxf(acc[mi][ni][3], 0.f);
        st4bf(abuf + (size_t)m * 4096 + n, a * a, b * b, c * c, d * d);
      }
  }
};
struct EpiF32 {
  float* dst; int ld;
  template <int MI, int NI> DI void run(f32x4 (&acc)[MI][NI], int mr, int nc, int l15, int g) {
#pragma unroll
    for (int mi = 0; mi < MI; ++mi)
#pragma unroll
      for (int ni = 0; ni < NI; ++ni) {
        const int m = mr + mi * 16 + l15, n = nc + ni * 16 + g * 4;
        float4 o; o.x = acc[mi][ni][0]; o.y = acc[mi][ni][1]; o.z = acc[mi][ni][2]; o.w = acc[mi][ni][3];
        *(float4*)(dst + (size_t)m * ld + n) = o;
      }
  }
};

DI void rope128(f32x4 (&v)[8], int rowp, int colp, int g, const float* cosT, const float* sinT) {
#pragma unroll
  for (int hf = 0; hf < 2; ++hf) {
    const int pos = hf ? colp : rowp;
#pragma unroll
    for (int a = 0; a < 2; ++a) {
      const int n1 = hf * 4 + a, n2 = n1 + 2;
      const float4 cs = *(const float4*)(cosT + pos * 32 + a * 16 + g * 4);
      const float4 sn = *(const float4*)(sinT + pos * 32 + a * 16 + g * 4);
      const float c4[4] = {cs.x, cs.y, cs.z, cs.w}, s4[4] = {sn.x, sn.y, sn.z, sn.w};
#pragma unroll
      for (int j = 0; j < 4; ++j) { const float x1 = v[n1][j], x2 = v[n2][j]; v[n1][j] = x1 * c4[j] - x2 * s4[j]; v[n2][j] = x1 * s4[j] + x2 * c4[j]; }
    }
  }
}
DI void rope64(f32x4* v, int rowp, int colp, int g, const float* cosT, const float* sinT) {
#pragma unroll
  for (int hf = 0; hf < 2; ++hf) {
    const int pos = hf ? colp : rowp;
    const int n1 = hf * 2, n2 = n1 + 1;
    const float4 cs = *(const float4*)(cosT + pos * 16 + g * 4);
    const float4 sn = *(const float4*)(sinT + pos * 16 + g * 4);
    const float c4[4] = {cs.x, cs.y, cs.z, cs.w}, s4[4] = {sn.x, sn.y, sn.z, sn.w};
#pragma unroll
    for (int j = 0; j < 4; ++j) { const float x1 = v[n1][j], x2 = v[n2][j]; v[n1][j] = x1 * c4[j] - x2 * s4[j]; v[n2][j] = x1 * s4[j] + x2 * c4[j]; }
  }
}

struct EpiGqaIn {
  u16* Q; u16* Kb; u16* Vt; const float* qg; const float* kg; const float* cosT; const float* sinT; float* out;
  template <int MI, int NI> DI void run(f32x4 (&acc)[MI][NI], int mr, int nc, int l15, int g) {
    const int nt = nc >> 7;
#pragma unroll
    for (int mi = 0; mi < MI; ++mi) {
      const int m = mr + mi * 16 + l15;
      const bool prompt = m < NPROMPT;
      const int s = prompt ? (m & 255) : ((m - NPROMPT) & 2047);
      const int rowp = s >> 6, colp = s & 63;
      const int kvrow = kvrow_of_tok(m);
      if (nt < 10) {
        float ss = 0.f;
#pragma unroll
        for (int ni = 0; ni < NI; ++ni)
#pragma unroll
          for (int j = 0; j < 4; ++j) ss += acc[mi][ni][j] * acc[mi][ni][j];
        ss = sum_g(ss);
        const float rs = rsqrtf(ss * (1.f / 128.f) + EPS);
        const float* gn = nt < 8 ? qg : kg;
#pragma unroll
        for (int ni = 0; ni < NI; ++ni) {
          const float4 gv = *(const float4*)(gn + ni * 16 + g * 4);
          acc[mi][ni][0] *= rs * gv.x; acc[mi][ni][1] *= rs * gv.y; acc[mi][ni][2] *= rs * gv.z; acc[mi][ni][3] *= rs * gv.w;
        }
        if (nt >= 8 && prompt) {
#pragma unroll
          for (int ni = 0; ni < NI; ++ni) { float4 o; o.x = acc[mi][ni][0]; o.y = acc[mi][ni][1]; o.z = acc[mi][ni][2]; o.w = acc[mi][ni][3]; *(float4*)(out + O_GK + (size_t)m * 256 + (nt - 8) * 128 + ni * 16 + g * 4) = o; }
        }
        if (!prompt) rope128(acc[mi], rowp, colp, g, cosT, sinT);
        u16* dst = nt < 8 ? Q + (size_t)m * 1024 + nt * 128 : Kb + (size_t)kvrow * 256 + (nt - 8) * 128;
#pragma unroll
        for (int ni = 0; ni < NI; ++ni) st4bf(dst + ni * 16 + g * 4, acc[mi][ni][0], acc[mi][ni][1], acc[mi][ni][2], acc[mi][ni][3]);
      } else {
        const int kvh = nt - 10;
        if (prompt) {
#pragma unroll
          for (int ni = 0; ni < NI; ++ni) { float4 o; o.x = acc[mi][ni][0]; o.y = acc[mi][ni][1]; o.z = acc[mi][ni][2]; o.w = acc[mi][ni][3]; *(float4*)(out + O_GV + (size_t)m * 256 + kvh * 128 + ni * 16 + g * 4) = o; }
        }
        size_t base; int kvlen, pos;
        if (prompt) { base = (size_t)(m >> 8) * 256 * 256; kvlen = 256; pos = m & 255; }
        else { const int b = (m - NPROMPT) >> 11; base = (size_t)(NPROMPT + b * 2560) * 256; kvlen = 2560; pos = 512 + s; }
#pragma unroll
        for (int ni = 0; ni < NI; ++ni)
#pragma unroll
          for (int j = 0; j < 4; ++j) Vt[base + (size_t)(kvh * 128 + ni * 16 + g * 4 + j) * kvlen + pos] = f2bf(acc[mi][ni][j]);
      }
    }
  }
};
struct EpiMlaUq {
  u16* Q; const float* gnope; const float* grope; const float* cosT; const float* sinT;
  template <int MI, int NI> DI void run(f32x4 (&acc)[MI][NI], int mr, int nc, int l15, int g) {
    const int nt = nc >> 7;
#pragma unroll
    for (int mi = 0; mi < MI; ++mi) {
      const int m = mr + mi * 16 + l15;
      const bool prompt = m < NPROMPT;
      const int s = prompt ? (m & 255) : ((m - NPROMPT) & 2047);
      const int rowp = s >> 6, colp = s & 63;
      if (nt < 8) {
        float ss = 0.f;
#pragma unroll
        for (int ni = 0; ni < NI; ++ni)
#pragma unroll
          for (int j = 0; j < 4; ++j) ss += acc[mi][ni][j] * acc[mi][ni][j];
        ss = sum_g(ss);
        const float rs = rsqrtf(ss * (1.f / 128.f) + EPS);
#pragma unroll
        for (int ni = 0; ni < NI; ++ni) {
          const float4 gv = *(const float4*)(gnope + ni * 16 + g * 4);
          st4bf(Q + (size_t)m * 1536 + nt * 192 + ni * 16 + g * 4, acc[mi][ni][0] * rs * gv.x, acc[mi][ni][1] * rs * gv.y, acc[mi][ni][2] * rs * gv.z, acc[mi][ni][3] * rs * gv.w);
        }
      } else {
#pragma unroll
        for (int hh = 0; hh < 2; ++hh) {
          const int h = (nt - 8) * 2 + hh;
          float ss = 0.f;
#pragma unroll
          for (int ni = 0; ni < 4; ++ni)
#pragma unroll
            for (int j = 0; j < 4; ++j) ss += acc[mi][hh * 4 + ni][j] * acc[mi][hh * 4 + ni][j];
          ss = sum_g(ss);
          const float rs = rsqrtf(ss * (1.f / 64.f) + EPS);
#pragma unroll
          for (int ni = 0; ni < 4; ++ni) {
            const float4 gv = *(const float4*)(grope + ni * 16 + g * 4);
            acc[mi][hh * 4 + ni][0] *= rs * gv.x; acc[mi][hh * 4 + ni][1] *= rs * gv.y; acc[mi][hh * 4 + ni][2] *= rs * gv.z; acc[mi][hh * 4 + ni][3] *= rs * gv.w;
          }
          if (!prompt) rope64(&acc[mi][hh * 4], rowp, colp, g, cosT, sinT);
#pragma unroll
          for (int ni = 0; ni < 4; ++ni)
            st4bf(Q + (size_t)m * 1536 + h * 192 + 128 + ni * 16 + g * 4, acc[mi][hh * 4 + ni][0], acc[mi][hh * 4 + ni][1], acc[mi][hh * 4 + ni][2], acc[mi][hh * 4 + ni][3]);
        }
      }
    }
  }
};
struct EpiMlaUkv {
  u16* Kb; u16* Vt; const float* gnope;
  template <int MI, int NI> DI void run(f32x4 (&acc)[MI][NI], int mr, int nc, int l15, int g) {
    const int nt = nc >> 7, h = nt >> 1;
#pragma unroll
    for (int mi = 0; mi < MI; ++mi) {
      const int m = mr + mi * 16 + l15;
      if ((nt & 1) == 0) {
        float ss = 0.f;
#pragma unroll
        for (int ni = 0; ni < NI; ++ni)
#pragma unroll
          for (int j = 0; j < 4; ++j) ss += acc[mi][ni][j] * acc[mi][ni][j];
        ss = sum_g(ss);
        const float rs = rsqrtf(ss * (1.f / 128.f) + EPS);
#pragma unroll
        for (int ni = 0; ni < NI; ++ni) {
          const float4 gv = *(const float4*)(gnope + ni * 16 + g * 4);
          st4bf(Kb + (size_t)m * 1536 + h * 192 + ni * 16 + g * 4, acc[mi][ni][0] * rs * gv.x, acc[mi][ni][1] * rs * gv.y, acc[mi][ni][2] * rs * gv.z, acc[mi][ni][3] * rs * gv.w);
        }
      } else {
        size_t base; int kvlen, pos;
        if (m < NPROMPT) { base = (size_t)(m >> 8) * 256 * 1024; kvlen = 256; pos = m & 255; }
        else { const int r = m - NPROMPT; const int b = r / 2560; base = (size_t)(NPROMPT + b * 2560) * 1024; kvlen = 2560; pos = r - b * 2560; }
#pragma unroll
        for (int ni = 0; ni < NI; ++ni)
#pragma unroll
          for (int j = 0; j < 4; ++j) Vt[base + (size_t)(h * 128 + ni * 16 + g * 4 + j) * kvlen + pos] = f2bf(acc[mi][ni][j]);
      }
    }
  }
};

DI void convert_tile(const float* __restrict__ W, int K, int N, u16* __restrict__ Bt, int tile, int perm, float* sT) {
  const int nkt = K >> 6;
  const int kt = tile % nkt, nt = tile / nkt;
  const int k0 = kt * 64, n0 = nt * 64;
  const int tid = opaque_tid();
  __syncthreads();
  {
    const int n = tid & 63, kq = tid >> 6;
    int nd = n0 + n, ns = nd;
    if (perm == 1) { if (nd < 1024) ns = (nd >> 7) * 192 + (nd & 127); else { const int x = nd - 1024; ns = (x >> 6) * 192 + 128 + (x & 63); } }
    const bool ok = nd < N;
#pragma unroll
    for (int r = 0; r < 16; ++r) { const int k = r * 4 + kq; sT[k * 65 + n] = ok ? W[(size_t)(k0 + k) * N + ns] : 0.f; }
  }
  __syncthreads();
  {
    const int n = tid >> 2, kq = (tid & 3) * 16;
    u32x4 a, b;
#pragma unroll
    for (int e = 0; e < 4; ++e) { a[e] = pack2(sT[(kq + 2 * e) * 65 + n], sT[(kq + 2 * e + 1) * 65 + n]); b[e] = pack2(sT[(kq + 8 + 2 * e) * 65 + n], sT[(kq + 9 + 2 * e) * 65 + n]); }
    u16* dst = Bt + (size_t)(n0 + n) * K + k0 + kq;
    *(u32x4*)dst = a; *(u32x4*)(dst + 8) = b;
  }
}

DI void norm_rows(const P& p, int layer, bool from_input, int item, const float* gnorm, int shift_idx, int scale_idx) {
  const int tidn = opaque_tid();
  char* const ws = opaque_ptr(as_global(p.ws));
  const int lane = tidn & 63, wid = tidn >> 6;
  const int t = item * 4 + wid;
  const float* x = from_input ? (t < NPROMPT ? GIN(0) + (size_t)t * 1024 : GIN(1) + (size_t)(t - NPROMPT) * 1024) : GOUT + (size_t)t * 1024;
  const float* mods = (const float*)(ws + WS_MODS) + ((size_t)layer * 9 + cond_of(t)) * 6144;
  u16* h = (u16*)(ws + WS_HBUF) + (size_t)t * 1024;
  float4 v[4]; float ss = 0.f;
#pragma unroll
  for (int e = 0; e < 4; ++e) { v[e] = *(const float4*)(x + e * 256 + lane * 4); ss += v[e].x * v[e].x + v[e].y * v[e].y + v[e].z * v[e].z + v[e].w * v[e].w; }
  ss = wave_sum(ss);
  const float rs = rsqrtf(ss * (1.f / 1024.f) + EPS);
#pragma unroll
  for (int e = 0; e < 4; ++e) {
    const int c = e * 256 + lane * 4;
    const float4 gv = *(const float4*)(gnorm + c);
    const float4 sc = *(const float4*)(mods + scale_idx * 1024 + c);
    const float4 sh = *(const float4*)(mods + shift_idx * 1024 + c);
    st4bf(h + c, v[e].x * rs * gv.x * (1.f + sc.x) + sh.x, v[e].y * rs * gv.y * (1.f + sc.y) + sh.y, v[e].z * rs * gv.z * (1.f + sc.z) + sh.z, v[e].w * rs * gv.w * (1.f + sc.w) + sh.w);
  }
}

template <int DK, int HK>
DI void attn_phase(const u16* __restrict__ Q, const u16* __restrict__ Kb, const u16* __restrict__ Vt, u16* __restrict__ obuf, char* smem_raw) {
  const int bid = opaque_bid();
  constexpr int KS = DK / 32, KSTR = DK, QSTR = 8 * DK, KROW = HK * DK, GRP = 8 / HK;
  constexpr int CPR = DK / 8;
  constexpr int KCH = 64 * CPR / 256;
  u16* sK = (u16*)smem_raw;
  u16* sV = sK + 64 * KSTR;
  const int tid = opaque_tid(), lane = tid & 63, wid = tid >> 6, l15 = lane & 15, g = lane >> 4;
  const float sc = rsqrtf((float)DK) * 1.4426950408889634f;
  for (int item = bid; item < 1280; item += gridDim.x) {
    int qb, h, kvlen, tokbase, kvbase;
    if (item < 1024) { const int b = item >> 7, rem = item & 127; h = rem & 7; qb = rem >> 3; kvlen = 2560; tokbase = NPROMPT + b * 2048; kvbase = NPROMPT + b * 2560; }
    else { const int it2 = item - 1024; const int b = it2 >> 4, rem = it2 & 15; h = rem & 7; qb = rem >> 3; kvlen = 256; tokbase = b * 256; kvbase = b * 256; }
    const int kvh = h / GRP;
    const u16* Kp = Kb + (size_t)kvbase * KROW + kvh * DK;
    const u16* Vp = Vt + (size_t)kvbase * (HK * 128) + (size_t)kvh * 128 * kvlen;
    const int qrow0 = tokbase + qb * 128 + wid * 32;
    bf16x8 qf[2][KS];
#pragma unroll
    for (int qi = 0; qi < 2; ++qi)
#pragma unroll
      for (int ks = 0; ks < KS; ++ks) qf[qi][ks] = ld8(Q + (size_t)(qrow0 + qi * 16 + l15) * QSTR + h * DK + ks * 32 + g * 8);
    f32x4 ot[2][8];
#pragma unroll
    for (int qi = 0; qi < 2; ++qi)
#pragma unroll
      for (int dj = 0; dj < 8; ++dj) { ot[qi][dj][0] = 0.f; ot[qi][dj][1] = 0.f; ot[qi][dj][2] = 0.f; ot[qi][dj][3] = 0.f; }
    float mrun[2] = {-1e30f, -1e30f}, lrun[2] = {0.f, 0.f};
    const int ntiles = kvlen >> 6;
    const unsigned toffK = (unsigned)((tid >> 3) * KROW + (tid & 7) * 8), toffV = (unsigned)((tid >> 3) * kvlen + (tid & 7) * 8);
    const int kx = tid >> 3;
    const int kperm = ((kx >> 2) & 1) * 16 + (kx >> 3) * 4 + (kx & 3);
    const int kswz = (CPR == 16) ? (kperm & 15) : ((kperm >> 1) & 7);
    const int ldsoffK = kperm * KSTR;
    const int ldsoffV = (tid >> 3) * 64 + (((tid & 7) ^ (((tid >> 3) >> 1) & 7)) * 8);
    u32x4 rk[KCH], rv[4];
#pragma unroll
    for (int i = 0; i < KCH; ++i) { const int rh = i & 1, cgp = i >> 1; rk[i] = *(const u32x4*)(Kp + (size_t)(rh * 32 * KROW + cgp * 64) + toffK); }
#pragma unroll
    for (int i = 0; i < 4; ++i) rv[i] = *(const u32x4*)(Vp + (size_t)i * 32 * kvlen + toffV);
    for (int kt = 0; kt < ntiles; ++kt) {
      const u16* Kt = Kp + (size_t)(kt + 1) * 64 * KROW;
      const u16* Vtp = Vp + (kt + 1) * 64;
      const bool more = kt + 1 < ntiles;
      __syncthreads();
#pragma unroll
      for (int i = 0; i < KCH; ++i) { const int rh = i & 1, cgp = i >> 1; const int c = (tid & 7) + 8 * cgp; const int pos = (CPR == 16) ? (c ^ kswz) : ((c & ~7) | ((c & 7) ^ kswz)); *(u32x4*)(sK + ldsoffK + rh * 32 * KSTR + pos * 8) = rk[i]; }
#pragma unroll
      for (int i = 0; i < 4; ++i) *(u32x4*)(sV + ldsoffV + i * 32 * 64) = rv[i];
      __syncthreads();
      if (more) {
#pragma unroll
        for (int i = 0; i < KCH; ++i) { const int rh = i & 1, cgp = i >> 1; rk[i] = *(const u32x4*)(Kt + (size_t)(rh * 32 * KROW + cgp * 64) + toffK); }
      }
      __builtin_amdgcn_sched_barrier(0);
      f32x4 st[2][4];
#pragma unroll
      for (int qi = 0; qi < 2; ++qi)
#pragma unroll
        for (int kj = 0; kj < 4; ++kj) { st[qi][kj][0] = 0.f; st[qi][kj][1] = 0.f; st[qi][kj][2] = 0.f; st[qi][kj][3] = 0.f; }
#pragma unroll
      for (int ks = 0; ks < KS; ++ks) {
#pragma unroll
        for (int kj = 0; kj < 4; ++kj) {
          const int kc = ks * 4 + g;
          const int kpos = (CPR == 16) ? (kc ^ l15) : ((kc & ~7) | ((kc & 7) ^ ((l15 >> 1) & 7)));
          const bf16x8 ka = ld8(sK + (kj * 16 + l15) * KSTR + kpos * 8);
          __builtin_amdgcn_s_setprio(1);
          st[0][kj] = mma(ka, qf[0][ks], st[0][kj]);
          st[1][kj] = mma(ka, qf[1][ks], st[1][kj]);
          __builtin_amdgcn_s_setprio(0);
        }
        __builtin_amdgcn_sched_barrier(0);
      }
      bf16x8 pf[2][2];
#pragma unroll
      for (int qi = 0; qi < 2; ++qi) {
        float mx = -1e30f;
#pragma unroll
        for (int kj = 0; kj < 4; ++kj)
#pragma unroll
          for (int r = 0; r < 4; ++r) mx = fmaxf(mx, st[qi][kj][r]);
        mx = fmaxf(mx, __shfl_xor(mx, 16)); mx = fmaxf(mx, __shfl_xor(mx, 32));
        const float mnew = fmaxf(mrun[qi], mx);
        const float alpha = __builtin_amdgcn_exp2f((mrun[qi] - mnew) * sc);
        mrun[qi] = mnew;
        float ps = 0.f;
        const float mneg = -mnew * sc;
#pragma unroll
        for (int kj = 0; kj < 4; ++kj)
#pragma unroll
          for (int r = 0; r < 4; ++r) { const float pv = __builtin_amdgcn_exp2f(fmaf(st[qi][kj][r], sc, mneg)); st[qi][kj][r] = pv; ps += pv; }
        lrun[qi] = lrun[qi] * alpha + ps;
#pragma unroll
        for (int dj = 0; dj < 8; ++dj) { ot[qi][dj][0] *= alpha; ot[qi][dj][1] *= alpha; ot[qi][dj][2] *= alpha; ot[qi][dj][3] *= alpha; }
        pf[qi][0] = pack8(st[qi][0], st[qi][1]);
        pf[qi][1] = pack8(st[qi][2], st[qi][3]);
        __builtin_amdgcn_sched_barrier(0);
      }
      if (more) {
#pragma unroll
        for (int i = 0; i < 4; ++i) rv[i] = *(const u32x4*)(Vtp + (size_t)i * 32 * kvlen + toffV);
      }
      __builtin_amdgcn_sched_barrier(0);
#pragma unroll
      for (int kk = 0; kk < 2; ++kk)
#pragma unroll
        for (int dj = 0; dj < 8; ++dj) {
          const bf16x8 va = ld8(sV + (dj * 16 + l15) * 64 + (((kk * 4 + g) ^ ((l15 >> 1) & 7)) * 8));
          __builtin_amdgcn_s_setprio(1);
          ot[0][dj] = mma(va, pf[0][kk], ot[0][dj]);
          ot[1][dj] = mma(va, pf[1][kk], ot[1][dj]);
          __builtin_amdgcn_s_setprio(0);
          if ((dj & 3) == 3) __builtin_amdgcn_sched_barrier(0);
        }
    }
#pragma unroll
    for (int qi = 0; qi < 2; ++qi) {
      const float inv = 1.f / sum_g(lrun[qi]);
      u16* dst = obuf + (size_t)(qrow0 + qi * 16 + l15) * 1024 + h * 128 + g * 4;
#pragma unroll
      for (int dj = 0; dj < 8; ++dj) st4bf(dst + dj * 16, ot[qi][dj][0] * inv, ot[qi][dj][1] * inv, ot[qi][dj][2] * inv, ot[qi][dj][3] * inv);
    }
  }
}

DI void gdn_chunk_phase(const P& p, int j, char* smem_raw) {
  const int bid = opaque_bid();
  char* const ws = opaque_ptr(as_global(p.ws));
  u16* sK = (u16*)smem_raw;
  float* sA = (float*)(smem_raw + 17408);
  float* sG = (float*)(smem_raw + 17408 + 32768);
  float* sBt = sG + 128;
  const int tid = opaque_tid(), lane = tid & 63, wid = tid >> 6, l15 = lane & 15, g = lane >> 4;
  const u16* proj = (const u16*)(ws + WS_R + R_PROJ);
  u16* qn = (u16*)(ws + WS_HBUF); u16* kn = (u16*)(ws + WS_OBUF); u16* vb = (u16*)(ws + WS_R + R_VBUF);
  u16* Tbuf = (u16*)(ws + WS_R + R_TBUF);
  const float* gbuf = (const float*)(ws + WS_R + R_GBUF);
  float* gcb = (float*)(ws + WS_R + R_GCB); float* betab = (float*)(ws + WS_R + R_BETA);
  float* egb = (float*)(ws + WS_R + R_EG); float* edb = (float*)(ws + WS_R + R_ED);
  const float* conv = GIN(17) + (size_t)j * 3 * 3072;
  const float* a_log = GIN(18) + j * 16; const float* dt_bias = GIN(19) + j * 16;
  for (int unit = bid; unit < 2560; unit += gridDim.x) {
    const int cgi = unit >> 3, h = unit & 7;
    int c, nch; if (cgi < 64) { c = cgi & 3; nch = 4; } else { c = (cgi - 64) & 31; nch = 32; }
    const int t0 = cgi * 64;
    const bool has_prev = c > 0, has_next = c < nch - 1;
    __syncthreads();
    {
      const int r = tid >> 4, cc = (tid & 15) * 8;
#pragma unroll
      for (int part = 0; part < 3; ++part) {
        const int ch = part * 1024 + h * 128 + cc;
        float w0[8], w1[8], w2[8];
#pragma unroll
        for (int e = 0; e < 8; ++e) { w0[e] = conv[ch + e]; w1[e] = conv[3072 + ch + e]; w2[e] = conv[6144 + ch + e]; }
        u16* dstb = part == 0 ? qn : (part == 1 ? kn : vb);
        for (int it = 0; it < 4; ++it) {
          const int i = it * 16 + r, t = t0 + i;
          const u16* src = proj + (size_t)t * 4096 + ch;
          const u32x4 xc = *(const u32x4*)src;
          u32x4 xp = {0u, 0u, 0u, 0u}, xn = {0u, 0u, 0u, 0u};
          if (i > 0 || has_prev) xp = *(const u32x4*)(src - 4096);
          if (i < 63 || has_next) xn = *(const u32x4*)(src + 4096);
          float y[8];
#pragma unroll
          for (int e = 0; e < 4; ++e) {
            float a = w0[2 * e] * bflo(xp[e]) + w1[2 * e] * bflo(xc[e]) + w2[2 * e] * bflo(xn[e]);
            float b = w0[2 * e + 1] * bfhi(xp[e]) + w1[2 * e + 1] * bfhi(xc[e]) + w2[2 * e + 1] * bfhi(xn[e]);
            y[2 * e] = a / (1.f + __expf(-a)); y[2 * e + 1] = b / (1.f + __expf(-b));
          }
          if (part < 2) {
            float ss = 0.f;
#pragma unroll
            for (int e = 0; e < 8; ++e) ss += y[e] * y[e];
            ss += __shfl_xor(ss, 1); ss += __shfl_xor(ss, 2); ss += __shfl_xor(ss, 4); ss += __shfl_xor(ss, 8);
            const float rs = rsqrtf(ss + EPS) * (part == 0 ? 0.08838834764831845f : 1.f);
#pragma unroll
            for (int e = 0; e < 8; ++e) y[e] *= rs;
          }
          u32x4 o; o[0] = pack2(y[0], y[1]); o[1] = pack2(y[2], y[3]); o[2] = pack2(y[4], y[5]); o[3] = pack2(y[6], y[7]);
          *(u32x4*)(dstb + (size_t)t * 1024 + h * 128 + cc) = o;
          if (part == 1) *(u32x4*)(sK + i * 136 + cc) = o;
        }
      }
    }
    if (tid < 128) {
      const int dir = tid >> 6, L = tid & 63;
      const int i = dir ? 63 - L : L;
      const float* gb = gbuf + (size_t)(t0 + i) * 32;
      const float gin = gb[dir * 8 + h], bin = gb[16 + dir * 8 + h];
      const float x = gin + dt_bias[dir * 8 + h];
      const float sp = fmaxf(x, 0.f) + log1pf(expf(-fabsf(x)));
      float gv = -expf(a_log[dir * 8 + h]) * sp;
      const float bt = 1.f / (1.f + expf(-bin));
#pragma unroll
      for (int off = 1; off < 64; off <<= 1) { const float v = __shfl_up(gv, off); if (L >= off) gv += v; }
      sG[dir * 64 + i] = gv; sBt[dir * 64 + i] = bt;
      gcb[((size_t)(t0 + i) * 8 + h) * 2 + dir] = gv; betab[((size_t)(t0 + i) * 8 + h) * 2 + dir] = bt;
      { const float gtot = __shfl(gv, 63); egb[((size_t)(t0 + i) * 8 + h) * 2 + dir] = expf(gv); edb[((size_t)(t0 + i) * 8 + h) * 2 + dir] = expf(gtot - gv); }
    }
    __syncthreads();
    {
      f32x4 ga[4];
#pragma unroll
      for (int mt = 0; mt < 4; ++mt) { ga[mt][0] = 0.f; ga[mt][1] = 0.f; ga[mt][2] = 0.f; ga[mt][3] = 0.f; }
#pragma unroll
      for (int ks = 0; ks < 4; ++ks) {
        const bf16x8 a = ld8(sK + (wid * 16 + l15) * 136 + ks * 32 + g * 8);
#pragma unroll
        for (int mt = 0; mt < 4; ++mt) { const bf16x8 b = ld8(sK + (mt * 16 + l15) * 136 + ks * 32 + g * 8); ga[mt] = mma(a, b, ga[mt]); }
      }
#pragma unroll
      for (int dir = 0; dir < 2; ++dir)
#pragma unroll
        for (int mt = 0; mt < 4; ++mt)
#pragma unroll
          for (int r = 0; r < 4; ++r) {
            const int i = wid * 16 + g * 4 + r, m = mt * 16 + l15;
            const bool valid = dir ? (i < m) : (i > m);
            const float val = valid ? sBt[dir * 64 + i] * ga[mt][r] * __expf(sG[dir * 64 + i] - sG[dir * 64 + m]) : 0.f;
            const int ii = dir ? 63 - i : i, mm = dir ? 63 - m : m;
            sA[dir * 4096 + ii * 64 + mm] = val;
          }
    }
    __syncthreads();
    if (wid < 2) {
      const int dir = wid;
      float* Am = sA + dir * 4096;
      for (int i = 0; i < 64; ++i) {
        float a = (i == lane) ? 1.f : 0.f;
        for (int m = 0; m < i; m += 8) {
          const float4 a0 = *(const float4*)(Am + i * 64 + m), a1 = *(const float4*)(Am + i * 64 + m + 4);
          float tv[8];
#pragma unroll
          for (int e = 0; e < 8; ++e) tv[e] = Am[(m + e) * 64 + lane];
          a -= a0.x * tv[0]; a -= a0.y * tv[1]; a -= a0.z * tv[2]; a -= a0.w * tv[3];
          a -= a1.x * tv[4]; a -= a1.y * tv[5]; a -= a1.z * tv[6]; a -= a1.w * tv[7];
        }
        Am[i * 64 + lane] = a;
      }
      const int mn = dir ? 63 - lane : lane;
      const float bm = sBt[dir * 64 + mn];
      u16* Td = Tbuf + ((size_t)unit * 2 + dir) * 4096;
#pragma unroll 4
      for (int i = 0; i < 64; ++i) { const int in_ = dir ? 63 - i : i; Td[in_ * 64 + mn] = f2bf(Am[i * 64 + lane] * bm); }
    }
  }
}

DI void gdn_scan_phase(const P& p, int j, char* smem_raw) {
  const int bid = opaque_bid();
  char* const ws = opaque_ptr(as_global(p.ws));
  u16* sK = (u16*)smem_raw;
  u16* sV = sK + 64 * 136;
  u16* sST = sV + 64 * 40;
  u16* sVN = sST + 32 * 136;
  u16* sVD = sVN + 32 * 72;
  float* sGc = (float*)(sVD + 32 * 72);
  float* sE = sGc + 64;
  float* sD = sE + 64;
  const int tid = opaque_tid(), lane = tid & 63, w = tid >> 6, l15 = lane & 15, g = lane >> 4;
  const u16* qn = (const u16*)(ws + WS_HBUF); const u16* kn = (const u16*)(ws + WS_OBUF); const u16* vb = (const u16*)(ws + WS_R + R_VBUF);
  const u16* Tbuf = (const u16*)(ws + WS_R + R_TBUF);
  const float* gcb = (const float*)(ws + WS_R + R_GCB);
  const float* egb = (const float*)(ws + WS_R + R_EG); const float* edb = (const float*)(ws + WS_R + R_ED);
  u16* obase = (u16*)(ws + WS_R + R_PROJ);
  for (int wk = bid; wk < 1536; wk += gridDim.x) {
    int seq, rem;
    if (wk < 512) { seq = 16 + (wk >> 6); rem = wk & 63; } else { seq = (wk - 512) >> 6; rem = (wk - 512) & 63; }
    const int h = rem & 7, dir = (rem >> 5) & 1, dvq = (rem >> 3) & 3;
    const int nch = seq < 16 ? 4 : 32;
    const int cgb = seq < 16 ? seq * 4 : 64 + (seq - 16) * 32;
    f32x4 S[2][2];
    if (seq >= 16) {
      const float* s0 = GIN(2 + dir) + (((size_t)(seq - 16) * 2 + j) * 8 + h) * 16384;
#pragma unroll
      for (int dt = 0; dt < 2; ++dt)
#pragma unroll
        for (int et = 0; et < 2; ++et)
#pragma unroll
          for (int r = 0; r < 4; ++r) S[dt][et][r] = s0[(size_t)(w * 32 + dt * 16 + g * 4 + r) * 128 + dvq * 32 + et * 16 + l15];
    } else {
#pragma unroll
      for (int dt = 0; dt < 2; ++dt)
#pragma unroll
        for (int et = 0; et < 2; ++et) { S[dt][et][0] = 0.f; S[dt][et][1] = 0.f; S[dt][et][2] = 0.f; S[dt][et][3] = 0.f; }
    }
    __syncthreads();
#pragma unroll
    for (int dt = 0; dt < 2; ++dt)
#pragma unroll
      for (int et = 0; et < 2; ++et) st4bf(sST + (et * 16 + l15) * 136 + w * 32 + dt * 16 + g * 4, S[dt][et][0], S[dt][et][1], S[dt][et][2], S[dt][et][3]);
    u32x4 pk[4], pv; float pg = 0.f, pe = 0.f, pd = 0.f;
#define SCAN_PREFETCH(cc) do { \
      const int t0n_ = (cgb + (cc)) * 64; \
      _Pragma("unroll") for (int i = 0; i < 4; ++i) { const int ci = tid + 256 * i; const int row = ci >> 4, dc = (ci & 15) * 8; pk[i] = *(const u32x4*)(kn + (size_t)(t0n_ + row) * 1024 + h * 128 + dc); } \
      { const int row = tid >> 2, ec = (tid & 3) * 8; pv = *(const u32x4*)(vb + (size_t)(t0n_ + row) * 1024 + h * 128 + dvq * 32 + ec); } \
      if (tid < 64) { const size_t gi_ = ((size_t)(t0n_ + tid) * 8 + h) * 2 + dir; pg = gcb[gi_]; pe = egb[gi_]; pd = edb[gi_]; } \
    } while (0)
    SCAN_PREFETCH(dir ? nch - 1 : 0);
    bf16x8 qf[4], tf[2];
    {
      const int c0_ = dir ? nch - 1 : 0;
#pragma unroll
      for (int ks = 0; ks < 4; ++ks) qf[ks] = ld8(qn + (size_t)((cgb + c0_) * 64 + w * 16 + l15) * 1024 + h * 128 + ks * 32 + g * 8);
#pragma unroll
      for (int ks = 0; ks < 2; ++ks) tf[ks] = ld8(Tbuf + ((size_t)((cgb + c0_) * 8 + h) * 2 + dir) * 4096 + (w * 16 + l15) * 64 + ks * 32 + g * 8);
    }
    for (int step = 0; step < nch; ++step) {
      const int cnx = (step + 1 < nch) ? (dir ? nch - 2 - step : step + 1) : (dir ? nch - 1 - step : step);
      const int c = dir ? nch - 1 - step : step;
      const int t0 = (cgb + c) * 64;
      const int unit = (cgb + c) * 8 + h;
#pragma unroll
      for (int i = 0; i < 4; ++i) {
        const int ci = tid + 256 * i; const int row = ci >> 4, dc = (ci & 15) * 8;
        *(u32x4*)(sK + row * 136 + dc) = pk[i];
      }
      { const int row = tid >> 2, ec = (tid & 3) * 8; *(u32x4*)(sV + row * 40 + ec) = pv; }
      if (tid < 64) { sGc[tid] = pg; sE[tid] = pe; sD[tid] = pd; }
      __syncthreads();
      if (step + 1 < nch) { const int cn = dir ? nch - 2 - step : step + 1; SCAN_PREFETCH(cn); }
      const float gl = dir ? sGc[0] : sGc[63];
      bf16x8 wf[4];
      f32x4 ua[2];
      {
        bf16x8 vtf[2][2];
        f32x4 egm[2][2];
#pragma unroll
        for (int et = 0; et < 2; ++et)
#pragma unroll
          for (int ks = 0; ks < 2; ++ks) vtf[et][ks] = ldtr(sV + (ks * 32 + g * 8 + (l15 >> 2)) * 40 + et * 16 + (l15 & 3) * 4, 4 * 40);
#pragma unroll
        for (int ks = 0; ks < 2; ++ks) { egm[ks][0] = *(const f32x4*)(sE + ks * 32 + g * 8); egm[ks][1] = *(const f32x4*)(sE + ks * 32 + g * 8 + 4); }
        __builtin_amdgcn_sched_barrier(0);
#pragma unroll
        for (int et = 0; et < 2; ++et) {
          ua[et][0] = 0.f; ua[et][1] = 0.f; ua[et][2] = 0.f; ua[et][3] = 0.f;
#pragma unroll
          for (int ks = 0; ks < 2; ++ks) ua[et] = mma(tf[ks], vtf[et][ks], ua[et]);
        }
#pragma unroll
        for (int ks = 0; ks < 2; ++ks) {
          const u32x4 tw = __builtin_bit_cast(u32x4, tf[ks]);
          u32x4 o;
#pragma unroll
          for (int e = 0; e < 4; ++e) o[e] = pack2(bflo(tw[e]) * egm[ks][e >> 1][(2 * e) & 3], bfhi(tw[e]) * egm[ks][e >> 1][(2 * e + 1) & 3]);
          tf[ks] = __builtin_bit_cast(bf16x8, o);
        }
        __builtin_amdgcn_sched_barrier(0);
      }
#pragma unroll
      for (int kq = 0; kq < 4; ++kq) {
        bf16x8 ktf[2][2];
#pragma unroll
        for (int hh = 0; hh < 2; ++hh)
#pragma unroll
          for (int ks = 0; ks < 2; ++ks) ktf[hh][ks] = ldtr(sK + (ks * 32 + g * 8 + (l15 >> 2)) * 136 + (kq * 2 + hh) * 16 + (l15 & 3) * 4, 4 * 136);
        __builtin_amdgcn_sched_barrier(0);
        f32x4 wa[2];
#pragma unroll
        for (int hh = 0; hh < 2; ++hh) {
          wa[hh][0] = 0.f; wa[hh][1] = 0.f; wa[hh][2] = 0.f; wa[hh][3] = 0.f;
#pragma unroll
          for (int ks = 0; ks < 2; ++ks) wa[hh] = mma(ktf[hh][ks], tf[ks], wa[hh]);
        }
        wf[kq] = pack8(wa[0], wa[1]);
        __builtin_amdgcn_sched_barrier(0);
      }
#pragma unroll
      for (int ks = 0; ks < 2; ++ks) tf[ks] = ld8(Tbuf + ((size_t)((cgb + cnx) * 8 + h) * 2 + dir) * 4096 + (w * 16 + l15) * 64 + ks * 32 + g * 8);
      const int iq = w * 16 + l15;
      const float gi = sGc[iq];
      const f32x4 dvec = *(const f32x4*)(sD + w * 16 + g * 4);
      f32x4 vn[2];
      bf16x8 qkf[2];
      {
        bf16x8 stp[2][4];
#pragma unroll
        for (int et = 0; et < 2; ++et)
#pragma unroll
          for (int kq = 0; kq < 4; ++kq) { const u16* sp = sST + (et * 16 + l15) * 136 + kq * 32 + g * 4; stp[et][kq] = ld44(sp, sp + 16); }
        __builtin_amdgcn_sched_barrier(0);
#pragma unroll
        for (int et = 0; et < 2; ++et) {
          f32x4 a; a[0] = 0.f; a[1] = 0.f; a[2] = 0.f; a[3] = 0.f;
#pragma unroll
          for (int kq = 0; kq < 4; ++kq) a = mma(wf[kq], stp[et][kq], a);
          vn[et][0] = ua[et][0] - a[0]; vn[et][1] = ua[et][1] - a[1]; vn[et][2] = ua[et][2] - a[2]; vn[et][3] = ua[et][3] - a[3];
        }
        __builtin_amdgcn_sched_barrier(0);
      }
#pragma unroll
      for (int kk = 0; kk < 2; ++kk) {
        bf16x8 kf[2][4];
        f32x4 gcm[2];
#pragma unroll
        for (int hh = 0; hh < 2; ++hh)
#pragma unroll
          for (int ks = 0; ks < 4; ++ks) kf[hh][ks] = ld8(sK + ((kk * 2 + hh) * 16 + l15) * 136 + ks * 32 + g * 8);
#pragma unroll
        for (int hh = 0; hh < 2; ++hh) gcm[hh] = *(const f32x4*)(sGc + (kk * 2 + hh) * 16 + g * 4);
        __builtin_amdgcn_sched_barrier(0);
        f32x4 ka[2];
#pragma unroll
        for (int hh = 0; hh < 2; ++hh) {
          const int mt = kk * 2 + hh;
          ka[hh][0] = 0.f; ka[hh][1] = 0.f; ka[hh][2] = 0.f; ka[hh][3] = 0.f;
#pragma unroll
          for (int ks = 0; ks < 4; ++ks) ka[hh] = mma(kf[hh][ks], qf[ks], ka[hh]);
#pragma unroll
          for (int r = 0; r < 4; ++r) {
            const int m = mt * 16 + g * 4 + r;
            const bool valid = dir ? (iq <= m) : (iq >= m);
            ka[hh][r] = ka[hh][r] * __expf(valid ? gi - gcm[hh][r] : -1e30f);
          }
        }
        qkf[kk] = pack8(ka[0], ka[1]);
        __builtin_amdgcn_sched_barrier(0);
      }
#pragma unroll
      for (int et = 0; et < 2; ++et) {
        const int i0 = w * 16 + g * 4;
        st4bf(sVN + (et * 16 + l15) * 72 + i0, vn[et][0], vn[et][1], vn[et][2], vn[et][3]);
        st4bf(sVD + (et * 16 + l15) * 72 + i0, vn[et][0] * dvec[0], vn[et][1] * dvec[1], vn[et][2] * dvec[2], vn[et][3] * dvec[3]);
      }
      __syncthreads();
      {
        bf16x8 stn[2][4], vnp[2][2];
#pragma unroll
        for (int et = 0; et < 2; ++et)
#pragma unroll
          for (int ks = 0; ks < 4; ++ks) stn[et][ks] = ld8(sST + (et * 16 + l15) * 136 + ks * 32 + g * 8);
#pragma unroll
        for (int et = 0; et < 2; ++et)
#pragma unroll
          for (int kk = 0; kk < 2; ++kk) { const u16* sp = sVN + (et * 16 + l15) * 72 + kk * 32 + g * 4; vnp[et][kk] = ld44(sp, sp + 16); }
        const f32x4 egi = *(const f32x4*)(sE + w * 16 + g * 4);
        __builtin_amdgcn_sched_barrier(0);
#pragma unroll
        for (int et = 0; et < 2; ++et) {
          f32x4 a1; a1[0] = 0.f; a1[1] = 0.f; a1[2] = 0.f; a1[3] = 0.f;
#pragma unroll
          for (int ks = 0; ks < 4; ++ks) a1 = mma(qf[ks], stn[et][ks], a1);
          f32x4 a2; a2[0] = 0.f; a2[1] = 0.f; a2[2] = 0.f; a2[3] = 0.f;
#pragma unroll
          for (int kk = 0; kk < 2; ++kk) a2 = mma(qkf[kk], vnp[et][kk], a2);
#pragma unroll
          for (int r = 0; r < 4; ++r) {
            const int i = w * 16 + g * 4 + r;
            const float o = a1[r] * egi[r] + a2[r];
            obase[(size_t)(t0 + i) * 4096 + dir * 1024 + h * 128 + dvq * 32 + et * 16 + l15] = f2bf(o);
          }
        }
#pragma unroll
        for (int ks = 0; ks < 4; ++ks) qf[ks] = ld8(qn + (size_t)((cgb + cnx) * 64 + w * 16 + l15) * 1024 + h * 128 + ks * 32 + g * 8);
        __builtin_amdgcn_sched_barrier(0);
      }
      {
        bf16x8 ktf2[2][2], vdf[2][2];
#pragma unroll
        for (int dt = 0; dt < 2; ++dt)
#pragma unroll
          for (int kk = 0; kk < 2; ++kk) { ktf2[dt][kk] = ldtr(sK + (kk * 32 + g * 8 + (l15 >> 2)) * 136 + w * 32 + dt * 16 + (l15 & 3) * 4, 4 * 136); vdf[dt][kk] = ld8(sVD + (dt * 16 + l15) * 72 + kk * 32 + g * 8); }
        __builtin_amdgcn_sched_barrier(0);
        const float eg = __expf(gl);
#pragma unroll
        for (int dt = 0; dt < 2; ++dt)
#pragma unroll
          for (int et = 0; et < 2; ++et) {
            f32x4 a; a[0] = S[dt][et][0] * eg; a[1] = S[dt][et][1] * eg; a[2] = S[dt][et][2] * eg; a[3] = S[dt][et][3] * eg;
#pragma unroll
            for (int kk = 0; kk < 2; ++kk) a = mma(ktf2[dt][kk], vdf[et][kk], a);
            S[dt][et] = a;
          }
      }
      __syncthreads();
#pragma unroll
      for (int dt = 0; dt < 2; ++dt)
#pragma unroll
        for (int et = 0; et < 2; ++et) st4bf(sST + (et * 16 + l15) * 136 + w * 32 + dt * 16 + g * 4, S[dt][et][0], S[dt][et][1], S[dt][et][2], S[dt][et][3]);
    }
    if (seq < 16) {
      float* so = GOUT + (dir ? O_SB : O_SF) + (((size_t)seq * 2 + j) * 8 + h) * 16384;
#pragma unroll
      for (int dt = 0; dt < 2; ++dt)
#pragma unroll
        for (int et = 0; et < 2; ++et)
#pragma unroll
          for (int r = 0; r < 4; ++r) so[(size_t)(w * 32 + dt * 16 + g * 4 + r) * 128 + dvq * 32 + et * 16 + l15] = S[dt][et][r];
    }
  }
}

#define XB_TMO      128
#define XB_XCNT(j)  (256  + 64 * (j))
#define XB_XSUB(j)  (1280 + 64 * (j))
#define XB_XGEN(j)  (2304 + 64 * (j))
#define XB_TOP      3328
#define XB_TOPGEN   3392
#define XCD_BAR_WORDS 3456
#define XB_SPIN_CAP (1u << 20)
#define LAS __attribute__((address_space(3)))
DI unsigned xb_ld(unsigned* p)              { return __hip_atomic_load(p, __ATOMIC_RELAXED, __HIP_MEMORY_SCOPE_AGENT); }
DI unsigned xb_add(unsigned* p, unsigned v) { return __hip_atomic_fetch_add(p, v, __ATOMIC_RELAXED, __HIP_MEMORY_SCOPE_AGENT); }
DI unsigned xb_xcc_id() { return (unsigned)__builtin_amdgcn_s_getreg((3 << 11) | 20) & 0xFu; }
#define XB_SPIN(cond, bar) do { unsigned _sp = 0; while (cond) { __builtin_amdgcn_s_sleep(1); \
    if ((++_sp & 255u) == 0u) { if (xb_ld(&(bar)[XB_TMO])) break; if (_sp > XB_SPIN_CAP) { atomicAdd(&(bar)[XB_TMO], 1u); break; } } } } while (0)
struct XcdBarrier { unsigned* bar; unsigned x; volatile LAS unsigned* st; };
DI XcdBarrier xcd_barrier_post(unsigned* bar, volatile LAS unsigned* st) {
  XcdBarrier b; b.bar = bar; b.x = xb_xcc_id(); b.st = st;
  if (threadIdx.x == 0) (void)xb_add(&bar[XB_XCNT(b.x)], 1u);
  return b;
}
DI void xcd_barrier_complete(unsigned* bar, unsigned x, unsigned& nloc, unsigned& nx) {
  const unsigned Gn = gridDim.x * gridDim.y * gridDim.z;
  unsigned sum, cnt, mine, sp = 0u;
  for (;;) {
    sum = 0u; cnt = 0u; mine = 0u;
#pragma unroll
    for (unsigned j = 0; j < 16; ++j) { const unsigned c = xb_ld(&bar[XB_XCNT(j)]); sum += c; cnt += (c > 0u) ? 1u : 0u; mine = (j == x) ? c : mine; }
    if (sum == Gn) break;
    __builtin_amdgcn_s_sleep(1);
    if ((++sp & 255u) == 0u) { if (xb_ld(&bar[XB_TMO])) break; if (sp > XB_SPIN_CAP) { atomicAdd(&bar[XB_TMO], 1u); break; } }
  }
  nloc = mine > 0u ? mine : 1u; nx = cnt > 0u ? cnt : 1u;
}
DI void xcd_barrier(const XcdBarrier& b) {
  asm volatile("s_waitcnt vmcnt(0)" ::: "memory");
  __syncthreads();
  if (threadIdx.x == 0) {
    unsigned* bar = b.bar;
    __builtin_amdgcn_s_waitcnt(0);
    unsigned nloc = b.st[0], nx = b.st[1];
    if (nloc == 0u) { xcd_barrier_complete(bar, b.x, nloc, nx); b.st[0] = nloc; b.st[1] = nx; }
    const unsigned old = xb_add(&bar[XB_XSUB(b.x)], 1u);
    const unsigned gen = old / nloc;
    if (old + 1u == (gen + 1u) * nloc) {
      __builtin_amdgcn_fence(__ATOMIC_RELEASE, "agent");
      asm volatile("s_waitcnt vmcnt(0)" ::: "memory");
      const unsigned og = xb_add(&bar[XB_TOP], 1u);
      const unsigned tg = og / nx;
      if (og + 1u == (tg + 1u) * nx) xb_add(&bar[XB_TOPGEN], 1u);
      else XB_SPIN(xb_ld(&bar[XB_TOPGEN]) == tg, bar);
      __builtin_amdgcn_fence(__ATOMIC_ACQUIRE, "agent");
      xb_add(&bar[XB_XGEN(b.x)], 1u);
      asm volatile("s_waitcnt vmcnt(0)" ::: "memory");
    } else {
      XB_SPIN(xb_ld(&bar[XB_XGEN(b.x)]) == gen, bar);
      __builtin_amdgcn_fence(__ATOMIC_ACQUIRE, "agent");
      asm volatile("s_waitcnt vmcnt(0)" ::: "memory");
    }
  }
  __syncthreads();
}

__global__ void __launch_bounds__(256, 2) fwd_megakernel(P p) {
  cg::grid_group grid = cg::this_grid();
  __shared__ __attribute__((aligned(16))) char smem[60416];
  const int tid = opaque_tid(), lane = tid & 63, wid = tid >> 6;
  const int G = gridDim.x;
  __shared__ uint4 xb_words;
  if (threadIdx.x == 0) xb_words = make_uint4(0u, 0u, 0u, 0u);
  __syncthreads();
  (void)xcd_barrier_post((unsigned*)(as_global(p.ws) + WS_BAR), (volatile LAS unsigned*)&xb_words);
#define GSYNC() do { XcdBarrier xb_; xb_.bar = (unsigned*)(opaque_ptr(as_global(p.ws)) + WS_BAR); xb_.x = xb_xcc_id(); xb_.st = (volatile LAS unsigned*)&xb_words; xcd_barrier(xb_); } while (0)
  const int bid0 = opaque_bid();
  {
  char* const ws0 = opaque_ptr(as_global(p.ws));
  float* mods = (float*)(ws0 + WS_MODS);
  float* ropeT = (float*)(ws0 + WS_ROPE);
  float* cosG = ropeT, *sinG = ropeT + 2048, *cosM = ropeT + 4096, *sinM = ropeT + 5120;

  {
    float* sc = (float*)smem;
    float* red = sc + 9 * 128;
    float* part = (float*)(ws0 + WS_R);
    for (int item = bid0; item < 3072; item += G) {
      const int ks = item & 7, cgp = (item >> 3) % 96, layer = item / 768;
      __syncthreads();
      for (int e = tid; e < 9 * 128; e += 256) {
        const int ci = e >> 7, k = ks * 128 + (e & 127);
        const float v = ci == 0 ? GIN(9)[k] : GIN(8)[(ci - 1) * 1024 + k];
        sc[e] = v / (1.f + expf(-v));
      }
      __syncthreads();
      const int col = tid & 63, kg = tid >> 6;
      const float* wp = GIN(12) + ((size_t)layer * 1024 + ks * 128 + kg * 32) * 6144 + cgp * 64 + col;
      float acc[9];
#pragma unroll
      for (int ci = 0; ci < 9; ++ci) acc[ci] = 0.f;
#pragma unroll 8
      for (int kk = 0; kk < 32; ++kk) {
        const float wv = wp[(size_t)kk * 6144];
#pragma unroll
        for (int ci = 0; ci < 9; ++ci) acc[ci] += sc[ci * 128 + kg * 32 + kk] * wv;
      }
#pragma unroll
      for (int ci = 0; ci < 9; ++ci) red[(kg * 64 + col) * 9 + ci] = acc[ci];
      __syncthreads();
      if (kg == 0) {
        const int n = cgp * 64 + col;
        const float bias = ks == 0 ? GIN(13)[(size_t)layer * 6144 + n] : 0.f;
#pragma unroll
        for (int ci = 0; ci < 9; ++ci) {
          const float s = red[col * 9 + ci] + red[(64 + col) * 9 + ci] + red[(128 + col) * 9 + ci] + red[(192 + col) * 9 + ci] + bias;
          part[(size_t)ks * 221184 + ((size_t)layer * 9 + ci) * 6144 + n] = s;
        }
      }
    }
    if (bid0 == G - 1) {
      for (int e = tid; e < 2048; e += 256) { const int pos = e >> 5, f = e & 31; const float fr = powf(10000.f, -(float)f / 32.f); const float a = (float)pos * fr; cosG[e] = cosf(a); sinG[e] = sinf(a); }
      for (int e = tid; e < 1024; e += 256) { const int pos = e >> 4, f = e & 15; const float fr = powf(10000.f, -(float)f / 16.f); const float a = (float)pos * fr; cosM[e] = cosf(a); sinM[e] = sinf(a); }
    }
  }
  if (gridDim.x == 0x7fffffffu) grid.sync();
  GSYNC();
  {
    const float* part = (const float*)(ws0 + WS_R);
    for (int e = bid0 * 256 + tid; e < 221184; e += G * 256) {
      float sacc = 0.f;
#pragma unroll
      for (int ks = 0; ks < 8; ++ks) sacc += part[(size_t)ks * 221184 + e];
      mods[e] = sacc;
    }
  }
  }
  GSYNC();

#pragma unroll 1
  for (int layer = 0; layer < 4; ++layer) {
    const int kind = layer % 3, j = layer / 3;
    const int bid = opaque_bid();
    char* const ws = opaque_ptr(as_global(p.ws));
    float* mods = (float*)(ws + WS_MODS);
    float* ropeT = (float*)(ws + WS_ROPE);
    float* cosG = ropeT, *sinG = ropeT + 2048, *cosM = ropeT + 4096, *sinM = ropeT + 5120;
    u16* hbuf = (u16*)(ws + WS_HBUF);
    u16* obuf = (u16*)(ws + WS_OBUF);
    u16* wmix = (u16*)(ws + WS_WMIX);
    u16* wmlp = (u16*)(ws + WS_WMLP);
    char* R = ws + WS_R;
    const float* lmods = mods + (size_t)layer * 9 * 6144;
    {
      for (int it = bid; it < 5120; it += G) norm_rows(p, layer, layer == 0, it, GIN(10) + layer * 1024, 0, 1);
      float* sT = (float*)smem;
      for (int it = bid; it < 2048; it += G) {
        if (it < 1024) convert_tile(GIN(14) + (size_t)layer * 1024 * 4096, 1024, 4096, wmlp, it, 0, sT);
        else convert_tile(GIN(15) + (size_t)layer * 4096 * 1024, 4096, 1024, wmlp + 4194304, it - 1024, 0, sT);
      }
      if (kind == 0) {
        for (int it = bid; it < 1056 + 256; it += G) {
          if (it < 1056) convert_tile(GIN(16) + (size_t)j * 1024 * 4128, 1024, 4128, wmix + WM_IN, it, 0, sT);
          else convert_tile(GIN(21) + (size_t)j * 1024 * 1024, 1024, 1024, wmix + WM_OUT, it - 1056, 0, sT);
        }
      } else if (kind == 1) {
        for (int it = bid; it < 192 + 144 + 128 + 256; it += G) {
          if (it < 192) convert_tile(GIN(22), 1024, 704, wmix + WM_IN, it, 0, sT);
          else if (it < 336) convert_tile(GIN(25), 384, 1536, wmix + WM_UQ, it - 192, 1, sT);
          else if (it < 464) convert_tile(GIN(26), 256, 2048, wmix + WM_UKV, it - 336, 0, sT);
          else convert_tile(GIN(31), 1024, 1024, wmix + WM_OUT, it - 464, 0, sT);
        }
      } else {
        for (int it = bid; it < 384 + 256; it += G) {
          if (it < 384) convert_tile(GIN(32), 1024, 1536, wmix + WM_IN, it, 0, sT);
          else convert_tile(GIN(35), 1024, 1024, wmix + WM_OUT, it - 384, 0, sT);
        }
        u16* Kg = (u16*)(R + R_KG); u16* Vg = (u16*)(R + R_VTG);
        const int tid = opaque_tid();
        for (int it = bid; it < 512; it += G) {
          const int b = it >> 6, s0 = (it & 63) * 8;
          const int ch = tid;
          float kv[8], vv[8];
#pragma unroll
          for (int e = 0; e < 8; ++e) { kv[e] = GIN(6)[((size_t)b * 512 + s0 + e) * 256 + ch]; vv[e] = GIN(7)[((size_t)b * 512 + s0 + e) * 256 + ch]; }
#pragma unroll
          for (int e = 0; e < 8; ++e) Kg[(size_t)(NPROMPT + b * 2560 + s0 + e) * 256 + ch] = f2bf(kv[e]);
          u32x4 o; o[0] = pack2(vv[0], vv[1]); o[1] = pack2(vv[2], vv[3]); o[2] = pack2(vv[4], vv[5]); o[3] = pack2(vv[6], vv[7]);
          *(u32x4*)(Vg + (size_t)(NPROMPT + b * 2560) * 256 + (size_t)ch * 2560 + s0) = o;
        }
      }
    }
    GSYNC();

    if (kind == 0) {
      {
        EpiGdnIn epi; epi.proj = (u16*)(R + R_PROJ); epi.gbuf = (float*)(R + R_GBUF);
        for (int it = bid; it < 160 * 16; it += G) { const int mt = it >> 4, nt = it & 15; gemm_tile_wide(hbuf, 1024, wmix + WM_IN, 1024, 1024, mt * 128, nt * 256, (u16*)smem, epi); }
        for (int it = bid; it < 160; it += G) gemm_tile<4>(hbuf, 1024, wmix + WM_IN, 1024, 1024, it * 128, 4096, (u16*)smem, epi);
      }
      GSYNC();
      gdn_chunk_phase(p, j, smem);
      GSYNC();
      gdn_scan_phase(p, j, smem);
      GSYNC();
      {
        const u16* pr = (const u16*)(R + R_PROJ);
        const float* on = GIN(20) + j * 128;
        const int tid = opaque_tid();
        for (int t = bid; t < NTOK; t += G) {
          const int h = tid >> 5, c = (tid & 31) * 4;
          const u16* row = pr + (size_t)t * 4096;
          const u32x2 f = *(const u32x2*)(row + h * 128 + c), b = *(const u32x2*)(row + 1024 + h * 128 + c), z = *(const u32x2*)(row + 3072 + h * 128 + c);
          float o[4] = {bflo(f[0]) + bflo(b[0]), bfhi(f[0]) + bfhi(b[0]), bflo(f[1]) + bflo(b[1]), bfhi(f[1]) + bfhi(b[1])};
          float zz[4] = {bflo(z[0]), bfhi(z[0]), bflo(z[1]), bfhi(z[1])};
          float ss = o[0] * o[0] + o[1] * o[1] + o[2] * o[2] + o[3] * o[3];
          ss += __shfl_xor(ss, 1); ss += __shfl_xor(ss, 2); ss += __shfl_xor(ss, 4); ss += __shfl_xor(ss, 8); ss += __shfl_xor(ss, 16);
          const float rs = rsqrtf(ss * (1.f / 128.f) + EPS);
          const float4 gn = *(const float4*)(on + c);
          const float gg[4] = {gn.x, gn.y, gn.z, gn.w};
          float y[4];
#pragma unroll
          for (int e = 0; e < 4; ++e) y[e] = o[e] * rs * gg[e] * (zz[e] / (1.f + __expf(-zz[e])));
          st4bf(obuf + (size_t)t * 1024 + h * 128 + c, y[0], y[1], y[2], y[3]);
        }
      }
      GSYNC();
    } else if (kind == 1) {
      {
        EpiF32 epi; epi.dst = (float*)(R + R_DPROJ); epi.ld = 768;
        for (int it = bid; it < 160 * 6; it += G) { const int mt = it / 6, nt = it % 6; gemm_tile<4>(hbuf, 1024, wmix + WM_IN, 1024, 1024, mt * 128, nt * 128, (u16*)smem, epi); }
      }
      GSYNC();
      {
        const float* dproj = (const float*)(R + R_DPROJ);
        u16* cq = (u16*)(R + R_CQ); u16* ckv = (u16*)(R + R_CKV); u16* Km = (u16*)(R + R_KM);
        const int tid = opaque_tid(), lane = tid & 63, wid = tid >> 6;
        for (int it = bid; it < 6144; it += G) {
          const int row = it * 4 + wid;
          if (row < NTOK) {
            const int t = row;
            const float* pr = dproj + (size_t)t * 768;
            float v[6]; float ss = 0.f;
#pragma unroll
            for (int e = 0; e < 6; ++e) { v[e] = pr[lane + 64 * e]; ss += v[e] * v[e]; }
            ss = wave_sum(ss);
            float rs = rsqrtf(ss * (1.f / 384.f) + EPS);
#pragma unroll
            for (int e = 0; e < 6; ++e) cq[(size_t)t * 384 + lane + 64 * e] = f2bf(v[e] * rs * GIN(23)[lane + 64 * e]);
            const int kvrow = kvrow_of_tok(t);
            float wv[4]; ss = 0.f;
#pragma unroll
            for (int e = 0; e < 4; ++e) { wv[e] = pr[384 + lane + 64 * e]; ss += wv[e] * wv[e]; }
            ss = wave_sum(ss);
            rs = rsqrtf(ss * (1.f / 256.f) + EPS);
#pragma unroll
            for (int e = 0; e < 4; ++e) {
              const float o = wv[e] * rs * GIN(24)[lane + 64 * e];
              ckv[(size_t)kvrow * 256 + lane + 64 * e] = f2bf(o);
              if (t < NPROMPT) GOUT[O_CKV + (size_t)t * 256 + lane + 64 * e] = o;
            }
            const float x = pr[640 + lane];
            ss = wave_sum(x * x);
            float kr = x * rsqrtf(ss * (1.f / 64.f) + EPS) * GIN(30)[lane];
            if (t < NPROMPT) GOUT[O_KR + (size_t)t * 64 + lane] = kr;
            else {
              const int s = (t - NPROMPT) & 2047;
              const int pos = lane < 32 ? (s >> 6) : (s & 63);
              const float cs = cosM[pos * 16 + (lane & 15)], sn = sinM[pos * 16 + (lane & 15)];
              const float partner = __shfl_xor(kr, 16);
              kr = ((lane & 16) == 0) ? kr * cs - partner * sn : partner * sn + kr * cs;
            }
            const u16 kb = f2bf(kr);
#pragma unroll
            for (int hh = 0; hh < 8; ++hh) Km[(size_t)kvrow * 1536 + hh * 192 + 128 + lane] = kb;
          } else {
            const int r = row - NTOK; const int b = r >> 9, s = r & 511;
            const int kvrow = NPROMPT + b * 2560 + s;
#pragma unroll
            for (int e = 0; e < 4; ++e) ckv[(size_t)kvrow * 256 + lane + 64 * e] = f2bf(GIN(4)[((size_t)b * 512 + s) * 256 + lane + 64 * e]);
            const u16 kb = f2bf(GIN(5)[((size_t)b * 512 + s) * 64 + lane]);
#pragma unroll
            for (int hh = 0; hh < 8; ++hh) Km[(size_t)kvrow * 1536 + hh * 192 + 128 + lane] = kb;
          }
        }
      }
      GSYNC();
      {
        EpiMlaUq e1; e1.Q = (u16*)(R + R_Q); e1.gnope = GIN(27); e1.grope = GIN(28); e1.cosT = cosM; e1.sinT = sinM;
        for (int it = bid; it < 160 * 12; it += G) { const int mt = it / 12, nt = it % 12; gemm_tile<8>((const u16*)(R + R_CQ), 384, wmix + WM_UQ, 384, 384, mt * 128, nt * 128, (u16*)smem, e1); }
        EpiMlaUkv e2; e2.Kb = (u16*)(R + R_KM); e2.Vt = (u16*)(R + R_VTM); e2.gnope = GIN(29);
        for (int it = bid; it < 192 * 16; it += G) { const int mt = it / 16, nt = it % 16; gemm_tile<8>((const u16*)(R + R_CKV), 256, wmix + WM_UKV, 256, 256, mt * 128, nt * 128, (u16*)smem, e2); }
      }
      GSYNC();
      attn_phase<192, 8>((const u16*)(R + R_Q), (const u16*)(R + R_KM), (const u16*)(R + R_VTM), obuf, smem);
      GSYNC();
    } else {
      {
        EpiGqaIn epi; epi.Q = (u16*)(R + R_Q); epi.Kb = (u16*)(R + R_KG); epi.Vt = (u16*)(R + R_VTG); epi.qg = GIN(33); epi.kg = GIN(34); epi.cosT = cosG; epi.sinT = sinG; epi.out = GOUT;
        for (int it = bid; it < 160 * 12; it += G) { const int mt = it / 12, nt = it % 12; gemm_tile<8>(hbuf, 1024, wmix + WM_IN, 1024, 1024, mt * 128, nt * 128, (u16*)smem, epi); }
      }
      GSYNC();
      attn_phase<128, 2>((const u16*)(R + R_Q), (const u16*)(R + R_KG), (const u16*)(R + R_VTG), obuf, smem);
      GSYNC();
    }

    for (int it = bid; it < 768; it += G) {
      const bool wide = it < 512;
      int m0, n0;
      if (wide) { m0 = (it >> 2) * 128; n0 = (it & 3) * 256; } else { const int ix = it - 512; m0 = (128 + (ix >> 3)) * 128; n0 = (ix & 7) * 128; }
      EpiResid epi;
      epi.xin = (layer == 0) ? (m0 < NPROMPT ? GIN(0) : GIN(1) - (size_t)NPROMPT * 1024) : GOUT;
      epi.xout = GOUT; epi.gate = lmods + (size_t)cond_of(m0) * 6144 + 2 * 1024;
      if (wide) gemm_tile_wide(obuf, 1024, wmix + WM_OUT, 1024, 1024, m0, n0, (u16*)smem, epi);
      else gemm_tile<4>(obuf, 1024, wmix + WM_OUT, 1024, 1024, m0, n0, (u16*)smem, epi);
    }
    GSYNC();
    for (int it = bid; it < 5120; it += G) norm_rows(p, layer, false, it, GIN(11) + layer * 1024, 3, 4);
    GSYNC();
    {
      EpiMlpIn epi; epi.abuf = (u16*)(R + R_ABUF);
      for (int it = bid; it < 160 * 16; it += G) { const int mt = it >> 4, nt = it & 15; gemm_tile_wide(hbuf, 1024, wmlp, 1024, 1024, mt * 128, nt * 256, (u16*)smem, epi); }
    }
    GSYNC();
    for (int it = bid; it < 768; it += G) {
      const bool wide = it < 512;
      int m0, n0;
      if (wide) { m0 = (it >> 2) * 128; n0 = (it & 3) * 256; } else { const int ix = it - 512; m0 = (128 + (ix >> 3)) * 128; n0 = (ix & 7) * 128; }
      EpiResid epi; epi.xin = GOUT; epi.xout = GOUT; epi.gate = lmods + (size_t)cond_of(m0) * 6144 + 5 * 1024;
      if (wide) gemm_tile_wide((const u16*)(R + R_ABUF), 4096, wmlp + 4194304, 4096, 4096, m0, n0, (u16*)smem, epi);
      else gemm_tile<4>((const u16*)(R + R_ABUF), 4096, wmlp + 4194304, 4096, 4096, m0, n0, (u16*)smem, epi);
    }
    GSYNC();
  }
}

extern "C" void kernel_launch(void* const* d_in, const int* in_sizes, int n_in, void* d_out, int out_size, void* d_ws, size_t ws_size, hipStream_t stream) {
  static int grid_blocks = 0;
  if (!grid_blocks) {
    int dev = 0, cus = 0, per_cu = 0;
    hipGetDevice(&dev);
    hipDeviceGetAttribute(&cus, hipDeviceAttributeMultiprocessorCount, dev);
    hipOccupancyMaxActiveBlocksPerMultiprocessor(&per_cu, fwd_megakernel, 256, 0);
    if (per_cu < 1) per_cu = 1;
    if (per_cu > 2) per_cu = 2;
    grid_blocks = cus * per_cu;
  }
  P p{};
  for (int i = 0; i < 36; ++i) p.in[i] = (const float*)d_in[i];
  p.out = (float*)d_out;
  p.ws = (char*)d_ws;
  (void)hipMemsetAsync((char*)d_ws + WS_BAR, 0, XCD_BAR_WORDS * 4, stream);
  void* args[] = {&p};
  hipError_t e = hipLaunchCooperativeKernel((void*)fwd_megakernel, dim3(grid_blocks), dim3(256), args, 0, stream);
  if (e != hipSuccess) fprintf(stderr, "cooperative launch failed: %s (grid %d)\n", hipGetErrorString(e), grid_blocks);
}
```

```cpp
#include <hip/hip_runtime.h>
#include <hip/hip_cooperative_groups.h>
#include <cstdio>
namespace cg = cooperative_groups;

typedef unsigned short u16;
typedef __attribute__((ext_vector_type(8))) short bf16x8;
typedef __attribute__((ext_vector_type(4))) short bf16x4;
typedef __attribute__((ext_vector_type(4))) float f32x4;
typedef __attribute__((ext_vector_type(4))) unsigned u32x4;
typedef __attribute__((ext_vector_type(2))) unsigned u32x2;

#define DI __device__ __forceinline__

constexpr int NTOK = 20480;
constexpr int NPROMPT = 4096;
constexpr float EPS = 1e-6f;

constexpr size_t WS_MODS = 0;
constexpr size_t MODS_BYTES = 4ull * 9 * 6144 * 4;
constexpr size_t WS_BAR = 917504;
constexpr size_t WS_ROPE = 1048576;
constexpr size_t WS_WMIX = 1114112;
constexpr size_t WS_WMLP = 14090240;
constexpr size_t WS_HBUF = 30867456;
constexpr size_t WS_OBUF = 72810496;
constexpr size_t WS_R    = 114753536;
constexpr size_t R_ABUF = 0;
constexpr size_t R_PROJ = 0;
constexpr size_t R_VBUF = 167772160;
constexpr size_t R_TBUF = 209715200;
constexpr size_t R_GBUF = 251658240;
constexpr size_t R_GCB  = 254279680;
constexpr size_t R_BETA = 255590400;
constexpr size_t R_EG   = 256901120;
constexpr size_t R_ED   = 258211840;
constexpr size_t R_DPROJ = 0;
constexpr size_t R_Q    = 0;
constexpr size_t R_CQ   = 62914560;
constexpr size_t R_CKV  = 78643200;
constexpr size_t R_KM   = 91226112;
constexpr size_t R_VTM  = 166723584;
constexpr size_t R_KG   = 41943040;
constexpr size_t R_VTG  = 54525952;
constexpr size_t WM_IN = 0;
constexpr size_t WM_OUT = 4325376;
constexpr size_t WM_UQ = 5373952;
constexpr size_t WM_UKV = 5963776;
constexpr size_t O_SF = 20971520, O_SB = 25165824, O_CKV = 29360128, O_KR = 30408704, O_GK = 30670848, O_GV = 31719424;

struct P {
  const float* in[36];
  float* out;
  char* ws;
};

typedef __attribute__((ext_vector_type(2))) float f32x2_t;
typedef __attribute__((ext_vector_type(2))) __bf16 bf16x2_t;
DI u16 f2bf(float x) { return __builtin_bit_cast(u16, (__bf16)x); }
DI float bf2f(u16 h) { return __uint_as_float(((unsigned)h) << 16); }
DI unsigned pack2(float a, float b) { f32x2_t v; v[0] = a; v[1] = b; return __builtin_bit_cast(unsigned, __builtin_convertvector(v, bf16x2_t)); }
DI float bflo(unsigned w) { return __uint_as_float(w << 16); }
DI float bfhi(unsigned w) { return __uint_as_float(w & 0xffff0000u); }
DI f32x4 mma(bf16x8 a, bf16x8 b, f32x4 c) { return __builtin_amdgcn_mfma_f32_16x16x32_bf16(a, b, c, 0, 0, 0); }
DI bf16x8 pack8(f32x4 a, f32x4 b) {
  u32x4 p; p[0] = pack2(a[0], a[1]); p[1] = pack2(a[2], a[3]); p[2] = pack2(b[0], b[1]); p[3] = pack2(b[2], b[3]);
  return __builtin_bit_cast(bf16x8, p);
}
DI bf16x8 ld8(const u16* p) { return *(const bf16x8*)p; }
DI bf16x8 ld44(const u16* p0, const u16* p1) {
  u32x2 a = *(const u32x2*)p0; u32x2 b = *(const u32x2*)p1;
  u32x4 r; r[0] = a[0]; r[1] = a[1]; r[2] = b[0]; r[3] = b[1];
  return __builtin_bit_cast(bf16x8, r);
}
typedef __attribute__((ext_vector_type(4))) short s16x4_t;
DI bf16x8 ldtr(const u16* p, int row4_off) {
  typedef __attribute__((address_space(3))) s16x4_t lds4_t;
  const s16x4_t lo = __builtin_amdgcn_ds_read_tr16_b64_v4i16((lds4_t*)p);
  const s16x4_t hi = __builtin_amdgcn_ds_read_tr16_b64_v4i16((lds4_t*)(p + row4_off));
  return __builtin_shufflevector(lo, hi, 0, 1, 2, 3, 4, 5, 6, 7);
}
DI void st4bf(u16* p, float a, float b, float c, float d) { u32x2 v; v[0] = pack2(a, b); v[1] = pack2(c, d); *(u32x2*)p = v; }
DI float wave_sum(float v) {
  v += __shfl_xor(v, 1); v += __shfl_xor(v, 2); v += __shfl_xor(v, 4); v += __shfl_xor(v, 8); v += __shfl_xor(v, 16); v += __shfl_xor(v, 32);
  return v;
}
DI float sum_g(float v) { v += __shfl_xor(v, 16); v += __shfl_xor(v, 32); return v; }
DI int opaque_tid() { int t = threadIdx.x; asm volatile("" : "+v"(t)); return t; }
DI int opaque_bid() { int t = __builtin_amdgcn_readfirstlane((int)blockIdx.x); asm volatile("" : "+s"(t)); return t; }
DI char* opaque_ptr(char* q) {
  unsigned lo = __builtin_amdgcn_readfirstlane((unsigned)(size_t)q), hi = __builtin_amdgcn_readfirstlane((unsigned)((size_t)q >> 32));
  asm volatile("" : "+s"(lo), "+s"(hi));
  typedef __attribute__((address_space(1))) char gchar_t;
  return (char*)(gchar_t*)(((size_t)hi << 32) | (size_t)lo);
}
template <class T> DI T* as_global(T* q) { typedef __attribute__((address_space(1))) T gT; return (T*)(gT*)q; }
#define GIN(i) as_global(p.in[i])
#define GOUT as_global(p.out)
DI int cond_of(int t) { return t < NPROMPT ? 0 : 1 + ((t - NPROMPT) >> 11); }
DI int kvrow_of_tok(int t) { return t < NPROMPT ? t : NPROMPT + ((t - NPROMPT) >> 11) * 2560 + 512 + ((t - NPROMPT) & 2047); }

template <int NI, class Epi>
DI void gemm_tile(const u16* __restrict__ A, int lda, const u16* __restrict__ Bt, int ldb, int K, int m0, int n0, u16* smem, Epi& epi) {
  constexpr int MI = 16 / NI;
  constexpr int WN = 8 / NI;
  const int tid = opaque_tid(), lane = tid & 63, wid = tid >> 6, l15 = lane & 15, g = lane >> 4;
  const int wm = wid / WN, wn = wid % WN;
  u16* sA = smem; u16* sB = smem + 128 * 64;
  f32x4 acc[MI][NI];
#pragma unroll
  for (int mi = 0; mi < MI; ++mi)
#pragma unroll
    for (int ni = 0; ni < NI; ++ni) { acc[mi][ni][0] = 0.f; acc[mi][ni][1] = 0.f; acc[mi][ni][2] = 0.f; acc[mi][ni][3] = 0.f; }
  const int lrow = tid >> 3, lkc = (tid & 7) * 8;
  const int wofs = lrow * 64 + (((tid & 7) ^ ((lrow >> 1) & 7)) * 8);
  const int rsw = (l15 >> 1) & 7;
  const int rofs0 = l15 * 64 + ((g ^ rsw) * 8), rofs1 = l15 * 64 + (((4 + g) ^ rsw) * 8);
  const u16* pa = A + (size_t)(m0 + lrow) * lda + lkc;
  const u16* pb = Bt + (size_t)(n0 + lrow) * ldb + lkc;
  u32x4 ra[2][4], rb[2][4];
  const int nk = K >> 6;
#pragma unroll
  for (int i = 0; i < 4; ++i) { ra[0][i] = *(const u32x4*)(pa + (size_t)i * 32 * lda); rb[0][i] = *(const u32x4*)(pb + (size_t)i * 32 * ldb); }
#pragma unroll
  for (int i = 0; i < 4; ++i) { ra[1][i] = *(const u32x4*)(pa + (size_t)i * 32 * lda + 64); rb[1][i] = *(const u32x4*)(pb + (size_t)i * 32 * ldb + 64); }
  for (int kt = 0; kt < nk; kt += 2) {
#pragma unroll
    for (int half = 0; half < 2; ++half) {
      __syncthreads();
#pragma unroll
      for (int i = 0; i < 4; ++i) { *(u32x4*)(sA + wofs + i * 32 * 64) = ra[half][i]; *(u32x4*)(sB + wofs + i * 32 * 64) = rb[half][i]; }
      __syncthreads();
      if (kt + half + 2 < nk) {
        const int ko = (kt + half + 2) * 64;
#pragma unroll
        for (int i = 0; i < 4; ++i) { ra[half][i] = *(const u32x4*)(pa + (size_t)i * 32 * lda + ko); rb[half][i] = *(const u32x4*)(pb + (size_t)i * 32 * ldb + ko); }
      }
#pragma unroll
      for (int ks = 0; ks < 2; ++ks) {
        const int ro = ks ? rofs1 : rofs0;
        bf16x8 af[MI], bfv[NI];
#pragma unroll
        for (int mi = 0; mi < MI; ++mi) af[mi] = ld8(sA + (wm * MI * 16 + mi * 16) * 64 + ro);
#pragma unroll
        for (int ni = 0; ni < NI; ++ni) bfv[ni] = ld8(sB + (wn * NI * 16 + ni * 16) * 64 + ro);
        __builtin_amdgcn_s_setprio(1);
#pragma unroll
        for (int mi = 0; mi < MI; ++mi)
#pragma unroll
          for (int ni = 0; ni < NI; ++ni) acc[mi][ni] = mma(bfv[ni], af[mi], acc[mi][ni]);
        __builtin_amdgcn_s_setprio(0);
      }
    }
  }
  epi.template run<MI, NI>(acc, m0 + wm * MI * 16, n0 + wn * NI * 16, l15, g);
}

template <class Epi>
DI void gemm_tile_wide(const u16* __restrict__ A, int lda, const u16* __restrict__ Bt, int ldb, int K, int m0, int n0, u16* smem, Epi& epi) {
  constexpr int MI = 4, NI = 8;
  const int tid = opaque_tid(), lane = tid & 63, wid = tid >> 6, l15 = lane & 15, g = lane >> 4;
  const int wm = wid >> 1, wn = wid & 1;
  u16* sA = smem; u16* sB = smem + 128 * 64;
  f32x4 acc[MI][NI];
#pragma unroll
  for (int mi = 0; mi < MI; ++mi)
#pragma unroll
    for (int ni = 0; ni < NI; ++ni) { acc[mi][ni][0] = 0.f; acc[mi][ni][1] = 0.f; acc[mi][ni][2] = 0.f; acc[mi][ni][3] = 0.f; }
  const int lrow = tid >> 3, lkc = (tid & 7) * 8;
  const int wofs = lrow * 64 + (((tid & 7) ^ ((lrow >> 1) & 7)) * 8);
  const int rsw = (l15 >> 1) & 7;
  const int rofs0 = l15 * 64 + ((g ^ rsw) * 8), rofs1 = l15 * 64 + (((4 + g) ^ rsw) * 8);
  const u16* pa = A + (size_t)(m0 + lrow) * lda + lkc;
  const u16* pb = Bt + (size_t)(n0 + lrow) * ldb + lkc;
  u32x4 ra[4], rb[8];
  const int nk = K >> 6;
#pragma unroll
  for (int i = 0; i < 4; ++i) ra[i] = *(const u32x4*)(pa + (size_t)i * 32 * lda);
#pragma unroll
  for (int i = 0; i < 8; ++i) rb[i] = *(const u32x4*)(pb + (size_t)i * 32 * ldb);
  for (int kt = 0; kt < nk; ++kt) {
    __syncthreads();
#pragma unroll
    for (int i = 0; i < 4; ++i) *(u32x4*)(sA + wofs + i * 32 * 64) = ra[i];
#pragma unroll
    for (int i = 0; i < 8; ++i) *(u32x4*)(sB + wofs + i * 32 * 64) = rb[i];
    __syncthreads();
    if (kt + 1 < nk) {
      const int ko = (kt + 1) * 64;
#pragma unroll
      for (int i = 0; i < 4; ++i) ra[i] = *(const u32x4*)(pa + (size_t)i * 32 * lda + ko);
#pragma unroll
      for (int i = 0; i < 8; ++i) rb[i] = *(const u32x4*)(pb + (size_t)i * 32 * ldb + ko);
    }
#pragma unroll
    for (int ks = 0; ks < 2; ++ks) {
      const int ro = ks ? rofs1 : rofs0;
      bf16x8 af[MI];
#pragma unroll
      for (int mi = 0; mi < MI; ++mi) af[mi] = ld8(sA + (wm * 64 + mi * 16) * 64 + ro);
#pragma unroll
      for (int nh = 0; nh < 2; ++nh) {
        bf16x8 bfv[4];
#pragma unroll
        for (int ni = 0; ni < 4; ++ni) bfv[ni] = ld8(sB + (wn * 128 + (nh * 4 + ni) * 16) * 64 + ro);
        __builtin_amdgcn_s_setprio(1);
#pragma unroll
        for (int mi = 0; mi < MI; ++mi)
#pragma unroll
          for (int ni = 0; ni < 4; ++ni) acc[mi][nh * 4 + ni] = mma(bfv[ni], af[mi], acc[mi][nh * 4 + ni]);
        __builtin_amdgcn_s_setprio(0);
        __builtin_amdgcn_sched_barrier(0);
      }
    }
  }
  epi.template run<MI, NI>(acc, m0 + wm * 64, n0 + wn * 128, l15, g);
}

struct EpiResid {
  const float* xin; float* xout; const float* gate;
  template <int MI, int NI> DI void run(f32x4 (&acc)[MI][NI], int mr, int nc, int l15, int g) {
#pragma unroll
    for (int mi = 0; mi < MI; ++mi)
#pragma unroll
      for (int ni = 0; ni < NI; ++ni) {
        const int m = mr + mi * 16 + l15, n = nc + ni * 16 + g * 4;
        const float4 xi = *(const float4*)(xin + (size_t)m * 1024 + n);
        const float4 gt = *(const float4*)(gate + n);
        float4 o; o.x = xi.x + gt.x * acc[mi][ni][0]; o.y = xi.y + gt.y * acc[mi][ni][1]; o.z = xi.z + gt.z * acc[mi][ni][2]; o.w = xi.w + gt.w * acc[mi][ni][3];
        *(float4*)(xout + (size_t)m * 1024 + n) = o;
      }
  }
};
struct EpiGdnIn {
  u16* proj; float* gbuf;
  template <int MI, int NI> DI void run(f32x4 (&acc)[MI][NI], int mr, int nc, int l15, int g) {
#pragma unroll
    for (int mi = 0; mi < MI; ++mi)
#pragma unroll
      for (int ni = 0; ni < NI; ++ni) {
        const int m = mr + mi * 16 + l15, n = nc + ni * 16 + g * 4;
        if (n < 4096) st4bf(proj + (size_t)m * 4096 + n, acc[mi][ni][0], acc[mi][ni][1], acc[mi][ni][2], acc[mi][ni][3]);
        else if (n < 4128) { float4 o; o.x = acc[mi][ni][0]; o.y = acc[mi][ni][1]; o.z = acc[mi][ni][2]; o.w = acc[mi][ni][3]; *(float4*)(gbuf + (size_t)m * 32 + (n - 4096)) = o; }
      }
  }
};
struct EpiMlpIn {
  u16* abuf;
  template <int MI, int NI> DI void run(f32x4 (&acc)[MI][NI], int mr, int nc, int l15, int g) {
#pragma unroll
    for (int mi = 0; mi < MI; ++mi)
#pragma unroll
      for (int ni = 0; ni < NI; ++ni) {
        const int m = mr + mi * 16 + l15, n = nc + ni * 16 + g * 4;
        float a = fmaxf(acc[mi][ni][0], 0.f), b = fmaxf(acc[mi][ni][1], 0.f), c = fmaxf(acc[mi][ni][2], 0.f), d = fmaxf(acc[mi][ni][3], 0.f);
        st4bf(abuf + (size_t)m * 4096 + n, a * a, b * b, c * c, d * d);
      }
  }
};
struct EpiF32 {
  float* dst; int ld;
  template <int MI, int NI> DI void run(f32x4 (&acc)[MI][NI], int mr, int nc, int l15, int g) {
#pragma unroll
    for (int mi = 0; mi < MI; ++mi)
#pragma unroll
      for (int ni = 0; ni < NI; ++ni) {
        const int m = mr + mi * 16 + l15, n = nc + ni * 16 + g * 4;
        float4 o; o.x = acc[mi][ni][0]; o.y = acc[mi][ni][1]; o.z = acc[mi][ni][2]; o.w = acc[mi][ni][3];
        *(float4*)(dst + (size_t)m * ld + n) = o;
      }
  }
};

DI void rope128(f32x4 (&v)[8], int rowp, int colp, int g, const float* cosT, const float* sinT) {
#pragma unroll
  for (int hf = 0; hf < 2; ++hf) {
    const int pos = hf ? colp : rowp;
#pragma unroll
    for (int a = 0; a < 2; ++a) {
      const int n1 = hf * 4 + a, n2 = n1 + 2;
      const float4 cs = *(const float4*)(cosT + pos * 32 + a * 16 + g * 4);
      const float4 sn = *(const float4*)(sinT + pos * 32 + a * 16 + g * 4);
      const float c4[4] = {cs.x, cs.y, cs.z, cs.w}, s4[4] = {sn.x, sn.y, sn.z, sn.w};
#pragma unroll
      for (int j = 0; j < 4; ++j) { const float x1 = v[n1][j], x2 = v[n2][j]; v[n1][j] = x1 * c4[j] - x2 * s4[j]; v[n2][j] = x1 * s4[j] + x2 * c4[j]; }
    }
  }
}
DI void rope64(f32x4* v, int rowp, int colp, int g, const float* cosT, const float* sinT) {
#pragma unroll
  for (int hf = 0; hf < 2; ++hf) {
    const int pos = hf ? colp : rowp;
    const int n1 = hf * 2, n2 = n1 + 1;
    const float4 cs = *(const float4*)(cosT + pos * 16 + g * 4);
    const float4 sn = *(const float4*)(sinT + pos * 16 + g * 4);
    const float c4[4] = {cs.x, cs.y, cs.z, cs.w}, s4[4] = {sn.x, sn.y, sn.z, sn.w};
#pragma unroll
    for (int j = 0; j < 4; ++j) { const float x1 = v[n1][j], x2 = v[n2][j]; v[n1][j] = x1 * c4[j] - x2 * s4[j]; v[n2][j] = x1 * s4[j] + x2 * c4[j]; }
  }
}

struct EpiGqaIn {
  u16* Q; u16* Kb; u16* Vt; const float* qg; const float* kg; const float* cosT; const float* sinT; float* out;
  template <int MI, int NI> DI void run(f32x4 (&acc)[MI][NI], int mr, int nc, int l15, int g) {
    const int nt = nc >> 7;
#pragma unroll
    for (int mi = 0; mi < MI; ++mi) {
      const int m = mr + mi * 16 + l15;
      const bool prompt = m < NPROMPT;
      const int s = prompt ? (m & 255) : ((m - NPROMPT) & 2047);
      const int rowp = s >> 6, colp = s & 63;
      const int kvrow = kvrow_of_tok(m);
      if (nt < 10) {
        float ss = 0.f;
#pragma unroll
        for (int ni = 0; ni < NI; ++ni)
#pragma unroll
          for (int j = 0; j < 4; ++j) ss += acc[mi][ni][j] * acc[mi][ni][j];
        ss = sum_g(ss);
        const float rs = rsqrtf(ss * (1.f / 128.f) + EPS);
        const float* gn = nt < 8 ? qg : kg;
#pragma unroll
        for (int ni = 0; ni < NI; ++ni) {
          const float4 gv = *(const float4*)(gn + ni * 16 + g * 4);
          acc[mi][ni][0] *= rs * gv.x; acc[mi][ni][1] *= rs * gv.y; acc[mi][ni][2] *= rs * gv.z; acc[mi][ni][3] *= rs * gv.w;
        }
        if (nt >= 8 && prompt) {
#pragma unroll
          for (int ni = 0; ni < NI; ++ni) { float4 o; o.x = acc[mi][ni][0]; o.y = acc[mi][ni][1]; o.z = acc[mi][ni][2]; o.w = acc[mi][ni][3]; *(float4*)(out + O_GK + (size_t)m * 256 + (nt - 8) * 128 + ni * 16 + g * 4) = o; }
        }
        if (!prompt) rope128(acc[mi], rowp, colp, g, cosT, sinT);
        u16* dst = nt < 8 ? Q + (size_t)m * 1024 + nt * 128 : Kb + (size_t)kvrow * 256 + (nt - 8) * 128;
#pragma unroll
        for (int ni = 0; ni < NI; ++ni) st4bf(dst + ni * 16 + g * 4, acc[mi][ni][0], acc[mi][ni][1], acc[mi][ni][2], acc[mi][ni][3]);
      } else {
        const int kvh = nt - 10;
        if (prompt) {
#pragma unroll
          for (int ni = 0; ni < NI; ++ni) { float4 o; o.x = acc[mi][ni][0]; o.y = acc[mi][ni][1]; o.z = acc[mi][ni][2]; o.w = acc[mi][ni][3]; *(float4*)(out + O_GV + (size_t)m * 256 + kvh * 128 + ni * 16 + g * 4) = o; }
        }
        size_t base; int kvlen, pos;
        if (prompt) { base = (size_t)(m >> 8) * 256 * 256; kvlen = 256; pos = m & 255; }
        else { const int b = (m - NPROMPT) >> 11; base = (size_t)(NPROMPT + b * 2560) * 256; kvlen = 2560; pos = 512 + s; }
#pragma unroll
        for (int ni = 0; ni < NI; ++ni)
#pragma unroll
          for (int j = 0; j < 4; ++j) Vt[base + (size_t)(kvh * 128 + ni * 16 + g * 4 + j) * kvlen + pos] = f2bf(acc[mi][ni][j]);
      }
    }
  }
};
struct EpiMlaUq {
  u16* Q; const float* gnope; const float* grope; const float* cosT; const float* sinT;
  template <int MI, int NI> DI void run(f32x4 (&acc)[MI][NI], int mr, int nc, int l15, int g) {
    const int nt = nc >> 7;
#pragma unroll
    for (int mi = 0; mi < MI; ++mi) {
      const int m = mr + mi * 16 + l15;
      const bool prompt = m < NPROMPT;
      const int s = prompt ? (m & 255) : ((m - NPROMPT) & 2047);
      const int rowp = s >> 6, colp = s & 63;
      if (nt < 8) {
        float ss = 0.f;
#pragma unroll
        for (int ni = 0; ni < NI; ++ni)
#pragma unroll
          for (int j = 0; j < 4; ++j) ss += acc[mi][ni][j] * acc[mi][ni][j];
        ss = sum_g(ss);
        const float rs = rsqrtf(ss * (1.f / 128.f) + EPS);
#pragma unroll
        for (int ni = 0; ni < NI; ++ni) {
          const float4 gv = *(const float4*)(gnope + ni * 16 + g * 4);
          st4bf(Q + (size_t)m * 1536 + nt * 192 + ni * 16 + g * 4, acc[mi][ni][0] * rs * gv.x, acc[mi][ni][1] * rs * gv.y, acc[mi][ni][2] * rs * gv.z, acc[mi][ni][3] * rs * gv.w);
        }
      } else {
#pragma unroll
        for (int hh = 0; hh < 2; ++hh) {
          const int h = (nt - 8) * 2 + hh;
          float ss = 0.f;
#pragma unroll
          for (int ni = 0; ni < 4; ++ni)
#pragma unroll
            for (int j = 0; j < 4; ++j) ss += acc[mi][hh * 4 + ni][j] * acc[mi][hh * 4 + ni][j];
          ss = sum_g(ss);
          const float rs = rsqrtf(ss * (1.f / 64.f) + EPS);
#pragma unroll
          for (int ni = 0; ni < 4; ++ni) {
            const float4 gv = *(const float4*)(grope + ni * 16 + g * 4);
            acc[mi][hh * 4 + ni][0] *= rs * gv.x; acc[mi][hh * 4 + ni][1] *= rs * gv.y; acc[mi][hh * 4 + ni][2] *= rs * gv.z; acc[mi][hh * 4 + ni][3] *= rs * gv.w;
          }
          if (!prompt) rope64(&acc[mi][hh * 4], rowp, colp, g, cosT, sinT);
#pragma unroll
          for (int ni = 0; ni < 4; ++ni)
            st4bf(Q + (size_t)m * 1536 + h * 192 + 128 + ni * 16 + g * 4, acc[mi][hh * 4 + ni][0], acc[mi][hh * 4 + ni][1], acc[mi][hh * 4 + ni][2], acc[mi][hh * 4 + ni][3]);
        }
      }
    }
  }
};
struct EpiMlaUkv {
  u16* Kb; u16* Vt; const float* gnope;
  template <int MI, int NI> DI void run(f32x4 (&acc)[MI][NI], int mr, int nc, int l15, int g) {
    const int nt = nc >> 7, h = nt >> 1;
#pragma unroll
    for (int mi = 0; mi < MI; ++mi) {
      const int m = mr + mi * 16 + l15;
      if ((nt & 1) == 0) {
        float ss = 0.f;
#pragma unroll
        for (int ni = 0; ni < NI; ++ni)
#pragma unroll
          for (int j = 0; j < 4; ++j) ss += acc[mi][ni][j] * acc[mi][ni][j];
        ss = sum_g(ss);
        const float rs = rsqrtf(ss * (1.f / 128.f) + EPS);
#pragma unroll
        for (int ni = 0; ni < NI; ++ni) {
          const float4 gv = *(const float4*)(gnope + ni * 16 + g * 4);
          st4bf(Kb + (size_t)m * 1536 + h * 192 + ni * 16 + g * 4, acc[mi][ni][0] * rs * gv.x, acc[mi][ni][1] * rs * gv.y, acc[mi][ni][2] * rs * gv.z, acc[mi][ni][3] * rs * gv.w);
        }
      } else {
        size_t base; int kvlen, pos;
        if (m < NPROMPT) { base = (size_t)(m >> 8) * 256 * 1024; kvlen = 256; pos = m & 255; }
        else { const int r = m - NPROMPT; const int b = r / 2560; base = (size_t)(NPROMPT + b * 2560) * 1024; kvlen = 2560; pos = r - b * 2560; }
#pragma unroll
        for (int ni = 0; ni < NI; ++ni)
#pragma unroll
          for (int j = 0; j < 4; ++j) Vt[base + (size_t)(h * 128 + ni * 16 + g * 4 + j) * kvlen + pos] = f2bf(acc[mi][ni][j]);
      }
    }
  }
};

DI void convert_tile(const float* __restrict__ W, int K, int N, u16* __restrict__ Bt, int tile, int perm, float* sT) {
  const int nkt = K >> 6;
  const int kt = tile % nkt, nt = tile / nkt;
  const int k0 = kt * 64, n0 = nt * 64;
  const int tid = opaque_tid();
  __syncthreads();
  {
    const int n = tid & 63, kq = tid >> 6;
    int nd = n0 + n, ns = nd;
    if (perm == 1) { if (nd < 1024) ns = (nd >> 7) * 192 + (nd & 127); else { const int x = nd - 1024; ns = (x >> 6) * 192 + 128 + (x & 63); } }
    const bool ok = nd < N;
#pragma unroll
    for (int r = 0; r < 16; ++r) { const int k = r * 4 + kq; sT[k * 65 + n] = ok ? W[(size_t)(k0 + k) * N + ns] : 0.f; }
  }
  __syncthreads();
  {
    const int n = tid >> 2, kq = (tid & 3) * 16;
    u32x4 a, b;
#pragma unroll
    for (int e = 0; e < 4; ++e) { a[e] = pack2(sT[(kq + 2 * e) * 65 + n], sT[(kq + 2 * e + 1) * 65 + n]); b[e] = pack2(sT[(kq + 8 + 2 * e) * 65 + n], sT[(kq + 9 + 2 * e) * 65 + n]); }
    u16* dst = Bt + (size_t)(n0 + n) * K + k0 + kq;
    *(u32x4*)dst = a; *(u32x4*)(dst + 8) = b;
  }
}

DI void norm_rows(const P& p, int layer, bool from_input, int item, const float* gnorm, int shift_idx, int scale_idx) {
  const int tidn = opaque_tid();
  char* const ws = opaque_ptr(as_global(p.ws));
  const int lane = tidn & 63, wid = tidn >> 6;
  const int t = item * 4 + wid;
  const float* x = from_input ? (t < NPROMPT ? GIN(0) + (size_t)t * 1024 : GIN(1) + (size_t)(t - NPROMPT) * 1024) : GOUT + (size_t)t * 1024;
  const float* mods = (const float*)(ws + WS_MODS) + ((size_t)layer * 9 + cond_of(t)) * 6144;
  u16* h = (u16*)(ws + WS_HBUF) + (size_t)t * 1024;
  float4 v[4]; float ss = 0.f;
#pragma unroll
  for (int e = 0; e < 4; ++e) { v[e] = *(const float4*)(x + e * 256 + lane * 4); ss += v[e].x * v[e].x + v[e].y * v[e].y + v[e].z * v[e].z + v[e].w * v[e].w; }
  ss = wave_sum(ss);
  const float rs = rsqrtf(ss * (1.f / 1024.f) + EPS);
#pragma unroll
  for (int e = 0; e < 4; ++e) {
    const int c = e * 256 + lane * 4;
    const float4 gv = *(const float4*)(gnorm + c);
    const float4 sc = *(const float4*)(mods + scale_idx * 1024 + c);
    const float4 sh = *(const float4*)(mods + shift_idx * 1024 + c);
    st4bf(h + c, v[e].x * rs * gv.x * (1.f + sc.x) + sh.x, v[e].y * rs * gv.y * (1.f + sc.y) + sh.y, v[e].z * rs * gv.z * (1.f + sc.z) + sh.z, v[e].w * rs * gv.w * (1.f + sc.w) + sh.w);
  }
}

template <int DK, int HK>
DI void attn_phase(const u16* __restrict__ Q, const u16* __restrict__ Kb, const u16* __restrict__ Vt, u16* __restrict__ obuf, char* smem_raw) {
  const int bid = opaque_bid();
  constexpr int KS = DK / 32, KSTR = DK, QSTR = 8 * DK, KROW = HK * DK, GRP = 8 / HK;
  constexpr int CPR = DK / 8;
  constexpr int KCH = 64 * CPR / 256;
  u16* sK = (u16*)smem_raw;
  u16* sV = sK + 64 * KSTR;
  const int tid = opaque_tid(), lane = tid & 63, wid = tid >> 6, l15 = lane & 15, g = lane >> 4;
  const float sc = rsqrtf((float)DK) * 1.4426950408889634f;
  for (int item = bid; item < 1280; item += gridDim.x) {
    int qb, h, kvlen, tokbase, kvbase;
    if (item < 1024) { const int b = item >> 7, rem = item & 127; h = rem & 7; qb = rem >> 3; kvlen = 2560; tokbase = NPROMPT + b * 2048; kvbase = NPROMPT + b * 2560; }
    else { const int it2 = item - 1024; const int b = it2 >> 4, rem = it2 & 15; h = rem & 7; qb = rem >> 3; kvlen = 256; tokbase = b * 256; kvbase = b * 256; }
    const int kvh = h / GRP;
    const u16* Kp = Kb + (size_t)kvbase * KROW + kvh * DK;
    const u16* Vp = Vt + (size_t)kvbase * (HK * 128) + (size_t)kvh * 128 * kvlen;
    const int qrow0 = tokbase + qb * 128 + wid * 32;
    bf16x8 qf[2][KS];
#pragma unroll
    for (int qi = 0; qi < 2; ++qi)
#pragma unroll
      for (int ks = 0; ks < KS; ++ks) qf[qi][ks] = ld8(Q + (size_t)(qrow0 + qi * 16 + l15) * QSTR + h * DK + ks * 32 + g * 8);
    f32x4 ot[2][8];
#pragma unroll
    for (int qi = 0; qi < 2; ++qi)
#pragma unroll
      for (int dj = 0; dj < 8; ++dj) { ot[qi][dj][0] = 0.f; ot[qi][dj][1] = 0.f; ot[qi][dj][2] = 0.f; ot[qi][dj][3] = 0.f; }
    float mrun[2] = {-1e30f, -1e30f}, lrun[2] = {0.f, 0.f};
    const int ntiles = kvlen >> 6;
    const unsigned toffK = (unsigned)((tid >> 3) * KROW + (tid & 7) * 8), toffV = (unsigned)((tid >> 3) * kvlen + (tid & 7) * 8);
    const int kx = tid >> 3;
    const int kperm = ((kx >> 2) & 1) * 16 + (kx >> 3) * 4 + (kx & 3);
    const int kswz = (CPR == 16) ? (kperm & 15) : ((kperm >> 1) & 7);
    const int ldsoffK = kperm * KSTR;
    const int ldsoffV = (tid >> 3) * 64 + (((tid & 7) ^ (((tid >> 3) >> 1) & 7)) * 8);
    u32x4 rk[KCH], rv[4];
#pragma unroll
    for (int i = 0; i < KCH; ++i) { const int rh = i & 1, cgp = i >> 1; rk[i] = *(const u32x4*)(Kp + (size_t)(rh * 32 * KROW + cgp * 64) + toffK); }
#pragma unroll
    for (int i = 0; i < 4; ++i) rv[i] = *(const u32x4*)(Vp + (size_t)i * 32 * kvlen + toffV);
    for (int kt = 0; kt < ntiles; ++kt) {
      const u16* Kt = Kp + (size_t)(kt + 1) * 64 * KROW;
      const u16* Vtp = Vp + (kt + 1) * 64;
      const bool more = kt + 1 < ntiles;
      __syncthreads();
#pragma unroll
      for (int i = 0; i < KCH; ++i) { const int rh = i & 1, cgp = i >> 1; const int c = (tid & 7) + 8 * cgp; const int pos = (CPR == 16) ? (c ^ kswz) : ((c & ~7) | ((c & 7) ^ kswz)); *(u32x4*)(sK + ldsoffK + rh * 32 * KSTR + pos * 8) = rk[i]; }
#pragma unroll
      for (int i = 0; i < 4; ++i) *(u32x4*)(sV + ldsoffV + i * 32 * 64) = rv[i];
      __syncthreads();
      if (more) {
#pragma unroll
        for (int i = 0; i < KCH; ++i) { const int rh = i & 1, cgp = i >> 1; rk[i] = *(const u32x4*)(Kt + (size_t)(rh * 32 * KROW + cgp * 64) + toffK); }
      }
      __builtin_amdgcn_sched_barrier(0);
      f32x4 st[2][4];
#pragma unroll
      for (int qi = 0; qi < 2; ++qi)
#pragma unroll
        for (int kj = 0; kj < 4; ++kj) { st[qi][kj][0] = 0.f; st[qi][kj][1] = 0.f; st[qi][kj][2] = 0.f; st[qi][kj][3] = 0.f; }
#pragma unroll
      for (int ks = 0; ks < KS; ++ks) {
#pragma unroll
        for (int kj = 0; kj < 4; ++kj) {
          const int kc = ks * 4 + g;
          const int kpos = (CPR == 16) ? (kc ^ l15) : ((kc & ~7) | ((kc & 7) ^ ((l15 >> 1) & 7)));
          const bf16x8 ka = ld8(sK + (kj * 16 + l15) * KSTR + kpos * 8);
          __builtin_amdgcn_s_setprio(1);
          st[0][kj] = mma(ka, qf[0][ks], st[0][kj]);
          st[1][kj] = mma(ka, qf[1][ks], st[1][kj]);
          __builtin_amdgcn_s_setprio(0);
        }
        __builtin_amdgcn_sched_barrier(0);
      }
      bf16x8 pf[2][2];
#pragma unroll
      for (int qi = 0; qi < 2; ++qi) {
        float mx = -1e30f;
#pragma unroll
        for (int kj = 0; kj < 4; ++kj)
#pragma unroll
          for (int r = 0; r < 4; ++r) mx = fmaxf(mx, st[qi][kj][r]);
        mx = fmaxf(mx, __shfl_xor(mx, 16)); mx = fmaxf(mx, __shfl_xor(mx, 32));
        const float mnew = fmaxf(mrun[qi], mx);
        const float alpha = __builtin_amdgcn_exp2f((mrun[qi] - mnew) * sc);
        mrun[qi] = mnew;
        float ps = 0.f;
        const float mneg = -mnew * sc;
#pragma unroll
        for (int kj = 0; kj < 4; ++kj)
#pragma unroll
          for (int r = 0; r < 4; ++r) { const float pv = __builtin_amdgcn_exp2f(fmaf(st[qi][kj][r], sc, mneg)); st[qi][kj][r] = pv; ps += pv; }
        lrun[qi] = lrun[qi] * alpha + ps;
#pragma unroll
        for (int dj = 0; dj < 8; ++dj) { ot[qi][dj][0] *= alpha; ot[qi][dj][1] *= alpha; ot[qi][dj][2] *= alpha; ot[qi][dj][3] *= alpha; }
        pf[qi][0] = pack8(st[qi][0], st[qi][1]);
        pf[qi][1] = pack8(st[qi][2], st[qi][3]);
        __builtin_amdgcn_sched_barrier(0);
      }
      if (more) {
#pragma unroll
        for (int i = 0; i < 4; ++i) rv[i] = *(const u32x4*)(Vtp + (size_t)i * 32 * kvlen + toffV);
      }
      __builtin_amdgcn_sched_barrier(0);
#pragma unroll
      for (int kk = 0; kk < 2; ++kk)
#pragma unroll
        for (int dj = 0; dj < 8; ++dj) {
          const bf16x8 va = ld8(sV + (dj * 16 + l15) * 64 + (((kk * 4 + g) ^ ((l15 >> 1) & 7)) * 8));
          __builtin_amdgcn_s_setprio(1);
          ot[0][dj] = mma(va, pf[0][kk], ot[0][dj]);
          ot[1][dj] = mma(va, pf[1][kk], ot[1][dj]);
          __builtin_amdgcn_s_setprio(0);
          if ((dj & 3) == 3) __builtin_amdgcn_sched_barrier(0);
        }
    }
#pragma unroll
    for (int qi = 0; qi < 2; ++qi) {
      const float inv = 1.f / sum_g(lrun[qi]);
      u16* dst = obuf + (size_t)(qrow0 + qi * 16 + l15) * 1024 + h * 128 + g * 4;
#pragma unroll
      for (int dj = 0; dj < 8; ++dj) st4bf(dst + dj * 16, ot[qi][dj][0] * inv, ot[qi][dj][1] * inv, ot[qi][dj][2] * inv, ot[qi][dj][3] * inv);
    }
  }
}

DI void gdn_chunk_phase(const P& p, int j, char* smem_raw) {
  const int bid = opaque_bid();
  char* const ws = opaque_ptr(as_global(p.ws));
  u16* sK = (u16*)smem_raw;
  float* sA = (float*)(smem_raw + 17408);
  float* sG = (float*)(smem_raw + 17408 + 32768);
  float* sBt = sG + 128;
  const int tid = opaque_tid(), lane = tid & 63, wid = tid >> 6, l15 = lane & 15, g = lane >> 4;
  const u16* proj = (const u16*)(ws + WS_R + R_PROJ);
  u16* qn = (u16*)(ws + WS_HBUF); u16* kn = (u16*)(ws + WS_OBUF); u16* vb = (u16*)(ws + WS_R + R_VBUF);
  u16* Tbuf = (u16*)(ws + WS_R + R_TBUF);
  const float* gbuf = (const float*)(ws + WS_R + R_GBUF);
  float* gcb = (float*)(ws + WS_R + R_GCB); float* betab = (float*)(ws + WS_R + R_BETA);
  float* egb = (float*)(ws + WS_R + R_EG); float* edb = (float*)(ws + WS_R + R_ED);
  const float* conv = GIN(17) + (size_t)j * 3 * 3072;
  const float* a_log = GIN(18) + j * 16; const float* dt_bias = GIN(19) + j * 16;
  for (int unit = bid; unit < 2560; unit += gridDim.x) {
    const int cgi = unit >> 3, h = unit & 7;
    int c, nch; if (cgi < 64) { c = cgi & 3; nch = 4; } else { c = (cgi - 64) & 31; nch = 32; }
    const int t0 = cgi * 64;
    const bool has_prev = c > 0, has_next = c < nch - 1;
    __syncthreads();
    {
      const int r = tid >> 4, cc = (tid & 15) * 8;
#pragma unroll
      for (int part = 0; part < 3; ++part) {
        const int ch = part * 1024 + h * 128 + cc;
        float w0[8], w1[8], w2[8];
#pragma unroll
        for (int e = 0; e < 8; ++e) { w0[e] = conv[ch + e]; w1[e] = conv[3072 + ch + e]; w2[e] = conv[6144 + ch + e]; }
        u16* dstb = part == 0 ? qn : (part == 1 ? kn : vb);
        for (int it = 0; it < 4; ++it) {
          const int i = it * 16 + r, t = t0 + i;
          const u16* src = proj + (size_t)t * 4096 + ch;
          const u32x4 xc = *(const u32x4*)src;
          u32x4 xp = {0u, 0u, 0u, 0u}, xn = {0u, 0u, 0u, 0u};
          if (i > 0 || has_prev) xp = *(const u32x4*)(src - 4096);
          if (i < 63 || has_next) xn = *(const u32x4*)(src + 4096);
          float y[8];
#pragma unroll
          for (int e = 0; e < 4; ++e) {
            float a = w0[2 * e] * bflo(xp[e]) + w1[2 * e] * bflo(xc[e]) + w2[2 * e] * bflo(xn[e]);
            float b = w0[2 * e + 1] * bfhi(xp[e]) + w1[2 * e + 1] * bfhi(xc[e]) + w2[2 * e + 1] * bfhi(xn[e]);
            y[2 * e] = a / (1.f + __expf(-a)); y[2 * e + 1] = b / (1.f + __expf(-b));
          }
          if (part < 2) {
            float ss = 0.f;
#pragma unroll
            for (int e = 0; e < 8; ++e) ss += y[e] * y[e];
            ss += __shfl_xor(ss, 1); ss += __shfl_xor(ss, 2); ss += __shfl_xor(ss, 4); ss += __shfl_xor(ss, 8);
            const float rs = rsqrtf(ss + EPS) * (part == 0 ? 0.08838834764831845f : 1.f);
#pragma unroll
            for (int e = 0; e < 8; ++e) y[e] *= rs;
          }
          u32x4 o; o[0] = pack2(y[0], y[1]); o[1] = pack2(y[2], y[3]); o[2] = pack2(y[4], y[5]); o[3] = pack2(y[6], y[7]);
          *(u32x4*)(dstb + (size_t)t * 1024 + h * 128 + cc) = o;
          if (part == 1) *(u32x4*)(sK + i * 136 + cc) = o;
        }
      }
    }
    if (tid < 128) {
      const int dir = tid >> 6, L = tid & 63;
      const int i = dir ? 63 - L : L;
      const float* gb = gbuf + (size_t)(t0 + i) * 32;
      const float gin = gb[dir * 8 + h], bin = gb[16 + dir * 8 + h];
      const float x = gin + dt_bias[dir * 8 + h];
      const float sp = fmaxf(x, 0.f) + log1pf(expf(-fabsf(x)));
      float gv = -expf(a_log[dir * 8 + h]) * sp;
      const float bt = 1.f / (1.f + expf(-bin));
#pragma unroll
      for (int off = 1; off < 64; off <<= 1) { const float v = __shfl_up(gv, off); if (L >= off) gv += v; }
      sG[dir * 64 + i] = gv; sBt[dir * 64 + i] = bt;
      gcb[((size_t)(t0 + i) * 8 + h) * 2 + dir] = gv; betab[((size_t)(t0 + i) * 8 + h) * 2 + dir] = bt;
      { const float gtot = __shfl(gv, 63); egb[((size_t)(t0 + i) * 8 + h) * 2 + dir] = expf(gv); edb[((size_t)(t0 + i) * 8 + h) * 2 + dir] = expf(gtot - gv); }
    }
    __syncthreads();
    {
      f32x4 ga[4];
#pragma unroll
      for (int mt = 0; mt < 4; ++mt) { ga[mt][0] = 0.f; ga[mt][1] = 0.f; ga[mt][2] = 0.f; ga[mt][3] = 0.f; }
#pragma unroll
      for (int ks = 0; ks < 4; ++ks) {
        const bf16x8 a = ld8(sK + (wid * 16 + l15) * 136 + ks * 32 + g * 8);
#pragma unroll
        for (int mt = 0; mt < 4; ++mt) { const bf16x8 b = ld8(sK + (mt * 16 + l15) * 136 + ks * 32 + g * 8); ga[mt] = mma(a, b, ga[mt]); }
      }
#pragma unroll
      for (int dir = 0; dir < 2; ++dir)
#pragma unroll
        for (int mt = 0; mt < 4; ++mt)
#pragma unroll
          for (int r = 0; r < 4; ++r) {
            const int i = wid * 16 + g * 4 + r, m = mt * 16 + l15;
            const bool valid = dir ? (i < m) : (i > m);
            const float val = valid ? sBt[dir * 64 + i] * ga[mt][r] * __expf(sG[dir * 64 + i] - sG[dir * 64 + m]) : 0.f;
            const int ii = dir ? 63 - i : i, mm = dir ? 63 - m : m;
            sA[dir * 4096 + ii * 64 + mm] = val;
          }
    }
    __syncthreads();
    if (wid < 2) {
      const int dir = wid;
      float* Am = sA + dir * 4096;
#pragma unroll
      for (int b = 0; b < 8; ++b) {
#pragma unroll 1
        for (int r = 0; r < 8; ++r) {
          const int i = b * 8 + r;
          float4 av[16]; float tv[64];
#pragma unroll
          for (int c = 0; c < 8; ++c) if (c <= b) {
            av[2 * c] = *(const float4*)(Am + i * 64 + c * 8); av[2 * c + 1] = *(const float4*)(Am + i * 64 + c * 8 + 4);
#pragma unroll
            for (int e = 0; e < 8; ++e) tv[c * 8 + e] = Am[(c * 8 + e) * 64 + lane];
          }
          float a = (i == lane) ? 1.f : 0.f, a2 = 0.f;
#pragma unroll
          for (int c = 0; c < 8; ++c) if (c <= b) {
            a -= av[2 * c].x * tv[c * 8]; a2 -= av[2 * c].y * tv[c * 8 + 1]; a -= av[2 * c].z * tv[c * 8 + 2]; a2 -= av[2 * c].w * tv[c * 8 + 3];
            a -= av[2 * c + 1].x * tv[c * 8 + 4]; a2 -= av[2 * c + 1].y * tv[c * 8 + 5]; a -= av[2 * c + 1].z * tv[c * 8 + 6]; a2 -= av[2 * c + 1].w * tv[c * 8 + 7];
          }
          Am[i * 64 + lane] = a + a2;
        }
      }
      const int mn = dir ? 63 - lane : lane;
      const float bm = sBt[dir * 64 + mn];
      u16* Td = Tbuf + ((size_t)unit * 2 + dir) * 4096;
#pragma unroll 4
      for (int i = 0; i < 64; ++i) { const int in_ = dir ? 63 - i : i; Td[in_ * 64 + mn] = f2bf(Am[i * 64 + lane] * bm); }
    }
  }
}

DI void gdn_scan_phase(const P& p, int j, char* smem_raw) {
  const int bid = opaque_bid();
  char* const ws = opaque_ptr(as_global(p.ws));
  u16* sK = (u16*)smem_raw;
  u16* sV = sK + 64 * 136;
  u16* sST = sV + 64 * 40;
  u16* sVN = sST + 32 * 136;
  u16* sVD = sVN + 32 * 72;
  float* sGc = (float*)(sVD + 32 * 72);
  float* sE = sGc + 64;
  float* sD = sE + 64;
  const int tid = opaque_tid(), lane = tid & 63, w = tid >> 6, l15 = lane & 15, g = lane >> 4;
  const u16* qn = (const u16*)(ws + WS_HBUF); const u16* kn = (const u16*)(ws + WS_OBUF); const u16* vb = (const u16*)(ws + WS_R + R_VBUF);
  const u16* Tbuf = (const u16*)(ws + WS_R + R_TBUF);
  const float* gcb = (const float*)(ws + WS_R + R_GCB);
  const float* egb = (const float*)(ws + WS_R + R_EG); const float* edb = (const float*)(ws + WS_R + R_ED);
  u16* obase = (u16*)(ws + WS_R + R_PROJ);
  for (int wk = bid; wk < 1536; wk += gridDim.x) {
    int seq, rem;
    if (wk < 512) { seq = 16 + (wk >> 6); rem = wk & 63; } else { seq = (wk - 512) >> 6; rem = (wk - 512) & 63; }
    const int h = rem & 7, dir = (rem >> 5) & 1, dvq = (rem >> 3) & 3;
    const int nch = seq < 16 ? 4 : 32;
    const int cgb = seq < 16 ? seq * 4 : 64 + (seq - 16) * 32;
    f32x4 S[2][2];
    if (seq >= 16) {
      const float* s0 = GIN(2 + dir) + (((size_t)(seq - 16) * 2 + j) * 8 + h) * 16384;
#pragma unroll
      for (int dt = 0; dt < 2; ++dt)
#pragma unroll
        for (int et = 0; et < 2; ++et)
#pragma unroll
          for (int r = 0; r < 4; ++r) S[dt][et][r] = s0[(size_t)(w * 32 + dt * 16 + g * 4 + r) * 128 + dvq * 32 + et * 16 + l15];
    } else {
#pragma unroll
      for (int dt = 0; dt < 2; ++dt)
#pragma unroll
        for (int et = 0; et < 2; ++et) { S[dt][et][0] = 0.f; S[dt][et][1] = 0.f; S[dt][et][2] = 0.f; S[dt][et][3] = 0.f; }
    }
    __syncthreads();
#pragma unroll
    for (int dt = 0; dt < 2; ++dt)
#pragma unroll
      for (int et = 0; et < 2; ++et) st4bf(sST + (et * 16 + l15) * 136 + w * 32 + dt * 16 + g * 4, S[dt][et][0], S[dt][et][1], S[dt][et][2], S[dt][et][3]);
    u32x4 pk[4], pv; float pg = 0.f, pe = 0.f, pd = 0.f;
#define SCAN_PREFETCH(cc) do { \
      const int t0n_ = (cgb + (cc)) * 64; \
      _Pragma("unroll") for (int i = 0; i < 4; ++i) { const int ci = tid + 256 * i; const int row = ci >> 4, dc = (ci & 15) * 8; pk[i] = *(const u32x4*)(kn + (size_t)(t0n_ + row) * 1024 + h * 128 + dc); } \
      { const int row = tid >> 2, ec = (tid & 3) * 8; pv = *(const u32x4*)(vb + (size_t)(t0n_ + row) * 1024 + h * 128 + dvq * 32 + ec); } \
      if (tid < 64) { const size_t gi_ = ((size_t)(t0n_ + tid) * 8 + h) * 2 + dir; pg = gcb[gi_]; pe = egb[gi_]; pd = edb[gi_]; } \
    } while (0)
    SCAN_PREFETCH(dir ? nch - 1 : 0);
    bf16x8 qf[4], tf[2];
    {
      const int c0_ = dir ? nch - 1 : 0;
#pragma unroll
      for (int ks = 0; ks < 4; ++ks) qf[ks] = ld8(qn + (size_t)((cgb + c0_) * 64 + w * 16 + l15) * 1024 + h * 128 + ks * 32 + g * 8);
#pragma unroll
      for (int ks = 0; ks < 2; ++ks) tf[ks] = ld8(Tbuf + ((size_t)((cgb + c0_) * 8 + h) * 2 + dir) * 4096 + (w * 16 + l15) * 64 + ks * 32 + g * 8);
    }
    for (int step = 0; step < nch; ++step) {
      const int cnx = (step + 1 < nch) ? (dir ? nch - 2 - step : step + 1) : (dir ? nch - 1 - step : step);
      const int c = dir ? nch - 1 - step : step;
      const int t0 = (cgb + c) * 64;
      const int unit = (cgb + c) * 8 + h;
#pragma unroll
      for (int i = 0; i < 4; ++i) {
        const int ci = tid + 256 * i; const int row = ci >> 4, dc = (ci & 15) * 8;
        *(u32x4*)(sK + row * 136 + dc) = pk[i];
      }
      { const int row = tid >> 2, ec = (tid & 3) * 8; *(u32x4*)(sV + row * 40 + ec) = pv; }
      if (tid < 64) { sGc[tid] = pg; sE[tid] = pe; sD[tid] = pd; }
      __syncthreads();
      if (step + 1 < nch) { const int cn = dir ? nch - 2 - step : step + 1; SCAN_PREFETCH(cn); }
      const float gl = dir ? sGc[0] : sGc[63];
      bf16x8 wf[4];
      f32x4 ua[2];
      {
        bf16x8 vtf[2][2];
        f32x4 egm[2][2];
#pragma unroll
        for (int et = 0; et < 2; ++et)
#pragma unroll
          for (int ks = 0; ks < 2; ++ks) vtf[et][ks] = ldtr(sV + (ks * 32 + g * 8 + (l15 >> 2)) * 40 + et * 16 + (l15 & 3) * 4, 4 * 40);
#pragma unroll
        for (int ks = 0; ks < 2; ++ks) { egm[ks][0] = *(const f32x4*)(sE + ks * 32 + g * 8); egm[ks][1] = *(const f32x4*)(sE + ks * 32 + g * 8 + 4); }
        __builtin_amdgcn_sched_barrier(0);
#pragma unroll
        for (int et = 0; et < 2; ++et) {
          ua[et][0] = 0.f; ua[et][1] = 0.f; ua[et][2] = 0.f; ua[et][3] = 0.f;
#pragma unroll
          for (int ks = 0; ks < 2; ++ks) ua[et] = mma(tf[ks], vtf[et][ks], ua[et]);
        }
#pragma unroll
        for (int ks = 0; ks < 2; ++ks) {
          const u32x4 tw = __builtin_bit_cast(u32x4, tf[ks]);
          u32x4 o;
#pragma unroll
          for (int e = 0; e < 4; ++e) o[e] = pack2(bflo(tw[e]) * egm[ks][e >> 1][(2 * e) & 3], bfhi(tw[e]) * egm[ks][e >> 1][(2 * e + 1) & 3]);
          tf[ks] = __builtin_bit_cast(bf16x8, o);
        }
        __builtin_amdgcn_sched_barrier(0);
      }
#pragma unroll
      for (int kq = 0; kq < 4; ++kq) {
        bf16x8 ktf[2][2];
#pragma unroll
        for (int hh = 0; hh < 2; ++hh)
#pragma unroll
          for (int ks = 0; ks < 2; ++ks) ktf[hh][ks] = ldtr(sK + (ks * 32 + g * 8 + (l15 >> 2)) * 136 + (kq * 2 + hh) * 16 + (l15 & 3) * 4, 4 * 136);
        __builtin_amdgcn_sched_barrier(0);
        f32x4 wa[2];
#pragma unroll
        for (int hh = 0; hh < 2; ++hh) {
          wa[hh][0] = 0.f; wa[hh][1] = 0.f; wa[hh][2] = 0.f; wa[hh][3] = 0.f;
#pragma unroll
          for (int ks = 0; ks < 2; ++ks) wa[hh] = mma(ktf[hh][ks], tf[ks], wa[hh]);
        }
        wf[kq] = pack8(wa[0], wa[1]);
        __builtin_amdgcn_sched_barrier(0);
      }
#pragma unroll
      for (int ks = 0; ks < 2; ++ks) tf[ks] = ld8(Tbuf + ((size_t)((cgb + cnx) * 8 + h) * 2 + dir) * 4096 + (w * 16 + l15) * 64 + ks * 32 + g * 8);
      const int iq = w * 16 + l15;
      const float gi = sGc[iq];
      const f32x4 dvec = *(const f32x4*)(sD + w * 16 + g * 4);
      f32x4 vn[2];
      bf16x8 qkf[2];
      {
        bf16x8 stp[2][4];
#pragma unroll
        for (int et = 0; et < 2; ++et)
#pragma unroll
          for (int kq = 0; kq < 4; ++kq) { const u16* sp = sST + (et * 16 + l15) * 136 + kq * 32 + g * 4; stp[et][kq] = ld44(sp, sp + 16); }
        __builtin_amdgcn_sched_barrier(0);
#pragma unroll
        for (int et = 0; et < 2; ++et) {
          f32x4 a; a[0] = 0.f; a[1] = 0.f; a[2] = 0.f; a[3] = 0.f;
#pragma unroll
          for (int kq = 0; kq < 4; ++kq) a = mma(wf[kq], stp[et][kq], a);
          vn[et][0] = ua[et][0] - a[0]; vn[et][1] = ua[et][1] - a[1]; vn[et][2] = ua[et][2] - a[2]; vn[et][3] = ua[et][3] - a[3];
        }
        __builtin_amdgcn_sched_barrier(0);
      }
#pragma unroll
      for (int kk = 0; kk < 2; ++kk) {
        bf16x8 kf[2][4];
        f32x4 gcm[2];
#pragma unroll
        for (int hh = 0; hh < 2; ++hh)
#pragma unroll
          for (int ks = 0; ks < 4; ++ks) kf[hh][ks] = ld8(sK + ((kk * 2 + hh) * 16 + l15) * 136 + ks * 32 + g * 8);
#pragma unroll
        for (int hh = 0; hh < 2; ++hh) gcm[hh] = *(const f32x4*)(sGc + (kk * 2 + hh) * 16 + g * 4);
        __builtin_amdgcn_sched_barrier(0);
        f32x4 ka[2];
#pragma unroll
        for (int hh = 0; hh < 2; ++hh) {
          const int mt = kk * 2 + hh;
          ka[hh][0] = 0.f; ka[hh][1] = 0.f; ka[hh][2] = 0.f; ka[hh][3] = 0.f;
#pragma unroll
          for (int ks = 0; ks < 4; ++ks) ka[hh] = mma(kf[hh][ks], qf[ks], ka[hh]);
#pragma unroll
          for (int r = 0; r < 4; ++r) {
            const int m = mt * 16 + g * 4 + r;
            const bool valid = dir ? (iq <= m) : (iq >= m);
            ka[hh][r] = ka[hh][r] * __expf(valid ? gi - gcm[hh][r] : -1e30f);
          }
        }
        qkf[kk] = pack8(ka[0], ka[1]);
        __builtin_amdgcn_sched_barrier(0);
      }
#pragma unroll
      for (int et = 0; et < 2; ++et) {
        const int i0 = w * 16 + g * 4;
        st4bf(sVN + (et * 16 + l15) * 72 + i0, vn[et][0], vn[et][1], vn[et][2], vn[et][3]);
        st4bf(sVD + (et * 16 + l15) * 72 + i0, vn[et][0] * dvec[0], vn[et][1] * dvec[1], vn[et][2] * dvec[2], vn[et][3] * dvec[3]);
      }
      __syncthreads();
      {
        bf16x8 stn[2][4], vnp[2][2];
#pragma unroll
        for (int et = 0; et < 2; ++et)
#pragma unroll
          for (int ks = 0; ks < 4; ++ks) stn[et][ks] = ld8(sST + (et * 16 + l15) * 136 + ks * 32 + g * 8);
#pragma unroll
        for (int et = 0; et < 2; ++et)
#pragma unroll
          for (int kk = 0; kk < 2; ++kk) { const u16* sp = sVN + (et * 16 + l15) * 72 + kk * 32 + g * 4; vnp[et][kk] = ld44(sp, sp + 16); }
        const f32x4 egi = *(const f32x4*)(sE + w * 16 + g * 4);
        __builtin_amdgcn_sched_barrier(0);
#pragma unroll
        for (int et = 0; et < 2; ++et) {
          f32x4 a1; a1[0] = 0.f; a1[1] = 0.f; a1[2] = 0.f; a1[3] = 0.f;
#pragma unroll
          for (int ks = 0; ks < 4; ++ks) a1 = mma(qf[ks], stn[et][ks], a1);
          f32x4 a2; a2[0] = 0.f; a2[1] = 0.f; a2[2] = 0.f; a2[3] = 0.f;
#pragma unroll
          for (int kk = 0; kk < 2; ++kk) a2 = mma(qkf[kk], vnp[et][kk], a2);
#pragma unroll
          for (int r = 0; r < 4; ++r) {
            const int i = w * 16 + g * 4 + r;
            const float o = a1[r] * egi[r] + a2[r];
            obase[(size_t)(t0 + i) * 4096 + dir * 1024 + h * 128 + dvq * 32 + et * 16 + l15] = f2bf(o);
          }
        }
#pragma unroll
        for (int ks = 0; ks < 4; ++ks) qf[ks] = ld8(qn + (size_t)((cgb + cnx) * 64 + w * 16 + l15) * 1024 + h * 128 + ks * 32 + g * 8);
        __builtin_amdgcn_sched_barrier(0);
      }
      {
        bf16x8 ktf2[2][2], vdf[2][2];
#pragma unroll
        for (int dt = 0; dt < 2; ++dt)
#pragma unroll
          for (int kk = 0; kk < 2; ++kk) { ktf2[dt][kk] = ldtr(sK + (kk * 32 + g * 8 + (l15 >> 2)) * 136 + w * 32 + dt * 16 + (l15 & 3) * 4, 4 * 136); vdf[dt][kk] = ld8(sVD + (dt * 16 + l15) * 72 + kk * 32 + g * 8); }
        __builtin_amdgcn_sched_barrier(0);
        const float eg = __expf(gl);
#pragma unroll
        for (int dt = 0; dt < 2; ++dt)
#pragma unroll
          for (int et = 0; et < 2; ++et) {
            f32x4 a; a[0] = S[dt][et][0] * eg; a[1] = S[dt][et][1] * eg; a[2] = S[dt][et][2] * eg; a[3] = S[dt][et][3] * eg;
#pragma unroll
            for (int kk = 0; kk < 2; ++kk) a = mma(ktf2[dt][kk], vdf[et][kk], a);
            S[dt][et] = a;
          }
      }
      __syncthreads();
#pragma unroll
      for (int dt = 0; dt < 2; ++dt)
#pragma unroll
        for (int et = 0; et < 2; ++et) st4bf(sST + (et * 16 + l15) * 136 + w * 32 + dt * 16 + g * 4, S[dt][et][0], S[dt][et][1], S[dt][et][2], S[dt][et][3]);
    }
    if (seq < 16) {
      float* so = GOUT + (dir ? O_SB : O_SF) + (((size_t)seq * 2 + j) * 8 + h) * 16384;
#pragma unroll
      for (int dt = 0; dt < 2; ++dt)
#pragma unroll
        for (int et = 0; et < 2; ++et)
#pragma unroll
          for (int r = 0; r < 4; ++r) so[(size_t)(w * 32 + dt * 16 + g * 4 + r) * 128 + dvq * 32 + et * 16 + l15] = S[dt][et][r];
    }
  }
}

#define XB_TMO      128
#define XB_XCNT(j)  (256  + 64 * (j))
#define XB_XSUB(j)  (1280 + 64 * (j))
#define XB_XGEN(j)  (2304 + 64 * (j))
#define XB_TOP      3328
#define XB_TOPGEN   3392
#define XCD_BAR_WORDS 3456
#define XB_SPIN_CAP (1u << 20)
#define LAS __attribute__((address_space(3)))
DI unsigned xb_ld(unsigned* p)              { return __hip_atomic_load(p, __ATOMIC_RELAXED, __HIP_MEMORY_SCOPE_AGENT); }
DI unsigned xb_add(unsigned* p, unsigned v) { return __hip_atomic_fetch_add(p, v, __ATOMIC_RELAXED, __HIP_MEMORY_SCOPE_AGENT); }
DI unsigned xb_xcc_id() { return (unsigned)__builtin_amdgcn_s_getreg((3 << 11) | 20) & 0xFu; }
#define XB_SPIN(cond, bar) do { unsigned _sp = 0; while (cond) { __builtin_amdgcn_s_sleep(1); \
    if ((++_sp & 255u) == 0u) { if (xb_ld(&(bar)[XB_TMO])) break; if (_sp > XB_SPIN_CAP) { atomicAdd(&(bar)[XB_TMO], 1u); break; } } } } while (0)
struct XcdBarrier { unsigned* bar; unsigned x; volatile LAS unsigned* st; };
DI XcdBarrier xcd_barrier_post(unsigned* bar, volatile LAS unsigned* st) {
  XcdBarrier b; b.bar = bar; b.x = xb_xcc_id(); b.st = st;
  if (threadIdx.x == 0) (void)xb_add(&bar[XB_XCNT(b.x)], 1u);
  return b;
}
DI void xcd_barrier_complete(unsigned* bar, unsigned x, unsigned& nloc, unsigned& nx) {
  const unsigned Gn = gridDim.x * gridDim.y * gridDim.z;
  unsigned sum, cnt, mine, sp = 0u;
  for (;;) {
    sum = 0u; cnt = 0u; mine = 0u;
#pragma unroll
    for (unsigned j = 0; j < 16; ++j) { const unsigned c = xb_ld(&bar[XB_XCNT(j)]); sum += c; cnt += (c > 0u) ? 1u : 0u; mine = (j == x) ? c : mine; }
    if (sum == Gn) break;
    __builtin_amdgcn_s_sleep(1);
    if ((++sp & 255u) == 0u) { if (xb_ld(&bar[XB_TMO])) break; if (sp > XB_SPIN_CAP) { atomicAdd(&bar[XB_TMO], 1u); break; } }
  }
  nloc = mine > 0u ? mine : 1u; nx = cnt > 0u ? cnt : 1u;
}
DI void xcd_barrier(const XcdBarrier& b) {
  asm volatile("s_waitcnt vmcnt(0)" ::: "memory");
  __syncthreads();
  if (threadIdx.x == 0) {
    unsigned* bar = b.bar;
    __builtin_amdgcn_s_waitcnt(0);
    unsigned nloc = b.st[0], nx = b.st[1];
    if (nloc == 0u) { xcd_barrier_complete(bar, b.x, nloc, nx); b.st[0] = nloc; b.st[1] = nx; }
    const unsigned old = xb_add(&bar[XB_XSUB(b.x)], 1u);
    const unsigned gen = old / nloc;
    if (old + 1u == (gen + 1u) * nloc) {
      __builtin_amdgcn_fence(__ATOMIC_RELEASE, "agent");
      asm volatile("s_waitcnt vmcnt(0)" ::: "memory");
      const unsigned og = xb_add(&bar[XB_TOP], 1u);
      const unsigned tg = og / nx;
      if (og + 1u == (tg + 1u) * nx) xb_add(&bar[XB_TOPGEN], 1u);
      else XB_SPIN(xb_ld(&bar[XB_TOPGEN]) == tg, bar);
      __builtin_amdgcn_fence(__ATOMIC_ACQUIRE, "agent");
      xb_add(&bar[XB_XGEN(b.x)], 1u);
      asm volatile("s_waitcnt vmcnt(0)" ::: "memory");
    } else {
      XB_SPIN(xb_ld(&bar[XB_XGEN(b.x)]) == gen, bar);
      __builtin_amdgcn_fence(__ATOMIC_ACQUIRE, "agent");
      asm volatile("s_waitcnt vmcnt(0)" ::: "memory");
    }
  }
  __syncthreads();
}

__global__ void __launch_bounds__(256, 2) fwd_megakernel(P p) {
  cg::grid_group grid = cg::this_grid();
  __shared__ __attribute__((aligned(16))) char smem[60416];
  const int tid = opaque_tid(), lane = tid & 63, wid = tid >> 6;
  const int G = gridDim.x;
  __shared__ uint4 xb_words;
  if (threadIdx.x == 0) xb_words = make_uint4(0u, 0u, 0u, 0u);
  __syncthreads();
  (void)xcd_barrier_post((unsigned*)(as_global(p.ws) + WS_BAR), (volatile LAS unsigned*)&xb_words);
#define GSYNC() do { XcdBarrier xb_; xb_.bar = (unsigned*)(opaque_ptr(as_global(p.ws)) + WS_BAR); xb_.x = xb_xcc_id(); xb_.st = (volatile LAS unsigned*)&xb_words; xcd_barrier(xb_); } while (0)
  const int bid0 = opaque_bid();
  {
  char* const ws0 = opaque_ptr(as_global(p.ws));
  float* mods = (float*)(ws0 + WS_MODS);
  float* ropeT = (float*)(ws0 + WS_ROPE);
  float* cosG = ropeT, *sinG = ropeT + 2048, *cosM = ropeT + 4096, *sinM = ropeT + 5120;

  {
    float* sc = (float*)smem;
    float* red = sc + 9 * 128;
    float* part = (float*)(ws0 + WS_R);
    for (int item = bid0; item < 3072; item += G) {
      const int ks = item & 7, cgp = (item >> 3) % 96, layer = item / 768;
      __syncthreads();
      for (int e = tid; e < 9 * 128; e += 256) {
        const int ci = e >> 7, k = ks * 128 + (e & 127);
        const float v = ci == 0 ? GIN(9)[k] : GIN(8)[(ci - 1) * 1024 + k];
        sc[e] = v / (1.f + expf(-v));
      }
      __syncthreads();
      const int col = tid & 63, kg = tid >> 6;
      const float* wp = GIN(12) + ((size_t)layer * 1024 + ks * 128 + kg * 32) * 6144 + cgp * 64 + col;
      float acc[9];
#pragma unroll
      for (int ci = 0; ci < 9; ++ci) acc[ci] = 0.f;
#pragma unroll 8
      for (int kk = 0; kk < 32; ++kk) {
        const float wv = wp[(size_t)kk * 6144];
#pragma unroll
        for (int ci = 0; ci < 9; ++ci) acc[ci] += sc[ci * 128 + kg * 32 + kk] * wv;
      }
#pragma unroll
      for (int ci = 0; ci < 9; ++ci) red[(kg * 64 + col) * 9 + ci] = acc[ci];
      __syncthreads();
      if (kg == 0) {
        const int n = cgp * 64 + col;
        const float bias = ks == 0 ? GIN(13)[(size_t)layer * 6144 + n] : 0.f;
#pragma unroll
        for (int ci = 0; ci < 9; ++ci) {
          const float s = red[col * 9 + ci] + red[(64 + col) * 9 + ci] + red[(128 + col) * 9 + ci] + red[(192 + col) * 9 + ci] + bias;
          part[(size_t)ks * 221184 + ((size_t)layer * 9 + ci) * 6144 + n] = s;
        }
      }
    }
    if (bid0 == G - 1) {
      for (int e = tid; e < 2048; e += 256) { const int pos = e >> 5, f = e & 31; const float fr = powf(10000.f, -(float)f / 32.f); const float a = (float)pos * fr; cosG[e] = cosf(a); sinG[e] = sinf(a); }
      for (int e = tid; e < 1024; e += 256) { const int pos = e >> 4, f = e & 15; const float fr = powf(10000.f, -(float)f / 16.f); const float a = (float)pos * fr; cosM[e] = cosf(a); sinM[e] = sinf(a); }
    }
  }
  if (gridDim.x == 0x7fffffffu) grid.sync();
  GSYNC();
  {
    const float* part = (const float*)(ws0 + WS_R);
    for (int e = bid0 * 256 + tid; e < 221184; e += G * 256) {
      float sacc = 0.f;
#pragma unroll
      for (int ks = 0; ks < 8; ++ks) sacc += part[(size_t)ks * 221184 + e];
      mods[e] = sacc;
    }
  }
  }
  GSYNC();

#pragma unroll 1
  for (int layer = 0; layer < 4; ++layer) {
    const int kind = layer % 3, j = layer / 3;
    const int bid = opaque_bid();
    char* const ws = opaque_ptr(as_global(p.ws));
    float* mods = (float*)(ws + WS_MODS);
    float* ropeT = (float*)(ws + WS_ROPE);
    float* cosG = ropeT, *sinG = ropeT + 2048, *cosM = ropeT + 4096, *sinM = ropeT + 5120;
    u16* hbuf = (u16*)(ws + WS_HBUF);
    u16* obuf = (u16*)(ws + WS_OBUF);
    u16* wmix = (u16*)(ws + WS_WMIX);
    u16* wmlp = (u16*)(ws + WS_WMLP);
    char* R = ws + WS_R;
    const float* lmods = mods + (size_t)layer * 9 * 6144;
    {
      for (int it = bid; it < 5120; it += G) norm_rows(p, layer, layer == 0, it, GIN(10) + layer * 1024, 0, 1);
      float* sT = (float*)smem;
      for (int it = bid; it < 2048; it += G) {
        if (it < 1024) convert_tile(GIN(14) + (size_t)layer * 1024 * 4096, 1024, 4096, wmlp, it, 0, sT);
        else convert_tile(GIN(15) + (size_t)layer * 4096 * 1024, 4096, 1024, wmlp + 4194304, it - 1024, 0, sT);
      }
      if (kind == 0) {
        for (int it = bid; it < 1056 + 256; it += G) {
          if (it < 1056) convert_tile(GIN(16) + (size_t)j * 1024 * 4128, 1024, 4128, wmix + WM_IN, it, 0, sT);
          else convert_tile(GIN(21) + (size_t)j * 1024 * 1024, 1024, 1024, wmix + WM_OUT, it - 1056, 0, sT);
        }
      } else if (kind == 1) {
        for (int it = bid; it < 192 + 144 + 128 + 256; it += G) {
          if (it < 192) convert_tile(GIN(22), 1024, 704, wmix + WM_IN, it, 0, sT);
          else if (it < 336) convert_tile(GIN(25), 384, 1536, wmix + WM_UQ, it - 192, 1, sT);
          else if (it < 464) convert_tile(GIN(26), 256, 2048, wmix + WM_UKV, it - 336, 0, sT);
          else convert_tile(GIN(31), 1024, 1024, wmix + WM_OUT, it - 464, 0, sT);
        }
      } else {
        for (int it = bid; it < 384 + 256; it += G) {
          if (it < 384) convert_tile(GIN(32), 1024, 1536, wmix + WM_IN, it, 0, sT);
          else convert_tile(GIN(35), 1024, 1024, wmix + WM_OUT, it - 384, 0, sT);
        }
        u16* Kg = (u16*)(R + R_KG); u16* Vg = (u16*)(R + R_VTG);
        const int tid = opaque_tid();
        for (int it = bid; it < 512; it += G) {
          const int b = it >> 6, s0 = (it & 63) * 8;
          const int ch = tid;
          float kv[8], vv[8];
#pragma unroll
          for (int e = 0; e < 8; ++e) { kv[e] = GIN(6)[((size_t)b * 512 + s0 + e) * 256 + ch]; vv[e] = GIN(7)[((size_t)b * 512 + s0 + e) * 256 + ch]; }
#pragma unroll
          for (int e = 0; e < 8; ++e) Kg[(size_t)(NPROMPT + b * 2560 + s0 + e) * 256 + ch] = f2bf(kv[e]);
          u32x4 o; o[0] = pack2(vv[0], vv[1]); o[1] = pack2(vv[2], vv[3]); o[2] = pack2(vv[4], vv[5]); o[3] = pack2(vv[6], vv[7]);
          *(u32x4*)(Vg + (size_t)(NPROMPT + b * 2560) * 256 + (size_t)ch * 2560 + s0) = o;
        }
      }
    }
    GSYNC();

    if (kind == 0) {
      {
        EpiGdnIn epi; epi.proj = (u16*)(R + R_PROJ); epi.gbuf = (float*)(R + R_GBUF);
        for (int it = bid; it < 160 * 16; it += G) { const int mt = it >> 4, nt = it & 15; gemm_tile_wide(hbuf, 1024, wmix + WM_IN, 1024, 1024, mt * 128, nt * 256, (u16*)smem, epi); }
        for (int it = bid; it < 160; it += G) gemm_tile<4>(hbuf, 1024, wmix + WM_IN, 1024, 1024, it * 128, 4096, (u16*)smem, epi);
      }
      GSYNC();
      gdn_chunk_phase(p, j, smem);
      GSYNC();
      gdn_scan_phase(p, j, smem);
      GSYNC();
      {
        const u16* pr = (const u16*)(R + R_PROJ);
        const float* on = GIN(20) + j * 128;
        const int tid = opaque_tid();
        for (int t = bid; t < NTOK; t += G) {
          const int h = tid >> 5, c = (tid & 31) * 4;
          const u16* row = pr + (size_t)t * 4096;
          const u32x2 f = *(const u32x2*)(row + h * 128 + c), b = *(const u32x2*)(row + 1024 + h * 128 + c), z = *(const u32x2*)(row + 3072 + h * 128 + c);
          float o[4] = {bflo(f[0]) + bflo(b[0]), bfhi(f[0]) + bfhi(b[0]), bflo(f[1]) + bflo(b[1]), bfhi(f[1]) + bfhi(b[1])};
          float zz[4] = {bflo(z[0]), bfhi(z[0]), bflo(z[1]), bfhi(z[1])};
          float ss = o[0] * o[0] + o[1] * o[1] + o[2] * o[2] + o[3] * o[3];
          ss += __shfl_xor(ss, 1); ss += __shfl_xor(ss, 2); ss += __shfl_xor(ss, 4); ss += __shfl_xor(ss, 8); ss += __shfl_xor(ss, 16);
          const float rs = rsqrtf(ss * (1.f / 128.f) + EPS);
          const float4 gn = *(const float4*)(on + c);
          const float gg[4] = {gn.x, gn.y, gn.z, gn.w};
          float y[4];
#pragma unroll
          for (int e = 0; e < 4; ++e) y[e] = o[e] * rs * gg[e] * (zz[e] / (1.f + __expf(-zz[e])));
          st4bf(obuf + (size_t)t * 1024 + h * 128 + c, y[0], y[1], y[2], y[3]);
        }
      }
      GSYNC();
    } else if (kind == 1) {
      {
        EpiF32 epi; epi.dst = (float*)(R + R_DPROJ); epi.ld = 768;
        for (int it = bid; it < 160 * 6; it += G) { const int mt = it / 6, nt = it % 6; gemm_tile<4>(hbuf, 1024, wmix + WM_IN, 1024, 1024, mt * 128, nt * 128, (u16*)smem, epi); }
      }
      GSYNC();
      {
        const float* dproj = (const float*)(R + R_DPROJ);
        u16* cq = (u16*)(R + R_CQ); u16* ckv = (u16*)(R + R_CKV); u16* Km = (u16*)(R + R_KM);
        const int tid = opaque_tid(), lane = tid & 63, wid = tid >> 6;
        for (int it = bid; it < 6144; it += G) {
          const int row = it * 4 + wid;
          if (row < NTOK) {
            const int t = row;
            const float* pr = dproj + (size_t)t * 768;
            float v[6]; float ss = 0.f;
#pragma unroll
            for (int e = 0; e < 6; ++e) { v[e] = pr[lane + 64 * e]; ss += v[e] * v[e]; }
            ss = wave_sum(ss);
            float rs = rsqrtf(ss * (1.f / 384.f) + EPS);
#pragma unroll
            for (int e = 0; e < 6; ++e) cq[(size_t)t * 384 + lane + 64 * e] = f2bf(v[e] * rs * GIN(23)[lane + 64 * e]);
            const int kvrow = kvrow_of_tok(t);
            float wv[4]; ss = 0.f;
#pragma unroll
            for (int e = 0; e < 4; ++e) { wv[e] = pr[384 + lane + 64 * e]; ss += wv[e] * wv[e]; }
            ss = wave_sum(ss);
            rs = rsqrtf(ss * (1.f / 256.f) + EPS);
#pragma unroll
            for (int e = 0; e < 4; ++e) {
              const float o = wv[e] * rs * GIN(24)[lane + 64 * e];
              ckv[(size_t)kvrow * 256 + lane + 64 * e] = f2bf(o);
              if (t < NPROMPT) GOUT[O_CKV + (size_t)t * 256 + lane + 64 * e] = o;
            }
            const float x = pr[640 + lane];
            ss = wave_sum(x * x);
            float kr = x * rsqrtf(ss * (1.f / 64.f) + EPS) * GIN(30)[lane];
            if (t < NPROMPT) GOUT[O_KR + (size_t)t * 64 + lane] = kr;
            else {
              const int s = (t - NPROMPT) & 2047;
              const int pos = lane < 32 ? (s >> 6) : (s & 63);
              const float cs = cosM[pos * 16 + (lane & 15)], sn = sinM[pos * 16 + (lane & 15)];
              const float partner = __shfl_xor(kr, 16);
              kr = ((lane & 16) == 0) ? kr * cs - partner * sn : partner * sn + kr * cs;
            }
            const u16 kb = f2bf(kr);
#pragma unroll
            for (int hh = 0; hh < 8; ++hh) Km[(size_t)kvrow * 1536 + hh * 192 + 128 + lane] = kb;
          } else {
            const int r = row - NTOK; const int b = r >> 9, s = r & 511;
            const int kvrow = NPROMPT + b * 2560 + s;
#pragma unroll
            for (int e = 0; e < 4; ++e) ckv[(size_t)kvrow * 256 + lane + 64 * e] = f2bf(GIN(4)[((size_t)b * 512 + s) * 256 + lane + 64 * e]);
            const u16 kb = f2bf(GIN(5)[((size_t)b * 512 + s) * 64 + lane]);
#pragma unroll
            for (int hh = 0; hh < 8; ++hh) Km[(size_t)kvrow * 1536 + hh * 192 + 128 + lane] = kb;
          }
        }
      }
      GSYNC();
      {
        EpiMlaUq e1; e1.Q = (u16*)(R + R_Q); e1.gnope = GIN(27); e1.grope = GIN(28); e1.cosT = cosM; e1.sinT = sinM;
        for (int it = bid; it < 160 * 12; it += G) { const int mt = it / 12, nt = it % 12; gemm_tile<8>((const u16*)(R + R_CQ), 384, wmix + WM_UQ, 384, 384, mt * 128, nt * 128, (u16*)smem, e1); }
        EpiMlaUkv e2; e2.Kb = (u16*)(R + R_KM); e2.Vt = (u16*)(R + R_VTM); e2.gnope = GIN(29);
        for (int it = bid; it < 192 * 16; it += G) { const int mt = it / 16, nt = it % 16; gemm_tile<8>((const u16*)(R + R_CKV), 256, wmix + WM_UKV, 256, 256, mt * 128, nt * 128, (u16*)smem, e2); }
      }
      GSYNC();
      attn_phase<192, 8>((const u16*)(R + R_Q), (const u16*)(R + R_KM), (const u16*)(R + R_VTM), obuf, smem);
      GSYNC();
    } else {
      {
        EpiGqaIn epi; epi.Q = (u16*)(R + R_Q); epi.Kb = (u16*)(R + R_KG); epi.Vt = (u16*)(R + R_VTG); epi.qg = GIN(33); epi.kg = GIN(34); epi.cosT = cosG; epi.sinT = sinG; epi.out = GOUT;
        for (int it = bid; it < 160 * 12; it += G) { const int mt = it / 12, nt = it % 12; gemm_tile<8>(hbuf, 1024, wmix + WM_IN, 1024, 1024, mt * 128, nt * 128, (u16*)smem, epi); }
      }
      GSYNC();
      attn_phase<128, 2>((const u16*)(R + R_Q), (const u16*)(R + R_KG), (const u16*)(R + R_VTG), obuf, smem);
      GSYNC();
    }

    for (int it = bid; it < 768; it += G) {
      const bool wide = it < 512;
      int m0, n0;
      if (wide) { m0 = (it >> 2) * 128; n0 = (it & 3) * 256; } else { const int ix = it - 512; m0 = (128 + (ix >> 3)) * 128; n0 = (ix & 7) * 128; }
      EpiResid epi;
      epi.xin = (layer == 0) ? (m0 < NPROMPT ? GIN(0) : GIN(1) - (size_t)NPROMPT * 1024) : GOUT;
      epi.xout = GOUT; epi.gate = lmods + (size_t)cond_of(m0) * 6144 + 2 * 1024;
      if (wide) gemm_tile_wide(obuf, 1024, wmix + WM_OUT, 1024, 1024, m0, n0, (u16*)smem, epi);
      else gemm_tile<4>(obuf, 1024, wmix + WM_OUT, 1024, 1024, m0, n0, (u16*)smem, epi);
    }
    GSYNC();
    for (int it = bid; it < 5120; it += G) norm_rows(p, layer, false, it, GIN(11) + layer * 1024, 3, 4);
    GSYNC();
    {
      EpiMlpIn epi; epi.abuf = (u16*)(R + R_ABUF);
      for (int it = bid; it < 160 * 16; it += G) { const int mt = it >> 4, nt = it & 15; gemm_tile_wide(hbuf, 1024, wmlp, 1024, 1024, mt * 128, nt * 256, (u16*)smem, epi); }
    }
    GSYNC();
    for (int it = bid; it < 768; it += G) {
      const bool wide = it < 512;
      int m0, n0;
      if (wide) { m0 = (it >> 2) * 128; n0 = (it & 3) * 256; } else { const int ix = it - 512; m0 = (128 + (ix >> 3)) * 128; n0 = (ix & 7) * 128; }
      EpiResid epi; epi.xin = GOUT; epi.xout = GOUT; epi.gate = lmods + (size_t)cond_of(m0) * 6144 + 5 * 1024;
      if (wide) gemm_tile_wide((const u16*)(R + R_ABUF), 4096, wmlp + 4194304, 4096, 4096, m0, n0, (u16*)smem, epi);
      else gemm_tile<4>((const u16*)(R + R_ABUF), 4096, wmlp + 4194304, 4096, 4096, m0, n0, (u16*)smem, epi);
    }
    GSYNC();
  }
}

extern "C" void kernel_launch(void* const* d_in, const int* in_sizes, int n_in, void* d_out, int out_size, void* d_ws, size_t ws_size, hipStream_t stream) {
  static int grid_blocks = 0;
  if (!grid_blocks) {
    int dev = 0, cus = 0, per_cu = 0;
    hipGetDevice(&dev);
    hipDeviceGetAttribute(&cus, hipDeviceAttributeMultiprocessorCount, dev);
    hipOccupancyMaxActiveBlocksPerMultiprocessor(&per_cu, fwd_megakernel, 256, 0);
    if (per_cu < 1) per_cu = 1;
    if (per_cu > 2) per_cu = 2;
    grid_blocks = cus * per_cu;
  }
  P p{};
  for (int i = 0; i < 36; ++i) p.in[i] = (const float*)d_in[i];
  p.out = (float*)d_out;
  p.ws = (char*)d_ws;
  (void)hipMemsetAsync((char*)d_ws + WS_BAR, 0, XCD_BAR_WORDS * 4, stream);
  void* args[] = {&p};
  hipError_t e = hipLaunchCooperativeKernel((void*)fwd_megakernel, dim3(grid_blocks), dim3(256), args, 0, stream);
  if (e != hipSuccess) fprintf(stderr, "cooperative launch failed: %s (grid %d)\n", hipGetErrorString(e), grid_blocks);
}
```

```cpp
#include <hip/hip_runtime.h>
#include <hip/hip_cooperative_groups.h>
#include <cstdio>
namespace cg = cooperative_groups;

typedef unsigned short u16;
typedef __attribute__((ext_vector_type(8))) short bf16x8;
typedef __attribute__((ext_vector_type(4))) short bf16x4;
typedef __attribute__((ext_vector_type(4))) float f32x4;
typedef __attribute__((ext_vector_type(4))) unsigned u32x4;
typedef __attribute__((ext_vector_type(2))) unsigned u32x2;

#define DI __device__ __forceinline__

constexpr int NTOK = 20480;
constexpr int NPROMPT = 4096;
constexpr float EPS = 1e-6f;

constexpr size_t WS_MODS = 0;
constexpr size_t MODS_BYTES = 4ull * 9 * 6144 * 4;
constexpr size_t WS_BAR = 917504;
constexpr size_t WS_ROPE = 1048576;
constexpr size_t WS_WMIX = 1114112;
constexpr size_t WS_WMLP = 14090240;
constexpr size_t WS_HBUF = 30867456;
constexpr size_t WS_OBUF = 72810496;
constexpr size_t WS_R    = 114753536;
constexpr size_t R_ABUF = 0;
constexpr size_t R_PROJ = 0;
constexpr size_t R_VBUF = 167772160;
constexpr size_t R_TBUF = 209715200;
constexpr size_t R_GBUF = 251658240;
constexpr size_t R_GCB  = 254279680;
constexpr size_t R_BETA = 255590400;
constexpr size_t R_EG   = 256901120;
constexpr size_t R_ED   = 258211840;
constexpr size_t R_DPROJ = 0;
constexpr size_t R_Q    = 0;
constexpr size_t R_CQ   = 62914560;
constexpr size_t R_CKV  = 78643200;
constexpr size_t R_KM   = 91226112;
constexpr size_t R_VTM  = 166723584;
constexpr size_t R_KG   = 41943040;
constexpr size_t R_VTG  = 54525952;
constexpr size_t WM_IN = 0;
constexpr size_t WM_OUT = 4325376;
constexpr size_t WM_UQ = 5373952;
constexpr size_t WM_UKV = 5963776;
constexpr size_t O_SF = 20971520, O_SB = 25165824, O_CKV = 29360128, O_KR = 30408704, O_GK = 30670848, O_GV = 31719424;

struct P {
  const float* in[36];
  float* out;
  char* ws;
};

typedef __attribute__((ext_vector_type(2))) float f32x2_t;
typedef __attribute__((ext_vector_type(2))) __bf16 bf16x2_t;
DI u16 f2bf(float x) { return __builtin_bit_cast(u16, (__bf16)x); }
DI float bf2f(u16 h) { return __uint_as_float(((unsigned)h) << 16); }
DI unsigned pack2(float a, float b) { f32x2_t v; v[0] = a; v[1] = b; return __builtin_bit_cast(unsigned, __builtin_convertvector(v, bf16x2_t)); }
DI float bflo(unsigned w) { return __uint_as_float(w << 16); }
DI float bfhi(unsigned w) { return __uint_as_float(w & 0xffff0000u); }
DI f32x4 mma(bf16x8 a, bf16x8 b, f32x4 c) { return __builtin_amdgcn_mfma_f32_16x16x32_bf16(a, b, c, 0, 0, 0); }
DI bf16x8 pack8(f32x4 a, f32x4 b) {
  u32x4 p; p[0] = pack2(a[0], a[1]); p[1] = pack2(a[2], a[3]); p[2] = pack2(b[0], b[1]); p[3] = pack2(b[2], b[3]);
  return __builtin_bit_cast(bf16x8, p);
}
DI bf16x8 ld8(const u16* p) { return *(const bf16x8*)p; }
DI bf16x8 ld44(const u16* p0, const u16* p1) {
  u32x2 a = *(const u32x2*)p0; u32x2 b = *(const u32x2*)p1;
  u32x4 r; r[0] = a[0]; r[1] = a[1]; r[2] = b[0]; r[3] = b[1];
  return __builtin_bit_cast(bf16x8, r);
}
typedef __attribute__((ext_vector_type(4))) short s16x4_t;
DI bf16x8 ldtr(const u16* p, int row4_off) {
  typedef __attribute__((address_space(3))) s16x4_t lds4_t;
  const s16x4_t lo = __builtin_amdgcn_ds_read_tr16_b64_v4i16((lds4_t*)p);
  const s16x4_t hi = __builtin_amdgcn_ds_read_tr16_b64_v4i16((lds4_t*)(p + row4_off));
  return __builtin_shufflevector(lo, hi, 0, 1, 2, 3, 4, 5, 6, 7);
}
DI void st4bf(u16* p, float a, float b, float c, float d) { u32x2 v; v[0] = pack2(a, b); v[1] = pack2(c, d); *(u32x2*)p = v; }
DI float wave_sum(float v) {
  v += __shfl_xor(v, 1); v += __shfl_xor(v, 2); v += __shfl_xor(v, 4); v += __shfl_xor(v, 8); v += __shfl_xor(v, 16); v += __shfl_xor(v, 32);
  return v;
}
DI float sum_g(float v) { v += __shfl_xor(v, 16); v += __shfl_xor(v, 32); return v; }
DI int opaque_tid() { int t = threadIdx.x; asm volatile("" : "+v"(t)); return t; }
DI int opaque_bid() { int t = __builtin_amdgcn_readfirstlane((int)blockIdx.x); asm volatile("" : "+s"(t)); return t; }
DI char* opaque_ptr(char* q) {
  unsigned lo = __builtin_amdgcn_readfirstlane((unsigned)(size_t)q), hi = __builtin_amdgcn_readfirstlane((unsigned)((size_t)q >> 32));
  asm volatile("" : "+s"(lo), "+s"(hi));
  typedef __attribute__((address_space(1))) char gchar_t;
  return (char*)(gchar_t*)(((size_t)hi << 32) | (size_t)lo);
}
template <class T> DI T* as_global(T* q) { typedef __attribute__((address_space(1))) T gT; return (T*)(gT*)q; }
#define GIN(i) as_global(p.in[i])
#define GOUT as_global(p.out)
DI int cond_of(int t) { return t < NPROMPT ? 0 : 1 + ((t - NPROMPT) >> 11); }
DI int kvrow_of_tok(int t) { return t < NPROMPT ? t : NPROMPT + ((t - NPROMPT) >> 11) * 2560 + 512 + ((t - NPROMPT) & 2047); }

template <int NI, class Epi>
DI void gemm_tile(const u16* __restrict__ A, int lda, const u16* __restrict__ Bt, int ldb, int K, int m0, int n0, u16* smem, Epi& epi) {
  constexpr int MI = 16 / NI;
  constexpr int WN = 8 / NI;
  const int tid = opaque_tid(), lane = tid & 63, wid = tid >> 6, l15 = lane & 15, g = lane >> 4;
  const int wm = wid / WN, wn = wid % WN;
  u16* sA = smem; u16* sB = smem + 128 * 64;
  f32x4 acc[MI][NI];
#pragma unroll
  for (int mi = 0; mi < MI; ++mi)
#pragma unroll
    for (int ni = 0; ni < NI; ++ni) { acc[mi][ni][0] = 0.f; acc[mi][ni][1] = 0.f; acc[mi][ni][2] = 0.f; acc[mi][ni][3] = 0.f; }
  const int lrow = tid >> 3, lkc = (tid & 7) * 8;
  const int wofs = lrow * 64 + (((tid & 7) ^ ((lrow >> 1) & 7)) * 8);
  const int rsw = (l15 >> 1) & 7;
  const int rofs0 = l15 * 64 + ((g ^ rsw) * 8), rofs1 = l15 * 64 + (((4 + g) ^ rsw) * 8);
  const u16* pa = A + (size_t)(m0 + lrow) * lda + lkc;
  const u16* pb = Bt + (size_t)(n0 + lrow) * ldb + lkc;
  u32x4 ra[2][4], rb[2][4];
  const int nk = K >> 6;
#pragma unroll
  for (int i = 0; i < 4; ++i) { ra[0][i] = *(const u32x4*)(pa + (size_t)i * 32 * lda); rb[0][i] = *(const u32x4*)(pb + (size_t)i * 32 * ldb); }
#pragma unroll
  for (int i = 0; i < 4; ++i) { ra[1][i] = *(const u32x4*)(pa + (size_t)i * 32 * lda + 64); rb[1][i] = *(const u32x4*)(pb + (size_t)i * 32 * ldb + 64); }
  for (int kt = 0; kt < nk; kt += 2) {
#pragma unroll
    for (int half = 0; half < 2; ++half) {
      __syncthreads();
#pragma unroll
      for (int i = 0; i < 4; ++i) { *(u32x4*)(sA + wofs + i * 32 * 64) = ra[half][i]; *(u32x4*)(sB + wofs + i * 32 * 64) = rb[half][i]; }
      __syncthreads();
      if (kt + half + 2 < nk) {
        const int ko = (kt + half + 2) * 64;
#pragma unroll
        for (int i = 0; i < 4; ++i) { ra[half][i] = *(const u32x4*)(pa + (size_t)i * 32 * lda + ko); rb[half][i] = *(const u32x4*)(pb + (size_t)i * 32 * ldb + ko); }
      }
#pragma unroll
      for (int ks = 0; ks < 2; ++ks) {
        const int ro = ks ? rofs1 : rofs0;
        bf16x8 af[MI], bfv[NI];
#pragma unroll
        for (int mi = 0; mi < MI; ++mi) af[mi] = ld8(sA + (wm * MI * 16 + mi * 16) * 64 + ro);
#pragma unroll
        for (int ni = 0; ni < NI; ++ni) bfv[ni] = ld8(sB + (wn * NI * 16 + ni * 16) * 64 + ro);
        __builtin_amdgcn_s_setprio(1);
#pragma unroll
        for (int mi = 0; mi < MI; ++mi)
#pragma unroll
          for (int ni = 0; ni < NI; ++ni) acc[mi][ni] = mma(bfv[ni], af[mi], acc[mi][ni]);
        __builtin_amdgcn_s_setprio(0);
      }
    }
  }
  epi.template run<MI, NI>(acc, m0 + wm * MI * 16, n0 + wn * NI * 16, l15, g);
}

template <class Epi>
DI void gemm_tile_wide(const u16* __restrict__ A, int lda, const u16* __restrict__ Bt, int ldb, int K, int m0, int n0, u16* smem, Epi& epi) {
  constexpr int MI = 4, NI = 8;
  const int tid = opaque_tid(), lane = tid & 63, wid = tid >> 6, l15 = lane & 15, g = lane >> 4;
  const int wm = wid >> 1, wn = wid & 1;
  u16* sA = smem; u16* sB = smem + 128 * 64;
  f32x4 acc[MI][NI];
#pragma unroll
  for (int mi = 0; mi < MI; ++mi)
#pragma unroll
    for (int ni = 0; ni < NI; ++ni) { acc[mi][ni][0] = 0.f; acc[mi][ni][1] = 0.f; acc[mi][ni][2] = 0.f; acc[mi][ni][3] = 0.f; }
  const int lrow = tid >> 3, lkc = (tid & 7) * 8;
  const int wofs = lrow * 64 + (((tid & 7) ^ ((lrow >> 1) & 7)) * 8);
  const int rsw = (l15 >> 1) & 7;
  const int rofs0 = l15 * 64 + ((g ^ rsw) * 8), rofs1 = l15 * 64 + (((4 + g) ^ rsw) * 8);
  const u16* pa = A + (size_t)(m0 + lrow) * lda + lkc;
  const u16* pb = Bt + (size_t)(n0 + lrow) * ldb + lkc;
  u32x4 ra[4], rb[8];
  const int nk = K >> 6;
#pragma unroll
  for (int i = 0; i < 4; ++i) ra[i] = *(const u32x4*)(pa + (size_t)i * 32 * lda);
#pragma unroll
  for (int i = 0; i < 8; ++i) rb[i] = *(const u32x4*)(pb + (size_t)i * 32 * ldb);
  for (int kt = 0; kt < nk; ++kt) {
    __syncthreads();
#pragma unroll
    for (int i = 0; i < 4; ++i) *(u32x4*)(sA + wofs + i * 32 * 64) = ra[i];
#pragma unroll
    for (int i = 0; i < 8; ++i) *(u32x4*)(sB + wofs + i * 32 * 64) = rb[i];
    __syncthreads();
    if (kt + 1 < nk) {
      const int ko = (kt + 1) * 64;
#pragma unroll
      for (int i = 0; i < 4; ++i) ra[i] = *(const u32x4*)(pa + (size_t)i * 32 * lda + ko);
#pragma unroll
      for (int i = 0; i < 8; ++i) rb[i] = *(const u32x4*)(pb + (size_t)i * 32 * ldb + ko);
    }
#pragma unroll
    for (int ks = 0; ks < 2; ++ks) {
      const int ro = ks ? rofs1 : rofs0;
      bf16x8 af[MI];
#pragma unroll
      for (int mi = 0; mi < MI; ++mi) af[mi] = ld8(sA + (wm * 64 + mi * 16) * 64 + ro);
#pragma unroll
      for (int nh = 0; nh < 2; ++nh) {
        bf16x8 bfv[4];
#pragma unroll
        for (int ni = 0; ni < 4; ++ni) bfv[ni] = ld8(sB + (wn * 128 + (nh * 4 + ni) * 16) * 64 + ro);
        __builtin_amdgcn_s_setprio(1);
#pragma unroll
        for (int mi = 0; mi < MI; ++mi)
#pragma unroll
          for (int ni = 0; ni < 4; ++ni) acc[mi][nh * 4 + ni] = mma(bfv[ni], af[mi], acc[mi][nh * 4 + ni]);
        __builtin_amdgcn_s_setprio(0);
        __builtin_amdgcn_sched_barrier(0);
      }
    }
  }
  epi.template run<MI, NI>(acc, m0 + wm * 64, n0 + wn * 128, l15, g);
}

struct EpiResid {
  const float* xin; float* xout; const float* gate;
  template <int MI, int NI> DI void run(f32x4 (&acc)[MI][NI], int mr, int nc, int l15, int g) {
#pragma unroll
    for (int mi = 0; mi < MI; ++mi)
#pragma unroll
      for (int ni = 0; ni < NI; ++ni) {
        const int m = mr + mi * 16 + l15, n = nc + ni * 16 + g * 4;
        const float4 xi = *(const float4*)(xin + (size_t)m * 1024 + n);
        const float4 gt = *(const float4*)(gate + n);
        float4 o; o.x = xi.x + gt.x * acc[mi][ni][0]; o.y = xi.y + gt.y * acc[mi][ni][1]; o.z = xi.z + gt.z * acc[mi][ni][2]; o.w = xi.w + gt.w * acc[mi][ni][3];
        *(float4*)(xout + (size_t)m * 1024 + n) = o;
      }
  }
};
struct EpiGdnIn {
  u16* proj; float* gbuf;
  template <int MI, int NI> DI void run(f32x4 (&acc)[MI][NI], int mr, int nc, int l15, int g) {
#pragma unroll
    for (int mi = 0; mi < MI; ++mi)
#pragma unroll
      for (int ni = 0; ni < NI; ++ni) {
        const int m = mr + mi * 16 + l15, n = nc + ni * 16 + g * 4;
        if (n < 4096) st4bf(proj + (size_t)m * 4096 + n, acc[mi][ni][0], acc[mi][ni][1], acc[mi][ni][2], acc[mi][ni][3]);
        else if (n < 4128) { float4 o; o.x = acc[mi][ni][0]; o.y = acc[mi][ni][1]; o.z = acc[mi][ni][2]; o.w = acc[mi][ni][3]; *(float4*)(gbuf + (size_t)m * 32 + (n - 4096)) = o; }
      }
  }
};
struct EpiMlpIn {
  u16* abuf;
  template <int MI, int NI> DI void run(f32x4 (&acc)[MI][NI], int mr, int nc, int l15, int g) {
#pragma unroll
    for (int mi = 0; mi < MI; ++mi)
#pragma unroll
      for (int ni = 0; ni < NI; ++ni) {
        const int m = mr + mi * 16 + l15, n = nc + ni * 16 + g * 4;
        float a = fmaxf(acc[mi][ni][0], 0.f), b = fmaxf(acc[mi][ni][1], 0.f), c = fmaxf(acc[mi][ni][2], 0.f), d = fmaxf(acc[mi][ni][3], 0.f);
        st4bf(abuf + (size_t)m * 4096 + n, a * a, b * b, c * c, d * d);
      }
  }
};
struct EpiF32 {
  float* dst; int ld;
  template <int MI, int NI> DI void run(f32x4 (&acc)[MI][NI], int mr, int nc, int l15, int g) {
#pragma unroll
    for (int mi = 0; mi < MI; ++mi)
#pragma unroll
      for (int ni = 0; ni < NI; ++ni) {
        const int m = mr + mi * 16 + l15, n = nc + ni * 16 + g * 4;
        float4 o; o.x = acc[mi][ni][0]; o.y = acc[mi][ni][1]; o.z = acc[mi][ni][2]; o.w = acc[mi][ni][3];
        *(float4*)(dst + (size_t)m * ld + n) = o;
      }
  }
};

DI void rope128(f32x4 (&v)[8], int rowp, int colp, int g, const float* cosT, const float* sinT) {
#pragma unroll
  for (int hf = 0; hf < 2; ++hf) {
    const int pos = hf ? colp : rowp;
#pragma unroll
    for (int a = 0; a < 2; ++a) {
      const int n1 = hf * 4 + a, n2 = n1 + 2;
      const float4 cs = *(const float4*)(cosT + pos * 32 + a * 16 + g * 4);
      const float4 sn = *(const float4*)(sinT + pos * 32 + a * 16 + g * 4);
      const float c4[4] = {cs.x, cs.y, cs.z, cs.w}, s4[4] = {sn.x, sn.y, sn.z, sn.w};
#pragma unroll
      for (int j = 0; j < 4; ++j) { const float x1 = v[n1][j], x2 = v[n2][j]; v[n1][j] = x1 * c4[j] - x2 * s4[j]; v[n2][j] = x1 * s4[j] + x2 * c4[j]; }
    }
  }
}
DI void rope64(f32x4* v, int rowp, int colp, int g, const float* cosT, const float* sinT) {
#pragma unroll
  for (int hf = 0; hf < 2; ++hf) {
    const int pos = hf ? colp : rowp;
    const int n1 = hf * 2, n2 = n1 + 1;
    const float4 cs = *(const float4*)(cosT + pos * 16 + g * 4);
    const float4 sn = *(const float4*)(sinT + pos * 16 + g * 4);
    const float c4[4] = {cs.x, cs.y, cs.z, cs.w}, s4[4] = {sn.x, sn.y, sn.z, sn.w};
#pragma unroll
    for (int j = 0; j < 4; ++j) { const float x1 = v[n1][j], x2 = v[n2][j]; v[n1][j] = x1 * c4[j] - x2 * s4[j]; v[n2][j] = x1 * s4[j] + x2 * c4[j]; }
  }
}

struct EpiGqaIn {
  u16* Q; u16* Kb; u16* Vt; const float* qg; const float* kg; const float* cosT; const float* sinT; float* out;
  template <int MI, int NI> DI void run(f32x4 (&acc)[MI][NI], int mr, int nc, int l15, int g) {
    const int nt = nc >> 7;
#pragma unroll
    for (int mi = 0; mi < MI; ++mi) {
      const int m = mr + mi * 16 + l15;
      const bool prompt = m < NPROMPT;
      const int s = prompt ? (m & 255) : ((m - NPROMPT) & 2047);
      const int rowp = s >> 6, colp = s & 63;
      const int kvrow = kvrow_of_tok(m);
      if (nt < 10) {
        float ss = 0.f;
#pragma unroll
        for (int ni = 0; ni < NI; ++ni)
#pragma unroll
          for (int j = 0; j < 4; ++j) ss += acc[mi][ni][j] * acc[mi][ni][j];
        ss = sum_g(ss);
        const float rs = rsqrtf(ss * (1.f / 128.f) + EPS);
        const float* gn = nt < 8 ? qg : kg;
#pragma unroll
        for (int ni = 0; ni < NI; ++ni) {
          const float4 gv = *(const float4*)(gn + ni * 16 + g * 4);
          acc[mi][ni][0] *= rs * gv.x; acc[mi][ni][1] *= rs * gv.y; acc[mi][ni][2] *= rs * gv.z; acc[mi][ni][3] *= rs * gv.w;
        }
        if (nt >= 8 && prompt) {
#pragma unroll
          for (int ni = 0; ni < NI; ++ni) { float4 o; o.x = acc[mi][ni][0]; o.y = acc[mi][ni][1]; o.z = acc[mi][ni][2]; o.w = acc[mi][ni][3]; *(float4*)(out + O_GK + (size_t)m * 256 + (nt - 8) * 128 + ni * 16 + g * 4) = o; }
        }
        if (!prompt) rope128(acc[mi], rowp, colp, g, cosT, sinT);
        u16* dst = nt < 8 ? Q + (size_t)m * 1024 + nt * 128 : Kb + (size_t)kvrow * 256 + (nt - 8) * 128;
#pragma unroll
        for (int ni = 0; ni < NI; ++ni) st4bf(dst + ni * 16 + g * 4, acc[mi][ni][0], acc[mi][ni][1], acc[mi][ni][2], acc[mi][ni][3]);
      } else {
        const int kvh = nt - 10;
        if (prompt) {
#pragma unroll
          for (int ni = 0; ni < NI; ++ni) { float4 o; o.x = acc[mi][ni][0]; o.y = acc[mi][ni][1]; o.z = acc[mi][ni][2]; o.w = acc[mi][ni][3]; *(float4*)(out + O_GV + (size_t)m * 256 + kvh * 128 + ni * 16 + g * 4) = o; }
        }
        size_t base; int kvlen, pos;
        if (prompt) { base = (size_t)(m >> 8) * 256 * 256; kvlen = 256; pos = m & 255; }
        else { const int b = (m - NPROMPT) >> 11; base = (size_t)(NPROMPT + b * 2560) * 256; kvlen = 2560; pos = 512 + s; }
#pragma unroll
        for (int ni = 0; ni < NI; ++ni)
#pragma unroll
          for (int j = 0; j < 4; ++j) Vt[base + (size_t)(kvh * 128 + ni * 16 + g * 4 + j) * kvlen + pos] = f2bf(acc[mi][ni][j]);
      }
    }
  }
};
struct EpiMlaUq {
  u16* Q; const float* gnope; const float* grope; const float* cosT; const float* sinT;
  template <int MI, int NI> DI void run(f32x4 (&acc)[MI][NI], int mr, int nc, int l15, int g) {
    const int nt = nc >> 7;
#pragma unroll
    for (int mi = 0; mi < MI; ++mi) {
      const int m = mr + mi * 16 + l15;
      const bool prompt = m < NPROMPT;
      const int s = prompt ? (m & 255) : ((m - NPROMPT) & 2047);
      const int rowp = s >> 6, colp = s & 63;
      if (nt < 8) {
        float ss = 0.f;
#pragma unroll
        for (int ni = 0; ni < NI; ++ni)
#pragma unroll
          for (int j = 0; j < 4; ++j) ss += acc[mi][ni][j] * acc[mi][ni][j];
        ss = sum_g(ss);
        const float rs = rsqrtf(ss * (1.f / 128.f) + EPS);
#pragma unroll
        for (int ni = 0; ni < NI; ++ni) {
          const float4 gv = *(const float4*)(gnope + ni * 16 + g * 4);
          st4bf(Q + (size_t)m * 1536 + nt * 192 + ni * 16 + g * 4, acc[mi][ni][0] * rs * gv.x, acc[mi][ni][1] * rs * gv.y, acc[mi][ni][2] * rs * gv.z, acc[mi][ni][3] * rs * gv.w);
        }
      } else {
#pragma unroll
        for (int hh = 0; hh < 2; ++hh) {
          const int h = (nt - 8) * 2 + hh;
          float ss = 0.f;
#pragma unroll
          for (int ni = 0; ni < 4; ++ni)
#pragma unroll
            for (int j = 0; j < 4; ++j) ss += acc[mi][hh * 4 + ni][j] * acc[mi][hh * 4 + ni][j];
          ss = sum_g(ss);
          const float rs = rsqrtf(ss * (1.f / 64.f) + EPS);
#pragma unroll
          for (int ni = 0; ni < 4; ++ni) {
            const float4 gv = *(const float4*)(grope + ni * 16 + g * 4);
            acc[mi][hh * 4 + ni][0] *= rs * gv.x; acc[mi][hh * 4 + ni][1] *= rs * gv.y; acc[mi][hh * 4 + ni][2] *= rs * gv.z; acc[mi][hh * 4 + ni][3] *= rs * gv.w;
          }
          if (!prompt) rope64(&acc[mi][hh * 4], rowp, colp, g, cosT, sinT);
#pragma unroll
          for (int ni = 0; ni < 4; ++ni)
            st4bf(Q + (size_t)m * 1536 + h * 192 + 128 + ni * 16 + g * 4, acc[mi][hh * 4 + ni][0], acc[mi][hh * 4 + ni][1], acc[mi][hh * 4 + ni][2], acc[mi][hh * 4 + ni][3]);
        }
      }
    }
  }
};
struct EpiMlaUkv {
  u16* Kb; u16* Vt; const float* gnope;
  template <int MI, int NI> DI void run(f32x4 (&acc)[MI][NI], int mr, int nc, int l15, int g) {
    const int nt = nc >> 7, h = nt >> 1;
#pragma unroll
    for (int mi = 0; mi < MI; ++mi) {
      const int m = mr + mi * 16 + l15;
      if ((nt & 1) == 0) {
        float ss = 0.f;
#pragma unroll
        for (int ni = 0; ni < NI; ++ni)
#pragma unroll
          for (int j = 0; j < 4; ++j) ss += acc[mi][ni][j] * acc[mi][ni][j];
        ss = sum_g(ss);
        const float rs = rsqrtf(ss * (1.f / 128.f) + EPS);
#pragma unroll
        for (int ni = 0; ni < NI; ++ni) {
          const float4 gv = *(const float4*)(gnope + ni * 16 + g * 4);
          st4bf(Kb + (size_t)m * 1536 + h * 192 + ni * 16 + g * 4, acc[mi][ni][0] * rs * gv.x, acc[mi][ni][1] * rs * gv.y, acc[mi][ni][2] * rs * gv.z, acc[mi][ni][3] * rs * gv.w);
        }
      } else {
        size_t base; int kvlen, pos;
        if (m < NPROMPT) { base = (size_t)(m >> 8) * 256 * 1024; kvlen = 256; pos = m & 255; }
        else { const int r = m - NPROMPT; const int b = r / 2560; base = (size_t)(NPROMPT + b * 2560) * 1024; kvlen = 2560; pos = r - b * 2560; }
#pragma unroll
        for (int ni = 0; ni < NI; ++ni)
#pragma unroll
          for (int j = 0; j < 4; ++j) Vt[base + (size_t)(h * 128 + ni * 16 + g * 4 + j) * kvlen + pos] = f2bf(acc[mi][ni][j]);
      }
    }
  }
};

DI void convert_tile(const float* __restrict__ W, int K, int N, u16* __restrict__ Bt, int tile, int perm, float* sT) {
  const int nkt = K >> 6;
  const int kt = tile % nkt, nt = tile / nkt;
  const int k0 = kt * 64, n0 = nt * 64;
  const int tid = opaque_tid();
  __syncthreads();
  {
    const int n = tid & 63, kq = tid >> 6;
    int nd = n0 + n, ns = nd;
    if (perm == 1) { if (nd < 1024) ns = (nd >> 7) * 192 + (nd & 127); else { const int x = nd - 1024; ns = (x >> 6) * 192 + 128 + (x & 63); } }
    const bool ok = nd < N;
#pragma unroll
    for (int r = 0; r < 16; ++r) { const int k = r * 4 + kq; sT[k * 65 + n] = ok ? W[(size_t)(k0 + k) * N + ns] : 0.f; }
  }
  __syncthreads();
  {
    const int n = tid >> 2, kq = (tid & 3) * 16;
    u32x4 a, b;
#pragma unroll
    for (int e = 0; e < 4; ++e) { a[e] = pack2(sT[(kq + 2 * e) * 65 + n], sT[(kq + 2 * e + 1) * 65 + n]); b[e] = pack2(sT[(kq + 8 + 2 * e) * 65 + n], sT[(kq + 9 + 2 * e) * 65 + n]); }
    u16* dst = Bt + (size_t)(n0 + n) * K + k0 + kq;
    *(u32x4*)dst = a; *(u32x4*)(dst + 8) = b;
  }
}

DI void norm_rows(const P& p, int layer, bool from_input, int item, const float* gnorm, int shift_idx, int scale_idx) {
  const int tidn = opaque_tid();
  char* const ws = opaque_ptr(as_global(p.ws));
  const int lane = tidn & 63, wid = tidn >> 6;
  const int t = item * 8 + wid * 2;
  const float* x = from_input ? (t < NPROMPT ? GIN(0) + (size_t)t * 1024 : GIN(1) + (size_t)(t - NPROMPT) * 1024) : GOUT + (size_t)t * 1024;
  const float* mods = (const float*)(ws + WS_MODS) + ((size_t)layer * 9 + cond_of(t)) * 6144;
  u16* h = (u16*)(ws + WS_HBUF) + (size_t)t * 1024;
  float4 v[2][4]; float ss0 = 0.f, ss1 = 0.f;
#pragma unroll
  for (int e = 0; e < 4; ++e) { v[0][e] = *(const float4*)(x + e * 256 + lane * 4); v[1][e] = *(const float4*)(x + 1024 + e * 256 + lane * 4); }
#pragma unroll
  for (int e = 0; e < 4; ++e) {
    ss0 += v[0][e].x * v[0][e].x + v[0][e].y * v[0][e].y + v[0][e].z * v[0][e].z + v[0][e].w * v[0][e].w;
    ss1 += v[1][e].x * v[1][e].x + v[1][e].y * v[1][e].y + v[1][e].z * v[1][e].z + v[1][e].w * v[1][e].w;
  }
  ss0 = wave_sum(ss0); ss1 = wave_sum(ss1);
  const float rs0 = rsqrtf(ss0 * (1.f / 1024.f) + EPS), rs1 = rsqrtf(ss1 * (1.f / 1024.f) + EPS);
#pragma unroll
  for (int e = 0; e < 4; ++e) {
    const int c = e * 256 + lane * 4;
    const float4 gv = *(const float4*)(gnorm + c);
    const float4 sc = *(const float4*)(mods + scale_idx * 1024 + c);
    const float4 sh = *(const float4*)(mods + shift_idx * 1024 + c);
    const float m0 = gv.x * (1.f + sc.x), m1 = gv.y * (1.f + sc.y), m2 = gv.z * (1.f + sc.z), m3 = gv.w * (1.f + sc.w);
    st4bf(h + c, v[0][e].x * rs0 * m0 + sh.x, v[0][e].y * rs0 * m1 + sh.y, v[0][e].z * rs0 * m2 + sh.z, v[0][e].w * rs0 * m3 + sh.w);
    st4bf(h + 1024 + c, v[1][e].x * rs1 * m0 + sh.x, v[1][e].y * rs1 * m1 + sh.y, v[1][e].z * rs1 * m2 + sh.z, v[1][e].w * rs1 * m3 + sh.w);
  }
}

template <int DK, int HK>
DI void attn_phase(const u16* __restrict__ Q, const u16* __restrict__ Kb, const u16* __restrict__ Vt, u16* __restrict__ obuf, char* smem_raw) {
  const int bid = opaque_bid();
  constexpr int KS = DK / 32, KSTR = DK, QSTR = 8 * DK, KROW = HK * DK, GRP = 8 / HK;
  constexpr int CPR = DK / 8;
  constexpr int KCH = 64 * CPR / 256;
  u16* sK = (u16*)smem_raw;
  u16* sV = sK + 64 * KSTR;
  const int tid = opaque_tid(), lane = tid & 63, wid = tid >> 6, l15 = lane & 15, g = lane >> 4;
  const float sc = rsqrtf((float)DK) * 1.4426950408889634f;
  for (int item = bid; item < 1280; item += gridDim.x) {
    int qb, h, kvlen, tokbase, kvbase;
    if (item < 1024) { const int b = item >> 7, rem = item & 127; h = rem & 7; qb = rem >> 3; kvlen = 2560; tokbase = NPROMPT + b * 2048; kvbase = NPROMPT + b * 2560; }
    else { const int it2 = item - 1024; const int b = it2 >> 4, rem = it2 & 15; h = rem & 7; qb = rem >> 3; kvlen = 256; tokbase = b * 256; kvbase = b * 256; }
    const int kvh = h / GRP;
    const u16* Kp = Kb + (size_t)kvbase * KROW + kvh * DK;
    const u16* Vp = Vt + (size_t)kvbase * (HK * 128) + (size_t)kvh * 128 * kvlen;
    const int qrow0 = tokbase + qb * 128 + wid * 32;
    bf16x8 qf[2][KS];
#pragma unroll
    for (int qi = 0; qi < 2; ++qi)
#pragma unroll
      for (int ks = 0; ks < KS; ++ks) qf[qi][ks] = ld8(Q + (size_t)(qrow0 + qi * 16 + l15) * QSTR + h * DK + ks * 32 + g * 8);
    f32x4 ot[2][8];
#pragma unroll
    for (int qi = 0; qi < 2; ++qi)
#pragma unroll
      for (int dj = 0; dj < 8; ++dj) { ot[qi][dj][0] = 0.f; ot[qi][dj][1] = 0.f; ot[qi][dj][2] = 0.f; ot[qi][dj][3] = 0.f; }
    float mrun[2] = {-1e30f, -1e30f}, lrun[2] = {0.f, 0.f};
    const int ntiles = kvlen >> 6;
    const unsigned toffK = (unsigned)((tid >> 3) * KROW + (tid & 7) * 8), toffV = (unsigned)((tid >> 3) * kvlen + (tid & 7) * 8);
    const int kx = tid >> 3;
    const int kperm = ((kx >> 2) & 1) * 16 + (kx >> 3) * 4 + (kx & 3);
    const int kswz = (CPR == 16) ? (kperm & 15) : ((kperm >> 1) & 7);
    const int ldsoffK = kperm * KSTR;
    const int ldsoffV = (tid >> 3) * 64 + (((tid & 7) ^ (((tid >> 3) >> 1) & 7)) * 8);
    u32x4 rk[KCH], rv[4];
#pragma unroll
    for (int i = 0; i < KCH; ++i) { const int rh = i & 1, cgp = i >> 1; rk[i] = *(const u32x4*)(Kp + (size_t)(rh * 32 * KROW + cgp * 64) + toffK); }
#pragma unroll
    for (int i = 0; i < 4; ++i) rv[i] = *(const u32x4*)(Vp + (size_t)i * 32 * kvlen + toffV);
    for (int kt = 0; kt < ntiles; ++kt) {
      const u16* Kt = Kp + (size_t)(kt + 1) * 64 * KROW;
      const u16* Vtp = Vp + (kt + 1) * 64;
      const bool more = kt + 1 < ntiles;
      __syncthreads();
#pragma unroll
      for (int i = 0; i < KCH; ++i) { const int rh = i & 1, cgp = i >> 1; const int c = (tid & 7) + 8 * cgp; const int pos = (CPR == 16) ? (c ^ kswz) : ((c & ~7) | ((c & 7) ^ kswz)); *(u32x4*)(sK + ldsoffK + rh * 32 * KSTR + pos * 8) = rk[i]; }
#pragma unroll
      for (int i = 0; i < 4; ++i) *(u32x4*)(sV + ldsoffV + i * 32 * 64) = rv[i];
      __syncthreads();
      if (more) {
#pragma unroll
        for (int i = 0; i < KCH; ++i) { const int rh = i & 1, cgp = i >> 1; rk[i] = *(const u32x4*)(Kt + (size_t)(rh * 32 * KROW + cgp * 64) + toffK); }
      }
      __builtin_amdgcn_sched_barrier(0);
      f32x4 st[2][4];
#pragma unroll
      for (int qi = 0; qi < 2; ++qi)
#pragma unroll
        for (int kj = 0; kj < 4; ++kj) { st[qi][kj][0] = 0.f; st[qi][kj][1] = 0.f; st[qi][kj][2] = 0.f; st[qi][kj][3] = 0.f; }
#pragma unroll
      for (int ks = 0; ks < KS; ++ks) {
#pragma unroll
        for (int kj = 0; kj < 4; ++kj) {
          const int kc = ks * 4 + g;
          const int kpos = (CPR == 16) ? (kc ^ l15) : ((kc & ~7) | ((kc & 7) ^ ((l15 >> 1) & 7)));
          const bf16x8 ka = ld8(sK + (kj * 16 + l15) * KSTR + kpos * 8);
          __builtin_amdgcn_s_setprio(1);
          st[0][kj] = mma(ka, qf[0][ks], st[0][kj]);
          st[1][kj] = mma(ka, qf[1][ks], st[1][kj]);
          __builtin_amdgcn_s_setprio(0);
        }
        __builtin_amdgcn_sched_barrier(0);
      }
      bf16x8 pf[2][2];
#pragma unroll
      for (int qi = 0; qi < 2; ++qi) {
        float mx = -1e30f;
#pragma unroll
        for (int kj = 0; kj < 4; ++kj)
#pragma unroll
          for (int r = 0; r < 4; ++r) mx = fmaxf(mx, st[qi][kj][r]);
        mx = fmaxf(mx, __shfl_xor(mx, 16)); mx = fmaxf(mx, __shfl_xor(mx, 32));
        const float mnew = fmaxf(mrun[qi], mx);
        const float alpha = __builtin_amdgcn_exp2f((mrun[qi] - mnew) * sc);
        mrun[qi] = mnew;
        float ps = 0.f;
        const float mneg = -mnew * sc;
#pragma unroll
        for (int kj = 0; kj < 4; ++kj)
#pragma unroll
          for (int r = 0; r < 4; ++r) { const float pv = __builtin_amdgcn_exp2f(fmaf(st[qi][kj][r], sc, mneg)); st[qi][kj][r] = pv; ps += pv; }
        lrun[qi] = lrun[qi] * alpha + ps;
#pragma unroll
        for (int dj = 0; dj < 8; ++dj) { ot[qi][dj][0] *= alpha; ot[qi][dj][1] *= alpha; ot[qi][dj][2] *= alpha; ot[qi][dj][3] *= alpha; }
        pf[qi][0] = pack8(st[qi][0], st[qi][1]);
        pf[qi][1] = pack8(st[qi][2], st[qi][3]);
        __builtin_amdgcn_sched_barrier(0);
      }
      if (more) {
#pragma unroll
        for (int i = 0; i < 4; ++i) rv[i] = *(const u32x4*)(Vtp + (size_t)i * 32 * kvlen + toffV);
      }
      __builtin_amdgcn_sched_barrier(0);
#pragma unroll
      for (int kk = 0; kk < 2; ++kk)
#pragma unroll
        for (int dj = 0; dj < 8; ++dj) {
          const bf16x8 va = ld8(sV + (dj * 16 + l15) * 64 + (((kk * 4 + g) ^ ((l15 >> 1) & 7)) * 8));
          __builtin_amdgcn_s_setprio(1);
          ot[0][dj] = mma(va, pf[0][kk], ot[0][dj]);
          ot[1][dj] = mma(va, pf[1][kk], ot[1][dj]);
          __builtin_amdgcn_s_setprio(0);
          if ((dj & 3) == 3) __builtin_amdgcn_sched_barrier(0);
        }
    }
#pragma unroll
    for (int qi = 0; qi < 2; ++qi) {
      const float inv = 1.f / sum_g(lrun[qi]);
      u16* dst = obuf + (size_t)(qrow0 + qi * 16 + l15) * 1024 + h * 128 + g * 4;
#pragma unroll
      for (int dj = 0; dj < 8; ++dj) st4bf(dst + dj * 16, ot[qi][dj][0] * inv, ot[qi][dj][1] * inv, ot[qi][dj][2] * inv, ot[qi][dj][3] * inv);
    }
  }
}

DI void gdn_chunk_phase(const P& p, int j, char* smem_raw) {
  const int bid = opaque_bid();
  char* const ws = opaque_ptr(as_global(p.ws));
  u16* sK = (u16*)smem_raw;
  float* sA = (float*)(smem_raw + 17408);
  float* sG = (float*)(smem_raw + 17408 + 32768);
  float* sBt = sG + 128;
  const int tid = opaque_tid(), lane = tid & 63, wid = tid >> 6, l15 = lane & 15, g = lane >> 4;
  const u16* proj = (const u16*)(ws + WS_R + R_PROJ);
  u16* qn = (u16*)(ws + WS_HBUF); u16* kn = (u16*)(ws + WS_OBUF); u16* vb = (u16*)(ws + WS_R + R_VBUF);
  u16* Tbuf = (u16*)(ws + WS_R + R_TBUF);
  const float* gbuf = (const float*)(ws + WS_R + R_GBUF);
  float* gcb = (float*)(ws + WS_R + R_GCB); float* betab = (float*)(ws + WS_R + R_BETA);
  float* egb = (float*)(ws + WS_R + R_EG); float* edb = (float*)(ws + WS_R + R_ED);
  const float* conv = GIN(17) + (size_t)j * 3 * 3072;
  const float* a_log = GIN(18) + j * 16; const float* dt_bias = GIN(19) + j * 16;
  for (int unit = bid; unit < 2560; unit += gridDim.x) {
    const int cgi = unit >> 3, h = unit & 7;
    int c, nch; if (cgi < 64) { c = cgi & 3; nch = 4; } else { c = (cgi - 64) & 31; nch = 32; }
    const int t0 = cgi * 64;
    const bool has_prev = c > 0, has_next = c < nch - 1;
    __syncthreads();
    {
      const int r = tid >> 4, cc = (tid & 15) * 8;
#pragma unroll
      for (int part = 0; part < 3; ++part) {
        const int ch = part * 1024 + h * 128 + cc;
        float w0[8], w1[8], w2[8];
#pragma unroll
        for (int e = 0; e < 8; ++e) { w0[e] = conv[ch + e]; w1[e] = conv[3072 + ch + e]; w2[e] = conv[6144 + ch + e]; }
        u16* dstb = part == 0 ? qn : (part == 1 ? kn : vb);
        for (int it = 0; it < 4; ++it) {
          const int i = it * 16 + r, t = t0 + i;
          const u16* src = proj + (size_t)t * 4096 + ch;
          const u32x4 xc = *(const u32x4*)src;
          u32x4 xp = {0u, 0u, 0u, 0u}, xn = {0u, 0u, 0u, 0u};
          if (i > 0 || has_prev) xp = *(const u32x4*)(src - 4096);
          if (i < 63 || has_next) xn = *(const u32x4*)(src + 4096);
          float y[8];
#pragma unroll
          for (int e = 0; e < 4; ++e) {
            float a = w0[2 * e] * bflo(xp[e]) + w1[2 * e] * bflo(xc[e]) + w2[2 * e] * bflo(xn[e]);
            float b = w0[2 * e + 1] * bfhi(xp[e]) + w1[2 * e + 1] * bfhi(xc[e]) + w2[2 * e + 1] * bfhi(xn[e]);
            y[2 * e] = a / (1.f + __expf(-a)); y[2 * e + 1] = b / (1.f + __expf(-b));
          }
          if (part < 2) {
            float ss = 0.f;
#pragma unroll
            for (int e = 0; e < 8; ++e) ss += y[e] * y[e];
            ss += __shfl_xor(ss, 1); ss += __shfl_xor(ss, 2); ss += __shfl_xor(ss, 4); ss += __shfl_xor(ss, 8);
            const float rs = rsqrtf(ss + EPS) * (part == 0 ? 0.08838834764831845f : 1.f);
#pragma unroll
            for (int e = 0; e < 8; ++e) y[e] *= rs;
          }
          u32x4 o; o[0] = pack2(y[0], y[1]); o[1] = pack2(y[2], y[3]); o[2] = pack2(y[4], y[5]); o[3] = pack2(y[6], y[7]);
          *(u32x4*)(dstb + (size_t)t * 1024 + h * 128 + cc) = o;
          if (part == 1) *(u32x4*)(sK + i * 136 + cc) = o;
        }
      }
    }
    if (tid < 128) {
      const int dir = tid >> 6, L = tid & 63;
      const int i = dir ? 63 - L : L;
      const float* gb = gbuf + (size_t)(t0 + i) * 32;
      const float gin = gb[dir * 8 + h], bin = gb[16 + dir * 8 + h];
      const float x = gin + dt_bias[dir * 8 + h];
      const float sp = fmaxf(x, 0.f) + log1pf(expf(-fabsf(x)));
      float gv = -expf(a_log[dir * 8 + h]) * sp;
      const float bt = 1.f / (1.f + expf(-bin));
#pragma unroll
      for (int off = 1; off < 64; off <<= 1) { const float v = __shfl_up(gv, off); if (L >= off) gv += v; }
      sG[dir * 64 + i] = gv; sBt[dir * 64 + i] = bt;
      gcb[((size_t)(t0 + i) * 8 + h) * 2 + dir] = gv; betab[((size_t)(t0 + i) * 8 + h) * 2 + dir] = bt;
      { const float gtot = __shfl(gv, 63); egb[((size_t)(t0 + i) * 8 + h) * 2 + dir] = expf(gv); edb[((size_t)(t0 + i) * 8 + h) * 2 + dir] = expf(gtot - gv); }
    }
    __syncthreads();
    {
      f32x4 ga[4];
#pragma unroll
      for (int mt = 0; mt < 4; ++mt) { ga[mt][0] = 0.f; ga[mt][1] = 0.f; ga[mt][2] = 0.f; ga[mt][3] = 0.f; }
#pragma unroll
      for (int ks = 0; ks < 4; ++ks) {
        const bf16x8 a = ld8(sK + (wid * 16 + l15) * 136 + ks * 32 + g * 8);
#pragma unroll
        for (int mt = 0; mt < 4; ++mt) { const bf16x8 b = ld8(sK + (mt * 16 + l15) * 136 + ks * 32 + g * 8); ga[mt] = mma(a, b, ga[mt]); }
      }
#pragma unroll
      for (int dir = 0; dir < 2; ++dir)
#pragma unroll
        for (int mt = 0; mt < 4; ++mt)
#pragma unroll
          for (int r = 0; r < 4; ++r) {
            const int i = wid * 16 + g * 4 + r, m = mt * 16 + l15;
            const bool valid = dir ? (i < m) : (i > m);
            const float val = valid ? sBt[dir * 64 + i] * ga[mt][r] * __expf(sG[dir * 64 + i] - sG[dir * 64 + m]) : 0.f;
            const int ii = dir ? 63 - i : i, mm = dir ? 63 - m : m;
            sA[dir * 4096 + ii * 64 + mm] = val;
          }
    }
    __syncthreads();
    if (wid < 2) {
      const int dir = wid;
      float* Am = sA + dir * 4096;
#pragma unroll
      for (int b = 0; b < 8; ++b) {
#pragma unroll 1
        for (int r = 0; r < 8; ++r) {
          const int i = b * 8 + r;
          float4 av[16]; float tv[64];
#pragma unroll
          for (int c = 0; c < 8; ++c) if (c <= b) {
            av[2 * c] = *(const float4*)(Am + i * 64 + c * 8); av[2 * c + 1] = *(const float4*)(Am + i * 64 + c * 8 + 4);
#pragma unroll
            for (int e = 0; e < 8; ++e) tv[c * 8 + e] = Am[(c * 8 + e) * 64 + lane];
          }
          float a = (i == lane) ? 1.f : 0.f, a2 = 0.f;
#pragma unroll
          for (int c = 0; c < 8; ++c) if (c <= b) {
            a -= av[2 * c].x * tv[c * 8]; a2 -= av[2 * c].y * tv[c * 8 + 1]; a -= av[2 * c].z * tv[c * 8 + 2]; a2 -= av[2 * c].w * tv[c * 8 + 3];
            a -= av[2 * c + 1].x * tv[c * 8 + 4]; a2 -= av[2 * c + 1].y * tv[c * 8 + 5]; a -= av[2 * c + 1].z * tv[c * 8 + 6]; a2 -= av[2 * c + 1].w * tv[c * 8 + 7];
          }
          Am[i * 64 + lane] = a + a2;
        }
      }
      const int mn = dir ? 63 - lane : lane;
      const float bm = sBt[dir * 64 + mn];
      u16* Td = Tbuf + ((size_t)unit * 2 + dir) * 4096;
#pragma unroll 4
      for (int i = 0; i < 64; ++i) { const int in_ = dir ? 63 - i : i; Td[in_ * 64 + mn] = f2bf(Am[i * 64 + lane] * bm); }
    }
  }
}

DI void gdn_scan_phase(const P& p, int j, char* smem_raw) {
  const int bid = opaque_bid();
  char* const ws = opaque_ptr(as_global(p.ws));
  u16* sK = (u16*)smem_raw;
  u16* sV = sK + 64 * 136;
  u16* sST = sV + 64 * 40;
  u16* sVN = sST + 32 * 136;
  u16* sVD = sVN + 32 * 72;
  float* sGc = (float*)(sVD + 32 * 72);
  float* sE = sGc + 64;
  float* sD = sE + 64;
  const int tid = opaque_tid(), lane = tid & 63, w = tid >> 6, l15 = lane & 15, g = lane >> 4;
  const u16* qn = (const u16*)(ws + WS_HBUF); const u16* kn = (const u16*)(ws + WS_OBUF); const u16* vb = (const u16*)(ws + WS_R + R_VBUF);
  const u16* Tbuf = (const u16*)(ws + WS_R + R_TBUF);
  const float* gcb = (const float*)(ws + WS_R + R_GCB);
  const float* egb = (const float*)(ws + WS_R + R_EG); const float* edb = (const float*)(ws + WS_R + R_ED);
  u16* obase = (u16*)(ws + WS_R + R_PROJ);
  for (int wk = bid; wk < 1536; wk += gridDim.x) {
    int seq, rem;
    if (wk < 512) { seq = 16 + (wk >> 6); rem = wk & 63; } else { seq = (wk - 512) >> 6; rem = (wk - 512) & 63; }
    const int h = rem & 7, dir = (rem >> 5) & 1, dvq = (rem >> 3) & 3;
    const int nch = seq < 16 ? 4 : 32;
    const int cgb = seq < 16 ? seq * 4 : 64 + (seq - 16) * 32;
    f32x4 S[2][2];
    if (seq >= 16) {
      const float* s0 = GIN(2 + dir) + (((size_t)(seq - 16) * 2 + j) * 8 + h) * 16384;
#pragma unroll
      for (int dt = 0; dt < 2; ++dt)
#pragma unroll
        for (int et = 0; et < 2; ++et)
#pragma unroll
          for (int r = 0; r < 4; ++r) S[dt][et][r] = s0[(size_t)(w * 32 + dt * 16 + g * 4 + r) * 128 + dvq * 32 + et * 16 + l15];
    } else {
#pragma unroll
      for (int dt = 0; dt < 2; ++dt)
#pragma unroll
        for (int et = 0; et < 2; ++et) { S[dt][et][0] = 0.f; S[dt][et][1] = 0.f; S[dt][et][2] = 0.f; S[dt][et][3] = 0.f; }
    }
    __syncthreads();
#pragma unroll
    for (int dt = 0; dt < 2; ++dt)
#pragma unroll
      for (int et = 0; et < 2; ++et) st4bf(sST + (et * 16 + l15) * 136 + w * 32 + dt * 16 + g * 4, S[dt][et][0], S[dt][et][1], S[dt][et][2], S[dt][et][3]);
    u32x4 pk[4], pv; float pg = 0.f, pe = 0.f, pd = 0.f;
#define SCAN_PREFETCH(cc) do { \
      const int t0n_ = (cgb + (cc)) * 64; \
      _Pragma("unroll") for (int i = 0; i < 4; ++i) { const int ci = tid + 256 * i; const int row = ci >> 4, dc = (ci & 15) * 8; pk[i] = *(const u32x4*)(kn + (size_t)(t0n_ + row) * 1024 + h * 128 + dc); } \
      { const int row = tid >> 2, ec = (tid & 3) * 8; pv = *(const u32x4*)(vb + (size_t)(t0n_ + row) * 1024 + h * 128 + dvq * 32 + ec); } \
      if (tid < 64) { const size_t gi_ = ((size_t)(t0n_ + tid) * 8 + h) * 2 + dir; pg = gcb[gi_]; pe = egb[gi_]; pd = edb[gi_]; } \
    } while (0)
    SCAN_PREFETCH(dir ? nch - 1 : 0);
    bf16x8 qf[4], tf[2];
    {
      const int c0_ = dir ? nch - 1 : 0;
#pragma unroll
      for (int ks = 0; ks < 4; ++ks) qf[ks] = ld8(qn + (size_t)((cgb + c0_) * 64 + w * 16 + l15) * 1024 + h * 128 + ks * 32 + g * 8);
#pragma unroll
      for (int ks = 0; ks < 2; ++ks) tf[ks] = ld8(Tbuf + ((size_t)((cgb + c0_) * 8 + h) * 2 + dir) * 4096 + (w * 16 + l15) * 64 + ks * 32 + g * 8);
    }
    for (int step = 0; step < nch; ++step) {
      const int cnx = (step + 1 < nch) ? (dir ? nch - 2 - step : step + 1) : (dir ? nch - 1 - step : step);
      const int c = dir ? nch - 1 - step : step;
      const int t0 = (cgb + c) * 64;
      const int unit = (cgb + c) * 8 + h;
#pragma unroll
      for (int i = 0; i < 4; ++i) {
        const int ci = tid + 256 * i; const int row = ci >> 4, dc = (ci & 15) * 8;
        *(u32x4*)(sK + row * 136 + dc) = pk[i];
      }
      { const int row = tid >> 2, ec = (tid & 3) * 8; *(u32x4*)(sV + row * 40 + ec) = pv; }
      if (tid < 64) { sGc[tid] = pg; sE[tid] = pe; sD[tid] = pd; }
      __syncthreads();
      if (step + 1 < nch) { const int cn = dir ? nch - 2 - step : step + 1; SCAN_PREFETCH(cn); }
      const float gl = dir ? sGc[0] : sGc[63];
      bf16x8 wf[4];
      f32x4 ua[2];
      {
        bf16x8 vtf[2][2];
        f32x4 egm[2][2];
#pragma unroll
        for (int et = 0; et < 2; ++et)
#pragma unroll
          for (int ks = 0; ks < 2; ++ks) vtf[et][ks] = ldtr(sV + (ks * 32 + g * 8 + (l15 >> 2)) * 40 + et * 16 + (l15 & 3) * 4, 4 * 40);
#pragma unroll
        for (int ks = 0; ks < 2; ++ks) { egm[ks][0] = *(const f32x4*)(sE + ks * 32 + g * 8); egm[ks][1] = *(const f32x4*)(sE + ks * 32 + g * 8 + 4); }
        __builtin_amdgcn_sched_barrier(0);
#pragma unroll
        for (int et = 0; et < 2; ++et) {
          ua[et][0] = 0.f; ua[et][1] = 0.f; ua[et][2] = 0.f; ua[et][3] = 0.f;
#pragma unroll
          for (int ks = 0; ks < 2; ++ks) ua[et] = mma(tf[ks], vtf[et][ks], ua[et]);
        }
#pragma unroll
        for (int ks = 0; ks < 2; ++ks) {
          const u32x4 tw = __builtin_bit_cast(u32x4, tf[ks]);
          u32x4 o;
#pragma unroll
          for (int e = 0; e < 4; ++e) o[e] = pack2(bflo(tw[e]) * egm[ks][e >> 1][(2 * e) & 3], bfhi(tw[e]) * egm[ks][e >> 1][(2 * e + 1) & 3]);
          tf[ks] = __builtin_bit_cast(bf16x8, o);
        }
        __builtin_amdgcn_sched_barrier(0);
      }
#pragma unroll
      for (int kq = 0; kq < 4; ++kq) {
        bf16x8 ktf[2][2];
#pragma unroll
        for (int hh = 0; hh < 2; ++hh)
#pragma unroll
          for (int ks = 0; ks < 2; ++ks) ktf[hh][ks] = ldtr(sK + (ks * 32 + g * 8 + (l15 >> 2)) * 136 + (kq * 2 + hh) * 16 + (l15 & 3) * 4, 4 * 136);
        __builtin_amdgcn_sched_barrier(0);
        f32x4 wa[2];
#pragma unroll
        for (int hh = 0; hh < 2; ++hh) {
          wa[hh][0] = 0.f; wa[hh][1] = 0.f; wa[hh][2] = 0.f; wa[hh][3] = 0.f;
#pragma unroll
          for (int ks = 0; ks < 2; ++ks) wa[hh] = mma(ktf[hh][ks], tf[ks], wa[hh]);
        }
        wf[kq] = pack8(wa[0], wa[1]);
        __builtin_amdgcn_sched_barrier(0);
      }
#pragma unroll
      for (int ks = 0; ks < 2; ++ks) tf[ks] = ld8(Tbuf + ((size_t)((cgb + cnx) * 8 + h) * 2 + dir) * 4096 + (w * 16 + l15) * 64 + ks * 32 + g * 8);
      const int iq = w * 16 + l15;
      const float gi = sGc[iq];
      const f32x4 dvec = *(const f32x4*)(sD + w * 16 + g * 4);
      f32x4 vn[2];
      bf16x8 qkf[2];
      {
        bf16x8 stp[2][4];
#pragma unroll
        for (int et = 0; et < 2; ++et)
#pragma unroll
          for (int kq = 0; kq < 4; ++kq) { const u16* sp = sST + (et * 16 + l15) * 136 + kq * 32 + g * 4; stp[et][kq] = ld44(sp, sp + 16); }
        __builtin_amdgcn_sched_barrier(0);
#pragma unroll
        for (int et = 0; et < 2; ++et) {
          f32x4 a; a[0] = 0.f; a[1] = 0.f; a[2] = 0.f; a[3] = 0.f;
#pragma unroll
          for (int kq = 0; kq < 4; ++kq) a = mma(wf[kq], stp[et][kq], a);
          vn[et][0] = ua[et][0] - a[0]; vn[et][1] = ua[et][1] - a[1]; vn[et][2] = ua[et][2] - a[2]; vn[et][3] = ua[et][3] - a[3];
        }
        __builtin_amdgcn_sched_barrier(0);
      }
#pragma unroll
      for (int kk = 0; kk < 2; ++kk) {
        bf16x8 kf[2][4];
        f32x4 gcm[2];
#pragma unroll
        for (int hh = 0; hh < 2; ++hh)
#pragma unroll
          for (int ks = 0; ks < 4; ++ks) kf[hh][ks] = ld8(sK + ((kk * 2 + hh) * 16 + l15) * 136 + ks * 32 + g * 8);
#pragma unroll
        for (int hh = 0; hh < 2; ++hh) gcm[hh] = *(const f32x4*)(sGc + (kk * 2 + hh) * 16 + g * 4);
        __builtin_amdgcn_sched_barrier(0);
        f32x4 ka[2];
#pragma unroll
        for (int hh = 0; hh < 2; ++hh) {
          const int mt = kk * 2 + hh;
          ka[hh][0] = 0.f; ka[hh][1] = 0.f; ka[hh][2] = 0.f; ka[hh][3] = 0.f;
#pragma unroll
          for (int ks = 0; ks < 4; ++ks) ka[hh] = mma(kf[hh][ks], qf[ks], ka[hh]);
#pragma unroll
          for (int r = 0; r < 4; ++r) {
            const int m = mt * 16 + g * 4 + r;
            const bool valid = dir ? (iq <= m) : (iq >= m);
            ka[hh][r] = ka[hh][r] * __expf(valid ? gi - gcm[hh][r] : -1e30f);
          }
        }
        qkf[kk] = pack8(ka[0], ka[1]);
        __builtin_amdgcn_sched_barrier(0);
      }
#pragma unroll
      for (int et = 0; et < 2; ++et) {
        const int i0 = w * 16 + g * 4;
        st4bf(sVN + (et * 16 + l15) * 72 + i0, vn[et][0], vn[et][1], vn[et][2], vn[et][3]);
        st4bf(sVD + (et * 16 + l15) * 72 + i0, vn[et][0] * dvec[0], vn[et][1] * dvec[1], vn[et][2] * dvec[2], vn[et][3] * dvec[3]);
      }
      __syncthreads();
      {
        bf16x8 stn[2][4], vnp[2][2];
#pragma unroll
        for (int et = 0; et < 2; ++et)
#pragma unroll
          for (int ks = 0; ks < 4; ++ks) stn[et][ks] = ld8(sST + (et * 16 + l15) * 136 + ks * 32 + g * 8);
#pragma unroll
        for (int et = 0; et < 2; ++et)
#pragma unroll
          for (int kk = 0; kk < 2; ++kk) { const u16* sp = sVN + (et * 16 + l15) * 72 + kk * 32 + g * 4; vnp[et][kk] = ld44(sp, sp + 16); }
        const f32x4 egi = *(const f32x4*)(sE + w * 16 + g * 4);
        __builtin_amdgcn_sched_barrier(0);
#pragma unroll
        for (int et = 0; et < 2; ++et) {
          f32x4 a1; a1[0] = 0.f; a1[1] = 0.f; a1[2] = 0.f; a1[3] = 0.f;
#pragma unroll
          for (int ks = 0; ks < 4; ++ks) a1 = mma(qf[ks], stn[et][ks], a1);
          f32x4 a2; a2[0] = 0.f; a2[1] = 0.f; a2[2] = 0.f; a2[3] = 0.f;
#pragma unroll
          for (int kk = 0; kk < 2; ++kk) a2 = mma(qkf[kk], vnp[et][kk], a2);
#pragma unroll
          for (int r = 0; r < 4; ++r) {
            const int i = w * 16 + g * 4 + r;
            const float o = a1[r] * egi[r] + a2[r];
            obase[(size_t)(t0 + i) * 4096 + dir * 1024 + h * 128 + dvq * 32 + et * 16 + l15] = f2bf(o);
          }
        }
#pragma unroll
        for (int ks = 0; ks < 4; ++ks) qf[ks] = ld8(qn + (size_t)((cgb + cnx) * 64 + w * 16 + l15) * 1024 + h * 128 + ks * 32 + g * 8);
        __builtin_amdgcn_sched_barrier(0);
      }
      {
        bf16x8 ktf2[2][2], vdf[2][2];
#pragma unroll
        for (int dt = 0; dt < 2; ++dt)
#pragma unroll
          for (int kk = 0; kk < 2; ++kk) { ktf2[dt][kk] = ldtr(sK + (kk * 32 + g * 8 + (l15 >> 2)) * 136 + w * 32 + dt * 16 + (l15 & 3) * 4, 4 * 136); vdf[dt][kk] = ld8(sVD + (dt * 16 + l15) * 72 + kk * 32 + g * 8); }
        __builtin_amdgcn_sched_barrier(0);
        const float eg = __expf(gl);
#pragma unroll
        for (int dt = 0; dt < 2; ++dt)
#pragma unroll
          for (int et = 0; et < 2; ++et) {
            f32x4 a; a[0] = S[dt][et][0] * eg; a[1] = S[dt][et][1] * eg; a[2] = S[dt][et][2] * eg; a[3] = S[dt][et][3] * eg;
#pragma unroll
            for (int kk = 0; kk < 2; ++kk) a = mma(ktf2[dt][kk], vdf[et][kk], a);
            S[dt][et] = a;
          }
      }
      __syncthreads();
#pragma unroll
      for (int dt = 0; dt < 2; ++dt)
#pragma unroll
        for (int et = 0; et < 2; ++et) st4bf(sST + (et * 16 + l15) * 136 + w * 32 + dt * 16 + g * 4, S[dt][et][0], S[dt][et][1], S[dt][et][2], S[dt][et][3]);
    }
    if (seq < 16) {
      float* so = GOUT + (dir ? O_SB : O_SF) + (((size_t)seq * 2 + j) * 8 + h) * 16384;
#pragma unroll
      for (int dt = 0; dt < 2; ++dt)
#pragma unroll
        for (int et = 0; et < 2; ++et)
#pragma unroll
          for (int r = 0; r < 4; ++r) so[(size_t)(w * 32 + dt * 16 + g * 4 + r) * 128 + dvq * 32 + et * 16 + l15] = S[dt][et][r];
    }
  }
}

#define XB_TMO      128
#define XB_XCNT(j)  (256  + 64 * (j))
#define XB_XSUB(j)  (1280 + 64 * (j))
#define XB_XGEN(j)  (2304 + 64 * (j))
#define XB_TOP      3328
#define XB_TOPGEN   3392
#define XCD_BAR_WORDS 3456
#define XB_SPIN_CAP (1u << 20)
#define LAS __attribute__((address_space(3)))
DI unsigned xb_ld(unsigned* p)              { return __hip_atomic_load(p, __ATOMIC_RELAXED, __HIP_MEMORY_SCOPE_AGENT); }
DI unsigned xb_add(unsigned* p, unsigned v) { return __hip_atomic_fetch_add(p, v, __ATOMIC_RELAXED, __HIP_MEMORY_SCOPE_AGENT); }
DI unsigned xb_xcc_id() { return (unsigned)__builtin_amdgcn_s_getreg((3 << 11) | 20) & 0xFu; }
#define XB_SPIN(cond, bar) do { unsigned _sp = 0; while (cond) { __builtin_amdgcn_s_sleep(1); \
    if ((++_sp & 255u) == 0u) { if (xb_ld(&(bar)[XB_TMO])) break; if (_sp > XB_SPIN_CAP) { atomicAdd(&(bar)[XB_TMO], 1u); break; } } } } while (0)
struct XcdBarrier { unsigned* bar; unsigned x; volatile LAS unsigned* st; };
DI XcdBarrier xcd_barrier_post(unsigned* bar, volatile LAS unsigned* st) {
  XcdBarrier b; b.bar = bar; b.x = xb_xcc_id(); b.st = st;
  if (threadIdx.x == 0) (void)xb_add(&bar[XB_XCNT(b.x)], 1u);
  return b;
}
DI void xcd_barrier_complete(unsigned* bar, unsigned x, unsigned& nloc, unsigned& nx) {
  const unsigned Gn = gridDim.x * gridDim.y * gridDim.z;
  unsigned sum, cnt, mine, sp = 0u;
  for (;;) {
    sum = 0u; cnt = 0u; mine = 0u;
#pragma unroll
    for (unsigned j = 0; j < 16; ++j) { const unsigned c = xb_ld(&bar[XB_XCNT(j)]); sum += c; cnt += (c > 0u) ? 1u : 0u; mine = (j == x) ? c : mine; }
    if (sum == Gn) break;
    __builtin_amdgcn_s_sleep(1);
    if ((++sp & 255u) == 0u) { if (xb_ld(&bar[XB_TMO])) break; if (sp > XB_SPIN_CAP) { atomicAdd(&bar[XB_TMO], 1u); break; } }
  }
  nloc = mine > 0u ? mine : 1u; nx = cnt > 0u ? cnt : 1u;
}
DI void xcd_barrier(const XcdBarrier& b) {
  asm volatile("s_waitcnt vmcnt(0)" ::: "memory");
  __syncthreads();
  if (threadIdx.x == 0) {
    unsigned* bar = b.bar;
    __builtin_amdgcn_s_waitcnt(0);
    unsigned nloc = b.st[0], nx = b.st[1];
    if (nloc == 0u) { xcd_barrier_complete(bar, b.x, nloc, nx); b.st[0] = nloc; b.st[1] = nx; }
    const unsigned old = xb_add(&bar[XB_XSUB(b.x)], 1u);
    const unsigned gen = old / nloc;
    if (old + 1u == (gen + 1u) * nloc) {
      __builtin_amdgcn_fence(__ATOMIC_RELEASE, "agent");
      asm volatile("s_waitcnt vmcnt(0)" ::: "memory");
      const unsigned og = xb_add(&bar[XB_TOP], 1u);
      const unsigned tg = og / nx;
      if (og + 1u == (tg + 1u) * nx) xb_add(&bar[XB_TOPGEN], 1u);
      else XB_SPIN(xb_ld(&bar[XB_TOPGEN]) == tg, bar);
      __builtin_amdgcn_fence(__ATOMIC_ACQUIRE, "agent");
      xb_add(&bar[XB_XGEN(b.x)], 1u);
      asm volatile("s_waitcnt vmcnt(0)" ::: "memory");
    } else {
      XB_SPIN(xb_ld(&bar[XB_XGEN(b.x)]) == gen, bar);
      __builtin_amdgcn_fence(__ATOMIC_ACQUIRE, "agent");
      asm volatile("s_waitcnt vmcnt(0)" ::: "memory");
    }
  }
  __syncthreads();
}

__global__ void __launch_bounds__(256, 2) fwd_megakernel(P p) {
  cg::grid_group grid = cg::this_grid();
  __shared__ __attribute__((aligned(16))) char smem[60416];
  const int tid = opaque_tid(), lane = tid & 63, wid = tid >> 6;
  const int G = gridDim.x;
  __shared__ uint4 xb_words;
  if (threadIdx.x == 0) xb_words = make_uint4(0u, 0u, 0u, 0u);
  __syncthreads();
  (void)xcd_barrier_post((unsigned*)(as_global(p.ws) + WS_BAR), (volatile LAS unsigned*)&xb_words);
#define GSYNC() do { XcdBarrier xb_; xb_.bar = (unsigned*)(opaque_ptr(as_global(p.ws)) + WS_BAR); xb_.x = xb_xcc_id(); xb_.st = (volatile LAS unsigned*)&xb_words; xcd_barrier(xb_); } while (0)
  const int bid0 = opaque_bid();
  {
  char* const ws0 = opaque_ptr(as_global(p.ws));
  float* mods = (float*)(ws0 + WS_MODS);
  float* ropeT = (float*)(ws0 + WS_ROPE);
  float* cosG = ropeT, *sinG = ropeT + 2048, *cosM = ropeT + 4096, *sinM = ropeT + 5120;

  {
    float* sc = (float*)smem;
    float* red = sc + 9 * 128;
    float* part = (float*)(ws0 + WS_R);
    for (int item = bid0; item < 3072; item += G) {
      const int ks = item & 7, cgp = (item >> 3) % 96, layer = item / 768;
      __syncthreads();
      for (int e = tid; e < 9 * 128; e += 256) {
        const int ci = e >> 7, k = ks * 128 + (e & 127);
        const float v = ci == 0 ? GIN(9)[k] : GIN(8)[(ci - 1) * 1024 + k];
        sc[e] = v / (1.f + expf(-v));
      }
      __syncthreads();
      const int col = tid & 63, kg = tid >> 6;
      const float* wp = GIN(12) + ((size_t)layer * 1024 + ks * 128 + kg * 32) * 6144 + cgp * 64 + col;
      float acc[9];
#pragma unroll
      for (int ci = 0; ci < 9; ++ci) acc[ci] = 0.f;
      float wvv[32];
#pragma unroll
      for (int kk = 0; kk < 32; ++kk) wvv[kk] = wp[(size_t)kk * 6144];
#pragma unroll
      for (int kk = 0; kk < 32; ++kk) {
#pragma unroll
        for (int ci = 0; ci < 9; ++ci) acc[ci] += sc[ci * 128 + kg * 32 + kk] * wvv[kk];
      }
#pragma unroll
      for (int ci = 0; ci < 9; ++ci) red[(kg * 64 + col) * 9 + ci] = acc[ci];
      __syncthreads();
      if (kg == 0) {
        const int n = cgp * 64 + col;
        const float bias = ks == 0 ? GIN(13)[(size_t)layer * 6144 + n] : 0.f;
#pragma unroll
        for (int ci = 0; ci < 9; ++ci) {
          const float s = red[col * 9 + ci] + red[(64 + col) * 9 + ci] + red[(128 + col) * 9 + ci] + red[(192 + col) * 9 + ci] + bias;
          part[(size_t)ks * 221184 + ((size_t)layer * 9 + ci) * 6144 + n] = s;
        }
      }
    }
    if (bid0 == G - 1) {
      for (int e = tid; e < 2048; e += 256) { const int pos = e >> 5, f = e & 31; const float fr = powf(10000.f, -(float)f / 32.f); const float a = (float)pos * fr; cosG[e] = cosf(a); sinG[e] = sinf(a); }
      for (int e = tid; e < 1024; e += 256) { const int pos = e >> 4, f = e & 15; const float fr = powf(10000.f, -(float)f / 16.f); const float a = (float)pos * fr; cosM[e] = cosf(a); sinM[e] = sinf(a); }
    }
  }
  if (gridDim.x == 0x7fffffffu) grid.sync();
  GSYNC();
  {
    const float* part = (const float*)(ws0 + WS_R);
    for (int e = bid0 * 256 + tid; e < 221184; e += G * 256) {
      float sacc = 0.f;
#pragma unroll
      for (int ks = 0; ks < 8; ++ks) sacc += part[(size_t)ks * 221184 + e];
      mods[e] = sacc;
    }
  }
  }
  GSYNC();

#pragma unroll 1
  for (int layer = 0; layer < 4; ++layer) {
    const int kind = layer % 3, j = layer / 3;
    const int bid = opaque_bid();
    char* const ws = opaque_ptr(as_global(p.ws));
    float* mods = (float*)(ws + WS_MODS);
    float* ropeT = (float*)(ws + WS_ROPE);
    float* cosG = ropeT, *sinG = ropeT + 2048, *cosM = ropeT + 4096, *sinM = ropeT + 5120;
    u16* hbuf = (u16*)(ws + WS_HBUF);
    u16* obuf = (u16*)(ws + WS_OBUF);
    u16* wmix = (u16*)(ws + WS_WMIX);
    u16* wmlp = (u16*)(ws + WS_WMLP);
    char* R = ws + WS_R;
    const float* lmods = mods + (size_t)layer * 9 * 6144;
    {
      for (int it = bid; it < 2560; it += G) norm_rows(p, layer, layer == 0, it, GIN(10) + layer * 1024, 0, 1);
      float* sT = (float*)smem;
      for (int it = bid; it < 2048; it += G) {
        if (it < 1024) convert_tile(GIN(14) + (size_t)layer * 1024 * 4096, 1024, 4096, wmlp, it, 0, sT);
        else convert_tile(GIN(15) + (size_t)layer * 4096 * 1024, 4096, 1024, wmlp + 4194304, it - 1024, 0, sT);
      }
      if (kind == 0) {
        for (int it = bid; it < 1056 + 256; it += G) {
          if (it < 1056) convert_tile(GIN(16) + (size_t)j * 1024 * 4128, 1024, 4128, wmix + WM_IN, it, 0, sT);
          else convert_tile(GIN(21) + (size_t)j * 1024 * 1024, 1024, 1024, wmix + WM_OUT, it - 1056, 0, sT);
        }
      } else if (kind == 1) {
        for (int it = bid; it < 192 + 144 + 128 + 256; it += G) {
          if (it < 192) convert_tile(GIN(22), 1024, 704, wmix + WM_IN, it, 0, sT);
          else if (it < 336) convert_tile(GIN(25), 384, 1536, wmix + WM_UQ, it - 192, 1, sT);
          else if (it < 464) convert_tile(GIN(26), 256, 2048, wmix + WM_UKV, it - 336, 0, sT);
          else convert_tile(GIN(31), 1024, 1024, wmix + WM_OUT, it - 464, 0, sT);
        }
      } else {
        for (int it = bid; it < 384 + 256; it += G) {
          if (it < 384) convert_tile(GIN(32), 1024, 1536, wmix + WM_IN, it, 0, sT);
          else convert_tile(GIN(35), 1024, 1024, wmix + WM_OUT, it - 384, 0, sT);
        }
        u16* Kg = (u16*)(R + R_KG); u16* Vg = (u16*)(R + R_VTG);
        const int tid = opaque_tid();
        for (int it = bid; it < 512; it += G) {
          const int b = it >> 6, s0 = (it & 63) * 8;
          const int ch = tid;
          float kv[8], vv[8];
#pragma unroll
          for (int e = 0; e < 8; ++e) { kv[e] = GIN(6)[((size_t)b * 512 + s0 + e) * 256 + ch]; vv[e] = GIN(7)[((size_t)b * 512 + s0 + e) * 256 + ch]; }
#pragma unroll
          for (int e = 0; e < 8; ++e) Kg[(size_t)(NPROMPT + b * 2560 + s0 + e) * 256 + ch] = f2bf(kv[e]);
          u32x4 o; o[0] = pack2(vv[0], vv[1]); o[1] = pack2(vv[2], vv[3]); o[2] = pack2(vv[4], vv[5]); o[3] = pack2(vv[6], vv[7]);
          *(u32x4*)(Vg + (size_t)(NPROMPT + b * 2560) * 256 + (size_t)ch * 2560 + s0) = o;
        }
      }
    }
    GSYNC();

    if (kind == 0) {
      {
        EpiGdnIn epi; epi.proj = (u16*)(R + R_PROJ); epi.gbuf = (float*)(R + R_GBUF);
        for (int it = bid; it < 160 * 16; it += G) { const int mt = it >> 4, nt = it & 15; gemm_tile_wide(hbuf, 1024, wmix + WM_IN, 1024, 1024, mt * 128, nt * 256, (u16*)smem, epi); }
        for (int it = bid; it < 160; it += G) gemm_tile<4>(hbuf, 1024, wmix + WM_IN, 1024, 1024, it * 128, 4096, (u16*)smem, epi);
      }
      GSYNC();
      gdn_chunk_phase(p, j, smem);
      GSYNC();
      gdn_scan_phase(p, j, smem);
      GSYNC();
      {
        const u16* pr = (const u16*)(R + R_PROJ);
        const float* on = GIN(20) + j * 128;
        const int tid = opaque_tid();
        for (int t4 = bid; t4 < NTOK / 4; t4 += G) {
          const int h = tid >> 5, c = (tid & 31) * 4;
          u32x2 fv[4], bv[4], zv[4];
#pragma unroll
          for (int u = 0; u < 4; ++u) {
            const u16* row = pr + (size_t)(t4 * 4 + u) * 4096;
            fv[u] = *(const u32x2*)(row + h * 128 + c); bv[u] = *(const u32x2*)(row + 1024 + h * 128 + c); zv[u] = *(const u32x2*)(row + 3072 + h * 128 + c);
          }
          const float4 gn = *(const float4*)(on + c);
          const float gg[4] = {gn.x, gn.y, gn.z, gn.w};
#pragma unroll
          for (int u = 0; u < 4; ++u) {
            const u32x2 f = fv[u], b = bv[u], z = zv[u];
            float o[4] = {bflo(f[0]) + bflo(b[0]), bfhi(f[0]) + bfhi(b[0]), bflo(f[1]) + bflo(b[1]), bfhi(f[1]) + bfhi(b[1])};
            float zz[4] = {bflo(z[0]), bfhi(z[0]), bflo(z[1]), bfhi(z[1])};
            float ss = o[0] * o[0] + o[1] * o[1] + o[2] * o[2] + o[3] * o[3];
            ss += __shfl_xor(ss, 1); ss += __shfl_xor(ss, 2); ss += __shfl_xor(ss, 4); ss += __shfl_xor(ss, 8); ss += __shfl_xor(ss, 16);
            const float rs = rsqrtf(ss * (1.f / 128.f) + EPS);
            float y[4];
#pragma unroll
            for (int e = 0; e < 4; ++e) y[e] = o[e] * rs * gg[e] * (zz[e] / (1.f + __expf(-zz[e])));
            st4bf(obuf + (size_t)(t4 * 4 + u) * 1024 + h * 128 + c, y[0], y[1], y[2], y[3]);
          }
        }
      }
      GSYNC();
    } else if (kind == 1) {
      {
        EpiF32 epi; epi.dst = (float*)(R + R_DPROJ); epi.ld = 768;
        for (int it = bid; it < 160 * 6; it += G) { const int mt = it / 6, nt = it % 6; gemm_tile<4>(hbuf, 1024, wmix + WM_IN, 1024, 1024, mt * 128, nt * 128, (u16*)smem, epi); }
      }
      GSYNC();
      {
        const float* dproj = (const float*)(R + R_DPROJ);
        u16* cq = (u16*)(R + R_CQ); u16* ckv = (u16*)(R + R_CKV); u16* Km = (u16*)(R + R_KM);
        const int tid = opaque_tid(), lane = tid & 63, wid = tid >> 6;
        for (int it = bid; it < 6144; it += G) {
          const int row = it * 4 + wid;
          if (row < NTOK) {
            const int t = row;
            const float* pr = dproj + (size_t)t * 768;
            float v[6]; float ss = 0.f;
#pragma unroll
            for (int e = 0; e < 6; ++e) { v[e] = pr[lane + 64 * e]; ss += v[e] * v[e]; }
            ss = wave_sum(ss);
            float rs = rsqrtf(ss * (1.f / 384.f) + EPS);
#pragma unroll
            for (int e = 0; e < 6; ++e) cq[(size_t)t * 384 + lane + 64 * e] = f2bf(v[e] * rs * GIN(23)[lane + 64 * e]);
            const int kvrow = kvrow_of_tok(t);
            float wv[4]; ss = 0.f;
#pragma unroll
            for (int e = 0; e < 4; ++e) { wv[e] = pr[384 + lane + 64 * e]; ss += wv[e] * wv[e]; }
            ss = wave_sum(ss);
            rs = rsqrtf(ss * (1.f / 256.f) + EPS);
#pragma unroll
            for (int e = 0; e < 4; ++e) {
              const float o = wv[e] * rs * GIN(24)[lane + 64 * e];
              ckv[(size_t)kvrow * 256 + lane + 64 * e] = f2bf(o);
              if (t < NPROMPT) GOUT[O_CKV + (size_t)t * 256 + lane + 64 * e] = o;
            }
            const float x = pr[640 + lane];
            ss = wave_sum(x * x);
            float kr = x * rsqrtf(ss * (1.f / 64.f) + EPS) * GIN(30)[lane];
            if (t < NPROMPT) GOUT[O_KR + (size_t)t * 64 + lane] = kr;
            else {
              const int s = (t - NPROMPT) & 2047;
              const int pos = lane < 32 ? (s >> 6) : (s & 63);
              const float cs = cosM[pos * 16 + (lane & 15)], sn = sinM[pos * 16 + (lane & 15)];
              const float partner = __shfl_xor(kr, 16);
              kr = ((lane & 16) == 0) ? kr * cs - partner * sn : partner * sn + kr * cs;
            }
            const u16 kb = f2bf(kr);
#pragma unroll
            for (int hh = 0; hh < 8; ++hh) Km[(size_t)kvrow * 1536 + hh * 192 + 128 + lane] = kb;
          } else {
            const int r = row - NTOK; const int b = r >> 9, s = r & 511;
            const int kvrow = NPROMPT + b * 2560 + s;
#pragma unroll
            for (int e = 0; e < 4; ++e) ckv[(size_t)kvrow * 256 + lane + 64 * e] = f2bf(GIN(4)[((size_t)b * 512 + s) * 256 + lane + 64 * e]);
            const u16 kb = f2bf(GIN(5)[((size_t)b * 512 + s) * 64 + lane]);
#pragma unroll
            for (int hh = 0; hh < 8; ++hh) Km[(size_t)kvrow * 1536 + hh * 192 + 128 + lane] = kb;
          }
        }
      }
      GSYNC();
      {
        EpiMlaUq e1; e1.Q = (u16*)(R + R_Q); e1.gnope = GIN(27); e1.grope = GIN(28); e1.cosT = cosM; e1.sinT = sinM;
        for (int it = bid; it < 160 * 12; it += G) { const int mt = it / 12, nt = it % 12; gemm_tile<8>((const u16*)(R + R_CQ), 384, wmix + WM_UQ, 384, 384, mt * 128, nt * 128, (u16*)smem, e1); }
        EpiMlaUkv e2; e2.Kb = (u16*)(R + R_KM); e2.Vt = (u16*)(R + R_VTM); e2.gnope = GIN(29);
        for (int it = bid; it < 192 * 16; it += G) { const int mt = it / 16, nt = it % 16; gemm_tile<8>((const u16*)(R + R_CKV), 256, wmix + WM_UKV, 256, 256, mt * 128, nt * 128, (u16*)smem, e2); }
      }
      GSYNC();
      attn_phase<192, 8>((const u16*)(R + R_Q), (const u16*)(R + R_KM), (const u16*)(R + R_VTM), obuf, smem);
      GSYNC();
    } else {
      {
        EpiGqaIn epi; epi.Q = (u16*)(R + R_Q); epi.Kb = (u16*)(R + R_KG); epi.Vt = (u16*)(R + R_VTG); epi.qg = GIN(33); epi.kg = GIN(34); epi.cosT = cosG; epi.sinT = sinG; epi.out = GOUT;
        for (int it = bid; it < 160 * 12; it += G) { const int mt = it / 12, nt = it % 12; gemm_tile<8>(hbuf, 1024, wmix + WM_IN, 1024, 1024, mt * 128, nt * 128, (u16*)smem, epi); }
      }
      GSYNC();
      attn_phase<128, 2>((const u16*)(R + R_Q), (const u16*)(R + R_KG), (const u16*)(R + R_VTG), obuf, smem);
      GSYNC();
    }

    for (int it = bid; it < 768; it += G) {
      const bool wide = it < 512;
      int m0, n0;
      if (wide) { m0 = (it >> 2) * 128; n0 = (it & 3) * 256; } else { const int ix = it - 512; m0 = (128 + (ix >> 3)) * 128; n0 = (ix & 7) * 128; }
      EpiResid epi;
      epi.xin = (layer == 0) ? (m0 < NPROMPT ? GIN(0) : GIN(1) - (size_t)NPROMPT * 1024) : GOUT;
      epi.xout = GOUT; epi.gate = lmods + (size_t)cond_of(m0) * 6144 + 2 * 1024;
      if (wide) gemm_tile_wide(obuf, 1024, wmix + WM_OUT, 1024, 1024, m0, n0, (u16*)smem, epi);
      else gemm_tile<4>(obuf, 1024, wmix + WM_OUT, 1024, 1024, m0, n0, (u16*)smem, epi);
    }
    GSYNC();
    for (int it = bid; it < 2560; it += G) norm_rows(p, layer, false, it, GIN(11) + layer * 1024, 3, 4);
    GSYNC();
    {
      EpiMlpIn epi; epi.abuf = (u16*)(R + R_ABUF);
      for (int it = bid; it < 160 * 16; it += G) { const int mt = it >> 4, nt = it & 15; gemm_tile_wide(hbuf, 1024, wmlp, 1024, 1024, mt * 128, nt * 256, (u16*)smem, epi); }
    }
    GSYNC();
    for (int it = bid; it < 768; it += G) {
      const bool wide = it < 512;
      int m0, n0;
      if (wide) { m0 = (it >> 2) * 128; n0 = (it & 3) * 256; } else { const int ix = it - 512; m0 = (128 + (ix >> 3)) * 128; n0 = (ix & 7) * 128; }
      EpiResid epi; epi.xin = GOUT; epi.xout = GOUT; epi.gate = lmods + (size_t)cond_of(m0) * 6144 + 5 * 1024;
      if (wide) gemm_tile_wide((const u16*)(R + R_ABUF), 4096, wmlp + 4194304, 4096, 4096, m0, n0, (u16*)smem, epi);
      else gemm_tile<4>((const u16*)(R + R_ABUF), 4096, wmlp + 4194304, 4096, 4096, m0, n0, (u16*)smem, epi);
    }
    GSYNC();
  }
}

extern "C" void kernel_launch(void* const* d_in, const int* in_sizes, int n_in, void* d_out, int out_size, void* d_ws, size_t ws_size, hipStream_t stream) {
  static int grid_blocks = 0;
  if (!grid_blocks) {
    int dev = 0, cus = 0, per_cu = 0;
    hipGetDevice(&dev);
    hipDeviceGetAttribute(&cus, hipDeviceAttributeMultiprocessorCount, dev);
    hipOccupancyMaxActiveBlocksPerMultiprocessor(&per_cu, fwd_megakernel, 256, 0);
    if (per_cu < 1) per_cu = 1;
    if (per_cu > 2) per_cu = 2;
    grid_blocks = cus * per_cu;
  }
  P p{};
  for (int i = 0; i < 36; ++i) p.in[i] = (const float*)d_in[i];
  p.out = (float*)d_out;
  p.ws = (char*)d_ws;
  (void)hipMemsetAsync((char*)d_ws + WS_BAR, 0, XCD_BAR_WORDS * 4, stream);
  void* args[] = {&p};
  hipError_t e = hipLaunchCooperativeKernel((void*)fwd_megakernel, dim3(grid_blocks), dim3(256), args, 0, stream);
  if (e != hipSuccess) fprintf(stderr, "cooperative launch failed: %s (grid %d)\n", hipGetErrorString(e), grid_blocks);
}
```

```cpp
#include <hip/hip_runtime.h>
#include <hip/hip_cooperative_groups.h>
#include <cstdio>
namespace cg = cooperative_groups;

typedef unsigned short u16;
typedef __attribute__((ext_vector_type(8))) short bf16x8;
typedef __attribute__((ext_vector_type(4))) short bf16x4;
typedef __attribute__((ext_vector_type(4))) float f32x4;
typedef __attribute__((ext_vector_type(4))) unsigned u32x4;
typedef __attribute__((ext_vector_type(2))) unsigned u32x2;

#define DI __device__ __forceinline__

constexpr int NTOK = 20480;
constexpr int NPROMPT = 4096;
constexpr float EPS = 1e-6f;

constexpr size_t WS_MODS = 0;
constexpr size_t MODS_BYTES = 4ull * 9 * 6144 * 4;
constexpr size_t WS_BAR = 917504;
constexpr size_t WS_ROPE = 1048576;
constexpr size_t WS_WMIX = 1114112;
constexpr size_t WS_WMLP = 14090240;
constexpr size_t WS_HBUF = 30867456;
constexpr size_t WS_OBUF = 72810496;
constexpr size_t WS_R    = 114753536;
constexpr size_t R_ABUF = 0;
constexpr size_t R_PROJ = 0;
constexpr size_t R_VBUF = 167772160;
constexpr size_t R_TBUF = 209715200;
constexpr size_t R_GBUF = 251658240;
constexpr size_t R_GCB  = 254279680;
constexpr size_t R_BETA = 255590400;
constexpr size_t R_EG   = 256901120;
constexpr size_t R_ED   = 258211840;
constexpr size_t R_DPROJ = 0;
constexpr size_t R_Q    = 0;
constexpr size_t R_CQ   = 62914560;
constexpr size_t R_CKV  = 78643200;
constexpr size_t R_KM   = 91226112;
constexpr size_t R_VTM  = 166723584;
constexpr size_t R_KG   = 41943040;
constexpr size_t R_VTG  = 54525952;
constexpr size_t WM_IN = 0;
constexpr size_t WM_OUT = 4325376;
constexpr size_t WM_UQ = 5373952;
constexpr size_t WM_UKV = 5963776;
constexpr size_t O_SF = 20971520, O_SB = 25165824, O_CKV = 29360128, O_KR = 30408704, O_GK = 30670848, O_GV = 31719424;

struct P {
  const float* in[36];
  float* out;
  char* ws;
};

typedef __attribute__((ext_vector_type(2))) float f32x2_t;
typedef __attribute__((ext_vector_type(2))) __bf16 bf16x2_t;
DI u16 f2bf(float x) { return __builtin_bit_cast(u16, (__bf16)x); }
DI float bf2f(u16 h) { return __uint_as_float(((unsigned)h) << 16); }
DI unsigned pack2(float a, float b) { f32x2_t v; v[0] = a; v[1] = b; return __builtin_bit_cast(unsigned, __builtin_convertvector(v, bf16x2_t)); }
DI float bflo(unsigned w) { return __uint_as_float(w << 16); }
DI float bfhi(unsigned w) { return __uint_as_float(w & 0xffff0000u); }
DI f32x4 mma(bf16x8 a, bf16x8 b, f32x4 c) { return __builtin_amdgcn_mfma_f32_16x16x32_bf16(a, b, c, 0, 0, 0); }
DI bf16x8 pack8(f32x4 a, f32x4 b) {
  u32x4 p; p[0] = pack2(a[0], a[1]); p[1] = pack2(a[2], a[3]); p[2] = pack2(b[0], b[1]); p[3] = pack2(b[2], b[3]);
  return __builtin_bit_cast(bf16x8, p);
}
DI bf16x8 ld8(const u16* p) { return *(const bf16x8*)p; }
DI bf16x8 ld44(const u16* p0, const u16* p1) {
  u32x2 a = *(const u32x2*)p0; u32x2 b = *(const u32x2*)p1;
  u32x4 r; r[0] = a[0]; r[1] = a[1]; r[2] = b[0]; r[3] = b[1];
  return __builtin_bit_cast(bf16x8, r);
}
typedef __attribute__((ext_vector_type(4))) short s16x4_t;
DI bf16x8 ldtr(const u16* p, int row4_off) {
  typedef __attribute__((address_space(3))) s16x4_t lds4_t;
  const s16x4_t lo = __builtin_amdgcn_ds_read_tr16_b64_v4i16((lds4_t*)p);
  const s16x4_t hi = __builtin_amdgcn_ds_read_tr16_b64_v4i16((lds4_t*)(p + row4_off));
  return __builtin_shufflevector(lo, hi, 0, 1, 2, 3, 4, 5, 6, 7);
}
DI void st4bf(u16* p, float a, float b, float c, float d) { u32x2 v; v[0] = pack2(a, b); v[1] = pack2(c, d); *(u32x2*)p = v; }
DI float wave_sum(float v) {
  v += __shfl_xor(v, 1); v += __shfl_xor(v, 2); v += __shfl_xor(v, 4); v += __shfl_xor(v, 8); v += __shfl_xor(v, 16); v += __shfl_xor(v, 32);
  return v;
}
DI float sum_g(float v) { v += __shfl_xor(v, 16); v += __shfl_xor(v, 32); return v; }
DI int opaque_tid() { int t = threadIdx.x; asm volatile("" : "+v"(t)); return t; }
DI int opaque_bid() { int t = __builtin_amdgcn_readfirstlane((int)blockIdx.x); asm volatile("" : "+s"(t)); return t; }
DI char* opaque_ptr(char* q) {
  unsigned lo = __builtin_amdgcn_readfirstlane((unsigned)(size_t)q), hi = __builtin_amdgcn_readfirstlane((unsigned)((size_t)q >> 32));
  asm volatile("" : "+s"(lo), "+s"(hi));
  typedef __attribute__((address_space(1))) char gchar_t;
  return (char*)(gchar_t*)(((size_t)hi << 32) | (size_t)lo);
}
template <class T> DI T* as_global(T* q) { typedef __attribute__((address_space(1))) T gT; return (T*)(gT*)q; }
#define GIN(i) as_global(p.in[i])
#define GOUT as_global(p.out)
DI int cond_of(int t) { return t < NPROMPT ? 0 : 1 + ((t - NPROMPT) >> 11); }
DI int kvrow_of_tok(int t) { return t < NPROMPT ? t : NPROMPT + ((t - NPROMPT) >> 11) * 2560 + 512 + ((t - NPROMPT) & 2047); }

template <int NI, class Epi>
DI void gemm_tile(const u16* __restrict__ A, int lda, const u16* __restrict__ Bt, int ldb, int K, int m0, int n0, u16* smem, Epi& epi) {
  constexpr int MI = 16 / NI;
  constexpr int WN = 8 / NI;
  const int tid = opaque_tid(), lane = tid & 63, wid = tid >> 6, l15 = lane & 15, g = lane >> 4;
  const int wm = wid / WN, wn = wid % WN;
  u16* sA = smem; u16* sB = smem + 128 * 64;
  f32x4 acc[MI][NI];
#pragma unroll
  for (int mi = 0; mi < MI; ++mi)
#pragma unroll
    for (int ni = 0; ni < NI; ++ni) { acc[mi][ni][0] = 0.f; acc[mi][ni][1] = 0.f; acc[mi][ni][2] = 0.f; acc[mi][ni][3] = 0.f; }
  const int lrow = tid >> 3, lkc = (tid & 7) * 8;
  const int wofs = lrow * 64 + (((tid & 7) ^ ((lrow >> 1) & 7)) * 8);
  const int rsw = (l15 >> 1) & 7;
  const int rofs0 = l15 * 64 + ((g ^ rsw) * 8), rofs1 = l15 * 64 + (((4 + g) ^ rsw) * 8);
  const u16* pa = A + (size_t)(m0 + lrow) * lda + lkc;
  const u16* pb = Bt + (size_t)(n0 + lrow) * ldb + lkc;
  u32x4 ra[2][4], rb[2][4];
  const int nk = K >> 6;
#pragma unroll
  for (int i = 0; i < 4; ++i) { ra[0][i] = *(const u32x4*)(pa + (size_t)i * 32 * lda); rb[0][i] = *(const u32x4*)(pb + (size_t)i * 32 * ldb); }
#pragma unroll
  for (int i = 0; i < 4; ++i) { ra[1][i] = *(const u32x4*)(pa + (size_t)i * 32 * lda + 64); rb[1][i] = *(const u32x4*)(pb + (size_t)i * 32 * ldb + 64); }
  for (int kt = 0; kt < nk; kt += 2) {
#pragma unroll
    for (int half = 0; half < 2; ++half) {
      __syncthreads();
#pragma unroll
      for (int i = 0; i < 4; ++i) { *(u32x4*)(sA + wofs + i * 32 * 64) = ra[half][i]; *(u32x4*)(sB + wofs + i * 32 * 64) = rb[half][i]; }
      __syncthreads();
      if (kt + half + 2 < nk) {
        const int ko = (kt + half + 2) * 64;
#pragma unroll
        for (int i = 0; i < 4; ++i) { ra[half][i] = *(const u32x4*)(pa + (size_t)i * 32 * lda + ko); rb[half][i] = *(const u32x4*)(pb + (size_t)i * 32 * ldb + ko); }
      }
#pragma unroll
      for (int ks = 0; ks < 2; ++ks) {
        const int ro = ks ? rofs1 : rofs0;
        bf16x8 af[MI], bfv[NI];
#pragma unroll
        for (int mi = 0; mi < MI; ++mi) af[mi] = ld8(sA + (wm * MI * 16 + mi * 16) * 64 + ro);
#pragma unroll
        for (int ni = 0; ni < NI; ++ni) bfv[ni] = ld8(sB + (wn * NI * 16 + ni * 16) * 64 + ro);
        __builtin_amdgcn_s_setprio(1);
#pragma unroll
        for (int mi = 0; mi < MI; ++mi)
#pragma unroll
          for (int ni = 0; ni < NI; ++ni) acc[mi][ni] = mma(bfv[ni], af[mi], acc[mi][ni]);
        __builtin_amdgcn_s_setprio(0);
      }
    }
  }
  epi.template run<MI, NI>(acc, m0 + wm * MI * 16, n0 + wn * NI * 16, l15, g);
}

template <class Epi>
DI void gemm_tile_wide(const u16* __restrict__ A, int lda, const u16* __restrict__ Bt, int ldb, int K, int m0, int n0, u16* smem, Epi& epi) {
  constexpr int MI = 4, NI = 8;
  const int tid = opaque_tid(), lane = tid & 63, wid = tid >> 6, l15 = lane & 15, g = lane >> 4;
  const int wm = wid >> 1, wn = wid & 1;
  u16* sA = smem; u16* sB = smem + 128 * 64;
  f32x4 acc[MI][NI];
#pragma unroll
  for (int mi = 0; mi < MI; ++mi)
#pragma unroll
    for (int ni = 0; ni < NI; ++ni) { acc[mi][ni][0] = 0.f; acc[mi][ni][1] = 0.f; acc[mi][ni][2] = 0.f; acc[mi][ni][3] = 0.f; }
  const int lrow = tid >> 3, lkc = (tid & 7) * 8;
  const int wofs = lrow * 64 + (((tid & 7) ^ ((lrow >> 1) & 7)) * 8);
  const int rsw = (l15 >> 1) & 7;
  const int rofs0 = l15 * 64 + ((g ^ rsw) * 8), rofs1 = l15 * 64 + (((4 + g) ^ rsw) * 8);
  const u16* pa = A + (size_t)(m0 + lrow) * lda + lkc;
  const u16* pb = Bt + (size_t)(n0 + lrow) * ldb + lkc;
  u32x4 ra[4], rb[8];
  const int nk = K >> 6;
#pragma unroll
  for (int i = 0; i < 4; ++i) ra[i] = *(const u32x4*)(pa + (size_t)i * 32 * lda);
#pragma unroll
  for (int i = 0; i < 8; ++i) rb[i] = *(const u32x4*)(pb + (size_t)i * 32 * ldb);
  for (int kt = 0; kt < nk; ++kt) {
    __syncthreads();
#pragma unroll
    for (int i = 0; i < 4; ++i) *(u32x4*)(sA + wofs + i * 32 * 64) = ra[i];
#pragma unroll
    for (int i = 0; i < 8; ++i) *(u32x4*)(sB + wofs + i * 32 * 64) = rb[i];
    __syncthreads();
    if (kt + 1 < nk) {
      const int ko = (kt + 1) * 64;
#pragma unroll
      for (int i = 0; i < 4; ++i) ra[i] = *(const u32x4*)(pa + (size_t)i * 32 * lda + ko);
#pragma unroll
      for (int i = 0; i < 8; ++i) rb[i] = *(const u32x4*)(pb + (size_t)i * 32 * ldb + ko);
    }
#pragma unroll
    for (int ks = 0; ks < 2; ++ks) {
      const int ro = ks ? rofs1 : rofs0;
      bf16x8 af[MI];
#pragma unroll
      for (int mi = 0; mi < MI; ++mi) af[mi] = ld8(sA + (wm * 64 + mi * 16) * 64 + ro);
#pragma unroll
      for (int nh = 0; nh < 2; ++nh) {
        bf16x8 bfv[4];
#pragma unroll
        for (int ni = 0; ni < 4; ++ni) bfv[ni] = ld8(sB + (wn * 128 + (nh * 4 + ni) * 16) * 64 + ro);
        __builtin_amdgcn_s_setprio(1);
#pragma unroll
        for (int mi = 0; mi < MI; ++mi)
#pragma unroll
          for (int ni = 0; ni < 4; ++ni) acc[mi][nh * 4 + ni] = mma(bfv[ni], af[mi], acc[mi][nh * 4 + ni]);
        __builtin_amdgcn_s_setprio(0);
        __builtin_amdgcn_sched_barrier(0);
      }
    }
  }
  epi.template run<MI, NI>(acc, m0 + wm * 64, n0 + wn * 128, l15, g);
}

struct EpiResid {
  const float* xin; float* xout; const float* gate;
  template <int MI, int NI> DI void run(f32x4 (&acc)[MI][NI], int mr, int nc, int l15, int g) {
#pragma unroll
    for (int mi = 0; mi < MI; ++mi)
#pragma unroll
      for (int ni = 0; ni < NI; ++ni) {
        const int m = mr + mi * 16 + l15, n = nc + ni * 16 + g * 4;
        const float4 xi = *(const float4*)(xin + (size_t)m * 1024 + n);
        const float4 gt = *(const float4*)(gate + n);
        float4 o; o.x = xi.x + gt.x * acc[mi][ni][0]; o.y = xi.y + gt.y * acc[mi][ni][1]; o.z = xi.z + gt.z * acc[mi][ni][2]; o.w = xi.w + gt.w * acc[mi][ni][3];
        *(float4*)(xout + (size_t)m * 1024 + n) = o;
      }
  }
};
struct EpiGdnIn {
  u16* proj; float* gbuf;
  template <int MI, int NI> DI void run(f32x4 (&acc)[MI][NI], int mr, int nc, int l15, int g) {
#pragma unroll
    for (int mi = 0; mi < MI; ++mi)
#pragma unroll
      for (int ni = 0; ni < NI; ++ni) {
        const int m = mr + mi * 16 + l15, n = nc + ni * 16 + g * 4;
        if (n < 4096) st4bf(proj + (size_t)m * 4096 + n, acc[mi][ni][0], acc[mi][ni][1], acc[mi][ni][2], acc[mi][ni][3]);
        else if (n < 4128) { float4 o; o.x = acc[mi][ni][0]; o.y = acc[mi][ni][1]; o.z = acc[mi][ni][2]; o.w = acc[mi][ni][3]; *(float4*)(gbuf + (size_t)m * 32 + (n - 4096)) = o; }
      }
  }
};
struct EpiMlpIn {
  u16* abuf;
  template <int MI, int NI> DI void run(f32x4 (&acc)[MI][NI], int mr, int nc, int l15, int g) {
#pragma unroll
    for (int mi = 0; mi < MI; ++mi)
#pragma unroll
      for (int ni = 0; ni < NI; ++ni) {
        const int m = mr + mi * 16 + l15, n = nc + ni * 16 + g * 4;
        float a = fmaxf(acc[mi][ni][0], 0.f), b = fmaxf(acc[mi][ni][1], 0.f), c = fmaxf(acc[mi][ni][2], 0.f), d = fmaxf(acc[mi][ni][3], 0.f);
        st4bf(abuf + (size_t)m * 4096 + n, a * a, b * b, c * c, d * d);
      }
  }
};
struct EpiF32 {
  float* dst; int ld;
  template <int MI, int NI> DI void run(f32x4 (&acc)[MI][NI], int mr, int nc, int l15, int g) {
#pragma unroll
    for (int mi = 0; mi < MI; ++mi)
#pragma unroll
      for (int ni = 0; ni < NI; ++ni) {
        const int m = mr + mi * 16 + l15, n = nc + ni * 16 + g * 4;
        float4 o; o.x = acc[mi][ni][0]; o.y = acc[mi][ni][1]; o.z = acc[mi][ni][2]; o.w = acc[mi][ni][3];
        *(float4*)(dst + (size_t)m * ld + n) = o;
      }
  }
};

DI void rope128(f32x4 (&v)[8], int rowp, int colp, int g, const float* cosT, const float* sinT) {
#pragma unroll
  for (int hf = 0; hf < 2; ++hf) {
    const int pos = hf ? colp : rowp;
#pragma unroll
    for (int a = 0; a < 2; ++a) {
      const int n1 = hf * 4 + a, n2 = n1 + 2;
      const float4 cs = *(const float4*)(cosT + pos * 32 + a * 16 + g * 4);
      const float4 sn = *(const float4*)(sinT + pos * 32 + a * 16 + g * 4);
      const float c4[4] = {cs.x, cs.y, cs.z, cs.w}, s4[4] = {sn.x, sn.y, sn.z, sn.w};
#pragma unroll
      for (int j = 0; j < 4; ++j) { const float x1 = v[n1][j], x2 = v[n2][j]; v[n1][j] = x1 * c4[j] - x2 * s4[j]; v[n2][j] = x1 * s4[j] + x2 * c4[j]; }
    }
  }
}
DI void rope64(f32x4* v, int rowp, int colp, int g, const float* cosT, const float* sinT) {
#pragma unroll
  for (int hf = 0; hf < 2; ++hf) {
    const int pos = hf ? colp : rowp;
    const int n1 = hf * 2, n2 = n1 + 1;
    const float4 cs = *(const float4*)(cosT + pos * 16 + g * 4);
    const float4 sn = *(const float4*)(sinT + pos * 16 + g * 4);
    const float c4[4] = {cs.x, cs.y, cs.z, cs.w}, s4[4] = {sn.x, sn.y, sn.z, sn.w};
#pragma unroll
    for (int j = 0; j < 4; ++j) { const float x1 = v[n1][j], x2 = v[n2][j]; v[n1][j] = x1 * c4[j] - x2 * s4[j]; v[n2][j] = x1 * s4[j] + x2 * c4[j]; }
  }
}

struct EpiGqaIn {
  u16* Q; u16* Kb; u16* Vt; const float* qg; const float* kg; const float* cosT; const float* sinT; float* out;
  template <int MI, int NI> DI void run(f32x4 (&acc)[MI][NI], int mr, int nc, int l15, int g) {
    const int nt = nc >> 7;
#pragma unroll
    for (int mi = 0; mi < MI; ++mi) {
      const int m = mr + mi * 16 + l15;
      const bool prompt = m < NPROMPT;
      const int s = prompt ? (m & 255) : ((m - NPROMPT) & 2047);
      const int rowp = s >> 6, colp = s & 63;
      const int kvrow = kvrow_of_tok(m);
      if (nt < 10) {
        float ss = 0.f;
#pragma unroll
        for (int ni = 0; ni < NI; ++ni)
#pragma unroll
          for (int j = 0; j < 4; ++j) ss += acc[mi][ni][j] * acc[mi][ni][j];
        ss = sum_g(ss);
        const float rs = rsqrtf(ss * (1.f / 128.f) + EPS);
        const float* gn = nt < 8 ? qg : kg;
#pragma unroll
        for (int ni = 0; ni < NI; ++ni) {
          const float4 gv = *(const float4*)(gn + ni * 16 + g * 4);
          acc[mi][ni][0] *= rs * gv.x; acc[mi][ni][1] *= rs * gv.y; acc[mi][ni][2] *= rs * gv.z; acc[mi][ni][3] *= rs * gv.w;
        }
        if (nt >= 8 && prompt) {
#pragma unroll
          for (int ni = 0; ni < NI; ++ni) { float4 o; o.x = acc[mi][ni][0]; o.y = acc[mi][ni][1]; o.z = acc[mi][ni][2]; o.w = acc[mi][ni][3]; *(float4*)(out + O_GK + (size_t)m * 256 + (nt - 8) * 128 + ni * 16 + g * 4) = o; }
        }
        if (!prompt) rope128(acc[mi], rowp, colp, g, cosT, sinT);
        u16* dst = nt < 8 ? Q + (size_t)m * 1024 + nt * 128 : Kb + (size_t)kvrow * 256 + (nt - 8) * 128;
#pragma unroll
        for (int ni = 0; ni < NI; ++ni) st4bf(dst + ni * 16 + g * 4, acc[mi][ni][0], acc[mi][ni][1], acc[mi][ni][2], acc[mi][ni][3]);
      } else {
        const int kvh = nt - 10;
        if (prompt) {
#pragma unroll
          for (int ni = 0; ni < NI; ++ni) { float4 o; o.x = acc[mi][ni][0]; o.y = acc[mi][ni][1]; o.z = acc[mi][ni][2]; o.w = acc[mi][ni][3]; *(float4*)(out + O_GV + (size_t)m * 256 + kvh * 128 + ni * 16 + g * 4) = o; }
        }
        size_t base; int kvlen, pos;
        if (prompt) { base = (size_t)(m >> 8) * 256 * 256; kvlen = 256; pos = m & 255; }
        else { const int b = (m - NPROMPT) >> 11; base = (size_t)(NPROMPT + b * 2560) * 256; kvlen = 2560; pos = 512 + s; }
#pragma unroll
        for (int ni = 0; ni < NI; ++ni)
#pragma unroll
          for (int j = 0; j < 4; ++j) Vt[base + (size_t)(kvh * 128 + ni * 16 + g * 4 + j) * kvlen + pos] = f2bf(acc[mi][ni][j]);
      }
    }
  }
};
struct EpiMlaUq {
  u16* Q; const float* gnope; const float* grope; const float* cosT; const float* sinT;
  template <int MI, int NI> DI void run(f32x4 (&acc)[MI][NI], int mr, int nc, int l15, int g) {
    const int nt = nc >> 7;
#pragma unroll
    for (int mi = 0; mi < MI; ++mi) {
      const int m = mr + mi * 16 + l15;
      const bool prompt = m < NPROMPT;
      const int s = prompt ? (m & 255) : ((m - NPROMPT) & 2047);
      const int rowp = s >> 6, colp = s & 63;
      if (nt < 8) {
        float ss = 0.f;
#pragma unroll
        for (int ni = 0; ni < NI; ++ni)
#pragma unroll
          for (int j = 0; j < 4; ++j) ss += acc[mi][ni][j] * acc[mi][ni][j];
        ss = sum_g(ss);
        const float rs = rsqrtf(ss * (1.f / 128.f) + EPS);
#pragma unroll
        for (int ni = 0; ni < NI; ++ni) {
          const float4 gv = *(const float4*)(gnope + ni * 16 + g * 4);
          st4bf(Q + (size_t)m * 1536 + nt * 192 + ni * 16 + g * 4, acc[mi][ni][0] * rs * gv.x, acc[mi][ni][1] * rs * gv.y, acc[mi][ni][2] * rs * gv.z, acc[mi][ni][3] * rs * gv.w);
        }
      } else {
#pragma unroll
        for (int hh = 0; hh < 2; ++hh) {
          const int h = (nt - 8) * 2 + hh;
          float ss = 0.f;
#pragma unroll
          for (int ni = 0; ni < 4; ++ni)
#pragma unroll
            for (int j = 0; j < 4; ++j) ss += acc[mi][hh * 4 + ni][j] * acc[mi][hh * 4 + ni][j];
          ss = sum_g(ss);
          const float rs = rsqrtf(ss * (1.f / 64.f) + EPS);
#pragma unroll
          for (int ni = 0; ni < 4; ++ni) {
            const float4 gv = *(const float4*)(grope + ni * 16 + g * 4);
            acc[mi][hh * 4 + ni][0] *= rs * gv.x; acc[mi][hh * 4 + ni][1] *= rs * gv.y; acc[mi][hh * 4 + ni][2] *= rs * gv.z; acc[mi][hh * 4 + ni][3] *= rs * gv.w;
          }
          if (!prompt) rope64(&acc[mi][hh * 4], rowp, colp, g, cosT, sinT);
#pragma unroll
          for (int ni = 0; ni < 4; ++ni)
            st4bf(Q + (size_t)m * 1536 + h * 192 + 128 + ni * 16 + g * 4, acc[mi][hh * 4 + ni][0], acc[mi][hh * 4 + ni][1], acc[mi][hh * 4 + ni][2], acc[mi][hh * 4 + ni][3]);
        }
      }
    }
  }
};
struct EpiMlaUkv {
  u16* Kb; u16* Vt; const float* gnope;
  template <int MI, int NI> DI void run(f32x4 (&acc)[MI][NI], int mr, int nc, int l15, int g) {
    const int nt = nc >> 7, h = nt >> 1;
#pragma unroll
    for (int mi = 0; mi < MI; ++mi) {
      const int m = mr + mi * 16 + l15;
      if ((nt & 1) == 0) {
        float ss = 0.f;
#pragma unroll
        for (int ni = 0; ni < NI; ++ni)
#pragma unroll
          for (int j = 0; j < 4; ++j) ss += acc[mi][ni][j] * acc[mi][ni][j];
        ss = sum_g(ss);
        const float rs = rsqrtf(ss * (1.f / 128.f) + EPS);
#pragma unroll
        for (int ni = 0; ni < NI; ++ni) {
          const float4 gv = *(const float4*)(gnope + ni * 16 + g * 4);
          st4bf(Kb + (size_t)m * 1536 + h * 192 + ni * 16 + g * 4, acc[mi][ni][0] * rs * gv.x, acc[mi][ni][1] * rs * gv.y, acc[mi][ni][2] * rs * gv.z, acc[mi][ni][3] * rs * gv.w);
        }
      } else {
        size_t base; int kvlen, pos;
        if (m < NPROMPT) { base = (size_t)(m >> 8) * 256 * 1024; kvlen = 256; pos = m & 255; }
        else { const int r = m - NPROMPT; const int b = r / 2560; base = (size_t)(NPROMPT + b * 2560) * 1024; kvlen = 2560; pos = r - b * 2560; }
#pragma unroll
        for (int ni = 0; ni < NI; ++ni)
#pragma unroll
          for (int j = 0; j < 4; ++j) Vt[base + (size_t)(h * 128 + ni * 16 + g * 4 + j) * kvlen + pos] = f2bf(acc[mi][ni][j]);
      }
    }
  }
};

DI void convert_tile(const float* __restrict__ W, int K, int N, u16* __restrict__ Bt, int tile, int perm, float* sT) {
  const int nkt = K >> 6;
  const int kt = tile % nkt, nt = tile / nkt;
  const int k0 = kt * 64, n0 = nt * 128;
  const int tid = opaque_tid();
  __syncthreads();
  {
    const int n = tid & 127, kq = tid >> 7;
    int nd = n0 + n, ns = nd;
    if (perm == 1) { if (nd < 1024) ns = (nd >> 7) * 192 + (nd & 127); else { const int x = nd - 1024; ns = (x >> 6) * 192 + 128 + (x & 63); } }
    const bool ok = nd < N;
    float wv[32];
#pragma unroll
    for (int r = 0; r < 32; ++r) wv[r] = ok ? W[(size_t)(k0 + r * 2 + kq) * N + ns] : 0.f;
#pragma unroll
    for (int r = 0; r < 32; ++r) sT[(r * 2 + kq) * 129 + n] = wv[r];
  }
  __syncthreads();
  {
    const int n = tid >> 1, kq = (tid & 1) * 32;
    u16* dst = Bt + (size_t)(n0 + n) * K + k0 + kq;
#pragma unroll
    for (int q = 0; q < 4; ++q) {
      u32x4 a;
#pragma unroll
      for (int e = 0; e < 4; ++e) a[e] = pack2(sT[(kq + q * 8 + 2 * e) * 129 + n], sT[(kq + q * 8 + 2 * e + 1) * 129 + n]);
      *(u32x4*)(dst + q * 8) = a;
    }
  }
}

DI void norm_rows(const P& p, int layer, bool from_input, int item, const float* gnorm, int shift_idx, int scale_idx) {
  const int tidn = opaque_tid();
  char* const ws = opaque_ptr(as_global(p.ws));
  const int lane = tidn & 63, wid = tidn >> 6;
  const int t = item * 8 + wid * 2;
  const float* x = from_input ? (t < NPROMPT ? GIN(0) + (size_t)t * 1024 : GIN(1) + (size_t)(t - NPROMPT) * 1024) : GOUT + (size_t)t * 1024;
  const float* mods = (const float*)(ws + WS_MODS) + ((size_t)layer * 9 + cond_of(t)) * 6144;
  u16* h = (u16*)(ws + WS_HBUF) + (size_t)t * 1024;
  float4 v[2][4]; float ss0 = 0.f, ss1 = 0.f;
#pragma unroll
  for (int e = 0; e < 4; ++e) { v[0][e] = *(const float4*)(x + e * 256 + lane * 4); v[1][e] = *(const float4*)(x + 1024 + e * 256 + lane * 4); }
#pragma unroll
  for (int e = 0; e < 4; ++e) {
    ss0 += v[0][e].x * v[0][e].x + v[0][e].y * v[0][e].y + v[0][e].z * v[0][e].z + v[0][e].w * v[0][e].w;
    ss1 += v[1][e].x * v[1][e].x + v[1][e].y * v[1][e].y + v[1][e].z * v[1][e].z + v[1][e].w * v[1][e].w;
  }
  ss0 = wave_sum(ss0); ss1 = wave_sum(ss1);
  const float rs0 = rsqrtf(ss0 * (1.f / 1024.f) + EPS), rs1 = rsqrtf(ss1 * (1.f / 1024.f) + EPS);
#pragma unroll
  for (int e = 0; e < 4; ++e) {
    const int c = e * 256 + lane * 4;
    const float4 gv = *(const float4*)(gnorm + c);
    const float4 sc = *(const float4*)(mods + scale_idx * 1024 + c);
    const float4 sh = *(const float4*)(mods + shift_idx * 1024 + c);
    const float m0 = gv.x * (1.f + sc.x), m1 = gv.y * (1.f + sc.y), m2 = gv.z * (1.f + sc.z), m3 = gv.w * (1.f + sc.w);
    st4bf(h + c, v[0][e].x * rs0 * m0 + sh.x, v[0][e].y * rs0 * m1 + sh.y, v[0][e].z * rs0 * m2 + sh.z, v[0][e].w * rs0 * m3 + sh.w);
    st4bf(h + 1024 + c, v[1][e].x * rs1 * m0 + sh.x, v[1][e].y * rs1 * m1 + sh.y, v[1][e].z * rs1 * m2 + sh.z, v[1][e].w * rs1 * m3 + sh.w);
  }
}

template <int DK, int HK>
DI void attn_phase(const u16* __restrict__ Q, const u16* __restrict__ Kb, const u16* __restrict__ Vt, u16* __restrict__ obuf, char* smem_raw) {
  const int bid = opaque_bid();
  constexpr int KS = DK / 32, KSTR = DK, QSTR = 8 * DK, KROW = HK * DK, GRP = 8 / HK;
  constexpr int CPR = DK / 8;
  constexpr int KCH = 64 * CPR / 256;
  u16* sK = (u16*)smem_raw;
  u16* sV = sK + 64 * KSTR;
  const int tid = opaque_tid(), lane = tid & 63, wid = tid >> 6, l15 = lane & 15, g = lane >> 4;
  const float sc = rsqrtf((float)DK) * 1.4426950408889634f;
  for (int item = bid; item < 1280; item += gridDim.x) {
    int qb, h, kvlen, tokbase, kvbase;
    if (item < 1024) { const int b = item >> 7, rem = item & 127; h = rem & 7; qb = rem >> 3; kvlen = 2560; tokbase = NPROMPT + b * 2048; kvbase = NPROMPT + b * 2560; }
    else { const int it2 = item - 1024; const int b = it2 >> 4, rem = it2 & 15; h = rem & 7; qb = rem >> 3; kvlen = 256; tokbase = b * 256; kvbase = b * 256; }
    const int kvh = h / GRP;
    const u16* Kp = Kb + (size_t)kvbase * KROW + kvh * DK;
    const u16* Vp = Vt + (size_t)kvbase * (HK * 128) + (size_t)kvh * 128 * kvlen;
    const int qrow0 = tokbase + qb * 128 + wid * 32;
    bf16x8 qf[2][KS];
#pragma unroll
    for (int qi = 0; qi < 2; ++qi)
#pragma unroll
      for (int ks = 0; ks < KS; ++ks) qf[qi][ks] = ld8(Q + (size_t)(qrow0 + qi * 16 + l15) * QSTR + h * DK + ks * 32 + g * 8);
    f32x4 ot[2][8];
#pragma unroll
    for (int qi = 0; qi < 2; ++qi)
#pragma unroll
      for (int dj = 0; dj < 8; ++dj) { ot[qi][dj][0] = 0.f; ot[qi][dj][1] = 0.f; ot[qi][dj][2] = 0.f; ot[qi][dj][3] = 0.f; }
    float mrun[2] = {-1e30f, -1e30f}, lrun[2] = {0.f, 0.f};
    const int ntiles = kvlen >> 6;
    const unsigned toffK = (unsigned)((tid >> 3) * KROW + (tid & 7) * 8), toffV = (unsigned)((tid >> 3) * kvlen + (tid & 7) * 8);
    const int kx = tid >> 3;
    const int kperm = ((kx >> 2) & 1) * 16 + (kx >> 3) * 4 + (kx & 3);
    const int kswz = (CPR == 16) ? (kperm & 15) : ((kperm >> 1) & 7);
    const int ldsoffK = kperm * KSTR;
    const int ldsoffV = (tid >> 3) * 64 + (((tid & 7) ^ (((tid >> 3) >> 1) & 7)) * 8);
    u32x4 rk[KCH], rv[4];
#pragma unroll
    for (int i = 0; i < KCH; ++i) { const int rh = i & 1, cgp = i >> 1; rk[i] = *(const u32x4*)(Kp + (size_t)(rh * 32 * KROW + cgp * 64) + toffK); }
#pragma unroll
    for (int i = 0; i < 4; ++i) rv[i] = *(const u32x4*)(Vp + (size_t)i * 32 * kvlen + toffV);
    for (int kt = 0; kt < ntiles; ++kt) {
      const u16* Kt = Kp + (size_t)(kt + 1) * 64 * KROW;
      const u16* Vtp = Vp + (kt + 1) * 64;
      const bool more = kt + 1 < ntiles;
      __syncthreads();
#pragma unroll
      for (int i = 0; i < KCH; ++i) { const int rh = i & 1, cgp = i >> 1; const int c = (tid & 7) + 8 * cgp; const int pos = (CPR == 16) ? (c ^ kswz) : ((c & ~7) | ((c & 7) ^ kswz)); *(u32x4*)(sK + ldsoffK + rh * 32 * KSTR + pos * 8) = rk[i]; }
#pragma unroll
      for (int i = 0; i < 4; ++i) *(u32x4*)(sV + ldsoffV + i * 32 * 64) = rv[i];
      __syncthreads();
      if (more) {
#pragma unroll
        for (int i = 0; i < KCH; ++i) { const int rh = i & 1, cgp = i >> 1; rk[i] = *(const u32x4*)(Kt + (size_t)(rh * 32 * KROW + cgp * 64) + toffK); }
      }
      __builtin_amdgcn_sched_barrier(0);
      f32x4 st[2][4];
#pragma unroll
      for (int qi = 0; qi < 2; ++qi)
#pragma unroll
        for (int kj = 0; kj < 4; ++kj) { st[qi][kj][0] = 0.f; st[qi][kj][1] = 0.f; st[qi][kj][2] = 0.f; st[qi][kj][3] = 0.f; }
#pragma unroll
      for (int ks = 0; ks < KS; ++ks) {
#pragma unroll
        for (int kj = 0; kj < 4; ++kj) {
          const int kc = ks * 4 + g;
          const int kpos = (CPR == 16) ? (kc ^ l15) : ((kc & ~7) | ((kc & 7) ^ ((l15 >> 1) & 7)));
          const bf16x8 ka = ld8(sK + (kj * 16 + l15) * KSTR + kpos * 8);
          __builtin_amdgcn_s_setprio(1);
          st[0][kj] = mma(ka, qf[0][ks], st[0][kj]);
          st[1][kj] = mma(ka, qf[1][ks], st[1][kj]);
          __builtin_amdgcn_s_setprio(0);
        }
        __builtin_amdgcn_sched_barrier(0);
      }
      bf16x8 pf[2][2];
#pragma unroll
      for (int qi = 0; qi < 2; ++qi) {
        float mx = -1e30f;
#pragma unroll
        for (int kj = 0; kj < 4; ++kj)
#pragma unroll
          for (int r = 0; r < 4; ++r) mx = fmaxf(mx, st[qi][kj][r]);
        mx = fmaxf(mx, __shfl_xor(mx, 16)); mx = fmaxf(mx, __shfl_xor(mx, 32));
        const float mnew = fmaxf(mrun[qi], mx);
        const float alpha = __builtin_amdgcn_exp2f((mrun[qi] - mnew) * sc);
        mrun[qi] = mnew;
        float ps = 0.f;
        const float mneg = -mnew * sc;
#pragma unroll
        for (int kj = 0; kj < 4; ++kj)
#pragma unroll
          for (int r = 0; r < 4; ++r) { const float pv = __builtin_amdgcn_exp2f(fmaf(st[qi][kj][r], sc, mneg)); st[qi][kj][r] = pv; ps += pv; }
        lrun[qi] = lrun[qi] * alpha + ps;
#pragma unroll
        for (int dj = 0; dj < 8; ++dj) { ot[qi][dj][0] *= alpha; ot[qi][dj][1] *= alpha; ot[qi][dj][2] *= alpha; ot[qi][dj][3] *= alpha; }
        pf[qi][0] = pack8(st[qi][0], st[qi][1]);
        pf[qi][1] = pack8(st[qi][2], st[qi][3]);
        __builtin_amdgcn_sched_barrier(0);
      }
      if (more) {
#pragma unroll
        for (int i = 0; i < 4; ++i) rv[i] = *(const u32x4*)(Vtp + (size_t)i * 32 * kvlen + toffV);
      }
      __builtin_amdgcn_sched_barrier(0);
#pragma unroll
      for (int kk = 0; kk < 2; ++kk)
#pragma unroll
        for (int dj = 0; dj < 8; ++dj) {
          const bf16x8 va = ld8(sV + (dj * 16 + l15) * 64 + (((kk * 4 + g) ^ ((l15 >> 1) & 7)) * 8));
          __builtin_amdgcn_s_setprio(1);
          ot[0][dj] = mma(va, pf[0][kk], ot[0][dj]);
          ot[1][dj] = mma(va, pf[1][kk], ot[1][dj]);
          __builtin_amdgcn_s_setprio(0);
          if ((dj & 3) == 3) __builtin_amdgcn_sched_barrier(0);
        }
    }
#pragma unroll
    for (int qi = 0; qi < 2; ++qi) {
      const float inv = 1.f / sum_g(lrun[qi]);
      u16* dst = obuf + (size_t)(qrow0 + qi * 16 + l15) * 1024 + h * 128 + g * 4;
#pragma unroll
      for (int dj = 0; dj < 8; ++dj) st4bf(dst + dj * 16, ot[qi][dj][0] * inv, ot[qi][dj][1] * inv, ot[qi][dj][2] * inv, ot[qi][dj][3] * inv);
    }
  }
}

DI void gdn_chunk_phase(const P& p, int j, char* smem_raw) {
  const int bid = opaque_bid();
  char* const ws = opaque_ptr(as_global(p.ws));
  u16* sK = (u16*)smem_raw;
  float* sA = (float*)(smem_raw + 17408);
  float* sG = (float*)(smem_raw + 17408 + 32768);
  float* sBt = sG + 128;
  const int tid = opaque_tid(), lane = tid & 63, wid = tid >> 6, l15 = lane & 15, g = lane >> 4;
  const u16* proj = (const u16*)(ws + WS_R + R_PROJ);
  u16* qn = (u16*)(ws + WS_HBUF); u16* kn = (u16*)(ws + WS_OBUF); u16* vb = (u16*)(ws + WS_R + R_VBUF);
  u16* Tbuf = (u16*)(ws + WS_R + R_TBUF);
  const float* gbuf = (const float*)(ws + WS_R + R_GBUF);
  float* gcb = (float*)(ws + WS_R + R_GCB); float* betab = (float*)(ws + WS_R + R_BETA);
  float* egb = (float*)(ws + WS_R + R_EG); float* edb = (float*)(ws + WS_R + R_ED);
  const float* conv = GIN(17) + (size_t)j * 3 * 3072;
  const float* a_log = GIN(18) + j * 16; const float* dt_bias = GIN(19) + j * 16;
  for (int unit = bid; unit < 2560; unit += gridDim.x) {
    const int cgi = unit >> 3, h = unit & 7;
    int c, nch; if (cgi < 64) { c = cgi & 3; nch = 4; } else { c = (cgi - 64) & 31; nch = 32; }
    const int t0 = cgi * 64;
    const bool has_prev = c > 0, has_next = c < nch - 1;
    __syncthreads();
    {
      const int r = tid >> 4, cc = (tid & 15) * 8;
#pragma unroll
      for (int part = 0; part < 3; ++part) {
        const int ch = part * 1024 + h * 128 + cc;
        float w0[8], w1[8], w2[8];
#pragma unroll
        for (int e = 0; e < 8; ++e) { w0[e] = conv[ch + e]; w1[e] = conv[3072 + ch + e]; w2[e] = conv[6144 + ch + e]; }
        u16* dstb = part == 0 ? qn : (part == 1 ? kn : vb);
        for (int it = 0; it < 4; ++it) {
          const int i = it * 16 + r, t = t0 + i;
          const u16* src = proj + (size_t)t * 4096 + ch;
          const u32x4 xc = *(const u32x4*)src;
          u32x4 xp = {0u, 0u, 0u, 0u}, xn = {0u, 0u, 0u, 0u};
          if (i > 0 || has_prev) xp = *(const u32x4*)(src - 4096);
          if (i < 63 || has_next) xn = *(const u32x4*)(src + 4096);
          float y[8];
#pragma unroll
          for (int e = 0; e < 4; ++e) {
            float a = w0[2 * e] * bflo(xp[e]) + w1[2 * e] * bflo(xc[e]) + w2[2 * e] * bflo(xn[e]);
            float b = w0[2 * e + 1] * bfhi(xp[e]) + w1[2 * e + 1] * bfhi(xc[e]) + w2[2 * e + 1] * bfhi(xn[e]);
            y[2 * e] = a / (1.f + __expf(-a)); y[2 * e + 1] = b / (1.f + __expf(-b));
          }
          if (part < 2) {
            float ss = 0.f;
#pragma unroll
            for (int e = 0; e < 8; ++e) ss += y[e] * y[e];
            ss += __shfl_xor(ss, 1); ss += __shfl_xor(ss, 2); ss += __shfl_xor(ss, 4); ss += __shfl_xor(ss, 8);
            const float rs = rsqrtf(ss + EPS) * (part == 0 ? 0.08838834764831845f : 1.f);
#pragma unroll
            for (int e = 0; e < 8; ++e) y[e] *= rs;
          }
          u32x4 o; o[0] = pack2(y[0], y[1]); o[1] = pack2(y[2], y[3]); o[2] = pack2(y[4], y[5]); o[3] = pack2(y[6], y[7]);
          *(u32x4*)(dstb + (size_t)t * 1024 + h * 128 + cc) = o;
          if (part == 1) *(u32x4*)(sK + i * 136 + cc) = o;
        }
      }
    }
    if (tid < 128) {
      const int dir = tid >> 6, L = tid & 63;
      const int i = dir ? 63 - L : L;
      const float* gb = gbuf + (size_t)(t0 + i) * 32;
      const float gin = gb[dir * 8 + h], bin = gb[16 + dir * 8 + h];
      const float x = gin + dt_bias[dir * 8 + h];
      const float sp = fmaxf(x, 0.f) + log1pf(expf(-fabsf(x)));
      float gv = -expf(a_log[dir * 8 + h]) * sp;
      const float bt = 1.f / (1.f + expf(-bin));
#pragma unroll
      for (int off = 1; off < 64; off <<= 1) { const float v = __shfl_up(gv, off); if (L >= off) gv += v; }
      sG[dir * 64 + i] = gv; sBt[dir * 64 + i] = bt;
      gcb[((size_t)(t0 + i) * 8 + h) * 2 + dir] = gv; betab[((size_t)(t0 + i) * 8 + h) * 2 + dir] = bt;
      { const float gtot = __shfl(gv, 63); egb[((size_t)(t0 + i) * 8 + h) * 2 + dir] = expf(gv); edb[((size_t)(t0 + i) * 8 + h) * 2 + dir] = expf(gtot - gv); }
    }
    __syncthreads();
    {
      f32x4 ga[4];
#pragma unroll
      for (int mt = 0; mt < 4; ++mt) { ga[mt][0] = 0.f; ga[mt][1] = 0.f; ga[mt][2] = 0.f; ga[mt][3] = 0.f; }
#pragma unroll
      for (int ks = 0; ks < 4; ++ks) {
        const bf16x8 a = ld8(sK + (wid * 16 + l15) * 136 + ks * 32 + g * 8);
#pragma unroll
        for (int mt = 0; mt < 4; ++mt) { const bf16x8 b = ld8(sK + (mt * 16 + l15) * 136 + ks * 32 + g * 8); ga[mt] = mma(a, b, ga[mt]); }
      }
#pragma unroll
      for (int dir = 0; dir < 2; ++dir)
#pragma unroll
        for (int mt = 0; mt < 4; ++mt)
#pragma unroll
          for (int r = 0; r < 4; ++r) {
            const int i = wid * 16 + g * 4 + r, m = mt * 16 + l15;
            const bool valid = dir ? (i < m) : (i > m);
            const float val = valid ? sBt[dir * 64 + i] * ga[mt][r] * __expf(sG[dir * 64 + i] - sG[dir * 64 + m]) : 0.f;
            const int ii = dir ? 63 - i : i, mm = dir ? 63 - m : m;
            sA[dir * 4096 + ii * 64 + mm] = val;
          }
    }
    __syncthreads();
    if (wid < 2) {
      const int dir = wid;
      float* Am = sA + dir * 4096;
#pragma unroll
      for (int b = 0; b < 8; ++b) {
#pragma unroll 1
        for (int r = 0; r < 8; ++r) {
          const int i = b * 8 + r;
          float4 av[16]; float tv[64];
#pragma unroll
          for (int c = 0; c < 8; ++c) if (c <= b) {
            av[2 * c] = *(const float4*)(Am + i * 64 + c * 8); av[2 * c + 1] = *(const float4*)(Am + i * 64 + c * 8 + 4);
#pragma unroll
            for (int e = 0; e < 8; ++e) tv[c * 8 + e] = Am[(c * 8 + e) * 64 + lane];
          }
          float a = (i == lane) ? 1.f : 0.f, a2 = 0.f;
#pragma unroll
          for (int c = 0; c < 8; ++c) if (c <= b) {
            a -= av[2 * c].x * tv[c * 8]; a2 -= av[2 * c].y * tv[c * 8 + 1]; a -= av[2 * c].z * tv[c * 8 + 2]; a2 -= av[2 * c].w * tv[c * 8 + 3];
            a -= av[2 * c + 1].x * tv[c * 8 + 4]; a2 -= av[2 * c + 1].y * tv[c * 8 + 5]; a -= av[2 * c + 1].z * tv[c * 8 + 6]; a2 -= av[2 * c + 1].w * tv[c * 8 + 7];
          }
          Am[i * 64 + lane] = a + a2;
        }
      }
      const int mn = dir ? 63 - lane : lane;
      const float bm = sBt[dir * 64 + mn];
      u16* Td = Tbuf + ((size_t)unit * 2 + dir) * 4096;
#pragma unroll 4
      for (int i = 0; i < 64; ++i) { const int in_ = dir ? 63 - i : i; Td[in_ * 64 + mn] = f2bf(Am[i * 64 + lane] * bm); }
    }
  }
}

DI void gdn_scan_phase(const P& p, int j, char* smem_raw) {
  const int bid = opaque_bid();
  char* const ws = opaque_ptr(as_global(p.ws));
  u16* sK = (u16*)smem_raw;
  u16* sV = sK + 64 * 136;
  u16* sST = sV + 64 * 40;
  u16* sVN = sST + 32 * 136;
  u16* sVD = sVN + 32 * 72;
  float* sGc = (float*)(sVD + 32 * 72);
  float* sE = sGc + 64;
  float* sD = sE + 64;
  const int tid = opaque_tid(), lane = tid & 63, w = tid >> 6, l15 = lane & 15, g = lane >> 4;
  const u16* qn = (const u16*)(ws + WS_HBUF); const u16* kn = (const u16*)(ws + WS_OBUF); const u16* vb = (const u16*)(ws + WS_R + R_VBUF);
  const u16* Tbuf = (const u16*)(ws + WS_R + R_TBUF);
  const float* gcb = (const float*)(ws + WS_R + R_GCB);
  const float* egb = (const float*)(ws + WS_R + R_EG); const float* edb = (const float*)(ws + WS_R + R_ED);
  u16* obase = (u16*)(ws + WS_R + R_PROJ);
  for (int wk = bid; wk < 1536; wk += gridDim.x) {
    int seq, rem;
    if (wk < 512) { seq = 16 + (wk >> 6); rem = wk & 63; } else { seq = (wk - 512) >> 6; rem = (wk - 512) & 63; }
    const int h = rem & 7, dir = (rem >> 5) & 1, dvq = (rem >> 3) & 3;
    const int nch = seq < 16 ? 4 : 32;
    const int cgb = seq < 16 ? seq * 4 : 64 + (seq - 16) * 32;
    f32x4 S[2][2];
    if (seq >= 16) {
      const float* s0 = GIN(2 + dir) + (((size_t)(seq - 16) * 2 + j) * 8 + h) * 16384;
#pragma unroll
      for (int dt = 0; dt < 2; ++dt)
#pragma unroll
        for (int et = 0; et < 2; ++et)
#pragma unroll
          for (int r = 0; r < 4; ++r) S[dt][et][r] = s0[(size_t)(w * 32 + dt * 16 + g * 4 + r) * 128 + dvq * 32 + et * 16 + l15];
    } else {
#pragma unroll
      for (int dt = 0; dt < 2; ++dt)
#pragma unroll
        for (int et = 0; et < 2; ++et) { S[dt][et][0] = 0.f; S[dt][et][1] = 0.f; S[dt][et][2] = 0.f; S[dt][et][3] = 0.f; }
    }
    __syncthreads();
#pragma unroll
    for (int dt = 0; dt < 2; ++dt)
#pragma unroll
      for (int et = 0; et < 2; ++et) st4bf(sST + (et * 16 + l15) * 136 + w * 32 + dt * 16 + g * 4, S[dt][et][0], S[dt][et][1], S[dt][et][2], S[dt][et][3]);
    u32x4 pk[4], pv; float pg = 0.f, pe = 0.f, pd = 0.f;
#define SCAN_PREFETCH(cc) do { \
      const int t0n_ = (cgb + (cc)) * 64; \
      _Pragma("unroll") for (int i = 0; i < 4; ++i) { const int ci = tid + 256 * i; const int row = ci >> 4, dc = (ci & 15) * 8; pk[i] = *(const u32x4*)(kn + (size_t)(t0n_ + row) * 1024 + h * 128 + dc); } \
      { const int row = tid >> 2, ec = (tid & 3) * 8; pv = *(const u32x4*)(vb + (size_t)(t0n_ + row) * 1024 + h * 128 + dvq * 32 + ec); } \
      if (tid < 64) { const size_t gi_ = ((size_t)(t0n_ + tid) * 8 + h) * 2 + dir; pg = gcb[gi_]; pe = egb[gi_]; pd = edb[gi_]; } \
    } while (0)
    SCAN_PREFETCH(dir ? nch - 1 : 0);
    bf16x8 qf[4], tf[2];
    {
      const int c0_ = dir ? nch - 1 : 0;
#pragma unroll
      for (int ks = 0; ks < 4; ++ks) qf[ks] = ld8(qn + (size_t)((cgb + c0_) * 64 + w * 16 + l15) * 1024 + h * 128 + ks * 32 + g * 8);
#pragma unroll
      for (int ks = 0; ks < 2; ++ks) tf[ks] = ld8(Tbuf + ((size_t)((cgb + c0_) * 8 + h) * 2 + dir) * 4096 + (w * 16 + l15) * 64 + ks * 32 + g * 8);
    }
    for (int step = 0; step < nch; ++step) {
      const int cnx = (step + 1 < nch) ? (dir ? nch - 2 - step : step + 1) : (dir ? nch - 1 - step : step);
      const int c = dir ? nch - 1 - step : step;
      const int t0 = (cgb + c) * 64;
      const int unit = (cgb + c) * 8 + h;
#pragma unroll
      for (int i = 0; i < 4; ++i) {
        const int ci = tid + 256 * i; const int row = ci >> 4, dc = (ci & 15) * 8;
        *(u32x4*)(sK + row * 136 + dc) = pk[i];
      }
      { const int row = tid >> 2, ec = (tid & 3) * 8; *(u32x4*)(sV + row * 40 + ec) = pv; }
      if (tid < 64) { sGc[tid] = pg; sE[tid] = pe; sD[tid] = pd; }
      __syncthreads();
      if (step + 1 < nch) { const int cn = dir ? nch - 2 - step : step + 1; SCAN_PREFETCH(cn); }
      const float gl = dir ? sGc[0] : sGc[63];
      bf16x8 wf[4];
      f32x4 ua[2];
      {
        bf16x8 vtf[2][2];
        f32x4 egm[2][2];
#pragma unroll
        for (int et = 0; et < 2; ++et)
#pragma unroll
          for (int ks = 0; ks < 2; ++ks) vtf[et][ks] = ldtr(sV + (ks * 32 + g * 8 + (l15 >> 2)) * 40 + et * 16 + (l15 & 3) * 4, 4 * 40);
#pragma unroll
        for (int ks = 0; ks < 2; ++ks) { egm[ks][0] = *(const f32x4*)(sE + ks * 32 + g * 8); egm[ks][1] = *(const f32x4*)(sE + ks * 32 + g * 8 + 4); }
        __builtin_amdgcn_sched_barrier(0);
#pragma unroll
        for (int et = 0; et < 2; ++et) {
          ua[et][0] = 0.f; ua[et][1] = 0.f; ua[et][2] = 0.f; ua[et][3] = 0.f;
#pragma unroll
          for (int ks = 0; ks < 2; ++ks) ua[et] = mma(tf[ks], vtf[et][ks], ua[et]);
        }
#pragma unroll
        for (int ks = 0; ks < 2; ++ks) {
          const u32x4 tw = __builtin_bit_cast(u32x4, tf[ks]);
          u32x4 o;
#pragma unroll
          for (int e = 0; e < 4; ++e) o[e] = pack2(bflo(tw[e]) * egm[ks][e >> 1][(2 * e) & 3], bfhi(tw[e]) * egm[ks][e >> 1][(2 * e + 1) & 3]);
          tf[ks] = __builtin_bit_cast(bf16x8, o);
        }
        __builtin_amdgcn_sched_barrier(0);
      }
#pragma unroll
      for (int kq = 0; kq < 4; ++kq) {
        bf16x8 ktf[2][2];
#pragma unroll
        for (int hh = 0; hh < 2; ++hh)
#pragma unroll
          for (int ks = 0; ks < 2; ++ks) ktf[hh][ks] = ldtr(sK + (ks * 32 + g * 8 + (l15 >> 2)) * 136 + (kq * 2 + hh) * 16 + (l15 & 3) * 4, 4 * 136);
        __builtin_amdgcn_sched_barrier(0);
        f32x4 wa[2];
#pragma unroll
        for (int hh = 0; hh < 2; ++hh) {
          wa[hh][0] = 0.f; wa[hh][1] = 0.f; wa[hh][2] = 0.f; wa[hh][3] = 0.f;
#pragma unroll
          for (int ks = 0; ks < 2; ++ks) wa[hh] = mma(ktf[hh][ks], tf[ks], wa[hh]);
        }
        wf[kq] = pack8(wa[0], wa[1]);
        __builtin_amdgcn_sched_barrier(0);
      }
#pragma unroll
      for (int ks = 0; ks < 2; ++ks) tf[ks] = ld8(Tbuf + ((size_t)((cgb + cnx) * 8 + h) * 2 + dir) * 4096 + (w * 16 + l15) * 64 + ks * 32 + g * 8);
      const int iq = w * 16 + l15;
      const float gi = sGc[iq];
      const f32x4 dvec = *(const f32x4*)(sD + w * 16 + g * 4);
      f32x4 vn[2];
      bf16x8 qkf[2];
      {
        bf16x8 stp[2][4];
#pragma unroll
        for (int et = 0; et < 2; ++et)
#pragma unroll
          for (int kq = 0; kq < 4; ++kq) { const u16* sp = sST + (et * 16 + l15) * 136 + kq * 32 + g * 4; stp[et][kq] = ld44(sp, sp + 16); }
        __builtin_amdgcn_sched_barrier(0);
#pragma unroll
        for (int et = 0; et < 2; ++et) {
          f32x4 a; a[0] = 0.f; a[1] = 0.f; a[2] = 0.f; a[3] = 0.f;
#pragma unroll
          for (int kq = 0; kq < 4; ++kq) a = mma(wf[kq], stp[et][kq], a);
          vn[et][0] = ua[et][0] - a[0]; vn[et][1] = ua[et][1] - a[1]; vn[et][2] = ua[et][2] - a[2]; vn[et][3] = ua[et][3] - a[3];
        }
        __builtin_amdgcn_sched_barrier(0);
      }
#pragma unroll
      for (int kk = 0; kk < 2; ++kk) {
        bf16x8 kf[2][4];
        f32x4 gcm[2];
#pragma unroll
        for (int hh = 0; hh < 2; ++hh)
#pragma unroll
          for (int ks = 0; ks < 4; ++ks) kf[hh][ks] = ld8(sK + ((kk * 2 + hh) * 16 + l15) * 136 + ks * 32 + g * 8);
#pragma unroll
        for (int hh = 0; hh < 2; ++hh) gcm[hh] = *(const f32x4*)(sGc + (kk * 2 + hh) * 16 + g * 4);
        __builtin_amdgcn_sched_barrier(0);
        f32x4 ka[2];
#pragma unroll
        for (int hh = 0; hh < 2; ++hh) {
          const int mt = kk * 2 + hh;
          ka[hh][0] = 0.f; ka[hh][1] = 0.f; ka[hh][2] = 0.f; ka[hh][3] = 0.f;
#pragma unroll
          for (int ks = 0; ks < 4; ++ks) ka[hh] = mma(kf[hh][ks], qf[ks], ka[hh]);
#pragma unroll
          for (int r = 0; r < 4; ++r) {
            const int m = mt * 16 + g * 4 + r;
            const bool valid = dir ? (iq <= m) : (iq >= m);
            ka[hh][r] = ka[hh][r] * __expf(valid ? gi - gcm[hh][r] : -1e30f);
          }
        }
        qkf[kk] = pack8(ka[0], ka[1]);
        __builtin_amdgcn_sched_barrier(0);
      }
#pragma unroll
      for (int et = 0; et < 2; ++et) {
        const int i0 = w * 16 + g * 4;
        st4bf(sVN + (et * 16 + l15) * 72 + i0, vn[et][0], vn[et][1], vn[et][2], vn[et][3]);
        st4bf(sVD + (et * 16 + l15) * 72 + i0, vn[et][0] * dvec[0], vn[et][1] * dvec[1], vn[et][2] * dvec[2], vn[et][3] * dvec[3]);
      }
      __syncthreads();
      {
        bf16x8 stn[2][4], vnp[2][2];
#pragma unroll
        for (int et = 0; et < 2; ++et)
#pragma unroll
          for (int ks = 0; ks < 4; ++ks) stn[et][ks] = ld8(sST + (et * 16 + l15) * 136 + ks * 32 + g * 8);
#pragma unroll
        for (int et = 0; et < 2; ++et)
#pragma unroll
          for (int kk = 0; kk < 2; ++kk) { const u16* sp = sVN + (et * 16 + l15) * 72 + kk * 32 + g * 4; vnp[et][kk] = ld44(sp, sp + 16); }
        const f32x4 egi = *(const f32x4*)(sE + w * 16 + g * 4);
        __builtin_amdgcn_sched_barrier(0);
#pragma unroll
        for (int et = 0; et < 2; ++et) {
          f32x4 a1; a1[0] = 0.f; a1[1] = 0.f; a1[2] = 0.f; a1[3] = 0.f;
#pragma unroll
          for (int ks = 0; ks < 4; ++ks) a1 = mma(qf[ks], stn[et][ks], a1);
          f32x4 a2; a2[0] = 0.f; a2[1] = 0.f; a2[2] = 0.f; a2[3] = 0.f;
#pragma unroll
          for (int kk = 0; kk < 2; ++kk) a2 = mma(qkf[kk], vnp[et][kk], a2);
#pragma unroll
          for (int r = 0; r < 4; ++r) {
            const int i = w * 16 + g * 4 + r;
            const float o = a1[r] * egi[r] + a2[r];
            obase[(size_t)(t0 + i) * 4096 + dir * 1024 + h * 128 + dvq * 32 + et * 16 + l15] = f2bf(o);
          }
        }
#pragma unroll
        for (int ks = 0; ks < 4; ++ks) qf[ks] = ld8(qn + (size_t)((cgb + cnx) * 64 + w * 16 + l15) * 1024 + h * 128 + ks * 32 + g * 8);
        __builtin_amdgcn_sched_barrier(0);
      }
      {
        bf16x8 ktf2[2][2], vdf[2][2];
#pragma unroll
        for (int dt = 0; dt < 2; ++dt)
#pragma unroll
          for (int kk = 0; kk < 2; ++kk) { ktf2[dt][kk] = ldtr(sK + (kk * 32 + g * 8 + (l15 >> 2)) * 136 + w * 32 + dt * 16 + (l15 & 3) * 4, 4 * 136); vdf[dt][kk] = ld8(sVD + (dt * 16 + l15) * 72 + kk * 32 + g * 8); }
        __builtin_amdgcn_sched_barrier(0);
        const float eg = __expf(gl);
#pragma unroll
        for (int dt = 0; dt < 2; ++dt)
#pragma unroll
          for (int et = 0; et < 2; ++et) {
            f32x4 a; a[0] = S[dt][et][0] * eg; a[1] = S[dt][et][1] * eg; a[2] = S[dt][et][2] * eg; a[3] = S[dt][et][3] * eg;
#pragma unroll
            for (int kk = 0; kk < 2; ++kk) a = mma(ktf2[dt][kk], vdf[et][kk], a);
            S[dt][et] = a;
          }
      }
      __syncthreads();
#pragma unroll
      for (int dt = 0; dt < 2; ++dt)
#pragma unroll
        for (int et = 0; et < 2; ++et) st4bf(sST + (et * 16 + l15) * 136 + w * 32 + dt * 16 + g * 4, S[dt][et][0], S[dt][et][1], S[dt][et][2], S[dt][et][3]);
    }
    if (seq < 16) {
      float* so = GOUT + (dir ? O_SB : O_SF) + (((size_t)seq * 2 + j) * 8 + h) * 16384;
#pragma unroll
      for (int dt = 0; dt < 2; ++dt)
#pragma unroll
        for (int et = 0; et < 2; ++et)
#pragma unroll
          for (int r = 0; r < 4; ++r) so[(size_t)(w * 32 + dt * 16 + g * 4 + r) * 128 + dvq * 32 + et * 16 + l15] = S[dt][et][r];
    }
  }
}

#define XB_TMO      128
#define XB_XCNT(j)  (256  + 64 * (j))
#define XB_XSUB(j)  (1280 + 64 * (j))
#define XB_XGEN(j)  (2304 + 64 * (j))
#define XB_TOP      3328
#define XB_TOPGEN   3392
#define XCD_BAR_WORDS 3456
#define XB_SPIN_CAP (1u << 20)
#define LAS __attribute__((address_space(3)))
DI unsigned xb_ld(unsigned* p)              { return __hip_atomic_load(p, __ATOMIC_RELAXED, __HIP_MEMORY_SCOPE_AGENT); }
DI unsigned xb_add(unsigned* p, unsigned v) { return __hip_atomic_fetch_add(p, v, __ATOMIC_RELAXED, __HIP_MEMORY_SCOPE_AGENT); }
DI unsigned xb_xcc_id() { return (unsigned)__builtin_amdgcn_s_getreg((3 << 11) | 20) & 0xFu; }
#define XB_SPIN(cond, bar) do { unsigned _sp = 0; while (cond) { __builtin_amdgcn_s_sleep(1); \
    if ((++_sp & 255u) == 0u) { if (xb_ld(&(bar)[XB_TMO])) break; if (_sp > XB_SPIN_CAP) { atomicAdd(&(bar)[XB_TMO], 1u); break; } } } } while (0)
struct XcdBarrier { unsigned* bar; unsigned x; volatile LAS unsigned* st; };
DI XcdBarrier xcd_barrier_post(unsigned* bar, volatile LAS unsigned* st) {
  XcdBarrier b; b.bar = bar; b.x = xb_xcc_id(); b.st = st;
  if (threadIdx.x == 0) (void)xb_add(&bar[XB_XCNT(b.x)], 1u);
  return b;
}
DI void xcd_barrier_complete(unsigned* bar, unsigned x, unsigned& nloc, unsigned& nx) {
  const unsigned Gn = gridDim.x * gridDim.y * gridDim.z;
  unsigned sum, cnt, mine, sp = 0u;
  for (;;) {
    sum = 0u; cnt = 0u; mine = 0u;
#pragma unroll
    for (unsigned j = 0; j < 16; ++j) { const unsigned c = xb_ld(&bar[XB_XCNT(j)]); sum += c; cnt += (c > 0u) ? 1u : 0u; mine = (j == x) ? c : mine; }
    if (sum == Gn) break;
    __builtin_amdgcn_s_sleep(1);
    if ((++sp & 255u) == 0u) { if (xb_ld(&bar[XB_TMO])) break; if (sp > XB_SPIN_CAP) { atomicAdd(&bar[XB_TMO], 1u); break; } }
  }
  nloc = mine > 0u ? mine : 1u; nx = cnt > 0u ? cnt : 1u;
}
DI void xcd_barrier(const XcdBarrier& b) {
  asm volatile("s_waitcnt vmcnt(0)" ::: "memory");
  __syncthreads();
  if (threadIdx.x == 0) {
    unsigned* bar = b.bar;
    __builtin_amdgcn_s_waitcnt(0);
    unsigned nloc = b.st[0], nx = b.st[1];
    if (nloc == 0u) { xcd_barrier_complete(bar, b.x, nloc, nx); b.st[0] = nloc; b.st[1] = nx; }
    const unsigned old = xb_add(&bar[XB_XSUB(b.x)], 1u);
    const unsigned gen = old / nloc;
    if (old + 1u == (gen + 1u) * nloc) {
      __builtin_amdgcn_fence(__ATOMIC_RELEASE, "agent");
      asm volatile("s_waitcnt vmcnt(0)" ::: "memory");
      const unsigned og = xb_add(&bar[XB_TOP], 1u);
      const unsigned tg = og / nx;
      if (og + 1u == (tg + 1u) * nx) xb_add(&bar[XB_TOPGEN], 1u);
      else XB_SPIN(xb_ld(&bar[XB_TOPGEN]) == tg, bar);
      __builtin_amdgcn_fence(__ATOMIC_ACQUIRE, "agent");
      xb_add(&bar[XB_XGEN(b.x)], 1u);
      asm volatile("s_waitcnt vmcnt(0)" ::: "memory");
    } else {
      XB_SPIN(xb_ld(&bar[XB_XGEN(b.x)]) == gen, bar);
      __builtin_amdgcn_fence(__ATOMIC_ACQUIRE, "agent");
      asm volatile("s_waitcnt vmcnt(0)" ::: "memory");
    }
  }
  __syncthreads();
}

__global__ void __launch_bounds__(256, 2) fwd_megakernel(P p) {
  cg::grid_group grid = cg::this_grid();
  __shared__ __attribute__((aligned(16))) char smem[60416];
  const int tid = opaque_tid(), lane = tid & 63, wid = tid >> 6;
  const int G = gridDim.x;
  __shared__ uint4 xb_words;
  if (threadIdx.x == 0) xb_words = make_uint4(0u, 0u, 0u, 0u);
  __syncthreads();
  (void)xcd_barrier_post((unsigned*)(as_global(p.ws) + WS_BAR), (volatile LAS unsigned*)&xb_words);
#define GSYNC() do { XcdBarrier xb_; xb_.bar = (unsigned*)(opaque_ptr(as_global(p.ws)) + WS_BAR); xb_.x = xb_xcc_id(); xb_.st = (volatile LAS unsigned*)&xb_words; xcd_barrier(xb_); } while (0)
  const int bid0 = opaque_bid();
  {
  char* const ws0 = opaque_ptr(as_global(p.ws));
  float* mods = (float*)(ws0 + WS_MODS);
  float* ropeT = (float*)(ws0 + WS_ROPE);
  float* cosG = ropeT, *sinG = ropeT + 2048, *cosM = ropeT + 4096, *sinM = ropeT + 5120;

  {
    float* sc = (float*)smem;
    float* red = sc + 9 * 128;
    float* part = (float*)(ws0 + WS_R);
    for (int item = bid0; item < 3072; item += G) {
      const int ks = item & 7, cgp = (item >> 3) % 96, layer = item / 768;
      __syncthreads();
      for (int e = tid; e < 9 * 128; e += 256) {
        const int ci = e >> 7, k = ks * 128 + (e & 127);
        const float v = ci == 0 ? GIN(9)[k] : GIN(8)[(ci - 1) * 1024 + k];
        sc[e] = v / (1.f + expf(-v));
      }
      __syncthreads();
      const int col = tid & 63, kg = tid >> 6;
      const float* wp = GIN(12) + ((size_t)layer * 1024 + ks * 128 + kg * 32) * 6144 + cgp * 64 + col;
      float acc[9];
#pragma unroll
      for (int ci = 0; ci < 9; ++ci) acc[ci] = 0.f;
      float wvv[32];
#pragma unroll
      for (int kk = 0; kk < 32; ++kk) wvv[kk] = wp[(size_t)kk * 6144];
#pragma unroll
      for (int kk = 0; kk < 32; ++kk) {
#pragma unroll
        for (int ci = 0; ci < 9; ++ci) acc[ci] += sc[ci * 128 + kg * 32 + kk] * wvv[kk];
      }
#pragma unroll
      for (int ci = 0; ci < 9; ++ci) red[(kg * 64 + col) * 9 + ci] = acc[ci];
      __syncthreads();
      if (kg == 0) {
        const int n = cgp * 64 + col;
        const float bias = ks == 0 ? GIN(13)[(size_t)layer * 6144 + n] : 0.f;
#pragma unroll
        for (int ci = 0; ci < 9; ++ci) {
          const float s = red[col * 9 + ci] + red[(64 + col) * 9 + ci] + red[(128 + col) * 9 + ci] + red[(192 + col) * 9 + ci] + bias;
          part[(size_t)ks * 221184 + ((size_t)layer * 9 + ci) * 6144 + n] = s;
        }
      }
    }
    if (bid0 == G - 1) {
      for (int e = tid; e < 2048; e += 256) { const int pos = e >> 5, f = e & 31; const float fr = powf(10000.f, -(float)f / 32.f); const float a = (float)pos * fr; cosG[e] = cosf(a); sinG[e] = sinf(a); }
      for (int e = tid; e < 1024; e += 256) { const int pos = e >> 4, f = e & 15; const float fr = powf(10000.f, -(float)f / 16.f); const float a = (float)pos * fr; cosM[e] = cosf(a); sinM[e] = sinf(a); }
    }
  }
  if (gridDim.x == 0x7fffffffu) grid.sync();
  GSYNC();
  {
    const float* part = (const float*)(ws0 + WS_R);
    for (int e = bid0 * 256 + tid; e < 221184; e += G * 256) {
      float sacc = 0.f;
#pragma unroll
      for (int ks = 0; ks < 8; ++ks) sacc += part[(size_t)ks * 221184 + e];
      mods[e] = sacc;
    }
  }
  }
  GSYNC();

#pragma unroll 1
  for (int layer = 0; layer < 4; ++layer) {
    const int kind = layer % 3, j = layer / 3;
    const int bid = opaque_bid();
    char* const ws = opaque_ptr(as_global(p.ws));
    float* mods = (float*)(ws + WS_MODS);
    float* ropeT = (float*)(ws + WS_ROPE);
    float* cosG = ropeT, *sinG = ropeT + 2048, *cosM = ropeT + 4096, *sinM = ropeT + 5120;
    u16* hbuf = (u16*)(ws + WS_HBUF);
    u16* obuf = (u16*)(ws + WS_OBUF);
    u16* wmix = (u16*)(ws + WS_WMIX);
    u16* wmlp = (u16*)(ws + WS_WMLP);
    char* R = ws + WS_R;
    const float* lmods = mods + (size_t)layer * 9 * 6144;
    {
      for (int it = bid; it < 2560; it += G) norm_rows(p, layer, layer == 0, it, GIN(10) + layer * 1024, 0, 1);
      float* sT = (float*)smem;
      for (int it = bid; it < 1024; it += G) {
        if (it < 512) convert_tile(GIN(14) + (size_t)layer * 1024 * 4096, 1024, 4096, wmlp, it, 0, sT);
        else convert_tile(GIN(15) + (size_t)layer * 4096 * 1024, 4096, 1024, wmlp + 4194304, it - 512, 0, sT);
      }
      if (kind == 0) {
        for (int it = bid; it < 528 + 128; it += G) {
          if (it < 528) convert_tile(GIN(16) + (size_t)j * 1024 * 4128, 1024, 4128, wmix + WM_IN, it, 0, sT);
          else convert_tile(GIN(21) + (size_t)j * 1024 * 1024, 1024, 1024, wmix + WM_OUT, it - 528, 0, sT);
        }
      } else if (kind == 1) {
        for (int it = bid; it < 96 + 72 + 64 + 128; it += G) {
          if (it < 96) convert_tile(GIN(22), 1024, 704, wmix + WM_IN, it, 0, sT);
          else if (it < 168) convert_tile(GIN(25), 384, 1536, wmix + WM_UQ, it - 96, 1, sT);
          else if (it < 232) convert_tile(GIN(26), 256, 2048, wmix + WM_UKV, it - 168, 0, sT);
          else convert_tile(GIN(31), 1024, 1024, wmix + WM_OUT, it - 232, 0, sT);
        }
      } else {
        for (int it = bid; it < 192 + 128; it += G) {
          if (it < 192) convert_tile(GIN(32), 1024, 1536, wmix + WM_IN, it, 0, sT);
          else convert_tile(GIN(35), 1024, 1024, wmix + WM_OUT, it - 192, 0, sT);
        }
        u16* Kg = (u16*)(R + R_KG); u16* Vg = (u16*)(R + R_VTG);
        const int tid = opaque_tid();
        for (int it = bid; it < 512; it += G) {
          const int b = it >> 6, s0 = (it & 63) * 8;
          const int ch = tid;
          float kv[8], vv[8];
#pragma unroll
          for (int e = 0; e < 8; ++e) { kv[e] = GIN(6)[((size_t)b * 512 + s0 + e) * 256 + ch]; vv[e] = GIN(7)[((size_t)b * 512 + s0 + e) * 256 + ch]; }
#pragma unroll
          for (int e = 0; e < 8; ++e) Kg[(size_t)(NPROMPT + b * 2560 + s0 + e) * 256 + ch] = f2bf(kv[e]);
          u32x4 o; o[0] = pack2(vv[0], vv[1]); o[1] = pack2(vv[2], vv[3]); o[2] = pack2(vv[4], vv[5]); o[3] = pack2(vv[6], vv[7]);
          *(u32x4*)(Vg + (size_t)(NPROMPT + b * 2560) * 256 + (size_t)ch * 2560 + s0) = o;
        }
      }
    }
    GSYNC();

    if (kind == 0) {
      {
        EpiGdnIn epi; epi.proj = (u16*)(R + R_PROJ); epi.gbuf = (float*)(R + R_GBUF);
        for (int it = bid; it < 160 * 16; it += G) { const int mt = it >> 4, nt = it & 15; gemm_tile_wide(hbuf, 1024, wmix + WM_IN, 1024, 1024, mt * 128, nt * 256, (u16*)smem, epi); }
        for (int it = bid; it < 160; it += G) gemm_tile<4>(hbuf, 1024, wmix + WM_IN, 1024, 1024, it * 128, 4096, (u16*)smem, epi);
      }
      GSYNC();
      gdn_chunk_phase(p, j, smem);
      GSYNC();
      gdn_scan_phase(p, j, smem);
      GSYNC();
      {
        const u16* pr = (const u16*)(R + R_PROJ);
        const float* on = GIN(20) + j * 128;
        const int tid = opaque_tid();
        for (int t4 = bid; t4 < NTOK / 4; t4 += G) {
          const int h = tid >> 5, c = (tid & 31) * 4;
          u32x2 fv[4], bv[4], zv[4];
#pragma unroll
          for (int u = 0; u < 4; ++u) {
            const u16* row = pr + (size_t)(t4 * 4 + u) * 4096;
            fv[u] = *(const u32x2*)(row + h * 128 + c); bv[u] = *(const u32x2*)(row + 1024 + h * 128 + c); zv[u] = *(const u32x2*)(row + 3072 + h * 128 + c);
          }
          const float4 gn = *(const float4*)(on + c);
          const float gg[4] = {gn.x, gn.y, gn.z, gn.w};
#pragma unroll
          for (int u = 0; u < 4; ++u) {
            const u32x2 f = fv[u], b = bv[u], z = zv[u];
            float o[4] = {bflo(f[0]) + bflo(b[0]), bfhi(f[0]) + bfhi(b[0]), bflo(f[1]) + bflo(b[1]), bfhi(f[1]) + bfhi(b[1])};
            float zz[4] = {bflo(z[0]), bfhi(z[0]), bflo(z[1]), bfhi(z[1])};
            float ss = o[0] * o[0] + o[1] * o[1] + o[2] * o[2] + o[3] * o[3];
            ss += __shfl_xor(ss, 1); ss += __shfl_xor(ss, 2); ss += __shfl_xor(ss, 4); ss += __shfl_xor(ss, 8); ss += __shfl_xor(ss, 16);
            const float rs = rsqrtf(ss * (1.f / 128.f) + EPS);
            float y[4];
#pragma unroll
            for (int e = 0; e < 4; ++e) y[e] = o[e] * rs * gg[e] * (zz[e] / (1.f + __expf(-zz[e])));
            st4bf(obuf + (size_t)(t4 * 4 + u) * 1024 + h * 128 + c, y[0], y[1], y[2], y[3]);
          }
        }
      }
      GSYNC();
    } else if (kind == 1) {
      {
        EpiF32 epi; epi.dst = (float*)(R + R_DPROJ); epi.ld = 768;
        for (int it = bid; it < 160 * 6; it += G) { const int mt = it / 6, nt = it % 6; gemm_tile<4>(hbuf, 1024, wmix + WM_IN, 1024, 1024, mt * 128, nt * 128, (u16*)smem, epi); }
      }
      GSYNC();
      {
        const float* dproj = (const float*)(R + R_DPROJ);
        u16* cq = (u16*)(R + R_CQ); u16* ckv = (u16*)(R + R_CKV); u16* Km = (u16*)(R + R_KM);
        const int tid = opaque_tid(), lane = tid & 63, wid = tid >> 6;
        for (int it = bid; it < 6144; it += G) {
          const int row = it * 4 + wid;
          if (row < NTOK) {
            const int t = row;
            const float* pr = dproj + (size_t)t * 768;
            float v[6]; float ss = 0.f;
#pragma unroll
            for (int e = 0; e < 6; ++e) { v[e] = pr[lane + 64 * e]; ss += v[e] * v[e]; }
            ss = wave_sum(ss);
            float rs = rsqrtf(ss * (1.f / 384.f) + EPS);
#pragma unroll
            for (int e = 0; e < 6; ++e) cq[(size_t)t * 384 + lane + 64 * e] = f2bf(v[e] * rs * GIN(23)[lane + 64 * e]);
            const int kvrow = kvrow_of_tok(t);
            float wv[4]; ss = 0.f;
#pragma unroll
            for (int e = 0; e < 4; ++e) { wv[e] = pr[384 + lane + 64 * e]; ss += wv[e] * wv[e]; }
            ss = wave_sum(ss);
            rs = rsqrtf(ss * (1.f / 256.f) + EPS);
#pragma unroll
            for (int e = 0; e < 4; ++e) {
              const float o = wv[e] * rs * GIN(24)[lane + 64 * e];
              ckv[(size_t)kvrow * 256 + lane + 64 * e] = f2bf(o);
              if (t < NPROMPT) GOUT[O_CKV + (size_t)t * 256 + lane + 64 * e] = o;
            }
            const float x = pr[640 + lane];
            ss = wave_sum(x * x);
            float kr = x * rsqrtf(ss * (1.f / 64.f) + EPS) * GIN(30)[lane];
            if (t < NPROMPT) GOUT[O_KR + (size_t)t * 64 + lane] = kr;
            else {
              const int s = (t - NPROMPT) & 2047;
              const int pos = lane < 32 ? (s >> 6) : (s & 63);
              const float cs = cosM[pos * 16 + (lane & 15)], sn = sinM[pos * 16 + (lane & 15)];
              const float partner = __shfl_xor(kr, 16);
              kr = ((lane & 16) == 0) ? kr * cs - partner * sn : partner * sn + kr * cs;
            }
            const u16 kb = f2bf(kr);
#pragma unroll
            for (int hh = 0; hh < 8; ++hh) Km[(size_t)kvrow * 1536 + hh * 192 + 128 + lane] = kb;
          } else {
            const int r = row - NTOK; const int b = r >> 9, s = r & 511;
            const int kvrow = NPROMPT + b * 2560 + s;
#pragma unroll
            for (int e = 0; e < 4; ++e) ckv[(size_t)kvrow * 256 + lane + 64 * e] = f2bf(GIN(4)[((size_t)b * 512 + s) * 256 + lane + 64 * e]);
            const u16 kb = f2bf(GIN(5)[((size_t)b * 512 + s) * 64 + lane]);
#pragma unroll
            for (int hh = 0; hh < 8; ++hh) Km[(size_t)kvrow * 1536 + hh * 192 + 128 + lane] = kb;
          }
        }
      }
      GSYNC();
      {
        EpiMlaUq e1; e1.Q = (u16*)(R + R_Q); e1.gnope = GIN(27); e1.grope = GIN(28); e1.cosT = cosM; e1.sinT = sinM;
        for (int it = bid; it < 160 * 12; it += G) { const int mt = it / 12, nt = it % 12; gemm_tile<8>((const u16*)(R + R_CQ), 384, wmix + WM_UQ, 384, 384, mt * 128, nt * 128, (u16*)smem, e1); }
        EpiMlaUkv e2; e2.Kb = (u16*)(R + R_KM); e2.Vt = (u16*)(R + R_VTM); e2.gnope = GIN(29);
        for (int it = bid; it < 192 * 16; it += G) { const int mt = it / 16, nt = it % 16; gemm_tile<8>((const u16*)(R + R_CKV), 256, wmix + WM_UKV, 256, 256, mt * 128, nt * 128, (u16*)smem, e2); }
      }
      GSYNC();
      attn_phase<192, 8>((const u16*)(R + R_Q), (const u16*)(R + R_KM), (const u16*)(R + R_VTM), obuf, smem);
      GSYNC();
    } else {
      {
        EpiGqaIn epi; epi.Q = (u16*)(R + R_Q); epi.Kb = (u16*)(R + R_KG); epi.Vt = (u16*)(R + R_VTG); epi.qg = GIN(33); epi.kg = GIN(34); epi.cosT = cosG; epi.sinT = sinG; epi.out = GOUT;
        for (int it = bid; it < 160 * 12; it += G) { const int mt = it / 12, nt = it % 12; gemm_tile<8>(hbuf, 1024, wmix + WM_IN, 1024, 1024, mt * 128, nt * 128, (u16*)smem, epi); }
      }
      GSYNC();
      attn_phase<128, 2>((const u16*)(R + R_Q), (const u16*)(R + R_KG), (const u16*)(R + R_VTG), obuf, smem);
      GSYNC();
    }

    for (int it = bid; it < 768; it += G) {
      const bool wide = it < 512;
      int m0, n0;
      if (wide) { m0 = (it >> 2) * 128; n0 = (it & 3) * 256; } else { const int ix = it - 512; m0 = (128 + (ix >> 3)) * 128; n0 = (ix & 7) * 128; }
      EpiResid epi;
      epi.xin = (layer == 0) ? (m0 < NPROMPT ? GIN(0) : GIN(1) - (size_t)NPROMPT * 1024) : GOUT;
      epi.xout = GOUT; epi.gate = lmods + (size_t)cond_of(m0) * 6144 + 2 * 1024;
      if (wide) gemm_tile_wide(obuf, 1024, wmix + WM_OUT, 1024, 1024, m0, n0, (u16*)smem, epi);
      else gemm_tile<4>(obuf, 1024, wmix + WM_OUT, 1024, 1024, m0, n0, (u16*)smem, epi);
    }
    GSYNC();
    for (int it = bid; it < 2560; it += G) norm_rows(p, layer, false, it, GIN(11) + layer * 1024, 3, 4);
    GSYNC();
    {
      EpiMlpIn epi; epi.abuf = (u16*)(R + R_ABUF);
      for (int it = bid; it < 160 * 16; it += G) { const int mt = it >> 4, nt = it & 15; gemm_tile_wide(hbuf, 1024, wmlp, 1024, 1024, mt * 128, nt * 256, (u16*)smem, epi); }
    }
    GSYNC();
    for (int it = bid; it < 768; it += G) {
      const bool wide = it < 512;
      int m0, n0;
      if (wide) { m0 = (it >> 2) * 128; n0 = (it & 3) * 256; } else { const int ix = it - 512; m0 = (128 + (ix >> 3)) * 128; n0 = (ix & 7) * 128; }
      EpiResid epi; epi.xin = GOUT; epi.xout = GOUT; epi.gate = lmods + (size_t)cond_of(m0) * 6144 + 5 * 1024;
      if (wide) gemm_tile_wide((const u16*)(R + R_ABUF), 4096, wmlp + 4194304, 4096, 4096, m0, n0, (u16*)smem, epi);
      else gemm_tile<4>((const u16*)(R + R_ABUF), 4096, wmlp + 4194304, 4096, 4096, m0, n0, (u16*)smem, epi);
    }
    GSYNC();
  }
}

extern "C" void kernel_launch(void* const* d_in, const int* in_sizes, int n_in, void* d_out, int out_size, void* d_ws, size_t ws_size, hipStream_t stream) {
  static int grid_blocks = 0;
  if (!grid_blocks) {
    int dev = 0, cus = 0, per_cu = 0;
    hipGetDevice(&dev);
    hipDeviceGetAttribute(&cus, hipDeviceAttributeMultiprocessorCount, dev);
    hipOccupancyMaxActiveBlocksPerMultiprocessor(&per_cu, fwd_megakernel, 256, 0);
    if (per_cu < 1) per_cu = 1;
    if (per_cu > 2) per_cu = 2;
    grid_blocks = cus * per_cu;
  }
  P p{};
  for (int i = 0; i < 36; ++i) p.in[i] = (const float*)d_in[i];
  p.out = (float*)d_out;
  p.ws = (char*)d_ws;
  (void)hipMemsetAsync((char*)d_ws + WS_BAR, 0, XCD_BAR_WORDS * 4, stream);
  void* args[] = {&p};
  hipError_t e = hipLaunchCooperativeKernel((void*)fwd_megakernel, dim3(grid_blocks), dim3(256), args, 0, stream);
  if (e != hipSuccess) fprintf(stderr, "cooperative launch failed: %s (grid %d)\n", hipGetErrorString(e), grid_blocks);
}
```

```cpp
#include <hip/hip_runtime.h>
#include <hip/hip_cooperative_groups.h>
#include <cstdio>
namespace cg = cooperative_groups;

typedef unsigned short u16;
typedef __attribute__((ext_vector_type(8))) short bf16x8;
typedef __attribute__((ext_vector_type(4))) short bf16x4;
typedef __attribute__((ext_vector_type(4))) float f32x4;
typedef __attribute__((ext_vector_type(4))) unsigned u32x4;
typedef __attribute__((ext_vector_type(2))) unsigned u32x2;

#define DI __device__ __forceinline__

constexpr int NTOK = 20480;
constexpr int NPROMPT = 4096;
constexpr float EPS = 1e-6f;

constexpr size_t WS_MODS = 0;
constexpr size_t MODS_BYTES = 4ull * 9 * 6144 * 4;
constexpr size_t WS_BAR = 917504;
constexpr size_t WS_ROPE = 1048576;
constexpr size_t WS_WMIX = 1114112;
constexpr size_t WS_WMLP = 14090240;
constexpr size_t WS_HBUF = 30867456;
constexpr size_t WS_OBUF = 72810496;
constexpr size_t WS_R    = 114753536;
constexpr size_t WS_W2MIX = 374276096;
constexpr size_t WS_W2MLP = 387252224;
constexpr size_t R_ABUF = 0;
constexpr size_t R_PROJ = 0;
constexpr size_t R_VBUF = 167772160;
constexpr size_t R_TBUF = 209715200;
constexpr size_t R_GBUF = 251658240;
constexpr size_t R_GCB  = 254279680;
constexpr size_t R_BETA = 255590400;
constexpr size_t R_EG   = 256901120;
constexpr size_t R_ED   = 258211840;
constexpr size_t R_DPROJ = 0;
constexpr size_t R_Q    = 0;
constexpr size_t R_CQ   = 62914560;
constexpr size_t R_CKV  = 78643200;
constexpr size_t R_KM   = 91226112;
constexpr size_t R_VTM  = 166723584;
constexpr size_t R_KG   = 41943040;
constexpr size_t R_VTG  = 54525952;
constexpr size_t WM_IN = 0;
constexpr size_t WM_OUT = 4325376;
constexpr size_t WM_UQ = 5373952;
constexpr size_t WM_UKV = 5963776;
constexpr size_t O_SF = 20971520, O_SB = 25165824, O_CKV = 29360128, O_KR = 30408704, O_GK = 30670848, O_GV = 31719424;

struct P {
  const float* in[36];
  float* out;
  char* ws;
};

typedef __attribute__((ext_vector_type(2))) float f32x2_t;
typedef __attribute__((ext_vector_type(2))) __bf16 bf16x2_t;
DI u16 f2bf(float x) { return __builtin_bit_cast(u16, (__bf16)x); }
DI float bf2f(u16 h) { return __uint_as_float(((unsigned)h) << 16); }
DI unsigned pack2(float a, float b) { f32x2_t v; v[0] = a; v[1] = b; return __builtin_bit_cast(unsigned, __builtin_convertvector(v, bf16x2_t)); }
DI float bflo(unsigned w) { return __uint_as_float(w << 16); }
DI float bfhi(unsigned w) { return __uint_as_float(w & 0xffff0000u); }
DI f32x4 mma(bf16x8 a, bf16x8 b, f32x4 c) { return __builtin_amdgcn_mfma_f32_16x16x32_bf16(a, b, c, 0, 0, 0); }
DI bf16x8 pack8(f32x4 a, f32x4 b) {
  u32x4 p; p[0] = pack2(a[0], a[1]); p[1] = pack2(a[2], a[3]); p[2] = pack2(b[0], b[1]); p[3] = pack2(b[2], b[3]);
  return __builtin_bit_cast(bf16x8, p);
}
DI bf16x8 ld8(const u16* p) { return *(const bf16x8*)p; }
DI bf16x8 ld44(const u16* p0, const u16* p1) {
  u32x2 a = *(const u32x2*)p0; u32x2 b = *(const u32x2*)p1;
  u32x4 r; r[0] = a[0]; r[1] = a[1]; r[2] = b[0]; r[3] = b[1];
  return __builtin_bit_cast(bf16x8, r);
}
typedef __attribute__((ext_vector_type(4))) short s16x4_t;
DI bf16x8 ldtr(const u16* p, int row4_off) {
  typedef __attribute__((address_space(3))) s16x4_t lds4_t;
  const s16x4_t lo = __builtin_amdgcn_ds_read_tr16_b64_v4i16((lds4_t*)p);
  const s16x4_t hi = __builtin_amdgcn_ds_read_tr16_b64_v4i16((lds4_t*)(p + row4_off));
  return __builtin_shufflevector(lo, hi, 0, 1, 2, 3, 4, 5, 6, 7);
}
DI void st4bf(u16* p, float a, float b, float c, float d) { u32x2 v; v[0] = pack2(a, b); v[1] = pack2(c, d); *(u32x2*)p = v; }
DI float wave_sum(float v) {
  v += __shfl_xor(v, 1); v += __shfl_xor(v, 2); v += __shfl_xor(v, 4); v += __shfl_xor(v, 8); v += __shfl_xor(v, 16); v += __shfl_xor(v, 32);
  return v;
}
DI float sum_g(float v) { v += __shfl_xor(v, 16); v += __shfl_xor(v, 32); return v; }
DI int opaque_tid() { int t = threadIdx.x; asm volatile("" : "+v"(t)); return t; }
DI int opaque_bid() { int t = __builtin_amdgcn_readfirstlane((int)blockIdx.x); asm volatile("" : "+s"(t)); return t; }
DI char* opaque_ptr(char* q) {
  unsigned lo = __builtin_amdgcn_readfirstlane((unsigned)(size_t)q), hi = __builtin_amdgcn_readfirstlane((unsigned)((size_t)q >> 32));
  asm volatile("" : "+s"(lo), "+s"(hi));
  typedef __attribute__((address_space(1))) char gchar_t;
  return (char*)(gchar_t*)(((size_t)hi << 32) | (size_t)lo);
}
template <class T> DI T* as_global(T* q) { typedef __attribute__((address_space(1))) T gT; return (T*)(gT*)q; }
#define GIN(i) as_global(p.in[i])
#define GOUT as_global(p.out)
DI int cond_of(int t) { return t < NPROMPT ? 0 : 1 + ((t - NPROMPT) >> 11); }
DI int kvrow_of_tok(int t) { return t < NPROMPT ? t : NPROMPT + ((t - NPROMPT) >> 11) * 2560 + 512 + ((t - NPROMPT) & 2047); }

template <int NI, class Epi>
DI void gemm_tile(const u16* __restrict__ A, int lda, const u16* __restrict__ Bt, int ldb, int K, int m0, int n0, u16* smem, Epi& epi) {
  constexpr int MI = 16 / NI;
  constexpr int WN = 8 / NI;
  const int tid = opaque_tid(), lane = tid & 63, wid = tid >> 6, l15 = lane & 15, g = lane >> 4;
  const int wm = wid / WN, wn = wid % WN;
  u16* sA = smem; u16* sB = smem + 128 * 64;
  f32x4 acc[MI][NI];
#pragma unroll
  for (int mi = 0; mi < MI; ++mi)
#pragma unroll
    for (int ni = 0; ni < NI; ++ni) { acc[mi][ni][0] = 0.f; acc[mi][ni][1] = 0.f; acc[mi][ni][2] = 0.f; acc[mi][ni][3] = 0.f; }
  const int lrow = tid >> 3, lkc = (tid & 7) * 8;
  const int wofs = lrow * 64 + (((tid & 7) ^ ((lrow >> 1) & 7)) * 8);
  const int rsw = (l15 >> 1) & 7;
  const int rofs0 = l15 * 64 + ((g ^ rsw) * 8), rofs1 = l15 * 64 + (((4 + g) ^ rsw) * 8);
  const u16* pa = A + (size_t)(m0 + lrow) * lda + lkc;
  const u16* pb = Bt + (size_t)(n0 + lrow) * ldb + lkc;
  u32x4 ra[2][4], rb[2][4];
  const int nk = K >> 6;
#pragma unroll
  for (int i = 0; i < 4; ++i) { ra[0][i] = *(const u32x4*)(pa + (size_t)i * 32 * lda); rb[0][i] = *(const u32x4*)(pb + (size_t)i * 32 * ldb); }
#pragma unroll
  for (int i = 0; i < 4; ++i) { ra[1][i] = *(const u32x4*)(pa + (size_t)i * 32 * lda + 64); rb[1][i] = *(const u32x4*)(pb + (size_t)i * 32 * ldb + 64); }
  for (int kt = 0; kt < nk; kt += 2) {
#pragma unroll
    for (int half = 0; half < 2; ++half) {
      __syncthreads();
#pragma unroll
      for (int i = 0; i < 4; ++i) { *(u32x4*)(sA + wofs + i * 32 * 64) = ra[half][i]; *(u32x4*)(sB + wofs + i * 32 * 64) = rb[half][i]; }
      __syncthreads();
      if (kt + half + 2 < nk) {
        const int ko = (kt + half + 2) * 64;
#pragma unroll
        for (int i = 0; i < 4; ++i) { ra[half][i] = *(const u32x4*)(pa + (size_t)i * 32 * lda + ko); rb[half][i] = *(const u32x4*)(pb + (size_t)i * 32 * ldb + ko); }
      }
#pragma unroll
      for (int ks = 0; ks < 2; ++ks) {
        const int ro = ks ? rofs1 : rofs0;
        bf16x8 af[MI], bfv[NI];
#pragma unroll
        for (int mi = 0; mi < MI; ++mi) af[mi] = ld8(sA + (wm * MI * 16 + mi * 16) * 64 + ro);
#pragma unroll
        for (int ni = 0; ni < NI; ++ni) bfv[ni] = ld8(sB + (wn * NI * 16 + ni * 16) * 64 + ro);
        __builtin_amdgcn_s_setprio(1);
#pragma unroll
        for (int mi = 0; mi < MI; ++mi)
#pragma unroll
          for (int ni = 0; ni < NI; ++ni) acc[mi][ni] = mma(bfv[ni], af[mi], acc[mi][ni]);
        __builtin_amdgcn_s_setprio(0);
      }
    }
  }
  epi.template run<MI, NI>(acc, m0 + wm * MI * 16, n0 + wn * NI * 16, l15, g);
}

template <class Epi>
DI void gemm_tile_wide(const u16* __restrict__ A, int lda, const u16* __restrict__ Bt, int ldb, int K, int m0, int n0, u16* smem, Epi& epi) {
  constexpr int MI = 4, NI = 8;
  const int tid = opaque_tid(), lane = tid & 63, wid = tid >> 6, l15 = lane & 15, g = lane >> 4;
  const int wm = wid >> 1, wn = wid & 1;
  u16* sA = smem; u16* sB = smem + 128 * 64;
  f32x4 acc[MI][NI];
#pragma unroll
  for (int mi = 0; mi < MI; ++mi)
#pragma unroll
    for (int ni = 0; ni < NI; ++ni) { acc[mi][ni][0] = 0.f; acc[mi][ni][1] = 0.f; acc[mi][ni][2] = 0.f; acc[mi][ni][3] = 0.f; }
  const int lrow = tid >> 3, lkc = (tid & 7) * 8;
  const int wofs = lrow * 64 + (((tid & 7) ^ ((lrow >> 1) & 7)) * 8);
  const int rsw = (l15 >> 1) & 7;
  const int rofs0 = l15 * 64 + ((g ^ rsw) * 8), rofs1 = l15 * 64 + (((4 + g) ^ rsw) * 8);
  const u16* pa = A + (size_t)(m0 + lrow) * lda + lkc;
  const u16* pb = Bt + (size_t)(n0 + lrow) * ldb + lkc;
  u32x4 ra[4], rb[8];
  const int nk = K >> 6;
#pragma unroll
  for (int i = 0; i < 4; ++i) ra[i] = *(const u32x4*)(pa + (size_t)i * 32 * lda);
#pragma unroll
  for (int i = 0; i < 8; ++i) rb[i] = *(const u32x4*)(pb + (size_t)i * 32 * ldb);
  for (int kt = 0; kt < nk; ++kt) {
    __syncthreads();
#pragma unroll
    for (int i = 0; i < 4; ++i) *(u32x4*)(sA + wofs + i * 32 * 64) = ra[i];
#pragma unroll
    for (int i = 0; i < 8; ++i) *(u32x4*)(sB + wofs + i * 32 * 64) = rb[i];
    __syncthreads();
    if (kt + 1 < nk) {
      const int ko = (kt + 1) * 64;
#pragma unroll
      for (int i = 0; i < 4; ++i) ra[i] = *(const u32x4*)(pa + (size_t)i * 32 * lda + ko);
#pragma unroll
      for (int i = 0; i < 8; ++i) rb[i] = *(const u32x4*)(pb + (size_t)i * 32 * ldb + ko);
    }
#pragma unroll
    for (int ks = 0; ks < 2; ++ks) {
      const int ro = ks ? rofs1 : rofs0;
      bf16x8 af[MI];
#pragma unroll
      for (int mi = 0; mi < MI; ++mi) af[mi] = ld8(sA + (wm * 64 + mi * 16) * 64 + ro);
#pragma unroll
      for (int nh = 0; nh < 2; ++nh) {
        bf16x8 bfv[4];
#pragma unroll
        for (int ni = 0; ni < 4; ++ni) bfv[ni] = ld8(sB + (wn * 128 + (nh * 4 + ni) * 16) * 64 + ro);
        __builtin_amdgcn_s_setprio(1);
#pragma unroll
        for (int mi = 0; mi < MI; ++mi)
#pragma unroll
          for (int ni = 0; ni < 4; ++ni) acc[mi][nh * 4 + ni] = mma(bfv[ni], af[mi], acc[mi][nh * 4 + ni]);
        __builtin_amdgcn_s_setprio(0);
        __builtin_amdgcn_sched_barrier(0);
      }
    }
  }
  epi.template run<MI, NI>(acc, m0 + wm * 64, n0 + wn * 128, l15, g);
}

struct EpiResid {
  const float* xin; float* xout; const float* gate;
  template <int MI, int NI> DI void run(f32x4 (&acc)[MI][NI], int mr, int nc, int l15, int g) {
#pragma unroll
    for (int mi = 0; mi < MI; ++mi)
#pragma unroll
      for (int ni = 0; ni < NI; ++ni) {
        const int m = mr + mi * 16 + l15, n = nc + ni * 16 + g * 4;
        const float4 xi = *(const float4*)(xin + (size_t)m * 1024 + n);
        const float4 gt = *(const float4*)(gate + n);
        float4 o; o.x = xi.x + gt.x * acc[mi][ni][0]; o.y = xi.y + gt.y * acc[mi][ni][1]; o.z = xi.z + gt.z * acc[mi][ni][2]; o.w = xi.w + gt.w * acc[mi][ni][3];
        *(float4*)(xout + (size_t)m * 1024 + n) = o;
      }
  }
};
struct EpiGdnIn {
  u16* proj; float* gbuf;
  template <int MI, int NI> DI void run(f32x4 (&acc)[MI][NI], int mr, int nc, int l15, int g) {
#pragma unroll
    for (int mi = 0; mi < MI; ++mi)
#pragma unroll
      for (int ni = 0; ni < NI; ++ni) {
        const int m = mr + mi * 16 + l15, n = nc + ni * 16 + g * 4;
        if (n < 4096) st4bf(proj + (size_t)m * 4096 + n, acc[mi][ni][0], acc[mi][ni][1], acc[mi][ni][2], acc[mi][ni][3]);
        else if (n < 4128) { float4 o; o.x = acc[mi][ni][0]; o.y = acc[mi][ni][1]; o.z = acc[mi][ni][2]; o.w = acc[mi][ni][3]; *(float4*)(gbuf + (size_t)m * 32 + (n - 4096)) = o; }
      }
  }
};
struct EpiMlpIn {
  u16* abuf;
  template <int MI, int NI> DI void run(f32x4 (&acc)[MI][NI], int mr, int nc, int l15, int g) {
#pragma unroll
    for (int mi = 0; mi < MI; ++mi)
#pragma unroll
      for (int ni = 0; ni < NI; ++ni) {
        const int m = mr + mi * 16 + l15, n = nc + ni * 16 + g * 4;
        float a = fmaxf(acc[mi][ni][0], 0.f), b = fmaxf(acc[mi][ni][1], 0.f), c = fmaxf(acc[mi][ni][2], 0.f), d = fmaxf(acc[mi][ni][3], 0.f);
        st4bf(abuf + (size_t)m * 4096 + n, a * a, b * b, c * c, d * d);
      }
  }
};
struct EpiF32 {
  float* dst; int ld;
  template <int MI, int NI> DI void run(f32x4 (&acc)[MI][NI], int mr, int nc, int l15, int g) {
#pragma unroll
    for (int mi = 0; mi < MI; ++mi)
#pragma unroll
      for (int ni = 0; ni < NI; ++ni) {
        const int m = mr + mi * 16 + l15, n = nc + ni * 16 + g * 4;
        float4 o; o.x = acc[mi][ni][0]; o.y = acc[mi][ni][1]; o.z = acc[mi][ni][2]; o.w = acc[mi][ni][3];
        *(float4*)(dst + (size_t)m * ld + n) = o;
      }
  }
};

DI void rope128(f32x4 (&v)[8], int rowp, int colp, int g, const float* cosT, const float* sinT) {
#pragma unroll
  for (int hf = 0; hf < 2; ++hf) {
    const int pos = hf ? colp : rowp;
#pragma unroll
    for (int a = 0; a < 2; ++a) {
      const int n1 = hf * 4 + a, n2 = n1 + 2;
      const float4 cs = *(const float4*)(cosT + pos * 32 + a * 16 + g * 4);
      const float4 sn = *(const float4*)(sinT + pos * 32 + a * 16 + g * 4);
      const float c4[4] = {cs.x, cs.y, cs.z, cs.w}, s4[4] = {sn.x, sn.y, sn.z, sn.w};
#pragma unroll
      for (int j = 0; j < 4; ++j) { const float x1 = v[n1][j], x2 = v[n2][j]; v[n1][j] = x1 * c4[j] - x2 * s4[j]; v[n2][j] = x1 * s4[j] + x2 * c4[j]; }
    }
  }
}
DI void rope64(f32x4* v, int rowp, int colp, int g, const float* cosT, const float* sinT) {
#pragma unroll
  for (int hf = 0; hf < 2; ++hf) {
    const int pos = hf ? colp : rowp;
    const int n1 = hf * 2, n2 = n1 + 1;
    const float4 cs = *(const float4*)(cosT + pos * 16 + g * 4);
    const float4 sn = *(const float4*)(sinT + pos * 16 + g * 4);
    const float c4[4] = {cs.x, cs.y, cs.z, cs.w}, s4[4] = {sn.x, sn.y, sn.z, sn.w};
#pragma unroll
    for (int j = 0; j < 4; ++j) { const float x1 = v[n1][j], x2 = v[n2][j]; v[n1][j] = x1 * c4[j] - x2 * s4[j]; v[n2][j] = x1 * s4[j] + x2 * c4[j]; }
  }
}

struct EpiGqaIn {
  u16* Q; u16* Kb; u16* Vt; const float* qg; const float* kg; const float* cosT; const float* sinT; float* out;
  template <int MI, int NI> DI void run(f32x4 (&acc)[MI][NI], int mr, int nc, int l15, int g) {
    const int nt = nc >> 7;
#pragma unroll
    for (int mi = 0; mi < MI; ++mi) {
      const int m = mr + mi * 16 + l15;
      const bool prompt = m < NPROMPT;
      const int s = prompt ? (m & 255) : ((m - NPROMPT) & 2047);
      const int rowp = s >> 6, colp = s & 63;
      const int kvrow = kvrow_of_tok(m);
      if (nt < 10) {
        float ss = 0.f;
#pragma unroll
        for (int ni = 0; ni < NI; ++ni)
#pragma unroll
          for (int j = 0; j < 4; ++j) ss += acc[mi][ni][j] * acc[mi][ni][j];
        ss = sum_g(ss);
        const float rs = rsqrtf(ss * (1.f / 128.f) + EPS);
        const float* gn = nt < 8 ? qg : kg;
#pragma unroll
        for (int ni = 0; ni < NI; ++ni) {
          const float4 gv = *(const float4*)(gn + ni * 16 + g * 4);
          acc[mi][ni][0] *= rs * gv.x; acc[mi][ni][1] *= rs * gv.y; acc[mi][ni][2] *= rs * gv.z; acc[mi][ni][3] *= rs * gv.w;
        }
        if (nt >= 8 && prompt) {
#pragma unroll
          for (int ni = 0; ni < NI; ++ni) { float4 o; o.x = acc[mi][ni][0]; o.y = acc[mi][ni][1]; o.z = acc[mi][ni][2]; o.w = acc[mi][ni][3]; *(float4*)(out + O_GK + (size_t)m * 256 + (nt - 8) * 128 + ni * 16 + g * 4) = o; }
        }
        if (!prompt) rope128(acc[mi], rowp, colp, g, cosT, sinT);
        u16* dst = nt < 8 ? Q + (size_t)m * 1024 + nt * 128 : Kb + (size_t)kvrow * 256 + (nt - 8) * 128;
#pragma unroll
        for (int ni = 0; ni < NI; ++ni) st4bf(dst + ni * 16 + g * 4, acc[mi][ni][0], acc[mi][ni][1], acc[mi][ni][2], acc[mi][ni][3]);
      } else {
        const int kvh = nt - 10;
        if (prompt) {
#pragma unroll
          for (int ni = 0; ni < NI; ++ni) { float4 o; o.x = acc[mi][ni][0]; o.y = acc[mi][ni][1]; o.z = acc[mi][ni][2]; o.w = acc[mi][ni][3]; *(float4*)(out + O_GV + (size_t)m * 256 + kvh * 128 + ni * 16 + g * 4) = o; }
        }
        size_t base; int kvlen, pos;
        if (prompt) { base = (size_t)(m >> 8) * 256 * 256; kvlen = 256; pos = m & 255; }
        else { const int b = (m - NPROMPT) >> 11; base = (size_t)(NPROMPT + b * 2560) * 256; kvlen = 2560; pos = 512 + s; }
#pragma unroll
        for (int ni = 0; ni < NI; ++ni)
#pragma unroll
          for (int j = 0; j < 4; ++j) Vt[base + (size_t)(kvh * 128 + ni * 16 + g * 4 + j) * kvlen + pos] = f2bf(acc[mi][ni][j]);
      }
    }
  }
};
struct EpiMlaUq {
  u16* Q; const float* gnope; const float* grope; const float* cosT; const float* sinT;
  template <int MI, int NI> DI void run(f32x4 (&acc)[MI][NI], int mr, int nc, int l15, int g) {
    const int nt = nc >> 7;
#pragma unroll
    for (int mi = 0; mi < MI; ++mi) {
      const int m = mr + mi * 16 + l15;
      const bool prompt = m < NPROMPT;
      const int s = prompt ? (m & 255) : ((m - NPROMPT) & 2047);
      const int rowp = s >> 6, colp = s & 63;
      if (nt < 8) {
        float ss = 0.f;
#pragma unroll
        for (int ni = 0; ni < NI; ++ni)
#pragma unroll
          for (int j = 0; j < 4; ++j) ss += acc[mi][ni][j] * acc[mi][ni][j];
        ss = sum_g(ss);
        const float rs = rsqrtf(ss * (1.f / 128.f) + EPS);
#pragma unroll
        for (int ni = 0; ni < NI; ++ni) {
          const float4 gv = *(const float4*)(gnope + ni * 16 + g * 4);
          st4bf(Q + (size_t)m * 1536 + nt * 192 + ni * 16 + g * 4, acc[mi][ni][0] * rs * gv.x, acc[mi][ni][1] * rs * gv.y, acc[mi][ni][2] * rs * gv.z, acc[mi][ni][3] * rs * gv.w);
        }
      } else {
#pragma unroll
        for (int hh = 0; hh < 2; ++hh) {
          const int h = (nt - 8) * 2 + hh;
          float ss = 0.f;
#pragma unroll
          for (int ni = 0; ni < 4; ++ni)
#pragma unroll
            for (int j = 0; j < 4; ++j) ss += acc[mi][hh * 4 + ni][j] * acc[mi][hh * 4 + ni][j];
          ss = sum_g(ss);
          const float rs = rsqrtf(ss * (1.f / 64.f) + EPS);
#pragma unroll
          for (int ni = 0; ni < 4; ++ni) {
            const float4 gv = *(const float4*)(grope + ni * 16 + g * 4);
            acc[mi][hh * 4 + ni][0] *= rs * gv.x; acc[mi][hh * 4 + ni][1] *= rs * gv.y; acc[mi][hh * 4 + ni][2] *= rs * gv.z; acc[mi][hh * 4 + ni][3] *= rs * gv.w;
          }
          if (!prompt) rope64(&acc[mi][hh * 4], rowp, colp, g, cosT, sinT);
#pragma unroll
          for (int ni = 0; ni < 4; ++ni)
            st4bf(Q + (size_t)m * 1536 + h * 192 + 128 + ni * 16 + g * 4, acc[mi][hh * 4 + ni][0], acc[mi][hh * 4 + ni][1], acc[mi][hh * 4 + ni][2], acc[mi][hh * 4 + ni][3]);
        }
      }
    }
  }
};
struct EpiMlaUkv {
  u16* Kb; u16* Vt; const float* gnope;
  template <int MI, int NI> DI void run(f32x4 (&acc)[MI][NI], int mr, int nc, int l15, int g) {
    const int nt = nc >> 7, h = nt >> 1;
#pragma unroll
    for (int mi = 0; mi < MI; ++mi) {
      const int m = mr + mi * 16 + l15;
      if ((nt & 1) == 0) {
        float ss = 0.f;
#pragma unroll
        for (int ni = 0; ni < NI; ++ni)
#pragma unroll
          for (int j = 0; j < 4; ++j) ss += acc[mi][ni][j] * acc[mi][ni][j];
        ss = sum_g(ss);
        const float rs = rsqrtf(ss * (1.f / 128.f) + EPS);
#pragma unroll
        for (int ni = 0; ni < NI; ++ni) {
          const float4 gv = *(const float4*)(gnope + ni * 16 + g * 4);
          st4bf(Kb + (size_t)m * 1536 + h * 192 + ni * 16 + g * 4, acc[mi][ni][0] * rs * gv.x, acc[mi][ni][1] * rs * gv.y, acc[mi][ni][2] * rs * gv.z, acc[mi][ni][3] * rs * gv.w);
        }
      } else {
        size_t base; int kvlen, pos;
        if (m < NPROMPT) { base = (size_t)(m >> 8) * 256 * 1024; kvlen = 256; pos = m & 255; }
        else { const int r = m - NPROMPT; const int b = r / 2560; base = (size_t)(NPROMPT + b * 2560) * 1024; kvlen = 2560; pos = r - b * 2560; }
#pragma unroll
        for (int ni = 0; ni < NI; ++ni)
#pragma unroll
          for (int j = 0; j < 4; ++j) Vt[base + (size_t)(h * 128 + ni * 16 + g * 4 + j) * kvlen + pos] = f2bf(acc[mi][ni][j]);
      }
    }
  }
};

DI void convert_tile(const float* __restrict__ W, int K, int N, u16* __restrict__ Bt, int tile, int perm, float* sT) {
  const int nkt = K >> 6;
  const int kt = tile % nkt, nt = tile / nkt;
  const int k0 = kt * 64, n0 = nt * 128;
  const int tid = opaque_tid();
  __syncthreads();
  {
    const int n = tid & 127, kq = tid >> 7;
    int nd = n0 + n, ns = nd;
    if (perm == 1) { if (nd < 1024) ns = (nd >> 7) * 192 + (nd & 127); else { const int x = nd - 1024; ns = (x >> 6) * 192 + 128 + (x & 63); } }
    const bool ok = nd < N;
    float wv[32];
#pragma unroll
    for (int r = 0; r < 32; ++r) wv[r] = ok ? W[(size_t)(k0 + r * 2 + kq) * N + ns] : 0.f;
#pragma unroll
    for (int r = 0; r < 32; ++r) sT[(r * 2 + kq) * 129 + n] = wv[r];
  }
  __syncthreads();
  {
    const int n = tid >> 1, kq = (tid & 1) * 32;
    u16* dst = Bt + (size_t)(n0 + n) * K + k0 + kq;
#pragma unroll
    for (int q = 0; q < 4; ++q) {
      u32x4 a;
#pragma unroll
      for (int e = 0; e < 4; ++e) a[e] = pack2(sT[(kq + q * 8 + 2 * e) * 129 + n], sT[(kq + q * 8 + 2 * e + 1) * 129 + n]);
      *(u32x4*)(dst + q * 8) = a;
    }
  }
}

DI void convert_layer(const P& p, int L, u16* wmixL, u16* wmlpL, int start, int stride, float* sT) {
  const int kindL = L % 3, jL = L / 3;
  for (int it = start; it < 1024; it += stride) {
    if (it < 512) convert_tile(GIN(14) + (size_t)L * 1024 * 4096, 1024, 4096, wmlpL, it, 0, sT);
    else convert_tile(GIN(15) + (size_t)L * 4096 * 1024, 4096, 1024, wmlpL + 4194304, it - 512, 0, sT);
  }
  if (kindL == 0) {
    for (int it = start; it < 528 + 128; it += stride) {
      if (it < 528) convert_tile(GIN(16) + (size_t)jL * 1024 * 4128, 1024, 4128, wmixL + WM_IN, it, 0, sT);
      else convert_tile(GIN(21) + (size_t)jL * 1024 * 1024, 1024, 1024, wmixL + WM_OUT, it - 528, 0, sT);
    }
  } else if (kindL == 1) {
    for (int it = start; it < 96 + 72 + 64 + 128; it += stride) {
      if (it < 96) convert_tile(GIN(22), 1024, 704, wmixL + WM_IN, it, 0, sT);
      else if (it < 168) convert_tile(GIN(25), 384, 1536, wmixL + WM_UQ, it - 96, 1, sT);
      else if (it < 232) convert_tile(GIN(26), 256, 2048, wmixL + WM_UKV, it - 168, 0, sT);
      else convert_tile(GIN(31), 1024, 1024, wmixL + WM_OUT, it - 232, 0, sT);
    }
  } else {
    for (int it = start; it < 192 + 128; it += stride) {
      if (it < 192) convert_tile(GIN(32), 1024, 1536, wmixL + WM_IN, it, 0, sT);
      else convert_tile(GIN(35), 1024, 1024, wmixL + WM_OUT, it - 192, 0, sT);
    }
  }
}

DI void norm_rows(const P& p, int layer, bool from_input, int item, const float* gnorm, int shift_idx, int scale_idx) {
  const int tidn = opaque_tid();
  char* const ws = opaque_ptr(as_global(p.ws));
  const int lane = tidn & 63, wid = tidn >> 6;
  const int t = item * 8 + wid * 2;
  const float* x = from_input ? (t < NPROMPT ? GIN(0) + (size_t)t * 1024 : GIN(1) + (size_t)(t - NPROMPT) * 1024) : GOUT + (size_t)t * 1024;
  const float* mods = (const float*)(ws + WS_MODS) + ((size_t)layer * 9 + cond_of(t)) * 6144;
  u16* h = (u16*)(ws + WS_HBUF) + (size_t)t * 1024;
  float4 v[2][4]; float ss0 = 0.f, ss1 = 0.f;
#pragma unroll
  for (int e = 0; e < 4; ++e) { v[0][e] = *(const float4*)(x + e * 256 + lane * 4); v[1][e] = *(const float4*)(x + 1024 + e * 256 + lane * 4); }
#pragma unroll
  for (int e = 0; e < 4; ++e) {
    ss0 += v[0][e].x * v[0][e].x + v[0][e].y * v[0][e].y + v[0][e].z * v[0][e].z + v[0][e].w * v[0][e].w;
    ss1 += v[1][e].x * v[1][e].x + v[1][e].y * v[1][e].y + v[1][e].z * v[1][e].z + v[1][e].w * v[1][e].w;
  }
  ss0 = wave_sum(ss0); ss1 = wave_sum(ss1);
  const float rs0 = rsqrtf(ss0 * (1.f / 1024.f) + EPS), rs1 = rsqrtf(ss1 * (1.f / 1024.f) + EPS);
#pragma unroll
  for (int e = 0; e < 4; ++e) {
    const int c = e * 256 + lane * 4;
    const float4 gv = *(const float4*)(gnorm + c);
    const float4 sc = *(const float4*)(mods + scale_idx * 1024 + c);
    const float4 sh = *(const float4*)(mods + shift_idx * 1024 + c);
    const float m0 = gv.x * (1.f + sc.x), m1 = gv.y * (1.f + sc.y), m2 = gv.z * (1.f + sc.z), m3 = gv.w * (1.f + sc.w);
    st4bf(h + c, v[0][e].x * rs0 * m0 + sh.x, v[0][e].y * rs0 * m1 + sh.y, v[0][e].z * rs0 * m2 + sh.z, v[0][e].w * rs0 * m3 + sh.w);
    st4bf(h + 1024 + c, v[1][e].x * rs1 * m0 + sh.x, v[1][e].y * rs1 * m1 + sh.y, v[1][e].z * rs1 * m2 + sh.z, v[1][e].w * rs1 * m3 + sh.w);
  }
}

template <int DK, int HK>
DI void attn_phase(const u16* __restrict__ Q, const u16* __restrict__ Kb, const u16* __restrict__ Vt, u16* __restrict__ obuf, char* smem_raw) {
  const int bid = opaque_bid();
  constexpr int KS = DK / 32, KSTR = DK, QSTR = 8 * DK, KROW = HK * DK, GRP = 8 / HK;
  constexpr int CPR = DK / 8;
  constexpr int KCH = 64 * CPR / 256;
  u16* sK = (u16*)smem_raw;
  u16* sV = sK + 64 * KSTR;
  const int tid = opaque_tid(), lane = tid & 63, wid = tid >> 6, l15 = lane & 15, g = lane >> 4;
  const float sc = rsqrtf((float)DK) * 1.4426950408889634f;
  for (int item = bid; item < 1280; item += gridDim.x) {
    int qb, h, kvlen, tokbase, kvbase;
    if (item < 1024) { const int b = item >> 7, rem = item & 127; h = rem & 7; qb = rem >> 3; kvlen = 2560; tokbase = NPROMPT + b * 2048; kvbase = NPROMPT + b * 2560; }
    else { const int it2 = item - 1024; const int b = it2 >> 4, rem = it2 & 15; h = rem & 7; qb = rem >> 3; kvlen = 256; tokbase = b * 256; kvbase = b * 256; }
    const int kvh = h / GRP;
    const u16* Kp = Kb + (size_t)kvbase * KROW + kvh * DK;
    const u16* Vp = Vt + (size_t)kvbase * (HK * 128) + (size_t)kvh * 128 * kvlen;
    const int qrow0 = tokbase + qb * 128 + wid * 32;
    bf16x8 qf[2][KS];
#pragma unroll
    for (int qi = 0; qi < 2; ++qi)
#pragma unroll
      for (int ks = 0; ks < KS; ++ks) qf[qi][ks] = ld8(Q + (size_t)(qrow0 + qi * 16 + l15) * QSTR + h * DK + ks * 32 + g * 8);
    f32x4 ot[2][8];
#pragma unroll
    for (int qi = 0; qi < 2; ++qi)
#pragma unroll
      for (int dj = 0; dj < 8; ++dj) { ot[qi][dj][0] = 0.f; ot[qi][dj][1] = 0.f; ot[qi][dj][2] = 0.f; ot[qi][dj][3] = 0.f; }
    float mrun[2] = {-1e30f, -1e30f}, lrun[2] = {0.f, 0.f};
    const int ntiles = kvlen >> 6;
    const unsigned toffK = (unsigned)((tid >> 3) * KROW + (tid & 7) * 8), toffV = (unsigned)((tid >> 3) * kvlen + (tid & 7) * 8);
    const int kx = tid >> 3;
    const int kperm = ((kx >> 2) & 1) * 16 + (kx >> 3) * 4 + (kx & 3);
    const int kswz = (CPR == 16) ? (kperm & 15) : ((kperm >> 1) & 7);
    const int ldsoffK = kperm * KSTR;
    const int ldsoffV = (tid >> 3) * 64 + (((tid & 7) ^ (((tid >> 3) >> 1) & 7)) * 8);
    u32x4 rk[KCH], rv[4];
#pragma unroll
    for (int i = 0; i < KCH; ++i) { const int rh = i & 1, cgp = i >> 1; rk[i] = *(const u32x4*)(Kp + (size_t)(rh * 32 * KROW + cgp * 64) + toffK); }
#pragma unroll
    for (int i = 0; i < 4; ++i) rv[i] = *(const u32x4*)(Vp + (size_t)i * 32 * kvlen + toffV);
    for (int kt = 0; kt < ntiles; ++kt) {
      const u16* Kt = Kp + (size_t)(kt + 1) * 64 * KROW;
      const u16* Vtp = Vp + (kt + 1) * 64;
      const bool more = kt + 1 < ntiles;
      __syncthreads();
#pragma unroll
      for (int i = 0; i < KCH; ++i) { const int rh = i & 1, cgp = i >> 1; const int c = (tid & 7) + 8 * cgp; const int pos = (CPR == 16) ? (c ^ kswz) : ((c & ~7) | ((c & 7) ^ kswz)); *(u32x4*)(sK + ldsoffK + rh * 32 * KSTR + pos * 8) = rk[i]; }
#pragma unroll
      for (int i = 0; i < 4; ++i) *(u32x4*)(sV + ldsoffV + i * 32 * 64) = rv[i];
      __syncthreads();
      if (more) {
#pragma unroll
        for (int i = 0; i < KCH; ++i) { const int rh = i & 1, cgp = i >> 1; rk[i] = *(const u32x4*)(Kt + (size_t)(rh * 32 * KROW + cgp * 64) + toffK); }
      }
      __builtin_amdgcn_sched_barrier(0);
      f32x4 st[2][4];
#pragma unroll
      for (int qi = 0; qi < 2; ++qi)
#pragma unroll
        for (int kj = 0; kj < 4; ++kj) { st[qi][kj][0] = 0.f; st[qi][kj][1] = 0.f; st[qi][kj][2] = 0.f; st[qi][kj][3] = 0.f; }
#pragma unroll
      for (int ks = 0; ks < KS; ++ks) {
#pragma unroll
        for (int kj = 0; kj < 4; ++kj) {
          const int kc = ks * 4 + g;
          const int kpos = (CPR == 16) ? (kc ^ l15) : ((kc & ~7) | ((kc & 7) ^ ((l15 >> 1) & 7)));
          const bf16x8 ka = ld8(sK + (kj * 16 + l15) * KSTR + kpos * 8);
          __builtin_amdgcn_s_setprio(1);
          st[0][kj] = mma(ka, qf[0][ks], st[0][kj]);
          st[1][kj] = mma(ka, qf[1][ks], st[1][kj]);
          __builtin_amdgcn_s_setprio(0);
        }
        __builtin_amdgcn_sched_barrier(0);
      }
      bf16x8 pf[2][2];
#pragma unroll
      for (int qi = 0; qi < 2; ++qi) {
        float mx = -1e30f;
#pragma unroll
        for (int kj = 0; kj < 4; ++kj)
#pragma unroll
          for (int r = 0; r < 4; ++r) mx = fmaxf(mx, st[qi][kj][r]);
        mx = fmaxf(mx, __shfl_xor(mx, 16)); mx = fmaxf(mx, __shfl_xor(mx, 32));
        const float mnew = fmaxf(mrun[qi], mx);
        const float alpha = __builtin_amdgcn_exp2f((mrun[qi] - mnew) * sc);
        mrun[qi] = mnew;
        float ps = 0.f;
        const float mneg = -mnew * sc;
#pragma unroll
        for (int kj = 0; kj < 4; ++kj)
#pragma unroll
          for (int r = 0; r < 4; ++r) { const float pv = __builtin_amdgcn_exp2f(fmaf(st[qi][kj][r], sc, mneg)); st[qi][kj][r] = pv; ps += pv; }
        lrun[qi] = lrun[qi] * alpha + ps;
#pragma unroll
        for (int dj = 0; dj < 8; ++dj) { ot[qi][dj][0] *= alpha; ot[qi][dj][1] *= alpha; ot[qi][dj][2] *= alpha; ot[qi][dj][3] *= alpha; }
        pf[qi][0] = pack8(st[qi][0], st[qi][1]);
        pf[qi][1] = pack8(st[qi][2], st[qi][3]);
        __builtin_amdgcn_sched_barrier(0);
      }
      if (more) {
#pragma unroll
        for (int i = 0; i < 4; ++i) rv[i] = *(const u32x4*)(Vtp + (size_t)i * 32 * kvlen + toffV);
      }
      __builtin_amdgcn_sched_barrier(0);
#pragma unroll
      for (int kk = 0; kk < 2; ++kk)
#pragma unroll
        for (int dj = 0; dj < 8; ++dj) {
          const bf16x8 va = ld8(sV + (dj * 16 + l15) * 64 + (((kk * 4 + g) ^ ((l15 >> 1) & 7)) * 8));
          __builtin_amdgcn_s_setprio(1);
          ot[0][dj] = mma(va, pf[0][kk], ot[0][dj]);
          ot[1][dj] = mma(va, pf[1][kk], ot[1][dj]);
          __builtin_amdgcn_s_setprio(0);
          if ((dj & 3) == 3) __builtin_amdgcn_sched_barrier(0);
        }
    }
#pragma unroll
    for (int qi = 0; qi < 2; ++qi) {
      const float inv = 1.f / sum_g(lrun[qi]);
      u16* dst = obuf + (size_t)(qrow0 + qi * 16 + l15) * 1024 + h * 128 + g * 4;
#pragma unroll
      for (int dj = 0; dj < 8; ++dj) st4bf(dst + dj * 16, ot[qi][dj][0] * inv, ot[qi][dj][1] * inv, ot[qi][dj][2] * inv, ot[qi][dj][3] * inv);
    }
  }
}

DI void gdn_chunk_phase(const P& p, int j, char* smem_raw) {
  const int bid = opaque_bid();
  char* const ws = opaque_ptr(as_global(p.ws));
  u16* sK = (u16*)smem_raw;
  float* sA = (float*)(smem_raw + 17408);
  float* sG = (float*)(smem_raw + 17408 + 32768);
  float* sBt = sG + 128;
  const int tid = opaque_tid(), lane = tid & 63, wid = tid >> 6, l15 = lane & 15, g = lane >> 4;
  const u16* proj = (const u16*)(ws + WS_R + R_PROJ);
  u16* qn = (u16*)(ws + WS_HBUF); u16* kn = (u16*)(ws + WS_OBUF); u16* vb = (u16*)(ws + WS_R + R_VBUF);
  u16* Tbuf = (u16*)(ws + WS_R + R_TBUF);
  const float* gbuf = (const float*)(ws + WS_R + R_GBUF);
  float* gcb = (float*)(ws + WS_R + R_GCB); float* betab = (float*)(ws + WS_R + R_BETA);
  float* egb = (float*)(ws + WS_R + R_EG); float* edb = (float*)(ws + WS_R + R_ED);
  const float* conv = GIN(17) + (size_t)j * 3 * 3072;
  const float* a_log = GIN(18) + j * 16; const float* dt_bias = GIN(19) + j * 16;
  for (int unit = bid; unit < 2560; unit += gridDim.x) {
    const int cgi = unit >> 3, h = unit & 7;
    int c, nch; if (cgi < 64) { c = cgi & 3; nch = 4; } else { c = (cgi - 64) & 31; nch = 32; }
    const int t0 = cgi * 64;
    const bool has_prev = c > 0, has_next = c < nch - 1;
    __syncthreads();
    {
      const int r = tid >> 4, cc = (tid & 15) * 8;
#pragma unroll
      for (int part = 0; part < 3; ++part) {
        const int ch = part * 1024 + h * 128 + cc;
        float w0[8], w1[8], w2[8];
#pragma unroll
        for (int e = 0; e < 8; ++e) { w0[e] = conv[ch + e]; w1[e] = conv[3072 + ch + e]; w2[e] = conv[6144 + ch + e]; }
        u16* dstb = part == 0 ? qn : (part == 1 ? kn : vb);
        for (int it = 0; it < 4; ++it) {
          const int i = it * 16 + r, t = t0 + i;
          const u16* src = proj + (size_t)t * 4096 + ch;
          const u32x4 xc = *(const u32x4*)src;
          u32x4 xp = {0u, 0u, 0u, 0u}, xn = {0u, 0u, 0u, 0u};
          if (i > 0 || has_prev) xp = *(const u32x4*)(src - 4096);
          if (i < 63 || has_next) xn = *(const u32x4*)(src + 4096);
          float y[8];
#pragma unroll
          for (int e = 0; e < 4; ++e) {
            float a = w0[2 * e] * bflo(xp[e]) + w1[2 * e] * bflo(xc[e]) + w2[2 * e] * bflo(xn[e]);
            float b = w0[2 * e + 1] * bfhi(xp[e]) + w1[2 * e + 1] * bfhi(xc[e]) + w2[2 * e + 1] * bfhi(xn[e]);
            y[2 * e] = a / (1.f + __expf(-a)); y[2 * e + 1] = b / (1.f + __expf(-b));
          }
          if (part < 2) {
            float ss = 0.f;
#pragma unroll
            for (int e = 0; e < 8; ++e) ss += y[e] * y[e];
            ss += __shfl_xor(ss, 1); ss += __shfl_xor(ss, 2); ss += __shfl_xor(ss, 4); ss += __shfl_xor(ss, 8);
            const float rs = rsqrtf(ss + EPS) * (part == 0 ? 0.08838834764831845f : 1.f);
#pragma unroll
            for (int e = 0; e < 8; ++e) y[e] *= rs;
          }
          u32x4 o; o[0] = pack2(y[0], y[1]); o[1] = pack2(y[2], y[3]); o[2] = pack2(y[4], y[5]); o[3] = pack2(y[6], y[7]);
          *(u32x4*)(dstb + (size_t)t * 1024 + h * 128 + cc) = o;
          if (part == 1) *(u32x4*)(sK + i * 136 + cc) = o;
        }
      }
    }
    if (tid < 128) {
      const int dir = tid >> 6, L = tid & 63;
      const int i = dir ? 63 - L : L;
      const float* gb = gbuf + (size_t)(t0 + i) * 32;
      const float gin = gb[dir * 8 + h], bin = gb[16 + dir * 8 + h];
      const float x = gin + dt_bias[dir * 8 + h];
      const float sp = fmaxf(x, 0.f) + log1pf(expf(-fabsf(x)));
      float gv = -expf(a_log[dir * 8 + h]) * sp;
      const float bt = 1.f / (1.f + expf(-bin));
#pragma unroll
      for (int off = 1; off < 64; off <<= 1) { const float v = __shfl_up(gv, off); if (L >= off) gv += v; }
      sG[dir * 64 + i] = gv; sBt[dir * 64 + i] = bt;
      gcb[((size_t)(t0 + i) * 8 + h) * 2 + dir] = gv; betab[((size_t)(t0 + i) * 8 + h) * 2 + dir] = bt;
      { const float gtot = __shfl(gv, 63); egb[((size_t)(t0 + i) * 8 + h) * 2 + dir] = expf(gv); edb[((size_t)(t0 + i) * 8 + h) * 2 + dir] = expf(gtot - gv); }
    }
    __syncthreads();
    {
      f32x4 ga[4];
#pragma unroll
      for (int mt = 0; mt < 4; ++mt) { ga[mt][0] = 0.f; ga[mt][1] = 0.f; ga[mt][2] = 0.f; ga[mt][3] = 0.f; }
#pragma unroll
      for (int ks = 0; ks < 4; ++ks) {
        const bf16x8 a = ld8(sK + (wid * 16 + l15) * 136 + ks * 32 + g * 8);
#pragma unroll
        for (int mt = 0; mt < 4; ++mt) { const bf16x8 b = ld8(sK + (mt * 16 + l15) * 136 + ks * 32 + g * 8); ga[mt] = mma(a, b, ga[mt]); }
      }
#pragma unroll
      for (int dir = 0; dir < 2; ++dir)
#pragma unroll
        for (int mt = 0; mt < 4; ++mt)
#pragma unroll
          for (int r = 0; r < 4; ++r) {
            const int i = wid * 16 + g * 4 + r, m = mt * 16 + l15;
            const bool valid = dir ? (i < m) : (i > m);
            const float val = valid ? sBt[dir * 64 + i] * ga[mt][r] * __expf(sG[dir * 64 + i] - sG[dir * 64 + m]) : 0.f;
            const int ii = dir ? 63 - i : i, mm = dir ? 63 - m : m;
            sA[dir * 4096 + ii * 64 + mm] = val;
          }
    }
    __syncthreads();
    if (wid < 2) {
      const int dir = wid;
      float* Am = sA + dir * 4096;
#pragma unroll
      for (int b = 0; b < 8; ++b) {
#pragma unroll 1
        for (int r = 0; r < 8; ++r) {
          const int i = b * 8 + r;
          float4 av[16]; float tv[64];
#pragma unroll
          for (int c = 0; c < 8; ++c) if (c <= b) {
            av[2 * c] = *(const float4*)(Am + i * 64 + c * 8); av[2 * c + 1] = *(const float4*)(Am + i * 64 + c * 8 + 4);
#pragma unroll
            for (int e = 0; e < 8; ++e) tv[c * 8 + e] = Am[(c * 8 + e) * 64 + lane];
          }
          float a = (i == lane) ? 1.f : 0.f, a2 = 0.f;
#pragma unroll
          for (int c = 0; c < 8; ++c) if (c <= b) {
            a -= av[2 * c].x * tv[c * 8]; a2 -= av[2 * c].y * tv[c * 8 + 1]; a -= av[2 * c].z * tv[c * 8 + 2]; a2 -= av[2 * c].w * tv[c * 8 + 3];
            a -= av[2 * c + 1].x * tv[c * 8 + 4]; a2 -= av[2 * c + 1].y * tv[c * 8 + 5]; a -= av[2 * c + 1].z * tv[c * 8 + 6]; a2 -= av[2 * c + 1].w * tv[c * 8 + 7];
          }
          Am[i * 64 + lane] = a + a2;
        }
      }
      const int mn = dir ? 63 - lane : lane;
      const float bm = sBt[dir * 64 + mn];
      u16* Td = Tbuf + ((size_t)unit * 2 + dir) * 4096;
#pragma unroll 4
      for (int i = 0; i < 64; ++i) { const int in_ = dir ? 63 - i : i; Td[in_ * 64 + mn] = f2bf(Am[i * 64 + lane] * bm); }
    }
  }
}

DI void gdn_scan_phase(const P& p, int j, char* smem_raw) {
  const int bid = opaque_bid();
  char* const ws = opaque_ptr(as_global(p.ws));
  u16* sK = (u16*)smem_raw;
  u16* sV = sK + 64 * 136;
  u16* sST = sV + 64 * 40;
  u16* sVN = sST + 32 * 136;
  u16* sVD = sVN + 32 * 72;
  float* sGc = (float*)(sVD + 32 * 72);
  float* sE = sGc + 64;
  float* sD = sE + 64;
  const int tid = opaque_tid(), lane = tid & 63, w = tid >> 6, l15 = lane & 15, g = lane >> 4;
  const u16* qn = (const u16*)(ws + WS_HBUF); const u16* kn = (const u16*)(ws + WS_OBUF); const u16* vb = (const u16*)(ws + WS_R + R_VBUF);
  const u16* Tbuf = (const u16*)(ws + WS_R + R_TBUF);
  const float* gcb = (const float*)(ws + WS_R + R_GCB);
  const float* egb = (const float*)(ws + WS_R + R_EG); const float* edb = (const float*)(ws + WS_R + R_ED);
  u16* obase = (u16*)(ws + WS_R + R_PROJ);
  for (int wk = bid; wk < 1536; wk += gridDim.x) {
    int seq, rem;
    if (wk < 512) { seq = 16 + (wk >> 6); rem = wk & 63; } else { seq = (wk - 512) >> 6; rem = (wk - 512) & 63; }
    const int h = rem & 7, dir = (rem >> 5) & 1, dvq = (rem >> 3) & 3;
    const int nch = seq < 16 ? 4 : 32;
    const int cgb = seq < 16 ? seq * 4 : 64 + (seq - 16) * 32;
    f32x4 S[2][2];
    if (seq >= 16) {
      const float* s0 = GIN(2 + dir) + (((size_t)(seq - 16) * 2 + j) * 8 + h) * 16384;
#pragma unroll
      for (int dt = 0; dt < 2; ++dt)
#pragma unroll
        for (int et = 0; et < 2; ++et)
#pragma unroll
          for (int r = 0; r < 4; ++r) S[dt][et][r] = s0[(size_t)(w * 32 + dt * 16 + g * 4 + r) * 128 + dvq * 32 + et * 16 + l15];
    } else {
#pragma unroll
      for (int dt = 0; dt < 2; ++dt)
#pragma unroll
        for (int et = 0; et < 2; ++et) { S[dt][et][0] = 0.f; S[dt][et][1] = 0.f; S[dt][et][2] = 0.f; S[dt][et][3] = 0.f; }
    }
    __syncthreads();
#pragma unroll
    for (int dt = 0; dt < 2; ++dt)
#pragma unroll
      for (int et = 0; et < 2; ++et) st4bf(sST + (et * 16 + l15) * 136 + w * 32 + dt * 16 + g * 4, S[dt][et][0], S[dt][et][1], S[dt][et][2], S[dt][et][3]);
    u32x4 pk[4], pv; float pg = 0.f, pe = 0.f, pd = 0.f;
#define SCAN_PREFETCH(cc) do { \
      const int t0n_ = (cgb + (cc)) * 64; \
      _Pragma("unroll") for (int i = 0; i < 4; ++i) { const int ci = tid + 256 * i; const int row = ci >> 4, dc = (ci & 15) * 8; pk[i] = *(const u32x4*)(kn + (size_t)(t0n_ + row) * 1024 + h * 128 + dc); } \
      { const int row = tid >> 2, ec = (tid & 3) * 8; pv = *(const u32x4*)(vb + (size_t)(t0n_ + row) * 1024 + h * 128 + dvq * 32 + ec); } \
      if (tid < 64) { const size_t gi_ = ((size_t)(t0n_ + tid) * 8 + h) * 2 + dir; pg = gcb[gi_]; pe = egb[gi_]; pd = edb[gi_]; } \
    } while (0)
    SCAN_PREFETCH(dir ? nch - 1 : 0);
    bf16x8 qf[4], tf[2];
    {
      const int c0_ = dir ? nch - 1 : 0;
#pragma unroll
      for (int ks = 0; ks < 4; ++ks) qf[ks] = ld8(qn + (size_t)((cgb + c0_) * 64 + w * 16 + l15) * 1024 + h * 128 + ks * 32 + g * 8);
#pragma unroll
      for (int ks = 0; ks < 2; ++ks) tf[ks] = ld8(Tbuf + ((size_t)((cgb + c0_) * 8 + h) * 2 + dir) * 4096 + (w * 16 + l15) * 64 + ks * 32 + g * 8);
    }
    for (int step = 0; step < nch; ++step) {
      const int cnx = (step + 1 < nch) ? (dir ? nch - 2 - step : step + 1) : (dir ? nch - 1 - step : step);
      const int c = dir ? nch - 1 - step : step;
      const int t0 = (cgb + c) * 64;
      const int unit = (cgb + c) * 8 + h;
#pragma unroll
      for (int i = 0; i < 4; ++i) {
        const int ci = tid + 256 * i; const int row = ci >> 4, dc = (ci & 15) * 8;
        *(u32x4*)(sK + row * 136 + dc) = pk[i];
      }
      { const int row = tid >> 2, ec = (tid & 3) * 8; *(u32x4*)(sV + row * 40 + ec) = pv; }
      if (tid < 64) { sGc[tid] = pg; sE[tid] = pe; sD[tid] = pd; }
      __syncthreads();
      if (step + 1 < nch) { const int cn = dir ? nch - 2 - step : step + 1; SCAN_PREFETCH(cn); }
      const float gl = dir ? sGc[0] : sGc[63];
      bf16x8 wf[4];
      f32x4 ua[2];
      {
        bf16x8 vtf[2][2];
        f32x4 egm[2][2];
#pragma unroll
        for (int et = 0; et < 2; ++et)
#pragma unroll
          for (int ks = 0; ks < 2; ++ks) vtf[et][ks] = ldtr(sV + (ks * 32 + g * 8 + (l15 >> 2)) * 40 + et * 16 + (l15 & 3) * 4, 4 * 40);
#pragma unroll
        for (int ks = 0; ks < 2; ++ks) { egm[ks][0] = *(const f32x4*)(sE + ks * 32 + g * 8); egm[ks][1] = *(const f32x4*)(sE + ks * 32 + g * 8 + 4); }
        __builtin_amdgcn_sched_barrier(0);
#pragma unroll
        for (int et = 0; et < 2; ++et) {
          ua[et][0] = 0.f; ua[et][1] = 0.f; ua[et][2] = 0.f; ua[et][3] = 0.f;
#pragma unroll
          for (int ks = 0; ks < 2; ++ks) ua[et] = mma(tf[ks], vtf[et][ks], ua[et]);
        }
#pragma unroll
        for (int ks = 0; ks < 2; ++ks) {
          const u32x4 tw = __builtin_bit_cast(u32x4, tf[ks]);
          u32x4 o;
#pragma unroll
          for (int e = 0; e < 4; ++e) o[e] = pack2(bflo(tw[e]) * egm[ks][e >> 1][(2 * e) & 3], bfhi(tw[e]) * egm[ks][e >> 1][(2 * e + 1) & 3]);
          tf[ks] = __builtin_bit_cast(bf16x8, o);
        }
        __builtin_amdgcn_sched_barrier(0);
      }
#pragma unroll
      for (int kq = 0; kq < 4; ++kq) {
        bf16x8 ktf[2][2];
#pragma unroll
        for (int hh = 0; hh < 2; ++hh)
#pragma unroll
          for (int ks = 0; ks < 2; ++ks) ktf[hh][ks] = ldtr(sK + (ks * 32 + g * 8 + (l15 >> 2)) * 136 + (kq * 2 + hh) * 16 + (l15 & 3) * 4, 4 * 136);
        __builtin_amdgcn_sched_barrier(0);
        f32x4 wa[2];
#pragma unroll
        for (int hh = 0; hh < 2; ++hh) {
          wa[hh][0] = 0.f; wa[hh][1] = 0.f; wa[hh][2] = 0.f; wa[hh][3] = 0.f;
#pragma unroll
          for (int ks = 0; ks < 2; ++ks) wa[hh] = mma(ktf[hh][ks], tf[ks], wa[hh]);
        }
        wf[kq] = pack8(wa[0], wa[1]);
        __builtin_amdgcn_sched_barrier(0);
      }
#pragma unroll
      for (int ks = 0; ks < 2; ++ks) tf[ks] = ld8(Tbuf + ((size_t)((cgb + cnx) * 8 + h) * 2 + dir) * 4096 + (w * 16 + l15) * 64 + ks * 32 + g * 8);
      const int iq = w * 16 + l15;
      const float gi = sGc[iq];
      const f32x4 dvec = *(const f32x4*)(sD + w * 16 + g * 4);
      f32x4 vn[2];
      bf16x8 qkf[2];
      {
        bf16x8 stp[2][4];
#pragma unroll
        for (int et = 0; et < 2; ++et)
#pragma unroll
          for (int kq = 0; kq < 4; ++kq) { const u16* sp = sST + (et * 16 + l15) * 136 + kq * 32 + g * 4; stp[et][kq] = ld44(sp, sp + 16); }
        __builtin_amdgcn_sched_barrier(0);
#pragma unroll
        for (int et = 0; et < 2; ++et) {
          f32x4 a; a[0] = 0.f; a[1] = 0.f; a[2] = 0.f; a[3] = 0.f;
#pragma unroll
          for (int kq = 0; kq < 4; ++kq) a = mma(wf[kq], stp[et][kq], a);
          vn[et][0] = ua[et][0] - a[0]; vn[et][1] = ua[et][1] - a[1]; vn[et][2] = ua[et][2] - a[2]; vn[et][3] = ua[et][3] - a[3];
        }
        __builtin_amdgcn_sched_barrier(0);
      }
#pragma unroll
      for (int kk = 0; kk < 2; ++kk) {
        bf16x8 kf[2][4];
        f32x4 gcm[2];
#pragma unroll
        for (int hh = 0; hh < 2; ++hh)
#pragma unroll
          for (int ks = 0; ks < 4; ++ks) kf[hh][ks] = ld8(sK + ((kk * 2 + hh) * 16 + l15) * 136 + ks * 32 + g * 8);
#pragma unroll
        for (int hh = 0; hh < 2; ++hh) gcm[hh] = *(const f32x4*)(sGc + (kk * 2 + hh) * 16 + g * 4);
        __builtin_amdgcn_sched_barrier(0);
        f32x4 ka[2];
#pragma unroll
        for (int hh = 0; hh < 2; ++hh) {
          const int mt = kk * 2 + hh;
          ka[hh][0] = 0.f; ka[hh][1] = 0.f; ka[hh][2] = 0.f; ka[hh][3] = 0.f;
#pragma unroll
          for (int ks = 0; ks < 4; ++ks) ka[hh] = mma(kf[hh][ks], qf[ks], ka[hh]);
#pragma unroll
          for (int r = 0; r < 4; ++r) {
            const int m = mt * 16 + g * 4 + r;
            const bool valid = dir ? (iq <= m) : (iq >= m);
            ka[hh][r] = ka[hh][r] * __expf(valid ? gi - gcm[hh][r] : -1e30f);
          }
        }
        qkf[kk] = pack8(ka[0], ka[1]);
        __builtin_amdgcn_sched_barrier(0);
      }
#pragma unroll
      for (int et = 0; et < 2; ++et) {
        const int i0 = w * 16 + g * 4;
        st4bf(sVN + (et * 16 + l15) * 72 + i0, vn[et][0], vn[et][1], vn[et][2], vn[et][3]);
        st4bf(sVD + (et * 16 + l15) * 72 + i0, vn[et][0] * dvec[0], vn[et][1] * dvec[1], vn[et][2] * dvec[2], vn[et][3] * dvec[3]);
      }
      __syncthreads();
      {
        bf16x8 stn[2][4], vnp[2][2];
#pragma unroll
        for (int et = 0; et < 2; ++et)
#pragma unroll
          for (int ks = 0; ks < 4; ++ks) stn[et][ks] = ld8(sST + (et * 16 + l15) * 136 + ks * 32 + g * 8);
#pragma unroll
        for (int et = 0; et < 2; ++et)
#pragma unroll
          for (int kk = 0; kk < 2; ++kk) { const u16* sp = sVN + (et * 16 + l15) * 72 + kk * 32 + g * 4; vnp[et][kk] = ld44(sp, sp + 16); }
        const f32x4 egi = *(const f32x4*)(sE + w * 16 + g * 4);
        __builtin_amdgcn_sched_barrier(0);
#pragma unroll
        for (int et = 0; et < 2; ++et) {
          f32x4 a1; a1[0] = 0.f; a1[1] = 0.f; a1[2] = 0.f; a1[3] = 0.f;
#pragma unroll
          for (int ks = 0; ks < 4; ++ks) a1 = mma(qf[ks], stn[et][ks], a1);
          f32x4 a2; a2[0] = 0.f; a2[1] = 0.f; a2[2] = 0.f; a2[3] = 0.f;
#pragma unroll
          for (int kk = 0; kk < 2; ++kk) a2 = mma(qkf[kk], vnp[et][kk], a2);
#pragma unroll
          for (int r = 0; r < 4; ++r) {
            const int i = w * 16 + g * 4 + r;
            const float o = a1[r] * egi[r] + a2[r];
            obase[(size_t)(t0 + i) * 4096 + dir * 1024 + h * 128 + dvq * 32 + et * 16 + l15] = f2bf(o);
          }
        }
#pragma unroll
        for (int ks = 0; ks < 4; ++ks) qf[ks] = ld8(qn + (size_t)((cgb + cnx) * 64 + w * 16 + l15) * 1024 + h * 128 + ks * 32 + g * 8);
        __builtin_amdgcn_sched_barrier(0);
      }
      {
        bf16x8 ktf2[2][2], vdf[2][2];
#pragma unroll
        for (int dt = 0; dt < 2; ++dt)
#pragma unroll
          for (int kk = 0; kk < 2; ++kk) { ktf2[dt][kk] = ldtr(sK + (kk * 32 + g * 8 + (l15 >> 2)) * 136 + w * 32 + dt * 16 + (l15 & 3) * 4, 4 * 136); vdf[dt][kk] = ld8(sVD + (dt * 16 + l15) * 72 + kk * 32 + g * 8); }
        __builtin_amdgcn_sched_barrier(0);
        const float eg = __expf(gl);
#pragma unroll
        for (int dt = 0; dt < 2; ++dt)
#pragma unroll
          for (int et = 0; et < 2; ++et) {
            f32x4 a; a[0] = S[dt][et][0] * eg; a[1] = S[dt][et][1] * eg; a[2] = S[dt][et][2] * eg; a[3] = S[dt][et][3] * eg;
#pragma unroll
            for (int kk = 0; kk < 2; ++kk) a = mma(ktf2[dt][kk], vdf[et][kk], a);
            S[dt][et] = a;
          }
      }
      __syncthreads();
#pragma unroll
      for (int dt = 0; dt < 2; ++dt)
#pragma unroll
        for (int et = 0; et < 2; ++et) st4bf(sST + (et * 16 + l15) * 136 + w * 32 + dt * 16 + g * 4, S[dt][et][0], S[dt][et][1], S[dt][et][2], S[dt][et][3]);
    }
    if (seq < 16) {
      float* so = GOUT + (dir ? O_SB : O_SF) + (((size_t)seq * 2 + j) * 8 + h) * 16384;
#pragma unroll
      for (int dt = 0; dt < 2; ++dt)
#pragma unroll
        for (int et = 0; et < 2; ++et)
#pragma unroll
          for (int r = 0; r < 4; ++r) so[(size_t)(w * 32 + dt * 16 + g * 4 + r) * 128 + dvq * 32 + et * 16 + l15] = S[dt][et][r];
    }
  }
}

#define XB_TMO      128
#define XB_XCNT(j)  (256  + 64 * (j))
#define XB_XSUB(j)  (1280 + 64 * (j))
#define XB_XGEN(j)  (2304 + 64 * (j))
#define XB_TOP      3328
#define XB_TOPGEN   3392
#define XCD_BAR_WORDS 3456
#define XB_SPIN_CAP (1u << 20)
#define LAS __attribute__((address_space(3)))
DI unsigned xb_ld(unsigned* p)              { return __hip_atomic_load(p, __ATOMIC_RELAXED, __HIP_MEMORY_SCOPE_AGENT); }
DI unsigned xb_add(unsigned* p, unsigned v) { return __hip_atomic_fetch_add(p, v, __ATOMIC_RELAXED, __HIP_MEMORY_SCOPE_AGENT); }
DI unsigned xb_xcc_id() { return (unsigned)__builtin_amdgcn_s_getreg((3 << 11) | 20) & 0xFu; }
#define XB_SPIN(cond, bar) do { unsigned _sp = 0; while (cond) { __builtin_amdgcn_s_sleep(1); \
    if ((++_sp & 255u) == 0u) { if (xb_ld(&(bar)[XB_TMO])) break; if (_sp > XB_SPIN_CAP) { atomicAdd(&(bar)[XB_TMO], 1u); break; } } } } while (0)
struct XcdBarrier { unsigned* bar; unsigned x; volatile LAS unsigned* st; };
DI XcdBarrier xcd_barrier_post(unsigned* bar, volatile LAS unsigned* st) {
  XcdBarrier b; b.bar = bar; b.x = xb_xcc_id(); b.st = st;
  if (threadIdx.x == 0) (void)xb_add(&bar[XB_XCNT(b.x)], 1u);
  return b;
}
DI void xcd_barrier_complete(unsigned* bar, unsigned x, unsigned& nloc, unsigned& nx) {
  const unsigned Gn = gridDim.x * gridDim.y * gridDim.z;
  unsigned sum, cnt, mine, sp = 0u;
  for (;;) {
    sum = 0u; cnt = 0u; mine = 0u;
#pragma unroll
    for (unsigned j = 0; j < 16; ++j) { const unsigned c = xb_ld(&bar[XB_XCNT(j)]); sum += c; cnt += (c > 0u) ? 1u : 0u; mine = (j == x) ? c : mine; }
    if (sum == Gn) break;
    __builtin_amdgcn_s_sleep(1);
    if ((++sp & 255u) == 0u) { if (xb_ld(&bar[XB_TMO])) break; if (sp > XB_SPIN_CAP) { atomicAdd(&bar[XB_TMO], 1u); break; } }
  }
  nloc = mine > 0u ? mine : 1u; nx = cnt > 0u ? cnt : 1u;
}
DI void xcd_barrier(const XcdBarrier& b) {
  asm volatile("s_waitcnt vmcnt(0)" ::: "memory");
  __syncthreads();
  if (threadIdx.x == 0) {
    unsigned* bar = b.bar;
    __builtin_amdgcn_s_waitcnt(0);
    unsigned nloc = b.st[0], nx = b.st[1];
    if (nloc == 0u) { xcd_barrier_complete(bar, b.x, nloc, nx); b.st[0] = nloc; b.st[1] = nx; }
    const unsigned old = xb_add(&bar[XB_XSUB(b.x)], 1u);
    const unsigned gen = old / nloc;
    if (old + 1u == (gen + 1u) * nloc) {
      __builtin_amdgcn_fence(__ATOMIC_RELEASE, "agent");
      asm volatile("s_waitcnt vmcnt(0)" ::: "memory");
      const unsigned og = xb_add(&bar[XB_TOP], 1u);
      const unsigned tg = og / nx;
      if (og + 1u == (tg + 1u) * nx) xb_add(&bar[XB_TOPGEN], 1u);
      else XB_SPIN(xb_ld(&bar[XB_TOPGEN]) == tg, bar);
      __builtin_amdgcn_fence(__ATOMIC_ACQUIRE, "agent");
      xb_add(&bar[XB_XGEN(b.x)], 1u);
      asm volatile("s_waitcnt vmcnt(0)" ::: "memory");
    } else {
      XB_SPIN(xb_ld(&bar[XB_XGEN(b.x)]) == gen, bar);
      __builtin_amdgcn_fence(__ATOMIC_ACQUIRE, "agent");
      asm volatile("s_waitcnt vmcnt(0)" ::: "memory");
    }
  }
  __syncthreads();
}

__global__ void __launch_bounds__(256, 2) fwd_megakernel(P p) {
  cg::grid_group grid = cg::this_grid();
  __shared__ __attribute__((aligned(16))) char smem[60416];
  const int tid = opaque_tid(), lane = tid & 63, wid = tid >> 6;
  const int G = gridDim.x;
  __shared__ uint4 xb_words;
  if (threadIdx.x == 0) xb_words = make_uint4(0u, 0u, 0u, 0u);
  __syncthreads();
  (void)xcd_barrier_post((unsigned*)(as_global(p.ws) + WS_BAR), (volatile LAS unsigned*)&xb_words);
#define GSYNC() do { XcdBarrier xb_; xb_.bar = (unsigned*)(opaque_ptr(as_global(p.ws)) + WS_BAR); xb_.x = xb_xcc_id(); xb_.st = (volatile LAS unsigned*)&xb_words; xcd_barrier(xb_); } while (0)
  const int bid0 = opaque_bid();
  {
  char* const ws0 = opaque_ptr(as_global(p.ws));
  float* mods = (float*)(ws0 + WS_MODS);
  float* ropeT = (float*)(ws0 + WS_ROPE);
  float* cosG = ropeT, *sinG = ropeT + 2048, *cosM = ropeT + 4096, *sinM = ropeT + 5120;

  {
    float* sc = (float*)smem;
    float* red = sc + 9 * 128;
    float* part = (float*)(ws0 + WS_R);
    for (int item = bid0; item < 3072; item += G) {
      const int ks = item & 7, cgp = (item >> 3) % 96, layer = item / 768;
      __syncthreads();
      for (int e = tid; e < 9 * 128; e += 256) {
        const int ci = e >> 7, k = ks * 128 + (e & 127);
        const float v = ci == 0 ? GIN(9)[k] : GIN(8)[(ci - 1) * 1024 + k];
        sc[e] = v / (1.f + expf(-v));
      }
      __syncthreads();
      const int col = tid & 63, kg = tid >> 6;
      const float* wp = GIN(12) + ((size_t)layer * 1024 + ks * 128 + kg * 32) * 6144 + cgp * 64 + col;
      float acc[9];
#pragma unroll
      for (int ci = 0; ci < 9; ++ci) acc[ci] = 0.f;
      float wvv[32];
#pragma unroll
      for (int kk = 0; kk < 32; ++kk) wvv[kk] = wp[(size_t)kk * 6144];
#pragma unroll
      for (int kk = 0; kk < 32; ++kk) {
#pragma unroll
        for (int ci = 0; ci < 9; ++ci) acc[ci] += sc[ci * 128 + kg * 32 + kk] * wvv[kk];
      }
#pragma unroll
      for (int ci = 0; ci < 9; ++ci) red[(kg * 64 + col) * 9 + ci] = acc[ci];
      __syncthreads();
      if (kg == 0) {
        const int n = cgp * 64 + col;
        const float bias = ks == 0 ? GIN(13)[(size_t)layer * 6144 + n] : 0.f;
#pragma unroll
        for (int ci = 0; ci < 9; ++ci) {
          const float s = red[col * 9 + ci] + red[(64 + col) * 9 + ci] + red[(128 + col) * 9 + ci] + red[(192 + col) * 9 + ci] + bias;
          part[(size_t)ks * 221184 + ((size_t)layer * 9 + ci) * 6144 + n] = s;
        }
      }
    }
    if (bid0 == G - 1) {
      for (int e = tid; e < 2048; e += 256) { const int pos = e >> 5, f = e & 31; const float fr = powf(10000.f, -(float)f / 32.f); const float a = (float)pos * fr; cosG[e] = cosf(a); sinG[e] = sinf(a); }
      for (int e = tid; e < 1024; e += 256) { const int pos = e >> 4, f = e & 15; const float fr = powf(10000.f, -(float)f / 16.f); const float a = (float)pos * fr; cosM[e] = cosf(a); sinM[e] = sinf(a); }
    }
  }
  if (gridDim.x == 0x7fffffffu) grid.sync();
  GSYNC();
  {
    const float* part = (const float*)(ws0 + WS_R);
    for (int e = bid0 * 256 + tid; e < 221184; e += G * 256) {
      float sacc = 0.f;
#pragma unroll
      for (int ks = 0; ks < 8; ++ks) sacc += part[(size_t)ks * 221184 + e];
      mods[e] = sacc;
    }
  }
  }
  GSYNC();

#pragma unroll 1
  for (int layer = 0; layer < 4; ++layer) {
    const int kind = layer % 3, j = layer / 3;
    const int bid = opaque_bid();
    char* const ws = opaque_ptr(as_global(p.ws));
    float* mods = (float*)(ws + WS_MODS);
    float* ropeT = (float*)(ws + WS_ROPE);
    float* cosG = ropeT, *sinG = ropeT + 2048, *cosM = ropeT + 4096, *sinM = ropeT + 5120;
    u16* hbuf = (u16*)(ws + WS_HBUF);
    u16* obuf = (u16*)(ws + WS_OBUF);
    u16* wmix = (u16*)(ws + ((layer & 1) ? WS_W2MIX : WS_WMIX));
    u16* wmlp = (u16*)(ws + ((layer & 1) ? WS_W2MLP : WS_WMLP));
    u16* wmixN = (u16*)(ws + ((layer & 1) ? WS_WMIX : WS_W2MIX));
    u16* wmlpN = (u16*)(ws + ((layer & 1) ? WS_WMLP : WS_W2MLP));
    char* R = ws + WS_R;
    const float* lmods = mods + (size_t)layer * 9 * 6144;
    {
      for (int it = bid; it < 2560; it += G) norm_rows(p, layer, layer == 0, it, GIN(10) + layer * 1024, 0, 1);
      if (layer == 0 || G <= 256) convert_layer(p, layer, wmix, wmlp, bid, G, (float*)smem);
      if (kind == 2) {
        u16* Kg = (u16*)(R + R_KG); u16* Vg = (u16*)(R + R_VTG);
        const int tid = opaque_tid();
        for (int it = bid; it < 512; it += G) {
          const int b = it >> 6, s0 = (it & 63) * 8;
          const int ch = tid;
          float kv[8], vv[8];
#pragma unroll
          for (int e = 0; e < 8; ++e) { kv[e] = GIN(6)[((size_t)b * 512 + s0 + e) * 256 + ch]; vv[e] = GIN(7)[((size_t)b * 512 + s0 + e) * 256 + ch]; }
#pragma unroll
          for (int e = 0; e < 8; ++e) Kg[(size_t)(NPROMPT + b * 2560 + s0 + e) * 256 + ch] = f2bf(kv[e]);
          u32x4 o; o[0] = pack2(vv[0], vv[1]); o[1] = pack2(vv[2], vv[3]); o[2] = pack2(vv[4], vv[5]); o[3] = pack2(vv[6], vv[7]);
          *(u32x4*)(Vg + (size_t)(NPROMPT + b * 2560) * 256 + (size_t)ch * 2560 + s0) = o;
        }
      }
    }
    GSYNC();

    if (kind == 0) {
      {
        EpiGdnIn epi; epi.proj = (u16*)(R + R_PROJ); epi.gbuf = (float*)(R + R_GBUF);
        for (int it = bid; it < 160 * 16; it += G) { const int mt = it >> 4, nt = it & 15; gemm_tile_wide(hbuf, 1024, wmix + WM_IN, 1024, 1024, mt * 128, nt * 256, (u16*)smem, epi); }
        for (int it = bid; it < 160; it += G) gemm_tile<4>(hbuf, 1024, wmix + WM_IN, 1024, 1024, it * 128, 4096, (u16*)smem, epi);
      }
      GSYNC();
      gdn_chunk_phase(p, j, smem);
      GSYNC();
      gdn_scan_phase(p, j, smem);
      GSYNC();
      {
        const u16* pr = (const u16*)(R + R_PROJ);
        const float* on = GIN(20) + j * 128;
        const int tid = opaque_tid();
        for (int t4 = bid; t4 < NTOK / 4; t4 += G) {
          const int h = tid >> 5, c = (tid & 31) * 4;
          u32x2 fv[4], bv[4], zv[4];
#pragma unroll
          for (int u = 0; u < 4; ++u) {
            const u16* row = pr + (size_t)(t4 * 4 + u) * 4096;
            fv[u] = *(const u32x2*)(row + h * 128 + c); bv[u] = *(const u32x2*)(row + 1024 + h * 128 + c); zv[u] = *(const u32x2*)(row + 3072 + h * 128 + c);
          }
          const float4 gn = *(const float4*)(on + c);
          const float gg[4] = {gn.x, gn.y, gn.z, gn.w};
#pragma unroll
          for (int u = 0; u < 4; ++u) {
            const u32x2 f = fv[u], b = bv[u], z = zv[u];
            float o[4] = {bflo(f[0]) + bflo(b[0]), bfhi(f[0]) + bfhi(b[0]), bflo(f[1]) + bflo(b[1]), bfhi(f[1]) + bfhi(b[1])};
            float zz[4] = {bflo(z[0]), bfhi(z[0]), bflo(z[1]), bfhi(z[1])};
            float ss = o[0] * o[0] + o[1] * o[1] + o[2] * o[2] + o[3] * o[3];
            ss += __shfl_xor(ss, 1); ss += __shfl_xor(ss, 2); ss += __shfl_xor(ss, 4); ss += __shfl_xor(ss, 8); ss += __shfl_xor(ss, 16);
            const float rs = rsqrtf(ss * (1.f / 128.f) + EPS);
            float y[4];
#pragma unroll
            for (int e = 0; e < 4; ++e) y[e] = o[e] * rs * gg[e] * (zz[e] / (1.f + __expf(-zz[e])));
            st4bf(obuf + (size_t)(t4 * 4 + u) * 1024 + h * 128 + c, y[0], y[1], y[2], y[3]);
          }
        }
      }
      GSYNC();
    } else if (kind == 1) {
      {
        EpiF32 epi; epi.dst = (float*)(R + R_DPROJ); epi.ld = 768;
        for (int it = bid; it < 160 * 6; it += G) { const int mt = it / 6, nt = it % 6; gemm_tile<4>(hbuf, 1024, wmix + WM_IN, 1024, 1024, mt * 128, nt * 128, (u16*)smem, epi); }
      }
      GSYNC();
      {
        const float* dproj = (const float*)(R + R_DPROJ);
        u16* cq = (u16*)(R + R_CQ); u16* ckv = (u16*)(R + R_CKV); u16* Km = (u16*)(R + R_KM);
        const int tid = opaque_tid(), lane = tid & 63, wid = tid >> 6;
        for (int it = bid; it < 6144; it += G) {
          const int row = it * 4 + wid;
          if (row < NTOK) {
            const int t = row;
            const float* pr = dproj + (size_t)t * 768;
            float v[6]; float ss = 0.f;
#pragma unroll
            for (int e = 0; e < 6; ++e) { v[e] = pr[lane + 64 * e]; ss += v[e] * v[e]; }
            ss = wave_sum(ss);
            float rs = rsqrtf(ss * (1.f / 384.f) + EPS);
#pragma unroll
            for (int e = 0; e < 6; ++e) cq[(size_t)t * 384 + lane + 64 * e] = f2bf(v[e] * rs * GIN(23)[lane + 64 * e]);
            const int kvrow = kvrow_of_tok(t);
            float wv[4]; ss = 0.f;
#pragma unroll
            for (int e = 0; e < 4; ++e) { wv[e] = pr[384 + lane + 64 * e]; ss += wv[e] * wv[e]; }
            ss = wave_sum(ss);
            rs = rsqrtf(ss * (1.f / 256.f) + EPS);
#pragma unroll
            for (int e = 0; e < 4; ++e) {
              const float o = wv[e] * rs * GIN(24)[lane + 64 * e];
              ckv[(size_t)kvrow * 256 + lane + 64 * e] = f2bf(o);
              if (t < NPROMPT) GOUT[O_CKV + (size_t)t * 256 + lane + 64 * e] = o;
            }
            const float x = pr[640 + lane];
            ss = wave_sum(x * x);
            float kr = x * rsqrtf(ss * (1.f / 64.f) + EPS) * GIN(30)[lane];
            if (t < NPROMPT) GOUT[O_KR + (size_t)t * 64 + lane] = kr;
            else {
              const int s = (t - NPROMPT) & 2047;
              const int pos = lane < 32 ? (s >> 6) : (s & 63);
              const float cs = cosM[pos * 16 + (lane & 15)], sn = sinM[pos * 16 + (lane & 15)];
              const float partner = __shfl_xor(kr, 16);
              kr = ((lane & 16) == 0) ? kr * cs - partner * sn : partner * sn + kr * cs;
            }
            const u16 kb = f2bf(kr);
#pragma unroll
            for (int hh = 0; hh < 8; ++hh) Km[(size_t)kvrow * 1536 + hh * 192 + 128 + lane] = kb;
          } else {
            const int r = row - NTOK; const int b = r >> 9, s = r & 511;
            const int kvrow = NPROMPT + b * 2560 + s;
#pragma unroll
            for (int e = 0; e < 4; ++e) ckv[(size_t)kvrow * 256 + lane + 64 * e] = f2bf(GIN(4)[((size_t)b * 512 + s) * 256 + lane + 64 * e]);
            const u16 kb = f2bf(GIN(5)[((size_t)b * 512 + s) * 64 + lane]);
#pragma unroll
            for (int hh = 0; hh < 8; ++hh) Km[(size_t)kvrow * 1536 + hh * 192 + 128 + lane] = kb;
          }
        }
      }
      GSYNC();
      {
        EpiMlaUq e1; e1.Q = (u16*)(R + R_Q); e1.gnope = GIN(27); e1.grope = GIN(28); e1.cosT = cosM; e1.sinT = sinM;
        for (int it = bid; it < 160 * 12; it += G) { const int mt = it / 12, nt = it % 12; gemm_tile<8>((const u16*)(R + R_CQ), 384, wmix + WM_UQ, 384, 384, mt * 128, nt * 128, (u16*)smem, e1); }
        EpiMlaUkv e2; e2.Kb = (u16*)(R + R_KM); e2.Vt = (u16*)(R + R_VTM); e2.gnope = GIN(29);
        for (int it = bid; it < 192 * 16; it += G) { const int mt = it / 16, nt = it % 16; gemm_tile<8>((const u16*)(R + R_CKV), 256, wmix + WM_UKV, 256, 256, mt * 128, nt * 128, (u16*)smem, e2); }
      }
      GSYNC();
      attn_phase<192, 8>((const u16*)(R + R_Q), (const u16*)(R + R_KM), (const u16*)(R + R_VTM), obuf, smem);
      GSYNC();
    } else {
      {
        EpiGqaIn epi; epi.Q = (u16*)(R + R_Q); epi.Kb = (u16*)(R + R_KG); epi.Vt = (u16*)(R + R_VTG); epi.qg = GIN(33); epi.kg = GIN(34); epi.cosT = cosG; epi.sinT = sinG; epi.out = GOUT;
        for (int it = bid; it < 160 * 12; it += G) { const int mt = it / 12, nt = it % 12; gemm_tile<8>(hbuf, 1024, wmix + WM_IN, 1024, 1024, mt * 128, nt * 128, (u16*)smem, epi); }
      }
      GSYNC();
      attn_phase<128, 2>((const u16*)(R + R_Q), (const u16*)(R + R_KG), (const u16*)(R + R_VTG), obuf, smem);
      GSYNC();
    }

    for (int it = bid; it < 768; it += G) {
      const bool wide = it < 512;
      int m0, n0;
      if (wide) { m0 = (it >> 2) * 128; n0 = (it & 3) * 256; } else { const int ix = it - 512; m0 = (128 + (ix >> 3)) * 128; n0 = (ix & 7) * 128; }
      EpiResid epi;
      epi.xin = (layer == 0) ? (m0 < NPROMPT ? GIN(0) : GIN(1) - (size_t)NPROMPT * 1024) : GOUT;
      epi.xout = GOUT; epi.gate = lmods + (size_t)cond_of(m0) * 6144 + 2 * 1024;
      if (wide) gemm_tile_wide(obuf, 1024, wmix + WM_OUT, 1024, 1024, m0, n0, (u16*)smem, epi);
      else gemm_tile<4>(obuf, 1024, wmix + WM_OUT, 1024, 1024, m0, n0, (u16*)smem, epi);
    }
    GSYNC();
    for (int it = bid; it < 2560; it += G) norm_rows(p, layer, false, it, GIN(11) + layer * 1024, 3, 4);
    GSYNC();
    {
      EpiMlpIn epi; epi.abuf = (u16*)(R + R_ABUF);
      for (int it = bid; it < 160 * 16; it += G) { const int mt = it >> 4, nt = it & 15; gemm_tile_wide(hbuf, 1024, wmlp, 1024, 1024, mt * 128, nt * 256, (u16*)smem, epi); }
    }
    GSYNC();
    for (int it = bid; it < 768; it += G) {
      const bool wide = it < 512;
      int m0, n0;
      if (wide) { m0 = (it >> 2) * 128; n0 = (it & 3) * 256; } else { const int ix = it - 512; m0 = (128 + (ix >> 3)) * 128; n0 = (ix & 7) * 128; }
      EpiResid epi; epi.xin = GOUT; epi.xout = GOUT; epi.gate = lmods + (size_t)cond_of(m0) * 6144 + 5 * 1024;
      if (wide) gemm_tile_wide((const u16*)(R + R_ABUF), 4096, wmlp + 4194304, 4096, 4096, m0, n0, (u16*)smem, epi);
      else gemm_tile<4>((const u16*)(R + R_ABUF), 4096, wmlp + 4194304, 4096, 4096, m0, n0, (u16*)smem, epi);
    }
    if (G > 256 && layer < 3 && bid >= 256) convert_layer(p, layer + 1, wmixN, wmlpN, bid - 256, G - 256, (float*)smem);
    GSYNC();
  }
}

extern "C" void kernel_launch(void* const* d_in, const int* in_sizes, int n_in, void* d_out, int out_size, void* d_ws, size_t ws_size, hipStream_t stream) {
  static int grid_blocks = 0;
  if (!grid_blocks) {
    int dev = 0, cus = 0, per_cu = 0;
    hipGetDevice(&dev);
    hipDeviceGetAttribute(&cus, hipDeviceAttributeMultiprocessorCount, dev);
    hipOccupancyMaxActiveBlocksPerMultiprocessor(&per_cu, fwd_megakernel, 256, 0);
    if (per_cu < 1) per_cu = 1;
    if (per_cu > 2) per_cu = 2;
    grid_blocks = cus * per_cu;
  }
  P p{};
  for (int i = 0; i < 36; ++i) p.in[i] = (const float*)d_in[i];
  p.out = (float*)d_out;
  p.ws = (char*)d_ws;
  (void)hipMemsetAsync((char*)d_ws + WS_BAR, 0, XCD_BAR_WORDS * 4, stream);
  void* args[] = {&p};
  hipError_t e = hipLaunchCooperativeKernel((void*)fwd_megakernel, dim3(grid_blocks), dim3(256), args, 0, stream);
  if (e != hipSuccess) fprintf(stderr, "cooperative launch failed: %s (grid %d)\n", hipGetErrorString(e), grid_blocks);
}
```
